# Optimizing an MI355X kernel written in HIP

```python
import jax
import jax.numpy as jnp
from jax import lax
import numpy as np

D_MODEL = 1024
BATCH = 8
SEQ = 2048
DEPTH = 1

MEM_LEN = 256
HEAD_DIM = 64
NORM_EPS = 1e-5

RWKV_HEADS = 8
RWKV_DIM = RWKV_HEADS * HEAD_DIM
DECAY_LORA = 64
AAA_LORA = 64
GATE_LORA = 128
GN_EPS = HEAD_DIM * 1e-5
RWKV_SPLITS = (RWKV_DIM, RWKV_DIM, RWKV_DIM, DECAY_LORA, AAA_LORA, GATE_LORA)
RWKV_IN = 3 * RWKV_DIM + DECAY_LORA + AAA_LORA + GATE_LORA

DIL_PATTERNS = ((128, 1), (512, 4), (2048, 16))
DIL_HEADS_PER_GROUP = 4
DIL_HEADS = DIL_HEADS_PER_GROUP * 3
DIL_DIM = DIL_HEADS * HEAD_DIM
DIL_OUT_DIM = DIL_HEADS_PER_GROUP * HEAD_DIM
ATTN_BLOCK = 128

MEM_HEADS = 4
MEM_HEAD_DIM = 128
MEM_DIM = MEM_HEADS * MEM_HEAD_DIM

N_BRANCHES = 3
IN_COLS = RWKV_IN + 3 * DIL_DIM + MEM_DIM + N_BRANCHES * D_MODEL

N_EXPERTS = 32
TOP_K = 4
D_FF = D_MODEL
SWIGLU_ALPHA = 1.702
SWIGLU_LIMIT = 7.0
MOE_BLOCK = 128

kernel_name = 'rwkv7_dilated_memory_moe_hybrid'


def rms_norm(x, gain):
    xf = x.astype(jnp.float32)
    y = xf * lax.rsqrt(jnp.mean(xf * xf, axis=-1, keepdims=True) + NORM_EPS)
    return (y * gain.astype(jnp.float32)).astype(x.dtype)


def token_shift(z):
    return jnp.pad(z, ((0, 0), (1, 0), (0, 0)))[:, :-1]


def rwkv7_scan(r, w, k, v, a, b):
    bsz, _, h, n = r.shape

    def step(state, inp):
        r_t, w_t, k_t, v_t, a_t, b_t = inp
        sa = jnp.einsum('bhvk,bhk->bhv', state, a_t)
        state = (state * w_t[:, :, None, :] + sa[..., None] * b_t[:, :, None, :]
                 + v_t[..., None] * k_t[:, :, None, :])
        return state, jnp.einsum('bhvk,bhk->bhv', state, r_t)

    xs = tuple(jnp.swapaxes(t, 0, 1) for t in (r, w, k, v, a, b))
    _, ys = lax.scan(step, jnp.zeros((bsz, h, n, n), jnp.float32), xs)
    return jnp.swapaxes(ys, 0, 1)


def rwkv7_time_mix(zr, w0, w2, a0, a2, g2, k_k, k_a, r_k, ln_w, ln_b):
    bsz, s, _ = zr.shape
    r, k, v, zw, za, zg = jnp.split(zr, list(np.cumsum(RWKV_SPLITS)[:-1]), axis=-1)
    w = -jax.nn.softplus(-(w0 + jnp.tanh(zw) @ w2)) - 0.5
    decay = jnp.exp(-jnp.exp(w.astype(jnp.float32)))
    a = jax.nn.sigmoid(a0 + za @ a2)
    g = jax.nn.sigmoid(zg) @ g2

    def hd(t):
        return t.reshape(bsz, s, RWKV_HEADS, HEAD_DIM).astype(jnp.float32)

    kk = hd(k * k_k)
    kk = kk / jnp.maximum(jnp.sqrt(jnp.sum(kk * kk, axis=-1, keepdims=True)), 1e-12)
    k = k * (1.0 + (a - 1.0) * k_a)
    r_h, k_h, v_h, a_h = hd(r), hd(k), hd(v), hd(a)
    y = rwkv7_scan(r_h, hd(decay), k_h, v_h, -kk, kk * a_h)
    mu = jnp.mean(y, axis=-1, keepdims=True)
    var = jnp.mean(jnp.square(y - mu), axis=-1, keepdims=True)
    yn = ((y - mu) * lax.rsqrt(var + GN_EPS)).reshape(bsz, s, RWKV_DIM)
    yn = yn * ln_w.astype(jnp.float32) + ln_b.astype(jnp.float32)
    bonus = (jnp.sum(r_h * k_h * r_k.astype(jnp.float32), axis=-1, keepdims=True) * v_h).reshape(bsz, s, RWKV_DIM)
    return ((yn + bonus) * g.astype(jnp.float32)).astype(zr.dtype)


def dilated_group_attn(q, k, v, window, dilation):
    bsz, h, s, dh = q.shape
    span = window // dilation
    n = s // dilation
    nb = -(-n // ATTN_BLOCK)
    n_pad = nb * ATTN_BLOCK

    def strided(t, front):
        t = t.reshape(bsz, h, n, dilation, dh).transpose(0, 1, 3, 2, 4)
        return jnp.pad(t, ((0, 0), (0, 0), (0, 0), (front, n_pad - n), (0, 0)))

    qb = strided(q, 0).reshape(bsz, h, dilation, nb, ATTN_BLOCK, dh)

    def key_blocks(t):
        tb = strided(t, ATTN_BLOCK).reshape(bsz, h, dilation, nb + 1, ATTN_BLOCK, dh)
        return jnp.concatenate([tb[:, :, :, :-1], tb[:, :, :, 1:]], axis=4)

    kb = key_blocks(k)
    vb = key_blocks(v)
    sc = jnp.einsum('bhrnqd,bhrnkd->bhrnqk', qb, kb).astype(jnp.float32) * dh ** -0.5
    qi = jnp.arange(ATTN_BLOCK)[:, None]
    ki = jnp.arange(2 * ATTN_BLOCK)[None, :]
    offset = qi + ATTN_BLOCK - ki
    key_idx = jnp.arange(nb)[:, None, None] * ATTN_BLOCK - ATTN_BLOCK + ki
    mask = (offset >= 0) & (offset <= span) & (key_idx >= 0)
    sc = jnp.where(mask, sc, -jnp.inf)
    m = jnp.max(sc, axis=-1, keepdims=True)
    p = jnp.exp(sc - m)
    den = jnp.sum(p, axis=-1, keepdims=True)
    o = jnp.einsum('bhrnqk,bhrnkd->bhrnqd', p, vb.astype(jnp.float32)) / den
    lse = (m + jnp.log(den))[..., 0]
    o = o.reshape(bsz, h, dilation, n_pad, dh)[:, :, :, :n].transpose(0, 1, 3, 2, 4).reshape(bsz, h, s, dh)
    lse = lse.reshape(bsz, h, dilation, n_pad)[..., :n].transpose(0, 1, 3, 2).reshape(bsz, h, s)
    return o, lse


def dilated_attention(q, k, v, q_norm, k_norm):
    bsz, s, _ = q.shape

    def heads(t):
        return t.reshape(bsz, s, DIL_HEADS, HEAD_DIM)

    qh = rms_norm(heads(q), q_norm).transpose(0, 2, 1, 3)
    kh = rms_norm(heads(k), k_norm).transpose(0, 2, 1, 3)
    vh = heads(v).transpose(0, 2, 1, 3)
    outs, lses = [], []
    for gi, (window, dilation) in enumerate(DIL_PATTERNS):
        sl = slice(gi * DIL_HEADS_PER_GROUP, (gi + 1) * DIL_HEADS_PER_GROUP)
        o, l = dilated_group_attn(qh[:, sl], kh[:, sl], vh[:, sl], window, dilation)
        outs.append(o)
        lses.append(l)
    outs = jnp.stack(outs)
    wts = jax.nn.softmax(jnp.stack(lses), axis=0)
    o = jnp.sum(wts[..., None] * outs, axis=0)
    return o.transpose(0, 2, 1, 3).reshape(bsz, s, DIL_OUT_DIM).astype(q.dtype)


def memory_cross_attn(q, mem, ln_mem, w_mem_kv, q_norm, k_norm):
    bsz, s, _ = q.shape
    m_len = mem.shape[1]
    kv = rms_norm(mem, ln_mem) @ w_mem_kv
    k, v = jnp.split(kv, 2, axis=-1)
    qh = rms_norm(q.reshape(bsz, s, MEM_HEADS, MEM_HEAD_DIM), q_norm)
    kh = rms_norm(k.reshape(bsz, m_len, MEM_HEADS, MEM_HEAD_DIM), k_norm)
    vh = v.reshape(bsz, m_len, MEM_HEADS, MEM_HEAD_DIM)
    sc = jnp.einsum('bshd,bmhd->bhsm', qh, kh).astype(jnp.float32) * MEM_HEAD_DIM ** -0.5
    p = jax.nn.softmax(sc, axis=-1)
    o = jnp.einsum('bhsm,bmhd->bshd', p, vh.astype(jnp.float32))
    return o.reshape(bsz, s, MEM_DIM).astype(q.dtype)


def mixer_sublayer(x, mem, ln1, w_in, token_mu, rwkv_w0, rwkv_w2, rwkv_a0, rwkv_a2, rwkv_g2,
                   rwkv_k_k, rwkv_k_a, rwkv_r_k, rwkv_ln_w, rwkv_ln_b, dil_q_norm, dil_k_norm,
                   ln_mem, w_mem_kv, mem_q_norm, mem_k_norm, p_rwkv, p_dil, p_mem, w_out):
    bsz, s, _ = x.shape
    h = rms_norm(x, ln1)
    z = h @ w_in
    cut = [RWKV_IN, RWKV_IN + 3 * DIL_DIM, RWKV_IN + 3 * DIL_DIM + MEM_DIM]
    zr, z_dil, z_memq, z_gate = jnp.split(z, cut, axis=-1)
    zr = zr + (token_shift(zr) - zr) * token_mu
    y_rwkv = rwkv7_time_mix(zr, rwkv_w0, rwkv_w2, rwkv_a0, rwkv_a2, rwkv_g2,
                            rwkv_k_k, rwkv_k_a, rwkv_r_k, rwkv_ln_w, rwkv_ln_b)
    dq, dk, dv = jnp.split(z_dil, 3, axis=-1)
    y_dil = dilated_attention(dq, dk, dv, dil_q_norm, dil_k_norm)
    y_mem = memory_cross_attn(z_memq, mem, ln_mem, w_mem_kv, mem_q_norm, mem_k_norm)
    g = jax.nn.sigmoid(z_gate).reshape(bsz, s, N_BRANCHES, D_MODEL)
    mixed = (g[:, :, 0] * (y_rwkv @ p_rwkv) + g[:, :, 1] * (y_dil @ p_dil)
             + g[:, :, 2] * (y_mem @ p_mem))
    return x + mixed @ w_out


def moe_ffn(h, w_router, b_router, w1, b1, w2, b2):
    bsz, s, d = h.shape
    n_tok = bsz * s
    n_asg = n_tok * TOP_K
    xt = h.reshape(n_tok, d)
    logits = (xt @ w_router).astype(jnp.float32) + b_router.astype(jnp.float32)
    top_vals, top_idx = lax.top_k(logits, TOP_K)
    gates = jax.nn.softmax(top_vals, axis=-1)
    flat_e = top_idx.reshape(-1).astype(jnp.int32)
    flat_w = gates.reshape(-1)
    flat_tok = jnp.arange(n_asg, dtype=jnp.int32) // TOP_K
    order = jnp.argsort(flat_e)
    se, stok, sw = flat_e[order], flat_tok[order], flat_w[order]
    counts = jnp.bincount(flat_e, length=N_EXPERTS).astype(jnp.int32)
    padded = ((counts + MOE_BLOCK - 1) // MOE_BLOCK) * MOE_BLOCK
    pend = jnp.cumsum(padded)
    pstart = pend - padded
    sstart = jnp.cumsum(counts) - counts
    dest = pstart[se] + (jnp.arange(n_asg, dtype=jnp.int32) - sstart[se])
    n_blocks = -(-n_asg // MOE_BLOCK) + N_EXPERTS
    n_slots = n_blocks * MOE_BLOCK
    slot_tok = jnp.zeros((n_slots,), jnp.int32).at[dest].set(stok)
    slot_w = jnp.zeros((n_slots,), jnp.float32).at[dest].set(sw)
    block_start = jnp.arange(n_blocks, dtype=jnp.int32) * MOE_BLOCK
    block_e = jnp.minimum(jnp.searchsorted(pend, block_start, side='right'), N_EXPERTS - 1)
    xs = xt[slot_tok].reshape(n_blocks, MOE_BLOCK, d)

    def expert_block(args):
        xb, e = args
        hb = xb @ w1[e] + b1[e]
        x_glu = jnp.minimum(hb[:, ::2], SWIGLU_LIMIT)
        x_lin = jnp.clip(hb[:, 1::2], -SWIGLU_LIMIT, SWIGLU_LIMIT)
        act = x_glu * jax.nn.sigmoid(SWIGLU_ALPHA * x_glu) * (x_lin + 1.0)
        return act @ w2[e] + b2[e]

    ys = lax.map(expert_block, (xs, block_e)).reshape(n_slots, d)
    out = jnp.zeros((n_tok, d), jnp.float32).at[slot_tok].add(ys.astype(jnp.float32) * slot_w[:, None])
    return out.reshape(bsz, s, d).astype(h.dtype)


def setup_inputs(seed: int = 0) -> dict:
    key = jax.random.key(seed)
    ks = iter(jax.random.split(key, 40))
    f32 = jnp.float32
    L = (DEPTH,)

    def nrm(shape, scale):
        return jax.random.normal(next(ks), shape, f32) * scale

    def unif(shape, lo, hi):
        return jax.random.uniform(next(ks), shape, f32, lo, hi)

    return {
        'x': nrm((BATCH, SEQ, D_MODEL), 1.0),
        'mem': nrm((BATCH, MEM_LEN, D_MODEL), 1.0),
        'ln1': 1.0 + nrm(L + (D_MODEL,), 0.05),
        'w_in': nrm(L + (D_MODEL, IN_COLS), D_MODEL ** -0.5),
        'token_mu': unif(L + (RWKV_IN,), 0.0, 1.0),
        'rwkv_w0': unif(L + (RWKV_DIM,), -3.0, 1.0),
        'rwkv_w2': nrm(L + (DECAY_LORA, RWKV_DIM), 0.5 * DECAY_LORA ** -0.5),
        'rwkv_a0': nrm(L + (RWKV_DIM,), 0.1),
        'rwkv_a2': nrm(L + (AAA_LORA, RWKV_DIM), 0.5 * AAA_LORA ** -0.5),
        'rwkv_g2': nrm(L + (GATE_LORA, RWKV_DIM), GATE_LORA ** -0.5),
        'rwkv_k_k': 0.85 + nrm(L + (RWKV_DIM,), 0.05),
        'rwkv_k_a': 1.0 + nrm(L + (RWKV_DIM,), 0.05),
        'rwkv_r_k': nrm(L + (RWKV_HEADS, HEAD_DIM), 0.1),
        'rwkv_ln_w': 1.0 + nrm(L + (RWKV_DIM,), 0.05),
        'rwkv_ln_b': nrm(L + (RWKV_DIM,), 0.01),
        'dil_q_norm': 1.0 + nrm(L + (HEAD_DIM,), 0.05),
        'dil_k_norm': 1.0 + nrm(L + (HEAD_DIM,), 0.05),
        'ln_mem': 1.0 + nrm(L + (D_MODEL,), 0.05),
        'w_mem_kv': nrm(L + (D_MODEL, 2 * MEM_DIM), D_MODEL ** -0.5),
        'mem_q_norm': 1.0 + nrm(L + (MEM_HEAD_DIM,), 0.05),
        'mem_k_norm': 1.0 + nrm(L + (MEM_HEAD_DIM,), 0.05),
        'p_rwkv': nrm(L + (RWKV_DIM, D_MODEL), RWKV_DIM ** -0.5),
        'p_dil': nrm(L + (DIL_OUT_DIM, D_MODEL), DIL_OUT_DIM ** -0.5),
        'p_mem': nrm(L + (MEM_DIM, D_MODEL), MEM_DIM ** -0.5),
        'w_out': nrm(L + (D_MODEL, D_MODEL), D_MODEL ** -0.5),
        'ln2': 1.0 + nrm(L + (D_MODEL,), 0.05),
        'w_router': nrm(L + (D_MODEL, N_EXPERTS), D_MODEL ** -0.5),
        'b_router': nrm(L + (N_EXPERTS,), 0.01),
        'w1': nrm(L + (N_EXPERTS, D_MODEL, 2 * D_FF), D_MODEL ** -0.5),
        'b1': nrm(L + (N_EXPERTS, 2 * D_FF), 0.01),
        'w2': nrm(L + (N_EXPERTS, D_FF, D_MODEL), D_FF ** -0.5),
        'b2': nrm(L + (N_EXPERTS, D_MODEL), 0.01),
    }


def reference(x, mem, ln1, w_in, token_mu, rwkv_w0, rwkv_w2, rwkv_a0, rwkv_a2, rwkv_g2,
              rwkv_k_k, rwkv_k_a, rwkv_r_k, rwkv_ln_w, rwkv_ln_b, dil_q_norm, dil_k_norm,
              ln_mem, w_mem_kv, mem_q_norm, mem_k_norm, p_rwkv, p_dil, p_mem, w_out,
              ln2, w_router, b_router, w1, b1, w2, b2):
    for l in range(DEPTH):
        x = mixer_sublayer(x, mem, ln1[l], w_in[l], token_mu[l], rwkv_w0[l], rwkv_w2[l],
                           rwkv_a0[l], rwkv_a2[l], rwkv_g2[l], rwkv_k_k[l], rwkv_k_a[l],
                           rwkv_r_k[l], rwkv_ln_w[l], rwkv_ln_b[l], dil_q_norm[l], dil_k_norm[l],
                           ln_mem[l], w_mem_kv[l], mem_q_norm[l], mem_k_norm[l],
                           p_rwkv[l], p_dil[l], p_mem[l], w_out[l])
        x = x + moe_ffn(rms_norm(x, ln2[l]), w_router[l], b_router[l], w1[l], b1[l], w2[l], b2[l])
    return x
```

```cpp
#include <hip/hip_runtime.h>
#include <cstdio>
#include <cstdint>

#define LAS __attribute__((address_space(3)))
typedef unsigned short bf16_t;
typedef short bf16x8 __attribute__((ext_vector_type(8)));
typedef short s16x4 __attribute__((ext_vector_type(4)));
typedef float f32x4 __attribute__((ext_vector_type(4)));
typedef float f32x2 __attribute__((ext_vector_type(2)));
typedef unsigned u32x4 __attribute__((ext_vector_type(4)));
typedef unsigned u32x2 __attribute__((ext_vector_type(2)));
typedef int i32x8 __attribute__((ext_vector_type(8)));
typedef int i32x4 __attribute__((ext_vector_type(4)));

#ifndef DBL_MASK
#define DBL_MASK 0
#endif
#ifndef MK_N_LAUNCH_PER_PHASE
#define MK_N_LAUNCH_PER_PHASE 0
#endif

constexpr int NTOK = 16384, SEQ = 2048, INC = 7680;
constexpr int C_K = 512, C_V = 1024, C_ZW = 1536, C_DQ = 1792, C_DK = 2560, C_DV = 3328, C_MQ = 4096, C_GATE = 4608;
constexpr int NPHASE = 14;
constexpr int NSLOT_MAX = 65536 + 32 * 256;

constexpr size_t MiB = 1ull << 20;
constexpr size_t OFF_CTL = 0;
constexpr size_t CTL_BYTES = 32768;
constexpr size_t CTL_CNT = 16384;
constexpr size_t CTL_CUR = 16384 + 256;
constexpr size_t OFF_TOPE = 1 * MiB;
constexpr size_t OFF_TOPG = 1 * MiB + 262144;
constexpr size_t OFF_SLOT = 1 * MiB + 524288;
constexpr size_t OFF_STOK = 2 * MiB;
constexpr size_t OFF_WRT = 3 * MiB;
constexpr size_t OFF_WINT = 4 * MiB, OFF_WMKVT = 19 * MiB, OFF_LORAT = 21 * MiB, OFF_PRT = 22 * MiB, OFF_PDT = 23 * MiB, OFF_PMT = 24 * MiB, OFF_WOT = 25 * MiB;
constexpr size_t OFF_WIN8 = 8 * MiB;
constexpr size_t OFF_H8 = 539 * MiB;
constexpr size_t OFF_YCAT = 223 * MiB;
constexpr size_t OFF_PCAT = 22 * MiB;
constexpr size_t OFF_W1T = 27 * MiB, OFF_W2T = 155 * MiB, OFF_KV = 219 * MiB, OFF_YM = 223 * MiB, OFF_YR = 239 * MiB, OFF_YD = 255 * MiB, OFF_Z = 263 * MiB;
constexpr size_t OFF_H = 503 * MiB, OFF_HM = 535 * MiB, OFF_ALORA = 503 * MiB, OFF_L = 511 * MiB, OFF_REC = 607 * MiB;
constexpr size_t OFF_GF = OFF_REC;
constexpr size_t OFF_LW = OFF_REC + 64 * MiB;
constexpr size_t OFF_VB = OFF_REC + 96 * MiB;
constexpr size_t OFF_GTF = OFF_REC + 112 * MiB;
constexpr size_t OFF_RTF = OFF_REC + 144 * MiB;
constexpr size_t OFF_HHF = OFF_REC + 160 * MiB;
constexpr size_t OFF_YLF = OFF_REC + 192 * MiB;
constexpr size_t OFF_C1 = 816 * MiB, OFF_C2 = 832 * MiB, OFF_YRAW = 848 * MiB, OFF_DILO = 880 * MiB, OFF_LSE = 928 * MiB;
constexpr size_t OFF_MIX32 = 503 * MiB, OFF_MIXBF = 567 * MiB, OFF_XN2 = 503 * MiB, OFF_XS = 263 * MiB, OFF_ACT = 607 * MiB, OFF_YS = 407 * MiB;
constexpr size_t WS_NEED = 929 * MiB;

constexpr int LDS_BYTES = 160 * 1024;
constexpr int LDS_X = LDS_BYTES - 4096;
constexpr int LX_TSTART = LDS_X + 64;
constexpr int LX_SBASE = LDS_X + 256;
constexpr int LX_CNT = LDS_X + 512;
constexpr int LX_HIST = LDS_X + 768;
constexpr int LX_BBASE = LDS_X + 1024;
constexpr int LX_SLOTL = LDS_X + 2048;
constexpr int LX_TEXP = LDS_X + 3072;

struct Params { const float* in[32]; float* out; unsigned char* ws; int ph_lo, ph_hi; };
typedef const Params __attribute__((address_space(4))) KParams;
__device__ __forceinline__ KParams* kparams() { KParams* kp = (KParams*)__builtin_amdgcn_kernarg_segment_ptr(); asm volatile("" : "+s"(kp)); return kp; }

typedef __bf16 bf16x2_t __attribute__((ext_vector_type(2)));
__device__ __forceinline__ unsigned cvt_pk_bf16(float lo, float hi) { f32x2 v = {lo, hi}; bf16x2_t b = __builtin_convertvector(v, bf16x2_t); unsigned r; __builtin_memcpy(&r, &b, 4); return r; }
__device__ __forceinline__ unsigned pack4_fp8(float a, float b, float c, float d) { int r = __builtin_amdgcn_cvt_pk_fp8_f32(a, b, 0, false); r = __builtin_amdgcn_cvt_pk_fp8_f32(c, d, r, true); return (unsigned)r; }
__device__ __forceinline__ float bf_lo(unsigned u) { return __uint_as_float(u << 16); }
__device__ __forceinline__ float bf_hi(unsigned u) { return __uint_as_float(u & 0xffff0000u); }
__device__ __forceinline__ int lane_id() { int l; asm volatile("v_mbcnt_lo_u32_b32 %0, -1, 0\n\tv_mbcnt_hi_u32_b32 %0, -1, %0" : "=v"(l)); return l; }
__device__ __forceinline__ int sxor(int x, int m) { return __builtin_amdgcn_ds_bpermute((lane_id() ^ m) << 2, x); }
__device__ __forceinline__ float sxor(float x, int m) { return __int_as_float(__builtin_amdgcn_ds_bpermute((lane_id() ^ m) << 2, __float_as_int(x))); }
template <int CTRL> __device__ __forceinline__ float dpp_f(float x) { return __int_as_float(__builtin_amdgcn_update_dpp(0, __float_as_int(x), CTRL, 0xF, 0xF, true)); }
__device__ __forceinline__ float red4(float x) { x += dpp_f<0xB1>(x); x += dpp_f<0x4E>(x); return x; }
__device__ __forceinline__ float red8(float x) { x = red4(x); x += dpp_f<0x141>(x); return x; }
__device__ __forceinline__ float red16(float x) { x = red8(x); x += dpp_f<0x140>(x); return x; }
__device__ __forceinline__ float red64(float x) { x = red16(x); x += sxor(x, 16); x += sxor(x, 32); return x; }
__device__ __forceinline__ int opaque_tid(const int wv) { int t = (wv << 6) | lane_id(); asm volatile("" : "+v"(t)); return t; }
__device__ __forceinline__ f32x4 zero4f() { float z = 0.f; asm volatile("" : "+v"(z)); return (f32x4){z, z, z, z}; }
__device__ __forceinline__ u32x4 zero4u() { unsigned z = 0u; asm volatile("" : "+v"(z)); return (u32x4){z, z, z, z}; }
__device__ __forceinline__ float sigmoidf_(float x) { return __builtin_amdgcn_rcpf(1.0f + __builtin_amdgcn_exp2f(-1.44269504f * x)); }
__device__ __forceinline__ void unpack8(const u32x4 v, float (&f)[8]) { f[0] = bf_lo(v.x); f[1] = bf_hi(v.x); f[2] = bf_lo(v.y); f[3] = bf_hi(v.y); f[4] = bf_lo(v.z); f[5] = bf_hi(v.z); f[6] = bf_lo(v.w); f[7] = bf_hi(v.w); }
__device__ __forceinline__ u32x4 pack8(const float (&f)[8]) { u32x4 w; w.x = cvt_pk_bf16(f[0], f[1]); w.y = cvt_pk_bf16(f[2], f[3]); w.z = cvt_pk_bf16(f[4], f[5]); w.w = cvt_pk_bf16(f[6], f[7]); return w; }
__device__ __forceinline__ float sumsq8(const u32x4 v) { float f[8]; unpack8(v, f); float s = 0.f;
#pragma unroll
    for (int j = 0; j < 8; ++j) s += f[j] * f[j];
    return s; }
__device__ __forceinline__ u32x4 scale8(const u32x4 v, const float rs, const float* w) { float f[8]; unpack8(v, f); const f32x4 w0 = *(const f32x4*)w, w1 = *(const f32x4*)(w + 4);
    f[0] *= rs * w0[0]; f[1] *= rs * w0[1]; f[2] *= rs * w0[2]; f[3] *= rs * w0[3]; f[4] *= rs * w1[0]; f[5] *= rs * w1[1]; f[6] *= rs * w1[2]; f[7] *= rs * w1[3]; return pack8(f); }
__device__ __forceinline__ u32x4 scale8r(const u32x4 v, const float rs, const float (&w)[8]) { float f[8]; unpack8(v, f);
#pragma unroll
    for (int j = 0; j < 8; ++j) f[j] *= rs * w[j];
    return pack8(f); }
__device__ __forceinline__ u32x4 scale8s(const u32x4 v, const float rs) { float f[8]; unpack8(v, f);
#pragma unroll
    for (int j = 0; j < 8; ++j) f[j] *= rs;
    return pack8(f); }
__device__ __forceinline__ void unpack4(const u32x2 v, float (&f)[4]) { f[0] = bf_lo(v.x); f[1] = bf_hi(v.x); f[2] = bf_lo(v.y); f[3] = bf_hi(v.y); }

#define XB_TMO      128
#define XB_XCNT(j)  (256  + 64 * (j))
#define XB_XSUB(j)  (1280 + 64 * (j))
#define XB_XGEN(j)  (2304 + 64 * (j))
#define XB_TOP      3328
#define XB_TOPGEN   3392
#define XCD_BAR_WORDS 3456
#define XB_SPIN_CAP (1u << 22)
__device__ __forceinline__ unsigned xb_ld(unsigned* p)              { return __hip_atomic_load(p, __ATOMIC_RELAXED, __HIP_MEMORY_SCOPE_AGENT); }
__device__ __forceinline__ unsigned xb_add(unsigned* p, unsigned v) { return __hip_atomic_fetch_add(p, v, __ATOMIC_RELAXED, __HIP_MEMORY_SCOPE_AGENT); }
__device__ __forceinline__ unsigned xb_xcc_id() { return (unsigned)__builtin_amdgcn_s_getreg((3 << 11) | 20) & 0xFu; }
#define XB_SPIN(cond, bar) do { unsigned _sp = 0; while (cond) { __builtin_amdgcn_s_sleep(1); \
    if ((++_sp & 255u) == 0u) { if (xb_ld(&(bar)[XB_TMO])) break; if (_sp > XB_SPIN_CAP) { atomicAdd(&(bar)[XB_TMO], 1u); break; } } } } while (0)
struct XcdBarrier { unsigned* bar; unsigned x; volatile LAS unsigned* st; };
__device__ __forceinline__ XcdBarrier xcd_barrier_post(unsigned* bar, volatile LAS unsigned* st, const int wv) {
    XcdBarrier b; b.bar = bar; b.x = xb_xcc_id(); b.st = st;
    if (wv == 0 && lane_id() == 0) (void)xb_add(&bar[XB_XCNT(b.x)], 1u);
    return b;
}
__device__ __forceinline__ void xcd_barrier_complete(unsigned* bar, unsigned x, unsigned& nloc, unsigned& nx) {
    const unsigned G = gridDim.x * gridDim.y * gridDim.z;
    unsigned sum, cnt, mine, sp = 0u;
    for (;;) {
        sum = 0u; cnt = 0u; mine = 0u;
#pragma unroll
        for (unsigned j = 0; j < 16; ++j) { const unsigned c = xb_ld(&bar[XB_XCNT(j)]); sum += c; cnt += (c > 0u) ? 1u : 0u; mine = (j == x) ? c : mine; }
        if (sum == G) break;
        __builtin_amdgcn_s_sleep(1);
        if ((++sp & 255u) == 0u) { if (xb_ld(&bar[XB_TMO])) break; if (sp > XB_SPIN_CAP) { atomicAdd(&bar[XB_TMO], 1u); break; } }
    }
    nloc = mine > 0u ? mine : 1u; nx = cnt > 0u ? cnt : 1u;
}
__device__ __forceinline__ void xcd_barrier(const XcdBarrier& b, const int wv) {
    asm volatile("s_waitcnt vmcnt(0)" ::: "memory");
    __syncthreads();
    if (wv == 0 && lane_id() == 0) {
        unsigned* bar = b.bar;
        __builtin_amdgcn_s_waitcnt(0);
        unsigned nloc = b.st[0], nx = b.st[1];
        if (nloc == 0u) { xcd_barrier_complete(bar, b.x, nloc, nx); b.st[0] = nloc; b.st[1] = nx; }
        const unsigned old = xb_add(&bar[XB_XSUB(b.x)], 1u);
        const unsigned gen = old / nloc;
        if (old + 1u == (gen + 1u) * nloc) {
            __builtin_amdgcn_fence(__ATOMIC_RELEASE, "agent");
            asm volatile("s_waitcnt vmcnt(0)" ::: "memory");
            const unsigned og = xb_add(&bar[XB_TOP], 1u);
            const unsigned tg = og / nx;
            if (og + 1u == (tg + 1u) * nx) xb_add(&bar[XB_TOPGEN], 1u);
            else XB_SPIN(xb_ld(&bar[XB_TOPGEN]) == tg, bar);
            __builtin_amdgcn_fence(__ATOMIC_ACQUIRE, "agent");
            xb_add(&bar[XB_XGEN(b.x)], 1u);
            asm volatile("s_waitcnt vmcnt(0)" ::: "memory");
        } else {
            XB_SPIN(xb_ld(&bar[XB_XGEN(b.x)]) == gen, bar);
            __builtin_amdgcn_fence(__ATOMIC_ACQUIRE, "agent");
            asm volatile("s_waitcnt vmcnt(0)" ::: "memory");
        }
    }
    __syncthreads();
}

namespace pg8 {
constexpr int BM = 256, BK = 64, HALF = 128, HTB = HALF * BK * 2, STAGE_BYTES = 8 * HTB, NXCD = 8, WGM = 8;
__host__ __device__ __forceinline__ int lds_byte(int r, int c) { const int st = (r >> 4) * 2 + (c >> 5), rr = r & 15, cc = c & 31, ob = rr * 64 + cc * 2; return st * 1024 + (ob ^ (((ob >> 9) & 1) << 5)); }
__host__ __device__ __forceinline__ void stage_rc(int b, int& R, int& C) { const int st = b / 1024, sb = b % 1024, swz = sb ^ (((sb >> 9) & 1) << 5); R = (st >> 1) * 16 + swz / 64; C = (st & 1) * 32 + (swz % 64) / 2; }
__host__ __device__ __forceinline__ int perm32(int rho) { const int n = rho >> 4, i = rho & 15; return 8 * (i >> 2) + 4 * n + (i & 3); }
struct Unit { int pm, pn, tag; const char* pa; const char* pb; };

__device__ __forceinline__ void static_map(long L, int nM, int nN, int& pm, int& pn) {
    const int nwg = nM * nN; int wgid = (int)L;
    { const int q = nwg / NXCD, r = nwg % NXCD, xcd = wgid % NXCD, off = wgid / NXCD; wgid = (xcd < r ? xcd * (q + 1) : r * (q + 1) + (xcd - r) * q) + off; }
    const int nig = WGM * nN, gid = wgid / nig, fm = gid * WGM, gsz = (nM - fm) < WGM ? (nM - fm) : WGM;
    pm = fm + ((wgid % nig) % gsz); pn = (wgid % nig) / gsz;
}
struct DenseOrder {
    static constexpr bool GATHER = false; __device__ __forceinline__ unsigned a_off(const Unit&, int, int, int, int) const { return 0u; }
    const char* A; const char* Bt; int nM, nN, G, c; size_t tstep;
    __device__ __forceinline__ void init(const void* A_, const void* Bt_, int M, int N, int K) { A = (const char*)A_; Bt = (const char*)Bt_; nM = M / BM; nN = N / BM; G = gridDim.x; c = blockIdx.x; tstep = (size_t)BM * K * 2; }
    __device__ __forceinline__ bool next(int i, Unit& u) const {
        const long L = (long)i * G + c; if (L >= (long)nM * nN) return false;
        static_map(L, nM, nN, u.pm, u.pn); u.tag = 0; u.pa = A + (size_t)u.pm * tstep; u.pb = Bt + (size_t)u.pn * tstep; return true;
    }
};

template <int H> __device__ __forceinline__ bf16x8 half8(const i32x8 v) { const i32x4 x = H ? __builtin_shufflevector(v, v, 4, 5, 6, 7) : __builtin_shufflevector(v, v, 0, 1, 2, 3); bf16x8 r; __builtin_memcpy(&r, &x, 16); return r; }
template <class Epi, class Sched, int ES = 2>
__device__ __forceinline__ void gemm_phase(const int wv, LAS unsigned char* lds, const int K, const Sched& S, const Epi& E) {
    int tid_ = (wv << 6) | lane_id(); asm volatile("" : "+v"(tid_));
    const int tid = tid_, wid = __builtin_amdgcn_readfirstlane(tid >> 6), lane = tid & 63, wr = wid >> 2, wc = wid & 3, fr = lane & 15, fq = lane >> 4;
    const int nt = K * ES / (BK * 2);
    unsigned voffA[2], voffB[2]; int RA[2], CA[2];
#pragma unroll
    for (int i = 0; i < 2; ++i) { int R, C; stage_rc(tid * 16 + i * 8192, R, C); const int Rb = Epi::PERM ? ((R & ~31) + perm32(R & 31)) : R; RA[i] = R; CA[i] = C;
        voffA[i] = (unsigned)(R * K * ES + C * 2); voffB[i] = (unsigned)(Rb * K * ES + C * 2); }
    unsigned vA[2][2][2];
    const size_t kstep = (size_t)(BK * 2);
    const size_t hstep = (size_t)HALF * K * ES;
    const unsigned ldsw = (unsigned)wid * 1024u;
    const int aoff = lds_byte(wr * 64 + fr, fq * 8), boff = lds_byte(wc * 32 + fr, fq * 8);
#define PG8_SA(b, h) (((b) * 2 + (h)) * HTB)
#define PG8_SB(b, h) ((4 + (b) * 2 + (h)) * HTB)
#define PG8_STAGE(bufoff, gbase, voff) do { _Pragma("unroll") for (int _i = 0; _i < 2; ++_i) \
        __builtin_amdgcn_global_load_lds((const unsigned*)((const char*)(gbase) + (voff)[_i]), (LAS unsigned*)(lds + (bufoff) + ldsw + _i * 8192), 16, 0, 0); } while (0)
#define PG8_LDA(dst, b, h) do { _Pragma("unroll") for (int m = 0; m < 4; ++m) { const i32x4 _lo = *(const LAS i32x4*)(lds + PG8_SA(b, h) + aoff + m * 2048), _hi = *(const LAS i32x4*)(lds + PG8_SA(b, h) + aoff + m * 2048 + 1024); dst[m] = __builtin_shufflevector(_lo, _hi, 0, 1, 2, 3, 4, 5, 6, 7); } } while (0)
#define PG8_LDB(dst, b, h) do { _Pragma("unroll") for (int n = 0; n < 2; ++n) { const i32x4 _lo = *(const LAS i32x4*)(lds + PG8_SB(b, h) + boff + n * 2048), _hi = *(const LAS i32x4*)(lds + PG8_SB(b, h) + boff + n * 2048 + 1024); dst[n] = __builtin_shufflevector(_lo, _hi, 0, 1, 2, 3, 4, 5, 6, 7); } } while (0)
#define PG8_MMA(ai, bj, At, Bt) do { __builtin_amdgcn_s_setprio(1); _Pragma("unroll") for (int m = 0; m < 4; ++m) _Pragma("unroll") for (int n = 0; n < 2; ++n) { \
        if (ES == 2) { acc[ai][bj][m][n] = __builtin_amdgcn_mfma_f32_16x16x32_bf16(half8<0>(Bt[n]), half8<0>(At[m]), acc[ai][bj][m][n], 0, 0, 0); \
                       acc[ai][bj][m][n] = __builtin_amdgcn_mfma_f32_16x16x32_bf16(half8<1>(Bt[n]), half8<1>(At[m]), acc[ai][bj][m][n], 0, 0, 0); } \
        else asm volatile("v_mfma_scale_f32_16x16x128_f8f6f4 %0, %1, %2, %0, %3, %3 op_sel_hi:[0,0,0]" : "+v"(acc[ai][bj][m][n]) : "v"(Bt[n]), "v"(At[m]), "v"(one_scale)); } \
        __builtin_amdgcn_s_setprio(0); } while (0)
#define PG8_WAIT_V(n) asm volatile("s_waitcnt vmcnt(" #n ")" ::: "memory")
#define PG8_WAIT_L(n) asm volatile("s_waitcnt lgkmcnt(" #n ")" ::: "memory")
#define PG8_BAR __builtin_amdgcn_s_barrier()
#define PG8_SCHED __builtin_amdgcn_sched_barrier(0)
    Unit cur, nxt; int ui = 0;
    if (!S.next(0, cur)) return;
    f32x4 acc[2][2][4][2]; const f32x4 zz0 = zero4f();
#pragma unroll
    for (int a = 0; a < 2; ++a)
#pragma unroll
        for (int b = 0; b < 2; ++b)
#pragma unroll
            for (int m = 0; m < 4; ++m)
#pragma unroll
                for (int n = 0; n < 2; ++n) acc[a][b][m][n] = zz0;
    i32x8 At[4], B0[2], B1[2];
    const int one_scale = 0x7f7f7f7f;
    const char* cA = cur.pa; const char* cB = cur.pb;
#pragma unroll
    for (int h = 0; h < 2; ++h)
#pragma unroll
        for (int i = 0; i < 2; ++i) vA[0][h][i] = Sched::GATHER ? S.a_off(cur, h, RA[i], CA[i], K * ES) : voffA[i] + (unsigned)(h * hstep);
    PG8_STAGE(PG8_SB(0, 0), cB, voffB); PG8_STAGE(PG8_SA(0, 0), cA, vA[0][0]); PG8_STAGE(PG8_SB(0, 1), cB + hstep, voffB); PG8_STAGE(PG8_SA(0, 1), cA, vA[0][1]);
    if (wr == 1) PG8_BAR;
    PG8_WAIT_V(4); PG8_BAR;
    PG8_STAGE(PG8_SB(1, 0), cB + kstep, voffB); PG8_STAGE(PG8_SA(1, 0), cA + kstep, vA[0][0]); PG8_STAGE(PG8_SB(1, 1), cB + hstep + kstep, voffB);
    PG8_WAIT_V(6); PG8_BAR;
    for (;;) {
        const bool has_next = S.next(ui + 1, nxt);
        const char* nA = has_next ? nxt.pa : cA; const char* nB = has_next ? nxt.pb : cB;
#pragma unroll
        for (int h = 0; h < 2; ++h)
#pragma unroll
            for (int i = 0; i < 2; ++i) vA[1][h][i] = has_next ? (Sched::GATHER ? S.a_off(nxt, h, RA[i], CA[i], K * ES) : voffA[i] + (unsigned)(h * hstep)) : vA[0][h][i];
#pragma clang loop unroll(disable)
        for (int t = 0; t < nt; t += 2) {
            if constexpr (Epi::MID) { if (t == 8 || t == 12) E.mid(acc, cur, t, wr, wc, fr, fq); }
            const bool last = (t == nt - 2);
            const char* a1 = cA + (size_t)(t + 1) * kstep;
            const char* a2 = last ? nA : cA + (size_t)(t + 2) * kstep; const char* b2 = last ? nB : cB + (size_t)(t + 2) * kstep;
            const char* a3 = a2 + kstep; const char* b3 = b2 + kstep;
            unsigned w0[2], w1[2];
#pragma unroll
            for (int i = 0; i < 2; ++i) { w0[i] = vA[0][0][i]; w1[i] = vA[0][1][i]; }
            if (last) { asm volatile("" ::: "memory");
#pragma unroll
                for (int i = 0; i < 2; ++i) { w0[i] = vA[1][0][i]; w1[i] = vA[1][1][i]; } }
            PG8_LDB(B0, 0, 0); PG8_SCHED; PG8_LDA(At, 0, 0); PG8_STAGE(PG8_SA(1, 1), a1, vA[0][1]);
            PG8_WAIT_L(8); PG8_BAR; PG8_WAIT_L(0); PG8_MMA(0, 0, At, B0); PG8_BAR; PG8_SCHED;
            PG8_LDB(B1, 0, 1); PG8_STAGE(PG8_SB(0, 0), b2, voffB);
            PG8_BAR; PG8_WAIT_L(0); PG8_MMA(0, 1, At, B1); PG8_BAR;
            PG8_LDA(At, 0, 1); PG8_STAGE(PG8_SA(0, 0), a2, w0);
            PG8_BAR; PG8_WAIT_L(0); PG8_MMA(1, 0, At, B0); PG8_BAR; PG8_SCHED;
            PG8_STAGE(PG8_SB(0, 1), b2 + hstep, voffB);
            PG8_WAIT_V(6); PG8_BAR; PG8_MMA(1, 1, At, B1); PG8_BAR;
            PG8_LDB(B0, 1, 0); PG8_SCHED; PG8_LDA(At, 1, 0); PG8_STAGE(PG8_SA(0, 1), a2, w1);
            PG8_WAIT_L(8); PG8_BAR; PG8_WAIT_L(0); PG8_MMA(0, 0, At, B0); PG8_BAR; PG8_SCHED;
            PG8_LDB(B1, 1, 1); PG8_STAGE(PG8_SB(1, 0), b3, voffB);
            PG8_BAR; PG8_WAIT_L(0); PG8_MMA(0, 1, At, B1); PG8_BAR;
            PG8_LDA(At, 1, 1); PG8_STAGE(PG8_SA(1, 0), a3, w0);
            PG8_BAR; PG8_WAIT_L(0); PG8_MMA(1, 0, At, B0); PG8_BAR; PG8_SCHED;
            PG8_STAGE(PG8_SB(1, 1), b3 + hstep, voffB);
            PG8_WAIT_V(6); PG8_BAR; PG8_MMA(1, 1, At, B1); PG8_BAR;
        }
        if (ES == 1) asm volatile("s_nop 15\n\ts_nop 15" ::: "memory");
        E(acc, cur, wr, wc, fr, fq);
        if (!has_next) break;
        const f32x4 zz1 = zero4f();
#pragma unroll
        for (int a = 0; a < 2; ++a)
#pragma unroll
            for (int b = 0; b < 2; ++b)
#pragma unroll
                for (int m = 0; m < 4; ++m)
#pragma unroll
                    for (int n = 0; n < 2; ++n) acc[a][b][m][n] = zz1;
        cur = nxt; cA = nA; cB = nB; ++ui;
#pragma unroll
        for (int h = 0; h < 2; ++h)
#pragma unroll
            for (int i = 0; i < 2; ++i) vA[0][h][i] = vA[1][h][i];
    }
    PG8_WAIT_V(0);
    if (wr == 0) PG8_BAR;
    PG8_BAR;
#undef PG8_SA
#undef PG8_SB
#undef PG8_STAGE
#undef PG8_LDA
#undef PG8_LDB
#undef PG8_MMA
#undef PG8_WAIT_V
#undef PG8_WAIT_L
#undef PG8_BAR
#undef PG8_SCHED
}
}
using pg8::Unit;

struct EpiZ {
    static constexpr bool PERM = true, MID = false;
    bf16_t* Z; bf16_t* KV; bf16_t* GFp; int pn0; float scale;
    __device__ __forceinline__ void operator()(const f32x4 (&acc)[2][2][4][2], const Unit& u, int wr, int wc, int fr, int fq) const {
        const bool kvu = u.pn >= 32; const int pn = (u.pn & 31) + (kvu ? 0 : pn0);
        bf16_t* base = kvu ? KV : Z; const int ldc = kvu ? 1024 : INC; const bool sg = (!kvu) && (pn >= C_GATE / 256);
        if (sg) {
            bf16_t* gf = GFp + ((size_t)(u.pm * 12 + (pn - C_GATE / 256)) * 16) * 4096 + (size_t)((wr * 4 + wc) * 64 + fq * 16 + fr) * 8;
#pragma unroll
            for (int ai = 0; ai < 2; ++ai)
#pragma unroll
                for (int m = 0; m < 4; ++m)
#pragma unroll
                    for (int bj = 0; bj < 2; ++bj) { f32x4 v0 = acc[ai][bj][m][0] * scale, v1 = acc[ai][bj][m][1] * scale;
#pragma unroll
                        for (int j = 0; j < 4; ++j) { v0[j] = sigmoidf_(v0[j]); v1[j] = sigmoidf_(v1[j]); }
                        u32x4 w; w.x = cvt_pk_bf16(v0[0], v0[1]); w.y = cvt_pk_bf16(v0[2], v0[3]); w.z = cvt_pk_bf16(v1[0], v1[1]); w.w = cvt_pk_bf16(v1[2], v1[3]);
                        *(u32x4*)(gf + (size_t)((ai * 4 + m) * 2 + bj) * 4096) = w; }
            return; }
        const int row0 = u.pm * 256 + wr * 64 + fr, col0 = pn * 256 + wc * 32 + 8 * fq;
#pragma unroll
        for (int ai = 0; ai < 2; ++ai)
#pragma unroll
            for (int m = 0; m < 4; ++m) { bf16_t* rowp = base + (size_t)(row0 + ai * 128 + m * 16) * ldc + col0;
#pragma unroll
                for (int bj = 0; bj < 2; ++bj) { f32x4 v0 = acc[ai][bj][m][0] * scale, v1 = acc[ai][bj][m][1] * scale;
                    if (sg) {
#pragma unroll
                        for (int j = 0; j < 4; ++j) { v0[j] = sigmoidf_(v0[j]); v1[j] = sigmoidf_(v1[j]); } }
                    u32x4 w; w.x = cvt_pk_bf16(v0[0], v0[1]); w.y = cvt_pk_bf16(v0[2], v0[3]); w.z = cvt_pk_bf16(v1[0], v1[1]); w.w = cvt_pk_bf16(v1[2], v1[3]);
                    *(u32x4*)(rowp + bj * 128) = w; } }
    }
};
struct SchedZ8 {
    static constexpr bool GATHER = false; __device__ __forceinline__ unsigned a_off(const Unit&, int, int, int, int) const { return 0u; }
    const char* H8; const char* WIN8; int G, c;
    __device__ __forceinline__ bool next(int i, Unit& u) const {
        const long L = (long)i * G + c; if (L >= 64 * 23) return false;
        pg8::static_map(L, 64, 23, u.pm, u.pn); u.tag = 0; u.pa = H8 + (size_t)u.pm * (256 * 1024); u.pb = WIN8 + (size_t)u.pn * (256 * 1024); return true;
    }
};
struct SchedZ {
    static constexpr bool GATHER = false; __device__ __forceinline__ unsigned a_off(const Unit&, int, int, int, int) const { return 0u; }
    const char* H; const char* WinT; const char* HM; const char* WmkvT; int G, c;
    __device__ __forceinline__ bool next(int i, Unit& u) const {
        const long L = (long)i * G + c; if (L >= 480) return false;
        const size_t tstep = (size_t)256 * 1024 * 2;
        if (L < 448) { pg8::static_map(L, 64, 7, u.pm, u.pn); u.tag = 0; u.pa = H + (size_t)u.pm * tstep; u.pb = WinT + (size_t)u.pn * tstep; }
        else { const int q = (int)(L - 448); u.pm = q >> 2; u.pn = 32 + (q & 3); u.tag = 0; u.pa = HM + (size_t)u.pm * tstep; u.pb = WmkvT + (size_t)(q & 3) * tstep; }
        return true;
    }
};
struct EpiLora {
    static constexpr bool PERM = false, MID = false;
    float* L; const float* w0; const float* a0;
    __device__ __forceinline__ void operator()(const f32x4 (&acc)[2][2][4][2], const Unit& u, int wr, int wc, int fr, int fq) const {
        const int row0 = u.pm * 256 + wr * 64 + fr, col0 = u.pn * 256 + wc * 32 + 4 * fq; const int kind = u.pn >> 1; const f32x4 zb = zero4f();
#pragma unroll
        for (int bj = 0; bj < 2; ++bj)
#pragma unroll
            for (int n = 0; n < 2; ++n) { const int c = col0 + bj * 128 + n * 16;
                f32x4 bv = zb;
                if (kind == 0) bv = *(const f32x4*)(w0 + c); else if (kind == 1) bv = *(const f32x4*)(a0 + (c - 512));
#pragma unroll
                for (int ai = 0; ai < 2; ++ai)
#pragma unroll
                    for (int m = 0; m < 4; ++m) { f32x4 v = acc[ai][bj][m][n] + bv;
                        if (kind == 0) {
#pragma unroll
                            for (int j = 0; j < 4; ++j) v[j] = -0.60653066f * sigmoidf_(v[j]); }
                        else if (kind == 1) {
#pragma unroll
                            for (int j = 0; j < 4; ++j) v[j] = sigmoidf_(v[j]); }
                        *(f32x4*)(L + (size_t)(row0 + ai * 128 + m * 16) * 1536 + c) = v; } }
    }
};
template <int mode> struct EpiMix {
    static constexpr bool PERM = false, MID = false;
    float* mix32; bf16_t* mixbf; const bf16_t* Z;
    __device__ __forceinline__ void operator()(const f32x4 (&acc)[2][2][4][2], const Unit& u, int wr, int wc, int fr, int fq) const {
        const int row0 = u.pm * 256 + wr * 64 + fr, col0 = u.pn * 256 + wc * 32 + 4 * fq;
#pragma unroll
        for (int ai = 0; ai < 2; ++ai)
#pragma unroll
            for (int m = 0; m < 4; ++m) { const size_t row = (size_t)(row0 + ai * 128 + m * 16);
#pragma unroll
                for (int bj = 0; bj < 2; ++bj)
#pragma unroll
                    for (int n = 0; n < 2; ++n) { const int c = col0 + bj * 128 + n * 16;
                        const u32x2 gz = *(const u32x2*)(Z + row * INC + C_GATE + mode * 1024 + c); float g[4]; unpack4(gz, g);
                        f32x4 v = acc[ai][bj][m][n]; v[0] *= g[0]; v[1] *= g[1]; v[2] *= g[2]; v[3] *= g[3];
                        if (mode > 0) v += *(const f32x4*)(mix32 + row * 1024 + c);
                        if (mode < 2) *(f32x4*)(mix32 + row * 1024 + c) = v;
                        else { u32x2 w; w.x = cvt_pk_bf16(v[0], v[1]); w.y = cvt_pk_bf16(v[2], v[3]); *(u32x2*)(mixbf + row * 1024 + c) = w; } }
                asm volatile("" ::: "memory"); }
    }
};
struct EpiMixCat {
    static constexpr bool PERM = true, MID = true;
    bf16_t* mixbf; const bf16_t* GF; int tid;
    __device__ __forceinline__ const bf16_t* gtile(const Unit& u, int b) const { return GF + ((size_t)(u.pm * 12 + 4 * b + u.pn) * 16) * 4096 + (size_t)tid * 8; }
    __device__ __forceinline__ void mid(f32x4 (&acc)[2][2][4][2], const Unit& u, int t, int wr, int wc, int fr, int fq) const {
        const int ga = (t == 8) ? 0 : 1; int off = 0; asm volatile("" : "+v"(off));
        const bf16_t* pa = gtile(u, ga) + off; const bf16_t* pb = gtile(u, ga + 1) + off;
#pragma unroll
        for (int ai = 0; ai < 2; ++ai) {
#pragma unroll
            for (int m = 0; m < 4; ++m)
#pragma unroll
                for (int bj = 0; bj < 2; ++bj) { float a[8], b[8]; unpack8(*(const u32x4*)(pa + (size_t)((ai * 4 + m) * 2 + bj) * 4096), a); unpack8(*(const u32x4*)(pb + (size_t)((ai * 4 + m) * 2 + bj) * 4096), b);
#pragma unroll
                    for (int j = 0; j < 4; ++j) { acc[ai][bj][m][0][j] *= a[j] * __builtin_amdgcn_rcpf(b[j]); acc[ai][bj][m][1][j] *= a[4 + j] * __builtin_amdgcn_rcpf(b[4 + j]); } }
            asm volatile("" ::: "memory"); }
    }
    __device__ __forceinline__ void operator()(const f32x4 (&acc)[2][2][4][2], const Unit& u, int wr, int wc, int fr, int fq) const {
        const int row0 = u.pm * 256 + wr * 64 + fr, col0 = u.pn * 256 + wc * 32 + 8 * fq; const bf16_t* pg = gtile(u, 2);
#pragma unroll
        for (int ai = 0; ai < 2; ++ai)
#pragma unroll
            for (int m = 0; m < 4; ++m) { bf16_t* rowp = mixbf + (size_t)(row0 + ai * 128 + m * 16) * 1024 + col0;
#pragma unroll
                for (int bj = 0; bj < 2; ++bj) { float g[8]; unpack8(*(const u32x4*)(pg + (size_t)((ai * 4 + m) * 2 + bj) * 4096), g);
                    const f32x4 v0 = acc[ai][bj][m][0], v1 = acc[ai][bj][m][1];
                    u32x4 w; w.x = cvt_pk_bf16(v0[0] * g[0], v0[1] * g[1]); w.y = cvt_pk_bf16(v0[2] * g[2], v0[3] * g[3]); w.z = cvt_pk_bf16(v1[0] * g[4], v1[1] * g[5]); w.w = cvt_pk_bf16(v1[2] * g[6], v1[3] * g[7]);
                    *(u32x4*)(rowp + bj * 128) = w; } }
    }
};
struct EpiX1 {
    static constexpr bool PERM = false, MID = false;
    const float* x; float* out;
    __device__ __forceinline__ void operator()(const f32x4 (&acc)[2][2][4][2], const Unit& u, int wr, int wc, int fr, int fq) const {
        const int row0 = u.pm * 256 + wr * 64 + fr, col0 = u.pn * 256 + wc * 32 + 4 * fq;
#pragma unroll
        for (int ai = 0; ai < 2; ++ai)
#pragma unroll
            for (int m = 0; m < 4; ++m) { const size_t off = (size_t)(row0 + ai * 128 + m * 16) * 1024 + col0;
#pragma unroll
                for (int bj = 0; bj < 2; ++bj)
#pragma unroll
                    for (int n = 0; n < 2; ++n) *(f32x4*)(out + off + bj * 128 + n * 16) = *(const f32x4*)(x + off + bj * 128 + n * 16) + acc[ai][bj][m][n];
                if (m & 1) asm volatile("" ::: "memory"); }
    }
};
struct EpiSwiglu {
    static constexpr bool PERM = true, MID = false;
    unsigned char* act; const float* b1;
    __device__ __forceinline__ void operator()(const f32x4 (&acc)[2][2][4][2], const Unit& u, int wr, int wc, int fr, int fq) const {
        const int row0 = u.pm * 256 + wr * 64 + fr; const float* be = b1 + (size_t)u.tag * 2048; const int j = 128 * u.pn + 32 * wc + 8 * fq;
        float bg[8], bl[8];
#pragma unroll
        for (int q = 0; q < 4; ++q) { const f32x4 t = *(const f32x4*)(be + 2 * j + 4 * q); bg[2 * q] = t[0]; bl[2 * q] = t[1]; bg[2 * q + 1] = t[2]; bl[2 * q + 1] = t[3]; }
#pragma unroll
        for (int ai = 0; ai < 2; ++ai)
#pragma unroll
            for (int m = 0; m < 4; ++m) { float o[8];
#pragma unroll
                for (int n = 0; n < 2; ++n)
#pragma unroll
                    for (int i = 0; i < 4; ++i) { const float xg = fminf(acc[ai][0][m][n][i] * (1.0f / 256.0f) + bg[4 * n + i], 7.0f); const float xl = fminf(fmaxf(acc[ai][1][m][n][i] * (1.0f / 256.0f) + bl[4 * n + i], -7.0f), 7.0f);
                        o[4 * n + i] = xg * __builtin_amdgcn_rcpf(1.0f + __builtin_amdgcn_exp2f(xg * (-1.702f * 1.44269504f))) * fmaf(xl, 4.0f, 4.0f); }
                u32x2 w; w.x = pack4_fp8(o[0], o[1], o[2], o[3]); w.y = pack4_fp8(o[4], o[5], o[6], o[7]);
                *(u32x2*)(act + (size_t)(row0 + ai * 128 + m * 16) * 1024 + j) = w; }
    }
};
struct EpiYs {
    static constexpr bool PERM = true, MID = false;
    bf16_t* ys; const float* b2;
    __device__ __forceinline__ void operator()(const f32x4 (&acc)[2][2][4][2], const Unit& u, int wr, int wc, int fr, int fq) const {
        const int row0 = u.pm * 256 + wr * 64 + fr, col0 = u.pn * 256 + wc * 32 + 8 * fq; const float* be = b2 + (size_t)u.tag * 1024;
#pragma unroll
        for (int bj = 0; bj < 2; ++bj) { const f32x4 c0 = *(const f32x4*)(be + col0 + bj * 128), c1 = *(const f32x4*)(be + col0 + bj * 128 + 4);
#pragma unroll
            for (int ai = 0; ai < 2; ++ai)
#pragma unroll
                for (int m = 0; m < 4; ++m) { const f32x4 v0 = acc[ai][bj][m][0] * (1.0f / 128.0f) + c0, v1 = acc[ai][bj][m][1] * (1.0f / 128.0f) + c1;
                    u32x4 w; w.x = cvt_pk_bf16(v0[0], v0[1]); w.y = cvt_pk_bf16(v0[2], v0[3]); w.z = cvt_pk_bf16(v1[0], v1[1]); w.w = cvt_pk_bf16(v1[2], v1[3]);
                    *(u32x4*)(ys + (size_t)(row0 + ai * 128 + m * 16) * 1024 + col0 + bj * 128) = w; } }
    }
};
template <bool GATHER_> struct SchedMoe {
    static constexpr bool GATHER = GATHER_;
    const char* A; const char* Bt; const LAS int* tstart; const int* stok; int lgN, total; size_t estride, tbytes;
    __device__ __forceinline__ bool next(int i, Unit& u) const {
        const int c = blockIdx.x; const int un = i * 256 + (c & 7) * 32 + (c >> 3); if (un >= total) return false;
        const int mt = un >> lgN, pn = un & ((1 << lgN) - 1); const int e = ((const LAS unsigned char*)tstart)[(LX_TEXP - LX_TSTART) + mt];
        u.pm = mt; u.pn = pn; u.tag = e; u.pa = GATHER ? A : A + (size_t)mt * tbytes; u.pb = Bt + (size_t)e * estride + (size_t)pn * tbytes; return true;
    }
    __device__ __forceinline__ unsigned a_off(const Unit& u, int h, int R, int C, int rowbytes) const { const int tok = stok[u.pm * 256 + h * 128 + R]; return (unsigned)(tok * rowbytes + C * 2); }
};

__device__ __forceinline__ int w1perm(int c) { const int j = c >> 1, s = c & 1; return ((j >> 7) << 8) | (s << 7) | (j & 127); }
__device__ __forceinline__ void phase_prep(const int wv, LAS unsigned char* lds) {
    KParams& p = *kparams();
    const int tid = opaque_tid(wv); unsigned char* ws = p.ws;
    LAS float* tile = (LAS float*)lds;
    struct TileJob { const float* src; bf16_t* dst; unsigned char* dst8; int K, N, perm, f8, ldd, k0, n0; };
    auto decode = [&](int t) -> TileJob { TileJob j; j.dst = nullptr; j.dst8 = nullptr; j.f8 = 0; j.perm = 0; j.ldd = 0; int lt;
        if (t < 960) { j.src = p.in[3]; j.dst = (bf16_t*)(ws + OFF_WINT); j.K = 1024; j.N = 7680; lt = t; if ((lt % 120) >= 28) { j.f8 = 1; j.dst8 = ws + OFF_WIN8 - (size_t)1792 * 1024; } }
        else if (t < 1088) { j.src = p.in[18]; j.dst = (bf16_t*)(ws + OFF_WMKVT); j.K = 1024; j.N = 1024; lt = t - 960; }
        else if (t < 1152) { j.src = p.in[21]; j.dst = (bf16_t*)(ws + OFF_PCAT); j.K = 512; j.N = 1024; lt = t - 1088; j.ldd = 1280; }
        else if (t < 1184) { j.src = p.in[22]; j.dst = (bf16_t*)(ws + OFF_PCAT) + 512; j.K = 256; j.N = 1024; lt = t - 1152; j.ldd = 1280; }
        else if (t < 1248) { j.src = p.in[23]; j.dst = (bf16_t*)(ws + OFF_PCAT) + 768; j.K = 512; j.N = 1024; lt = t - 1184; j.ldd = 1280; }
        else if (t < 1376) { j.src = p.in[24]; j.dst = (bf16_t*)(ws + OFF_WOT); j.K = 1024; j.N = 1024; lt = t - 1248; }
        else if (t < 9568) { const int q = t - 1376, e = q >> 8; j.src = p.in[28] + (size_t)e * 1024 * 2048; j.dst8 = ws + OFF_W1T + (size_t)e * 2048 * 1024; j.K = 1024; j.N = 2048; j.perm = 1; lt = q & 255; j.f8 = 1; }
        else { const int q = t - 9568, e = q >> 7; j.src = p.in[30] + (size_t)e * 1024 * 1024; j.dst8 = ws + OFF_W2T + (size_t)e * 1024 * 1024; j.K = 1024; j.N = 1024; lt = q & 127; j.f8 = 1; }
        const int tn = j.N >> 6; j.k0 = (lt / tn) * 128; j.n0 = (lt % tn) * 64; return j; };
    { const int G = (int)gridDim.x; int t = 13663 - (int)blockIdx.x;
      auto ldtile = [&](const TileJob& j, f32x4 (&v)[4]) {
#pragma unroll
          for (int i = 0; i < 4; ++i) { const int idx = tid + 512 * i, row = idx >> 4, c4 = idx & 15; v[i] = __builtin_nontemporal_load((const f32x4*)(j.src + (size_t)(j.k0 + row) * j.N + j.n0 + 4 * c4)); } };
      TileJob j0 = decode(t < 0 ? 0 : t), j1 = decode(t - G < 0 ? 0 : t - G); f32x4 v0[4], v1[4];
      if (t >= 0) ldtile(j0, v0);
      if (t - G >= 0) ldtile(j1, v1);
      for (; t >= 0; t -= G) {
#pragma unroll
          for (int i = 0; i < 4; ++i) { const int idx = tid + 512 * i, row = idx >> 4, c4 = idx & 15; LAS float* tp = tile + row * 65 + 4 * c4; tp[0] = v0[i][0]; tp[1] = v0[i][1]; tp[2] = v0[i][2]; tp[3] = v0[i][3]; }
          __syncthreads();
          const TileJob cur = j0; j0 = j1;
#pragma unroll
          for (int i = 0; i < 4; ++i) v0[i] = v1[i];
          if (t - 2 * G >= 0) { j1 = decode(t - 2 * G); ldtile(j1, v1); }
          if (!cur.f8) {
#pragma unroll
              for (int i = 0; i < 2; ++i) { const int kc = (tid & 3) | (((tid >> 8) & 1) << 2) | (i << 3), n = (tid >> 2) & 63; float f[8];
#pragma unroll
                  for (int j = 0; j < 8; ++j) f[j] = tile[(kc * 8 + j) * 65 + n];
                  const int drow = cur.n0 + n;
                  *(u32x4*)(cur.dst + (size_t)drow * (cur.ldd ? cur.ldd : cur.K) + cur.k0 + kc * 8) = pack8(f); }
          } else {
              const int kc = (tid & 3) | (((tid >> 8) & 1) << 2), n = (tid >> 2) & 63; float f[16];
#pragma unroll
              for (int j = 0; j < 16; ++j) f[j] = tile[(kc * 16 + j) * 65 + n] * 32.0f;
              const int drow = cur.perm ? w1perm(cur.n0 + n) : (cur.n0 + n);
              u32x4 w; w.x = pack4_fp8(f[0], f[1], f[2], f[3]); w.y = pack4_fp8(f[4], f[5], f[6], f[7]); w.z = pack4_fp8(f[8], f[9], f[10], f[11]); w.w = pack4_fp8(f[12], f[13], f[14], f[15]);
              *(u32x4*)(cur.dst8 + (size_t)drow * cur.K + cur.k0 + kc * 16) = w; }
          __syncthreads(); } }
    { const float* w2 = p.in[6]; const float* a2 = p.in[8]; const float* g2 = p.in[9]; bf16_t* lt = (bf16_t*)(ws + OFF_LORAT);
      for (int idx = blockIdx.x * 512 + tid; idx < 1536 * 32; idx += gridDim.x * 512) { const int n = idx >> 5, kc = idx & 31; float f[8];
#pragma unroll
          for (int j = 0; j < 8; ++j) { const int k = kc * 8 + j; float val = 0.f;
              if (n < 512) { if (k < 64) val = w2[k * 512 + n]; }
              else if (n < 1024) { if (k >= 64 && k < 128) val = a2[(k - 64) * 512 + (n - 512)]; }
              else { if (k >= 128) val = g2[(k - 128) * 512 + (n - 1024)]; }
              f[j] = val; }
          *(u32x4*)(lt + (size_t)n * 256 + kc * 8) = pack8(f); } }
    { const float* wr = p.in[26]; bf16_t* wt = (bf16_t*)(ws + OFF_WRT);
      for (int idx = blockIdx.x * 512 + tid; idx < 32 * 1024; idx += gridDim.x * 512) { const int e = idx >> 10, k = idx & 1023; const float v = wr[k * 32 + e];
          const unsigned hi = cvt_pk_bf16(v, 0.f) & 0xffffu; const float vh = __uint_as_float(hi << 16); const unsigned lo = cvt_pk_bf16(v - vh, 0.f) & 0xffffu;
          wt[idx] = (bf16_t)hi; wt[32768 + idx] = (bf16_t)lo; } }
    { const int wid = tid >> 6, lane = tid & 63; const int gw = blockIdx.x * 8 + wid, nw = gridDim.x * 8;
      for (int row0 = gw; row0 < NTOK + 2048; row0 += 3 * nw) {
          f32x4 v[3][4];
#pragma unroll
          for (int r3 = 0; r3 < 3; ++r3) { const int row = row0 + r3 * nw; if (row < NTOK + 2048) { const float* src = row >= NTOK ? p.in[1] + (size_t)(row - NTOK) * 1024 : p.in[0] + (size_t)row * 1024;
#pragma unroll
              for (int i = 0; i < 4; ++i) v[r3][i] = __builtin_nontemporal_load((const f32x4*)(src + 4 * lane + 256 * i)); } }
#pragma unroll
          for (int r3 = 0; r3 < 3; ++r3) { const int row = row0 + r3 * nw; if (row >= NTOK + 2048) break;
              const bool ism = row >= NTOK; const float* gain = ism ? p.in[17] : p.in[2]; bf16_t* dst = ism ? (bf16_t*)(ws + OFF_HM) + (size_t)(row - NTOK) * 1024 : (bf16_t*)(ws + OFF_H) + (size_t)row * 1024;
              float ss = 0.f;
#pragma unroll
              for (int i = 0; i < 4; ++i) ss += v[r3][i][0] * v[r3][i][0] + v[r3][i][1] * v[r3][i][1] + v[r3][i][2] * v[r3][i][2] + v[r3][i][3] * v[r3][i][3];
              ss = red64(ss); const float rs = rsqrtf(ss * (1.0f / 1024.0f) + 1e-5f);
#pragma unroll
              for (int i = 0; i < 4; ++i) { const f32x4 g = *(const f32x4*)(gain + 4 * lane + 256 * i); const f32x4 y = v[r3][i] * rs * g;
                  u32x2 w; w.x = cvt_pk_bf16(y[0], y[1]); w.y = cvt_pk_bf16(y[2], y[3]);
                  *(u32x2*)(dst + 4 * lane + 256 * i) = w;
                  if (!ism) *(unsigned*)(ws + OFF_H8 + (size_t)row * 1024 + 4 * lane + 256 * i) = pack4_fp8(y[0] * 8.0f, y[1] * 8.0f, y[2] * 8.0f, y[3] * 8.0f); } } }
    }
}

__device__ __forceinline__ void phase_elem_c(const int wv) {
    KParams& p = *kparams();
    const int gt = blockIdx.x * 512 + opaque_tid(wv), nthr = gridDim.x * 512; unsigned char* ws = p.ws;
    bf16_t* Z = (bf16_t*)(ws + OFF_Z); bf16_t* AL = (bf16_t*)(ws + OFF_ALORA); bf16_t* KV = (bf16_t*)(ws + OFF_KV);
    const float* mu = p.in[4];
    u32x4 za[4], zb[4]; const u32x4 zq0 = zero4u();
#pragma unroll
    for (int k = 0; k < 4; ++k) { const int idx = gt + k * nthr, t = idx >> 5, ch = idx & 31, col = C_ZW + 8 * ch;
        za[k] = *(const u32x4*)(Z + (size_t)t * INC + col);
        zb[k] = zq0; if ((t & (SEQ - 1)) != 0) zb[k] = *(const u32x4*)(Z + (size_t)(t - 1) * INC + col); }
#pragma unroll
    for (int k = 0; k < 4; ++k) { const int idx = gt + k * nthr, t = idx >> 5, ch = idx & 31, col = C_ZW + 8 * ch;
        float a[8], b[8]; unpack8(za[k], a); unpack8(zb[k], b);
        const f32x4 m0 = *(const f32x4*)(mu + col), m1 = *(const f32x4*)(mu + col + 4); const float mm[8] = {m0[0], m0[1], m0[2], m0[3], m1[0], m1[1], m1[2], m1[3]};
#pragma unroll
        for (int j = 0; j < 8; ++j) { float v = a[j] + (b[j] - a[j]) * mm[j]; if (ch < 8) v = tanhf(v); else if (ch >= 16) v = sigmoidf_(v); a[j] = v; }
        *(u32x4*)(AL + (size_t)t * 256 + 8 * ch) = pack8(a); }
}

__device__ __forceinline__ bf16x8 pack_frag(const f32x4 lo, const f32x4 hi) { u32x4 w; w.x = cvt_pk_bf16(lo[0], lo[1]); w.y = cvt_pk_bf16(lo[2], lo[3]); w.z = cvt_pk_bf16(hi[0], hi[1]); w.w = cvt_pk_bf16(hi[2], hi[3]); bf16x8 r; __builtin_memcpy(&r, &w, 16); return r; }
__device__ __forceinline__ bf16x8 tr2(LAS unsigned char* pa, LAS unsigned char* pb) { const s16x4 a = __builtin_amdgcn_ds_read_tr16_b64_v4i16((LAS s16x4*)pa), b = __builtin_amdgcn_ds_read_tr16_b64_v4i16((LAS s16x4*)pb); return __builtin_shufflevector(a, b, 0, 1, 2, 3, 4, 5, 6, 7); }
__device__ __forceinline__ bf16x8 rd2(LAS unsigned char* pa, LAS unsigned char* pb) { const s16x4 a = *(const LAS s16x4*)pa, b = *(const LAS s16x4*)pb; return __builtin_shufflevector(a, b, 0, 1, 2, 3, 4, 5, 6, 7); }
#define MFMA16(a, b, c) __builtin_amdgcn_mfma_f32_16x16x32_bf16((a), (b), (c), 0, 0, 0)
constexpr int CP_XA = 0, CP_XR = 4096, CP_XB = 8192, CP_XK = 12288, CP_VL = 16384, CP_NL = 16384, CP_WAVE = 20480;
__device__ __forceinline__ void phase_chunk_pre(const int wv, LAS unsigned char* lds) {
    KParams& p = *kparams();
    const int tid = opaque_tid(wv), wid = tid >> 6, lane = tid & 63, fr = lane & 15, fq = lane >> 4; unsigned char* ws = p.ws;
    u32x4 keep = zero4u(); if (tid == 0) keep = *(const LAS u32x4*)(lds + LDS_X);
    __syncthreads();
    LAS unsigned char* wl = lds + wid * CP_WAVE;
    const bf16_t* Z = (const bf16_t*)(ws + OFF_Z); const float* L = (const float*)(ws + OFF_L); bf16_t* C1 = (bf16_t*)(ws + OFF_C1); bf16_t* C2 = (bf16_t*)(ws + OFF_C2);
    const float* mu = p.in[4]; const float* k_k = p.in[10]; const float* k_a = p.in[11]; const float* r_k = p.in[12]; const float* ln_w = p.in[13]; const float* ln_b = p.in[14];
    const f32x4 z4 = zero4f();
    for (int pr = blockIdx.x * 8 + wid; pr < 4096; pr += gridDim.x * 8) {
        float gamC;
        { const int bh = pr >> 6, cc = pr & 63, b_ = bh >> 3, h_ = bh & 7; const int tok0 = b_ * SEQ + cc * 32; const int c = h_ * 64 + lane;
          const bf16_t* zp = Z + (size_t)tok0 * INC + c; const float* lp = L + (size_t)tok0 * 1536 + c;
          const float mur = mu[c], muk = mu[C_K + c], muv = mu[C_V + c], kk_ = k_k[c], ka_ = k_a[c], rk_ = r_k[c], lnw = ln_w[c], lnb = ln_b[c];
          float pzr = 0.f, pzk = 0.f, pzv = 0.f;
          if (cc != 0) { pzr = __uint_as_float((unsigned)zp[-INC] << 16); pzk = __uint_as_float((unsigned)zp[-INC + C_K] << 16); pzv = __uint_as_float((unsigned)zp[-INC + C_V] << 16); }
          unsigned short zq[2][4][3]; float lq[2][4][3];
#pragma unroll
          for (int e = 0; e < 4; ++e) {
#pragma unroll
              for (int q = 0; q < 3; ++q) { zq[0][e][q] = zp[(size_t)e * INC + q * 512]; lq[0][e][q] = lp[(size_t)e * 1536 + q * 512]; } }
          __builtin_amdgcn_sched_barrier(0);
          float cs = 0.f, g = 1.0f;
#pragma unroll
          for (int t4 = 0; t4 < 8; ++t4) { unsigned pa[2], pr_[2], pb[2], pk[2];
              if (t4 < 7) {
#pragma unroll
                  for (int e = 0; e < 4; ++e) {
#pragma unroll
                      for (int q = 0; q < 3; ++q) { zq[(t4 + 1) & 1][e][q] = zp[(size_t)((t4 + 1) * 4 + e) * INC + q * 512]; lq[(t4 + 1) & 1][e][q] = lp[(size_t)((t4 + 1) * 4 + e) * 1536 + q * 512]; } } }
              __builtin_amdgcn_sched_barrier(0);
#pragma unroll
              for (int tp = 0; tp < 2; ++tp) { float va[2], vr[2], vb[2], vk[2];
#pragma unroll
                  for (int e = 0; e < 2; ++e) { const int te = tp * 2 + e, t = t4 * 4 + te;
                      const float zr = __uint_as_float((unsigned)zq[t4 & 1][te][0] << 16), zk = __uint_as_float((unsigned)zq[t4 & 1][te][1] << 16), zv = __uint_as_float((unsigned)zq[t4 & 1][te][2] << 16);
                      const float r = zr + (pzr - zr) * mur, k = zk + (pzk - zk) * muk, v = zv + (pzv - zv) * muv; pzr = zr; pzk = zk; pzv = zv;
                      const float lw = lq[t4 & 1][te][0], al = lq[t4 & 1][te][1], gg = lq[t4 & 1][te][2];
                      const float kk = k * kk_, kp = k * (1.0f + (al - 1.0f) * ka_);
                      const float n2 = red64(kk * kk), bon = red64(r * kp * rk_);
                      const float kn = kk * __builtin_amdgcn_rsqf(fmaxf(n2, 1e-24f));
                      const float gm1 = g; cs += lw; g = __builtin_amdgcn_exp2f(cs * 1.44269504f); const float gi = __builtin_amdgcn_rcpf(g);
                      va[e] = -kn * gm1; vb[e] = kn * al * gi; vk[e] = kp * gi; vr[e] = r * g;
                      *(LAS bf16_t*)(wl + CP_VL + t * 128 + lane * 2) = (bf16_t)(cvt_pk_bf16(v, 0.f) & 0xffffu);
                      const size_t to = (size_t)(tok0 + t) * 512 + c;
                      C1[to] = (bf16_t)(cvt_pk_bf16(lnw * gg, 0.f) & 0xffffu); C2[to] = (bf16_t)(cvt_pk_bf16((lnb + bon * v) * gg, 0.f) & 0xffffu); }
                  pa[tp] = cvt_pk_bf16(va[0], va[1]); pr_[tp] = cvt_pk_bf16(vr[0], vr[1]); pb[tp] = cvt_pk_bf16(vb[0], vb[1]); pk[tp] = cvt_pk_bf16(vk[0], vk[1]); }
              *(LAS u32x2*)(wl + CP_XA + lane * 64 + t4 * 8) = (u32x2){pa[0], pa[1]}; *(LAS u32x2*)(wl + CP_XR + lane * 64 + t4 * 8) = (u32x2){pr_[0], pr_[1]};
              *(LAS u32x2*)(wl + CP_XB + lane * 64 + t4 * 8) = (u32x2){pb[0], pb[1]}; *(LAS u32x2*)(wl + CP_XK + lane * 64 + t4 * 8) = (u32x2){pk[0], pk[1]};
              __builtin_amdgcn_sched_barrier(0); }
          gamC = g; }
        asm volatile("s_waitcnt lgkmcnt(0)" ::: "memory");
        bf16x8 Vf[4];
        { const int vtb = (4 * fq + (fr >> 2)) * 128 + (fr & 3) * 8;
#pragma unroll
          for (int nv = 0; nv < 4; ++nv) { LAS unsigned char* pp = wl + CP_VL + vtb + nv * 32; Vf[nv] = tr2(pp, pp + 2048); } }
        asm volatile("s_waitcnt lgkmcnt(0)" ::: "memory");
        const int trb = (8 * fq + (fr >> 2)) * 64 + (fr & 3) * 8;
        bf16x8 LakF[2], QrbF[2], QrkF[2];
#pragma unroll
        for (int yi = 0; yi < 2; ++yi) {
            bf16x8 fy[2][2];
#pragma unroll
            for (int nt = 0; nt < 2; ++nt)
#pragma unroll
                for (int s2 = 0; s2 < 2; ++s2) { LAS unsigned char* pp = wl + (yi ? CP_XR : CP_XA) + trb + s2 * 2048 + nt * 32; fy[nt][s2] = tr2(pp, pp + 256); }
#pragma unroll
            for (int xi = 0; xi < 2; ++xi) {
                f32x4 d[2][2];
#pragma unroll
                for (int mi = 0; mi < 2; ++mi) { bf16x8 fx[2];
#pragma unroll
                    for (int s2 = 0; s2 < 2; ++s2) { LAS unsigned char* pp = wl + (xi ? CP_XK : CP_XB) + trb + s2 * 2048 + mi * 32; fx[s2] = tr2(pp, pp + 256); }
#pragma unroll
                    for (int nt = 0; nt < 2; ++nt) {
                        if (mi == 1 && nt == 0) { d[mi][nt] = z4; continue; }
                        f32x4 acc = MFMA16(fx[0], fy[nt][0], z4); acc = MFMA16(fx[1], fy[nt][1], acc);
#pragma unroll
                        for (int j = 0; j < 4; ++j) { const int i = 16 * mi + 4 * fq + j, t = 16 * nt + fr; const bool ok = yi ? (i <= t) : (i < t); acc[j] = ok ? acc[j] : 0.f; }
                        d[mi][nt] = acc; } }
                if (yi == 0 && xi == 0) {
#pragma unroll
                    for (int mi = 0; mi < 2; ++mi)
#pragma unroll
                        for (int nt = 0; nt < 2; ++nt)
#pragma unroll
                            for (int j = 0; j < 4; ++j) *(LAS float*)(wl + CP_NL + ((16 * nt + fr) * 32 + 16 * mi + 4 * fq + j) * 4) = d[mi][nt][j];
                } else {
#pragma unroll
                    for (int nt = 0; nt < 2; ++nt) { const bf16x8 f = pack_frag(d[0][nt], d[1][nt]); if (yi == 0) LakF[nt] = f; else if (xi == 0) QrbF[nt] = f; else QrkF[nt] = f; } } } }
        asm volatile("s_waitcnt lgkmcnt(0)" ::: "memory");
        bf16x8 InvF[2];
        { const int c = lane & 31; float X[32];
#pragma unroll
          for (int t = 0; t < 32; ++t) { float a0 = (t == c) ? 1.0f : 0.f, a1 = 0.f;
#pragma unroll
              for (int i4 = 0; i4 < (t + 3) / 4; ++i4) { const f32x4 nv = *(const LAS f32x4*)(wl + CP_NL + (t * 32 + 4 * i4) * 4);
#pragma unroll
                  for (int e = 0; e < 4; ++e) if (4 * i4 + e < t) { if (e & 1) a1 = fmaf(nv[e], X[4 * i4 + e], a1); else a0 = fmaf(nv[e], X[4 * i4 + e], a0); } }
              X[t] = a0 + a1; }
          asm volatile("s_waitcnt lgkmcnt(0)" ::: "memory");
#pragma unroll
          for (int t = 0; t < 32; ++t) *(LAS float*)(wl + CP_NL + (t * 32 + c) * 4) = X[t];
          asm volatile("s_waitcnt lgkmcnt(0)" ::: "memory");
#pragma unroll
          for (int n = 0; n < 2; ++n) { const f32x4 lo = *(const LAS f32x4*)(wl + CP_NL + ((16 * n + fr) * 32 + 4 * fq) * 4), hi = *(const LAS f32x4*)(wl + CP_NL + ((16 * n + fr) * 32 + 16 + 4 * fq) * 4); InvF[n] = pack_frag(lo, hi); } }
        bf16x8 UF[4], AhF[4];
#pragma unroll
        for (int nv = 0; nv < 4; ++nv) { const f32x4 w0 = MFMA16(LakF[0], Vf[nv], z4), w1 = MFMA16(LakF[1], Vf[nv], z4); const bf16x8 wf = pack_frag(w0, w1);
            const f32x4 u0 = MFMA16(InvF[0], wf, z4), u1 = MFMA16(InvF[1], wf, z4); UF[nv] = pack_frag(u0, u1); }
#pragma unroll
        for (int nc = 0; nc < 4; ++nc) { LAS unsigned char* pp = wl + CP_XA + (16 * nc + fr) * 64 + 8 * fq; const bf16x8 af = rd2(pp, pp + 32);
            const f32x4 h0 = MFMA16(InvF[0], af, z4), h1 = MFMA16(InvF[1], af, z4); AhF[nc] = pack_frag(h0, h1); }
        { f32x4 rt[4][2];
#pragma unroll
          for (int mc = 0; mc < 4; ++mc)
#pragma unroll
              for (int nt = 0; nt < 2; ++nt) { const s16x4 rr = __builtin_amdgcn_ds_read_tr16_b64_v4i16((LAS s16x4*)(wl + CP_XR + (16 * mc + 4 * fq + (fr >> 2)) * 64 + (fr & 3) * 8 + nt * 32));
                  f32x4 cin; cin[0] = __uint_as_float((unsigned)(unsigned short)rr[0] << 16); cin[1] = __uint_as_float((unsigned)(unsigned short)rr[1] << 16); cin[2] = __uint_as_float((unsigned)(unsigned short)rr[2] << 16); cin[3] = __uint_as_float((unsigned)(unsigned short)rr[3] << 16);
                  rt[mc][nt] = MFMA16(AhF[mc], QrbF[nt], cin); }
          bf16x8* RTF = (bf16x8*)(ws + OFF_RTF) + (size_t)pr * 256;
#pragma unroll
          for (int nt = 0; nt < 2; ++nt)
#pragma unroll
              for (int s2 = 0; s2 < 2; ++s2) RTF[(nt * 2 + s2) * 64 + lane] = pack_frag(rt[2 * s2][nt], rt[2 * s2 + 1][nt]); }
        { u32x2* YLF = (u32x2*)(ws + OFF_YLF) + (size_t)pr * 512;
#pragma unroll
          for (int nv = 0; nv < 4; ++nv)
#pragma unroll
              for (int mt = 0; mt < 2; ++mt) { f32x4 y = MFMA16(QrbF[mt], UF[nv], z4); y = MFMA16(QrkF[mt], Vf[nv], y);
                  u32x2 w; w.x = cvt_pk_bf16(y[0], y[1]); w.y = cvt_pk_bf16(y[2], y[3]); YLF[(nv * 2 + mt) * 64 + lane] = w; } }
        { bf16x8* GTF = (bf16x8*)(ws + OFF_GTF) + (size_t)pr * 512; u32x2* HHF = (u32x2*)(ws + OFF_HHF) + (size_t)pr * 1024;
#pragma unroll
          for (int nc = 0; nc < 4; ++nc) { LAS unsigned char* pp = wl + CP_XB + (16 * nc + fr) * 64 + 8 * fq; const bf16x8 bf_ = rd2(pp, pp + 32);
              LAS unsigned char* pk = wl + CP_XK + (16 * nc + fr) * 64 + 8 * fq; const bf16x8 kf_ = rd2(pk, pk + 32);
              const float gcol = __int_as_float(__builtin_amdgcn_ds_bpermute((16 * nc + fr) << 2, __float_as_int(gamC)));
              f32x4 gt[4];
#pragma unroll
              for (int mc = 0; mc < 4; ++mc) { f32x4 a = MFMA16(AhF[mc], bf_, z4);
#pragma unroll
                  for (int j = 0; j < 4; ++j) { if (mc == nc && 4 * fq + j == fr) a[j] += 1.0f; a[j] *= gcol; }
                  gt[mc] = a; }
              GTF[(nc * 2 + 0) * 64 + lane] = pack_frag(gt[0], gt[1]); GTF[(nc * 2 + 1) * 64 + lane] = pack_frag(gt[2], gt[3]);
              f32x4 grow;
#pragma unroll
              for (int j = 0; j < 4; ++j) grow[j] = __int_as_float(__builtin_amdgcn_ds_bpermute((16 * nc + 4 * fq + j) << 2, __float_as_int(gamC)));
#pragma unroll
              for (int nv = 0; nv < 4; ++nv) { f32x4 hh = MFMA16(bf_, UF[nv], z4); hh = MFMA16(kf_, Vf[nv], hh); hh = hh * grow;
                  u32x2 w; w.x = cvt_pk_bf16(hh[0], hh[1]); w.y = cvt_pk_bf16(hh[2], hh[3]); HHF[(nv * 4 + nc) * 64 + lane] = w; } } }
        asm volatile("s_waitcnt lgkmcnt(0)" ::: "memory");
    }
    __syncthreads();
    if (tid == 0) *(LAS u32x4*)(lds + LDS_X) = keep;
}
__device__ __forceinline__ void phase_scan_seq(const int wv, LAS unsigned char* lds) {
    KParams& p = *kparams();
    const int tid = opaque_tid(wv), wid = __builtin_amdgcn_readfirstlane(tid >> 6), lane = tid & 63, fr = lane & 15, fq = lane >> 4; unsigned char* ws = p.ws;
    if (blockIdx.x >= 64) return;
    const int bh = blockIdx.x, b = bh >> 3, h = bh & 7;
    const char* gG = (const char*)(ws + OFF_GTF) + (size_t)bh * 64 * 8192; const char* gR = (const char*)(ws + OFF_RTF) + (size_t)bh * 64 * 4096;
    const char* gH = (const char*)(ws + OFF_HHF) + (size_t)bh * 64 * 8192; const char* gY = (const char*)(ws + OFF_YLF) + (size_t)bh * 64 * 4096;
    constexpr int SLOT = 24576;
    if (wid >= 4) {
        const int w = wid - 4;
        auto issue = [&](int c) { LAS unsigned char* slot = lds + (c % 5) * SLOT;
#pragma unroll
            for (int i = 0; i < 6; ++i) { const int pc = w + 4 * i;
                const char* src = pc < 8 ? gG + (size_t)c * 8192 + pc * 1024 : pc < 12 ? gR + (size_t)c * 4096 + (pc - 8) * 1024 : pc < 20 ? gH + (size_t)c * 8192 + (pc - 12) * 1024 : gY + (size_t)c * 4096 + (pc - 20) * 1024;
                __builtin_amdgcn_global_load_lds((const unsigned*)(src + lane * 16), (LAS unsigned*)(slot + pc * 1024), 16, 0, 0); } };
        issue(0); issue(1); issue(2); issue(3);
        for (int c = 0; c < 64; ++c) {
            if (c < 60) asm volatile("s_waitcnt vmcnt(18)" ::: "memory"); else asm volatile("s_waitcnt vmcnt(0)" ::: "memory");
            __builtin_amdgcn_s_barrier();
            if (c + 4 < 64) issue(c + 4);
        }
        return; }
    const int nv = wid;
    float* Yraw = (float*)(ws + OFF_YRAW) + (size_t)b * SEQ * 512 + h * 64 + 16 * nv + fr;
    f32x4 T[4]; const f32x4 z4s = zero4f();
#pragma unroll
    for (int m = 0; m < 4; ++m) T[m] = z4s;
    for (int c = 0; c < 64; ++c) {
        __builtin_amdgcn_s_barrier();
        const LAS unsigned char* slot = lds + (c % 5) * SLOT + lane * 16;
        bf16x8 G[8], R[4]; u32x2 H[4], Y[2];
#pragma unroll
        for (int i = 0; i < 8; ++i) G[i] = *(const LAS bf16x8*)(slot + i * 1024);
#pragma unroll
        for (int i = 0; i < 4; ++i) R[i] = *(const LAS bf16x8*)(slot + 8192 + i * 1024);
#pragma unroll
        for (int i = 0; i < 4; ++i) H[i] = *(const LAS u32x2*)(lds + (c % 5) * SLOT + 12288 + (nv * 4 + i) * 512 + lane * 8);
#pragma unroll
        for (int i = 0; i < 2; ++i) Y[i] = *(const LAS u32x2*)(lds + (c % 5) * SLOT + 20480 + (nv * 2 + i) * 512 + lane * 8);
        const bf16x8 tf0 = pack_frag(T[0], T[1]), tf1 = pack_frag(T[2], T[3]);
#pragma unroll
        for (int nt = 0; nt < 2; ++nt) { f32x4 y; y[0] = bf_lo(Y[nt].x); y[1] = bf_hi(Y[nt].x); y[2] = bf_lo(Y[nt].y); y[3] = bf_hi(Y[nt].y);
            y = MFMA16(R[nt * 2], tf0, y); y = MFMA16(R[nt * 2 + 1], tf1, y);
#pragma unroll
            for (int j = 0; j < 4; ++j) Yraw[(size_t)(c * 32 + 16 * nt + 4 * fq + j) * 512] = y[j]; }
#pragma unroll
        for (int m = 0; m < 4; ++m) { f32x4 t; t[0] = bf_lo(H[m].x); t[1] = bf_hi(H[m].x); t[2] = bf_lo(H[m].y); t[3] = bf_hi(H[m].y);
            t = MFMA16(G[m * 2], tf0, t); t = MFMA16(G[m * 2 + 1], tf1, t); T[m] = t; }
        asm volatile("s_waitcnt lgkmcnt(0)" ::: "memory");
    }
}

__device__ __forceinline__ bf16x8 tr_pair(LAS unsigned char* pa, LAS unsigned char* pb, bool useB) {
    const s16x4 a = __builtin_amdgcn_ds_read_tr16_b64_v4i16((LAS s16x4*)pa);
    s16x4 b2 = (s16x4){0, 0, 0, 0};
    if (useB) b2 = __builtin_amdgcn_ds_read_tr16_b64_v4i16((LAS s16x4*)pb);
    return __builtin_shufflevector(a, b2, 0, 1, 2, 3, 4, 5, 6, 7);
}
__device__ __forceinline__ void phase_dil_attn(const int wv, LAS unsigned char* lds) {
    KParams& p = *kparams();
    const int tid = opaque_tid(wv), wid = tid >> 6, lane = tid & 63, fr = lane & 15, fq = lane >> 4; unsigned char* ws = p.ws;
    const bf16_t* Z = (const bf16_t*)(ws + OFF_Z); float* DILO = (float*)(ws + OFF_DILO); float* LSE = (float*)(ws + OFF_LSE);
    LAS unsigned char* kb = lds; LAS unsigned char* vb = lds + 32768; const float* qn = p.in[15]; const float* kn = p.in[16];
    float qkw[2][8];
#pragma unroll
    for (int ks = 0; ks < 2; ++ks)
#pragma unroll
        for (int j = 0; j < 8; ++j) qkw[ks][j] = qn[ks * 32 + 8 * fq + j] * kn[ks * 32 + 8 * fq + j];
    const bool seqwg = blockIdx.x < 64;
    const int u0 = seqwg ? 4 * (int)blockIdx.x : 256 + (int)blockIdx.x - 64, uend = seqwg ? 4 * (int)blockIdx.x + 4 : 1536, ustep = seqwg ? 1 : 192;
    auto umap = [&](int v) -> int { if (seqwg) return v; const int c2 = (int)blockIdx.x - 64, x = c2 & 7, y = c2 >> 3, i = (v - u0) / 192, k = 24 * i + y; return 256 + (k >> 3) * 64 + 8 * x + (k & 7); };
    const int ki = tid >> 1, half = tid & 1;
    u32x4 kvA[4], vvA[4], qvA[2], kvB[4], vvB[4], qvB[2]; bool kvalidA = false, kvalidB = false;
    auto unit_load = [&](int uv, u32x4 (&kv)[4], u32x4 (&vv)[4], u32x4 (&qv)[2], bool& kvalid) { const int u = umap(uv);
        const int b = u / 192, rem = u % 192, hh = rem >> 4, qb = rem & 15, g = hh >> 2;
        const int dil = g == 0 ? 1 : (g == 1 ? 4 : 16), nbc = 16 / dil, r = qb / nbc, j0 = (qb % nbc) * 128;
        const bf16_t* Zb = Z + (size_t)b * SEQ * INC; const int kj = j0 - 128 + ki; kvalid = kj >= 0;
        { const bf16_t* rowp = Zb + (size_t)((kvalid ? kj : 0) * dil + r) * INC + hh * 64 + half * 32;
#pragma unroll
            for (int i = 0; i < 4; ++i) { kv[i] = *(const u32x4*)(rowp + C_DK + 8 * i); vv[i] = *(const u32x4*)(rowp + C_DV + 8 * i); } }
        const int tq = (j0 + 16 * wid + fr) * dil + r;
#pragma unroll
        for (int ks = 0; ks < 2; ++ks) qv[ks] = *(const u32x4*)(Zb + (size_t)tq * INC + C_DQ + hh * 64 + ks * 32 + 8 * fq); };
    auto do_unit = [&](const int uvv, u32x4 (&kv)[4], u32x4 (&vv)[4], u32x4 (&qv)[2], bool& kvalid) { const int u = umap(uvv); const int uv_ = uvv;
        const int b = u / 192, rem = u % 192, hh = rem >> 4, qb = rem & 15, g = hh >> 2, hg = hh & 3;
        const int dil = g == 0 ? 1 : (g == 1 ? 4 : 16), nbc = 16 / dil, r = qb / nbc, j0 = (qb % nbc) * 128;
        { if (kvalid) {
              float ss = sumsq8(kv[0]) + sumsq8(kv[1]) + sumsq8(kv[2]) + sumsq8(kv[3]); ss += dpp_f<0xB1>(ss);
              const float rs = rsqrtf(ss * (1.0f / 64.0f) + 1e-5f);
#pragma unroll
              for (int i = 0; i < 4; ++i) kv[i] = scale8s(kv[i], rs); }
          else { const u32x4 zu = zero4u();
#pragma unroll
              for (int i = 0; i < 4; ++i) { kv[i] = zu; vv[i] = zu; } }
#pragma unroll
          for (int i = 0; i < 4; ++i) { const int sw = (half * 4 + i) ^ (ki & 7); *(LAS u32x4*)(kb + ki * 128 + sw * 16) = kv[i]; *(LAS u32x4*)(vb + ki * 128 + sw * 16) = vv[i]; } }
        const int qi = 16 * wid + fr, tq = (j0 + qi) * dil + r;
        bf16x8 qf[2];
        { float ss = sumsq8(qv[0]) + sumsq8(qv[1]); ss += sxor(ss, 16); ss += sxor(ss, 32);
          const float rs = rsqrtf(ss * (1.0f / 64.0f) + 1e-5f) * 0.125f;
#pragma unroll
          for (int ks = 0; ks < 2; ++ks) { const u32x4 w = scale8r(qv[ks], rs, qkw[ks]); __builtin_memcpy(&qf[ks], &w, 16); } }
        __syncthreads();
        if (uv_ + 2 * ustep < uend) unit_load(uv_ + 2 * ustep, kv, vv, qv, kvalid);
        f32x4 st[9]; float mx = -1e30f; const f32x4 zq = zero4f();
        LAS unsigned char* kp0 = kb + (16 * wid + fr) * 128 + ((fq ^ (fr & 7)) << 4); LAS unsigned char* kp1 = kb + (16 * wid + fr) * 128 + (((4 + fq) ^ (fr & 7)) << 4);
#pragma unroll
        for (int ti = 0; ti < 9; ++ti) {
            const bf16x8 k0 = *(const LAS bf16x8*)(kp0 + ti * 2048), k1 = *(const LAS bf16x8*)(kp1 + ti * 2048);
            f32x4 s = __builtin_amdgcn_mfma_f32_16x16x32_bf16(k0, qf[0], zq, 0, 0, 0);
            s = __builtin_amdgcn_mfma_f32_16x16x32_bf16(k1, qf[1], s, 0, 0, 0);
#pragma unroll
            for (int j = 0; j < 4; ++j) { const int ki = 16 * (wid + ti) + 4 * fq + j, off = qi + 128 - ki; const bool ok = (off >= 0) && (off <= 128) && (j0 - 128 + ki >= 0);
                s[j] = ok ? s[j] : -1e30f; mx = fmaxf(mx, s[j]); }
            st[ti] = s; }
        mx = fmaxf(mx, sxor(mx, 16)); mx = fmaxf(mx, sxor(mx, 32));
        float den = 0.f;
#pragma unroll
        for (int ti = 0; ti < 9; ++ti)
#pragma unroll
            for (int j = 0; j < 4; ++j) { const float e = __builtin_amdgcn_exp2f((st[ti][j] - mx) * 1.44269504f); st[ti][j] = e; den += e; }
        den += sxor(den, 16); den += sxor(den, 32);
        f32x4 o[4];
#pragma unroll
        for (int dt = 0; dt < 4; ++dt) o[dt] = zq;
        const int q4 = fr >> 2, p4 = fr & 3; const int kl = 4 * fq + q4;
        LAS unsigned char* vp[4];
#pragma unroll
        for (int dt = 0; dt < 4; ++dt) vp[dt] = vb + (16 * wid + kl) * 128 + (((2 * dt + (p4 >> 1)) ^ (kl & 7)) << 4) + (p4 & 1) * 8;
#pragma unroll
        for (int pp = 0; pp < 5; ++pp) { const bool two = pp < 4; const int tA = 2 * pp, tB = two ? 2 * pp + 1 : 2 * pp;
            u32x4 pw; pw.x = cvt_pk_bf16(st[tA][0], st[tA][1]); pw.y = cvt_pk_bf16(st[tA][2], st[tA][3]);
            if (two) { pw.z = cvt_pk_bf16(st[tB][0], st[tB][1]); pw.w = cvt_pk_bf16(st[tB][2], st[tB][3]); } else { pw.z = 0u; pw.w = 0u; }
            bf16x8 pf; __builtin_memcpy(&pf, &pw, 16);
#pragma unroll
            for (int dt = 0; dt < 4; ++dt) { const bf16x8 vf = tr_pair(vp[dt] + tA * 2048, vp[dt] + tB * 2048, two);
                o[dt] = __builtin_amdgcn_mfma_f32_16x16x32_bf16(vf, pf, o[dt], 0, 0, 0); } }
        const float inv = __builtin_amdgcn_rcpf(den); const size_t ob = ((size_t)(g * NTOK + b * SEQ + tq) * 4 + hg);
#pragma unroll
        for (int dt = 0; dt < 4; ++dt) *(f32x4*)(DILO + ob * 64 + 16 * dt + 4 * fq) = o[dt] * inv;
        if (fq == 0) LSE[ob] = mx + __logf(den);
        __syncthreads();
    };
    if (u0 < uend) unit_load(u0, kvA, vvA, qvA, kvalidA);
    if (u0 + ustep < uend) unit_load(u0 + ustep, kvB, vvB, qvB, kvalidB);
    for (int u = u0; u < uend; u += 2 * ustep) {
        do_unit(u, kvA, vvA, qvA, kvalidA);
        if (u + ustep < uend) do_unit(u + ustep, kvB, vvB, qvB, kvalidB);
    }
}

__device__ __forceinline__ void phase_mem_attn(const int wv, LAS unsigned char* lds) {
    KParams& p = *kparams();
    const int tid = opaque_tid(wv), wid = tid >> 6, lane = tid & 63, fr = lane & 15, fq = lane >> 4; unsigned char* ws = p.ws;
    const bf16_t* Z = (const bf16_t*)(ws + OFF_Z); const bf16_t* KV = (const bf16_t*)(ws + OFF_KV); bf16_t* YM = (bf16_t*)(ws + OFF_YCAT) + 768;
    LAS unsigned char* kb = lds; LAS unsigned char* vb = lds + 65536; const float* mqn = p.in[19]; const float* mkn = p.in[20];
    if (blockIdx.x < 64) return;
    float mqk[4][8];
#pragma unroll
    for (int ks = 0; ks < 4; ++ks)
#pragma unroll
        for (int j = 0; j < 8; ++j) mqk[ks][j] = mqn[ks * 32 + 8 * fq + j] * mkn[ks * 32 + 8 * fq + j];
    for (int bhq = (int)blockIdx.x - 64; bhq < 256; bhq += (int)gridDim.x - 64) {
        const int bhm = bhq >> 3, b = bhm >> 2, hm = bhm & 3;
        { const int ki = tid >> 1, half = tid & 1; const bf16_t* rowp = KV + (size_t)(b * 256 + ki) * 1024 + hm * 128 + half * 64;
          u32x4 kv[8], vv[8];
#pragma unroll
          for (int i = 0; i < 8; ++i) { kv[i] = *(const u32x4*)(rowp + 8 * i); vv[i] = *(const u32x4*)(rowp + 512 + 8 * i); }
          { float ss = 0.f;
#pragma unroll
            for (int i = 0; i < 8; ++i) ss += sumsq8(kv[i]);
            ss += dpp_f<0xB1>(ss); const float rs = rsqrtf(ss * (1.0f / 128.0f) + 1e-5f);
#pragma unroll
            for (int i = 0; i < 8; ++i) kv[i] = scale8s(kv[i], rs); }
#pragma unroll
          for (int i = 0; i < 8; ++i) { const int sw = (half * 8 + i) ^ (ki & 15); *(LAS u32x4*)(kb + ki * 256 + sw * 16) = kv[i]; *(LAS u32x4*)(vb + ki * 256 + sw * 16) = vv[i]; } }
        __syncthreads();
        const int q4 = fr >> 2, p4 = fr & 3; const int kl = 4 * fq + q4;
        LAS unsigned char* kp[4]; LAS unsigned char* vp[8];
#pragma unroll
        for (int ks = 0; ks < 4; ++ks) kp[ks] = kb + fr * 256 + (((4 * ks + fq) ^ fr) << 4);
#pragma unroll
        for (int dt = 0; dt < 8; ++dt) vp[dt] = vb + kl * 256 + (((2 * dt + (p4 >> 1)) ^ kl) << 4) + (p4 & 1) * 8;
        for (int qq = 0; qq < 2; ++qq) { const int qblk = (bhq & 7) * 2 + qq; const int tq = b * SEQ + qblk * 128 + 16 * wid + fr;
            bf16x8 qf[4];
#pragma unroll
            for (int ks = 0; ks < 4; ++ks) qf[ks] = *(const bf16x8*)(Z + (size_t)tq * INC + C_MQ + hm * 128 + ks * 32 + 8 * fq);
            { u32x4 qv[4]; float ss = 0.f;
#pragma unroll
              for (int ks = 0; ks < 4; ++ks) { __builtin_memcpy(&qv[ks], &qf[ks], 16); ss += sumsq8(qv[ks]); }
              ss += sxor(ss, 16); ss += sxor(ss, 32); const float rs = rsqrtf(ss * (1.0f / 128.0f) + 1e-5f);
#pragma unroll
              for (int ks = 0; ks < 4; ++ks) { const u32x4 w = scale8r(qv[ks], rs, mqk[ks]); __builtin_memcpy(&qf[ks], &w, 16); } }
            f32x4 st[16]; float mx = -1e30f; const f32x4 zq = zero4f();
#pragma unroll
            for (int ti = 0; ti < 16; ++ti) { f32x4 s = zq;
#pragma unroll
                for (int ks = 0; ks < 4; ++ks) { const bf16x8 kf = *(const LAS bf16x8*)(kp[ks] + ti * 4096); s = __builtin_amdgcn_mfma_f32_16x16x32_bf16(kf, qf[ks], s, 0, 0, 0); }
#pragma unroll
                for (int j = 0; j < 4; ++j) mx = fmaxf(mx, s[j]);
                st[ti] = s; if (ti & 1) asm volatile("" ::: "memory"); }
            mx = fmaxf(mx, sxor(mx, 16)); mx = fmaxf(mx, sxor(mx, 32));
            const float sc = 0.08838834764831845f * 1.44269504f; float den = 0.f;
#pragma unroll
            for (int ti = 0; ti < 16; ++ti)
#pragma unroll
                for (int j = 0; j < 4; ++j) { const float e = __builtin_amdgcn_exp2f((st[ti][j] - mx) * sc); st[ti][j] = e; den += e; }
            den += sxor(den, 16); den += sxor(den, 32);
            f32x4 o[8];
#pragma unroll
            for (int dt = 0; dt < 8; ++dt) o[dt] = zq;
#pragma unroll
            for (int pp = 0; pp < 8; ++pp) { const int tA = 2 * pp, tB = 2 * pp + 1;
                u32x4 pw; pw.x = cvt_pk_bf16(st[tA][0], st[tA][1]); pw.y = cvt_pk_bf16(st[tA][2], st[tA][3]); pw.z = cvt_pk_bf16(st[tB][0], st[tB][1]); pw.w = cvt_pk_bf16(st[tB][2], st[tB][3]);
                bf16x8 pf; __builtin_memcpy(&pf, &pw, 16);
#pragma unroll
                for (int dt = 0; dt < 8; ++dt) { const bf16x8 vf = tr_pair(vp[dt] + tA * 4096, vp[dt] + tB * 4096, true);
                    o[dt] = __builtin_amdgcn_mfma_f32_16x16x32_bf16(vf, pf, o[dt], 0, 0, 0); } }
            const float inv = __builtin_amdgcn_rcpf(den);
#pragma unroll
            for (int dt = 0; dt < 8; ++dt) { u32x2 w; w.x = cvt_pk_bf16(o[dt][0] * inv, o[dt][1] * inv); w.y = cvt_pk_bf16(o[dt][2] * inv, o[dt][3] * inv);
                *(u32x2*)(YM + (size_t)tq * 1280 + hm * 128 + 16 * dt + 4 * fq) = w; } }
        __syncthreads();
    }
}

__device__ __forceinline__ void phase_post(const int wv) {
    KParams& p = *kparams();
    const int gt = blockIdx.x * 512 + opaque_tid(wv), nthr = gridDim.x * 512; unsigned char* ws = p.ws;
    const float* Yraw = (const float*)(ws + OFF_YRAW); const bf16_t* C1 = (const bf16_t*)(ws + OFF_C1); const bf16_t* C2 = (const bf16_t*)(ws + OFF_C2); bf16_t* YR = (bf16_t*)(ws + OFF_YCAT);
    for (int idx = gt; idx < NTOK * 128; idx += nthr) { const int t = idx >> 7, c = ((idx >> 4) & 7) * 64 + 4 * (idx & 15);
        const f32x4 y = *(const f32x4*)(Yraw + (size_t)t * 512 + c);
        const float mean = red16(y[0] + y[1] + y[2] + y[3]) * (1.0f / 64.0f);
        const f32x4 d = y - mean; const float var = red16(d[0] * d[0] + d[1] * d[1] + d[2] * d[2] + d[3] * d[3]) * (1.0f / 64.0f);
        const float rs = rsqrtf(var + 64.0f * 1e-5f);
        float c1[4], c2[4]; unpack4(*(const u32x2*)(C1 + (size_t)t * 512 + c), c1); unpack4(*(const u32x2*)(C2 + (size_t)t * 512 + c), c2);
        u32x2 w; w.x = cvt_pk_bf16(d[0] * rs * c1[0] + c2[0], d[1] * rs * c1[1] + c2[1]); w.y = cvt_pk_bf16(d[2] * rs * c1[2] + c2[2], d[3] * rs * c1[3] + c2[3]);
        *(u32x2*)(YR + (size_t)t * 1280 + c) = w; }
    const float* DILO = (const float*)(ws + OFF_DILO); const float* LSE = (const float*)(ws + OFF_LSE); bf16_t* YD = (bf16_t*)(ws + OFF_YCAT) + 512;
    for (int idx = gt; idx < NTOK * 64; idx += nthr) { const int t = idx >> 6, hg = (idx >> 4) & 3, q = idx & 15;
        const float l0 = LSE[(size_t)t * 4 + hg], l1 = LSE[((size_t)NTOK + t) * 4 + hg], l2 = LSE[((size_t)2 * NTOK + t) * 4 + hg];
        const float m = fmaxf(l0, fmaxf(l1, l2)); const float e0 = __expf(l0 - m), e1 = __expf(l1 - m), e2 = __expf(l2 - m); const float inv = __builtin_amdgcn_rcpf(e0 + e1 + e2);
        const f32x4 o0 = *(const f32x4*)(DILO + ((size_t)t * 4 + hg) * 64 + 4 * q), o1 = *(const f32x4*)(DILO + (((size_t)NTOK + t) * 4 + hg) * 64 + 4 * q), o2 = *(const f32x4*)(DILO + (((size_t)2 * NTOK + t) * 4 + hg) * 64 + 4 * q);
        const f32x4 o = (o0 * e0 + o1 * e1 + o2 * e2) * inv;
        u32x2 w; w.x = cvt_pk_bf16(o[0], o[1]); w.y = cvt_pk_bf16(o[2], o[3]); *(u32x2*)(YD + (size_t)t * 1280 + hg * 64 + 4 * q) = w; }
}

__device__ __forceinline__ void phase_router(const int wv, LAS unsigned char* lds, const bool real = true) {
    KParams& p = *kparams();
    const int tid = opaque_tid(wv), wid = tid >> 6, lane = tid & 63, fr = lane & 15, fq = lane >> 4; unsigned char* ws = p.ws;
    const float* X1 = p.out; const float* ln2 = p.in[25]; const float* br = p.in[27]; const bf16_t* WRT = (const bf16_t*)(ws + OFF_WRT);
    unsigned char* XN2 = ws + OFF_XN2; int* TOPE = (int*)(ws + OFF_TOPE); float* TOPG = (float*)(ws + OFF_TOPG);
    LAS int* hist = (LAS int*)(lds + LX_HIST);
    LAS float* red = (LAS float*)lds;
    LAS float* part = (LAS float*)(lds + 1024);
    if (tid < 32) hist[tid] = 0;
    const int grp = wid >> 2, kq = wid & 3;
    f32x4 xq[2][16];
#pragma unroll
    for (int rd = 0; rd < 2; ++rd) { const float* xp = X1 + (size_t)((blockIdx.x * 4 + rd * 2 + grp) * 16 + fr) * 1024 + kq * 256 + 8 * fq;
#pragma unroll
        for (int s2 = 0; s2 < 8; ++s2) { xq[rd][2 * s2] = __builtin_nontemporal_load((const f32x4*)(xp + 32 * s2)); xq[rd][2 * s2 + 1] = __builtin_nontemporal_load((const f32x4*)(xp + 32 * s2 + 4)); } }
#pragma unroll
    for (int rd = 0; rd < 2; ++rd) { const int t0 = (blockIdx.x * 4 + rd * 2 + grp) * 16;
        f32x4 xa[8], xb[8]; float ss = 0.f;
#pragma unroll
        for (int s2 = 0; s2 < 8; ++s2) { xa[s2] = xq[rd][2 * s2]; xb[s2] = xq[rd][2 * s2 + 1]; }
#pragma unroll
        for (int s2 = 0; s2 < 8; ++s2) ss += xa[s2][0] * xa[s2][0] + xa[s2][1] * xa[s2][1] + xa[s2][2] * xa[s2][2] + xa[s2][3] * xa[s2][3] + xb[s2][0] * xb[s2][0] + xb[s2][1] * xb[s2][1] + xb[s2][2] * xb[s2][2] + xb[s2][3] * xb[s2][3];
        ss += sxor(ss, 16); ss += sxor(ss, 32);
        __syncthreads();
        if (fq == 0) red[(grp * 4 + kq) * 16 + fr] = ss;
        __syncthreads();
        const float tot = red[(grp * 4 + 0) * 16 + fr] + red[(grp * 4 + 1) * 16 + fr] + red[(grp * 4 + 2) * 16 + fr] + red[(grp * 4 + 3) * 16 + fr];
        const float rs = rsqrtf(tot * (1.0f / 1024.0f) + 1e-5f);
        f32x4 acc[2]; acc[0] = zero4f(); acc[1] = acc[0];
#pragma unroll
        for (int s2 = 0; s2 < 8; ++s2) { const int k = kq * 256 + 32 * s2 + 8 * fq;
            const f32x4 g0 = *(const f32x4*)(ln2 + k), g1 = *(const f32x4*)(ln2 + k + 4);
            float xn[8]; xn[0] = xa[s2][0] * rs * g0[0]; xn[1] = xa[s2][1] * rs * g0[1]; xn[2] = xa[s2][2] * rs * g0[2]; xn[3] = xa[s2][3] * rs * g0[3];
            xn[4] = xb[s2][0] * rs * g1[0]; xn[5] = xb[s2][1] * rs * g1[1]; xn[6] = xb[s2][2] * rs * g1[2]; xn[7] = xb[s2][3] * rs * g1[3];
            const u32x4 hi = pack8(xn); float hf[8]; unpack8(hi, hf);
#pragma unroll
            for (int j = 0; j < 8; ++j) hf[j] = xn[j] - hf[j];
            const u32x4 lo = pack8(hf);
            { u32x2 q8; q8.x = pack4_fp8(xn[0] * 8.0f, xn[1] * 8.0f, xn[2] * 8.0f, xn[3] * 8.0f); q8.y = pack4_fp8(xn[4] * 8.0f, xn[5] * 8.0f, xn[6] * 8.0f, xn[7] * 8.0f); if (real) *(u32x2*)(XN2 + (size_t)(t0 + fr) * 1024 + k) = q8; }
            bf16x8 xh, xl; __builtin_memcpy(&xh, &hi, 16); __builtin_memcpy(&xl, &lo, 16);
#pragma unroll
            for (int m = 0; m < 2; ++m) { const bf16x8 wh = *(const bf16x8*)(WRT + (size_t)(16 * m + fr) * 1024 + k), wl = *(const bf16x8*)(WRT + 32768 + (size_t)(16 * m + fr) * 1024 + k);
                acc[m] = MFMA16(wh, xh, acc[m]); acc[m] = MFMA16(wh, xl, acc[m]); acc[m] = MFMA16(wl, xh, acc[m]); } }
#pragma unroll
        for (int m = 0; m < 2; ++m)
#pragma unroll
            for (int j = 0; j < 4; ++j) part[((grp * 4 + kq) * 32 + 16 * m + 4 * fq + j) * 16 + fr] = acc[m][j];
        __syncthreads();
        if (kq == 0) { float lg[8]; int le[8];
#pragma unroll
            for (int m = 0; m < 2; ++m)
#pragma unroll
                for (int j = 0; j < 4; ++j) { const int e = 16 * m + 4 * fq + j; le[m * 4 + j] = e;
                    lg[m * 4 + j] = part[((grp * 4 + 0) * 32 + e) * 16 + fr] + part[((grp * 4 + 1) * 32 + e) * 16 + fr] + part[((grp * 4 + 2) * 32 + e) * 16 + fr] + part[((grp * 4 + 3) * 32 + e) * 16 + fr] + br[e]; }
            float tv[4]; int te[4];
#pragma unroll
            for (int r = 0; r < 4; ++r) { float bv = lg[0]; int bi = le[0];
#pragma unroll
                for (int q = 1; q < 8; ++q) if (lg[q] > bv) { bv = lg[q]; bi = le[q]; }
#pragma unroll
                for (int sft = 16; sft < 64; sft <<= 1) { const float ov = sxor(bv, sft); const int oi = sxor(bi, sft); if (ov > bv || (ov == bv && oi < bi)) { bv = ov; bi = oi; } }
                tv[r] = bv; te[r] = bi;
#pragma unroll
                for (int q = 0; q < 8; ++q) if (le[q] == bi) lg[q] = -3.0e38f; }
            const float e1 = __expf(tv[1] - tv[0]), e2 = __expf(tv[2] - tv[0]), e3 = __expf(tv[3] - tv[0]); const float inv = 1.0f / (1.0f + e1 + e2 + e3);
            if (fq == 0 && real) { const int t = t0 + fr; *(int4*)(TOPE + (size_t)t * 4) = make_int4(te[0], te[1], te[2], te[3]); *(f32x4*)(TOPG + (size_t)t * 4) = (f32x4){inv, e1 * inv, e2 * inv, e3 * inv};
                atomicAdd((int*)&hist[te[0]], 1); atomicAdd((int*)&hist[te[1]], 1); atomicAdd((int*)&hist[te[2]], 1); atomicAdd((int*)&hist[te[3]], 1); } }
    }
    __syncthreads();
    if (tid < 32 && real) { const int hcount = hist[tid]; if (hcount) atomicAdd((int*)(ws + OFF_CTL + CTL_CNT) + tid, hcount); }
}

__device__ __forceinline__ void build_tables(const int wv, LAS unsigned char* lds) {
    KParams& p = *kparams();
    LAS int* ts = (LAS int*)(lds + LX_TSTART); LAS int* sb = (LAS int*)(lds + LX_SBASE); LAS int* cn = (LAS int*)(lds + LX_CNT);
    if (wv == 0) { const int l = lane_id(); int* gc = (int*)(p.ws + OFF_CTL + CTL_CNT);
        const int c = (l < 32) ? (int)__hip_atomic_load(gc + l, __ATOMIC_RELAXED, __HIP_MEMORY_SCOPE_AGENT) : 0; const int tl = (c + 255) >> 8; int v = tl;
#pragma unroll
        for (int d = 1; d < 32; d <<= 1) { const int o = __builtin_amdgcn_ds_bpermute((l - d) << 2, v); if (l >= d) v += o; }
        if (l < 32) { cn[l] = c; sb[l] = (v - tl) * 256; ts[l + 1] = v; if (l == 0) ts[0] = 0; } }
    __syncthreads();
    { const int tid = (wv << 6) | lane_id(); LAS unsigned char* te = (LAS unsigned char*)(lds + LX_TEXP); const int nt = ts[32];
      if (tid < nt) { int e = 0; while (e < 31 && tid >= ts[e + 1]) ++e; te[tid] = (unsigned char)e; } }
    __syncthreads();
}

__device__ __forceinline__ void phase_dispatch(const int wv, LAS unsigned char* lds, const bool real = true) {
    KParams& p = *kparams();
    const int tid = opaque_tid(wv); unsigned char* ws = p.ws;
    build_tables(wv, lds);
    const LAS int* sb = (const LAS int*)(lds + LX_SBASE); const LAS int* cn = (const LAS int*)(lds + LX_CNT);
    LAS int* hist = (LAS int*)(lds + LX_HIST); LAS int* bbase = (LAS int*)(lds + LX_BBASE);
    const int* TOPE = (const int*)(ws + OFF_TOPE); int* SLOT = (int*)(ws + OFF_SLOT); int* STOK = (int*)(ws + OFF_STOK);
    for (int tb = blockIdx.x; tb < NTOK / 64; tb += gridDim.x) {
        if (tid < 32) hist[tid] = 0;
        __syncthreads();
        int e = 0, lr = 0;
        if (tid < 256) { e = TOPE[(size_t)tb * 256 + tid]; lr = atomicAdd((int*)&hist[e], 1); }
        __syncthreads();
        if (tid < 32) { const int hcount = hist[tid]; bbase[tid] = (hcount && real) ? atomicAdd((int*)(ws + OFF_CTL + CTL_CUR) + tid, hcount) : 0; }
        __syncthreads();
        if (tid < 256 && real) { const int sl = sb[e] + bbase[e] + lr; SLOT[(size_t)tb * 256 + tid] = sl; STOK[sl] = tb * 64 + (tid >> 2); }
        __syncthreads();
    }
    for (int e = blockIdx.x; e < 32; e += gridDim.x) { const int lo = sb[e] + cn[e], hi = sb[e] + ((cn[e] + 255) & ~255);
        for (int rrow = lo + tid; rrow < hi; rrow += 512) STOK[rrow] = 0; }
}

__device__ __forceinline__ void phase_combine(const int wv, const bool real = true) {
    KParams& p = *kparams();
    const int tid = opaque_tid(wv), wid = tid >> 6, lane = tid & 63; unsigned char* ws = p.ws;
    const int* SLOT = (const int*)(ws + OFF_SLOT); const float* TOPG = (const float*)(ws + OFF_TOPG); const bf16_t* YS = (const bf16_t*)(ws + OFF_YS); float* out = p.out;
    for (int t0 = (blockIdx.x * 8 + wid) * 8; t0 < NTOK; t0 += gridDim.x * 64) {
        int4 sl[8]; f32x4 gg[8];
#pragma unroll
        for (int i = 0; i < 8; ++i) { sl[i] = *(const int4*)(SLOT + (size_t)(t0 + i) * 4); gg[i] = *(const f32x4*)(TOPG + (size_t)(t0 + i) * 4); }
#pragma unroll
        for (int i = 0; i < 8; ++i) { const int t = t0 + i; const int s4[4] = {sl[i].x, sl[i].y, sl[i].z, sl[i].w};
#pragma unroll
            for (int hf = 0; hf < 2; ++hf) { const int c = hf * 512 + 8 * lane; float acc[8];
                const f32x4 x0 = __builtin_nontemporal_load((const f32x4*)(out + (size_t)t * 1024 + c)), x1 = __builtin_nontemporal_load((const f32x4*)(out + (size_t)t * 1024 + c + 4));
                u32x4 yv[4];
#pragma unroll
                for (int k = 0; k < 4; ++k) yv[k] = __builtin_nontemporal_load((const u32x4*)(YS + (size_t)s4[k] * 1024 + c));
                acc[0] = x0[0]; acc[1] = x0[1]; acc[2] = x0[2]; acc[3] = x0[3]; acc[4] = x1[0]; acc[5] = x1[1]; acc[6] = x1[2]; acc[7] = x1[3];
#pragma unroll
                for (int k = 0; k < 4; ++k) { float f[8]; unpack8(yv[k], f);
#pragma unroll
                    for (int j = 0; j < 8; ++j) acc[j] = fmaf(gg[i][k], f[j], acc[j]); }
                float* dst = real ? out : (float*)(ws + OFF_ACT);
                *(f32x4*)(dst + (size_t)t * 1024 + c) = (f32x4){acc[0], acc[1], acc[2], acc[3]}; *(f32x4*)(dst + (size_t)t * 1024 + c + 4) = (f32x4){acc[4], acc[5], acc[6], acc[7]}; }
            if (i & 1) asm volatile("" ::: "memory"); }
    }
}

__global__ void __launch_bounds__(512, 2) mk_fwd(Params p) {
    extern __shared__ __attribute__((aligned(16))) unsigned char lds_raw[];
    LAS unsigned char* lds = (LAS unsigned char*)lds_raw;
    unsigned char* ws = p.ws;
    const int wv = __builtin_amdgcn_readfirstlane((int)threadIdx.x >> 6);
    const bool multi = (p.ph_hi - p.ph_lo) > 1;
    XcdBarrier xb; xb.bar = (unsigned*)(ws + OFF_CTL); xb.x = 0; xb.st = (volatile LAS unsigned*)(lds + LDS_X);
    if (multi) {
        if (wv == 0 && lane_id() == 0) { *(LAS u32x4*)(lds + LDS_X) = zero4u(); }
        __syncthreads();
        xb = xcd_barrier_post((unsigned*)(ws + OFF_CTL), (volatile LAS unsigned*)(lds + LDS_X), wv);
    }
    for (int ph = p.ph_lo; ph < p.ph_hi; ++ph) {
      for (int rep = 0; rep < (((DBL_MASK >> ph) & 1) ? 2 : 1); ++rep) {
        KParams& q = *kparams(); unsigned char* ws = q.ws;
        switch (ph) {
        case 0: phase_prep(wv, lds); break;
        case 1: { { SchedZ S; S.H = (const char*)(ws + OFF_H); S.WinT = (const char*)(ws + OFF_WINT); S.HM = (const char*)(ws + OFF_HM); S.WmkvT = (const char*)(ws + OFF_WMKVT); S.G = gridDim.x; S.c = blockIdx.x;
                    EpiZ E; E.Z = (bf16_t*)(ws + OFF_Z); E.KV = (bf16_t*)(ws + OFF_KV); E.GFp = (bf16_t*)(ws + OFF_GF); E.pn0 = 0; E.scale = 1.0f; pg8::gemm_phase(wv, lds, 1024, S, E); }
                  { SchedZ8 S; S.H8 = (const char*)(ws + OFF_H8); S.WIN8 = (const char*)(ws + OFF_WIN8); S.G = gridDim.x; S.c = blockIdx.x;
                    EpiZ E; E.Z = (bf16_t*)(ws + OFF_Z); E.KV = (bf16_t*)(ws + OFF_KV); E.GFp = (bf16_t*)(ws + OFF_GF); E.pn0 = 7; E.scale = 1.0f / 256.0f; pg8::gemm_phase<EpiZ, SchedZ8, 1>(wv, lds, 1024, S, E); } } break;
        case 2: phase_elem_c(wv); break;
        case 3: { pg8::DenseOrder S; S.init(ws + OFF_ALORA, ws + OFF_LORAT, NTOK, 1536, 256); EpiLora E; E.L = (float*)(ws + OFF_L); E.w0 = q.in[5]; E.a0 = q.in[7]; pg8::gemm_phase(wv, lds, 256, S, E); } break;
        case 4: phase_chunk_pre(wv, lds); break;
        case 5: for (int r2 = 0; r2 < (((DBL_MASK >> 16) & 1) ? 2 : 1); ++r2) phase_scan_seq(wv, lds);
                for (int r2 = 0; r2 < (((DBL_MASK >> 17) & 1) ? 2 : 1); ++r2) phase_dil_attn(wv, lds);
                for (int r2 = 0; r2 < (((DBL_MASK >> 18) & 1) ? 2 : 1); ++r2) phase_mem_attn(wv, lds); break;
        case 6: phase_post(wv); break;
        case 7: { pg8::DenseOrder S; S.init(ws + OFF_YCAT, ws + OFF_PCAT, NTOK, 1024, 1280); EpiMixCat E; E.mixbf = (bf16_t*)(ws + OFF_MIXBF); E.GF = (const bf16_t*)(ws + OFF_GF); E.tid = (wv << 6) | lane_id(); pg8::gemm_phase(wv, lds, 1280, S, E); } break;
        case 8: { pg8::DenseOrder S; S.init(ws + OFF_MIXBF, ws + OFF_WOT, NTOK, 1024, 1024); EpiX1 E; E.x = q.in[0]; E.out = q.out; pg8::gemm_phase(wv, lds, 1024, S, E); } break;
        case 9: phase_router(wv, lds, rep + 1 == (((DBL_MASK >> ph) & 1) ? 2 : 1)); break;
        case 10: phase_dispatch(wv, lds, rep + 1 == (((DBL_MASK >> ph) & 1) ? 2 : 1)); break;
        case 11: { build_tables(wv, lds); SchedMoe<true> S; S.A = (const char*)(ws + OFF_XN2); S.Bt = (const char*)(ws + OFF_W1T); S.tstart = (const LAS int*)(lds + LX_TSTART); S.stok = (const int*)(ws + OFF_STOK); S.lgN = 3; S.total = S.tstart[32] * 8; S.estride = (size_t)2048 * 1024; S.tbytes = (size_t)256 * 1024;
                   EpiSwiglu E; E.act = ws + OFF_ACT; E.b1 = q.in[29]; pg8::gemm_phase<EpiSwiglu, SchedMoe<true>, 1>(wv, lds, 1024, S, E); } break;
        case 12: { build_tables(wv, lds); SchedMoe<false> S; S.A = (const char*)(ws + OFF_ACT); S.Bt = (const char*)(ws + OFF_W2T); S.tstart = (const LAS int*)(lds + LX_TSTART); S.stok = nullptr; S.lgN = 2; S.total = S.tstart[32] * 4; S.estride = (size_t)1024 * 1024; S.tbytes = (size_t)256 * 1024;
                   EpiYs E; E.ys = (bf16_t*)(ws + OFF_YS); E.b2 = q.in[31]; pg8::gemm_phase<EpiYs, SchedMoe<false>, 1>(wv, lds, 1024, S, E); } break;
        case 13: phase_combine(wv, rep + 1 == (((DBL_MASK >> ph) & 1) ? 2 : 1)); break;
        default: break;
        }
      }
        if (ph + 1 < p.ph_hi) xcd_barrier(xb, wv);
        if (((DBL_MASK >> 20) & 1) && ph == 3 && multi) for (int e = 0; e < 10; ++e) xcd_barrier(xb, wv);
    }
}

extern "C" void kernel_launch(void* const* d_in, const int* in_sizes, int n_in, void* d_out, int out_size, void* d_ws, size_t ws_size, hipStream_t stream) {
    static int ready = 0;
    if (ready == 0) {
        if (n_in != 32 || out_size != NTOK * 1024 || ws_size < WS_NEED) { fprintf(stderr, "kernel_launch: unexpected shapes (n_in %d, out %d, ws %zu < %zu)\n", n_in, out_size, ws_size, (size_t)WS_NEED); ready = -1; return; }
        if (hipFuncSetAttribute((const void*)mk_fwd, hipFuncAttributeMaxDynamicSharedMemorySize, LDS_BYTES) != hipSuccess) { fprintf(stderr, "kernel_launch: hipFuncSetAttribute failed\n"); ready = -1; return; }
        int per_cu = 0, dev = 0, cus = 0; hipGetDevice(&dev); hipDeviceGetAttribute(&cus, hipDeviceAttributeMultiprocessorCount, dev);
        hipOccupancyMaxActiveBlocksPerMultiprocessor(&per_cu, (const void*)mk_fwd, 512, LDS_BYTES);
        if (per_cu < 1 || cus < 256) { fprintf(stderr, "kernel_launch: occupancy %d blocks/CU on %d CUs; need >= 1 on 256\n", per_cu, cus); ready = -1; (void)hipGetLastError(); return; }
        ready = 1;
    }
    if (ready < 0) return;
    hipMemsetAsync((char*)d_ws + OFF_CTL, 0, CTL_BYTES, stream);
    Params p{};
    for (int i = 0; i < 32; ++i) p.in[i] = (const float*)d_in[i];
    p.out = (float*)d_out; p.ws = (unsigned char*)d_ws;
#if MK_N_LAUNCH_PER_PHASE
    for (int ph = 0; ph < NPHASE; ++ph) { p.ph_lo = ph; p.ph_hi = ph + 1; hipLaunchKernelGGL(mk_fwd, dim3(256), dim3(512), LDS_BYTES, stream, p); }
#else
    p.ph_lo = 0; p.ph_hi = NPHASE;
    void* args[] = {&p};
    hipError_t e = hipLaunchCooperativeKernel((const void*)mk_fwd, dim3(256), dim3(512), args, LDS_BYTES, stream);
    if (e != hipSuccess) fprintf(stderr, "cooperative launch failed: %s\n", hipGetErrorString(e));
#endif
}
```

```cpp
#include <hip/hip_runtime.h>
#include <cstdio>
#include <cstdint>

#define LAS __attribute__((address_space(3)))
typedef unsigned short bf16_t;
typedef short bf16x8 __attribute__((ext_vector_type(8)));
typedef short s16x4 __attribute__((ext_vector_type(4)));
typedef float f32x4 __attribute__((ext_vector_type(4)));
typedef float f32x2 __attribute__((ext_vector_type(2)));
typedef unsigned u32x4 __attribute__((ext_vector_type(4)));
typedef unsigned u32x2 __attribute__((ext_vector_type(2)));
typedef int i32x8 __attribute__((ext_vector_type(8)));
typedef int i32x4 __attribute__((ext_vector_type(4)));

#ifndef DBL_MASK
#define DBL_MASK 0
#endif
#ifndef MK_N_LAUNCH_PER_PHASE
#define MK_N_LAUNCH_PER_PHASE 0
#endif

constexpr int NTOK = 16384, SEQ = 2048, INC = 7680;
constexpr int C_K = 512, C_V = 1024, C_ZW = 1536, C_DQ = 1792, C_DK = 2560, C_DV = 3328, C_MQ = 4096, C_GATE = 4608;
constexpr int NPHASE = 14;
constexpr int NSLOT_MAX = 65536 + 32 * 256;

constexpr size_t MiB = 1ull << 20;
constexpr size_t OFF_CTL = 0;
constexpr size_t CTL_BYTES = 32768;
constexpr size_t CTL_CNT = 16384;
constexpr size_t CTL_CUR = 16384 + 256;
constexpr size_t OFF_TOPE = 1 * MiB;
constexpr size_t OFF_TOPG = 1 * MiB + 262144;
constexpr size_t OFF_SLOT = 1 * MiB + 524288;
constexpr size_t OFF_STOK = 2 * MiB;
constexpr size_t OFF_WRT = 3 * MiB;
constexpr size_t OFF_WINT = 4 * MiB, OFF_WMKVT = 19 * MiB, OFF_LORAT = 21 * MiB, OFF_PRT = 22 * MiB, OFF_PDT = 23 * MiB, OFF_PMT = 24 * MiB, OFF_WOT = 25 * MiB;
constexpr size_t OFF_WIN8 = 8 * MiB;
constexpr size_t OFF_H8 = 539 * MiB;
constexpr size_t OFF_YCAT = 223 * MiB;
constexpr size_t OFF_PCAT = 22 * MiB;
constexpr size_t OFF_W1T = 27 * MiB, OFF_W2T = 155 * MiB, OFF_KV = 219 * MiB, OFF_YM = 223 * MiB, OFF_YR = 239 * MiB, OFF_YD = 255 * MiB, OFF_Z = 263 * MiB;
constexpr size_t OFF_H = 503 * MiB, OFF_HM = 535 * MiB, OFF_ALORA = 503 * MiB, OFF_L = 511 * MiB, OFF_REC = 607 * MiB;
constexpr size_t OFF_GF = OFF_REC;
constexpr size_t OFF_LW = OFF_REC + 64 * MiB;
constexpr size_t OFF_VB = OFF_REC + 96 * MiB;
constexpr size_t OFF_GTF = OFF_REC + 112 * MiB;
constexpr size_t OFF_RTF = OFF_REC + 144 * MiB;
constexpr size_t OFF_HHF = OFF_REC + 160 * MiB;
constexpr size_t OFF_YLF = OFF_REC + 192 * MiB;
constexpr size_t OFF_C1 = 816 * MiB, OFF_C2 = 832 * MiB, OFF_YRAW = 848 * MiB, OFF_DILO = 880 * MiB, OFF_LSE = 928 * MiB;
constexpr size_t OFF_MIX32 = 503 * MiB, OFF_MIXBF = 567 * MiB, OFF_XN2 = 503 * MiB, OFF_XS = 263 * MiB, OFF_ACT = 607 * MiB, OFF_YS = 407 * MiB;
constexpr size_t WS_NEED = 929 * MiB;

constexpr int LDS_BYTES = 160 * 1024;
constexpr int LDS_X = LDS_BYTES - 4096;
constexpr int LX_TSTART = LDS_X + 64;
constexpr int LX_SBASE = LDS_X + 256;
constexpr int LX_CNT = LDS_X + 512;
constexpr int LX_HIST = LDS_X + 768;
constexpr int LX_BBASE = LDS_X + 1024;
constexpr int LX_SLOTL = LDS_X + 2048;
constexpr int LX_TEXP = LDS_X + 3072;

struct Params { const float* in[32]; float* out; unsigned char* ws; int ph_lo, ph_hi; };
typedef const Params __attribute__((address_space(4))) KParams;
__device__ __forceinline__ KParams* kparams() { KParams* kp = (KParams*)__builtin_amdgcn_kernarg_segment_ptr(); asm volatile("" : "+s"(kp)); return kp; }

typedef __bf16 bf16x2_t __attribute__((ext_vector_type(2)));
__device__ __forceinline__ unsigned cvt_pk_bf16(float lo, float hi) { f32x2 v = {lo, hi}; bf16x2_t b = __builtin_convertvector(v, bf16x2_t); unsigned r; __builtin_memcpy(&r, &b, 4); return r; }
__device__ __forceinline__ unsigned pack4_fp8(float a, float b, float c, float d) { int r = __builtin_amdgcn_cvt_pk_fp8_f32(a, b, 0, false); r = __builtin_amdgcn_cvt_pk_fp8_f32(c, d, r, true); return (unsigned)r; }
__device__ __forceinline__ float bf_lo(unsigned u) { return __uint_as_float(u << 16); }
__device__ __forceinline__ float bf_hi(unsigned u) { return __uint_as_float(u & 0xffff0000u); }
__device__ __forceinline__ int lane_id() { int l; asm volatile("v_mbcnt_lo_u32_b32 %0, -1, 0\n\tv_mbcnt_hi_u32_b32 %0, -1, %0" : "=v"(l)); return l; }
__device__ __forceinline__ int sxor(int x, int m) { return __builtin_amdgcn_ds_bpermute((lane_id() ^ m) << 2, x); }
__device__ __forceinline__ float sxor(float x, int m) { return __int_as_float(__builtin_amdgcn_ds_bpermute((lane_id() ^ m) << 2, __float_as_int(x))); }
template <int CTRL> __device__ __forceinline__ float dpp_f(float x) { return __int_as_float(__builtin_amdgcn_update_dpp(0, __float_as_int(x), CTRL, 0xF, 0xF, true)); }
__device__ __forceinline__ float red4(float x) { x += dpp_f<0xB1>(x); x += dpp_f<0x4E>(x); return x; }
__device__ __forceinline__ float red8(float x) { x = red4(x); x += dpp_f<0x141>(x); return x; }
__device__ __forceinline__ float red16(float x) { x = red8(x); x += dpp_f<0x140>(x); return x; }
__device__ __forceinline__ float red64(float x) { x = red16(x); x += sxor(x, 16); x += sxor(x, 32); return x; }
__device__ __forceinline__ int opaque_tid(const int wv) { int t = (wv << 6) | lane_id(); asm volatile("" : "+v"(t)); return t; }
__device__ __forceinline__ f32x4 zero4f() { float z = 0.f; asm volatile("" : "+v"(z)); return (f32x4){z, z, z, z}; }
__device__ __forceinline__ u32x4 zero4u() { unsigned z = 0u; asm volatile("" : "+v"(z)); return (u32x4){z, z, z, z}; }
__device__ __forceinline__ float sigmoidf_(float x) { return __builtin_amdgcn_rcpf(1.0f + __builtin_amdgcn_exp2f(-1.44269504f * x)); }
__device__ __forceinline__ void unpack8(const u32x4 v, float (&f)[8]) { f[0] = bf_lo(v.x); f[1] = bf_hi(v.x); f[2] = bf_lo(v.y); f[3] = bf_hi(v.y); f[4] = bf_lo(v.z); f[5] = bf_hi(v.z); f[6] = bf_lo(v.w); f[7] = bf_hi(v.w); }
__device__ __forceinline__ u32x4 pack8(const float (&f)[8]) { u32x4 w; w.x = cvt_pk_bf16(f[0], f[1]); w.y = cvt_pk_bf16(f[2], f[3]); w.z = cvt_pk_bf16(f[4], f[5]); w.w = cvt_pk_bf16(f[6], f[7]); return w; }
__device__ __forceinline__ float sumsq8(const u32x4 v) { float f[8]; unpack8(v, f); float s = 0.f;
#pragma unroll
    for (int j = 0; j < 8; ++j) s += f[j] * f[j];
    return s; }
__device__ __forceinline__ u32x4 scale8(const u32x4 v, const float rs, const float* w) { float f[8]; unpack8(v, f); const f32x4 w0 = *(const f32x4*)w, w1 = *(const f32x4*)(w + 4);
    f[0] *= rs * w0[0]; f[1] *= rs * w0[1]; f[2] *= rs * w0[2]; f[3] *= rs * w0[3]; f[4] *= rs * w1[0]; f[5] *= rs * w1[1]; f[6] *= rs * w1[2]; f[7] *= rs * w1[3]; return pack8(f); }
__device__ __forceinline__ u32x4 scale8r(const u32x4 v, const float rs, const float (&w)[8]) { float f[8]; unpack8(v, f);
#pragma unroll
    for (int j = 0; j < 8; ++j) f[j] *= rs * w[j];
    return pack8(f); }
__device__ __forceinline__ u32x4 scale8s(const u32x4 v, const float rs) { float f[8]; unpack8(v, f);
#pragma unroll
    for (int j = 0; j < 8; ++j) f[j] *= rs;
    return pack8(f); }
__device__ __forceinline__ void unpack4(const u32x2 v, float (&f)[4]) { f[0] = bf_lo(v.x); f[1] = bf_hi(v.x); f[2] = bf_lo(v.y); f[3] = bf_hi(v.y); }

#define XB_TMO      128
#define XB_XCNT(j)  (256  + 64 * (j))
#define XB_XSUB(j)  (1280 + 64 * (j))
#define XB_XGEN(j)  (2304 + 64 * (j))
#define XB_TOP      3328
#define XB_TOPGEN   3392
#define XCD_BAR_WORDS 3456
#define XB_SPIN_CAP (1u << 22)
__device__ __forceinline__ unsigned xb_ld(unsigned* p)              { return __hip_atomic_load(p, __ATOMIC_RELAXED, __HIP_MEMORY_SCOPE_AGENT); }
__device__ __forceinline__ unsigned xb_add(unsigned* p, unsigned v) { return __hip_atomic_fetch_add(p, v, __ATOMIC_RELAXED, __HIP_MEMORY_SCOPE_AGENT); }
__device__ __forceinline__ unsigned xb_xcc_id() { return (unsigned)__builtin_amdgcn_s_getreg((3 << 11) | 20) & 0xFu; }
#define XB_SPIN(cond, bar) do { unsigned _sp = 0; while (cond) { __builtin_amdgcn_s_sleep(1); \
    if ((++_sp & 255u) == 0u) { if (xb_ld(&(bar)[XB_TMO])) break; if (_sp > XB_SPIN_CAP) { atomicAdd(&(bar)[XB_TMO], 1u); break; } } } } while (0)
struct XcdBarrier { unsigned* bar; unsigned x; volatile LAS unsigned* st; };
__device__ __forceinline__ XcdBarrier xcd_barrier_post(unsigned* bar, volatile LAS unsigned* st, const int wv) {
    XcdBarrier b; b.bar = bar; b.x = xb_xcc_id(); b.st = st;
    if (wv == 0 && lane_id() == 0) (void)xb_add(&bar[XB_XCNT(b.x)], 1u);
    return b;
}
__device__ __forceinline__ void xcd_barrier_complete(unsigned* bar, unsigned x, unsigned& nloc, unsigned& nx) {
    const unsigned G = gridDim.x * gridDim.y * gridDim.z;
    unsigned sum, cnt, mine, sp = 0u;
    for (;;) {
        sum = 0u; cnt = 0u; mine = 0u;
#pragma unroll
        for (unsigned j = 0; j < 16; ++j) { const unsigned c = xb_ld(&bar[XB_XCNT(j)]); sum += c; cnt += (c > 0u) ? 1u : 0u; mine = (j == x) ? c : mine; }
        if (sum == G) break;
        __builtin_amdgcn_s_sleep(1);
        if ((++sp & 255u) == 0u) { if (xb_ld(&bar[XB_TMO])) break; if (sp > XB_SPIN_CAP) { atomicAdd(&bar[XB_TMO], 1u); break; } }
    }
    nloc = mine > 0u ? mine : 1u; nx = cnt > 0u ? cnt : 1u;
}
__device__ __forceinline__ void xcd_barrier(const XcdBarrier& b, const int wv) {
    asm volatile("s_waitcnt vmcnt(0)" ::: "memory");
    __syncthreads();
    if (wv == 0 && lane_id() == 0) {
        unsigned* bar = b.bar;
        __builtin_amdgcn_s_waitcnt(0);
        unsigned nloc = b.st[0], nx = b.st[1];
        if (nloc == 0u) { xcd_barrier_complete(bar, b.x, nloc, nx); b.st[0] = nloc; b.st[1] = nx; }
        const unsigned old = xb_add(&bar[XB_XSUB(b.x)], 1u);
        const unsigned gen = old / nloc;
        if (old + 1u == (gen + 1u) * nloc) {
            __builtin_amdgcn_fence(__ATOMIC_RELEASE, "agent");
            asm volatile("s_waitcnt vmcnt(0)" ::: "memory");
            const unsigned og = xb_add(&bar[XB_TOP], 1u);
            const unsigned tg = og / nx;
            if (og + 1u == (tg + 1u) * nx) xb_add(&bar[XB_TOPGEN], 1u);
            else XB_SPIN(xb_ld(&bar[XB_TOPGEN]) == tg, bar);
            __builtin_amdgcn_fence(__ATOMIC_ACQUIRE, "agent");
            xb_add(&bar[XB_XGEN(b.x)], 1u);
            asm volatile("s_waitcnt vmcnt(0)" ::: "memory");
        } else {
            XB_SPIN(xb_ld(&bar[XB_XGEN(b.x)]) == gen, bar);
            __builtin_amdgcn_fence(__ATOMIC_ACQUIRE, "agent");
            asm volatile("s_waitcnt vmcnt(0)" ::: "memory");
        }
    }
    __syncthreads();
}

namespace pg8 {
constexpr int BM = 256, BK = 64, HALF = 128, HTB = HALF * BK * 2, STAGE_BYTES = 8 * HTB, NXCD = 8, WGM = 8;
__host__ __device__ __forceinline__ int lds_byte(int r, int c) { const int st = (r >> 4) * 2 + (c >> 5), rr = r & 15, cc = c & 31, ob = rr * 64 + cc * 2; return st * 1024 + (ob ^ (((ob >> 9) & 1) << 5)); }
__host__ __device__ __forceinline__ void stage_rc(int b, int& R, int& C) { const int st = b / 1024, sb = b % 1024, swz = sb ^ (((sb >> 9) & 1) << 5); R = (st >> 1) * 16 + swz / 64; C = (st & 1) * 32 + (swz % 64) / 2; }
__host__ __device__ __forceinline__ int perm32(int rho) { const int n = rho >> 4, i = rho & 15; return 8 * (i >> 2) + 4 * n + (i & 3); }
struct Unit { int pm, pn, tag; const char* pa; const char* pb; };

__device__ __forceinline__ void static_map(long L, int nM, int nN, int& pm, int& pn) {
    const int nwg = nM * nN; int wgid = (int)L;
    { const int q = nwg / NXCD, r = nwg % NXCD, xcd = wgid % NXCD, off = wgid / NXCD; wgid = (xcd < r ? xcd * (q + 1) : r * (q + 1) + (xcd - r) * q) + off; }
    const int nig = WGM * nN, gid = wgid / nig, fm = gid * WGM, gsz = (nM - fm) < WGM ? (nM - fm) : WGM;
    pm = fm + ((wgid % nig) % gsz); pn = (wgid % nig) / gsz;
}
struct DenseOrder {
    static constexpr bool GATHER = false; __device__ __forceinline__ unsigned a_off(const Unit&, int, int, int, int) const { return 0u; }
    const char* A; const char* Bt; int nM, nN, G, c; size_t tstep;
    __device__ __forceinline__ void init(const void* A_, const void* Bt_, int M, int N, int K) { A = (const char*)A_; Bt = (const char*)Bt_; nM = M / BM; nN = N / BM; G = gridDim.x; c = blockIdx.x; tstep = (size_t)BM * K * 2; }
    __device__ __forceinline__ bool next(int i, Unit& u) const {
        const long L = (long)i * G + c; if (L >= (long)nM * nN) return false;
        static_map(L, nM, nN, u.pm, u.pn); u.tag = 0; u.pa = A + (size_t)u.pm * tstep; u.pb = Bt + (size_t)u.pn * tstep; return true;
    }
};

template <int H> __device__ __forceinline__ bf16x8 half8(const i32x8 v) { const i32x4 x = H ? __builtin_shufflevector(v, v, 4, 5, 6, 7) : __builtin_shufflevector(v, v, 0, 1, 2, 3); bf16x8 r; __builtin_memcpy(&r, &x, 16); return r; }
template <class Epi, class Sched, int ES = 2>
__device__ __forceinline__ void gemm_phase(const int wv, LAS unsigned char* lds, const int K, const Sched& S, const Epi& E) {
    int tid_ = (wv << 6) | lane_id(); asm volatile("" : "+v"(tid_));
    const int tid = tid_, wid = __builtin_amdgcn_readfirstlane(tid >> 6), lane = tid & 63, wr = wid >> 2, wc = wid & 3, fr = lane & 15, fq = lane >> 4;
    const int nt = K * ES / (BK * 2);
    unsigned voffA[2], voffB[2]; int RA[2], CA[2];
#pragma unroll
    for (int i = 0; i < 2; ++i) { int R, C; stage_rc(tid * 16 + i * 8192, R, C); const int Rb = Epi::PERM ? ((R & ~31) + perm32(R & 31)) : R; RA[i] = R; CA[i] = C;
        voffA[i] = (unsigned)(R * K * ES + C * 2); voffB[i] = (unsigned)(Rb * K * ES + C * 2); }
    unsigned vA[2][2][2];
    const size_t kstep = (size_t)(BK * 2);
    const size_t hstep = (size_t)HALF * K * ES;
    const unsigned ldsw = (unsigned)wid * 1024u;
    const int aoff = lds_byte(wr * 64 + fr, fq * 8), boff = lds_byte(wc * 32 + fr, fq * 8);
#define PG8_SA(b, h) (((b) * 2 + (h)) * HTB)
#define PG8_SB(b, h) ((4 + (b) * 2 + (h)) * HTB)
#define PG8_STAGE(bufoff, gbase, voff) do { _Pragma("unroll") for (int _i = 0; _i < 2; ++_i) \
        __builtin_amdgcn_global_load_lds((const unsigned*)((const char*)(gbase) + (voff)[_i]), (LAS unsigned*)(lds + (bufoff) + ldsw + _i * 8192), 16, 0, 0); } while (0)
#define PG8_LDA(dst, b, h) do { _Pragma("unroll") for (int m = 0; m < 4; ++m) { const i32x4 _lo = *(const LAS i32x4*)(lds + PG8_SA(b, h) + aoff + m * 2048), _hi = *(const LAS i32x4*)(lds + PG8_SA(b, h) + aoff + m * 2048 + 1024); dst[m] = __builtin_shufflevector(_lo, _hi, 0, 1, 2, 3, 4, 5, 6, 7); } } while (0)
#define PG8_LDB(dst, b, h) do { _Pragma("unroll") for (int n = 0; n < 2; ++n) { const i32x4 _lo = *(const LAS i32x4*)(lds + PG8_SB(b, h) + boff + n * 2048), _hi = *(const LAS i32x4*)(lds + PG8_SB(b, h) + boff + n * 2048 + 1024); dst[n] = __builtin_shufflevector(_lo, _hi, 0, 1, 2, 3, 4, 5, 6, 7); } } while (0)
#define PG8_MMA(ai, bj, At, Bt) do { __builtin_amdgcn_s_setprio(1); _Pragma("unroll") for (int m = 0; m < 4; ++m) _Pragma("unroll") for (int n = 0; n < 2; ++n) { \
        if (ES == 2) { acc[ai][bj][m][n] = __builtin_amdgcn_mfma_f32_16x16x32_bf16(half8<0>(Bt[n]), half8<0>(At[m]), acc[ai][bj][m][n], 0, 0, 0); \
                       acc[ai][bj][m][n] = __builtin_amdgcn_mfma_f32_16x16x32_bf16(half8<1>(Bt[n]), half8<1>(At[m]), acc[ai][bj][m][n], 0, 0, 0); } \
        else asm volatile("v_mfma_scale_f32_16x16x128_f8f6f4 %0, %1, %2, %0, %3, %3 op_sel_hi:[0,0,0]" : "+v"(acc[ai][bj][m][n]) : "v"(Bt[n]), "v"(At[m]), "v"(one_scale)); } \
        __builtin_amdgcn_s_setprio(0); } while (0)
#define PG8_WAIT_V(n) asm volatile("s_waitcnt vmcnt(" #n ")" ::: "memory")
#define PG8_WAIT_L(n) asm volatile("s_waitcnt lgkmcnt(" #n ")" ::: "memory")
#define PG8_BAR __builtin_amdgcn_s_barrier()
#define PG8_SCHED __builtin_amdgcn_sched_barrier(0)
    Unit cur, nxt; int ui = 0;
    if (!S.next(0, cur)) return;
    f32x4 acc[2][2][4][2]; const f32x4 zz0 = zero4f();
#pragma unroll
    for (int a = 0; a < 2; ++a)
#pragma unroll
        for (int b = 0; b < 2; ++b)
#pragma unroll
            for (int m = 0; m < 4; ++m)
#pragma unroll
                for (int n = 0; n < 2; ++n) acc[a][b][m][n] = zz0;
    i32x8 At[4], B0[2], B1[2];
    const int one_scale = 0x7f7f7f7f;
    const char* cA = cur.pa; const char* cB = cur.pb;
#pragma unroll
    for (int h = 0; h < 2; ++h)
#pragma unroll
        for (int i = 0; i < 2; ++i) vA[0][h][i] = Sched::GATHER ? S.a_off(cur, h, RA[i], CA[i], K * ES) : voffA[i] + (unsigned)(h * hstep);
    PG8_STAGE(PG8_SB(0, 0), cB, voffB); PG8_STAGE(PG8_SA(0, 0), cA, vA[0][0]); PG8_STAGE(PG8_SB(0, 1), cB + hstep, voffB); PG8_STAGE(PG8_SA(0, 1), cA, vA[0][1]);
    if (wr == 1) PG8_BAR;
    PG8_WAIT_V(4); PG8_BAR;
    PG8_STAGE(PG8_SB(1, 0), cB + kstep, voffB); PG8_STAGE(PG8_SA(1, 0), cA + kstep, vA[0][0]); PG8_STAGE(PG8_SB(1, 1), cB + hstep + kstep, voffB);
    PG8_WAIT_V(6); PG8_BAR;
    for (;;) {
        const bool has_next = S.next(ui + 1, nxt);
        const char* nA = has_next ? nxt.pa : cA; const char* nB = has_next ? nxt.pb : cB;
#pragma unroll
        for (int h = 0; h < 2; ++h)
#pragma unroll
            for (int i = 0; i < 2; ++i) vA[1][h][i] = has_next ? (Sched::GATHER ? S.a_off(nxt, h, RA[i], CA[i], K * ES) : voffA[i] + (unsigned)(h * hstep)) : vA[0][h][i];
#pragma clang loop unroll(disable)
        for (int t = 0; t < nt; t += 2) {
            if constexpr (Epi::MID) { if (t == 8 || t == 12) E.mid(acc, cur, t, wr, wc, fr, fq); }
            const bool last = (t == nt - 2);
            const char* a1 = cA + (size_t)(t + 1) * kstep;
            const char* a2 = last ? nA : cA + (size_t)(t + 2) * kstep; const char* b2 = last ? nB : cB + (size_t)(t + 2) * kstep;
            const char* a3 = a2 + kstep; const char* b3 = b2 + kstep;
            unsigned w0[2], w1[2];
#pragma unroll
            for (int i = 0; i < 2; ++i) { w0[i] = vA[0][0][i]; w1[i] = vA[0][1][i]; }
            if (last) { asm volatile("" ::: "memory");
#pragma unroll
                for (int i = 0; i < 2; ++i) { w0[i] = vA[1][0][i]; w1[i] = vA[1][1][i]; } }
            PG8_LDB(B0, 0, 0); PG8_SCHED; PG8_LDA(At, 0, 0); PG8_STAGE(PG8_SA(1, 1), a1, vA[0][1]);
            PG8_WAIT_L(8); PG8_BAR; PG8_WAIT_L(0); PG8_MMA(0, 0, At, B0); PG8_BAR; PG8_SCHED;
            PG8_LDB(B1, 0, 1); PG8_STAGE(PG8_SB(0, 0), b2, voffB);
            PG8_BAR; PG8_WAIT_L(0); PG8_MMA(0, 1, At, B1); PG8_BAR;
            PG8_LDA(At, 0, 1); PG8_STAGE(PG8_SA(0, 0), a2, w0);
            PG8_BAR; PG8_WAIT_L(0); PG8_MMA(1, 0, At, B0); PG8_BAR; PG8_SCHED;
            PG8_STAGE(PG8_SB(0, 1), b2 + hstep, voffB);
            PG8_WAIT_V(6); PG8_BAR; PG8_MMA(1, 1, At, B1); PG8_BAR;
            PG8_LDB(B0, 1, 0); PG8_SCHED; PG8_LDA(At, 1, 0); PG8_STAGE(PG8_SA(0, 1), a2, w1);
            PG8_WAIT_L(8); PG8_BAR; PG8_WAIT_L(0); PG8_MMA(0, 0, At, B0); PG8_BAR; PG8_SCHED;
            PG8_LDB(B1, 1, 1); PG8_STAGE(PG8_SB(1, 0), b3, voffB);
            PG8_BAR; PG8_WAIT_L(0); PG8_MMA(0, 1, At, B1); PG8_BAR;
            PG8_LDA(At, 1, 1); PG8_STAGE(PG8_SA(1, 0), a3, w0);
            PG8_BAR; PG8_WAIT_L(0); PG8_MMA(1, 0, At, B0); PG8_BAR; PG8_SCHED;
            PG8_STAGE(PG8_SB(1, 1), b3 + hstep, voffB);
            PG8_WAIT_V(6); PG8_BAR; PG8_MMA(1, 1, At, B1); PG8_BAR;
        }
        if (ES == 1) asm volatile("s_nop 15\n\ts_nop 15" ::: "memory");
        E(acc, cur, wr, wc, fr, fq);
        if (!has_next) break;
        const f32x4 zz1 = zero4f();
#pragma unroll
        for (int a = 0; a < 2; ++a)
#pragma unroll
            for (int b = 0; b < 2; ++b)
#pragma unroll
                for (int m = 0; m < 4; ++m)
#pragma unroll
                    for (int n = 0; n < 2; ++n) acc[a][b][m][n] = zz1;
        cur = nxt; cA = nA; cB = nB; ++ui;
#pragma unroll
        for (int h = 0; h < 2; ++h)
#pragma unroll
            for (int i = 0; i < 2; ++i) vA[0][h][i] = vA[1][h][i];
    }
    PG8_WAIT_V(0);
    if (wr == 0) PG8_BAR;
    PG8_BAR;
#undef PG8_SA
#undef PG8_SB
#undef PG8_STAGE
#undef PG8_LDA
#undef PG8_LDB
#undef PG8_MMA
#undef PG8_WAIT_V
#undef PG8_WAIT_L
#undef PG8_BAR
#undef PG8_SCHED
}
}
using pg8::Unit;

struct EpiZ {
    static constexpr bool PERM = true, MID = false;
    bf16_t* Z; bf16_t* KV; bf16_t* GFp; int pn0; float scale;
    __device__ __forceinline__ void operator()(const f32x4 (&acc)[2][2][4][2], const Unit& u, int wr, int wc, int fr, int fq) const {
        const bool kvu = u.pn >= 32; const int pn = (u.pn & 31) + (kvu ? 0 : pn0);
        bf16_t* base = kvu ? KV : Z; const int ldc = kvu ? 1024 : INC; const bool sg = (!kvu) && (pn >= C_GATE / 256);
        if (sg) {
            bf16_t* gf = GFp + ((size_t)(u.pm * 12 + (pn - C_GATE / 256)) * 16) * 4096 + (size_t)((wr * 4 + wc) * 64 + fq * 16 + fr) * 8;
#pragma unroll
            for (int ai = 0; ai < 2; ++ai)
#pragma unroll
                for (int m = 0; m < 4; ++m)
#pragma unroll
                    for (int bj = 0; bj < 2; ++bj) { f32x4 v0 = acc[ai][bj][m][0] * scale, v1 = acc[ai][bj][m][1] * scale;
#pragma unroll
                        for (int j = 0; j < 4; ++j) { v0[j] = sigmoidf_(v0[j]); v1[j] = sigmoidf_(v1[j]); }
                        u32x4 w; w.x = cvt_pk_bf16(v0[0], v0[1]); w.y = cvt_pk_bf16(v0[2], v0[3]); w.z = cvt_pk_bf16(v1[0], v1[1]); w.w = cvt_pk_bf16(v1[2], v1[3]);
                        *(u32x4*)(gf + (size_t)((ai * 4 + m) * 2 + bj) * 4096) = w; }
            return; }
        const int row0 = u.pm * 256 + wr * 64 + fr, col0 = pn * 256 + wc * 32 + 8 * fq;
#pragma unroll
        for (int ai = 0; ai < 2; ++ai)
#pragma unroll
            for (int m = 0; m < 4; ++m) { bf16_t* rowp = base + (size_t)(row0 + ai * 128 + m * 16) * ldc + col0;
#pragma unroll
                for (int bj = 0; bj < 2; ++bj) { f32x4 v0 = acc[ai][bj][m][0] * scale, v1 = acc[ai][bj][m][1] * scale;
                    if (sg) {
#pragma unroll
                        for (int j = 0; j < 4; ++j) { v0[j] = sigmoidf_(v0[j]); v1[j] = sigmoidf_(v1[j]); } }
                    u32x4 w; w.x = cvt_pk_bf16(v0[0], v0[1]); w.y = cvt_pk_bf16(v0[2], v0[3]); w.z = cvt_pk_bf16(v1[0], v1[1]); w.w = cvt_pk_bf16(v1[2], v1[3]);
                    *(u32x4*)(rowp + bj * 128) = w; } }
    }
};
struct SchedZ8 {
    static constexpr bool GATHER = false; __device__ __forceinline__ unsigned a_off(const Unit&, int, int, int, int) const { return 0u; }
    const char* H8; const char* WIN8; int G, c;
    __device__ __forceinline__ bool next(int i, Unit& u) const {
        const long L = (long)i * G + c; if (L >= 64 * 23) return false;
        pg8::static_map(L, 64, 23, u.pm, u.pn); u.tag = 0; u.pa = H8 + (size_t)u.pm * (256 * 1024); u.pb = WIN8 + (size_t)u.pn * (256 * 1024); return true;
    }
};
struct SchedZ {
    static constexpr bool GATHER = false; __device__ __forceinline__ unsigned a_off(const Unit&, int, int, int, int) const { return 0u; }
    const char* H; const char* WinT; const char* HM; const char* WmkvT; int G, c;
    __device__ __forceinline__ bool next(int i, Unit& u) const {
        const long L = (long)i * G + c; if (L >= 480) return false;
        const size_t tstep = (size_t)256 * 1024 * 2;
        if (L < 448) { pg8::static_map(L, 64, 7, u.pm, u.pn); u.tag = 0; u.pa = H + (size_t)u.pm * tstep; u.pb = WinT + (size_t)u.pn * tstep; }
        else { const int q = (int)(L - 448); u.pm = q >> 2; u.pn = 32 + (q & 3); u.tag = 0; u.pa = HM + (size_t)u.pm * tstep; u.pb = WmkvT + (size_t)(q & 3) * tstep; }
        return true;
    }
};
struct EpiLora {
    static constexpr bool PERM = false, MID = false;
    float* L; const float* w0; const float* a0;
    __device__ __forceinline__ void operator()(const f32x4 (&acc)[2][2][4][2], const Unit& u, int wr, int wc, int fr, int fq) const {
        const int row0 = u.pm * 256 + wr * 64 + fr, col0 = u.pn * 256 + wc * 32 + 4 * fq; const int kind = u.pn >> 1; const f32x4 zb = zero4f();
#pragma unroll
        for (int bj = 0; bj < 2; ++bj)
#pragma unroll
            for (int n = 0; n < 2; ++n) { const int c = col0 + bj * 128 + n * 16;
                f32x4 bv = zb;
                if (kind == 0) bv = *(const f32x4*)(w0 + c); else if (kind == 1) bv = *(const f32x4*)(a0 + (c - 512));
#pragma unroll
                for (int ai = 0; ai < 2; ++ai)
#pragma unroll
                    for (int m = 0; m < 4; ++m) { f32x4 v = acc[ai][bj][m][n] + bv;
                        if (kind == 0) {
#pragma unroll
                            for (int j = 0; j < 4; ++j) v[j] = -0.60653066f * sigmoidf_(v[j]); }
                        else if (kind == 1) {
#pragma unroll
                            for (int j = 0; j < 4; ++j) v[j] = sigmoidf_(v[j]); }
                        const size_t row = (size_t)(row0 + ai * 128 + m * 16);
                        if (kind == 0) *(f32x4*)(L + row * 512 + c) = v;
                        else { u32x2 w; w.x = cvt_pk_bf16(v[0], v[1]); w.y = cvt_pk_bf16(v[2], v[3]); *(u32x2*)((bf16_t*)(L + (size_t)NTOK * 512) + row * 1024 + (c - 512)) = w; } } }
    }
};
template <int mode> struct EpiMix {
    static constexpr bool PERM = false, MID = false;
    float* mix32; bf16_t* mixbf; const bf16_t* Z;
    __device__ __forceinline__ void operator()(const f32x4 (&acc)[2][2][4][2], const Unit& u, int wr, int wc, int fr, int fq) const {
        const int row0 = u.pm * 256 + wr * 64 + fr, col0 = u.pn * 256 + wc * 32 + 4 * fq;
#pragma unroll
        for (int ai = 0; ai < 2; ++ai)
#pragma unroll
            for (int m = 0; m < 4; ++m) { const size_t row = (size_t)(row0 + ai * 128 + m * 16);
#pragma unroll
                for (int bj = 0; bj < 2; ++bj)
#pragma unroll
                    for (int n = 0; n < 2; ++n) { const int c = col0 + bj * 128 + n * 16;
                        const u32x2 gz = *(const u32x2*)(Z + row * INC + C_GATE + mode * 1024 + c); float g[4]; unpack4(gz, g);
                        f32x4 v = acc[ai][bj][m][n]; v[0] *= g[0]; v[1] *= g[1]; v[2] *= g[2]; v[3] *= g[3];
                        if (mode > 0) v += *(const f32x4*)(mix32 + row * 1024 + c);
                        if (mode < 2) *(f32x4*)(mix32 + row * 1024 + c) = v;
                        else { u32x2 w; w.x = cvt_pk_bf16(v[0], v[1]); w.y = cvt_pk_bf16(v[2], v[3]); *(u32x2*)(mixbf + row * 1024 + c) = w; } }
                asm volatile("" ::: "memory"); }
    }
};
struct EpiMixCat {
    static constexpr bool PERM = true, MID = true;
    bf16_t* mixbf; const bf16_t* GF; int tid;
    __device__ __forceinline__ const bf16_t* gtile(const Unit& u, int b) const { return GF + ((size_t)(u.pm * 12 + 4 * b + u.pn) * 16) * 4096 + (size_t)tid * 8; }
    __device__ __forceinline__ void mid(f32x4 (&acc)[2][2][4][2], const Unit& u, int t, int wr, int wc, int fr, int fq) const {
        const int ga = (t == 8) ? 0 : 1; int off = 0; asm volatile("" : "+v"(off));
        const bf16_t* pa = gtile(u, ga) + off; const bf16_t* pb = gtile(u, ga + 1) + off;
#pragma unroll
        for (int ai = 0; ai < 2; ++ai) {
#pragma unroll
            for (int m = 0; m < 4; ++m)
#pragma unroll
                for (int bj = 0; bj < 2; ++bj) { float a[8], b[8]; unpack8(*(const u32x4*)(pa + (size_t)((ai * 4 + m) * 2 + bj) * 4096), a); unpack8(*(const u32x4*)(pb + (size_t)((ai * 4 + m) * 2 + bj) * 4096), b);
#pragma unroll
                    for (int j = 0; j < 4; ++j) { acc[ai][bj][m][0][j] *= a[j] * __builtin_amdgcn_rcpf(b[j]); acc[ai][bj][m][1][j] *= a[4 + j] * __builtin_amdgcn_rcpf(b[4 + j]); } }
            asm volatile("" ::: "memory"); }
    }
    __device__ __forceinline__ void operator()(const f32x4 (&acc)[2][2][4][2], const Unit& u, int wr, int wc, int fr, int fq) const {
        const int row0 = u.pm * 256 + wr * 64 + fr, col0 = u.pn * 256 + wc * 32 + 8 * fq; const bf16_t* pg = gtile(u, 2);
#pragma unroll
        for (int ai = 0; ai < 2; ++ai)
#pragma unroll
            for (int m = 0; m < 4; ++m) { bf16_t* rowp = mixbf + (size_t)(row0 + ai * 128 + m * 16) * 1024 + col0;
#pragma unroll
                for (int bj = 0; bj < 2; ++bj) { float g[8]; unpack8(*(const u32x4*)(pg + (size_t)((ai * 4 + m) * 2 + bj) * 4096), g);
                    const f32x4 v0 = acc[ai][bj][m][0], v1 = acc[ai][bj][m][1];
                    u32x4 w; w.x = cvt_pk_bf16(v0[0] * g[0], v0[1] * g[1]); w.y = cvt_pk_bf16(v0[2] * g[2], v0[3] * g[3]); w.z = cvt_pk_bf16(v1[0] * g[4], v1[1] * g[5]); w.w = cvt_pk_bf16(v1[2] * g[6], v1[3] * g[7]);
                    *(u32x4*)(rowp + bj * 128) = w; } }
    }
};
struct EpiX1 {
    static constexpr bool PERM = false, MID = false;
    const float* x; float* out;
    __device__ __forceinline__ void operator()(const f32x4 (&acc)[2][2][4][2], const Unit& u, int wr, int wc, int fr, int fq) const {
        const int row0 = u.pm * 256 + wr * 64 + fr, col0 = u.pn * 256 + wc * 32 + 4 * fq;
#pragma unroll
        for (int ai = 0; ai < 2; ++ai)
#pragma unroll
            for (int m = 0; m < 4; ++m) { const size_t off = (size_t)(row0 + ai * 128 + m * 16) * 1024 + col0;
#pragma unroll
                for (int bj = 0; bj < 2; ++bj)
#pragma unroll
                    for (int n = 0; n < 2; ++n) *(f32x4*)(out + off + bj * 128 + n * 16) = *(const f32x4*)(x + off + bj * 128 + n * 16) + acc[ai][bj][m][n];
                if (m & 1) asm volatile("" ::: "memory"); }
    }
};
struct EpiSwiglu {
    static constexpr bool PERM = true, MID = false;
    unsigned char* act; const float* b1;
    __device__ __forceinline__ void operator()(const f32x4 (&acc)[2][2][4][2], const Unit& u, int wr, int wc, int fr, int fq) const {
        const int row0 = u.pm * 256 + wr * 64 + fr; const float* be = b1 + (size_t)u.tag * 2048; const int j = 128 * u.pn + 32 * wc + 8 * fq;
        float bg[8], bl[8];
#pragma unroll
        for (int q = 0; q < 4; ++q) { const f32x4 t = *(const f32x4*)(be + 2 * j + 4 * q); bg[2 * q] = t[0]; bl[2 * q] = t[1]; bg[2 * q + 1] = t[2]; bl[2 * q + 1] = t[3]; }
#pragma unroll
        for (int ai = 0; ai < 2; ++ai)
#pragma unroll
            for (int m = 0; m < 4; ++m) { float o[8];
#pragma unroll
                for (int n = 0; n < 2; ++n)
#pragma unroll
                    for (int i = 0; i < 4; ++i) { const float xg = fminf(acc[ai][0][m][n][i] * (1.0f / 256.0f) + bg[4 * n + i], 7.0f); const float xl = fminf(fmaxf(acc[ai][1][m][n][i] * (1.0f / 256.0f) + bl[4 * n + i], -7.0f), 7.0f);
                        o[4 * n + i] = xg * __builtin_amdgcn_rcpf(1.0f + __builtin_amdgcn_exp2f(xg * (-1.702f * 1.44269504f))) * fmaf(xl, 4.0f, 4.0f); }
                u32x2 w; w.x = pack4_fp8(o[0], o[1], o[2], o[3]); w.y = pack4_fp8(o[4], o[5], o[6], o[7]);
                *(u32x2*)(act + (size_t)(row0 + ai * 128 + m * 16) * 1024 + j) = w; }
    }
};
struct EpiYs {
    static constexpr bool PERM = true, MID = false;
    bf16_t* ys; const float* b2;
    __device__ __forceinline__ void operator()(const f32x4 (&acc)[2][2][4][2], const Unit& u, int wr, int wc, int fr, int fq) const {
        const int row0 = u.pm * 256 + wr * 64 + fr, col0 = u.pn * 256 + wc * 32 + 8 * fq; const float* be = b2 + (size_t)u.tag * 1024;
#pragma unroll
        for (int bj = 0; bj < 2; ++bj) { const f32x4 c0 = *(const f32x4*)(be + col0 + bj * 128), c1 = *(const f32x4*)(be + col0 + bj * 128 + 4);
#pragma unroll
            for (int ai = 0; ai < 2; ++ai)
#pragma unroll
                for (int m = 0; m < 4; ++m) { const f32x4 v0 = acc[ai][bj][m][0] * (1.0f / 128.0f) + c0, v1 = acc[ai][bj][m][1] * (1.0f / 128.0f) + c1;
                    u32x4 w; w.x = cvt_pk_bf16(v0[0], v0[1]); w.y = cvt_pk_bf16(v0[2], v0[3]); w.z = cvt_pk_bf16(v1[0], v1[1]); w.w = cvt_pk_bf16(v1[2], v1[3]);
                    *(u32x4*)(ys + (size_t)(row0 + ai * 128 + m * 16) * 1024 + col0 + bj * 128) = w; } }
    }
};
template <bool GATHER_> struct SchedMoe {
    static constexpr bool GATHER = GATHER_;
    const char* A; const char* Bt; const LAS int* tstart; const int* stok; int lgN, total; size_t estride, tbytes;
    __device__ __forceinline__ bool next(int i, Unit& u) const {
        const int c = blockIdx.x; const int un = i * 256 + (c & 7) * 32 + (c >> 3); if (un >= total) return false;
        const int mt = un >> lgN, pn = un & ((1 << lgN) - 1); const int e = ((const LAS unsigned char*)tstart)[(LX_TEXP - LX_TSTART) + mt];
        u.pm = mt; u.pn = pn; u.tag = e; u.pa = GATHER ? A : A + (size_t)mt * tbytes; u.pb = Bt + (size_t)e * estride + (size_t)pn * tbytes; return true;
    }
    __device__ __forceinline__ unsigned a_off(const Unit& u, int h, int R, int C, int rowbytes) const { const int tok = stok[u.pm * 256 + h * 128 + R]; return (unsigned)(tok * rowbytes + C * 2); }
};

__device__ __forceinline__ int w1perm(int c) { const int j = c >> 1, s = c & 1; return ((j >> 7) << 8) | (s << 7) | (j & 127); }
__device__ __forceinline__ void phase_prep(const int wv, LAS unsigned char* lds) {
    KParams& p = *kparams();
    const int tid = opaque_tid(wv); unsigned char* ws = p.ws;
    LAS float* tile = (LAS float*)lds;
    struct TileJob { const float* src; bf16_t* dst; unsigned char* dst8; int K, N, perm, f8, ldd, k0, n0; };
    auto decode = [&](int t) -> TileJob { TileJob j; j.dst = nullptr; j.dst8 = nullptr; j.f8 = 0; j.perm = 0; j.ldd = 0; int lt;
        if (t < 960) { j.src = p.in[3]; j.dst = (bf16_t*)(ws + OFF_WINT); j.K = 1024; j.N = 7680; lt = t; if ((lt % 120) >= 28) { j.f8 = 1; j.dst8 = ws + OFF_WIN8 - (size_t)1792 * 1024; } }
        else if (t < 1088) { j.src = p.in[18]; j.dst = (bf16_t*)(ws + OFF_WMKVT); j.K = 1024; j.N = 1024; lt = t - 960; }
        else if (t < 1152) { j.src = p.in[21]; j.dst = (bf16_t*)(ws + OFF_PCAT); j.K = 512; j.N = 1024; lt = t - 1088; j.ldd = 1280; }
        else if (t < 1184) { j.src = p.in[22]; j.dst = (bf16_t*)(ws + OFF_PCAT) + 512; j.K = 256; j.N = 1024; lt = t - 1152; j.ldd = 1280; }
        else if (t < 1248) { j.src = p.in[23]; j.dst = (bf16_t*)(ws + OFF_PCAT) + 768; j.K = 512; j.N = 1024; lt = t - 1184; j.ldd = 1280; }
        else if (t < 1376) { j.src = p.in[24]; j.dst = (bf16_t*)(ws + OFF_WOT); j.K = 1024; j.N = 1024; lt = t - 1248; }
        else if (t < 9568) { const int q = t - 1376, e = q >> 8; j.src = p.in[28] + (size_t)e * 1024 * 2048; j.dst8 = ws + OFF_W1T + (size_t)e * 2048 * 1024; j.K = 1024; j.N = 2048; j.perm = 1; lt = q & 255; j.f8 = 1; }
        else { const int q = t - 9568, e = q >> 7; j.src = p.in[30] + (size_t)e * 1024 * 1024; j.dst8 = ws + OFF_W2T + (size_t)e * 1024 * 1024; j.K = 1024; j.N = 1024; lt = q & 127; j.f8 = 1; }
        const int tn = j.N >> 6; j.k0 = (lt / tn) * 128; j.n0 = (lt % tn) * 64; return j; };
    { const int G = (int)gridDim.x; int t = 13663 - (int)blockIdx.x;
      auto ldtile = [&](const TileJob& j, f32x4 (&v)[4]) {
#pragma unroll
          for (int i = 0; i < 4; ++i) { const int idx = tid + 512 * i, row = idx >> 4, c4 = idx & 15; v[i] = __builtin_nontemporal_load((const f32x4*)(j.src + (size_t)(j.k0 + row) * j.N + j.n0 + 4 * c4)); } };
      TileJob j0 = decode(t < 0 ? 0 : t), j1 = decode(t - G < 0 ? 0 : t - G); f32x4 v0[4], v1[4];
      if (t >= 0) ldtile(j0, v0);
      if (t - G >= 0) ldtile(j1, v1);
      for (; t >= 0; t -= G) {
#pragma unroll
          for (int i = 0; i < 4; ++i) { const int idx = tid + 512 * i, row = idx >> 4, c4 = idx & 15; LAS float* tp = tile + row * 65 + 4 * c4; tp[0] = v0[i][0]; tp[1] = v0[i][1]; tp[2] = v0[i][2]; tp[3] = v0[i][3]; }
          __syncthreads();
          const TileJob cur = j0; j0 = j1;
#pragma unroll
          for (int i = 0; i < 4; ++i) v0[i] = v1[i];
          if (t - 2 * G >= 0) { j1 = decode(t - 2 * G); ldtile(j1, v1); }
          if (!cur.f8) {
#pragma unroll
              for (int i = 0; i < 2; ++i) { const int kc = (tid & 3) | (((tid >> 8) & 1) << 2) | (i << 3), n = (tid >> 2) & 63; float f[8];
#pragma unroll
                  for (int j = 0; j < 8; ++j) f[j] = tile[(kc * 8 + j) * 65 + n];
                  const int drow = cur.n0 + n;
                  *(u32x4*)(cur.dst + (size_t)drow * (cur.ldd ? cur.ldd : cur.K) + cur.k0 + kc * 8) = pack8(f); }
          } else {
              const int kc = (tid & 3) | (((tid >> 8) & 1) << 2), n = (tid >> 2) & 63; float f[16];
#pragma unroll
              for (int j = 0; j < 16; ++j) f[j] = tile[(kc * 16 + j) * 65 + n] * 32.0f;
              const int drow = cur.perm ? w1perm(cur.n0 + n) : (cur.n0 + n);
              u32x4 w; w.x = pack4_fp8(f[0], f[1], f[2], f[3]); w.y = pack4_fp8(f[4], f[5], f[6], f[7]); w.z = pack4_fp8(f[8], f[9], f[10], f[11]); w.w = pack4_fp8(f[12], f[13], f[14], f[15]);
              *(u32x4*)(cur.dst8 + (size_t)drow * cur.K + cur.k0 + kc * 16) = w; }
          __syncthreads(); } }
    { const float* w2 = p.in[6]; const float* a2 = p.in[8]; const float* g2 = p.in[9]; bf16_t* lt = (bf16_t*)(ws + OFF_LORAT);
      for (int idx = blockIdx.x * 512 + tid; idx < 1536 * 32; idx += gridDim.x * 512) { const int n = idx >> 5, kc = idx & 31; float f[8];
#pragma unroll
          for (int j = 0; j < 8; ++j) { const int k = kc * 8 + j; float val = 0.f;
              if (n < 512) { if (k < 64) val = w2[k * 512 + n]; }
              else if (n < 1024) { if (k >= 64 && k < 128) val = a2[(k - 64) * 512 + (n - 512)]; }
              else { if (k >= 128) val = g2[(k - 128) * 512 + (n - 1024)]; }
              f[j] = val; }
          *(u32x4*)(lt + (size_t)n * 256 + kc * 8) = pack8(f); } }
    { const float* wr = p.in[26]; bf16_t* wt = (bf16_t*)(ws + OFF_WRT);
      for (int idx = blockIdx.x * 512 + tid; idx < 32 * 1024; idx += gridDim.x * 512) { const int e = idx >> 10, k = idx & 1023; const float v = wr[k * 32 + e];
          const unsigned hi = cvt_pk_bf16(v, 0.f) & 0xffffu; const float vh = __uint_as_float(hi << 16); const unsigned lo = cvt_pk_bf16(v - vh, 0.f) & 0xffffu;
          wt[idx] = (bf16_t)hi; wt[32768 + idx] = (bf16_t)lo; } }
    { const int wid = tid >> 6, lane = tid & 63; const int gw = blockIdx.x * 8 + wid, nw = gridDim.x * 8;
      for (int row0 = gw; row0 < NTOK + 2048; row0 += 3 * nw) {
          f32x4 v[3][4];
#pragma unroll
          for (int r3 = 0; r3 < 3; ++r3) { const int row = row0 + r3 * nw; if (row < NTOK + 2048) { const float* src = row >= NTOK ? p.in[1] + (size_t)(row - NTOK) * 1024 : p.in[0] + (size_t)row * 1024;
#pragma unroll
              for (int i = 0; i < 4; ++i) v[r3][i] = __builtin_nontemporal_load((const f32x4*)(src + 4 * lane + 256 * i)); } }
#pragma unroll
          for (int r3 = 0; r3 < 3; ++r3) { const int row = row0 + r3 * nw; if (row >= NTOK + 2048) break;
              const bool ism = row >= NTOK; const float* gain = ism ? p.in[17] : p.in[2]; bf16_t* dst = ism ? (bf16_t*)(ws + OFF_HM) + (size_t)(row - NTOK) * 1024 : (bf16_t*)(ws + OFF_H) + (size_t)row * 1024;
              float ss = 0.f;
#pragma unroll
              for (int i = 0; i < 4; ++i) ss += v[r3][i][0] * v[r3][i][0] + v[r3][i][1] * v[r3][i][1] + v[r3][i][2] * v[r3][i][2] + v[r3][i][3] * v[r3][i][3];
              ss = red64(ss); const float rs = rsqrtf(ss * (1.0f / 1024.0f) + 1e-5f);
#pragma unroll
              for (int i = 0; i < 4; ++i) { const f32x4 g = *(const f32x4*)(gain + 4 * lane + 256 * i); const f32x4 y = v[r3][i] * rs * g;
                  u32x2 w; w.x = cvt_pk_bf16(y[0], y[1]); w.y = cvt_pk_bf16(y[2], y[3]);
                  *(u32x2*)(dst + 4 * lane + 256 * i) = w;
                  if (!ism) *(unsigned*)(ws + OFF_H8 + (size_t)row * 1024 + 4 * lane + 256 * i) = pack4_fp8(y[0] * 8.0f, y[1] * 8.0f, y[2] * 8.0f, y[3] * 8.0f); } } }
    }
}

__device__ __forceinline__ void phase_elem_c(const int wv) {
    KParams& p = *kparams();
    const int gt = blockIdx.x * 512 + opaque_tid(wv), nthr = gridDim.x * 512; unsigned char* ws = p.ws;
    bf16_t* Z = (bf16_t*)(ws + OFF_Z); bf16_t* AL = (bf16_t*)(ws + OFF_ALORA); bf16_t* KV = (bf16_t*)(ws + OFF_KV);
    const float* mu = p.in[4];
    u32x4 za[4], zb[4]; const u32x4 zq0 = zero4u();
#pragma unroll
    for (int k = 0; k < 4; ++k) { const int idx = gt + k * nthr, t = idx >> 5, ch = idx & 31, col = C_ZW + 8 * ch;
        za[k] = *(const u32x4*)(Z + (size_t)t * INC + col);
        zb[k] = zq0; if ((t & (SEQ - 1)) != 0) zb[k] = *(const u32x4*)(Z + (size_t)(t - 1) * INC + col); }
#pragma unroll
    for (int k = 0; k < 4; ++k) { const int idx = gt + k * nthr, t = idx >> 5, ch = idx & 31, col = C_ZW + 8 * ch;
        float a[8], b[8]; unpack8(za[k], a); unpack8(zb[k], b);
        const f32x4 m0 = *(const f32x4*)(mu + col), m1 = *(const f32x4*)(mu + col + 4); const float mm[8] = {m0[0], m0[1], m0[2], m0[3], m1[0], m1[1], m1[2], m1[3]};
#pragma unroll
        for (int j = 0; j < 8; ++j) { float v = a[j] + (b[j] - a[j]) * mm[j]; if (ch < 8) v = tanhf(v); else if (ch >= 16) v = sigmoidf_(v); a[j] = v; }
        *(u32x4*)(AL + (size_t)t * 256 + 8 * ch) = pack8(a); }
}

__device__ __forceinline__ bf16x8 pack_frag(const f32x4 lo, const f32x4 hi) { u32x4 w; w.x = cvt_pk_bf16(lo[0], lo[1]); w.y = cvt_pk_bf16(lo[2], lo[3]); w.z = cvt_pk_bf16(hi[0], hi[1]); w.w = cvt_pk_bf16(hi[2], hi[3]); bf16x8 r; __builtin_memcpy(&r, &w, 16); return r; }
__device__ __forceinline__ bf16x8 tr2(LAS unsigned char* pa, LAS unsigned char* pb) { const s16x4 a = __builtin_amdgcn_ds_read_tr16_b64_v4i16((LAS s16x4*)pa), b = __builtin_amdgcn_ds_read_tr16_b64_v4i16((LAS s16x4*)pb); return __builtin_shufflevector(a, b, 0, 1, 2, 3, 4, 5, 6, 7); }
__device__ __forceinline__ bf16x8 rd2(LAS unsigned char* pa, LAS unsigned char* pb) { const s16x4 a = *(const LAS s16x4*)pa, b = *(const LAS s16x4*)pb; return __builtin_shufflevector(a, b, 0, 1, 2, 3, 4, 5, 6, 7); }
#define MFMA16(a, b, c) __builtin_amdgcn_mfma_f32_16x16x32_bf16((a), (b), (c), 0, 0, 0)
constexpr int CP_XA = 0, CP_XR = 4096, CP_XB = 8192, CP_XK = 12288, CP_VL = 16384, CP_NL = 16384, CP_WAVE = 20480;
__device__ __forceinline__ void phase_chunk_pre(const int wv, LAS unsigned char* lds) {
    KParams& p = *kparams();
    const int tid = opaque_tid(wv), wid = tid >> 6, lane = tid & 63, fr = lane & 15, fq = lane >> 4; unsigned char* ws = p.ws;
    u32x4 keep = zero4u(); if (tid == 0) keep = *(const LAS u32x4*)(lds + LDS_X);
    __syncthreads();
    LAS unsigned char* wl = lds + wid * CP_WAVE;
    const bf16_t* Z = (const bf16_t*)(ws + OFF_Z); const float* L = (const float*)(ws + OFF_L); const bf16_t* AG = (const bf16_t*)(L + (size_t)NTOK * 512); bf16_t* C1 = (bf16_t*)(ws + OFF_C1); bf16_t* C2 = (bf16_t*)(ws + OFF_C2);
    const float* mu = p.in[4]; const float* k_k = p.in[10]; const float* k_a = p.in[11]; const float* r_k = p.in[12]; const float* ln_w = p.in[13]; const float* ln_b = p.in[14];
    const f32x4 z4 = zero4f();
    for (int pr = blockIdx.x * 8 + wid; pr < 4096; pr += gridDim.x * 8) {
        float gamC;
        { const int bh = pr >> 6, cc = pr & 63, b_ = bh >> 3, h_ = bh & 7; const int tok0 = b_ * SEQ + cc * 32; const int c = h_ * 64 + lane;
          const bf16_t* zp = Z + (size_t)tok0 * INC + c; const float* lp = L + (size_t)tok0 * 512 + c; const bf16_t* gp = AG + (size_t)tok0 * 1024 + c;
          const float mur = mu[c], muk = mu[C_K + c], muv = mu[C_V + c], kk_ = k_k[c], ka_ = k_a[c], rk_ = r_k[c], lnw = ln_w[c], lnb = ln_b[c];
          float pzr = 0.f, pzk = 0.f, pzv = 0.f;
          if (cc != 0) { pzr = __uint_as_float((unsigned)zp[-INC] << 16); pzk = __uint_as_float((unsigned)zp[-INC + C_K] << 16); pzv = __uint_as_float((unsigned)zp[-INC + C_V] << 16); }
          unsigned short zq[2][4][3], gq[2][4][2]; float lq[2][4];
#pragma unroll
          for (int e = 0; e < 4; ++e) {
#pragma unroll
              for (int q = 0; q < 3; ++q) zq[0][e][q] = zp[(size_t)e * INC + q * 512];
              lq[0][e] = lp[(size_t)e * 512]; gq[0][e][0] = gp[(size_t)e * 1024]; gq[0][e][1] = gp[(size_t)e * 1024 + 512]; }
          __builtin_amdgcn_sched_barrier(0);
          float cs = 0.f, g = 1.0f;
#pragma unroll
          for (int t4 = 0; t4 < 8; ++t4) { unsigned pa[2], pr_[2], pb[2], pk[2];
              if (t4 < 7) {
#pragma unroll
                  for (int e = 0; e < 4; ++e) {
#pragma unroll
                      for (int q = 0; q < 3; ++q) zq[(t4 + 1) & 1][e][q] = zp[(size_t)((t4 + 1) * 4 + e) * INC + q * 512];
                      lq[(t4 + 1) & 1][e] = lp[(size_t)((t4 + 1) * 4 + e) * 512]; gq[(t4 + 1) & 1][e][0] = gp[(size_t)((t4 + 1) * 4 + e) * 1024]; gq[(t4 + 1) & 1][e][1] = gp[(size_t)((t4 + 1) * 4 + e) * 1024 + 512]; } }
              __builtin_amdgcn_sched_barrier(0);
#pragma unroll
              for (int tp = 0; tp < 2; ++tp) { float va[2], vr[2], vb[2], vk[2];
#pragma unroll
                  for (int e = 0; e < 2; ++e) { const int te = tp * 2 + e, t = t4 * 4 + te;
                      const float zr = __uint_as_float((unsigned)zq[t4 & 1][te][0] << 16), zk = __uint_as_float((unsigned)zq[t4 & 1][te][1] << 16), zv = __uint_as_float((unsigned)zq[t4 & 1][te][2] << 16);
                      const float r = zr + (pzr - zr) * mur, k = zk + (pzk - zk) * muk, v = zv + (pzv - zv) * muv; pzr = zr; pzk = zk; pzv = zv;
                      const float lw = lq[t4 & 1][te], al = __uint_as_float((unsigned)gq[t4 & 1][te][0] << 16), gg = __uint_as_float((unsigned)gq[t4 & 1][te][1] << 16);
                      const float kk = k * kk_, kp = k * (1.0f + (al - 1.0f) * ka_);
                      const float n2 = red64(kk * kk), bon = red64(r * kp * rk_);
                      const float kn = kk * __builtin_amdgcn_rsqf(fmaxf(n2, 1e-24f));
                      const float gm1 = g; cs += lw; g = __builtin_amdgcn_exp2f(cs * 1.44269504f); const float gi = __builtin_amdgcn_rcpf(g);
                      va[e] = -kn * gm1; vb[e] = kn * al * gi; vk[e] = kp * gi; vr[e] = r * g;
                      *(LAS bf16_t*)(wl + CP_VL + t * 128 + lane * 2) = (bf16_t)(cvt_pk_bf16(v, 0.f) & 0xffffu);
                      const size_t to = (size_t)(tok0 + t) * 512 + c;
                      C1[to] = (bf16_t)(cvt_pk_bf16(lnw * gg, 0.f) & 0xffffu); C2[to] = (bf16_t)(cvt_pk_bf16((lnb + bon * v) * gg, 0.f) & 0xffffu); }
                  pa[tp] = cvt_pk_bf16(va[0], va[1]); pr_[tp] = cvt_pk_bf16(vr[0], vr[1]); pb[tp] = cvt_pk_bf16(vb[0], vb[1]); pk[tp] = cvt_pk_bf16(vk[0], vk[1]); }
              *(LAS u32x2*)(wl + CP_XA + lane * 64 + t4 * 8) = (u32x2){pa[0], pa[1]}; *(LAS u32x2*)(wl + CP_XR + lane * 64 + t4 * 8) = (u32x2){pr_[0], pr_[1]};
              *(LAS u32x2*)(wl + CP_XB + lane * 64 + t4 * 8) = (u32x2){pb[0], pb[1]}; *(LAS u32x2*)(wl + CP_XK + lane * 64 + t4 * 8) = (u32x2){pk[0], pk[1]};
              __builtin_amdgcn_sched_barrier(0); }
          gamC = g; }
        asm volatile("s_waitcnt lgkmcnt(0)" ::: "memory");
        bf16x8 Vf[4];
        { const int vtb = (4 * fq + (fr >> 2)) * 128 + (fr & 3) * 8;
#pragma unroll
          for (int nv = 0; nv < 4; ++nv) { LAS unsigned char* pp = wl + CP_VL + vtb + nv * 32; Vf[nv] = tr2(pp, pp + 2048); } }
        asm volatile("s_waitcnt lgkmcnt(0)" ::: "memory");
        const int trb = (8 * fq + (fr >> 2)) * 64 + (fr & 3) * 8;
        bf16x8 LakF[2], QrbF[2], QrkF[2];
#pragma unroll
        for (int yi = 0; yi < 2; ++yi) {
            bf16x8 fy[2][2];
#pragma unroll
            for (int nt = 0; nt < 2; ++nt)
#pragma unroll
                for (int s2 = 0; s2 < 2; ++s2) { LAS unsigned char* pp = wl + (yi ? CP_XR : CP_XA) + trb + s2 * 2048 + nt * 32; fy[nt][s2] = tr2(pp, pp + 256); }
#pragma unroll
            for (int xi = 0; xi < 2; ++xi) {
                f32x4 d[2][2];
#pragma unroll
                for (int mi = 0; mi < 2; ++mi) { bf16x8 fx[2];
#pragma unroll
                    for (int s2 = 0; s2 < 2; ++s2) { LAS unsigned char* pp = wl + (xi ? CP_XK : CP_XB) + trb + s2 * 2048 + mi * 32; fx[s2] = tr2(pp, pp + 256); }
#pragma unroll
                    for (int nt = 0; nt < 2; ++nt) {
                        if (mi == 1 && nt == 0) { d[mi][nt] = z4; continue; }
                        f32x4 acc = MFMA16(fx[0], fy[nt][0], z4); acc = MFMA16(fx[1], fy[nt][1], acc);
#pragma unroll
                        for (int j = 0; j < 4; ++j) { const int i = 16 * mi + 4 * fq + j, t = 16 * nt + fr; const bool ok = yi ? (i <= t) : (i < t); acc[j] = ok ? acc[j] : 0.f; }
                        d[mi][nt] = acc; } }
                if (yi == 0 && xi == 0) {
#pragma unroll
                    for (int mi = 0; mi < 2; ++mi)
#pragma unroll
                        for (int nt = 0; nt < 2; ++nt)
#pragma unroll
                            for (int j = 0; j < 4; ++j) *(LAS float*)(wl + CP_NL + ((16 * nt + fr) * 32 + 16 * mi + 4 * fq + j) * 4) = d[mi][nt][j];
                } else {
#pragma unroll
                    for (int nt = 0; nt < 2; ++nt) { const bf16x8 f = pack_frag(d[0][nt], d[1][nt]); if (yi == 0) LakF[nt] = f; else if (xi == 0) QrbF[nt] = f; else QrkF[nt] = f; } } } }
        asm volatile("s_waitcnt lgkmcnt(0)" ::: "memory");
        bf16x8 InvF[2];
        { const int c = lane & 31; float X[32];
#pragma unroll
          for (int t = 0; t < 32; ++t) { float a0 = (t == c) ? 1.0f : 0.f, a1 = 0.f;
#pragma unroll
              for (int i4 = 0; i4 < (t + 3) / 4; ++i4) { const f32x4 nv = *(const LAS f32x4*)(wl + CP_NL + (t * 32 + 4 * i4) * 4);
#pragma unroll
                  for (int e = 0; e < 4; ++e) if (4 * i4 + e < t) { if (e & 1) a1 = fmaf(nv[e], X[4 * i4 + e], a1); else a0 = fmaf(nv[e], X[4 * i4 + e], a0); } }
              X[t] = a0 + a1; }
          asm volatile("s_waitcnt lgkmcnt(0)" ::: "memory");
#pragma unroll
          for (int t = 0; t < 32; ++t) *(LAS float*)(wl + CP_NL + (t * 32 + c) * 4) = X[t];
          asm volatile("s_waitcnt lgkmcnt(0)" ::: "memory");
#pragma unroll
          for (int n = 0; n < 2; ++n) { const f32x4 lo = *(const LAS f32x4*)(wl + CP_NL + ((16 * n + fr) * 32 + 4 * fq) * 4), hi = *(const LAS f32x4*)(wl + CP_NL + ((16 * n + fr) * 32 + 16 + 4 * fq) * 4); InvF[n] = pack_frag(lo, hi); } }
        bf16x8 UF[4], AhF[4];
#pragma unroll
        for (int nv = 0; nv < 4; ++nv) { const f32x4 w0 = MFMA16(LakF[0], Vf[nv], z4), w1 = MFMA16(LakF[1], Vf[nv], z4); const bf16x8 wf = pack_frag(w0, w1);
            const f32x4 u0 = MFMA16(InvF[0], wf, z4), u1 = MFMA16(InvF[1], wf, z4); UF[nv] = pack_frag(u0, u1); }
#pragma unroll
        for (int nc = 0; nc < 4; ++nc) { LAS unsigned char* pp = wl + CP_XA + (16 * nc + fr) * 64 + 8 * fq; const bf16x8 af = rd2(pp, pp + 32);
            const f32x4 h0 = MFMA16(InvF[0], af, z4), h1 = MFMA16(InvF[1], af, z4); AhF[nc] = pack_frag(h0, h1); }
        { f32x4 rt[4][2];
#pragma unroll
          for (int mc = 0; mc < 4; ++mc)
#pragma unroll
              for (int nt = 0; nt < 2; ++nt) { const s16x4 rr = __builtin_amdgcn_ds_read_tr16_b64_v4i16((LAS s16x4*)(wl + CP_XR + (16 * mc + 4 * fq + (fr >> 2)) * 64 + (fr & 3) * 8 + nt * 32));
                  f32x4 cin; cin[0] = __uint_as_float((unsigned)(unsigned short)rr[0] << 16); cin[1] = __uint_as_float((unsigned)(unsigned short)rr[1] << 16); cin[2] = __uint_as_float((unsigned)(unsigned short)rr[2] << 16); cin[3] = __uint_as_float((unsigned)(unsigned short)rr[3] << 16);
                  rt[mc][nt] = MFMA16(AhF[mc], QrbF[nt], cin); }
          bf16x8* RTF = (bf16x8*)(ws + OFF_RTF) + (size_t)pr * 256;
#pragma unroll
          for (int nt = 0; nt < 2; ++nt)
#pragma unroll
              for (int s2 = 0; s2 < 2; ++s2) RTF[(nt * 2 + s2) * 64 + lane] = pack_frag(rt[2 * s2][nt], rt[2 * s2 + 1][nt]); }
        { u32x2* YLF = (u32x2*)(ws + OFF_YLF) + (size_t)pr * 512;
#pragma unroll
          for (int nv = 0; nv < 4; ++nv)
#pragma unroll
              for (int mt = 0; mt < 2; ++mt) { f32x4 y = MFMA16(QrbF[mt], UF[nv], z4); y = MFMA16(QrkF[mt], Vf[nv], y);
                  u32x2 w; w.x = cvt_pk_bf16(y[0], y[1]); w.y = cvt_pk_bf16(y[2], y[3]); YLF[(nv * 2 + mt) * 64 + lane] = w; } }
        { bf16x8* GTF = (bf16x8*)(ws + OFF_GTF) + (size_t)pr * 512; u32x2* HHF = (u32x2*)(ws + OFF_HHF) + (size_t)pr * 1024;
#pragma unroll
          for (int nc = 0; nc < 4; ++nc) { LAS unsigned char* pp = wl + CP_XB + (16 * nc + fr) * 64 + 8 * fq; const bf16x8 bf_ = rd2(pp, pp + 32);
              LAS unsigned char* pk = wl + CP_XK + (16 * nc + fr) * 64 + 8 * fq; const bf16x8 kf_ = rd2(pk, pk + 32);
              const float gcol = __int_as_float(__builtin_amdgcn_ds_bpermute((16 * nc + fr) << 2, __float_as_int(gamC)));
              f32x4 gt[4];
#pragma unroll
              for (int mc = 0; mc < 4; ++mc) { f32x4 a = MFMA16(AhF[mc], bf_, z4);
#pragma unroll
                  for (int j = 0; j < 4; ++j) { if (mc == nc && 4 * fq + j == fr) a[j] += 1.0f; a[j] *= gcol; }
                  gt[mc] = a; }
              GTF[(nc * 2 + 0) * 64 + lane] = pack_frag(gt[0], gt[1]); GTF[(nc * 2 + 1) * 64 + lane] = pack_frag(gt[2], gt[3]);
              f32x4 grow;
#pragma unroll
              for (int j = 0; j < 4; ++j) grow[j] = __int_as_float(__builtin_amdgcn_ds_bpermute((16 * nc + 4 * fq + j) << 2, __float_as_int(gamC)));
#pragma unroll
              for (int nv = 0; nv < 4; ++nv) { f32x4 hh = MFMA16(bf_, UF[nv], z4); hh = MFMA16(kf_, Vf[nv], hh); hh = hh * grow;
                  u32x2 w; w.x = cvt_pk_bf16(hh[0], hh[1]); w.y = cvt_pk_bf16(hh[2], hh[3]); HHF[(nv * 4 + nc) * 64 + lane] = w; } } }
        asm volatile("s_waitcnt lgkmcnt(0)" ::: "memory");
    }
    __syncthreads();
    if (tid == 0) *(LAS u32x4*)(lds + LDS_X) = keep;
}
__device__ __forceinline__ void phase_scan_seq(const int wv, LAS unsigned char* lds) {
    KParams& p = *kparams();
    const int tid = opaque_tid(wv), wid = __builtin_amdgcn_readfirstlane(tid >> 6), lane = tid & 63, fr = lane & 15, fq = lane >> 4; unsigned char* ws = p.ws;
    if (blockIdx.x >= 64) return;
    const int bh = blockIdx.x, b = bh >> 3, h = bh & 7;
    const char* gG = (const char*)(ws + OFF_GTF) + (size_t)bh * 64 * 8192; const char* gR = (const char*)(ws + OFF_RTF) + (size_t)bh * 64 * 4096;
    const char* gH = (const char*)(ws + OFF_HHF) + (size_t)bh * 64 * 8192; const char* gY = (const char*)(ws + OFF_YLF) + (size_t)bh * 64 * 4096;
    constexpr int SLOT = 24576;
    if (wid >= 4) {
        const int w = wid - 4;
        auto issue = [&](int c) { LAS unsigned char* slot = lds + (c % 5) * SLOT;
#pragma unroll
            for (int i = 0; i < 6; ++i) { const int pc = w + 4 * i;
                const char* src = pc < 8 ? gG + (size_t)c * 8192 + pc * 1024 : pc < 12 ? gR + (size_t)c * 4096 + (pc - 8) * 1024 : pc < 20 ? gH + (size_t)c * 8192 + (pc - 12) * 1024 : gY + (size_t)c * 4096 + (pc - 20) * 1024;
                __builtin_amdgcn_global_load_lds((const unsigned*)(src + lane * 16), (LAS unsigned*)(slot + pc * 1024), 16, 0, 0); } };
        issue(0); issue(1); issue(2); issue(3);
        for (int c = 0; c < 64; ++c) {
            if (c < 60) asm volatile("s_waitcnt vmcnt(18)" ::: "memory"); else asm volatile("s_waitcnt vmcnt(0)" ::: "memory");
            __builtin_amdgcn_s_barrier();
            if (c + 4 < 64) issue(c + 4);
        }
        return; }
    const int nv = wid;
    float* Yraw = (float*)(ws + OFF_YRAW) + (size_t)b * SEQ * 512 + h * 64 + 16 * nv + fr;
    f32x4 T[4]; const f32x4 z4s = zero4f();
#pragma unroll
    for (int m = 0; m < 4; ++m) T[m] = z4s;
    for (int c = 0; c < 64; ++c) {
        __builtin_amdgcn_s_barrier();
        const LAS unsigned char* slot = lds + (c % 5) * SLOT + lane * 16;
        bf16x8 G[8], R[4]; u32x2 H[4], Y[2];
#pragma unroll
        for (int i = 0; i < 8; ++i) G[i] = *(const LAS bf16x8*)(slot + i * 1024);
#pragma unroll
        for (int i = 0; i < 4; ++i) R[i] = *(const LAS bf16x8*)(slot + 8192 + i * 1024);
#pragma unroll
        for (int i = 0; i < 4; ++i) H[i] = *(const LAS u32x2*)(lds + (c % 5) * SLOT + 12288 + (nv * 4 + i) * 512 + lane * 8);
#pragma unroll
        for (int i = 0; i < 2; ++i) Y[i] = *(const LAS u32x2*)(lds + (c % 5) * SLOT + 20480 + (nv * 2 + i) * 512 + lane * 8);
        const bf16x8 tf0 = pack_frag(T[0], T[1]), tf1 = pack_frag(T[2], T[3]);
#pragma unroll
        for (int nt = 0; nt < 2; ++nt) { f32x4 y; y[0] = bf_lo(Y[nt].x); y[1] = bf_hi(Y[nt].x); y[2] = bf_lo(Y[nt].y); y[3] = bf_hi(Y[nt].y);
            y = MFMA16(R[nt * 2], tf0, y); y = MFMA16(R[nt * 2 + 1], tf1, y);
#pragma unroll
            for (int j = 0; j < 4; ++j) Yraw[(size_t)(c * 32 + 16 * nt + 4 * fq + j) * 512] = y[j]; }
#pragma unroll
        for (int m = 0; m < 4; ++m) { f32x4 t; t[0] = bf_lo(H[m].x); t[1] = bf_hi(H[m].x); t[2] = bf_lo(H[m].y); t[3] = bf_hi(H[m].y);
            t = MFMA16(G[m * 2], tf0, t); t = MFMA16(G[m * 2 + 1], tf1, t); T[m] = t; }
        asm volatile("s_waitcnt lgkmcnt(0)" ::: "memory");
    }
}

__device__ __forceinline__ bf16x8 tr_pair(LAS unsigned char* pa, LAS unsigned char* pb, bool useB) {
    const s16x4 a = __builtin_amdgcn_ds_read_tr16_b64_v4i16((LAS s16x4*)pa);
    s16x4 b2 = (s16x4){0, 0, 0, 0};
    if (useB) b2 = __builtin_amdgcn_ds_read_tr16_b64_v4i16((LAS s16x4*)pb);
    return __builtin_shufflevector(a, b2, 0, 1, 2, 3, 4, 5, 6, 7);
}
__device__ __forceinline__ void phase_dil_attn(const int wv, LAS unsigned char* lds) {
    KParams& p = *kparams();
    const int tid = opaque_tid(wv), wid = tid >> 6, lane = tid & 63, fr = lane & 15, fq = lane >> 4; unsigned char* ws = p.ws;
    const bf16_t* Z = (const bf16_t*)(ws + OFF_Z); float* DILO = (float*)(ws + OFF_DILO); float* LSE = (float*)(ws + OFF_LSE);
    LAS unsigned char* kb = lds; LAS unsigned char* vb = lds + 32768; const float* qn = p.in[15]; const float* kn = p.in[16];
    float qkw[2][8];
#pragma unroll
    for (int ks = 0; ks < 2; ++ks)
#pragma unroll
        for (int j = 0; j < 8; ++j) qkw[ks][j] = qn[ks * 32 + 8 * fq + j] * kn[ks * 32 + 8 * fq + j];
    const bool seqwg = blockIdx.x < 64;
    const int u0 = seqwg ? 4 * (int)blockIdx.x : 256 + (int)blockIdx.x - 64, uend = seqwg ? 4 * (int)blockIdx.x + 4 : 1536, ustep = seqwg ? 1 : 192;
    auto umap = [&](int v) -> int { if (seqwg) return v; const int c2 = (int)blockIdx.x - 64, x = c2 & 7, y = c2 >> 3, i = (v - u0) / 192, k = 24 * i + y; return 256 + (k >> 3) * 64 + 8 * x + (k & 7); };
    const int ki = tid >> 1, half = tid & 1;
    u32x4 kvA[4], vvA[4], qvA[2], kvB[4], vvB[4], qvB[2]; bool kvalidA = false, kvalidB = false;
    auto unit_load = [&](int uv, u32x4 (&kv)[4], u32x4 (&vv)[4], u32x4 (&qv)[2], bool& kvalid) { const int u = umap(uv);
        const int b = u / 192, rem = u % 192, hh = rem >> 4, qb = rem & 15, g = hh >> 2;
        const int dil = g == 0 ? 1 : (g == 1 ? 4 : 16), nbc = 16 / dil, r = qb / nbc, j0 = (qb % nbc) * 128;
        const bf16_t* Zb = Z + (size_t)b * SEQ * INC; const int kj = j0 - 128 + ki; kvalid = kj >= 0;
        { const bf16_t* rowp = Zb + (size_t)((kvalid ? kj : 0) * dil + r) * INC + hh * 64 + half * 32;
#pragma unroll
            for (int i = 0; i < 4; ++i) { kv[i] = *(const u32x4*)(rowp + C_DK + 8 * i); vv[i] = *(const u32x4*)(rowp + C_DV + 8 * i); } }
        const int tq = (j0 + 16 * wid + fr) * dil + r;
#pragma unroll
        for (int ks = 0; ks < 2; ++ks) qv[ks] = *(const u32x4*)(Zb + (size_t)tq * INC + C_DQ + hh * 64 + ks * 32 + 8 * fq); };
    auto do_unit = [&](const int uvv, u32x4 (&kv)[4], u32x4 (&vv)[4], u32x4 (&qv)[2], bool& kvalid) { const int u = umap(uvv); const int uv_ = uvv;
        const int b = u / 192, rem = u % 192, hh = rem >> 4, qb = rem & 15, g = hh >> 2, hg = hh & 3;
        const int dil = g == 0 ? 1 : (g == 1 ? 4 : 16), nbc = 16 / dil, r = qb / nbc, j0 = (qb % nbc) * 128;
        { if (kvalid) {
              float ss = sumsq8(kv[0]) + sumsq8(kv[1]) + sumsq8(kv[2]) + sumsq8(kv[3]); ss += dpp_f<0xB1>(ss);
              const float rs = rsqrtf(ss * (1.0f / 64.0f) + 1e-5f);
#pragma unroll
              for (int i = 0; i < 4; ++i) kv[i] = scale8s(kv[i], rs); }
          else { const u32x4 zu = zero4u();
#pragma unroll
              for (int i = 0; i < 4; ++i) { kv[i] = zu; vv[i] = zu; } }
#pragma unroll
          for (int i = 0; i < 4; ++i) { const int sw = (half * 4 + i) ^ (ki & 7); *(LAS u32x4*)(kb + ki * 128 + sw * 16) = kv[i]; *(LAS u32x4*)(vb + ki * 128 + sw * 16) = vv[i]; } }
        const int qi = 16 * wid + fr, tq = (j0 + qi) * dil + r;
        bf16x8 qf[2];
        { float ss = sumsq8(qv[0]) + sumsq8(qv[1]); ss += sxor(ss, 16); ss += sxor(ss, 32);
          const float rs = rsqrtf(ss * (1.0f / 64.0f) + 1e-5f) * 0.125f;
#pragma unroll
          for (int ks = 0; ks < 2; ++ks) { const u32x4 w = scale8r(qv[ks], rs, qkw[ks]); __builtin_memcpy(&qf[ks], &w, 16); } }
        __syncthreads();
        if (uv_ + 2 * ustep < uend) unit_load(uv_ + 2 * ustep, kv, vv, qv, kvalid);
        f32x4 st[9]; float mx = -1e30f; const f32x4 zq = zero4f();
        LAS unsigned char* kp0 = kb + (16 * wid + fr) * 128 + ((fq ^ (fr & 7)) << 4); LAS unsigned char* kp1 = kb + (16 * wid + fr) * 128 + (((4 + fq) ^ (fr & 7)) << 4);
#pragma unroll
        for (int ti = 0; ti < 9; ++ti) {
            const bf16x8 k0 = *(const LAS bf16x8*)(kp0 + ti * 2048), k1 = *(const LAS bf16x8*)(kp1 + ti * 2048);
            f32x4 s = __builtin_amdgcn_mfma_f32_16x16x32_bf16(k0, qf[0], zq, 0, 0, 0);
            s = __builtin_amdgcn_mfma_f32_16x16x32_bf16(k1, qf[1], s, 0, 0, 0);
#pragma unroll
            for (int j = 0; j < 4; ++j) { const int ki = 16 * (wid + ti) + 4 * fq + j, off = qi + 128 - ki; const bool ok = (off >= 0) && (off <= 128) && (j0 - 128 + ki >= 0);
                s[j] = ok ? s[j] : -1e30f; mx = fmaxf(mx, s[j]); }
            st[ti] = s; }
        mx = fmaxf(mx, sxor(mx, 16)); mx = fmaxf(mx, sxor(mx, 32));
        float den = 0.f;
#pragma unroll
        for (int ti = 0; ti < 9; ++ti)
#pragma unroll
            for (int j = 0; j < 4; ++j) { const float e = __builtin_amdgcn_exp2f((st[ti][j] - mx) * 1.44269504f); st[ti][j] = e; den += e; }
        den += sxor(den, 16); den += sxor(den, 32);
        f32x4 o[4];
#pragma unroll
        for (int dt = 0; dt < 4; ++dt) o[dt] = zq;
        const int q4 = fr >> 2, p4 = fr & 3; const int kl = 4 * fq + q4;
        LAS unsigned char* vp[4];
#pragma unroll
        for (int dt = 0; dt < 4; ++dt) vp[dt] = vb + (16 * wid + kl) * 128 + (((2 * dt + (p4 >> 1)) ^ (kl & 7)) << 4) + (p4 & 1) * 8;
#pragma unroll
        for (int pp = 0; pp < 5; ++pp) { const bool two = pp < 4; const int tA = 2 * pp, tB = two ? 2 * pp + 1 : 2 * pp;
            u32x4 pw; pw.x = cvt_pk_bf16(st[tA][0], st[tA][1]); pw.y = cvt_pk_bf16(st[tA][2], st[tA][3]);
            if (two) { pw.z = cvt_pk_bf16(st[tB][0], st[tB][1]); pw.w = cvt_pk_bf16(st[tB][2], st[tB][3]); } else { pw.z = 0u; pw.w = 0u; }
            bf16x8 pf; __builtin_memcpy(&pf, &pw, 16);
#pragma unroll
            for (int dt = 0; dt < 4; ++dt) { const bf16x8 vf = tr_pair(vp[dt] + tA * 2048, vp[dt] + tB * 2048, two);
                o[dt] = __builtin_amdgcn_mfma_f32_16x16x32_bf16(vf, pf, o[dt], 0, 0, 0); } }
        const float inv = __builtin_amdgcn_rcpf(den); const size_t ob = ((size_t)(g * NTOK + b * SEQ + tq) * 4 + hg);
#pragma unroll
        for (int dt = 0; dt < 4; ++dt) *(f32x4*)(DILO + ob * 64 + 16 * dt + 4 * fq) = o[dt] * inv;
        if (fq == 0) LSE[ob] = mx + __logf(den);
        __syncthreads();
    };
    if (u0 < uend) unit_load(u0, kvA, vvA, qvA, kvalidA);
    if (u0 + ustep < uend) unit_load(u0 + ustep, kvB, vvB, qvB, kvalidB);
    for (int u = u0; u < uend; u += 2 * ustep) {
        do_unit(u, kvA, vvA, qvA, kvalidA);
        if (u + ustep < uend) do_unit(u + ustep, kvB, vvB, qvB, kvalidB);
    }
}

__device__ __forceinline__ void phase_mem_attn(const int wv, LAS unsigned char* lds) {
    KParams& p = *kparams();
    const int tid = opaque_tid(wv), wid = tid >> 6, lane = tid & 63, fr = lane & 15, fq = lane >> 4; unsigned char* ws = p.ws;
    const bf16_t* Z = (const bf16_t*)(ws + OFF_Z); const bf16_t* KV = (const bf16_t*)(ws + OFF_KV); bf16_t* YM = (bf16_t*)(ws + OFF_YCAT) + 768;
    LAS unsigned char* kb = lds; LAS unsigned char* vb = lds + 65536; const float* mqn = p.in[19]; const float* mkn = p.in[20];
    if (blockIdx.x < 64) return;
    float mqk[4][8];
#pragma unroll
    for (int ks = 0; ks < 4; ++ks)
#pragma unroll
        for (int j = 0; j < 8; ++j) mqk[ks][j] = mqn[ks * 32 + 8 * fq + j] * mkn[ks * 32 + 8 * fq + j];
    for (int bhq = (int)blockIdx.x - 64; bhq < 256; bhq += (int)gridDim.x - 64) {
        const int bhm = bhq >> 3, b = bhm >> 2, hm = bhm & 3;
        { const int ki = tid >> 1, half = tid & 1; const bf16_t* rowp = KV + (size_t)(b * 256 + ki) * 1024 + hm * 128 + half * 64;
          u32x4 kv[8], vv[8];
#pragma unroll
          for (int i = 0; i < 8; ++i) { kv[i] = *(const u32x4*)(rowp + 8 * i); vv[i] = *(const u32x4*)(rowp + 512 + 8 * i); }
          { float ss = 0.f;
#pragma unroll
            for (int i = 0; i < 8; ++i) ss += sumsq8(kv[i]);
            ss += dpp_f<0xB1>(ss); const float rs = rsqrtf(ss * (1.0f / 128.0f) + 1e-5f);
#pragma unroll
            for (int i = 0; i < 8; ++i) kv[i] = scale8s(kv[i], rs); }
#pragma unroll
          for (int i = 0; i < 8; ++i) { const int sw = (half * 8 + i) ^ (ki & 15); *(LAS u32x4*)(kb + ki * 256 + sw * 16) = kv[i]; *(LAS u32x4*)(vb + ki * 256 + sw * 16) = vv[i]; } }
        __syncthreads();
        const int q4 = fr >> 2, p4 = fr & 3; const int kl = 4 * fq + q4;
        LAS unsigned char* kp[4]; LAS unsigned char* vp[8];
#pragma unroll
        for (int ks = 0; ks < 4; ++ks) kp[ks] = kb + fr * 256 + (((4 * ks + fq) ^ fr) << 4);
#pragma unroll
        for (int dt = 0; dt < 8; ++dt) vp[dt] = vb + kl * 256 + (((2 * dt + (p4 >> 1)) ^ kl) << 4) + (p4 & 1) * 8;
        for (int qq = 0; qq < 2; ++qq) { const int qblk = (bhq & 7) * 2 + qq; const int tq = b * SEQ + qblk * 128 + 16 * wid + fr;
            bf16x8 qf[4];
#pragma unroll
            for (int ks = 0; ks < 4; ++ks) qf[ks] = *(const bf16x8*)(Z + (size_t)tq * INC + C_MQ + hm * 128 + ks * 32 + 8 * fq);
            { u32x4 qv[4]; float ss = 0.f;
#pragma unroll
              for (int ks = 0; ks < 4; ++ks) { __builtin_memcpy(&qv[ks], &qf[ks], 16); ss += sumsq8(qv[ks]); }
              ss += sxor(ss, 16); ss += sxor(ss, 32); const float rs = rsqrtf(ss * (1.0f / 128.0f) + 1e-5f);
#pragma unroll
              for (int ks = 0; ks < 4; ++ks) { const u32x4 w = scale8r(qv[ks], rs, mqk[ks]); __builtin_memcpy(&qf[ks], &w, 16); } }
            f32x4 st[16]; float mx = -1e30f; const f32x4 zq = zero4f();
#pragma unroll
            for (int ti = 0; ti < 16; ++ti) { f32x4 s = zq;
#pragma unroll
                for (int ks = 0; ks < 4; ++ks) { const bf16x8 kf = *(const LAS bf16x8*)(kp[ks] + ti * 4096); s = __builtin_amdgcn_mfma_f32_16x16x32_bf16(kf, qf[ks], s, 0, 0, 0); }
#pragma unroll
                for (int j = 0; j < 4; ++j) mx = fmaxf(mx, s[j]);
                st[ti] = s; if (ti & 1) asm volatile("" ::: "memory"); }
            mx = fmaxf(mx, sxor(mx, 16)); mx = fmaxf(mx, sxor(mx, 32));
            const float sc = 0.08838834764831845f * 1.44269504f; float den = 0.f;
#pragma unroll
            for (int ti = 0; ti < 16; ++ti)
#pragma unroll
                for (int j = 0; j < 4; ++j) { const float e = __builtin_amdgcn_exp2f((st[ti][j] - mx) * sc); st[ti][j] = e; den += e; }
            den += sxor(den, 16); den += sxor(den, 32);
            f32x4 o[8];
#pragma unroll
            for (int dt = 0; dt < 8; ++dt) o[dt] = zq;
#pragma unroll
            for (int pp = 0; pp < 8; ++pp) { const int tA = 2 * pp, tB = 2 * pp + 1;
                u32x4 pw; pw.x = cvt_pk_bf16(st[tA][0], st[tA][1]); pw.y = cvt_pk_bf16(st[tA][2], st[tA][3]); pw.z = cvt_pk_bf16(st[tB][0], st[tB][1]); pw.w = cvt_pk_bf16(st[tB][2], st[tB][3]);
                bf16x8 pf; __builtin_memcpy(&pf, &pw, 16);
#pragma unroll
                for (int dt = 0; dt < 8; ++dt) { const bf16x8 vf = tr_pair(vp[dt] + tA * 4096, vp[dt] + tB * 4096, true);
                    o[dt] = __builtin_amdgcn_mfma_f32_16x16x32_bf16(vf, pf, o[dt], 0, 0, 0); } }
            const float inv = __builtin_amdgcn_rcpf(den);
#pragma unroll
            for (int dt = 0; dt < 8; ++dt) { u32x2 w; w.x = cvt_pk_bf16(o[dt][0] * inv, o[dt][1] * inv); w.y = cvt_pk_bf16(o[dt][2] * inv, o[dt][3] * inv);
                *(u32x2*)(YM + (size_t)tq * 1280 + hm * 128 + 16 * dt + 4 * fq) = w; } }
        __syncthreads();
    }
}

__device__ __forceinline__ void phase_post(const int wv) {
    KParams& p = *kparams();
    const int gt = blockIdx.x * 512 + opaque_tid(wv), nthr = gridDim.x * 512; unsigned char* ws = p.ws;
    const float* Yraw = (const float*)(ws + OFF_YRAW); const bf16_t* C1 = (const bf16_t*)(ws + OFF_C1); const bf16_t* C2 = (const bf16_t*)(ws + OFF_C2); bf16_t* YR = (bf16_t*)(ws + OFF_YCAT);
    for (int idx = gt; idx < NTOK * 128; idx += nthr) { const int t = idx >> 7, c = ((idx >> 4) & 7) * 64 + 4 * (idx & 15);
        const f32x4 y = *(const f32x4*)(Yraw + (size_t)t * 512 + c);
        const float mean = red16(y[0] + y[1] + y[2] + y[3]) * (1.0f / 64.0f);
        const f32x4 d = y - mean; const float var = red16(d[0] * d[0] + d[1] * d[1] + d[2] * d[2] + d[3] * d[3]) * (1.0f / 64.0f);
        const float rs = rsqrtf(var + 64.0f * 1e-5f);
        float c1[4], c2[4]; unpack4(*(const u32x2*)(C1 + (size_t)t * 512 + c), c1); unpack4(*(const u32x2*)(C2 + (size_t)t * 512 + c), c2);
        u32x2 w; w.x = cvt_pk_bf16(d[0] * rs * c1[0] + c2[0], d[1] * rs * c1[1] + c2[1]); w.y = cvt_pk_bf16(d[2] * rs * c1[2] + c2[2], d[3] * rs * c1[3] + c2[3]);
        *(u32x2*)(YR + (size_t)t * 1280 + c) = w; }
    const float* DILO = (const float*)(ws + OFF_DILO); const float* LSE = (const float*)(ws + OFF_LSE); bf16_t* YD = (bf16_t*)(ws + OFF_YCAT) + 512;
    for (int idx = gt; idx < NTOK * 64; idx += nthr) { const int t = idx >> 6, hg = (idx >> 4) & 3, q = idx & 15;
        const float l0 = LSE[(size_t)t * 4 + hg], l1 = LSE[((size_t)NTOK + t) * 4 + hg], l2 = LSE[((size_t)2 * NTOK + t) * 4 + hg];
        const float m = fmaxf(l0, fmaxf(l1, l2)); const float e0 = __expf(l0 - m), e1 = __expf(l1 - m), e2 = __expf(l2 - m); const float inv = __builtin_amdgcn_rcpf(e0 + e1 + e2);
        const f32x4 o0 = *(const f32x4*)(DILO + ((size_t)t * 4 + hg) * 64 + 4 * q), o1 = *(const f32x4*)(DILO + (((size_t)NTOK + t) * 4 + hg) * 64 + 4 * q), o2 = *(const f32x4*)(DILO + (((size_t)2 * NTOK + t) * 4 + hg) * 64 + 4 * q);
        const f32x4 o = (o0 * e0 + o1 * e1 + o2 * e2) * inv;
        u32x2 w; w.x = cvt_pk_bf16(o[0], o[1]); w.y = cvt_pk_bf16(o[2], o[3]); *(u32x2*)(YD + (size_t)t * 1280 + hg * 64 + 4 * q) = w; }
}

__device__ __forceinline__ void phase_router(const int wv, LAS unsigned char* lds, const bool real = true) {
    KParams& p = *kparams();
    const int tid = opaque_tid(wv), wid = tid >> 6, lane = tid & 63, fr = lane & 15, fq = lane >> 4; unsigned char* ws = p.ws;
    const float* X1 = p.out; const float* ln2 = p.in[25]; const float* br = p.in[27]; const bf16_t* WRT = (const bf16_t*)(ws + OFF_WRT);
    unsigned char* XN2 = ws + OFF_XN2; int* TOPE = (int*)(ws + OFF_TOPE); float* TOPG = (float*)(ws + OFF_TOPG);
    LAS int* hist = (LAS int*)(lds + LX_HIST);
    LAS float* red = (LAS float*)lds;
    LAS float* part = (LAS float*)(lds + 1024);
    if (tid < 32) hist[tid] = 0;
    const int grp = wid >> 2, kq = wid & 3;
    f32x4 xq[2][16];
#pragma unroll
    for (int rd = 0; rd < 2; ++rd) { const float* xp = X1 + (size_t)((blockIdx.x * 4 + rd * 2 + grp) * 16 + fr) * 1024 + kq * 256 + 8 * fq;
#pragma unroll
        for (int s2 = 0; s2 < 8; ++s2) { xq[rd][2 * s2] = __builtin_nontemporal_load((const f32x4*)(xp + 32 * s2)); xq[rd][2 * s2 + 1] = __builtin_nontemporal_load((const f32x4*)(xp + 32 * s2 + 4)); } }
#pragma unroll
    for (int rd = 0; rd < 2; ++rd) { const int t0 = (blockIdx.x * 4 + rd * 2 + grp) * 16;
        f32x4 xa[8], xb[8]; float ss = 0.f;
#pragma unroll
        for (int s2 = 0; s2 < 8; ++s2) { xa[s2] = xq[rd][2 * s2]; xb[s2] = xq[rd][2 * s2 + 1]; }
#pragma unroll
        for (int s2 = 0; s2 < 8; ++s2) ss += xa[s2][0] * xa[s2][0] + xa[s2][1] * xa[s2][1] + xa[s2][2] * xa[s2][2] + xa[s2][3] * xa[s2][3] + xb[s2][0] * xb[s2][0] + xb[s2][1] * xb[s2][1] + xb[s2][2] * xb[s2][2] + xb[s2][3] * xb[s2][3];
        ss += sxor(ss, 16); ss += sxor(ss, 32);
        __syncthreads();
        if (fq == 0) red[(grp * 4 + kq) * 16 + fr] = ss;
        __syncthreads();
        const float tot = red[(grp * 4 + 0) * 16 + fr] + red[(grp * 4 + 1) * 16 + fr] + red[(grp * 4 + 2) * 16 + fr] + red[(grp * 4 + 3) * 16 + fr];
        const float rs = rsqrtf(tot * (1.0f / 1024.0f) + 1e-5f);
        f32x4 acc[2]; acc[0] = zero4f(); acc[1] = acc[0];
#pragma unroll
        for (int s2 = 0; s2 < 8; ++s2) { const int k = kq * 256 + 32 * s2 + 8 * fq;
            const f32x4 g0 = *(const f32x4*)(ln2 + k), g1 = *(const f32x4*)(ln2 + k + 4);
            float xn[8]; xn[0] = xa[s2][0] * rs * g0[0]; xn[1] = xa[s2][1] * rs * g0[1]; xn[2] = xa[s2][2] * rs * g0[2]; xn[3] = xa[s2][3] * rs * g0[3];
            xn[4] = xb[s2][0] * rs * g1[0]; xn[5] = xb[s2][1] * rs * g1[1]; xn[6] = xb[s2][2] * rs * g1[2]; xn[7] = xb[s2][3] * rs * g1[3];
            const u32x4 hi = pack8(xn); float hf[8]; unpack8(hi, hf);
#pragma unroll
            for (int j = 0; j < 8; ++j) hf[j] = xn[j] - hf[j];
            const u32x4 lo = pack8(hf);
            { u32x2 q8; q8.x = pack4_fp8(xn[0] * 8.0f, xn[1] * 8.0f, xn[2] * 8.0f, xn[3] * 8.0f); q8.y = pack4_fp8(xn[4] * 8.0f, xn[5] * 8.0f, xn[6] * 8.0f, xn[7] * 8.0f); if (real) *(u32x2*)(XN2 + (size_t)(t0 + fr) * 1024 + k) = q8; }
            bf16x8 xh, xl; __builtin_memcpy(&xh, &hi, 16); __builtin_memcpy(&xl, &lo, 16);
#pragma unroll
            for (int m = 0; m < 2; ++m) { const bf16x8 wh = *(const bf16x8*)(WRT + (size_t)(16 * m + fr) * 1024 + k), wl = *(const bf16x8*)(WRT + 32768 + (size_t)(16 * m + fr) * 1024 + k);
                acc[m] = MFMA16(wh, xh, acc[m]); acc[m] = MFMA16(wh, xl, acc[m]); acc[m] = MFMA16(wl, xh, acc[m]); } }
#pragma unroll
        for (int m = 0; m < 2; ++m)
#pragma unroll
            for (int j = 0; j < 4; ++j) part[((grp * 4 + kq) * 32 + 16 * m + 4 * fq + j) * 16 + fr] = acc[m][j];
        __syncthreads();
        if (kq == 0) { float lg[8]; int le[8];
#pragma unroll
            for (int m = 0; m < 2; ++m)
#pragma unroll
                for (int j = 0; j < 4; ++j) { const int e = 16 * m + 4 * fq + j; le[m * 4 + j] = e;
                    lg[m * 4 + j] = part[((grp * 4 + 0) * 32 + e) * 16 + fr] + part[((grp * 4 + 1) * 32 + e) * 16 + fr] + part[((grp * 4 + 2) * 32 + e) * 16 + fr] + part[((grp * 4 + 3) * 32 + e) * 16 + fr] + br[e]; }
            float tv[4]; int te[4];
#pragma unroll
            for (int r = 0; r < 4; ++r) { float bv = lg[0]; int bi = le[0];
#pragma unroll
                for (int q = 1; q < 8; ++q) if (lg[q] > bv) { bv = lg[q]; bi = le[q]; }
#pragma unroll
                for (int sft = 16; sft < 64; sft <<= 1) { const float ov = sxor(bv, sft); const int oi = sxor(bi, sft); if (ov > bv || (ov == bv && oi < bi)) { bv = ov; bi = oi; } }
                tv[r] = bv; te[r] = bi;
#pragma unroll
                for (int q = 0; q < 8; ++q) if (le[q] == bi) lg[q] = -3.0e38f; }
            const float e1 = __expf(tv[1] - tv[0]), e2 = __expf(tv[2] - tv[0]), e3 = __expf(tv[3] - tv[0]); const float inv = 1.0f / (1.0f + e1 + e2 + e3);
            if (fq == 0 && real) { const int t = t0 + fr; *(int4*)(TOPE + (size_t)t * 4) = make_int4(te[0], te[1], te[2], te[3]); *(f32x4*)(TOPG + (size_t)t * 4) = (f32x4){inv, e1 * inv, e2 * inv, e3 * inv};
                atomicAdd((int*)&hist[te[0]], 1); atomicAdd((int*)&hist[te[1]], 1); atomicAdd((int*)&hist[te[2]], 1); atomicAdd((int*)&hist[te[3]], 1); } }
    }
    __syncthreads();
    if (tid < 32 && real) { const int hcount = hist[tid]; if (hcount) atomicAdd((int*)(ws + OFF_CTL + CTL_CNT) + tid, hcount); }
}

__device__ __forceinline__ void build_tables(const int wv, LAS unsigned char* lds) {
    KParams& p = *kparams();
    LAS int* ts = (LAS int*)(lds + LX_TSTART); LAS int* sb = (LAS int*)(lds + LX_SBASE); LAS int* cn = (LAS int*)(lds + LX_CNT);
    if (wv == 0) { const int l = lane_id(); int* gc = (int*)(p.ws + OFF_CTL + CTL_CNT);
        const int c = (l < 32) ? (int)__hip_atomic_load(gc + l, __ATOMIC_RELAXED, __HIP_MEMORY_SCOPE_AGENT) : 0; const int tl = (c + 255) >> 8; int v = tl;
#pragma unroll
        for (int d = 1; d < 32; d <<= 1) { const int o = __builtin_amdgcn_ds_bpermute((l - d) << 2, v); if (l >= d) v += o; }
        if (l < 32) { cn[l] = c; sb[l] = (v - tl) * 256; ts[l + 1] = v; if (l == 0) ts[0] = 0; } }
    __syncthreads();
    { const int tid = (wv << 6) | lane_id(); LAS unsigned char* te = (LAS unsigned char*)(lds + LX_TEXP); const int nt = ts[32];
      if (tid < nt) { int e = 0; while (e < 31 && tid >= ts[e + 1]) ++e; te[tid] = (unsigned char)e; } }
    __syncthreads();
}

__device__ __forceinline__ void phase_dispatch(const int wv, LAS unsigned char* lds, const bool real = true) {
    KParams& p = *kparams();
    const int tid = opaque_tid(wv); unsigned char* ws = p.ws;
    build_tables(wv, lds);
    const LAS int* sb = (const LAS int*)(lds + LX_SBASE); const LAS int* cn = (const LAS int*)(lds + LX_CNT);
    LAS int* hist = (LAS int*)(lds + LX_HIST); LAS int* bbase = (LAS int*)(lds + LX_BBASE);
    const int* TOPE = (const int*)(ws + OFF_TOPE); int* SLOT = (int*)(ws + OFF_SLOT); int* STOK = (int*)(ws + OFF_STOK);
    for (int tb = blockIdx.x; tb < NTOK / 64; tb += gridDim.x) {
        if (tid < 32) hist[tid] = 0;
        __syncthreads();
        int e = 0, lr = 0;
        if (tid < 256) { e = TOPE[(size_t)tb * 256 + tid]; lr = atomicAdd((int*)&hist[e], 1); }
        __syncthreads();
        if (tid < 32) { const int hcount = hist[tid]; bbase[tid] = (hcount && real) ? atomicAdd((int*)(ws + OFF_CTL + CTL_CUR) + tid, hcount) : 0; }
        __syncthreads();
        if (tid < 256 && real) { const int sl = sb[e] + bbase[e] + lr; SLOT[(size_t)tb * 256 + tid] = sl; STOK[sl] = tb * 64 + (tid >> 2); }
        __syncthreads();
    }
    for (int e = blockIdx.x; e < 32; e += gridDim.x) { const int lo = sb[e] + cn[e], hi = sb[e] + ((cn[e] + 255) & ~255);
        for (int rrow = lo + tid; rrow < hi; rrow += 512) STOK[rrow] = 0; }
}

__device__ __forceinline__ void phase_combine(const int wv, const bool real = true) {
    KParams& p = *kparams();
    const int tid = opaque_tid(wv), wid = tid >> 6, lane = tid & 63; unsigned char* ws = p.ws;
    const int* SLOT = (const int*)(ws + OFF_SLOT); const float* TOPG = (const float*)(ws + OFF_TOPG); const bf16_t* YS = (const bf16_t*)(ws + OFF_YS); float* out = p.out;
    for (int t0 = (blockIdx.x * 8 + wid) * 8; t0 < NTOK; t0 += gridDim.x * 64) {
        int4 sl[8]; f32x4 gg[8];
#pragma unroll
        for (int i = 0; i < 8; ++i) { sl[i] = *(const int4*)(SLOT + (size_t)(t0 + i) * 4); gg[i] = *(const f32x4*)(TOPG + (size_t)(t0 + i) * 4); }
#pragma unroll
        for (int i = 0; i < 8; ++i) { const int t = t0 + i; const int s4[4] = {sl[i].x, sl[i].y, sl[i].z, sl[i].w};
#pragma unroll
            for (int hf = 0; hf < 2; ++hf) { const int c = hf * 512 + 8 * lane; float acc[8];
                const f32x4 x0 = __builtin_nontemporal_load((const f32x4*)(out + (size_t)t * 1024 + c)), x1 = __builtin_nontemporal_load((const f32x4*)(out + (size_t)t * 1024 + c + 4));
                u32x4 yv[4];
#pragma unroll
                for (int k = 0; k < 4; ++k) yv[k] = __builtin_nontemporal_load((const u32x4*)(YS + (size_t)s4[k] * 1024 + c));
                acc[0] = x0[0]; acc[1] = x0[1]; acc[2] = x0[2]; acc[3] = x0[3]; acc[4] = x1[0]; acc[5] = x1[1]; acc[6] = x1[2]; acc[7] = x1[3];
#pragma unroll
                for (int k = 0; k < 4; ++k) { float f[8]; unpack8(yv[k], f);
#pragma unroll
                    for (int j = 0; j < 8; ++j) acc[j] = fmaf(gg[i][k], f[j], acc[j]); }
                float* dst = real ? out : (float*)(ws + OFF_ACT);
                *(f32x4*)(dst + (size_t)t * 1024 + c) = (f32x4){acc[0], acc[1], acc[2], acc[3]}; *(f32x4*)(dst + (size_t)t * 1024 + c + 4) = (f32x4){acc[4], acc[5], acc[6], acc[7]}; }
            if (i & 1) asm volatile("" ::: "memory"); }
    }
}

__global__ void __launch_bounds__(512, 2) mk_fwd(Params p) {
    extern __shared__ __attribute__((aligned(16))) unsigned char lds_raw[];
    LAS unsigned char* lds = (LAS unsigned char*)lds_raw;
    unsigned char* ws = p.ws;
    const int wv = __builtin_amdgcn_readfirstlane((int)threadIdx.x >> 6);
    const bool multi = (p.ph_hi - p.ph_lo) > 1;
    XcdBarrier xb; xb.bar = (unsigned*)(ws + OFF_CTL); xb.x = 0; xb.st = (volatile LAS unsigned*)(lds + LDS_X);
    if (multi) {
        if (wv == 0 && lane_id() == 0) { *(LAS u32x4*)(lds + LDS_X) = zero4u(); }
        __syncthreads();
        xb = xcd_barrier_post((unsigned*)(ws + OFF_CTL), (volatile LAS unsigned*)(lds + LDS_X), wv);
    }
    for (int ph = p.ph_lo; ph < p.ph_hi; ++ph) {
      for (int rep = 0; rep < (((DBL_MASK >> ph) & 1) ? 2 : 1); ++rep) {
        KParams& q = *kparams(); unsigned char* ws = q.ws;
        switch (ph) {
        case 0: phase_prep(wv, lds); break;
        case 1: { { SchedZ S; S.H = (const char*)(ws + OFF_H); S.WinT = (const char*)(ws + OFF_WINT); S.HM = (const char*)(ws + OFF_HM); S.WmkvT = (const char*)(ws + OFF_WMKVT); S.G = gridDim.x; S.c = blockIdx.x;
                    EpiZ E; E.Z = (bf16_t*)(ws + OFF_Z); E.KV = (bf16_t*)(ws + OFF_KV); E.GFp = (bf16_t*)(ws + OFF_GF); E.pn0 = 0; E.scale = 1.0f; pg8::gemm_phase(wv, lds, 1024, S, E); }
                  { SchedZ8 S; S.H8 = (const char*)(ws + OFF_H8); S.WIN8 = (const char*)(ws + OFF_WIN8); S.G = gridDim.x; S.c = blockIdx.x;
                    EpiZ E; E.Z = (bf16_t*)(ws + OFF_Z); E.KV = (bf16_t*)(ws + OFF_KV); E.GFp = (bf16_t*)(ws + OFF_GF); E.pn0 = 7; E.scale = 1.0f / 256.0f; pg8::gemm_phase<EpiZ, SchedZ8, 1>(wv, lds, 1024, S, E); } } break;
        case 2: phase_elem_c(wv); break;
        case 3: { pg8::DenseOrder S; S.init(ws + OFF_ALORA, ws + OFF_LORAT, NTOK, 1536, 256); EpiLora E; E.L = (float*)(ws + OFF_L); E.w0 = q.in[5]; E.a0 = q.in[7]; pg8::gemm_phase(wv, lds, 256, S, E); } break;
        case 4: phase_chunk_pre(wv, lds); break;
        case 5: for (int r2 = 0; r2 < (((DBL_MASK >> 16) & 1) ? 2 : 1); ++r2) phase_scan_seq(wv, lds);
                for (int r2 = 0; r2 < (((DBL_MASK >> 17) & 1) ? 2 : 1); ++r2) phase_dil_attn(wv, lds);
                for (int r2 = 0; r2 < (((DBL_MASK >> 18) & 1) ? 2 : 1); ++r2) phase_mem_attn(wv, lds); break;
        case 6: phase_post(wv); break;
        case 7: { pg8::DenseOrder S; S.init(ws + OFF_YCAT, ws + OFF_PCAT, NTOK, 1024, 1280); EpiMixCat E; E.mixbf = (bf16_t*)(ws + OFF_MIXBF); E.GF = (const bf16_t*)(ws + OFF_GF); E.tid = (wv << 6) | lane_id(); pg8::gemm_phase(wv, lds, 1280, S, E); } break;
        case 8: { pg8::DenseOrder S; S.init(ws + OFF_MIXBF, ws + OFF_WOT, NTOK, 1024, 1024); EpiX1 E; E.x = q.in[0]; E.out = q.out; pg8::gemm_phase(wv, lds, 1024, S, E); } break;
        case 9: phase_router(wv, lds, rep + 1 == (((DBL_MASK >> ph) & 1) ? 2 : 1)); break;
        case 10: phase_dispatch(wv, lds, rep + 1 == (((DBL_MASK >> ph) & 1) ? 2 : 1)); break;
        case 11: { build_tables(wv, lds); SchedMoe<true> S; S.A = (const char*)(ws + OFF_XN2); S.Bt = (const char*)(ws + OFF_W1T); S.tstart = (const LAS int*)(lds + LX_TSTART); S.stok = (const int*)(ws + OFF_STOK); S.lgN = 3; S.total = S.tstart[32] * 8; S.estride = (size_t)2048 * 1024; S.tbytes = (size_t)256 * 1024;
                   EpiSwiglu E; E.act = ws + OFF_ACT; E.b1 = q.in[29]; pg8::gemm_phase<EpiSwiglu, SchedMoe<true>, 1>(wv, lds, 1024, S, E); } break;
        case 12: { build_tables(wv, lds); SchedMoe<false> S; S.A = (const char*)(ws + OFF_ACT); S.Bt = (const char*)(ws + OFF_W2T); S.tstart = (const LAS int*)(lds + LX_TSTART); S.stok = nullptr; S.lgN = 2; S.total = S.tstart[32] * 4; S.estride = (size_t)1024 * 1024; S.tbytes = (size_t)256 * 1024;
                   EpiYs E; E.ys = (bf16_t*)(ws + OFF_YS); E.b2 = q.in[31]; pg8::gemm_phase<EpiYs, SchedMoe<false>, 1>(wv, lds, 1024, S, E); } break;
        case 13: phase_combine(wv, rep + 1 == (((DBL_MASK >> ph) & 1) ? 2 : 1)); break;
        default: break;
        }
      }
        if (ph + 1 < p.ph_hi) xcd_barrier(xb, wv);
        if (((DBL_MASK >> 20) & 1) && ph == 3 && multi) for (int e = 0; e < 10; ++e) xcd_barrier(xb, wv);
    }
}

extern "C" void kernel_launch(void* const* d_in, const int* in_sizes, int n_in, void* d_out, int out_size, void* d_ws, size_t ws_size, hipStream_t stream) {
    static int ready = 0;
    if (ready == 0) {
        if (n_in != 32 || out_size != NTOK * 1024 || ws_size < WS_NEED) { fprintf(stderr, "kernel_launch: unexpected shapes (n_in %d, out %d, ws %zu < %zu)\n", n_in, out_size, ws_size, (size_t)WS_NEED); ready = -1; return; }
        if (hipFuncSetAttribute((const void*)mk_fwd, hipFuncAttributeMaxDynamicSharedMemorySize, LDS_BYTES) != hipSuccess) { fprintf(stderr, "kernel_launch: hipFuncSetAttribute failed\n"); ready = -1; return; }
        int per_cu = 0, dev = 0, cus = 0; hipGetDevice(&dev); hipDeviceGetAttribute(&cus, hipDeviceAttributeMultiprocessorCount, dev);
        hipOccupancyMaxActiveBlocksPerMultiprocessor(&per_cu, (const void*)mk_fwd, 512, LDS_BYTES);
        if (per_cu < 1 || cus < 256) { fprintf(stderr, "kernel_launch: occupancy %d blocks/CU on %d CUs; need >= 1 on 256\n", per_cu, cus); ready = -1; (void)hipGetLastError(); return; }
        ready = 1;
    }
    if (ready < 0) return;
    hipMemsetAsync((char*)d_ws + OFF_CTL, 0, CTL_BYTES, stream);
    Params p{};
    for (int i = 0; i < 32; ++i) p.in[i] = (const float*)d_in[i];
    p.out = (float*)d_out; p.ws = (unsigned char*)d_ws;
#if MK_N_LAUNCH_PER_PHASE
    for (int ph = 0; ph < NPHASE; ++ph) { p.ph_lo = ph; p.ph_hi = ph + 1; hipLaunchKernelGGL(mk_fwd, dim3(256), dim3(512), LDS_BYTES, stream, p); }
#else
    p.ph_lo = 0; p.ph_hi = NPHASE;
    void* args[] = {&p};
    hipError_t e = hipLaunchCooperativeKernel((const void*)mk_fwd, dim3(256), dim3(512), args, LDS_BYTES, stream);
    if (e != hipSuccess) fprintf(stderr, "cooperative launch failed: %s\n", hipGetErrorString(e));
#endif
}
```

```cpp
#include <hip/hip_runtime.h>
#include <cstdio>
#include <cstdint>

#define LAS __attribute__((address_space(3)))
typedef unsigned short bf16_t;
typedef short bf16x8 __attribute__((ext_vector_type(8)));
typedef short s16x4 __attribute__((ext_vector_type(4)));
typedef float f32x4 __attribute__((ext_vector_type(4)));
typedef float f32x2 __attribute__((ext_vector_type(2)));
typedef unsigned u32x4 __attribute__((ext_vector_type(4)));
typedef unsigned u32x2 __attribute__((ext_vector_type(2)));
typedef int i32x8 __attribute__((ext_vector_type(8)));
typedef int i32x4 __attribute__((ext_vector_type(4)));

#ifndef DBL_MASK
#define DBL_MASK 0
#endif
#ifndef MK_N_LAUNCH_PER_PHASE
#define MK_N_LAUNCH_PER_PHASE 0
#endif

constexpr int NTOK = 16384, SEQ = 2048, INC = 7680;
constexpr int C_K = 512, C_V = 1024, C_ZW = 1536, C_DQ = 1792, C_DK = 2560, C_DV = 3328, C_MQ = 4096, C_GATE = 4608;
constexpr int NPHASE = 14;
constexpr int NSLOT_MAX = 65536 + 32 * 256;

constexpr size_t MiB = 1ull << 20;
constexpr size_t OFF_CTL = 0;
constexpr size_t CTL_BYTES = 32768;
constexpr size_t CTL_CNT = 16384;
constexpr size_t CTL_CUR = 16384 + 256;
constexpr size_t OFF_TOPE = 1 * MiB;
constexpr size_t OFF_TOPG = 1 * MiB + 262144;
constexpr size_t OFF_SLOT = 1 * MiB + 524288;
constexpr size_t OFF_STOK = 2 * MiB;
constexpr size_t OFF_WRT = 3 * MiB;
constexpr size_t OFF_WINT = 4 * MiB, OFF_WMKVT = 19 * MiB, OFF_LORAT = 21 * MiB, OFF_PRT = 22 * MiB, OFF_PDT = 23 * MiB, OFF_PMT = 24 * MiB, OFF_WOT = 25 * MiB;
constexpr size_t OFF_WIN8 = 8 * MiB;
constexpr size_t OFF_H8 = 539 * MiB;
constexpr size_t OFF_YCAT = 223 * MiB;
constexpr size_t OFF_PCAT = 22 * MiB;
constexpr size_t OFF_W1T = 27 * MiB, OFF_W2T = 155 * MiB, OFF_KV = 219 * MiB, OFF_YM = 223 * MiB, OFF_YR = 239 * MiB, OFF_YD = 255 * MiB, OFF_Z = 263 * MiB;
constexpr size_t OFF_H = 503 * MiB, OFF_HM = 535 * MiB, OFF_ALORA = 503 * MiB, OFF_L = 511 * MiB, OFF_REC = 607 * MiB;
constexpr size_t OFF_GF = OFF_REC;
constexpr size_t OFF_LW = OFF_REC + 64 * MiB;
constexpr size_t OFF_VB = OFF_REC + 96 * MiB;
constexpr size_t OFF_GTF = OFF_REC + 112 * MiB;
constexpr size_t OFF_RTF = OFF_REC + 144 * MiB;
constexpr size_t OFF_HHF = OFF_REC + 160 * MiB;
constexpr size_t OFF_YLF = OFF_REC + 192 * MiB;
constexpr size_t OFF_C1 = 816 * MiB, OFF_C2 = 832 * MiB, OFF_YRAW = 848 * MiB, OFF_DILO = 880 * MiB, OFF_LSE = 928 * MiB;
constexpr size_t OFF_MIX32 = 503 * MiB, OFF_MIXBF = 567 * MiB, OFF_XN2 = 503 * MiB, OFF_XS = 263 * MiB, OFF_ACT = 607 * MiB, OFF_YS = 407 * MiB;
constexpr size_t OFF_X1B = 263 * MiB;
constexpr size_t WS_NEED = 929 * MiB;

constexpr int LDS_BYTES = 160 * 1024;
constexpr int LDS_X = LDS_BYTES - 4096;
constexpr int LX_TSTART = LDS_X + 64;
constexpr int LX_SBASE = LDS_X + 256;
constexpr int LX_CNT = LDS_X + 512;
constexpr int LX_HIST = LDS_X + 768;
constexpr int LX_BBASE = LDS_X + 1024;
constexpr int LX_SLOTL = LDS_X + 2048;
constexpr int LX_TEXP = LDS_X + 3072;

struct Params { const float* in[32]; float* out; unsigned char* ws; int ph_lo, ph_hi; };
typedef const Params __attribute__((address_space(4))) KParams;
__device__ __forceinline__ KParams* kparams() { KParams* kp = (KParams*)__builtin_amdgcn_kernarg_segment_ptr(); asm volatile("" : "+s"(kp)); return kp; }

typedef __bf16 bf16x2_t __attribute__((ext_vector_type(2)));
__device__ __forceinline__ unsigned cvt_pk_bf16(float lo, float hi) { f32x2 v = {lo, hi}; bf16x2_t b = __builtin_convertvector(v, bf16x2_t); unsigned r; __builtin_memcpy(&r, &b, 4); return r; }
__device__ __forceinline__ unsigned pack4_fp8(float a, float b, float c, float d) { int r = __builtin_amdgcn_cvt_pk_fp8_f32(a, b, 0, false); r = __builtin_amdgcn_cvt_pk_fp8_f32(c, d, r, true); return (unsigned)r; }
__device__ __forceinline__ float bf_lo(unsigned u) { return __uint_as_float(u << 16); }
__device__ __forceinline__ float bf_hi(unsigned u) { return __uint_as_float(u & 0xffff0000u); }
__device__ __forceinline__ int lane_id() { int l; asm volatile("v_mbcnt_lo_u32_b32 %0, -1, 0\n\tv_mbcnt_hi_u32_b32 %0, -1, %0" : "=v"(l)); return l; }
__device__ __forceinline__ int sxor(int x, int m) { return __builtin_amdgcn_ds_bpermute((lane_id() ^ m) << 2, x); }
__device__ __forceinline__ float sxor(float x, int m) { return __int_as_float(__builtin_amdgcn_ds_bpermute((lane_id() ^ m) << 2, __float_as_int(x))); }
template <int CTRL> __device__ __forceinline__ float dpp_f(float x) { return __int_as_float(__builtin_amdgcn_update_dpp(0, __float_as_int(x), CTRL, 0xF, 0xF, true)); }
__device__ __forceinline__ float red4(float x) { x += dpp_f<0xB1>(x); x += dpp_f<0x4E>(x); return x; }
__device__ __forceinline__ float red8(float x) { x = red4(x); x += dpp_f<0x141>(x); return x; }
__device__ __forceinline__ float red16(float x) { x = red8(x); x += dpp_f<0x140>(x); return x; }
__device__ __forceinline__ float red64(float x) { x = red16(x); x += sxor(x, 16); x += sxor(x, 32); return x; }
__device__ __forceinline__ int opaque_tid(const int wv) { int t = (wv << 6) | lane_id(); asm volatile("" : "+v"(t)); return t; }
__device__ __forceinline__ f32x4 zero4f() { float z = 0.f; asm volatile("" : "+v"(z)); return (f32x4){z, z, z, z}; }
__device__ __forceinline__ u32x4 zero4u() { unsigned z = 0u; asm volatile("" : "+v"(z)); return (u32x4){z, z, z, z}; }
__device__ __forceinline__ float sigmoidf_(float x) { return __builtin_amdgcn_rcpf(1.0f + __builtin_amdgcn_exp2f(-1.44269504f * x)); }
__device__ __forceinline__ void unpack8(const u32x4 v, float (&f)[8]) { f[0] = bf_lo(v.x); f[1] = bf_hi(v.x); f[2] = bf_lo(v.y); f[3] = bf_hi(v.y); f[4] = bf_lo(v.z); f[5] = bf_hi(v.z); f[6] = bf_lo(v.w); f[7] = bf_hi(v.w); }
__device__ __forceinline__ u32x4 pack8(const float (&f)[8]) { u32x4 w; w.x = cvt_pk_bf16(f[0], f[1]); w.y = cvt_pk_bf16(f[2], f[3]); w.z = cvt_pk_bf16(f[4], f[5]); w.w = cvt_pk_bf16(f[6], f[7]); return w; }
__device__ __forceinline__ float sumsq8(const u32x4 v) { float f[8]; unpack8(v, f); float s = 0.f;
#pragma unroll
    for (int j = 0; j < 8; ++j) s += f[j] * f[j];
    return s; }
__device__ __forceinline__ u32x4 scale8(const u32x4 v, const float rs, const float* w) { float f[8]; unpack8(v, f); const f32x4 w0 = *(const f32x4*)w, w1 = *(const f32x4*)(w + 4);
    f[0] *= rs * w0[0]; f[1] *= rs * w0[1]; f[2] *= rs * w0[2]; f[3] *= rs * w0[3]; f[4] *= rs * w1[0]; f[5] *= rs * w1[1]; f[6] *= rs * w1[2]; f[7] *= rs * w1[3]; return pack8(f); }
__device__ __forceinline__ u32x4 scale8r(const u32x4 v, const float rs, const float (&w)[8]) { float f[8]; unpack8(v, f);
#pragma unroll
    for (int j = 0; j < 8; ++j) f[j] *= rs * w[j];
    return pack8(f); }
__device__ __forceinline__ u32x4 scale8s(const u32x4 v, const float rs) { float f[8]; unpack8(v, f);
#pragma unroll
    for (int j = 0; j < 8; ++j) f[j] *= rs;
    return pack8(f); }
__device__ __forceinline__ void unpack4(const u32x2 v, float (&f)[4]) { f[0] = bf_lo(v.x); f[1] = bf_hi(v.x); f[2] = bf_lo(v.y); f[3] = bf_hi(v.y); }

#define XB_TMO      128
#define XB_XCNT(j)  (256  + 64 * (j))
#define XB_XSUB(j)  (1280 + 64 * (j))
#define XB_XGEN(j)  (2304 + 64 * (j))
#define XB_TOP      3328
#define XB_TOPGEN   3392
#define XCD_BAR_WORDS 3456
#define XB_SPIN_CAP (1u << 22)
__device__ __forceinline__ unsigned xb_ld(unsigned* p)              { return __hip_atomic_load(p, __ATOMIC_RELAXED, __HIP_MEMORY_SCOPE_AGENT); }
__device__ __forceinline__ unsigned xb_add(unsigned* p, unsigned v) { return __hip_atomic_fetch_add(p, v, __ATOMIC_RELAXED, __HIP_MEMORY_SCOPE_AGENT); }
__device__ __forceinline__ unsigned xb_xcc_id() { return (unsigned)__builtin_amdgcn_s_getreg((3 << 11) | 20) & 0xFu; }
#define XB_SPIN(cond, bar) do { unsigned _sp = 0; while (cond) { __builtin_amdgcn_s_sleep(1); \
    if ((++_sp & 255u) == 0u) { if (xb_ld(&(bar)[XB_TMO])) break; if (_sp > XB_SPIN_CAP) { atomicAdd(&(bar)[XB_TMO], 1u); break; } } } } while (0)
struct XcdBarrier { unsigned* bar; unsigned x; volatile LAS unsigned* st; };
__device__ __forceinline__ XcdBarrier xcd_barrier_post(unsigned* bar, volatile LAS unsigned* st, const int wv) {
    XcdBarrier b; b.bar = bar; b.x = xb_xcc_id(); b.st = st;
    if (wv == 0 && lane_id() == 0) (void)xb_add(&bar[XB_XCNT(b.x)], 1u);
    return b;
}
__device__ __forceinline__ void xcd_barrier_complete(unsigned* bar, unsigned x, unsigned& nloc, unsigned& nx) {
    const unsigned G = gridDim.x * gridDim.y * gridDim.z;
    unsigned sum, cnt, mine, sp = 0u;
    for (;;) {
        sum = 0u; cnt = 0u; mine = 0u;
#pragma unroll
        for (unsigned j = 0; j < 16; ++j) { const unsigned c = xb_ld(&bar[XB_XCNT(j)]); sum += c; cnt += (c > 0u) ? 1u : 0u; mine = (j == x) ? c : mine; }
        if (sum == G) break;
        __builtin_amdgcn_s_sleep(1);
        if ((++sp & 255u) == 0u) { if (xb_ld(&bar[XB_TMO])) break; if (sp > XB_SPIN_CAP) { atomicAdd(&bar[XB_TMO], 1u); break; } }
    }
    nloc = mine > 0u ? mine : 1u; nx = cnt > 0u ? cnt : 1u;
}
__device__ __forceinline__ void xcd_barrier(const XcdBarrier& b, const int wv) {
    asm volatile("s_waitcnt vmcnt(0)" ::: "memory");
    __syncthreads();
    if (wv == 0 && lane_id() == 0) {
        unsigned* bar = b.bar;
        __builtin_amdgcn_s_waitcnt(0);
        unsigned nloc = b.st[0], nx = b.st[1];
        if (nloc == 0u) { xcd_barrier_complete(bar, b.x, nloc, nx); b.st[0] = nloc; b.st[1] = nx; }
        const unsigned old = xb_add(&bar[XB_XSUB(b.x)], 1u);
        const unsigned gen = old / nloc;
        if (old + 1u == (gen + 1u) * nloc) {
            __builtin_amdgcn_fence(__ATOMIC_RELEASE, "agent");
            asm volatile("s_waitcnt vmcnt(0)" ::: "memory");
            const unsigned og = xb_add(&bar[XB_TOP], 1u);
            const unsigned tg = og / nx;
            if (og + 1u == (tg + 1u) * nx) xb_add(&bar[XB_TOPGEN], 1u);
            else XB_SPIN(xb_ld(&bar[XB_TOPGEN]) == tg, bar);
            __builtin_amdgcn_fence(__ATOMIC_ACQUIRE, "agent");
            xb_add(&bar[XB_XGEN(b.x)], 1u);
            asm volatile("s_waitcnt vmcnt(0)" ::: "memory");
        } else {
            XB_SPIN(xb_ld(&bar[XB_XGEN(b.x)]) == gen, bar);
            __builtin_amdgcn_fence(__ATOMIC_ACQUIRE, "agent");
            asm volatile("s_waitcnt vmcnt(0)" ::: "memory");
        }
    }
    __syncthreads();
}

#ifndef MFMA_BENCH
#define MFMA_BENCH 0
#endif
#ifndef EDBL
#define EDBL 0
#endif
#ifndef KMODE
#define KMODE 0
#endif
#ifndef KDBL
#define KDBL 0
#endif
struct EpiSwiglu; struct EpiYs; struct EpiZ; struct EpiMixCat; struct EpiX1;
namespace pg8 {
constexpr int BM = 256, BK = 64, HALF = 128, HTB = HALF * BK * 2, STAGE_BYTES = 8 * HTB, NXCD = 8, WGM = 8;
__host__ __device__ __forceinline__ int lds_byte(int r, int c) { const int st = (r >> 4) * 2 + (c >> 5), rr = r & 15, cc = c & 31, ob = rr * 64 + cc * 2; return st * 1024 + (ob ^ (((ob >> 9) & 1) << 5)); }
__host__ __device__ __forceinline__ void stage_rc(int b, int& R, int& C) { const int st = b / 1024, sb = b % 1024, swz = sb ^ (((sb >> 9) & 1) << 5); R = (st >> 1) * 16 + swz / 64; C = (st & 1) * 32 + (swz % 64) / 2; }
__host__ __device__ __forceinline__ int perm32(int rho) { const int n = rho >> 4, i = rho & 15; return 8 * (i >> 2) + 4 * n + (i & 3); }
struct Unit { int pm, pn, tag; const char* pa; const char* pb; };

__device__ __forceinline__ void static_map(long L, int nM, int nN, int& pm, int& pn) {
    const int nwg = nM * nN; int wgid = (int)L;
    { const int q = nwg / NXCD, r = nwg % NXCD, xcd = wgid % NXCD, off = wgid / NXCD; wgid = (xcd < r ? xcd * (q + 1) : r * (q + 1) + (xcd - r) * q) + off; }
    const int nig = WGM * nN, gid = wgid / nig, fm = gid * WGM, gsz = (nM - fm) < WGM ? (nM - fm) : WGM;
    pm = fm + ((wgid % nig) % gsz); pn = (wgid % nig) / gsz;
}
struct DenseOrder {
    static constexpr bool GATHER = false; __device__ __forceinline__ unsigned a_off(const Unit&, int, int, int, int) const { return 0u; }
    const char* A; const char* Bt; int nM, nN, G, c; size_t tstep;
    __device__ __forceinline__ void init(const void* A_, const void* Bt_, int M, int N, int K) { A = (const char*)A_; Bt = (const char*)Bt_; nM = M / BM; nN = N / BM; G = gridDim.x; c = blockIdx.x; tstep = (size_t)BM * K * 2; }
    __device__ __forceinline__ bool next(int i, Unit& u) const {
        const long L = (long)i * G + c; if (L >= (long)nM * nN) return false;
        static_map(L, nM, nN, u.pm, u.pn); u.tag = 0; u.pa = A + (size_t)u.pm * tstep; u.pb = Bt + (size_t)u.pn * tstep; return true;
    }
};

template <int H> __device__ __forceinline__ bf16x8 half8(const i32x8 v) { const i32x4 x = H ? __builtin_shufflevector(v, v, 4, 5, 6, 7) : __builtin_shufflevector(v, v, 0, 1, 2, 3); bf16x8 r; __builtin_memcpy(&r, &x, 16); return r; }
template <class Epi, class Sched, int ES = 2>
__device__ __forceinline__ void gemm_phase(const int wv, LAS unsigned char* lds, const int K, const Sched& S, const Epi& E) {
    int tid_ = (wv << 6) | lane_id(); asm volatile("" : "+v"(tid_));
    const int tid = tid_, wid = __builtin_amdgcn_readfirstlane(tid >> 6), lane = tid & 63, wr = wid >> 2, wc = wid & 3, fr = lane & 15, fq = lane >> 4;
    const int nt = K * ES / (BK * 2);
    unsigned voffA[2], voffB[2]; int RA[2], CA[2];
#pragma unroll
    for (int i = 0; i < 2; ++i) { int R, C; stage_rc(tid * 16 + i * 8192, R, C); const int Rb = Epi::PERM ? ((R & ~31) + perm32(R & 31)) : R; RA[i] = R; CA[i] = C;
        voffA[i] = (unsigned)(R * K * ES + C * 2); voffB[i] = (unsigned)(Rb * K * ES + C * 2); }
    unsigned vA[2][2][2];
    const size_t kstep = (size_t)(BK * 2);
    const size_t hstep = (size_t)HALF * K * ES;
    const unsigned ldsw = (unsigned)wid * 1024u;
    const int aoff = lds_byte(wr * 64 + fr, fq * 8), boff = lds_byte(wc * 32 + fr, fq * 8);
#define PG8_SA(b, h) (((b) * 2 + (h)) * HTB)
#define PG8_SB(b, h) ((4 + (b) * 2 + (h)) * HTB)
#define PG8_STAGE(bufoff, gbase, voff) do { _Pragma("unroll") for (int _i = 0; _i < 2; ++_i) \
        __builtin_amdgcn_global_load_lds((const unsigned*)((const char*)(gbase) + (voff)[_i]), (LAS unsigned*)(lds + (bufoff) + ldsw + _i * 8192), 16, 0, 0); } while (0)
#define PG8_LDA(dst, b, h) do { _Pragma("unroll") for (int m = 0; m < 4; ++m) { const i32x4 _lo = *(const LAS i32x4*)(lds + PG8_SA(b, h) + aoff + m * 2048), _hi = *(const LAS i32x4*)(lds + PG8_SA(b, h) + aoff + m * 2048 + 1024); dst[m] = __builtin_shufflevector(_lo, _hi, 0, 1, 2, 3, 4, 5, 6, 7); } } while (0)
#define PG8_LDB(dst, b, h) do { _Pragma("unroll") for (int n = 0; n < 2; ++n) { const i32x4 _lo = *(const LAS i32x4*)(lds + PG8_SB(b, h) + boff + n * 2048), _hi = *(const LAS i32x4*)(lds + PG8_SB(b, h) + boff + n * 2048 + 1024); dst[n] = __builtin_shufflevector(_lo, _hi, 0, 1, 2, 3, 4, 5, 6, 7); } } while (0)
#define PG8_MMA(ai, bj, At, Bt) do { __builtin_amdgcn_s_setprio(1); _Pragma("unroll") for (int m = 0; m < 4; ++m) _Pragma("unroll") for (int n = 0; n < 2; ++n) { \
        if (ES == 2) { acc[ai][bj][m][n] = __builtin_amdgcn_mfma_f32_16x16x32_bf16(half8<0>(Bt[n]), half8<0>(At[m]), acc[ai][bj][m][n], 0, 0, 0); \
                       acc[ai][bj][m][n] = __builtin_amdgcn_mfma_f32_16x16x32_bf16(half8<1>(Bt[n]), half8<1>(At[m]), acc[ai][bj][m][n], 0, 0, 0); } \
        else asm volatile("v_mfma_scale_f32_16x16x128_f8f6f4 %0, %1, %2, %0, %3, %3 op_sel_hi:[0,0,0]" : "+v"(acc[ai][bj][m][n]) : "v"(Bt[n]), "v"(At[m]), "v"(one_scale)); } \
        __builtin_amdgcn_s_setprio(0); } while (0)
#define PG8_WAIT_V(n) asm volatile("s_waitcnt vmcnt(" #n ")" ::: "memory")
#define PG8_WAIT_L(n) asm volatile("s_waitcnt lgkmcnt(" #n ")" ::: "memory")
#define PG8_BAR __builtin_amdgcn_s_barrier()
#define PG8_SCHED __builtin_amdgcn_sched_barrier(0)
    constexpr int kd = (KDBL == 1 && (__is_same(Epi, EpiSwiglu) || __is_same(Epi, EpiYs))) || (KDBL == 2 && __is_same(Epi, EpiZ)) || (KDBL == 3 && (__is_same(Epi, EpiMixCat) || __is_same(Epi, EpiX1))) ? 1 : 0;
    Unit cur, nxt; int ui = 0;
    if (!S.next(0, cur)) return;
    f32x4 acc[2][2][4][2]; const f32x4 zz0 = zero4f();
#pragma unroll
    for (int a = 0; a < 2; ++a)
#pragma unroll
        for (int b = 0; b < 2; ++b)
#pragma unroll
            for (int m = 0; m < 4; ++m)
#pragma unroll
                for (int n = 0; n < 2; ++n) acc[a][b][m][n] = zz0;
    i32x8 At[4], B0[2], B1[2];
    const int one_scale = 0x7f7f7f7f;
    const char* cA = cur.pa; const char* cB = cur.pb;
#pragma unroll
    for (int h = 0; h < 2; ++h)
#pragma unroll
        for (int i = 0; i < 2; ++i) vA[0][h][i] = Sched::GATHER ? S.a_off(cur, h, RA[i], CA[i], K * ES) : voffA[i] + (unsigned)(h * hstep);
    if constexpr (kd && KMODE == 1) { cA = S.A; cB = S.Bt;
#pragma unroll
        for (int h = 0; h < 2; ++h)
#pragma unroll
            for (int i = 0; i < 2; ++i) vA[0][h][i] = voffA[i] + (unsigned)(h * hstep); }
    PG8_STAGE(PG8_SB(0, 0), cB, voffB); PG8_STAGE(PG8_SA(0, 0), cA, vA[0][0]); PG8_STAGE(PG8_SB(0, 1), cB + hstep, voffB); PG8_STAGE(PG8_SA(0, 1), cA, vA[0][1]);
    if (wr == 1) PG8_BAR;
    PG8_WAIT_V(4); PG8_BAR;
    PG8_STAGE(PG8_SB(1, 0), cB + kstep, voffB); PG8_STAGE(PG8_SA(1, 0), cA + kstep, vA[0][0]); PG8_STAGE(PG8_SB(1, 1), cB + hstep + kstep, voffB);
    PG8_WAIT_V(6); PG8_BAR;
    for (;;) {
        const bool has_next = S.next((ui + 1) >> kd, nxt);
        const char* nA = has_next ? nxt.pa : cA; const char* nB = has_next ? nxt.pb : cB;
#pragma unroll
        for (int h = 0; h < 2; ++h)
#pragma unroll
            for (int i = 0; i < 2; ++i) vA[1][h][i] = has_next ? (Sched::GATHER ? S.a_off(nxt, h, RA[i], CA[i], K * ES) : voffA[i] + (unsigned)(h * hstep)) : vA[0][h][i];
        if constexpr (kd && KMODE == 1) { if (has_next && (ui & 1)) { nA = S.A; nB = S.Bt;
#pragma unroll
            for (int h = 0; h < 2; ++h)
#pragma unroll
                for (int i = 0; i < 2; ++i) vA[1][h][i] = voffA[i] + (unsigned)(h * hstep); } }
        const bool ld = !(kd && KMODE == 2 && !(ui & 1));
#pragma clang loop unroll(disable)
        for (int t = 0; t < nt; t += 2) {
            if constexpr (Epi::MID) { if (t == 8 || t == 12) E.mid(acc, cur, t, wr, wc, fr, fq); }
            const bool last = (t == nt - 2);
            const char* a1 = cA + (size_t)(t + 1) * kstep;
            const char* a2 = last ? nA : cA + (size_t)(t + 2) * kstep; const char* b2 = last ? nB : cB + (size_t)(t + 2) * kstep;
            const char* a3 = a2 + kstep; const char* b3 = b2 + kstep;
            unsigned w0[2], w1[2];
#pragma unroll
            for (int i = 0; i < 2; ++i) { w0[i] = vA[0][0][i]; w1[i] = vA[0][1][i]; }
            if (last) { asm volatile("" ::: "memory");
#pragma unroll
                for (int i = 0; i < 2; ++i) { w0[i] = vA[1][0][i]; w1[i] = vA[1][1][i]; } }
            PG8_LDB(B0, 0, 0); PG8_SCHED; PG8_LDA(At, 0, 0); if (ld) PG8_STAGE(PG8_SA(1, 1), a1, vA[0][1]);
            PG8_WAIT_L(8); PG8_BAR; PG8_WAIT_L(0); PG8_MMA(0, 0, At, B0); PG8_BAR; PG8_SCHED;
            PG8_LDB(B1, 0, 1); if (ld || last) PG8_STAGE(PG8_SB(0, 0), b2, voffB);
            PG8_BAR; PG8_WAIT_L(0); PG8_MMA(0, 1, At, B1); PG8_BAR;
            PG8_LDA(At, 0, 1); if (ld || last) PG8_STAGE(PG8_SA(0, 0), a2, w0);
            PG8_BAR; PG8_WAIT_L(0); PG8_MMA(1, 0, At, B0); PG8_BAR; PG8_SCHED;
            if (ld || last) PG8_STAGE(PG8_SB(0, 1), b2 + hstep, voffB);
            PG8_WAIT_V(6); PG8_BAR; PG8_MMA(1, 1, At, B1); PG8_BAR;
            PG8_LDB(B0, 1, 0); PG8_SCHED; PG8_LDA(At, 1, 0); if (ld || last) PG8_STAGE(PG8_SA(0, 1), a2, w1);
            PG8_WAIT_L(8); PG8_BAR; PG8_WAIT_L(0); PG8_MMA(0, 0, At, B0); PG8_BAR; PG8_SCHED;
            PG8_LDB(B1, 1, 1); if (ld || last) PG8_STAGE(PG8_SB(1, 0), b3, voffB);
            PG8_BAR; PG8_WAIT_L(0); PG8_MMA(0, 1, At, B1); PG8_BAR;
            PG8_LDA(At, 1, 1); if (ld || last) PG8_STAGE(PG8_SA(1, 0), a3, w0);
            PG8_BAR; PG8_WAIT_L(0); PG8_MMA(1, 0, At, B0); PG8_BAR; PG8_SCHED;
            if (ld || last) PG8_STAGE(PG8_SB(1, 1), b3 + hstep, voffB);
            PG8_WAIT_V(6); PG8_BAR; PG8_MMA(1, 1, At, B1); PG8_BAR;
        }
        if (ES == 1) asm volatile("s_nop 15\n\ts_nop 15" ::: "memory");
        if (!kd || (ui & 1)) E(acc, cur, wr, wc, fr, fq);
        if constexpr (EDBL == 1 && (__is_same(Epi, EpiSwiglu) || __is_same(Epi, EpiYs))) { asm volatile("" ::: "memory"); E(acc, cur, wr, wc, fr, fq); }
        if (!has_next) break;
        const f32x4 zz1 = zero4f();
#pragma unroll
        for (int a = 0; a < 2; ++a)
#pragma unroll
            for (int b = 0; b < 2; ++b)
#pragma unroll
                for (int m = 0; m < 4; ++m)
#pragma unroll
                    for (int n = 0; n < 2; ++n) acc[a][b][m][n] = zz1;
        cur = nxt; cA = nA; cB = nB; ++ui;
#pragma unroll
        for (int h = 0; h < 2; ++h)
#pragma unroll
            for (int i = 0; i < 2; ++i) vA[0][h][i] = vA[1][h][i];
    }
    PG8_WAIT_V(0);
    if (wr == 0) PG8_BAR;
    PG8_BAR;
#undef PG8_SA
#undef PG8_SB
#undef PG8_STAGE
#undef PG8_LDA
#undef PG8_LDB
#undef PG8_MMA
#undef PG8_WAIT_V
#undef PG8_WAIT_L
#undef PG8_BAR
#undef PG8_SCHED
}
}
using pg8::Unit;

struct EpiZ {
    static constexpr bool PERM = true, MID = false;
    bf16_t* Z; bf16_t* KV; bf16_t* GFp; int pn0; float scale;
    __device__ __forceinline__ void operator()(const f32x4 (&acc)[2][2][4][2], const Unit& u, int wr, int wc, int fr, int fq) const {
        const bool kvu = u.pn >= 32; const int pn = (u.pn & 31) + (kvu ? 0 : pn0);
        bf16_t* base = kvu ? KV : Z; const int ldc = kvu ? 1024 : INC; const bool sg = (!kvu) && (pn >= C_GATE / 256);
        if (sg) {
            bf16_t* gf = GFp + ((size_t)(u.pm * 12 + (pn - C_GATE / 256)) * 16) * 4096 + (size_t)((wr * 4 + wc) * 64 + fq * 16 + fr) * 8;
#pragma unroll
            for (int ai = 0; ai < 2; ++ai)
#pragma unroll
                for (int m = 0; m < 4; ++m)
#pragma unroll
                    for (int bj = 0; bj < 2; ++bj) { f32x4 v0 = acc[ai][bj][m][0] * scale, v1 = acc[ai][bj][m][1] * scale;
#pragma unroll
                        for (int j = 0; j < 4; ++j) { v0[j] = sigmoidf_(v0[j]); v1[j] = sigmoidf_(v1[j]); }
                        u32x4 w; w.x = cvt_pk_bf16(v0[0], v0[1]); w.y = cvt_pk_bf16(v0[2], v0[3]); w.z = cvt_pk_bf16(v1[0], v1[1]); w.w = cvt_pk_bf16(v1[2], v1[3]);
                        *(u32x4*)(gf + (size_t)((ai * 4 + m) * 2 + bj) * 4096) = w; }
            return; }
        const int row0 = u.pm * 256 + wr * 64 + fr, col0 = pn * 256 + wc * 32 + 8 * fq;
#pragma unroll
        for (int ai = 0; ai < 2; ++ai)
#pragma unroll
            for (int m = 0; m < 4; ++m) { bf16_t* rowp = base + (size_t)(row0 + ai * 128 + m * 16) * ldc + col0;
#pragma unroll
                for (int bj = 0; bj < 2; ++bj) { f32x4 v0 = acc[ai][bj][m][0] * scale, v1 = acc[ai][bj][m][1] * scale;
                    if (sg) {
#pragma unroll
                        for (int j = 0; j < 4; ++j) { v0[j] = sigmoidf_(v0[j]); v1[j] = sigmoidf_(v1[j]); } }
                    u32x4 w; w.x = cvt_pk_bf16(v0[0], v0[1]); w.y = cvt_pk_bf16(v0[2], v0[3]); w.z = cvt_pk_bf16(v1[0], v1[1]); w.w = cvt_pk_bf16(v1[2], v1[3]);
                    *(u32x4*)(rowp + bj * 128) = w; } }
    }
};
struct SchedZ8 {
    static constexpr bool GATHER = false; __device__ __forceinline__ unsigned a_off(const Unit&, int, int, int, int) const { return 0u; }
    const char* H8; const char* WIN8; int G, c;
    __device__ __forceinline__ bool next(int i, Unit& u) const {
        const long L = (long)i * G + c; if (L >= 64 * 23) return false;
        pg8::static_map(L, 64, 23, u.pm, u.pn); u.tag = 0; u.pa = H8 + (size_t)u.pm * (256 * 1024); u.pb = WIN8 + (size_t)u.pn * (256 * 1024); return true;
    }
};
struct SchedZ {
    static constexpr bool GATHER = false; __device__ __forceinline__ unsigned a_off(const Unit&, int, int, int, int) const { return 0u; }
    const char* H; const char* WinT; const char* HM; const char* WmkvT; int G, c;
    __device__ __forceinline__ bool next(int i, Unit& u) const {
        const long L = (long)i * G + c; if (L >= 480) return false;
        const size_t tstep = (size_t)256 * 1024 * 2;
        if (L < 448) { pg8::static_map(L, 64, 7, u.pm, u.pn); u.tag = 0; u.pa = H + (size_t)u.pm * tstep; u.pb = WinT + (size_t)u.pn * tstep; }
        else { const int q = (int)(L - 448); u.pm = q >> 2; u.pn = 32 + (q & 3); u.tag = 0; u.pa = HM + (size_t)u.pm * tstep; u.pb = WmkvT + (size_t)(q & 3) * tstep; }
        return true;
    }
};
struct EpiLora {
    static constexpr bool PERM = false, MID = false;
    float* L; const float* w0; const float* a0;
    __device__ __forceinline__ void operator()(const f32x4 (&acc)[2][2][4][2], const Unit& u, int wr, int wc, int fr, int fq) const {
        const int row0 = u.pm * 256 + wr * 64 + fr, col0 = u.pn * 256 + wc * 32 + 4 * fq; const int kind = u.pn >> 1; const f32x4 zb = zero4f();
#pragma unroll
        for (int bj = 0; bj < 2; ++bj)
#pragma unroll
            for (int n = 0; n < 2; ++n) { const int c = col0 + bj * 128 + n * 16;
                f32x4 bv = zb;
                if (kind == 0) bv = *(const f32x4*)(w0 + c); else if (kind == 1) bv = *(const f32x4*)(a0 + (c - 512));
#pragma unroll
                for (int ai = 0; ai < 2; ++ai)
#pragma unroll
                    for (int m = 0; m < 4; ++m) { f32x4 v = acc[ai][bj][m][n] + bv;
                        if (kind == 0) {
#pragma unroll
                            for (int j = 0; j < 4; ++j) v[j] = -0.60653066f * sigmoidf_(v[j]); }
                        else if (kind == 1) {
#pragma unroll
                            for (int j = 0; j < 4; ++j) v[j] = sigmoidf_(v[j]); }
                        const size_t row = (size_t)(row0 + ai * 128 + m * 16);
                        if (kind == 0) *(f32x4*)(L + row * 512 + c) = v;
                        else { u32x2 w; w.x = cvt_pk_bf16(v[0], v[1]); w.y = cvt_pk_bf16(v[2], v[3]); *(u32x2*)((bf16_t*)(L + (size_t)NTOK * 512) + row * 1024 + (c - 512)) = w; } } }
    }
};
template <int mode> struct EpiMix {
    static constexpr bool PERM = false, MID = false;
    float* mix32; bf16_t* mixbf; const bf16_t* Z;
    __device__ __forceinline__ void operator()(const f32x4 (&acc)[2][2][4][2], const Unit& u, int wr, int wc, int fr, int fq) const {
        const int row0 = u.pm * 256 + wr * 64 + fr, col0 = u.pn * 256 + wc * 32 + 4 * fq;
#pragma unroll
        for (int ai = 0; ai < 2; ++ai)
#pragma unroll
            for (int m = 0; m < 4; ++m) { const size_t row = (size_t)(row0 + ai * 128 + m * 16);
#pragma unroll
                for (int bj = 0; bj < 2; ++bj)
#pragma unroll
                    for (int n = 0; n < 2; ++n) { const int c = col0 + bj * 128 + n * 16;
                        const u32x2 gz = *(const u32x2*)(Z + row * INC + C_GATE + mode * 1024 + c); float g[4]; unpack4(gz, g);
                        f32x4 v = acc[ai][bj][m][n]; v[0] *= g[0]; v[1] *= g[1]; v[2] *= g[2]; v[3] *= g[3];
                        if (mode > 0) v += *(const f32x4*)(mix32 + row * 1024 + c);
                        if (mode < 2) *(f32x4*)(mix32 + row * 1024 + c) = v;
                        else { u32x2 w; w.x = cvt_pk_bf16(v[0], v[1]); w.y = cvt_pk_bf16(v[2], v[3]); *(u32x2*)(mixbf + row * 1024 + c) = w; } }
                asm volatile("" ::: "memory"); }
    }
};
struct EpiMixCat {
    static constexpr bool PERM = true, MID = true;
    bf16_t* mixbf; const bf16_t* GF; int tid;
    __device__ __forceinline__ const bf16_t* gtile(const Unit& u, int b) const { return GF + ((size_t)(u.pm * 12 + 4 * b + u.pn) * 16) * 4096 + (size_t)tid * 8; }
    __device__ __forceinline__ void mid(f32x4 (&acc)[2][2][4][2], const Unit& u, int t, int wr, int wc, int fr, int fq) const {
        const int ga = (t == 8) ? 0 : 1; int off = 0; asm volatile("" : "+v"(off));
        const bf16_t* pa = gtile(u, ga) + off; const bf16_t* pb = gtile(u, ga + 1) + off;
#pragma unroll
        for (int ai = 0; ai < 2; ++ai) {
#pragma unroll
            for (int m = 0; m < 4; ++m)
#pragma unroll
                for (int bj = 0; bj < 2; ++bj) { float a[8], b[8]; unpack8(*(const u32x4*)(pa + (size_t)((ai * 4 + m) * 2 + bj) * 4096), a); unpack8(*(const u32x4*)(pb + (size_t)((ai * 4 + m) * 2 + bj) * 4096), b);
#pragma unroll
                    for (int j = 0; j < 4; ++j) { acc[ai][bj][m][0][j] *= a[j] * __builtin_amdgcn_rcpf(b[j]); acc[ai][bj][m][1][j] *= a[4 + j] * __builtin_amdgcn_rcpf(b[4 + j]); } }
            asm volatile("" ::: "memory"); }
    }
    __device__ __forceinline__ void operator()(const f32x4 (&acc)[2][2][4][2], const Unit& u, int wr, int wc, int fr, int fq) const {
        const int row0 = u.pm * 256 + wr * 64 + fr, col0 = u.pn * 256 + wc * 32 + 8 * fq; const bf16_t* pg = gtile(u, 2);
#pragma unroll
        for (int ai = 0; ai < 2; ++ai)
#pragma unroll
            for (int m = 0; m < 4; ++m) { bf16_t* rowp = mixbf + (size_t)(row0 + ai * 128 + m * 16) * 1024 + col0;
#pragma unroll
                for (int bj = 0; bj < 2; ++bj) { float g[8]; unpack8(*(const u32x4*)(pg + (size_t)((ai * 4 + m) * 2 + bj) * 4096), g);
                    const f32x4 v0 = acc[ai][bj][m][0], v1 = acc[ai][bj][m][1];
                    u32x4 w; w.x = cvt_pk_bf16(v0[0] * g[0], v0[1] * g[1]); w.y = cvt_pk_bf16(v0[2] * g[2], v0[3] * g[3]); w.z = cvt_pk_bf16(v1[0] * g[4], v1[1] * g[5]); w.w = cvt_pk_bf16(v1[2] * g[6], v1[3] * g[7]);
                    *(u32x4*)(rowp + bj * 128) = w; } }
    }
};
struct EpiX1 {
    static constexpr bool PERM = true, MID = false;
    const float* x; bf16_t* x1;
    __device__ __forceinline__ void operator()(const f32x4 (&acc)[2][2][4][2], const Unit& u, int wr, int wc, int fr, int fq) const {
        const int row0 = u.pm * 256 + wr * 64 + fr, col0 = u.pn * 256 + wc * 32 + 8 * fq;
#pragma unroll
        for (int ai = 0; ai < 2; ++ai)
#pragma unroll
            for (int m = 0; m < 4; ++m) { const size_t off = (size_t)(row0 + ai * 128 + m * 16) * 1024 + col0;
#pragma unroll
                for (int bj = 0; bj < 2; ++bj) { const f32x4 a = __builtin_nontemporal_load((const f32x4*)(x + off + bj * 128)) + acc[ai][bj][m][0], b = __builtin_nontemporal_load((const f32x4*)(x + off + bj * 128 + 4)) + acc[ai][bj][m][1];
                    u32x4 w; w.x = cvt_pk_bf16(a[0], a[1]); w.y = cvt_pk_bf16(a[2], a[3]); w.z = cvt_pk_bf16(b[0], b[1]); w.w = cvt_pk_bf16(b[2], b[3]);
                    *(u32x4*)(x1 + off + bj * 128) = w; }
                if (m & 1) asm volatile("" ::: "memory"); }
    }
};
struct EpiSwiglu {
    static constexpr bool PERM = true, MID = false;
    unsigned char* act; const float* b1;
    __device__ __forceinline__ void operator()(const f32x4 (&acc)[2][2][4][2], const Unit& u, int wr, int wc, int fr, int fq) const {
        const int row0 = u.pm * 256 + wr * 64 + fr; const float* be = b1 + (size_t)u.tag * 2048; const int j = 128 * u.pn + 32 * wc + 8 * fq;
        float bg[8], bl[8];
#pragma unroll
        for (int q = 0; q < 4; ++q) { const f32x4 t = *(const f32x4*)(be + 2 * j + 4 * q); bg[2 * q] = t[0]; bl[2 * q] = t[1]; bg[2 * q + 1] = t[2]; bl[2 * q + 1] = t[3]; }
#pragma unroll
        for (int ai = 0; ai < 2; ++ai)
#pragma unroll
            for (int m = 0; m < 4; ++m) { float o[8];
#pragma unroll
                for (int n = 0; n < 2; ++n)
#pragma unroll
                    for (int i = 0; i < 4; ++i) { const float xg = fminf(acc[ai][0][m][n][i] * (1.0f / 256.0f) + bg[4 * n + i], 7.0f); const float xl = fminf(fmaxf(acc[ai][1][m][n][i] * (1.0f / 256.0f) + bl[4 * n + i], -7.0f), 7.0f);
                        o[4 * n + i] = xg * __builtin_amdgcn_rcpf(1.0f + __builtin_amdgcn_exp2f(xg * (-1.702f * 1.44269504f))) * fmaf(xl, 4.0f, 4.0f); }
                u32x2 w; w.x = pack4_fp8(o[0], o[1], o[2], o[3]); w.y = pack4_fp8(o[4], o[5], o[6], o[7]);
                *(u32x2*)(act + (size_t)(row0 + ai * 128 + m * 16) * 1024 + j) = w; }
    }
};
struct EpiYs {
    static constexpr bool PERM = true, MID = false;
    bf16_t* ys; const float* b2;
    __device__ __forceinline__ void operator()(const f32x4 (&acc)[2][2][4][2], const Unit& u, int wr, int wc, int fr, int fq) const {
        const int row0 = u.pm * 256 + wr * 64 + fr, col0 = u.pn * 256 + wc * 32 + 8 * fq; const float* be = b2 + (size_t)u.tag * 1024;
#pragma unroll
        for (int bj = 0; bj < 2; ++bj) { const f32x4 c0 = *(const f32x4*)(be + col0 + bj * 128), c1 = *(const f32x4*)(be + col0 + bj * 128 + 4);
#pragma unroll
            for (int ai = 0; ai < 2; ++ai)
#pragma unroll
                for (int m = 0; m < 4; ++m) { const f32x4 v0 = acc[ai][bj][m][0] * (1.0f / 128.0f) + c0, v1 = acc[ai][bj][m][1] * (1.0f / 128.0f) + c1;
                    u32x4 w; w.x = cvt_pk_bf16(v0[0], v0[1]); w.y = cvt_pk_bf16(v0[2], v0[3]); w.z = cvt_pk_bf16(v1[0], v1[1]); w.w = cvt_pk_bf16(v1[2], v1[3]);
                    *(u32x4*)(ys + (size_t)(row0 + ai * 128 + m * 16) * 1024 + col0 + bj * 128) = w; } }
    }
};
template <bool GATHER_> struct SchedMoe {
    static constexpr bool GATHER = GATHER_;
    const char* A; const char* Bt; const LAS int* tstart; const int* stok; int lgN, total; size_t estride, tbytes;
    __device__ __forceinline__ bool next(int i, Unit& u) const {
        const int c = blockIdx.x; const int un = i * 256 + (c & 7) * 32 + (c >> 3); if (un >= total) return false;
        const int mt = un >> lgN, pn = un & ((1 << lgN) - 1); const int e = ((const LAS unsigned char*)tstart)[(LX_TEXP - LX_TSTART) + mt];
        u.pm = mt; u.pn = pn; u.tag = e; u.pa = GATHER ? A : A + (size_t)mt * tbytes; u.pb = Bt + (size_t)e * estride + (size_t)pn * tbytes; return true;
    }
    __device__ __forceinline__ unsigned a_off(const Unit& u, int h, int R, int C, int rowbytes) const { const int tok = stok[u.pm * 256 + h * 128 + R]; return (unsigned)(tok * rowbytes + C * 2); }
};

__device__ __forceinline__ int w1perm(int c) { const int j = c >> 1, s = c & 1; return ((j >> 7) << 8) | (s << 7) | (j & 127); }
__device__ __forceinline__ void phase_prep(const int wv, LAS unsigned char* lds) {
    KParams& p = *kparams();
    const int tid = opaque_tid(wv); unsigned char* ws = p.ws;
    LAS float* tile = (LAS float*)lds;
    struct TileJob { const float* src; bf16_t* dst; unsigned char* dst8; int K, N, perm, f8, ldd, k0, n0; };
    auto decode = [&](int t) -> TileJob { TileJob j; j.dst = nullptr; j.dst8 = nullptr; j.f8 = 0; j.perm = 0; j.ldd = 0; int lt;
        if (t < 960) { j.src = p.in[3]; j.dst = (bf16_t*)(ws + OFF_WINT); j.K = 1024; j.N = 7680; lt = t; if ((lt % 120) >= 28) { j.f8 = 1; j.dst8 = ws + OFF_WIN8 - (size_t)1792 * 1024; } }
        else if (t < 1088) { j.src = p.in[18]; j.dst = (bf16_t*)(ws + OFF_WMKVT); j.K = 1024; j.N = 1024; lt = t - 960; }
        else if (t < 1152) { j.src = p.in[21]; j.dst = (bf16_t*)(ws + OFF_PCAT); j.K = 512; j.N = 1024; lt = t - 1088; j.ldd = 1280; }
        else if (t < 1184) { j.src = p.in[22]; j.dst = (bf16_t*)(ws + OFF_PCAT) + 512; j.K = 256; j.N = 1024; lt = t - 1152; j.ldd = 1280; }
        else if (t < 1248) { j.src = p.in[23]; j.dst = (bf16_t*)(ws + OFF_PCAT) + 768; j.K = 512; j.N = 1024; lt = t - 1184; j.ldd = 1280; }
        else if (t < 1376) { j.src = p.in[24]; j.dst = (bf16_t*)(ws + OFF_WOT); j.K = 1024; j.N = 1024; lt = t - 1248; }
        else if (t < 9568) { const int q = t - 1376, e = q >> 8; j.src = p.in[28] + (size_t)e * 1024 * 2048; j.dst8 = ws + OFF_W1T + (size_t)e * 2048 * 1024; j.K = 1024; j.N = 2048; j.perm = 1; lt = q & 255; j.f8 = 1; }
        else { const int q = t - 9568, e = q >> 7; j.src = p.in[30] + (size_t)e * 1024 * 1024; j.dst8 = ws + OFF_W2T + (size_t)e * 1024 * 1024; j.K = 1024; j.N = 1024; lt = q & 127; j.f8 = 1; }
        const int tn = j.N >> 6; j.k0 = (lt / tn) * 128; j.n0 = (lt % tn) * 64; return j; };
    { const int G = (int)gridDim.x; int t = 13663 - (int)blockIdx.x;
      auto ldtile = [&](const TileJob& j, f32x4 (&v)[4]) {
#pragma unroll
          for (int i = 0; i < 4; ++i) { const int idx = tid + 512 * i, row = idx >> 4, c4 = idx & 15; v[i] = __builtin_nontemporal_load((const f32x4*)(j.src + (size_t)(j.k0 + row) * j.N + j.n0 + 4 * c4)); } };
      TileJob j0 = decode(t < 0 ? 0 : t), j1 = decode(t - G < 0 ? 0 : t - G); f32x4 v0[4], v1[4];
      if (t >= 0) ldtile(j0, v0);
      if (t - G >= 0) ldtile(j1, v1);
      for (; t >= 0; t -= G) {
#pragma unroll
          for (int i = 0; i < 4; ++i) { const int idx = tid + 512 * i, row = idx >> 4, c4 = idx & 15; LAS float* tp = tile + row * 65 + 4 * c4; tp[0] = v0[i][0]; tp[1] = v0[i][1]; tp[2] = v0[i][2]; tp[3] = v0[i][3]; }
          __syncthreads();
          const TileJob cur = j0; j0 = j1;
#pragma unroll
          for (int i = 0; i < 4; ++i) v0[i] = v1[i];
          if (t - 2 * G >= 0) { j1 = decode(t - 2 * G); ldtile(j1, v1); }
          if (!cur.f8) {
#pragma unroll
              for (int i = 0; i < 2; ++i) { const int kc = (tid & 3) | (((tid >> 8) & 1) << 2) | (i << 3), n = (tid >> 2) & 63; float f[8];
#pragma unroll
                  for (int j = 0; j < 8; ++j) f[j] = tile[(kc * 8 + j) * 65 + n];
                  const int drow = cur.n0 + n;
                  *(u32x4*)(cur.dst + (size_t)drow * (cur.ldd ? cur.ldd : cur.K) + cur.k0 + kc * 8) = pack8(f); }
          } else {
              const int kc = (tid & 3) | (((tid >> 8) & 1) << 2), n = (tid >> 2) & 63; float f[16];
#pragma unroll
              for (int j = 0; j < 16; ++j) f[j] = tile[(kc * 16 + j) * 65 + n] * 32.0f;
              const int drow = cur.perm ? w1perm(cur.n0 + n) : (cur.n0 + n);
              u32x4 w; w.x = pack4_fp8(f[0], f[1], f[2], f[3]); w.y = pack4_fp8(f[4], f[5], f[6], f[7]); w.z = pack4_fp8(f[8], f[9], f[10], f[11]); w.w = pack4_fp8(f[12], f[13], f[14], f[15]);
              *(u32x4*)(cur.dst8 + (size_t)drow * cur.K + cur.k0 + kc * 16) = w; }
          __syncthreads(); } }
    { const float* w2 = p.in[6]; const float* a2 = p.in[8]; const float* g2 = p.in[9]; bf16_t* lt = (bf16_t*)(ws + OFF_LORAT);
      for (int idx = blockIdx.x * 512 + tid; idx < 1536 * 32; idx += gridDim.x * 512) { const int n = idx >> 5, kc = idx & 31; float f[8];
#pragma unroll
          for (int j = 0; j < 8; ++j) { const int k = kc * 8 + j; float val = 0.f;
              if (n < 512) { if (k < 64) val = w2[k * 512 + n]; }
              else if (n < 1024) { if (k >= 64 && k < 128) val = a2[(k - 64) * 512 + (n - 512)]; }
              else { if (k >= 128) val = g2[(k - 128) * 512 + (n - 1024)]; }
              f[j] = val; }
          *(u32x4*)(lt + (size_t)n * 256 + kc * 8) = pack8(f); } }
    { const float* wr = p.in[26]; bf16_t* wt = (bf16_t*)(ws + OFF_WRT);
      for (int idx = blockIdx.x * 512 + tid; idx < 32 * 1024; idx += gridDim.x * 512) { const int e = idx >> 10, k = idx & 1023; const float v = wr[k * 32 + e];
          const unsigned hi = cvt_pk_bf16(v, 0.f) & 0xffffu; const float vh = __uint_as_float(hi << 16); const unsigned lo = cvt_pk_bf16(v - vh, 0.f) & 0xffffu;
          wt[idx] = (bf16_t)hi; wt[32768 + idx] = (bf16_t)lo; } }
    { const int wid = tid >> 6, lane = tid & 63; const int gw = blockIdx.x * 8 + wid, nw = gridDim.x * 8;
      for (int row0 = gw; row0 < NTOK + 2048; row0 += 3 * nw) {
          f32x4 v[3][4];
#pragma unroll
          for (int r3 = 0; r3 < 3; ++r3) { const int row = row0 + r3 * nw; if (row < NTOK + 2048) { const float* src = row >= NTOK ? p.in[1] + (size_t)(row - NTOK) * 1024 : p.in[0] + (size_t)row * 1024;
#pragma unroll
              for (int i = 0; i < 4; ++i) v[r3][i] = __builtin_nontemporal_load((const f32x4*)(src + 4 * lane + 256 * i)); } }
#pragma unroll
          for (int r3 = 0; r3 < 3; ++r3) { const int row = row0 + r3 * nw; if (row >= NTOK + 2048) break;
              const bool ism = row >= NTOK; const float* gain = ism ? p.in[17] : p.in[2]; bf16_t* dst = ism ? (bf16_t*)(ws + OFF_HM) + (size_t)(row - NTOK) * 1024 : (bf16_t*)(ws + OFF_H) + (size_t)row * 1024;
              float ss = 0.f;
#pragma unroll
              for (int i = 0; i < 4; ++i) ss += v[r3][i][0] * v[r3][i][0] + v[r3][i][1] * v[r3][i][1] + v[r3][i][2] * v[r3][i][2] + v[r3][i][3] * v[r3][i][3];
              ss = red64(ss); const float rs = rsqrtf(ss * (1.0f / 1024.0f) + 1e-5f);
#pragma unroll
              for (int i = 0; i < 4; ++i) { const f32x4 g = *(const f32x4*)(gain + 4 * lane + 256 * i); const f32x4 y = v[r3][i] * rs * g;
                  u32x2 w; w.x = cvt_pk_bf16(y[0], y[1]); w.y = cvt_pk_bf16(y[2], y[3]);
                  *(u32x2*)(dst + 4 * lane + 256 * i) = w;
                  if (!ism) *(unsigned*)(ws + OFF_H8 + (size_t)row * 1024 + 4 * lane + 256 * i) = pack4_fp8(y[0] * 8.0f, y[1] * 8.0f, y[2] * 8.0f, y[3] * 8.0f); } } }
    }
}

__device__ __forceinline__ void phase_elem_c(const int wv) {
    KParams& p = *kparams();
    const int gt = blockIdx.x * 512 + opaque_tid(wv), nthr = gridDim.x * 512; unsigned char* ws = p.ws;
    bf16_t* Z = (bf16_t*)(ws + OFF_Z); bf16_t* AL = (bf16_t*)(ws + OFF_ALORA); bf16_t* KV = (bf16_t*)(ws + OFF_KV);
    const float* mu = p.in[4];
    u32x4 za[4], zb[4]; const u32x4 zq0 = zero4u();
#pragma unroll
    for (int k = 0; k < 4; ++k) { const int idx = gt + k * nthr, t = idx >> 5, ch = idx & 31, col = C_ZW + 8 * ch;
        za[k] = *(const u32x4*)(Z + (size_t)t * INC + col);
        zb[k] = zq0; if ((t & (SEQ - 1)) != 0) zb[k] = *(const u32x4*)(Z + (size_t)(t - 1) * INC + col); }
#pragma unroll
    for (int k = 0; k < 4; ++k) { const int idx = gt + k * nthr, t = idx >> 5, ch = idx & 31, col = C_ZW + 8 * ch;
        float a[8], b[8]; unpack8(za[k], a); unpack8(zb[k], b);
        const f32x4 m0 = *(const f32x4*)(mu + col), m1 = *(const f32x4*)(mu + col + 4); const float mm[8] = {m0[0], m0[1], m0[2], m0[3], m1[0], m1[1], m1[2], m1[3]};
#pragma unroll
        for (int j = 0; j < 8; ++j) { float v = a[j] + (b[j] - a[j]) * mm[j]; if (ch < 8) v = tanhf(v); else if (ch >= 16) v = sigmoidf_(v); a[j] = v; }
        *(u32x4*)(AL + (size_t)t * 256 + 8 * ch) = pack8(a); }
}

__device__ __forceinline__ bf16x8 pack_frag(const f32x4 lo, const f32x4 hi) { u32x4 w; w.x = cvt_pk_bf16(lo[0], lo[1]); w.y = cvt_pk_bf16(lo[2], lo[3]); w.z = cvt_pk_bf16(hi[0], hi[1]); w.w = cvt_pk_bf16(hi[2], hi[3]); bf16x8 r; __builtin_memcpy(&r, &w, 16); return r; }
__device__ __forceinline__ bf16x8 tr2(LAS unsigned char* pa, LAS unsigned char* pb) { const s16x4 a = __builtin_amdgcn_ds_read_tr16_b64_v4i16((LAS s16x4*)pa), b = __builtin_amdgcn_ds_read_tr16_b64_v4i16((LAS s16x4*)pb); return __builtin_shufflevector(a, b, 0, 1, 2, 3, 4, 5, 6, 7); }
__device__ __forceinline__ bf16x8 rd2(LAS unsigned char* pa, LAS unsigned char* pb) { const s16x4 a = *(const LAS s16x4*)pa, b = *(const LAS s16x4*)pb; return __builtin_shufflevector(a, b, 0, 1, 2, 3, 4, 5, 6, 7); }
#define MFMA16(a, b, c) __builtin_amdgcn_mfma_f32_16x16x32_bf16((a), (b), (c), 0, 0, 0)
constexpr int CP_XA = 0, CP_XR = 4096, CP_XB = 8192, CP_XK = 12288, CP_VL = 16384, CP_NL = 16384, CP_WAVE = 20480;
__device__ __forceinline__ void phase_chunk_pre(const int wv, LAS unsigned char* lds) {
    KParams& p = *kparams();
    const int tid = opaque_tid(wv), wid = tid >> 6, lane = tid & 63, fr = lane & 15, fq = lane >> 4; unsigned char* ws = p.ws;
    u32x4 keep = zero4u(); if (tid == 0) keep = *(const LAS u32x4*)(lds + LDS_X);
    __syncthreads();
    LAS unsigned char* wl = lds + wid * CP_WAVE;
    const bf16_t* Z = (const bf16_t*)(ws + OFF_Z); const float* L = (const float*)(ws + OFF_L); const bf16_t* AG = (const bf16_t*)(L + (size_t)NTOK * 512); bf16_t* C1 = (bf16_t*)(ws + OFF_C1); bf16_t* C2 = (bf16_t*)(ws + OFF_C2);
    const float* mu = p.in[4]; const float* k_k = p.in[10]; const float* k_a = p.in[11]; const float* r_k = p.in[12]; const float* ln_w = p.in[13]; const float* ln_b = p.in[14];
    const f32x4 z4 = zero4f();
    for (int pr = blockIdx.x * 8 + wid; pr < 4096; pr += gridDim.x * 8) {
        float gamC;
        { const int bh = pr >> 6, cc = pr & 63, b_ = bh >> 3, h_ = bh & 7; const int tok0 = b_ * SEQ + cc * 32; const int c = h_ * 64 + lane;
          const bf16_t* zp = Z + (size_t)tok0 * INC + c; const float* lp = L + (size_t)tok0 * 512 + c; const bf16_t* gp = AG + (size_t)tok0 * 1024 + c;
          const float mur = mu[c], muk = mu[C_K + c], muv = mu[C_V + c], kk_ = k_k[c], ka_ = k_a[c], rk_ = r_k[c], lnw = ln_w[c], lnb = ln_b[c];
          float pzr = 0.f, pzk = 0.f, pzv = 0.f;
          if (cc != 0) { pzr = __uint_as_float((unsigned)zp[-INC] << 16); pzk = __uint_as_float((unsigned)zp[-INC + C_K] << 16); pzv = __uint_as_float((unsigned)zp[-INC + C_V] << 16); }
          unsigned short zq[2][4][3], gq[2][4][2]; float lq[2][4];
#pragma unroll
          for (int e = 0; e < 4; ++e) {
#pragma unroll
              for (int q = 0; q < 3; ++q) zq[0][e][q] = zp[(size_t)e * INC + q * 512];
              lq[0][e] = lp[(size_t)e * 512]; gq[0][e][0] = gp[(size_t)e * 1024]; gq[0][e][1] = gp[(size_t)e * 1024 + 512]; }
          __builtin_amdgcn_sched_barrier(0);
          float cs = 0.f, g = 1.0f;
#pragma unroll
          for (int t4 = 0; t4 < 8; ++t4) { unsigned pa[2], pr_[2], pb[2], pk[2];
              if (t4 < 7) {
#pragma unroll
                  for (int e = 0; e < 4; ++e) {
#pragma unroll
                      for (int q = 0; q < 3; ++q) zq[(t4 + 1) & 1][e][q] = zp[(size_t)((t4 + 1) * 4 + e) * INC + q * 512];
                      lq[(t4 + 1) & 1][e] = lp[(size_t)((t4 + 1) * 4 + e) * 512]; gq[(t4 + 1) & 1][e][0] = gp[(size_t)((t4 + 1) * 4 + e) * 1024]; gq[(t4 + 1) & 1][e][1] = gp[(size_t)((t4 + 1) * 4 + e) * 1024 + 512]; } }
              __builtin_amdgcn_sched_barrier(0);
#pragma unroll
              for (int tp = 0; tp < 2; ++tp) { float va[2], vr[2], vb[2], vk[2];
#pragma unroll
                  for (int e = 0; e < 2; ++e) { const int te = tp * 2 + e, t = t4 * 4 + te;
                      const float zr = __uint_as_float((unsigned)zq[t4 & 1][te][0] << 16), zk = __uint_as_float((unsigned)zq[t4 & 1][te][1] << 16), zv = __uint_as_float((unsigned)zq[t4 & 1][te][2] << 16);
                      const float r = zr + (pzr - zr) * mur, k = zk + (pzk - zk) * muk, v = zv + (pzv - zv) * muv; pzr = zr; pzk = zk; pzv = zv;
                      const float lw = lq[t4 & 1][te], al = __uint_as_float((unsigned)gq[t4 & 1][te][0] << 16), gg = __uint_as_float((unsigned)gq[t4 & 1][te][1] << 16);
                      const float kk = k * kk_, kp = k * (1.0f + (al - 1.0f) * ka_);
                      const float n2 = red64(kk * kk), bon = red64(r * kp * rk_);
                      const float kn = kk * __builtin_amdgcn_rsqf(fmaxf(n2, 1e-24f));
                      const float gm1 = g; cs += lw; g = __builtin_amdgcn_exp2f(cs * 1.44269504f); const float gi = __builtin_amdgcn_rcpf(g);
                      va[e] = -kn * gm1; vb[e] = kn * al * gi; vk[e] = kp * gi; vr[e] = r * g;
                      *(LAS bf16_t*)(wl + CP_VL + t * 128 + lane * 2) = (bf16_t)(cvt_pk_bf16(v, 0.f) & 0xffffu);
                      const size_t to = (size_t)(tok0 + t) * 512 + c;
                      C1[to] = (bf16_t)(cvt_pk_bf16(lnw * gg, 0.f) & 0xffffu); C2[to] = (bf16_t)(cvt_pk_bf16((lnb + bon * v) * gg, 0.f) & 0xffffu); }
                  pa[tp] = cvt_pk_bf16(va[0], va[1]); pr_[tp] = cvt_pk_bf16(vr[0], vr[1]); pb[tp] = cvt_pk_bf16(vb[0], vb[1]); pk[tp] = cvt_pk_bf16(vk[0], vk[1]); }
              *(LAS u32x2*)(wl + CP_XA + lane * 64 + t4 * 8) = (u32x2){pa[0], pa[1]}; *(LAS u32x2*)(wl + CP_XR + lane * 64 + t4 * 8) = (u32x2){pr_[0], pr_[1]};
              *(LAS u32x2*)(wl + CP_XB + lane * 64 + t4 * 8) = (u32x2){pb[0], pb[1]}; *(LAS u32x2*)(wl + CP_XK + lane * 64 + t4 * 8) = (u32x2){pk[0], pk[1]};
              __builtin_amdgcn_sched_barrier(0); }
          gamC = g; }
        asm volatile("s_waitcnt lgkmcnt(0)" ::: "memory");
        bf16x8 Vf[4];
        { const int vtb = (4 * fq + (fr >> 2)) * 128 + (fr & 3) * 8;
#pragma unroll
          for (int nv = 0; nv < 4; ++nv) { LAS unsigned char* pp = wl + CP_VL + vtb + nv * 32; Vf[nv] = tr2(pp, pp + 2048); } }
        asm volatile("s_waitcnt lgkmcnt(0)" ::: "memory");
        const int trb = (8 * fq + (fr >> 2)) * 64 + (fr & 3) * 8;
        bf16x8 LakF[2], QrbF[2], QrkF[2];
#pragma unroll
        for (int yi = 0; yi < 2; ++yi) {
            bf16x8 fy[2][2];
#pragma unroll
            for (int nt = 0; nt < 2; ++nt)
#pragma unroll
                for (int s2 = 0; s2 < 2; ++s2) { LAS unsigned char* pp = wl + (yi ? CP_XR : CP_XA) + trb + s2 * 2048 + nt * 32; fy[nt][s2] = tr2(pp, pp + 256); }
#pragma unroll
            for (int xi = 0; xi < 2; ++xi) {
                f32x4 d[2][2];
#pragma unroll
                for (int mi = 0; mi < 2; ++mi) { bf16x8 fx[2];
#pragma unroll
                    for (int s2 = 0; s2 < 2; ++s2) { LAS unsigned char* pp = wl + (xi ? CP_XK : CP_XB) + trb + s2 * 2048 + mi * 32; fx[s2] = tr2(pp, pp + 256); }
#pragma unroll
                    for (int nt = 0; nt < 2; ++nt) {
                        if (mi == 1 && nt == 0) { d[mi][nt] = z4; continue; }
                        f32x4 acc = MFMA16(fx[0], fy[nt][0], z4); acc = MFMA16(fx[1], fy[nt][1], acc);
#pragma unroll
                        for (int j = 0; j < 4; ++j) { const int i = 16 * mi + 4 * fq + j, t = 16 * nt + fr; const bool ok = yi ? (i <= t) : (i < t); acc[j] = ok ? acc[j] : 0.f; }
                        d[mi][nt] = acc; } }
                if (yi == 0 && xi == 0) {
#pragma unroll
                    for (int mi = 0; mi < 2; ++mi)
#pragma unroll
                        for (int nt = 0; nt < 2; ++nt)
#pragma unroll
                            for (int j = 0; j < 4; ++j) *(LAS float*)(wl + CP_NL + ((16 * nt + fr) * 32 + 16 * mi + 4 * fq + j) * 4) = d[mi][nt][j];
                } else {
#pragma unroll
                    for (int nt = 0; nt < 2; ++nt) { const bf16x8 f = pack_frag(d[0][nt], d[1][nt]); if (yi == 0) LakF[nt] = f; else if (xi == 0) QrbF[nt] = f; else QrkF[nt] = f; } } } }
        asm volatile("s_waitcnt lgkmcnt(0)" ::: "memory");
        bf16x8 InvF[2];
        { const int c = lane & 31; float X[32];
#pragma unroll
          for (int t = 0; t < 32; ++t) { float a0 = (t == c) ? 1.0f : 0.f, a1 = 0.f;
#pragma unroll
              for (int i4 = 0; i4 < (t + 3) / 4; ++i4) { const f32x4 nv = *(const LAS f32x4*)(wl + CP_NL + (t * 32 + 4 * i4) * 4);
#pragma unroll
                  for (int e = 0; e < 4; ++e) if (4 * i4 + e < t) { if (e & 1) a1 = fmaf(nv[e], X[4 * i4 + e], a1); else a0 = fmaf(nv[e], X[4 * i4 + e], a0); } }
              X[t] = a0 + a1; }
          asm volatile("s_waitcnt lgkmcnt(0)" ::: "memory");
#pragma unroll
          for (int t = 0; t < 32; ++t) *(LAS float*)(wl + CP_NL + (t * 32 + c) * 4) = X[t];
          asm volatile("s_waitcnt lgkmcnt(0)" ::: "memory");
#pragma unroll
          for (int n = 0; n < 2; ++n) { const f32x4 lo = *(const LAS f32x4*)(wl + CP_NL + ((16 * n + fr) * 32 + 4 * fq) * 4), hi = *(const LAS f32x4*)(wl + CP_NL + ((16 * n + fr) * 32 + 16 + 4 * fq) * 4); InvF[n] = pack_frag(lo, hi); } }
        bf16x8 UF[4], AhF[4];
#pragma unroll
        for (int nv = 0; nv < 4; ++nv) { const f32x4 w0 = MFMA16(LakF[0], Vf[nv], z4), w1 = MFMA16(LakF[1], Vf[nv], z4); const bf16x8 wf = pack_frag(w0, w1);
            const f32x4 u0 = MFMA16(InvF[0], wf, z4), u1 = MFMA16(InvF[1], wf, z4); UF[nv] = pack_frag(u0, u1); }
#pragma unroll
        for (int nc = 0; nc < 4; ++nc) { LAS unsigned char* pp = wl + CP_XA + (16 * nc + fr) * 64 + 8 * fq; const bf16x8 af = rd2(pp, pp + 32);
            const f32x4 h0 = MFMA16(InvF[0], af, z4), h1 = MFMA16(InvF[1], af, z4); AhF[nc] = pack_frag(h0, h1); }
        { f32x4 rt[4][2];
#pragma unroll
          for (int mc = 0; mc < 4; ++mc)
#pragma unroll
              for (int nt = 0; nt < 2; ++nt) { const s16x4 rr = __builtin_amdgcn_ds_read_tr16_b64_v4i16((LAS s16x4*)(wl + CP_XR + (16 * mc + 4 * fq + (fr >> 2)) * 64 + (fr & 3) * 8 + nt * 32));
                  f32x4 cin; cin[0] = __uint_as_float((unsigned)(unsigned short)rr[0] << 16); cin[1] = __uint_as_float((unsigned)(unsigned short)rr[1] << 16); cin[2] = __uint_as_float((unsigned)(unsigned short)rr[2] << 16); cin[3] = __uint_as_float((unsigned)(unsigned short)rr[3] << 16);
                  rt[mc][nt] = MFMA16(AhF[mc], QrbF[nt], cin); }
          bf16x8* RTF = (bf16x8*)(ws + OFF_RTF) + (size_t)pr * 256;
#pragma unroll
          for (int nt = 0; nt < 2; ++nt)
#pragma unroll
              for (int s2 = 0; s2 < 2; ++s2) RTF[(nt * 2 + s2) * 64 + lane] = pack_frag(rt[2 * s2][nt], rt[2 * s2 + 1][nt]); }
        { u32x2* YLF = (u32x2*)(ws + OFF_YLF) + (size_t)pr * 512;
#pragma unroll
          for (int nv = 0; nv < 4; ++nv)
#pragma unroll
              for (int mt = 0; mt < 2; ++mt) { f32x4 y = MFMA16(QrbF[mt], UF[nv], z4); y = MFMA16(QrkF[mt], Vf[nv], y);
                  u32x2 w; w.x = cvt_pk_bf16(y[0], y[1]); w.y = cvt_pk_bf16(y[2], y[3]); YLF[(nv * 2 + mt) * 64 + lane] = w; } }
        { bf16x8* GTF = (bf16x8*)(ws + OFF_GTF) + (size_t)pr * 512; u32x2* HHF = (u32x2*)(ws + OFF_HHF) + (size_t)pr * 1024;
#pragma unroll
          for (int nc = 0; nc < 4; ++nc) { LAS unsigned char* pp = wl + CP_XB + (16 * nc + fr) * 64 + 8 * fq; const bf16x8 bf_ = rd2(pp, pp + 32);
              LAS unsigned char* pk = wl + CP_XK + (16 * nc + fr) * 64 + 8 * fq; const bf16x8 kf_ = rd2(pk, pk + 32);
              const float gcol = __int_as_float(__builtin_amdgcn_ds_bpermute((16 * nc + fr) << 2, __float_as_int(gamC)));
              f32x4 gt[4];
#pragma unroll
              for (int mc = 0; mc < 4; ++mc) { f32x4 a = MFMA16(AhF[mc], bf_, z4);
#pragma unroll
                  for (int j = 0; j < 4; ++j) { if (mc == nc && 4 * fq + j == fr) a[j] += 1.0f; a[j] *= gcol; }
                  gt[mc] = a; }
              GTF[(nc * 2 + 0) * 64 + lane] = pack_frag(gt[0], gt[1]); GTF[(nc * 2 + 1) * 64 + lane] = pack_frag(gt[2], gt[3]);
              f32x4 grow;
#pragma unroll
              for (int j = 0; j < 4; ++j) grow[j] = __int_as_float(__builtin_amdgcn_ds_bpermute((16 * nc + 4 * fq + j) << 2, __float_as_int(gamC)));
#pragma unroll
              for (int nv = 0; nv < 4; ++nv) { f32x4 hh = MFMA16(bf_, UF[nv], z4); hh = MFMA16(kf_, Vf[nv], hh); hh = hh * grow;
                  u32x2 w; w.x = cvt_pk_bf16(hh[0], hh[1]); w.y = cvt_pk_bf16(hh[2], hh[3]); HHF[(nv * 4 + nc) * 64 + lane] = w; } } }
        asm volatile("s_waitcnt lgkmcnt(0)" ::: "memory");
    }
    __syncthreads();
    if (tid == 0) *(LAS u32x4*)(lds + LDS_X) = keep;
}
__device__ __forceinline__ void phase_scan_seq(const int wv, LAS unsigned char* lds) {
    KParams& p = *kparams();
    const int tid = opaque_tid(wv), wid = __builtin_amdgcn_readfirstlane(tid >> 6), lane = tid & 63, fr = lane & 15, fq = lane >> 4; unsigned char* ws = p.ws;
    if (blockIdx.x >= 64) return;
    const int bh = blockIdx.x, b = bh >> 3, h = bh & 7;
    const char* gG = (const char*)(ws + OFF_GTF) + (size_t)bh * 64 * 8192; const char* gR = (const char*)(ws + OFF_RTF) + (size_t)bh * 64 * 4096;
    const char* gH = (const char*)(ws + OFF_HHF) + (size_t)bh * 64 * 8192; const char* gY = (const char*)(ws + OFF_YLF) + (size_t)bh * 64 * 4096;
    constexpr int SLOT = 24576;
    if (wid >= 4) {
        const int w = wid - 4;
        auto issue = [&](int c) { LAS unsigned char* slot = lds + (c % 5) * SLOT;
#pragma unroll
            for (int i = 0; i < 6; ++i) { const int pc = w + 4 * i;
                const char* src = pc < 8 ? gG + (size_t)c * 8192 + pc * 1024 : pc < 12 ? gR + (size_t)c * 4096 + (pc - 8) * 1024 : pc < 20 ? gH + (size_t)c * 8192 + (pc - 12) * 1024 : gY + (size_t)c * 4096 + (pc - 20) * 1024;
                __builtin_amdgcn_global_load_lds((const unsigned*)(src + lane * 16), (LAS unsigned*)(slot + pc * 1024), 16, 0, 0); } };
        issue(0); issue(1); issue(2); issue(3);
        for (int c = 0; c < 64; ++c) {
            if (c < 60) asm volatile("s_waitcnt vmcnt(18)" ::: "memory"); else asm volatile("s_waitcnt vmcnt(0)" ::: "memory");
            __builtin_amdgcn_s_barrier();
            if (c + 4 < 64) issue(c + 4);
        }
        return; }
    const int nv = wid;
    float* Yraw = (float*)(ws + OFF_YRAW) + (size_t)b * SEQ * 512 + h * 64 + 16 * nv + fr;
    f32x4 T[4]; const f32x4 z4s = zero4f();
#pragma unroll
    for (int m = 0; m < 4; ++m) T[m] = z4s;
    for (int c = 0; c < 64; ++c) {
        __builtin_amdgcn_s_barrier();
        const LAS unsigned char* slot = lds + (c % 5) * SLOT + lane * 16;
        bf16x8 G[8], R[4]; u32x2 H[4], Y[2];
#pragma unroll
        for (int i = 0; i < 8; ++i) G[i] = *(const LAS bf16x8*)(slot + i * 1024);
#pragma unroll
        for (int i = 0; i < 4; ++i) R[i] = *(const LAS bf16x8*)(slot + 8192 + i * 1024);
#pragma unroll
        for (int i = 0; i < 4; ++i) H[i] = *(const LAS u32x2*)(lds + (c % 5) * SLOT + 12288 + (nv * 4 + i) * 512 + lane * 8);
#pragma unroll
        for (int i = 0; i < 2; ++i) Y[i] = *(const LAS u32x2*)(lds + (c % 5) * SLOT + 20480 + (nv * 2 + i) * 512 + lane * 8);
        const bf16x8 tf0 = pack_frag(T[0], T[1]), tf1 = pack_frag(T[2], T[3]);
#pragma unroll
        for (int nt = 0; nt < 2; ++nt) { f32x4 y; y[0] = bf_lo(Y[nt].x); y[1] = bf_hi(Y[nt].x); y[2] = bf_lo(Y[nt].y); y[3] = bf_hi(Y[nt].y);
            y = MFMA16(R[nt * 2], tf0, y); y = MFMA16(R[nt * 2 + 1], tf1, y);
#pragma unroll
            for (int j = 0; j < 4; ++j) Yraw[(size_t)(c * 32 + 16 * nt + 4 * fq + j) * 512] = y[j]; }
#pragma unroll
        for (int m = 0; m < 4; ++m) { f32x4 t; t[0] = bf_lo(H[m].x); t[1] = bf_hi(H[m].x); t[2] = bf_lo(H[m].y); t[3] = bf_hi(H[m].y);
            t = MFMA16(G[m * 2], tf0, t); t = MFMA16(G[m * 2 + 1], tf1, t); T[m] = t; }
        asm volatile("s_waitcnt lgkmcnt(0)" ::: "memory");
    }
}

__device__ __forceinline__ bf16x8 tr_pair(LAS unsigned char* pa, LAS unsigned char* pb, bool useB) {
    const s16x4 a = __builtin_amdgcn_ds_read_tr16_b64_v4i16((LAS s16x4*)pa);
    s16x4 b2 = (s16x4){0, 0, 0, 0};
    if (useB) b2 = __builtin_amdgcn_ds_read_tr16_b64_v4i16((LAS s16x4*)pb);
    return __builtin_shufflevector(a, b2, 0, 1, 2, 3, 4, 5, 6, 7);
}
__device__ __forceinline__ void phase_dil_attn(const int wv, LAS unsigned char* lds) {
    KParams& p = *kparams();
    const int tid = opaque_tid(wv), wid = tid >> 6, lane = tid & 63, fr = lane & 15, fq = lane >> 4; unsigned char* ws = p.ws;
    const bf16_t* Z = (const bf16_t*)(ws + OFF_Z); float* DILO = (float*)(ws + OFF_DILO); float* LSE = (float*)(ws + OFF_LSE);
    LAS unsigned char* kb = lds; LAS unsigned char* vb = lds + 32768; const float* qn = p.in[15]; const float* kn = p.in[16];
    float qkw[2][8];
#pragma unroll
    for (int ks = 0; ks < 2; ++ks)
#pragma unroll
        for (int j = 0; j < 8; ++j) qkw[ks][j] = qn[ks * 32 + 8 * fq + j] * kn[ks * 32 + 8 * fq + j];
    const bool seqwg = blockIdx.x < 64;
    const int u0 = seqwg ? 4 * (int)blockIdx.x : 256 + (int)blockIdx.x - 64, uend = seqwg ? 4 * (int)blockIdx.x + 4 : 1536, ustep = seqwg ? 1 : 192;
    auto umap = [&](int v) -> int { if (seqwg) return v; const int c2 = (int)blockIdx.x - 64, x = c2 & 7, y = c2 >> 3, i = (v - u0) / 192, k = 24 * i + y; return 256 + (k >> 3) * 64 + 8 * x + (k & 7); };
    const int ki = tid >> 1, half = tid & 1;
    u32x4 kvA[4], vvA[4], qvA[2], kvB[4], vvB[4], qvB[2]; bool kvalidA = false, kvalidB = false;
    auto unit_load = [&](int uv, u32x4 (&kv)[4], u32x4 (&vv)[4], u32x4 (&qv)[2], bool& kvalid) { const int u = umap(uv);
        const int b = u / 192, rem = u % 192, hh = rem >> 4, qb = rem & 15, g = hh >> 2;
        const int dil = g == 0 ? 1 : (g == 1 ? 4 : 16), nbc = 16 / dil, r = qb / nbc, j0 = (qb % nbc) * 128;
        const bf16_t* Zb = Z + (size_t)b * SEQ * INC; const int kj = j0 - 128 + ki; kvalid = kj >= 0;
        { const bf16_t* rowp = Zb + (size_t)((kvalid ? kj : 0) * dil + r) * INC + hh * 64 + half * 32;
#pragma unroll
            for (int i = 0; i < 4; ++i) { kv[i] = *(const u32x4*)(rowp + C_DK + 8 * i); vv[i] = *(const u32x4*)(rowp + C_DV + 8 * i); } }
        const int tq = (j0 + 16 * wid + fr) * dil + r;
#pragma unroll
        for (int ks = 0; ks < 2; ++ks) qv[ks] = *(const u32x4*)(Zb + (size_t)tq * INC + C_DQ + hh * 64 + ks * 32 + 8 * fq); };
    auto do_unit = [&](const int uvv, u32x4 (&kv)[4], u32x4 (&vv)[4], u32x4 (&qv)[2], bool& kvalid) { const int u = umap(uvv); const int uv_ = uvv;
        const int b = u / 192, rem = u % 192, hh = rem >> 4, qb = rem & 15, g = hh >> 2, hg = hh & 3;
        const int dil = g == 0 ? 1 : (g == 1 ? 4 : 16), nbc = 16 / dil, r = qb / nbc, j0 = (qb % nbc) * 128;
        { if (kvalid) {
              float ss = sumsq8(kv[0]) + sumsq8(kv[1]) + sumsq8(kv[2]) + sumsq8(kv[3]); ss += dpp_f<0xB1>(ss);
              const float rs = rsqrtf(ss * (1.0f / 64.0f) + 1e-5f);
#pragma unroll
              for (int i = 0; i < 4; ++i) kv[i] = scale8s(kv[i], rs); }
          else { const u32x4 zu = zero4u();
#pragma unroll
              for (int i = 0; i < 4; ++i) { kv[i] = zu; vv[i] = zu; } }
#pragma unroll
          for (int i = 0; i < 4; ++i) { const int sw = (half * 4 + i) ^ (ki & 7); *(LAS u32x4*)(kb + ki * 128 + sw * 16) = kv[i]; *(LAS u32x4*)(vb + ki * 128 + sw * 16) = vv[i]; } }
        const int qi = 16 * wid + fr, tq = (j0 + qi) * dil + r;
        bf16x8 qf[2];
        { float ss = sumsq8(qv[0]) + sumsq8(qv[1]); ss += sxor(ss, 16); ss += sxor(ss, 32);
          const float rs = rsqrtf(ss * (1.0f / 64.0f) + 1e-5f) * 0.125f;
#pragma unroll
          for (int ks = 0; ks < 2; ++ks) { const u32x4 w = scale8r(qv[ks], rs, qkw[ks]); __builtin_memcpy(&qf[ks], &w, 16); } }
        __syncthreads();
        if (uv_ + 2 * ustep < uend) unit_load(uv_ + 2 * ustep, kv, vv, qv, kvalid);
        f32x4 st[9]; float mx = -1e30f; const f32x4 zq = zero4f();
        LAS unsigned char* kp0 = kb + (16 * wid + fr) * 128 + ((fq ^ (fr & 7)) << 4); LAS unsigned char* kp1 = kb + (16 * wid + fr) * 128 + (((4 + fq) ^ (fr & 7)) << 4);
#pragma unroll
        for (int ti = 0; ti < 9; ++ti) {
            const bf16x8 k0 = *(const LAS bf16x8*)(kp0 + ti * 2048), k1 = *(const LAS bf16x8*)(kp1 + ti * 2048);
            f32x4 s = __builtin_amdgcn_mfma_f32_16x16x32_bf16(k0, qf[0], zq, 0, 0, 0);
            s = __builtin_amdgcn_mfma_f32_16x16x32_bf16(k1, qf[1], s, 0, 0, 0);
#pragma unroll
            for (int j = 0; j < 4; ++j) { const int ki = 16 * (wid + ti) + 4 * fq + j, off = qi + 128 - ki; const bool ok = (off >= 0) && (off <= 128) && (j0 - 128 + ki >= 0);
                s[j] = ok ? s[j] : -1e30f; mx = fmaxf(mx, s[j]); }
            st[ti] = s; }
        mx = fmaxf(mx, sxor(mx, 16)); mx = fmaxf(mx, sxor(mx, 32));
        float den = 0.f;
#pragma unroll
        for (int ti = 0; ti < 9; ++ti)
#pragma unroll
            for (int j = 0; j < 4; ++j) { const float e = __builtin_amdgcn_exp2f((st[ti][j] - mx) * 1.44269504f); st[ti][j] = e; den += e; }
        den += sxor(den, 16); den += sxor(den, 32);
        f32x4 o[4];
#pragma unroll
        for (int dt = 0; dt < 4; ++dt) o[dt] = zq;
        const int q4 = fr >> 2, p4 = fr & 3; const int kl = 4 * fq + q4;
        LAS unsigned char* vp[4];
#pragma unroll
        for (int dt = 0; dt < 4; ++dt) vp[dt] = vb + (16 * wid + kl) * 128 + (((2 * dt + (p4 >> 1)) ^ (kl & 7)) << 4) + (p4 & 1) * 8;
#pragma unroll
        for (int pp = 0; pp < 5; ++pp) { const bool two = pp < 4; const int tA = 2 * pp, tB = two ? 2 * pp + 1 : 2 * pp;
            u32x4 pw; pw.x = cvt_pk_bf16(st[tA][0], st[tA][1]); pw.y = cvt_pk_bf16(st[tA][2], st[tA][3]);
            if (two) { pw.z = cvt_pk_bf16(st[tB][0], st[tB][1]); pw.w = cvt_pk_bf16(st[tB][2], st[tB][3]); } else { pw.z = 0u; pw.w = 0u; }
            bf16x8 pf; __builtin_memcpy(&pf, &pw, 16);
#pragma unroll
            for (int dt = 0; dt < 4; ++dt) { const bf16x8 vf = tr_pair(vp[dt] + tA * 2048, vp[dt] + tB * 2048, two);
                o[dt] = __builtin_amdgcn_mfma_f32_16x16x32_bf16(vf, pf, o[dt], 0, 0, 0); } }
        const float inv = __builtin_amdgcn_rcpf(den); const size_t ob = ((size_t)(g * NTOK + b * SEQ + tq) * 4 + hg);
#pragma unroll
        for (int dt = 0; dt < 4; ++dt) *(f32x4*)(DILO + ob * 64 + 16 * dt + 4 * fq) = o[dt] * inv;
        if (fq == 0) LSE[ob] = mx + __logf(den);
        __syncthreads();
    };
    if (u0 < uend) unit_load(u0, kvA, vvA, qvA, kvalidA);
    if (u0 + ustep < uend) unit_load(u0 + ustep, kvB, vvB, qvB, kvalidB);
    for (int u = u0; u < uend; u += 2 * ustep) {
        do_unit(u, kvA, vvA, qvA, kvalidA);
        if (u + ustep < uend) do_unit(u + ustep, kvB, vvB, qvB, kvalidB);
    }
}

__device__ __forceinline__ void phase_mem_attn(const int wv, LAS unsigned char* lds) {
    KParams& p = *kparams();
    const int tid = opaque_tid(wv), wid = tid >> 6, lane = tid & 63, fr = lane & 15, fq = lane >> 4; unsigned char* ws = p.ws;
    const bf16_t* Z = (const bf16_t*)(ws + OFF_Z); const bf16_t* KV = (const bf16_t*)(ws + OFF_KV); bf16_t* YM = (bf16_t*)(ws + OFF_YCAT) + 768;
    LAS unsigned char* kb = lds; LAS unsigned char* vb = lds + 65536; const float* mqn = p.in[19]; const float* mkn = p.in[20];
    if (blockIdx.x < 64) return;
    float mqk[4][8];
#pragma unroll
    for (int ks = 0; ks < 4; ++ks)
#pragma unroll
        for (int j = 0; j < 8; ++j) mqk[ks][j] = mqn[ks * 32 + 8 * fq + j] * mkn[ks * 32 + 8 * fq + j];
    for (int bhq = (int)blockIdx.x - 64; bhq < 256; bhq += (int)gridDim.x - 64) {
        const int bhm = bhq >> 3, b = bhm >> 2, hm = bhm & 3;
        { const int ki = tid >> 1, half = tid & 1; const bf16_t* rowp = KV + (size_t)(b * 256 + ki) * 1024 + hm * 128 + half * 64;
          u32x4 kv[8], vv[8];
#pragma unroll
          for (int i = 0; i < 8; ++i) { kv[i] = *(const u32x4*)(rowp + 8 * i); vv[i] = *(const u32x4*)(rowp + 512 + 8 * i); }
          { float ss = 0.f;
#pragma unroll
            for (int i = 0; i < 8; ++i) ss += sumsq8(kv[i]);
            ss += dpp_f<0xB1>(ss); const float rs = rsqrtf(ss * (1.0f / 128.0f) + 1e-5f);
#pragma unroll
            for (int i = 0; i < 8; ++i) kv[i] = scale8s(kv[i], rs); }
#pragma unroll
          for (int i = 0; i < 8; ++i) { const int sw = (half * 8 + i) ^ (ki & 15); *(LAS u32x4*)(kb + ki * 256 + sw * 16) = kv[i]; *(LAS u32x4*)(vb + ki * 256 + sw * 16) = vv[i]; } }
        __syncthreads();
        const int q4 = fr >> 2, p4 = fr & 3; const int kl = 4 * fq + q4;
        LAS unsigned char* kp[4]; LAS unsigned char* vp[8];
#pragma unroll
        for (int ks = 0; ks < 4; ++ks) kp[ks] = kb + fr * 256 + (((4 * ks + fq) ^ fr) << 4);
#pragma unroll
        for (int dt = 0; dt < 8; ++dt) vp[dt] = vb + kl * 256 + (((2 * dt + (p4 >> 1)) ^ kl) << 4) + (p4 & 1) * 8;
        for (int qq = 0; qq < 2; ++qq) { const int qblk = (bhq & 7) * 2 + qq; const int tq = b * SEQ + qblk * 128 + 16 * wid + fr;
            bf16x8 qf[4];
#pragma unroll
            for (int ks = 0; ks < 4; ++ks) qf[ks] = *(const bf16x8*)(Z + (size_t)tq * INC + C_MQ + hm * 128 + ks * 32 + 8 * fq);
            { u32x4 qv[4]; float ss = 0.f;
#pragma unroll
              for (int ks = 0; ks < 4; ++ks) { __builtin_memcpy(&qv[ks], &qf[ks], 16); ss += sumsq8(qv[ks]); }
              ss += sxor(ss, 16); ss += sxor(ss, 32); const float rs = rsqrtf(ss * (1.0f / 128.0f) + 1e-5f);
#pragma unroll
              for (int ks = 0; ks < 4; ++ks) { const u32x4 w = scale8r(qv[ks], rs, mqk[ks]); __builtin_memcpy(&qf[ks], &w, 16); } }
            f32x4 st[16]; float mx = -1e30f; const f32x4 zq = zero4f();
#pragma unroll
            for (int ti = 0; ti < 16; ++ti) { f32x4 s = zq;
#pragma unroll
                for (int ks = 0; ks < 4; ++ks) { const bf16x8 kf = *(const LAS bf16x8*)(kp[ks] + ti * 4096); s = __builtin_amdgcn_mfma_f32_16x16x32_bf16(kf, qf[ks], s, 0, 0, 0); }
#pragma unroll
                for (int j = 0; j < 4; ++j) mx = fmaxf(mx, s[j]);
                st[ti] = s; if (ti & 1) asm volatile("" ::: "memory"); }
            mx = fmaxf(mx, sxor(mx, 16)); mx = fmaxf(mx, sxor(mx, 32));
            const float sc = 0.08838834764831845f * 1.44269504f; float den = 0.f;
#pragma unroll
            for (int ti = 0; ti < 16; ++ti)
#pragma unroll
                for (int j = 0; j < 4; ++j) { const float e = __builtin_amdgcn_exp2f((st[ti][j] - mx) * sc); st[ti][j] = e; den += e; }
            den += sxor(den, 16); den += sxor(den, 32);
            f32x4 o[8];
#pragma unroll
            for (int dt = 0; dt < 8; ++dt) o[dt] = zq;
#pragma unroll
            for (int pp = 0; pp < 8; ++pp) { const int tA = 2 * pp, tB = 2 * pp + 1;
                u32x4 pw; pw.x = cvt_pk_bf16(st[tA][0], st[tA][1]); pw.y = cvt_pk_bf16(st[tA][2], st[tA][3]); pw.z = cvt_pk_bf16(st[tB][0], st[tB][1]); pw.w = cvt_pk_bf16(st[tB][2], st[tB][3]);
                bf16x8 pf; __builtin_memcpy(&pf, &pw, 16);
#pragma unroll
                for (int dt = 0; dt < 8; ++dt) { const bf16x8 vf = tr_pair(vp[dt] + tA * 4096, vp[dt] + tB * 4096, true);
                    o[dt] = __builtin_amdgcn_mfma_f32_16x16x32_bf16(vf, pf, o[dt], 0, 0, 0); } }
            const float inv = __builtin_amdgcn_rcpf(den);
#pragma unroll
            for (int dt = 0; dt < 8; ++dt) { u32x2 w; w.x = cvt_pk_bf16(o[dt][0] * inv, o[dt][1] * inv); w.y = cvt_pk_bf16(o[dt][2] * inv, o[dt][3] * inv);
                *(u32x2*)(YM + (size_t)tq * 1280 + hm * 128 + 16 * dt + 4 * fq) = w; } }
        __syncthreads();
    }
}

__device__ __forceinline__ void phase_post(const int wv) {
    KParams& p = *kparams();
    const int gt = blockIdx.x * 512 + opaque_tid(wv), nthr = gridDim.x * 512; unsigned char* ws = p.ws;
    const float* Yraw = (const float*)(ws + OFF_YRAW); const bf16_t* C1 = (const bf16_t*)(ws + OFF_C1); const bf16_t* C2 = (const bf16_t*)(ws + OFF_C2); bf16_t* YR = (bf16_t*)(ws + OFF_YCAT);
    for (int idx = gt; idx < NTOK * 128; idx += nthr) { const int t = idx >> 7, c = ((idx >> 4) & 7) * 64 + 4 * (idx & 15);
        const f32x4 y = *(const f32x4*)(Yraw + (size_t)t * 512 + c);
        const float mean = red16(y[0] + y[1] + y[2] + y[3]) * (1.0f / 64.0f);
        const f32x4 d = y - mean; const float var = red16(d[0] * d[0] + d[1] * d[1] + d[2] * d[2] + d[3] * d[3]) * (1.0f / 64.0f);
        const float rs = rsqrtf(var + 64.0f * 1e-5f);
        float c1[4], c2[4]; unpack4(*(const u32x2*)(C1 + (size_t)t * 512 + c), c1); unpack4(*(const u32x2*)(C2 + (size_t)t * 512 + c), c2);
        u32x2 w; w.x = cvt_pk_bf16(d[0] * rs * c1[0] + c2[0], d[1] * rs * c1[1] + c2[1]); w.y = cvt_pk_bf16(d[2] * rs * c1[2] + c2[2], d[3] * rs * c1[3] + c2[3]);
        *(u32x2*)(YR + (size_t)t * 1280 + c) = w; }
    const float* DILO = (const float*)(ws + OFF_DILO); const float* LSE = (const float*)(ws + OFF_LSE); bf16_t* YD = (bf16_t*)(ws + OFF_YCAT) + 512;
    for (int idx = gt; idx < NTOK * 64; idx += nthr) { const int t = idx >> 6, hg = (idx >> 4) & 3, q = idx & 15;
        const float l0 = LSE[(size_t)t * 4 + hg], l1 = LSE[((size_t)NTOK + t) * 4 + hg], l2 = LSE[((size_t)2 * NTOK + t) * 4 + hg];
        const float m = fmaxf(l0, fmaxf(l1, l2)); const float e0 = __expf(l0 - m), e1 = __expf(l1 - m), e2 = __expf(l2 - m); const float inv = __builtin_amdgcn_rcpf(e0 + e1 + e2);
        const f32x4 o0 = *(const f32x4*)(DILO + ((size_t)t * 4 + hg) * 64 + 4 * q), o1 = *(const f32x4*)(DILO + (((size_t)NTOK + t) * 4 + hg) * 64 + 4 * q), o2 = *(const f32x4*)(DILO + (((size_t)2 * NTOK + t) * 4 + hg) * 64 + 4 * q);
        const f32x4 o = (o0 * e0 + o1 * e1 + o2 * e2) * inv;
        u32x2 w; w.x = cvt_pk_bf16(o[0], o[1]); w.y = cvt_pk_bf16(o[2], o[3]); *(u32x2*)(YD + (size_t)t * 1280 + hg * 64 + 4 * q) = w; }
}

__device__ __forceinline__ void phase_router(const int wv, LAS unsigned char* lds, const bool real = true) {
    KParams& p = *kparams();
    const int tid = opaque_tid(wv), wid = tid >> 6, lane = tid & 63, fr = lane & 15, fq = lane >> 4; unsigned char* ws = p.ws;
    const bf16_t* X1 = (const bf16_t*)(ws + OFF_X1B); const float* ln2 = p.in[25]; const float* br = p.in[27]; const bf16_t* WRT = (const bf16_t*)(ws + OFF_WRT);
    unsigned char* XN2 = ws + OFF_XN2; int* TOPE = (int*)(ws + OFF_TOPE); float* TOPG = (float*)(ws + OFF_TOPG);
    LAS int* hist = (LAS int*)(lds + LX_HIST);
    LAS float* red = (LAS float*)lds;
    LAS float* part = (LAS float*)(lds + 1024);
    if (tid < 32) hist[tid] = 0;
    const int grp = wid >> 2, kq = wid & 3;
    u32x4 xq[2][8];
#pragma unroll
    for (int rd = 0; rd < 2; ++rd) { const bf16_t* xp = X1 + (size_t)((blockIdx.x * 4 + rd * 2 + grp) * 16 + fr) * 1024 + kq * 256 + 8 * fq;
#pragma unroll
        for (int s2 = 0; s2 < 8; ++s2) xq[rd][s2] = __builtin_nontemporal_load((const u32x4*)(xp + 32 * s2)); }
#pragma unroll
    for (int rd = 0; rd < 2; ++rd) { const int t0 = (blockIdx.x * 4 + rd * 2 + grp) * 16;
        f32x4 xa[8], xb[8]; float ss = 0.f;
#pragma unroll
        for (int s2 = 0; s2 < 8; ++s2) { float f[8]; unpack8(xq[rd][s2], f); xa[s2] = (f32x4){f[0], f[1], f[2], f[3]}; xb[s2] = (f32x4){f[4], f[5], f[6], f[7]}; }
#pragma unroll
        for (int s2 = 0; s2 < 8; ++s2) ss += xa[s2][0] * xa[s2][0] + xa[s2][1] * xa[s2][1] + xa[s2][2] * xa[s2][2] + xa[s2][3] * xa[s2][3] + xb[s2][0] * xb[s2][0] + xb[s2][1] * xb[s2][1] + xb[s2][2] * xb[s2][2] + xb[s2][3] * xb[s2][3];
        ss += sxor(ss, 16); ss += sxor(ss, 32);
        __syncthreads();
        if (fq == 0) red[(grp * 4 + kq) * 16 + fr] = ss;
        __syncthreads();
        const float tot = red[(grp * 4 + 0) * 16 + fr] + red[(grp * 4 + 1) * 16 + fr] + red[(grp * 4 + 2) * 16 + fr] + red[(grp * 4 + 3) * 16 + fr];
        const float rs = rsqrtf(tot * (1.0f / 1024.0f) + 1e-5f);
        f32x4 acc[2]; acc[0] = zero4f(); acc[1] = acc[0];
#pragma unroll
        for (int s2 = 0; s2 < 8; ++s2) { const int k = kq * 256 + 32 * s2 + 8 * fq;
            const f32x4 g0 = *(const f32x4*)(ln2 + k), g1 = *(const f32x4*)(ln2 + k + 4);
            float xn[8]; xn[0] = xa[s2][0] * rs * g0[0]; xn[1] = xa[s2][1] * rs * g0[1]; xn[2] = xa[s2][2] * rs * g0[2]; xn[3] = xa[s2][3] * rs * g0[3];
            xn[4] = xb[s2][0] * rs * g1[0]; xn[5] = xb[s2][1] * rs * g1[1]; xn[6] = xb[s2][2] * rs * g1[2]; xn[7] = xb[s2][3] * rs * g1[3];
            const u32x4 hi = pack8(xn); float hf[8]; unpack8(hi, hf);
#pragma unroll
            for (int j = 0; j < 8; ++j) hf[j] = xn[j] - hf[j];
            const u32x4 lo = pack8(hf);
            { u32x2 q8; q8.x = pack4_fp8(xn[0] * 8.0f, xn[1] * 8.0f, xn[2] * 8.0f, xn[3] * 8.0f); q8.y = pack4_fp8(xn[4] * 8.0f, xn[5] * 8.0f, xn[6] * 8.0f, xn[7] * 8.0f); if (real) *(u32x2*)(XN2 + (size_t)(t0 + fr) * 1024 + k) = q8; }
            bf16x8 xh, xl; __builtin_memcpy(&xh, &hi, 16); __builtin_memcpy(&xl, &lo, 16);
#pragma unroll
            for (int m = 0; m < 2; ++m) { const bf16x8 wh = *(const bf16x8*)(WRT + (size_t)(16 * m + fr) * 1024 + k), wl = *(const bf16x8*)(WRT + 32768 + (size_t)(16 * m + fr) * 1024 + k);
                acc[m] = MFMA16(wh, xh, acc[m]); acc[m] = MFMA16(wh, xl, acc[m]); acc[m] = MFMA16(wl, xh, acc[m]); } }
#pragma unroll
        for (int m = 0; m < 2; ++m)
#pragma unroll
            for (int j = 0; j < 4; ++j) part[((grp * 4 + kq) * 32 + 16 * m + 4 * fq + j) * 16 + fr] = acc[m][j];
        __syncthreads();
        if (kq == 0) { float lg[8]; int le[8];
#pragma unroll
            for (int m = 0; m < 2; ++m)
#pragma unroll
                for (int j = 0; j < 4; ++j) { const int e = 16 * m + 4 * fq + j; le[m * 4 + j] = e;
                    lg[m * 4 + j] = part[((grp * 4 + 0) * 32 + e) * 16 + fr] + part[((grp * 4 + 1) * 32 + e) * 16 + fr] + part[((grp * 4 + 2) * 32 + e) * 16 + fr] + part[((grp * 4 + 3) * 32 + e) * 16 + fr] + br[e]; }
            float tv[4]; int te[4];
#pragma unroll
            for (int r = 0; r < 4; ++r) { float bv = lg[0]; int bi = le[0];
#pragma unroll
                for (int q = 1; q < 8; ++q) if (lg[q] > bv) { bv = lg[q]; bi = le[q]; }
#pragma unroll
                for (int sft = 16; sft < 64; sft <<= 1) { const float ov = sxor(bv, sft); const int oi = sxor(bi, sft); if (ov > bv || (ov == bv && oi < bi)) { bv = ov; bi = oi; } }
                tv[r] = bv; te[r] = bi;
#pragma unroll
                for (int q = 0; q < 8; ++q) if (le[q] == bi) lg[q] = -3.0e38f; }
            const float e1 = __expf(tv[1] - tv[0]), e2 = __expf(tv[2] - tv[0]), e3 = __expf(tv[3] - tv[0]); const float inv = 1.0f / (1.0f + e1 + e2 + e3);
            if (fq == 0 && real) { const int t = t0 + fr; *(int4*)(TOPE + (size_t)t * 4) = make_int4(te[0], te[1], te[2], te[3]); *(f32x4*)(TOPG + (size_t)t * 4) = (f32x4){inv, e1 * inv, e2 * inv, e3 * inv};
                atomicAdd((int*)&hist[te[0]], 1); atomicAdd((int*)&hist[te[1]], 1); atomicAdd((int*)&hist[te[2]], 1); atomicAdd((int*)&hist[te[3]], 1); } }
    }
    __syncthreads();
    if (tid < 32 && real) { const int hcount = hist[tid]; if (hcount) atomicAdd((int*)(ws + OFF_CTL + CTL_CNT) + tid, hcount); }
}

__device__ __forceinline__ void build_tables(const int wv, LAS unsigned char* lds) {
    KParams& p = *kparams();
    LAS int* ts = (LAS int*)(lds + LX_TSTART); LAS int* sb = (LAS int*)(lds + LX_SBASE); LAS int* cn = (LAS int*)(lds + LX_CNT);
    if (wv == 0) { const int l = lane_id(); int* gc = (int*)(p.ws + OFF_CTL + CTL_CNT);
        const int c = (l < 32) ? (int)__hip_atomic_load(gc + l, __ATOMIC_RELAXED, __HIP_MEMORY_SCOPE_AGENT) : 0; const int tl = (c + 255) >> 8; int v = tl;
#pragma unroll
        for (int d = 1; d < 32; d <<= 1) { const int o = __builtin_amdgcn_ds_bpermute((l - d) << 2, v); if (l >= d) v += o; }
        if (l < 32) { cn[l] = c; sb[l] = (v - tl) * 256; ts[l + 1] = v; if (l == 0) ts[0] = 0; } }
    __syncthreads();
    { const int tid = (wv << 6) | lane_id(); LAS unsigned char* te = (LAS unsigned char*)(lds + LX_TEXP); const int nt = ts[32];
      if (tid < nt) { int e = 0; while (e < 31 && tid >= ts[e + 1]) ++e; te[tid] = (unsigned char)e; } }
    __syncthreads();
}

__device__ __forceinline__ void phase_dispatch(const int wv, LAS unsigned char* lds, const bool real = true) {
    KParams& p = *kparams();
    const int tid = opaque_tid(wv); unsigned char* ws = p.ws;
    build_tables(wv, lds);
    const LAS int* sb = (const LAS int*)(lds + LX_SBASE); const LAS int* cn = (const LAS int*)(lds + LX_CNT);
    LAS int* hist = (LAS int*)(lds + LX_HIST); LAS int* bbase = (LAS int*)(lds + LX_BBASE);
    const int* TOPE = (const int*)(ws + OFF_TOPE); int* SLOT = (int*)(ws + OFF_SLOT); int* STOK = (int*)(ws + OFF_STOK);
    for (int tb = blockIdx.x; tb < NTOK / 64; tb += gridDim.x) {
        if (tid < 32) hist[tid] = 0;
        __syncthreads();
        int e = 0, lr = 0;
        if (tid < 256) { e = TOPE[(size_t)tb * 256 + tid]; lr = atomicAdd((int*)&hist[e], 1); }
        __syncthreads();
        if (tid < 32) { const int hcount = hist[tid]; bbase[tid] = (hcount && real) ? atomicAdd((int*)(ws + OFF_CTL + CTL_CUR) + tid, hcount) : 0; }
        __syncthreads();
        if (tid < 256 && real) { const int sl = sb[e] + bbase[e] + lr; SLOT[(size_t)tb * 256 + tid] = sl; STOK[sl] = tb * 64 + (tid >> 2); }
        __syncthreads();
    }
    for (int e = blockIdx.x; e < 32; e += gridDim.x) { const int lo = sb[e] + cn[e], hi = sb[e] + ((cn[e] + 255) & ~255);
        for (int rrow = lo + tid; rrow < hi; rrow += 512) STOK[rrow] = 0; }
}

__device__ __forceinline__ void phase_combine(const int wv, const bool real = true) {
    KParams& p = *kparams();
    const int tid = opaque_tid(wv), wid = tid >> 6, lane = tid & 63; unsigned char* ws = p.ws;
    const int* SLOT = (const int*)(ws + OFF_SLOT); const float* TOPG = (const float*)(ws + OFF_TOPG); const bf16_t* YS = (const bf16_t*)(ws + OFF_YS); const bf16_t* X1 = (const bf16_t*)(ws + OFF_X1B); float* out = p.out;
    for (int t0 = (blockIdx.x * 8 + wid) * 8; t0 < NTOK; t0 += gridDim.x * 64) {
        int4 sl[8]; f32x4 gg[8];
#pragma unroll
        for (int i = 0; i < 8; ++i) { sl[i] = *(const int4*)(SLOT + (size_t)(t0 + i) * 4); gg[i] = *(const f32x4*)(TOPG + (size_t)(t0 + i) * 4); }
#pragma unroll
        for (int i = 0; i < 8; ++i) { const int t = t0 + i; const int s4[4] = {sl[i].x, sl[i].y, sl[i].z, sl[i].w};
#pragma unroll
            for (int hf = 0; hf < 2; ++hf) { const int c = hf * 512 + 8 * lane; float acc[8];
                const u32x4 xv = __builtin_nontemporal_load((const u32x4*)(X1 + (size_t)t * 1024 + c));
                u32x4 yv[4];
#pragma unroll
                for (int k = 0; k < 4; ++k) yv[k] = __builtin_nontemporal_load((const u32x4*)(YS + (size_t)s4[k] * 1024 + c));
                unpack8(xv, acc);
#pragma unroll
                for (int k = 0; k < 4; ++k) { float f[8]; unpack8(yv[k], f);
#pragma unroll
                    for (int j = 0; j < 8; ++j) acc[j] = fmaf(gg[i][k], f[j], acc[j]); }
                float* dst = real ? out : (float*)(ws + OFF_ACT);
                *(f32x4*)(dst + (size_t)t * 1024 + c) = (f32x4){acc[0], acc[1], acc[2], acc[3]}; *(f32x4*)(dst + (size_t)t * 1024 + c + 4) = (f32x4){acc[4], acc[5], acc[6], acc[7]}; }
            if (i & 1) asm volatile("" ::: "memory"); }
    }
}

__global__ void __launch_bounds__(512, 2) mk_fwd(Params p) {
    extern __shared__ __attribute__((aligned(16))) unsigned char lds_raw[];
    LAS unsigned char* lds = (LAS unsigned char*)lds_raw;
    unsigned char* ws = p.ws;
    const int wv = __builtin_amdgcn_readfirstlane((int)threadIdx.x >> 6);
    const bool multi = (p.ph_hi - p.ph_lo) > 1;
    XcdBarrier xb; xb.bar = (unsigned*)(ws + OFF_CTL); xb.x = 0; xb.st = (volatile LAS unsigned*)(lds + LDS_X);
    if (multi) {
        if (wv == 0 && lane_id() == 0) { *(LAS u32x4*)(lds + LDS_X) = zero4u(); }
        __syncthreads();
        xb = xcd_barrier_post((unsigned*)(ws + OFF_CTL), (volatile LAS unsigned*)(lds + LDS_X), wv);
    }
#if MFMA_BENCH
    { const int l = lane_id(); unsigned h = (unsigned)l * 2654435761u ^ (unsigned)blockIdx.x * 40503u ^ (unsigned)wv * 977u;
      i32x8 a, b;
#pragma unroll
      for (int j = 0; j < 8; ++j) { h = h * 1664525u + 1013904223u; a[j] = (int)(MFMA_BENCH == 1 ? ((h & 0x00ff00ffu) | 0x3f003f00u) : ((h & 0x0f0f0f0fu) | 0x30303030u));
                                    h = h * 1664525u + 1013904223u; b[j] = (int)(MFMA_BENCH == 1 ? ((h & 0x00ff00ffu) | 0x3f003f00u) : ((h & 0x0f0f0f0fu) | 0x30303030u)); }
      f32x4 c[8]; const f32x4 z0 = zero4f();
#pragma unroll
      for (int j = 0; j < 8; ++j) c[j] = z0;
      const int one_scale = 0x7f7f7f7f;
#pragma clang loop unroll(disable)
      for (int it = 0; it < (MFMA_BENCH == 1 ? 1875 : 938); ++it) {
#pragma unroll
          for (int j = 0; j < 8; ++j) {
              if (MFMA_BENCH == 1) c[j] = (j & 1) ? __builtin_amdgcn_mfma_f32_16x16x32_bf16(pg8::half8<1>(a), pg8::half8<1>(b), c[j], 0, 0, 0) : __builtin_amdgcn_mfma_f32_16x16x32_bf16(pg8::half8<0>(a), pg8::half8<0>(b), c[j], 0, 0, 0);
              else asm volatile("v_mfma_scale_f32_16x16x128_f8f6f4 %0, %1, %2, %0, %3, %3 op_sel_hi:[0,0,0]" : "+v"(c[j]) : "v"(a), "v"(b), "v"(one_scale)); } }
      asm volatile("s_nop 15\n\ts_nop 15" ::: "memory");
      float sm = 0.f;
#pragma unroll
      for (int j = 0; j < 8; ++j) sm += c[j][0] + c[j][1] + c[j][2] + c[j][3];
      if (sm == 1.2345f) *(float*)(ws + OFF_CTL + 8192) = sm; }
#endif
    for (int ph = p.ph_lo; ph < p.ph_hi; ++ph) {
      for (int rep = 0; rep < (((DBL_MASK >> ph) & 1) ? 2 : 1); ++rep) {
        KParams& q = *kparams(); unsigned char* ws = q.ws;
        switch (ph) {
        case 0: phase_prep(wv, lds); break;
        case 1: { { SchedZ S; S.H = (const char*)(ws + OFF_H); S.WinT = (const char*)(ws + OFF_WINT); S.HM = (const char*)(ws + OFF_HM); S.WmkvT = (const char*)(ws + OFF_WMKVT); S.G = gridDim.x; S.c = blockIdx.x;
                    EpiZ E; E.Z = (bf16_t*)(ws + OFF_Z); E.KV = (bf16_t*)(ws + OFF_KV); E.GFp = (bf16_t*)(ws + OFF_GF); E.pn0 = 0; E.scale = 1.0f; pg8::gemm_phase(wv, lds, 1024, S, E); }
                  { SchedZ8 S; S.H8 = (const char*)(ws + OFF_H8); S.WIN8 = (const char*)(ws + OFF_WIN8); S.G = gridDim.x; S.c = blockIdx.x;
                    EpiZ E; E.Z = (bf16_t*)(ws + OFF_Z); E.KV = (bf16_t*)(ws + OFF_KV); E.GFp = (bf16_t*)(ws + OFF_GF); E.pn0 = 7; E.scale = 1.0f / 256.0f; pg8::gemm_phase<EpiZ, SchedZ8, 1>(wv, lds, 1024, S, E); } } break;
        case 2: phase_elem_c(wv); break;
        case 3: { pg8::DenseOrder S; S.init(ws + OFF_ALORA, ws + OFF_LORAT, NTOK, 1536, 256); EpiLora E; E.L = (float*)(ws + OFF_L); E.w0 = q.in[5]; E.a0 = q.in[7]; pg8::gemm_phase(wv, lds, 256, S, E); } break;
        case 4: phase_chunk_pre(wv, lds); break;
        case 5: for (int r2 = 0; r2 < (((DBL_MASK >> 16) & 1) ? 2 : 1); ++r2) phase_scan_seq(wv, lds);
                for (int r2 = 0; r2 < (((DBL_MASK >> 17) & 1) ? 2 : 1); ++r2) phase_dil_attn(wv, lds);
                for (int r2 = 0; r2 < (((DBL_MASK >> 18) & 1) ? 2 : 1); ++r2) phase_mem_attn(wv, lds); break;
        case 6: phase_post(wv); break;
        case 7: { pg8::DenseOrder S; S.init(ws + OFF_YCAT, ws + OFF_PCAT, NTOK, 1024, 1280); EpiMixCat E; E.mixbf = (bf16_t*)(ws + OFF_MIXBF); E.GF = (const bf16_t*)(ws + OFF_GF); E.tid = (wv << 6) | lane_id(); pg8::gemm_phase(wv, lds, 1280, S, E); } break;
        case 8: { pg8::DenseOrder S; S.init(ws + OFF_MIXBF, ws + OFF_WOT, NTOK, 1024, 1024); EpiX1 E; E.x = q.in[0]; E.x1 = (bf16_t*)(ws + OFF_X1B); pg8::gemm_phase(wv, lds, 1024, S, E); } break;
        case 9: phase_router(wv, lds, rep + 1 == (((DBL_MASK >> ph) & 1) ? 2 : 1)); break;
        case 10: phase_dispatch(wv, lds, rep + 1 == (((DBL_MASK >> ph) & 1) ? 2 : 1)); break;
        case 11: { build_tables(wv, lds); SchedMoe<true> S; S.A = (const char*)(ws + OFF_XN2); S.Bt = (const char*)(ws + OFF_W1T); S.tstart = (const LAS int*)(lds + LX_TSTART); S.stok = (const int*)(ws + OFF_STOK); S.lgN = 3; S.total = S.tstart[32] * 8; S.estride = (size_t)2048 * 1024; S.tbytes = (size_t)256 * 1024;
                   EpiSwiglu E; E.act = ws + OFF_ACT; E.b1 = q.in[29]; pg8::gemm_phase<EpiSwiglu, SchedMoe<true>, 1>(wv, lds, 1024, S, E); } break;
        case 12: { build_tables(wv, lds); SchedMoe<false> S; S.A = (const char*)(ws + OFF_ACT); S.Bt = (const char*)(ws + OFF_W2T); S.tstart = (const LAS int*)(lds + LX_TSTART); S.stok = nullptr; S.lgN = 2; S.total = S.tstart[32] * 4; S.estride = (size_t)1024 * 1024; S.tbytes = (size_t)256 * 1024;
                   EpiYs E; E.ys = (bf16_t*)(ws + OFF_YS); E.b2 = q.in[31]; pg8::gemm_phase<EpiYs, SchedMoe<false>, 1>(wv, lds, 1024, S, E); } break;
        case 13: phase_combine(wv, rep + 1 == (((DBL_MASK >> ph) & 1) ? 2 : 1)); break;
        default: break;
        }
      }
        if (ph + 1 < p.ph_hi) xcd_barrier(xb, wv);
        if (((DBL_MASK >> 20) & 1) && ph == 3 && multi) for (int e = 0; e < 10; ++e) xcd_barrier(xb, wv);
    }
}

extern "C" void kernel_launch(void* const* d_in, const int* in_sizes, int n_in, void* d_out, int out_size, void* d_ws, size_t ws_size, hipStream_t stream) {
    static int ready = 0;
    if (ready == 0) {
        if (n_in != 32 || out_size != NTOK * 1024 || ws_size < WS_NEED) { fprintf(stderr, "kernel_launch: unexpected shapes (n_in %d, out %d, ws %zu < %zu)\n", n_in, out_size, ws_size, (size_t)WS_NEED); ready = -1; return; }
        if (hipFuncSetAttribute((const void*)mk_fwd, hipFuncAttributeMaxDynamicSharedMemorySize, LDS_BYTES) != hipSuccess) { fprintf(stderr, "kernel_launch: hipFuncSetAttribute failed\n"); ready = -1; return; }
        int per_cu = 0, dev = 0, cus = 0; hipGetDevice(&dev); hipDeviceGetAttribute(&cus, hipDeviceAttributeMultiprocessorCount, dev);
        hipOccupancyMaxActiveBlocksPerMultiprocessor(&per_cu, (const void*)mk_fwd, 512, LDS_BYTES);
        if (per_cu < 1 || cus < 256) { fprintf(stderr, "kernel_launch: occupancy %d blocks/CU on %d CUs; need >= 1 on 256\n", per_cu, cus); ready = -1; (void)hipGetLastError(); return; }
        ready = 1;
    }
    if (ready < 0) return;
    hipMemsetAsync((char*)d_ws + OFF_CTL, 0, CTL_BYTES, stream);
    Params p{};
    for (int i = 0; i < 32; ++i) p.in[i] = (const float*)d_in[i];
    p.out = (float*)d_out; p.ws = (unsigned char*)d_ws;
#if MK_N_LAUNCH_PER_PHASE
    for (int ph = 0; ph < NPHASE; ++ph) { p.ph_lo = ph; p.ph_hi = ph + 1; hipLaunchKernelGGL(mk_fwd, dim3(256), dim3(512), LDS_BYTES, stream, p); }
#else
    p.ph_lo = 0; p.ph_hi = NPHASE;
    void* args[] = {&p};
    hipError_t e = hipLaunchCooperativeKernel((const void*)mk_fwd, dim3(256), dim3(512), args, LDS_BYTES, stream);
    if (e != hipSuccess) fprintf(stderr, "cooperative launch failed: %s\n", hipGetErrorString(e));
#endif
}
```

```cpp
#include <hip/hip_runtime.h>
#include <cstdio>
#include <cstdint>

#define LAS __attribute__((address_space(3)))
typedef unsigned short bf16_t;
typedef short bf16x8 __attribute__((ext_vector_type(8)));
typedef short s16x4 __attribute__((ext_vector_type(4)));
typedef float f32x4 __attribute__((ext_vector_type(4)));
typedef float f32x2 __attribute__((ext_vector_type(2)));
typedef unsigned u32x4 __attribute__((ext_vector_type(4)));
typedef unsigned u32x2 __attribute__((ext_vector_type(2)));
typedef int i32x8 __attribute__((ext_vector_type(8)));
typedef int i32x4 __attribute__((ext_vector_type(4)));

#ifndef DBL_MASK
#define DBL_MASK 0
#endif
#ifndef MK_N_LAUNCH_PER_PHASE
#define MK_N_LAUNCH_PER_PHASE 0
#endif

constexpr int NTOK = 16384, SEQ = 2048, INC = 7680;
constexpr int C_K = 512, C_V = 1024, C_ZW = 1536, C_DQ = 1792, C_DK = 2560, C_DV = 3328, C_MQ = 4096, C_GATE = 4608;
constexpr int NPHASE = 14;
constexpr int NSLOT_MAX = 65536 + 32 * 256;

constexpr size_t MiB = 1ull << 20;
constexpr size_t OFF_CTL = 0;
constexpr size_t CTL_BYTES = 32768;
constexpr size_t CTL_CNT = 16384;
constexpr size_t CTL_CUR = 16384 + 256;
constexpr size_t OFF_TOPE = 1 * MiB;
constexpr size_t OFF_TOPG = 1 * MiB + 262144;
constexpr size_t OFF_SLOT = 1 * MiB + 524288;
constexpr size_t OFF_STOK = 2 * MiB;
constexpr size_t OFF_WRT = 3 * MiB;
constexpr size_t OFF_WINT = 4 * MiB, OFF_WMKVT = 19 * MiB, OFF_LORAT = 21 * MiB, OFF_PRT = 22 * MiB, OFF_PDT = 23 * MiB, OFF_PMT = 24 * MiB, OFF_WOT = 25 * MiB;
constexpr size_t OFF_WIN8 = 8 * MiB;
constexpr size_t OFF_H8 = 539 * MiB;
constexpr size_t OFF_YCAT = 223 * MiB;
constexpr size_t OFF_PCAT = 22 * MiB;
constexpr size_t OFF_W1T = 27 * MiB, OFF_W2T = 155 * MiB, OFF_KV = 219 * MiB, OFF_YM = 223 * MiB, OFF_YR = 239 * MiB, OFF_YD = 255 * MiB, OFF_Z = 263 * MiB;
constexpr size_t OFF_H = 503 * MiB, OFF_HM = 535 * MiB, OFF_ALORA = 503 * MiB, OFF_L = 511 * MiB, OFF_REC = 607 * MiB;
constexpr size_t OFF_GF = OFF_REC;
constexpr size_t OFF_LW = OFF_REC + 64 * MiB;
constexpr size_t OFF_VB = OFF_REC + 96 * MiB;
constexpr size_t OFF_GTF = OFF_REC + 112 * MiB;
constexpr size_t OFF_RTF = OFF_REC + 144 * MiB;
constexpr size_t OFF_HHF = OFF_REC + 160 * MiB;
constexpr size_t OFF_YLF = OFF_REC + 192 * MiB;
constexpr size_t OFF_C1 = 816 * MiB, OFF_C2 = 832 * MiB, OFF_YRAW = 848 * MiB, OFF_DILO = 880 * MiB, OFF_LSE = 928 * MiB;
constexpr size_t OFF_MIX32 = 503 * MiB, OFF_MIXBF = 567 * MiB, OFF_XN2 = 503 * MiB, OFF_XS = 263 * MiB, OFF_ACT = 607 * MiB, OFF_YS = 407 * MiB;
constexpr size_t OFF_X1B = 263 * MiB;
constexpr size_t WS_NEED = 929 * MiB;

constexpr int LDS_BYTES = 160 * 1024;
constexpr int LDS_X = LDS_BYTES - 4096;
constexpr int LX_TSTART = LDS_X + 64;
constexpr int LX_SBASE = LDS_X + 256;
constexpr int LX_CNT = LDS_X + 512;
constexpr int LX_HIST = LDS_X + 768;
constexpr int LX_BBASE = LDS_X + 1024;
constexpr int LX_SLOTL = LDS_X + 2048;
constexpr int LX_TEXP = LDS_X + 3072;

struct Params { const float* in[32]; float* out; unsigned char* ws; int ph_lo, ph_hi; };
typedef const Params __attribute__((address_space(4))) KParams;
__device__ __forceinline__ KParams* kparams() { KParams* kp = (KParams*)__builtin_amdgcn_kernarg_segment_ptr(); asm volatile("" : "+s"(kp)); return kp; }

typedef __bf16 bf16x2_t __attribute__((ext_vector_type(2)));
__device__ __forceinline__ unsigned cvt_pk_bf16(float lo, float hi) { f32x2 v = {lo, hi}; bf16x2_t b = __builtin_convertvector(v, bf16x2_t); unsigned r; __builtin_memcpy(&r, &b, 4); return r; }
__device__ __forceinline__ unsigned pack4_fp8(float a, float b, float c, float d) { int r = __builtin_amdgcn_cvt_pk_fp8_f32(a, b, 0, false); r = __builtin_amdgcn_cvt_pk_fp8_f32(c, d, r, true); return (unsigned)r; }
__device__ __forceinline__ float bf_lo(unsigned u) { return __uint_as_float(u << 16); }
__device__ __forceinline__ float bf_hi(unsigned u) { return __uint_as_float(u & 0xffff0000u); }
__device__ __forceinline__ int lane_id() { int l; asm volatile("v_mbcnt_lo_u32_b32 %0, -1, 0\n\tv_mbcnt_hi_u32_b32 %0, -1, %0" : "=v"(l)); return l; }
__device__ __forceinline__ int sxor(int x, int m) { return __builtin_amdgcn_ds_bpermute((lane_id() ^ m) << 2, x); }
__device__ __forceinline__ float sxor(float x, int m) { return __int_as_float(__builtin_amdgcn_ds_bpermute((lane_id() ^ m) << 2, __float_as_int(x))); }
template <int CTRL> __device__ __forceinline__ float dpp_f(float x) { return __int_as_float(__builtin_amdgcn_update_dpp(0, __float_as_int(x), CTRL, 0xF, 0xF, true)); }
__device__ __forceinline__ float red4(float x) { x += dpp_f<0xB1>(x); x += dpp_f<0x4E>(x); return x; }
__device__ __forceinline__ float red8(float x) { x = red4(x); x += dpp_f<0x141>(x); return x; }
__device__ __forceinline__ float red16(float x) { x = red8(x); x += dpp_f<0x140>(x); return x; }
__device__ __forceinline__ float red64(float x) { x = red16(x); x += sxor(x, 16); x += sxor(x, 32); return x; }
__device__ __forceinline__ int opaque_tid(const int wv) { int t = (wv << 6) | lane_id(); asm volatile("" : "+v"(t)); return t; }
__device__ __forceinline__ f32x4 zero4f() { float z = 0.f; asm volatile("" : "+v"(z)); return (f32x4){z, z, z, z}; }
__device__ __forceinline__ u32x4 zero4u() { unsigned z = 0u; asm volatile("" : "+v"(z)); return (u32x4){z, z, z, z}; }
__device__ __forceinline__ float sigmoidf_(float x) { return __builtin_amdgcn_rcpf(1.0f + __builtin_amdgcn_exp2f(-1.44269504f * x)); }
__device__ __forceinline__ void unpack8(const u32x4 v, float (&f)[8]) { f[0] = bf_lo(v.x); f[1] = bf_hi(v.x); f[2] = bf_lo(v.y); f[3] = bf_hi(v.y); f[4] = bf_lo(v.z); f[5] = bf_hi(v.z); f[6] = bf_lo(v.w); f[7] = bf_hi(v.w); }
__device__ __forceinline__ u32x4 pack8(const float (&f)[8]) { u32x4 w; w.x = cvt_pk_bf16(f[0], f[1]); w.y = cvt_pk_bf16(f[2], f[3]); w.z = cvt_pk_bf16(f[4], f[5]); w.w = cvt_pk_bf16(f[6], f[7]); return w; }
__device__ __forceinline__ float sumsq8(const u32x4 v) { float f[8]; unpack8(v, f); float s = 0.f;
#pragma unroll
    for (int j = 0; j < 8; ++j) s += f[j] * f[j];
    return s; }
__device__ __forceinline__ u32x4 scale8(const u32x4 v, const float rs, const float* w) { float f[8]; unpack8(v, f); const f32x4 w0 = *(const f32x4*)w, w1 = *(const f32x4*)(w + 4);
    f[0] *= rs * w0[0]; f[1] *= rs * w0[1]; f[2] *= rs * w0[2]; f[3] *= rs * w0[3]; f[4] *= rs * w1[0]; f[5] *= rs * w1[1]; f[6] *= rs * w1[2]; f[7] *= rs * w1[3]; return pack8(f); }
__device__ __forceinline__ u32x4 scale8r(const u32x4 v, const float rs, const float (&w)[8]) { float f[8]; unpack8(v, f);
#pragma unroll
    for (int j = 0; j < 8; ++j) f[j] *= rs * w[j];
    return pack8(f); }
__device__ __forceinline__ u32x4 scale8s(const u32x4 v, const float rs) { float f[8]; unpack8(v, f);
#pragma unroll
    for (int j = 0; j < 8; ++j) f[j] *= rs;
    return pack8(f); }
__device__ __forceinline__ void unpack4(const u32x2 v, float (&f)[4]) { f[0] = bf_lo(v.x); f[1] = bf_hi(v.x); f[2] = bf_lo(v.y); f[3] = bf_hi(v.y); }

#define XB_TMO      128
#define XB_XCNT(j)  (256  + 64 * (j))
#define XB_XSUB(j)  (1280 + 64 * (j))
#define XB_XGEN(j)  (2304 + 64 * (j))
#define XB_TOP      3328
#define XB_TOPGEN   3392
#define XCD_BAR_WORDS 3456
#define XB_SPIN_CAP (1u << 22)
__device__ __forceinline__ unsigned xb_ld(unsigned* p)              { return __hip_atomic_load(p, __ATOMIC_RELAXED, __HIP_MEMORY_SCOPE_AGENT); }
__device__ __forceinline__ unsigned xb_add(unsigned* p, unsigned v) { return __hip_atomic_fetch_add(p, v, __ATOMIC_RELAXED, __HIP_MEMORY_SCOPE_AGENT); }
__device__ __forceinline__ unsigned xb_xcc_id() { return (unsigned)__builtin_amdgcn_s_getreg((3 << 11) | 20) & 0xFu; }
#define XB_SPIN(cond, bar) do { unsigned _sp = 0; while (cond) { __builtin_amdgcn_s_sleep(1); \
    if ((++_sp & 255u) == 0u) { if (xb_ld(&(bar)[XB_TMO])) break; if (_sp > XB_SPIN_CAP) { atomicAdd(&(bar)[XB_TMO], 1u); break; } } } } while (0)
struct XcdBarrier { unsigned* bar; unsigned x; volatile LAS unsigned* st; };
__device__ __forceinline__ XcdBarrier xcd_barrier_post(unsigned* bar, volatile LAS unsigned* st, const int wv) {
    XcdBarrier b; b.bar = bar; b.x = xb_xcc_id(); b.st = st;
    if (wv == 0 && lane_id() == 0) (void)xb_add(&bar[XB_XCNT(b.x)], 1u);
    return b;
}
__device__ __forceinline__ void xcd_barrier_complete(unsigned* bar, unsigned x, unsigned& nloc, unsigned& nx) {
    const unsigned G = gridDim.x * gridDim.y * gridDim.z;
    unsigned sum, cnt, mine, sp = 0u;
    for (;;) {
        sum = 0u; cnt = 0u; mine = 0u;
#pragma unroll
        for (unsigned j = 0; j < 16; ++j) { const unsigned c = xb_ld(&bar[XB_XCNT(j)]); sum += c; cnt += (c > 0u) ? 1u : 0u; mine = (j == x) ? c : mine; }
        if (sum == G) break;
        __builtin_amdgcn_s_sleep(1);
        if ((++sp & 255u) == 0u) { if (xb_ld(&bar[XB_TMO])) break; if (sp > XB_SPIN_CAP) { atomicAdd(&bar[XB_TMO], 1u); break; } }
    }
    nloc = mine > 0u ? mine : 1u; nx = cnt > 0u ? cnt : 1u;
}
__device__ __forceinline__ void xcd_barrier(const XcdBarrier& b, const int wv) {
    asm volatile("s_waitcnt vmcnt(0)" ::: "memory");
    __syncthreads();
    if (wv == 0 && lane_id() == 0) {
        unsigned* bar = b.bar;
        __builtin_amdgcn_s_waitcnt(0);
        unsigned nloc = b.st[0], nx = b.st[1];
        if (nloc == 0u) { xcd_barrier_complete(bar, b.x, nloc, nx); b.st[0] = nloc; b.st[1] = nx; }
        const unsigned old = xb_add(&bar[XB_XSUB(b.x)], 1u);
        const unsigned gen = old / nloc;
        if (old + 1u == (gen + 1u) * nloc) {
            __builtin_amdgcn_fence(__ATOMIC_RELEASE, "agent");
            asm volatile("s_waitcnt vmcnt(0)" ::: "memory");
            const unsigned og = xb_add(&bar[XB_TOP], 1u);
            const unsigned tg = og / nx;
            if (og + 1u == (tg + 1u) * nx) xb_add(&bar[XB_TOPGEN], 1u);
            else XB_SPIN(xb_ld(&bar[XB_TOPGEN]) == tg, bar);
            __builtin_amdgcn_fence(__ATOMIC_ACQUIRE, "agent");
            xb_add(&bar[XB_XGEN(b.x)], 1u);
            asm volatile("s_waitcnt vmcnt(0)" ::: "memory");
        } else {
            XB_SPIN(xb_ld(&bar[XB_XGEN(b.x)]) == gen, bar);
            __builtin_amdgcn_fence(__ATOMIC_ACQUIRE, "agent");
            asm volatile("s_waitcnt vmcnt(0)" ::: "memory");
        }
    }
    __syncthreads();
}

#ifndef MFMA_BENCH
#define MFMA_BENCH 0
#endif
#ifndef EDBL
#define EDBL 0
#endif
#ifndef KMODE
#define KMODE 0
#endif
#ifndef KDBL
#define KDBL 0
#endif
struct EpiSwiglu; struct EpiYs; struct EpiZ; struct EpiMixCat; struct EpiX1;
namespace pg8 {
constexpr int BM = 256, BK = 64, HALF = 128, HTB = HALF * BK * 2, STAGE_BYTES = 8 * HTB, NXCD = 8, WGM = 8;
__host__ __device__ __forceinline__ int lds_byte(int r, int c) { const int st = (r >> 4) * 2 + (c >> 5), rr = r & 15, cc = c & 31, ob = rr * 64 + cc * 2; return st * 1024 + (ob ^ (((ob >> 9) & 1) << 5)); }
__host__ __device__ __forceinline__ void stage_rc(int b, int& R, int& C) { const int st = b / 1024, sb = b % 1024, swz = sb ^ (((sb >> 9) & 1) << 5); R = (st >> 1) * 16 + swz / 64; C = (st & 1) * 32 + (swz % 64) / 2; }
__host__ __device__ __forceinline__ int perm32(int rho) { const int n = rho >> 4, i = rho & 15; return 8 * (i >> 2) + 4 * n + (i & 3); }
struct Unit { int pm, pn, tag; const char* pa; const char* pb; };

__device__ __forceinline__ void static_map(long L, int nM, int nN, int& pm, int& pn) {
    const int nwg = nM * nN; int wgid = (int)L;
    { const int q = nwg / NXCD, r = nwg % NXCD, xcd = wgid % NXCD, off = wgid / NXCD; wgid = (xcd < r ? xcd * (q + 1) : r * (q + 1) + (xcd - r) * q) + off; }
    const int nig = WGM * nN, gid = wgid / nig, fm = gid * WGM, gsz = (nM - fm) < WGM ? (nM - fm) : WGM;
    pm = fm + ((wgid % nig) % gsz); pn = (wgid % nig) / gsz;
}
struct DenseOrder {
    static constexpr bool GATHER = false; __device__ __forceinline__ unsigned a_off(const Unit&, int, int, int, int) const { return 0u; }
    const char* A; const char* Bt; int nM, nN, G, c; size_t tstep;
    __device__ __forceinline__ void init(const void* A_, const void* Bt_, int M, int N, int K) { A = (const char*)A_; Bt = (const char*)Bt_; nM = M / BM; nN = N / BM; G = gridDim.x; c = blockIdx.x; tstep = (size_t)BM * K * 2; }
    __device__ __forceinline__ bool next(int i, Unit& u) const {
        const long L = (long)i * G + c; if (L >= (long)nM * nN) return false;
        static_map(L, nM, nN, u.pm, u.pn); u.tag = 0; u.pa = A + (size_t)u.pm * tstep; u.pb = Bt + (size_t)u.pn * tstep; return true;
    }
};

template <int H> __device__ __forceinline__ bf16x8 half8(const i32x8 v) { const i32x4 x = H ? __builtin_shufflevector(v, v, 4, 5, 6, 7) : __builtin_shufflevector(v, v, 0, 1, 2, 3); bf16x8 r; __builtin_memcpy(&r, &x, 16); return r; }
template <class Epi, class Sched, int ES = 2>
__device__ __forceinline__ void gemm_phase(const int wv, LAS unsigned char* lds, const int K, const Sched& S, const Epi& E) {
    int tid_ = (wv << 6) | lane_id(); asm volatile("" : "+v"(tid_));
    const int tid = tid_, wid = __builtin_amdgcn_readfirstlane(tid >> 6), lane = tid & 63, wr = wid >> 2, wc = wid & 3, fr = lane & 15, fq = lane >> 4;
    const int nt = K * ES / (BK * 2);
    unsigned voffA[2], voffB[2]; int RA[2], CA[2];
#pragma unroll
    for (int i = 0; i < 2; ++i) { int R, C; stage_rc(tid * 16 + i * 8192, R, C); const int Rb = Epi::PERM ? ((R & ~31) + perm32(R & 31)) : R; RA[i] = R; CA[i] = C;
        voffA[i] = (unsigned)(R * K * ES + C * 2); voffB[i] = (unsigned)(Rb * K * ES + C * 2); }
    unsigned vA[2][2][2];
    const size_t kstep = (size_t)(BK * 2);
    const size_t hstep = (size_t)HALF * K * ES;
    const unsigned ldsw = (unsigned)wid * 1024u;
    const int aoff = lds_byte(wr * 64 + fr, fq * 8), boff = lds_byte(wc * 32 + fr, fq * 8);
#define PG8_SA(b, h) (((b) * 2 + (h)) * HTB)
#define PG8_SB(b, h) ((4 + (b) * 2 + (h)) * HTB)
#define PG8_STAGE(bufoff, gbase, voff) do { _Pragma("unroll") for (int _i = 0; _i < 2; ++_i) \
        __builtin_amdgcn_global_load_lds((const unsigned*)((const char*)(gbase) + (voff)[_i]), (LAS unsigned*)(lds + (bufoff) + ldsw + _i * 8192), 16, 0, 0); } while (0)
#define PG8_LDA(dst, b, h) do { _Pragma("unroll") for (int m = 0; m < 4; ++m) { const i32x4 _lo = *(const LAS i32x4*)(lds + PG8_SA(b, h) + aoff + m * 2048), _hi = *(const LAS i32x4*)(lds + PG8_SA(b, h) + aoff + m * 2048 + 1024); dst[m] = __builtin_shufflevector(_lo, _hi, 0, 1, 2, 3, 4, 5, 6, 7); } } while (0)
#define PG8_LDB(dst, b, h) do { _Pragma("unroll") for (int n = 0; n < 2; ++n) { const i32x4 _lo = *(const LAS i32x4*)(lds + PG8_SB(b, h) + boff + n * 2048), _hi = *(const LAS i32x4*)(lds + PG8_SB(b, h) + boff + n * 2048 + 1024); dst[n] = __builtin_shufflevector(_lo, _hi, 0, 1, 2, 3, 4, 5, 6, 7); } } while (0)
#define PG8_MMA(ai, bj, At, Bt) do { __builtin_amdgcn_s_setprio(1); _Pragma("unroll") for (int m = 0; m < 4; ++m) _Pragma("unroll") for (int n = 0; n < 2; ++n) { \
        if (ES == 2) { acc[ai][bj][m][n] = __builtin_amdgcn_mfma_f32_16x16x32_bf16(half8<0>(Bt[n]), half8<0>(At[m]), acc[ai][bj][m][n], 0, 0, 0); \
                       acc[ai][bj][m][n] = __builtin_amdgcn_mfma_f32_16x16x32_bf16(half8<1>(Bt[n]), half8<1>(At[m]), acc[ai][bj][m][n], 0, 0, 0); } \
        else asm volatile("v_mfma_scale_f32_16x16x128_f8f6f4 %0, %1, %2, %0, %3, %3 op_sel_hi:[0,0,0]" : "+v"(acc[ai][bj][m][n]) : "v"(Bt[n]), "v"(At[m]), "v"(one_scale)); } \
        __builtin_amdgcn_s_setprio(0); } while (0)
#define PG8_WAIT_V(n) asm volatile("s_waitcnt vmcnt(" #n ")" ::: "memory")
#define PG8_WAIT_L(n) asm volatile("s_waitcnt lgkmcnt(" #n ")" ::: "memory")
#define PG8_BAR __builtin_amdgcn_s_barrier()
#define PG8_SCHED __builtin_amdgcn_sched_barrier(0)
    constexpr int kd = (KDBL == 1 && (__is_same(Epi, EpiSwiglu) || __is_same(Epi, EpiYs))) || (KDBL == 2 && __is_same(Epi, EpiZ)) || (KDBL == 3 && (__is_same(Epi, EpiMixCat) || __is_same(Epi, EpiX1))) ? 1 : 0;
    Unit cur, nxt; int ui = 0;
    if (!S.next(0, cur)) return;
    f32x4 acc[2][2][4][2]; const f32x4 zz0 = zero4f();
#pragma unroll
    for (int a = 0; a < 2; ++a)
#pragma unroll
        for (int b = 0; b < 2; ++b)
#pragma unroll
            for (int m = 0; m < 4; ++m)
#pragma unroll
                for (int n = 0; n < 2; ++n) acc[a][b][m][n] = zz0;
    i32x8 At[4], B0[2], B1[2];
    const int one_scale = 0x7f7f7f7f;
    const char* cA = cur.pa; const char* cB = cur.pb;
#pragma unroll
    for (int h = 0; h < 2; ++h)
#pragma unroll
        for (int i = 0; i < 2; ++i) vA[0][h][i] = Sched::GATHER ? S.a_off(cur, h, RA[i], CA[i], K * ES) : voffA[i] + (unsigned)(h * hstep);
    if constexpr (kd && KMODE == 1) { cA = S.A; cB = S.Bt;
#pragma unroll
        for (int h = 0; h < 2; ++h)
#pragma unroll
            for (int i = 0; i < 2; ++i) vA[0][h][i] = voffA[i] + (unsigned)(h * hstep); }
    PG8_STAGE(PG8_SB(0, 0), cB, voffB); PG8_STAGE(PG8_SA(0, 0), cA, vA[0][0]); PG8_STAGE(PG8_SB(0, 1), cB + hstep, voffB); PG8_STAGE(PG8_SA(0, 1), cA, vA[0][1]);
    if (wr == 1) PG8_BAR;
    PG8_WAIT_V(4); PG8_BAR;
    PG8_STAGE(PG8_SB(1, 0), cB + kstep, voffB); PG8_STAGE(PG8_SA(1, 0), cA + kstep, vA[0][0]); PG8_STAGE(PG8_SB(1, 1), cB + hstep + kstep, voffB);
    PG8_WAIT_V(6); PG8_BAR;
    for (;;) {
        const bool has_next = S.next((ui + 1) >> kd, nxt);
        const char* nA = has_next ? nxt.pa : cA; const char* nB = has_next ? nxt.pb : cB;
#pragma unroll
        for (int h = 0; h < 2; ++h)
#pragma unroll
            for (int i = 0; i < 2; ++i) vA[1][h][i] = has_next ? (Sched::GATHER ? S.a_off(nxt, h, RA[i], CA[i], K * ES) : voffA[i] + (unsigned)(h * hstep)) : vA[0][h][i];
        if constexpr (kd && KMODE == 1) { if (has_next && (ui & 1)) { nA = S.A; nB = S.Bt;
#pragma unroll
            for (int h = 0; h < 2; ++h)
#pragma unroll
                for (int i = 0; i < 2; ++i) vA[1][h][i] = voffA[i] + (unsigned)(h * hstep); } }
        const bool ld = !(kd && KMODE == 2 && !(ui & 1));
#pragma clang loop unroll(disable)
        for (int t = 0; t < nt; t += 2) {
            if constexpr (Epi::MID) { if (t == 8 || t == 12) E.mid(acc, cur, t, wr, wc, fr, fq); }
            const bool last = (t == nt - 2);
            const char* a1 = cA + (size_t)(t + 1) * kstep;
            const char* a2 = last ? nA : cA + (size_t)(t + 2) * kstep; const char* b2 = last ? nB : cB + (size_t)(t + 2) * kstep;
            const char* a3 = a2 + kstep; const char* b3 = b2 + kstep;
            unsigned w0[2], w1[2];
#pragma unroll
            for (int i = 0; i < 2; ++i) { w0[i] = vA[0][0][i]; w1[i] = vA[0][1][i]; }
            if (last) { asm volatile("" ::: "memory");
#pragma unroll
                for (int i = 0; i < 2; ++i) { w0[i] = vA[1][0][i]; w1[i] = vA[1][1][i]; } }
            PG8_LDB(B0, 0, 0); PG8_SCHED; PG8_LDA(At, 0, 0); if (ld) PG8_STAGE(PG8_SA(1, 1), a1, vA[0][1]);
            PG8_WAIT_L(8); PG8_BAR; PG8_WAIT_L(0); PG8_MMA(0, 0, At, B0); PG8_BAR; PG8_SCHED;
            PG8_LDB(B1, 0, 1); if (ld || last) PG8_STAGE(PG8_SB(0, 0), b2, voffB);
            PG8_BAR; PG8_WAIT_L(0); PG8_MMA(0, 1, At, B1); PG8_BAR;
            PG8_LDA(At, 0, 1); if (ld || last) PG8_STAGE(PG8_SA(0, 0), a2, w0);
            PG8_BAR; PG8_WAIT_L(0); PG8_MMA(1, 0, At, B0); PG8_BAR; PG8_SCHED;
            if (ld || last) PG8_STAGE(PG8_SB(0, 1), b2 + hstep, voffB);
            PG8_WAIT_V(6); PG8_BAR; PG8_MMA(1, 1, At, B1); PG8_BAR;
            PG8_LDB(B0, 1, 0); PG8_SCHED; PG8_LDA(At, 1, 0); if (ld || last) PG8_STAGE(PG8_SA(0, 1), a2, w1);
            PG8_WAIT_L(8); PG8_BAR; PG8_WAIT_L(0); PG8_MMA(0, 0, At, B0); PG8_BAR; PG8_SCHED;
            PG8_LDB(B1, 1, 1); if (ld || last) PG8_STAGE(PG8_SB(1, 0), b3, voffB);
            PG8_BAR; PG8_WAIT_L(0); PG8_MMA(0, 1, At, B1); PG8_BAR;
            PG8_LDA(At, 1, 1); if (ld || last) PG8_STAGE(PG8_SA(1, 0), a3, w0);
            PG8_BAR; PG8_WAIT_L(0); PG8_MMA(1, 0, At, B0); PG8_BAR; PG8_SCHED;
            if (ld || last) PG8_STAGE(PG8_SB(1, 1), b3 + hstep, voffB);
            PG8_WAIT_V(6); PG8_BAR; PG8_MMA(1, 1, At, B1); PG8_BAR;
        }
        if (ES == 1) asm volatile("s_nop 15\n\ts_nop 15" ::: "memory");
        if (!kd || (ui & 1)) E(acc, cur, wr, wc, fr, fq);
        if constexpr (EDBL == 1 && (__is_same(Epi, EpiSwiglu) || __is_same(Epi, EpiYs))) { asm volatile("" ::: "memory"); E(acc, cur, wr, wc, fr, fq); }
        if (!has_next) break;
        const f32x4 zz1 = zero4f();
#pragma unroll
        for (int a = 0; a < 2; ++a)
#pragma unroll
            for (int b = 0; b < 2; ++b)
#pragma unroll
                for (int m = 0; m < 4; ++m)
#pragma unroll
                    for (int n = 0; n < 2; ++n) acc[a][b][m][n] = zz1;
        cur = nxt; cA = nA; cB = nB; ++ui;
#pragma unroll
        for (int h = 0; h < 2; ++h)
#pragma unroll
            for (int i = 0; i < 2; ++i) vA[0][h][i] = vA[1][h][i];
    }
    PG8_WAIT_V(0);
    if (wr == 0) PG8_BAR;
    PG8_BAR;
#undef PG8_SA
#undef PG8_SB
#undef PG8_STAGE
#undef PG8_LDA
#undef PG8_LDB
#undef PG8_MMA
#undef PG8_WAIT_V
#undef PG8_WAIT_L
#undef PG8_BAR
#undef PG8_SCHED
}
}
using pg8::Unit;

struct EpiZ {
    static constexpr bool PERM = true, MID = false;
    bf16_t* Z; bf16_t* KV; bf16_t* GFp; int pn0; float scale;
    __device__ __forceinline__ void operator()(const f32x4 (&acc)[2][2][4][2], const Unit& u, int wr, int wc, int fr, int fq) const {
        const bool kvu = u.pn >= 32; const int pn = (u.pn & 31) + (kvu ? 0 : pn0);
        bf16_t* base = kvu ? KV : Z; const int ldc = kvu ? 1024 : INC; const bool sg = (!kvu) && (pn >= C_GATE / 256);
        if (sg) {
            bf16_t* gf = GFp + ((size_t)(u.pm * 12 + (pn - C_GATE / 256)) * 16) * 4096 + (size_t)((wr * 4 + wc) * 64 + fq * 16 + fr) * 8;
#pragma unroll
            for (int ai = 0; ai < 2; ++ai)
#pragma unroll
                for (int m = 0; m < 4; ++m)
#pragma unroll
                    for (int bj = 0; bj < 2; ++bj) { f32x4 v0 = acc[ai][bj][m][0] * scale, v1 = acc[ai][bj][m][1] * scale;
#pragma unroll
                        for (int j = 0; j < 4; ++j) { v0[j] = sigmoidf_(v0[j]); v1[j] = sigmoidf_(v1[j]); }
                        u32x4 w; w.x = cvt_pk_bf16(v0[0], v0[1]); w.y = cvt_pk_bf16(v0[2], v0[3]); w.z = cvt_pk_bf16(v1[0], v1[1]); w.w = cvt_pk_bf16(v1[2], v1[3]);
                        *(u32x4*)(gf + (size_t)((ai * 4 + m) * 2 + bj) * 4096) = w; }
            return; }
        const int row0 = u.pm * 256 + wr * 64 + fr, col0 = pn * 256 + wc * 32 + 8 * fq;
#pragma unroll
        for (int ai = 0; ai < 2; ++ai)
#pragma unroll
            for (int m = 0; m < 4; ++m) { bf16_t* rowp = base + (size_t)(row0 + ai * 128 + m * 16) * ldc + col0;
#pragma unroll
                for (int bj = 0; bj < 2; ++bj) { f32x4 v0 = acc[ai][bj][m][0] * scale, v1 = acc[ai][bj][m][1] * scale;
                    if (sg) {
#pragma unroll
                        for (int j = 0; j < 4; ++j) { v0[j] = sigmoidf_(v0[j]); v1[j] = sigmoidf_(v1[j]); } }
                    u32x4 w; w.x = cvt_pk_bf16(v0[0], v0[1]); w.y = cvt_pk_bf16(v0[2], v0[3]); w.z = cvt_pk_bf16(v1[0], v1[1]); w.w = cvt_pk_bf16(v1[2], v1[3]);
                    *(u32x4*)(rowp + bj * 128) = w; } }
    }
};
struct SchedZ8 {
    static constexpr bool GATHER = false; __device__ __forceinline__ unsigned a_off(const Unit&, int, int, int, int) const { return 0u; }
    const char* H8; const char* WIN8; int G, c;
    __device__ __forceinline__ bool next(int i, Unit& u) const {
        const long L = (long)i * G + c; if (L >= 64 * 23) return false;
        pg8::static_map(L, 64, 23, u.pm, u.pn); u.tag = 0; u.pa = H8 + (size_t)u.pm * (256 * 1024); u.pb = WIN8 + (size_t)u.pn * (256 * 1024); return true;
    }
};
struct SchedZ {
    static constexpr bool GATHER = false; __device__ __forceinline__ unsigned a_off(const Unit&, int, int, int, int) const { return 0u; }
    const char* H; const char* WinT; const char* HM; const char* WmkvT; int G, c;
    __device__ __forceinline__ bool next(int i, Unit& u) const {
        const long L = (long)i * G + c; if (L >= 480) return false;
        const size_t tstep = (size_t)256 * 1024 * 2;
        if (L < 448) { pg8::static_map(L, 64, 7, u.pm, u.pn); u.tag = 0; u.pa = H + (size_t)u.pm * tstep; u.pb = WinT + (size_t)u.pn * tstep; }
        else { const int q = (int)(L - 448); u.pm = q >> 2; u.pn = 32 + (q & 3); u.tag = 0; u.pa = HM + (size_t)u.pm * tstep; u.pb = WmkvT + (size_t)(q & 3) * tstep; }
        return true;
    }
};
struct EpiLora {
    static constexpr bool PERM = false, MID = false;
    float* L; const float* w0; const float* a0;
    __device__ __forceinline__ void operator()(const f32x4 (&acc)[2][2][4][2], const Unit& u, int wr, int wc, int fr, int fq) const {
        const int row0 = u.pm * 256 + wr * 64 + fr, col0 = u.pn * 256 + wc * 32 + 4 * fq; const int kind = u.pn >> 1; const f32x4 zb = zero4f();
#pragma unroll
        for (int bj = 0; bj < 2; ++bj)
#pragma unroll
            for (int n = 0; n < 2; ++n) { const int c = col0 + bj * 128 + n * 16;
                f32x4 bv = zb;
                if (kind == 0) bv = *(const f32x4*)(w0 + c); else if (kind == 1) bv = *(const f32x4*)(a0 + (c - 512));
#pragma unroll
                for (int ai = 0; ai < 2; ++ai)
#pragma unroll
                    for (int m = 0; m < 4; ++m) { f32x4 v = acc[ai][bj][m][n] + bv;
                        if (kind == 0) {
#pragma unroll
                            for (int j = 0; j < 4; ++j) v[j] = -0.60653066f * sigmoidf_(v[j]); }
                        else if (kind == 1) {
#pragma unroll
                            for (int j = 0; j < 4; ++j) v[j] = sigmoidf_(v[j]); }
                        const size_t row = (size_t)(row0 + ai * 128 + m * 16);
                        if (kind == 0) *(f32x4*)(L + row * 512 + c) = v;
                        else { u32x2 w; w.x = cvt_pk_bf16(v[0], v[1]); w.y = cvt_pk_bf16(v[2], v[3]); *(u32x2*)((bf16_t*)(L + (size_t)NTOK * 512) + row * 1024 + (c - 512)) = w; } } }
    }
};
template <int mode> struct EpiMix {
    static constexpr bool PERM = false, MID = false;
    float* mix32; bf16_t* mixbf; const bf16_t* Z;
    __device__ __forceinline__ void operator()(const f32x4 (&acc)[2][2][4][2], const Unit& u, int wr, int wc, int fr, int fq) const {
        const int row0 = u.pm * 256 + wr * 64 + fr, col0 = u.pn * 256 + wc * 32 + 4 * fq;
#pragma unroll
        for (int ai = 0; ai < 2; ++ai)
#pragma unroll
            for (int m = 0; m < 4; ++m) { const size_t row = (size_t)(row0 + ai * 128 + m * 16);
#pragma unroll
                for (int bj = 0; bj < 2; ++bj)
#pragma unroll
                    for (int n = 0; n < 2; ++n) { const int c = col0 + bj * 128 + n * 16;
                        const u32x2 gz = *(const u32x2*)(Z + row * INC + C_GATE + mode * 1024 + c); float g[4]; unpack4(gz, g);
                        f32x4 v = acc[ai][bj][m][n]; v[0] *= g[0]; v[1] *= g[1]; v[2] *= g[2]; v[3] *= g[3];
                        if (mode > 0) v += *(const f32x4*)(mix32 + row * 1024 + c);
                        if (mode < 2) *(f32x4*)(mix32 + row * 1024 + c) = v;
                        else { u32x2 w; w.x = cvt_pk_bf16(v[0], v[1]); w.y = cvt_pk_bf16(v[2], v[3]); *(u32x2*)(mixbf + row * 1024 + c) = w; } }
                asm volatile("" ::: "memory"); }
    }
};
struct EpiMixCat {
    static constexpr bool PERM = true, MID = true;
    bf16_t* mixbf; const bf16_t* GF; int tid;
    __device__ __forceinline__ const bf16_t* gtile(const Unit& u, int b) const { return GF + ((size_t)(u.pm * 12 + 4 * b + u.pn) * 16) * 4096 + (size_t)tid * 8; }
    __device__ __forceinline__ void mid(f32x4 (&acc)[2][2][4][2], const Unit& u, int t, int wr, int wc, int fr, int fq) const {
        const int ga = (t == 8) ? 0 : 1; int off = 0; asm volatile("" : "+v"(off));
        const bf16_t* pa = gtile(u, ga) + off; const bf16_t* pb = gtile(u, ga + 1) + off;
#pragma unroll
        for (int ai = 0; ai < 2; ++ai) {
#pragma unroll
            for (int m = 0; m < 4; ++m)
#pragma unroll
                for (int bj = 0; bj < 2; ++bj) { float a[8], b[8]; unpack8(*(const u32x4*)(pa + (size_t)((ai * 4 + m) * 2 + bj) * 4096), a); unpack8(*(const u32x4*)(pb + (size_t)((ai * 4 + m) * 2 + bj) * 4096), b);
#pragma unroll
                    for (int j = 0; j < 4; ++j) { acc[ai][bj][m][0][j] *= a[j] * __builtin_amdgcn_rcpf(b[j]); acc[ai][bj][m][1][j] *= a[4 + j] * __builtin_amdgcn_rcpf(b[4 + j]); } }
            asm volatile("" ::: "memory"); }
    }
    __device__ __forceinline__ void operator()(const f32x4 (&acc)[2][2][4][2], const Unit& u, int wr, int wc, int fr, int fq) const {
        const int row0 = u.pm * 256 + wr * 64 + fr, col0 = u.pn * 256 + wc * 32 + 8 * fq; const bf16_t* pg = gtile(u, 2);
#pragma unroll
        for (int ai = 0; ai < 2; ++ai)
#pragma unroll
            for (int m = 0; m < 4; ++m) { bf16_t* rowp = mixbf + (size_t)(row0 + ai * 128 + m * 16) * 1024 + col0;
#pragma unroll
                for (int bj = 0; bj < 2; ++bj) { float g[8]; unpack8(*(const u32x4*)(pg + (size_t)((ai * 4 + m) * 2 + bj) * 4096), g);
                    const f32x4 v0 = acc[ai][bj][m][0], v1 = acc[ai][bj][m][1];
                    u32x4 w; w.x = cvt_pk_bf16(v0[0] * g[0], v0[1] * g[1]); w.y = cvt_pk_bf16(v0[2] * g[2], v0[3] * g[3]); w.z = cvt_pk_bf16(v1[0] * g[4], v1[1] * g[5]); w.w = cvt_pk_bf16(v1[2] * g[6], v1[3] * g[7]);
                    *(u32x4*)(rowp + bj * 128) = w; } }
    }
};
struct EpiX1 {
    static constexpr bool PERM = true, MID = false;
    const float* x; bf16_t* x1;
    __device__ __forceinline__ void operator()(const f32x4 (&acc)[2][2][4][2], const Unit& u, int wr, int wc, int fr, int fq) const {
        const int row0 = u.pm * 256 + wr * 64 + fr, col0 = u.pn * 256 + wc * 32 + 8 * fq;
#pragma unroll
        for (int ai = 0; ai < 2; ++ai)
#pragma unroll
            for (int m = 0; m < 4; ++m) { const size_t off = (size_t)(row0 + ai * 128 + m * 16) * 1024 + col0;
#pragma unroll
                for (int bj = 0; bj < 2; ++bj) { const f32x4 a = __builtin_nontemporal_load((const f32x4*)(x + off + bj * 128)) + acc[ai][bj][m][0], b = __builtin_nontemporal_load((const f32x4*)(x + off + bj * 128 + 4)) + acc[ai][bj][m][1];
                    u32x4 w; w.x = cvt_pk_bf16(a[0], a[1]); w.y = cvt_pk_bf16(a[2], a[3]); w.z = cvt_pk_bf16(b[0], b[1]); w.w = cvt_pk_bf16(b[2], b[3]);
                    *(u32x4*)(x1 + off + bj * 128) = w; }
                if (m & 1) asm volatile("" ::: "memory"); }
    }
};
struct EpiSwiglu {
    static constexpr bool PERM = true, MID = false;
    unsigned char* act; const float* b1;
    __device__ __forceinline__ void operator()(const f32x4 (&acc)[2][2][4][2], const Unit& u, int wr, int wc, int fr, int fq) const {
        const int row0 = u.pm * 256 + wr * 64 + fr; const float* be = b1 + (size_t)u.tag * 2048; const int j = 128 * u.pn + 32 * wc + 8 * fq;
        constexpr float CS = -1.702f * 1.44269504f, ICS = 1.0f / CS;
        float bg[8], bl[8];
#pragma unroll
        for (int q = 0; q < 4; ++q) { const f32x4 t = *(const f32x4*)(be + 2 * j + 4 * q); bg[2 * q] = t[0] * CS; bl[2 * q] = (4.0f * t[1] + 4.0f) * ICS; bg[2 * q + 1] = t[2] * CS; bl[2 * q + 1] = (4.0f * t[3] + 4.0f) * ICS; }
#pragma unroll
        for (int ai = 0; ai < 2; ++ai)
#pragma unroll
            for (int m = 0; m < 4; ++m) { float o[8];
#pragma unroll
                for (int n = 0; n < 2; ++n)
#pragma unroll
                    for (int i = 0; i < 4; ++i) { const float sg = fmaxf(fmaf(acc[ai][0][m][n][i], CS / 256.0f, bg[4 * n + i]), 7.0f * CS);
                        const float ql = __builtin_amdgcn_fmed3f(fmaf(acc[ai][1][m][n][i], 4.0f * ICS / 256.0f, bl[4 * n + i]), -24.0f * ICS, 32.0f * ICS);
                        o[4 * n + i] = sg * __builtin_amdgcn_rcpf(1.0f + __builtin_amdgcn_exp2f(sg)) * ql; }
                u32x2 w; w.x = pack4_fp8(o[0], o[1], o[2], o[3]); w.y = pack4_fp8(o[4], o[5], o[6], o[7]);
                *(u32x2*)(act + (size_t)(row0 + ai * 128 + m * 16) * 1024 + j) = w; }
    }
};
struct EpiYs {
    static constexpr bool PERM = true, MID = false;
    bf16_t* ys; const float* b2;
    __device__ __forceinline__ void operator()(const f32x4 (&acc)[2][2][4][2], const Unit& u, int wr, int wc, int fr, int fq) const {
        const int row0 = u.pm * 256 + wr * 64 + fr, col0 = u.pn * 256 + wc * 32 + 8 * fq; const float* be = b2 + (size_t)u.tag * 1024;
#pragma unroll
        for (int bj = 0; bj < 2; ++bj) { const f32x4 c0 = *(const f32x4*)(be + col0 + bj * 128), c1 = *(const f32x4*)(be + col0 + bj * 128 + 4);
#pragma unroll
            for (int ai = 0; ai < 2; ++ai)
#pragma unroll
                for (int m = 0; m < 4; ++m) { const f32x4 v0 = acc[ai][bj][m][0] * (1.0f / 128.0f) + c0, v1 = acc[ai][bj][m][1] * (1.0f / 128.0f) + c1;
                    u32x4 w; w.x = cvt_pk_bf16(v0[0], v0[1]); w.y = cvt_pk_bf16(v0[2], v0[3]); w.z = cvt_pk_bf16(v1[0], v1[1]); w.w = cvt_pk_bf16(v1[2], v1[3]);
                    *(u32x4*)(ys + (size_t)(row0 + ai * 128 + m * 16) * 1024 + col0 + bj * 128) = w; } }
    }
};
template <bool GATHER_> struct SchedMoe {
    static constexpr bool GATHER = GATHER_;
    const char* A; const char* Bt; const LAS int* tstart; const int* stok; int lgN, total; size_t estride, tbytes;
    __device__ __forceinline__ bool next(int i, Unit& u) const {
        const int c = blockIdx.x; const int un = i * 256 + (c & 7) * 32 + (c >> 3); if (un >= total) return false;
        const int mt = un >> lgN, pn = un & ((1 << lgN) - 1); const int e = ((const LAS unsigned char*)tstart)[(LX_TEXP - LX_TSTART) + mt];
        u.pm = mt; u.pn = pn; u.tag = e; u.pa = GATHER ? A : A + (size_t)mt * tbytes; u.pb = Bt + (size_t)e * estride + (size_t)pn * tbytes; return true;
    }
    __device__ __forceinline__ unsigned a_off(const Unit& u, int h, int R, int C, int rowbytes) const { const int tok = stok[u.pm * 256 + h * 128 + R]; return (unsigned)(tok * rowbytes + C * 2); }
};

__device__ __forceinline__ int w1perm(int c) { const int j = c >> 1, s = c & 1; return ((j >> 7) << 8) | (s << 7) | (j & 127); }
__device__ __forceinline__ void phase_prep(const int wv, LAS unsigned char* lds) {
    KParams& p = *kparams();
    const int tid = opaque_tid(wv); unsigned char* ws = p.ws;
    LAS float* tile = (LAS float*)lds;
    struct TileJob { const float* src; bf16_t* dst; unsigned char* dst8; int K, N, perm, f8, ldd, k0, n0; };
    auto decode = [&](int t) -> TileJob { TileJob j; j.dst = nullptr; j.dst8 = nullptr; j.f8 = 0; j.perm = 0; j.ldd = 0; int lt;
        if (t < 960) { j.src = p.in[3]; j.dst = (bf16_t*)(ws + OFF_WINT); j.K = 1024; j.N = 7680; lt = t; if ((lt % 120) >= 28) { j.f8 = 1; j.dst8 = ws + OFF_WIN8 - (size_t)1792 * 1024; } }
        else if (t < 1088) { j.src = p.in[18]; j.dst = (bf16_t*)(ws + OFF_WMKVT); j.K = 1024; j.N = 1024; lt = t - 960; }
        else if (t < 1152) { j.src = p.in[21]; j.dst = (bf16_t*)(ws + OFF_PCAT); j.K = 512; j.N = 1024; lt = t - 1088; j.ldd = 1280; }
        else if (t < 1184) { j.src = p.in[22]; j.dst = (bf16_t*)(ws + OFF_PCAT) + 512; j.K = 256; j.N = 1024; lt = t - 1152; j.ldd = 1280; }
        else if (t < 1248) { j.src = p.in[23]; j.dst = (bf16_t*)(ws + OFF_PCAT) + 768; j.K = 512; j.N = 1024; lt = t - 1184; j.ldd = 1280; }
        else if (t < 1376) { j.src = p.in[24]; j.dst = (bf16_t*)(ws + OFF_WOT); j.K = 1024; j.N = 1024; lt = t - 1248; }
        else if (t < 9568) { const int q = t - 1376, e = q >> 8; j.src = p.in[28] + (size_t)e * 1024 * 2048; j.dst8 = ws + OFF_W1T + (size_t)e * 2048 * 1024; j.K = 1024; j.N = 2048; j.perm = 1; lt = q & 255; j.f8 = 1; }
        else { const int q = t - 9568, e = q >> 7; j.src = p.in[30] + (size_t)e * 1024 * 1024; j.dst8 = ws + OFF_W2T + (size_t)e * 1024 * 1024; j.K = 1024; j.N = 1024; lt = q & 127; j.f8 = 1; }
        const int tn = j.N >> 6; j.k0 = (lt / tn) * 128; j.n0 = (lt % tn) * 64; return j; };
    { const int G = (int)gridDim.x; int t = 13663 - (int)blockIdx.x;
      auto ldtile = [&](const TileJob& j, f32x4 (&v)[4]) {
#pragma unroll
          for (int i = 0; i < 4; ++i) { const int idx = tid + 512 * i, row = idx >> 4, c4 = idx & 15; v[i] = __builtin_nontemporal_load((const f32x4*)(j.src + (size_t)(j.k0 + row) * j.N + j.n0 + 4 * c4)); } };
      TileJob j0 = decode(t < 0 ? 0 : t), j1 = decode(t - G < 0 ? 0 : t - G); f32x4 v0[4], v1[4];
      if (t >= 0) ldtile(j0, v0);
      if (t - G >= 0) ldtile(j1, v1);
      for (; t >= 0; t -= G) {
#pragma unroll
          for (int i = 0; i < 4; ++i) { const int idx = tid + 512 * i, row = idx >> 4, c4 = idx & 15; LAS float* tp = tile + row * 65 + 4 * c4; tp[0] = v0[i][0]; tp[1] = v0[i][1]; tp[2] = v0[i][2]; tp[3] = v0[i][3]; }
          __syncthreads();
          const TileJob cur = j0; j0 = j1;
#pragma unroll
          for (int i = 0; i < 4; ++i) v0[i] = v1[i];
          if (t - 2 * G >= 0) { j1 = decode(t - 2 * G); ldtile(j1, v1); }
          if (!cur.f8) {
#pragma unroll
              for (int i = 0; i < 2; ++i) { const int kc = (tid & 3) | (((tid >> 8) & 1) << 2) | (i << 3), n = (tid >> 2) & 63; float f[8];
#pragma unroll
                  for (int j = 0; j < 8; ++j) f[j] = tile[(kc * 8 + j) * 65 + n];
                  const int drow = cur.n0 + n;
                  *(u32x4*)(cur.dst + (size_t)drow * (cur.ldd ? cur.ldd : cur.K) + cur.k0 + kc * 8) = pack8(f); }
          } else {
              const int kc = (tid & 3) | (((tid >> 8) & 1) << 2), n = (tid >> 2) & 63; float f[16];
#pragma unroll
              for (int j = 0; j < 16; ++j) f[j] = tile[(kc * 16 + j) * 65 + n] * 32.0f;
              const int drow = cur.perm ? w1perm(cur.n0 + n) : (cur.n0 + n);
              u32x4 w; w.x = pack4_fp8(f[0], f[1], f[2], f[3]); w.y = pack4_fp8(f[4], f[5], f[6], f[7]); w.z = pack4_fp8(f[8], f[9], f[10], f[11]); w.w = pack4_fp8(f[12], f[13], f[14], f[15]);
              *(u32x4*)(cur.dst8 + (size_t)drow * cur.K + cur.k0 + kc * 16) = w; }
          __syncthreads(); } }
    { const float* w2 = p.in[6]; const float* a2 = p.in[8]; const float* g2 = p.in[9]; bf16_t* lt = (bf16_t*)(ws + OFF_LORAT);
      for (int idx = blockIdx.x * 512 + tid; idx < 1536 * 32; idx += gridDim.x * 512) { const int n = idx >> 5, kc = idx & 31; float f[8];
#pragma unroll
          for (int j = 0; j < 8; ++j) { const int k = kc * 8 + j; float val = 0.f;
              if (n < 512) { if (k < 64) val = w2[k * 512 + n]; }
              else if (n < 1024) { if (k >= 64 && k < 128) val = a2[(k - 64) * 512 + (n - 512)]; }
              else { if (k >= 128) val = g2[(k - 128) * 512 + (n - 1024)]; }
              f[j] = val; }
          *(u32x4*)(lt + (size_t)n * 256 + kc * 8) = pack8(f); } }
    { const float* wr = p.in[26]; bf16_t* wt = (bf16_t*)(ws + OFF_WRT);
      for (int idx = blockIdx.x * 512 + tid; idx < 32 * 1024; idx += gridDim.x * 512) { const int e = idx >> 10, k = idx & 1023; const float v = wr[k * 32 + e];
          const unsigned hi = cvt_pk_bf16(v, 0.f) & 0xffffu; const float vh = __uint_as_float(hi << 16); const unsigned lo = cvt_pk_bf16(v - vh, 0.f) & 0xffffu;
          wt[idx] = (bf16_t)hi; wt[32768 + idx] = (bf16_t)lo; } }
    { const int wid = tid >> 6, lane = tid & 63; const int gw = blockIdx.x * 8 + wid, nw = gridDim.x * 8;
      for (int row0 = gw; row0 < NTOK + 2048; row0 += 3 * nw) {
          f32x4 v[3][4];
#pragma unroll
          for (int r3 = 0; r3 < 3; ++r3) { const int row = row0 + r3 * nw; if (row < NTOK + 2048) { const float* src = row >= NTOK ? p.in[1] + (size_t)(row - NTOK) * 1024 : p.in[0] + (size_t)row * 1024;
#pragma unroll
              for (int i = 0; i < 4; ++i) v[r3][i] = __builtin_nontemporal_load((const f32x4*)(src + 4 * lane + 256 * i)); } }
#pragma unroll
          for (int r3 = 0; r3 < 3; ++r3) { const int row = row0 + r3 * nw; if (row >= NTOK + 2048) break;
              const bool ism = row >= NTOK; const float* gain = ism ? p.in[17] : p.in[2]; bf16_t* dst = ism ? (bf16_t*)(ws + OFF_HM) + (size_t)(row - NTOK) * 1024 : (bf16_t*)(ws + OFF_H) + (size_t)row * 1024;
              float ss = 0.f;
#pragma unroll
              for (int i = 0; i < 4; ++i) ss += v[r3][i][0] * v[r3][i][0] + v[r3][i][1] * v[r3][i][1] + v[r3][i][2] * v[r3][i][2] + v[r3][i][3] * v[r3][i][3];
              ss = red64(ss); const float rs = rsqrtf(ss * (1.0f / 1024.0f) + 1e-5f);
#pragma unroll
              for (int i = 0; i < 4; ++i) { const f32x4 g = *(const f32x4*)(gain + 4 * lane + 256 * i); const f32x4 y = v[r3][i] * rs * g;
                  u32x2 w; w.x = cvt_pk_bf16(y[0], y[1]); w.y = cvt_pk_bf16(y[2], y[3]);
                  *(u32x2*)(dst + 4 * lane + 256 * i) = w;
                  if (!ism) *(unsigned*)(ws + OFF_H8 + (size_t)row * 1024 + 4 * lane + 256 * i) = pack4_fp8(y[0] * 8.0f, y[1] * 8.0f, y[2] * 8.0f, y[3] * 8.0f); } } }
    }
}

__device__ __forceinline__ void phase_elem_c(const int wv) {
    KParams& p = *kparams();
    const int gt = blockIdx.x * 512 + opaque_tid(wv), nthr = gridDim.x * 512; unsigned char* ws = p.ws;
    bf16_t* Z = (bf16_t*)(ws + OFF_Z); bf16_t* AL = (bf16_t*)(ws + OFF_ALORA); bf16_t* KV = (bf16_t*)(ws + OFF_KV);
    const float* mu = p.in[4];
    u32x4 za[4], zb[4]; const u32x4 zq0 = zero4u();
#pragma unroll
    for (int k = 0; k < 4; ++k) { const int idx = gt + k * nthr, t = idx >> 5, ch = idx & 31, col = C_ZW + 8 * ch;
        za[k] = *(const u32x4*)(Z + (size_t)t * INC + col);
        zb[k] = zq0; if ((t & (SEQ - 1)) != 0) zb[k] = *(const u32x4*)(Z + (size_t)(t - 1) * INC + col); }
#pragma unroll
    for (int k = 0; k < 4; ++k) { const int idx = gt + k * nthr, t = idx >> 5, ch = idx & 31, col = C_ZW + 8 * ch;
        float a[8], b[8]; unpack8(za[k], a); unpack8(zb[k], b);
        const f32x4 m0 = *(const f32x4*)(mu + col), m1 = *(const f32x4*)(mu + col + 4); const float mm[8] = {m0[0], m0[1], m0[2], m0[3], m1[0], m1[1], m1[2], m1[3]};
#pragma unroll
        for (int j = 0; j < 8; ++j) { float v = a[j] + (b[j] - a[j]) * mm[j]; if (ch < 8) v = tanhf(v); else if (ch >= 16) v = sigmoidf_(v); a[j] = v; }
        *(u32x4*)(AL + (size_t)t * 256 + 8 * ch) = pack8(a); }
}

__device__ __forceinline__ bf16x8 pack_frag(const f32x4 lo, const f32x4 hi) { u32x4 w; w.x = cvt_pk_bf16(lo[0], lo[1]); w.y = cvt_pk_bf16(lo[2], lo[3]); w.z = cvt_pk_bf16(hi[0], hi[1]); w.w = cvt_pk_bf16(hi[2], hi[3]); bf16x8 r; __builtin_memcpy(&r, &w, 16); return r; }
__device__ __forceinline__ bf16x8 tr2(LAS unsigned char* pa, LAS unsigned char* pb) { const s16x4 a = __builtin_amdgcn_ds_read_tr16_b64_v4i16((LAS s16x4*)pa), b = __builtin_amdgcn_ds_read_tr16_b64_v4i16((LAS s16x4*)pb); return __builtin_shufflevector(a, b, 0, 1, 2, 3, 4, 5, 6, 7); }
__device__ __forceinline__ bf16x8 rd2(LAS unsigned char* pa, LAS unsigned char* pb) { const s16x4 a = *(const LAS s16x4*)pa, b = *(const LAS s16x4*)pb; return __builtin_shufflevector(a, b, 0, 1, 2, 3, 4, 5, 6, 7); }
#define MFMA16(a, b, c) __builtin_amdgcn_mfma_f32_16x16x32_bf16((a), (b), (c), 0, 0, 0)
constexpr int CP_XA = 0, CP_XR = 4096, CP_XB = 8192, CP_XK = 12288, CP_VL = 16384, CP_NL = 16384, CP_WAVE = 20480;
__device__ __forceinline__ void phase_chunk_pre(const int wv, LAS unsigned char* lds) {
    KParams& p = *kparams();
    const int tid = opaque_tid(wv), wid = tid >> 6, lane = tid & 63, fr = lane & 15, fq = lane >> 4; unsigned char* ws = p.ws;
    u32x4 keep = zero4u(); if (tid == 0) keep = *(const LAS u32x4*)(lds + LDS_X);
    __syncthreads();
    LAS unsigned char* wl = lds + wid * CP_WAVE;
    const bf16_t* Z = (const bf16_t*)(ws + OFF_Z); const float* L = (const float*)(ws + OFF_L); const bf16_t* AG = (const bf16_t*)(L + (size_t)NTOK * 512); bf16_t* C1 = (bf16_t*)(ws + OFF_C1); bf16_t* C2 = (bf16_t*)(ws + OFF_C2);
    const float* mu = p.in[4]; const float* k_k = p.in[10]; const float* k_a = p.in[11]; const float* r_k = p.in[12]; const float* ln_w = p.in[13]; const float* ln_b = p.in[14];
    const f32x4 z4 = zero4f();
    for (int pr = blockIdx.x * 8 + wid; pr < 4096; pr += gridDim.x * 8) {
        float gamC;
        { const int bh = pr >> 6, cc = pr & 63, b_ = bh >> 3, h_ = bh & 7; const int tok0 = b_ * SEQ + cc * 32; const int c = h_ * 64 + lane;
          const bf16_t* zp = Z + (size_t)tok0 * INC + c; const float* lp = L + (size_t)tok0 * 512 + c; const bf16_t* gp = AG + (size_t)tok0 * 1024 + c;
          const float mur = mu[c], muk = mu[C_K + c], muv = mu[C_V + c], kk_ = k_k[c], ka_ = k_a[c], rk_ = r_k[c], lnw = ln_w[c], lnb = ln_b[c];
          float pzr = 0.f, pzk = 0.f, pzv = 0.f;
          if (cc != 0) { pzr = __uint_as_float((unsigned)zp[-INC] << 16); pzk = __uint_as_float((unsigned)zp[-INC + C_K] << 16); pzv = __uint_as_float((unsigned)zp[-INC + C_V] << 16); }
          unsigned short zq[2][4][3], gq[2][4][2]; float lq[2][4];
#pragma unroll
          for (int e = 0; e < 4; ++e) {
#pragma unroll
              for (int q = 0; q < 3; ++q) zq[0][e][q] = zp[(size_t)e * INC + q * 512];
              lq[0][e] = lp[(size_t)e * 512]; gq[0][e][0] = gp[(size_t)e * 1024]; gq[0][e][1] = gp[(size_t)e * 1024 + 512]; }
          __builtin_amdgcn_sched_barrier(0);
          float cs = 0.f, g = 1.0f;
#pragma unroll
          for (int t4 = 0; t4 < 8; ++t4) { unsigned pa[2], pr_[2], pb[2], pk[2];
              if (t4 < 7) {
#pragma unroll
                  for (int e = 0; e < 4; ++e) {
#pragma unroll
                      for (int q = 0; q < 3; ++q) zq[(t4 + 1) & 1][e][q] = zp[(size_t)((t4 + 1) * 4 + e) * INC + q * 512];
                      lq[(t4 + 1) & 1][e] = lp[(size_t)((t4 + 1) * 4 + e) * 512]; gq[(t4 + 1) & 1][e][0] = gp[(size_t)((t4 + 1) * 4 + e) * 1024]; gq[(t4 + 1) & 1][e][1] = gp[(size_t)((t4 + 1) * 4 + e) * 1024 + 512]; } }
              __builtin_amdgcn_sched_barrier(0);
#pragma unroll
              for (int tp = 0; tp < 2; ++tp) { float va[2], vr[2], vb[2], vk[2];
#pragma unroll
                  for (int e = 0; e < 2; ++e) { const int te = tp * 2 + e, t = t4 * 4 + te;
                      const float zr = __uint_as_float((unsigned)zq[t4 & 1][te][0] << 16), zk = __uint_as_float((unsigned)zq[t4 & 1][te][1] << 16), zv = __uint_as_float((unsigned)zq[t4 & 1][te][2] << 16);
                      const float r = zr + (pzr - zr) * mur, k = zk + (pzk - zk) * muk, v = zv + (pzv - zv) * muv; pzr = zr; pzk = zk; pzv = zv;
                      const float lw = lq[t4 & 1][te], al = __uint_as_float((unsigned)gq[t4 & 1][te][0] << 16), gg = __uint_as_float((unsigned)gq[t4 & 1][te][1] << 16);
                      const float kk = k * kk_, kp = k * (1.0f + (al - 1.0f) * ka_);
                      const float n2 = red64(kk * kk), bon = red64(r * kp * rk_);
                      const float kn = kk * __builtin_amdgcn_rsqf(fmaxf(n2, 1e-24f));
                      const float gm1 = g; cs += lw; g = __builtin_amdgcn_exp2f(cs * 1.44269504f); const float gi = __builtin_amdgcn_rcpf(g);
                      va[e] = -kn * gm1; vb[e] = kn * al * gi; vk[e] = kp * gi; vr[e] = r * g;
                      *(LAS bf16_t*)(wl + CP_VL + t * 128 + lane * 2) = (bf16_t)(cvt_pk_bf16(v, 0.f) & 0xffffu);
                      const size_t to = (size_t)(tok0 + t) * 512 + c;
                      C1[to] = (bf16_t)(cvt_pk_bf16(lnw * gg, 0.f) & 0xffffu); C2[to] = (bf16_t)(cvt_pk_bf16((lnb + bon * v) * gg, 0.f) & 0xffffu); }
                  pa[tp] = cvt_pk_bf16(va[0], va[1]); pr_[tp] = cvt_pk_bf16(vr[0], vr[1]); pb[tp] = cvt_pk_bf16(vb[0], vb[1]); pk[tp] = cvt_pk_bf16(vk[0], vk[1]); }
              *(LAS u32x2*)(wl + CP_XA + lane * 64 + t4 * 8) = (u32x2){pa[0], pa[1]}; *(LAS u32x2*)(wl + CP_XR + lane * 64 + t4 * 8) = (u32x2){pr_[0], pr_[1]};
              *(LAS u32x2*)(wl + CP_XB + lane * 64 + t4 * 8) = (u32x2){pb[0], pb[1]}; *(LAS u32x2*)(wl + CP_XK + lane * 64 + t4 * 8) = (u32x2){pk[0], pk[1]};
              __builtin_amdgcn_sched_barrier(0); }
          gamC = g; }
        asm volatile("s_waitcnt lgkmcnt(0)" ::: "memory");
        bf16x8 Vf[4];
        { const int vtb = (4 * fq + (fr >> 2)) * 128 + (fr & 3) * 8;
#pragma unroll
          for (int nv = 0; nv < 4; ++nv) { LAS unsigned char* pp = wl + CP_VL + vtb + nv * 32; Vf[nv] = tr2(pp, pp + 2048); } }
        asm volatile("s_waitcnt lgkmcnt(0)" ::: "memory");
        const int trb = (8 * fq + (fr >> 2)) * 64 + (fr & 3) * 8;
        bf16x8 LakF[2], QrbF[2], QrkF[2];
#pragma unroll
        for (int yi = 0; yi < 2; ++yi) {
            bf16x8 fy[2][2];
#pragma unroll
            for (int nt = 0; nt < 2; ++nt)
#pragma unroll
                for (int s2 = 0; s2 < 2; ++s2) { LAS unsigned char* pp = wl + (yi ? CP_XR : CP_XA) + trb + s2 * 2048 + nt * 32; fy[nt][s2] = tr2(pp, pp + 256); }
#pragma unroll
            for (int xi = 0; xi < 2; ++xi) {
                f32x4 d[2][2];
#pragma unroll
                for (int mi = 0; mi < 2; ++mi) { bf16x8 fx[2];
#pragma unroll
                    for (int s2 = 0; s2 < 2; ++s2) { LAS unsigned char* pp = wl + (xi ? CP_XK : CP_XB) + trb + s2 * 2048 + mi * 32; fx[s2] = tr2(pp, pp + 256); }
#pragma unroll
                    for (int nt = 0; nt < 2; ++nt) {
                        if (mi == 1 && nt == 0) { d[mi][nt] = z4; continue; }
                        f32x4 acc = MFMA16(fx[0], fy[nt][0], z4); acc = MFMA16(fx[1], fy[nt][1], acc);
#pragma unroll
                        for (int j = 0; j < 4; ++j) { const int i = 16 * mi + 4 * fq + j, t = 16 * nt + fr; const bool ok = yi ? (i <= t) : (i < t); acc[j] = ok ? acc[j] : 0.f; }
                        d[mi][nt] = acc; } }
                if (yi == 0 && xi == 0) {
#pragma unroll
                    for (int mi = 0; mi < 2; ++mi)
#pragma unroll
                        for (int nt = 0; nt < 2; ++nt)
#pragma unroll
                            for (int j = 0; j < 4; ++j) *(LAS float*)(wl + CP_NL + ((16 * nt + fr) * 32 + 16 * mi + 4 * fq + j) * 4) = d[mi][nt][j];
                } else {
#pragma unroll
                    for (int nt = 0; nt < 2; ++nt) { const bf16x8 f = pack_frag(d[0][nt], d[1][nt]); if (yi == 0) LakF[nt] = f; else if (xi == 0) QrbF[nt] = f; else QrkF[nt] = f; } } } }
        asm volatile("s_waitcnt lgkmcnt(0)" ::: "memory");
        bf16x8 InvF[2];
        { const int c = lane & 31; float X[32];
#pragma unroll
          for (int t = 0; t < 32; ++t) { float a0 = (t == c) ? 1.0f : 0.f, a1 = 0.f;
#pragma unroll
              for (int i4 = 0; i4 < (t + 3) / 4; ++i4) { const f32x4 nv = *(const LAS f32x4*)(wl + CP_NL + (t * 32 + 4 * i4) * 4);
#pragma unroll
                  for (int e = 0; e < 4; ++e) if (4 * i4 + e < t) { if (e & 1) a1 = fmaf(nv[e], X[4 * i4 + e], a1); else a0 = fmaf(nv[e], X[4 * i4 + e], a0); } }
              X[t] = a0 + a1; }
          asm volatile("s_waitcnt lgkmcnt(0)" ::: "memory");
#pragma unroll
          for (int t = 0; t < 32; ++t) *(LAS float*)(wl + CP_NL + (t * 32 + c) * 4) = X[t];
          asm volatile("s_waitcnt lgkmcnt(0)" ::: "memory");
#pragma unroll
          for (int n = 0; n < 2; ++n) { const f32x4 lo = *(const LAS f32x4*)(wl + CP_NL + ((16 * n + fr) * 32 + 4 * fq) * 4), hi = *(const LAS f32x4*)(wl + CP_NL + ((16 * n + fr) * 32 + 16 + 4 * fq) * 4); InvF[n] = pack_frag(lo, hi); } }
        bf16x8 UF[4], AhF[4];
#pragma unroll
        for (int nv = 0; nv < 4; ++nv) { const f32x4 w0 = MFMA16(LakF[0], Vf[nv], z4), w1 = MFMA16(LakF[1], Vf[nv], z4); const bf16x8 wf = pack_frag(w0, w1);
            const f32x4 u0 = MFMA16(InvF[0], wf, z4), u1 = MFMA16(InvF[1], wf, z4); UF[nv] = pack_frag(u0, u1); }
#pragma unroll
        for (int nc = 0; nc < 4; ++nc) { LAS unsigned char* pp = wl + CP_XA + (16 * nc + fr) * 64 + 8 * fq; const bf16x8 af = rd2(pp, pp + 32);
            const f32x4 h0 = MFMA16(InvF[0], af, z4), h1 = MFMA16(InvF[1], af, z4); AhF[nc] = pack_frag(h0, h1); }
        { f32x4 rt[4][2];
#pragma unroll
          for (int mc = 0; mc < 4; ++mc)
#pragma unroll
              for (int nt = 0; nt < 2; ++nt) { const s16x4 rr = __builtin_amdgcn_ds_read_tr16_b64_v4i16((LAS s16x4*)(wl + CP_XR + (16 * mc + 4 * fq + (fr >> 2)) * 64 + (fr & 3) * 8 + nt * 32));
                  f32x4 cin; cin[0] = __uint_as_float((unsigned)(unsigned short)rr[0] << 16); cin[1] = __uint_as_float((unsigned)(unsigned short)rr[1] << 16); cin[2] = __uint_as_float((unsigned)(unsigned short)rr[2] << 16); cin[3] = __uint_as_float((unsigned)(unsigned short)rr[3] << 16);
                  rt[mc][nt] = MFMA16(AhF[mc], QrbF[nt], cin); }
          bf16x8* RTF = (bf16x8*)(ws + OFF_RTF) + (size_t)pr * 256;
#pragma unroll
          for (int nt = 0; nt < 2; ++nt)
#pragma unroll
              for (int s2 = 0; s2 < 2; ++s2) RTF[(nt * 2 + s2) * 64 + lane] = pack_frag(rt[2 * s2][nt], rt[2 * s2 + 1][nt]); }
        { u32x2* YLF = (u32x2*)(ws + OFF_YLF) + (size_t)pr * 512;
#pragma unroll
          for (int nv = 0; nv < 4; ++nv)
#pragma unroll
              for (int mt = 0; mt < 2; ++mt) { f32x4 y = MFMA16(QrbF[mt], UF[nv], z4); y = MFMA16(QrkF[mt], Vf[nv], y);
                  u32x2 w; w.x = cvt_pk_bf16(y[0], y[1]); w.y = cvt_pk_bf16(y[2], y[3]); YLF[(nv * 2 + mt) * 64 + lane] = w; } }
        { bf16x8* GTF = (bf16x8*)(ws + OFF_GTF) + (size_t)pr * 512; u32x2* HHF = (u32x2*)(ws + OFF_HHF) + (size_t)pr * 1024;
#pragma unroll
          for (int nc = 0; nc < 4; ++nc) { LAS unsigned char* pp = wl + CP_XB + (16 * nc + fr) * 64 + 8 * fq; const bf16x8 bf_ = rd2(pp, pp + 32);
              LAS unsigned char* pk = wl + CP_XK + (16 * nc + fr) * 64 + 8 * fq; const bf16x8 kf_ = rd2(pk, pk + 32);
              const float gcol = __int_as_float(__builtin_amdgcn_ds_bpermute((16 * nc + fr) << 2, __float_as_int(gamC)));
              f32x4 gt[4];
#pragma unroll
              for (int mc = 0; mc < 4; ++mc) { f32x4 a = MFMA16(AhF[mc], bf_, z4);
#pragma unroll
                  for (int j = 0; j < 4; ++j) { if (mc == nc && 4 * fq + j == fr) a[j] += 1.0f; a[j] *= gcol; }
                  gt[mc] = a; }
              GTF[(nc * 2 + 0) * 64 + lane] = pack_frag(gt[0], gt[1]); GTF[(nc * 2 + 1) * 64 + lane] = pack_frag(gt[2], gt[3]);
              f32x4 grow;
#pragma unroll
              for (int j = 0; j < 4; ++j) grow[j] = __int_as_float(__builtin_amdgcn_ds_bpermute((16 * nc + 4 * fq + j) << 2, __float_as_int(gamC)));
#pragma unroll
              for (int nv = 0; nv < 4; ++nv) { f32x4 hh = MFMA16(bf_, UF[nv], z4); hh = MFMA16(kf_, Vf[nv], hh); hh = hh * grow;
                  u32x2 w; w.x = cvt_pk_bf16(hh[0], hh[1]); w.y = cvt_pk_bf16(hh[2], hh[3]); HHF[(nv * 4 + nc) * 64 + lane] = w; } } }
        asm volatile("s_waitcnt lgkmcnt(0)" ::: "memory");
    }
    __syncthreads();
    if (tid == 0) *(LAS u32x4*)(lds + LDS_X) = keep;
}
__device__ __forceinline__ void phase_scan_seq(const int wv, LAS unsigned char* lds) {
    KParams& p = *kparams();
    const int tid = opaque_tid(wv), wid = __builtin_amdgcn_readfirstlane(tid >> 6), lane = tid & 63, fr = lane & 15, fq = lane >> 4; unsigned char* ws = p.ws;
    if (blockIdx.x >= 64) return;
    const int bh = blockIdx.x, b = bh >> 3, h = bh & 7;
    const char* gG = (const char*)(ws + OFF_GTF) + (size_t)bh * 64 * 8192; const char* gR = (const char*)(ws + OFF_RTF) + (size_t)bh * 64 * 4096;
    const char* gH = (const char*)(ws + OFF_HHF) + (size_t)bh * 64 * 8192; const char* gY = (const char*)(ws + OFF_YLF) + (size_t)bh * 64 * 4096;
    constexpr int SLOT = 24576;
    if (wid >= 4) {
        const int w = wid - 4;
        auto issue = [&](int c) { LAS unsigned char* slot = lds + (c % 5) * SLOT;
#pragma unroll
            for (int i = 0; i < 6; ++i) { const int pc = w + 4 * i;
                const char* src = pc < 8 ? gG + (size_t)c * 8192 + pc * 1024 : pc < 12 ? gR + (size_t)c * 4096 + (pc - 8) * 1024 : pc < 20 ? gH + (size_t)c * 8192 + (pc - 12) * 1024 : gY + (size_t)c * 4096 + (pc - 20) * 1024;
                __builtin_amdgcn_global_load_lds((const unsigned*)(src + lane * 16), (LAS unsigned*)(slot + pc * 1024), 16, 0, 0); } };
        issue(0); issue(1); issue(2); issue(3);
        for (int c = 0; c < 64; ++c) {
            if (c < 60) asm volatile("s_waitcnt vmcnt(18)" ::: "memory"); else asm volatile("s_waitcnt vmcnt(0)" ::: "memory");
            __builtin_amdgcn_s_barrier();
            if (c + 4 < 64) issue(c + 4);
        }
        return; }
    const int nv = wid;
    float* Yraw = (float*)(ws + OFF_YRAW) + (size_t)b * SEQ * 512 + h * 64 + 16 * nv + fr;
    f32x4 T[4]; const f32x4 z4s = zero4f();
#pragma unroll
    for (int m = 0; m < 4; ++m) T[m] = z4s;
    for (int c = 0; c < 64; ++c) {
        __builtin_amdgcn_s_barrier();
        const LAS unsigned char* slot = lds + (c % 5) * SLOT + lane * 16;
        bf16x8 G[8], R[4]; u32x2 H[4], Y[2];
#pragma unroll
        for (int i = 0; i < 8; ++i) G[i] = *(const LAS bf16x8*)(slot + i * 1024);
#pragma unroll
        for (int i = 0; i < 4; ++i) R[i] = *(const LAS bf16x8*)(slot + 8192 + i * 1024);
#pragma unroll
        for (int i = 0; i < 4; ++i) H[i] = *(const LAS u32x2*)(lds + (c % 5) * SLOT + 12288 + (nv * 4 + i) * 512 + lane * 8);
#pragma unroll
        for (int i = 0; i < 2; ++i) Y[i] = *(const LAS u32x2*)(lds + (c % 5) * SLOT + 20480 + (nv * 2 + i) * 512 + lane * 8);
        const bf16x8 tf0 = pack_frag(T[0], T[1]), tf1 = pack_frag(T[2], T[3]);
#pragma unroll
        for (int nt = 0; nt < 2; ++nt) { f32x4 y; y[0] = bf_lo(Y[nt].x); y[1] = bf_hi(Y[nt].x); y[2] = bf_lo(Y[nt].y); y[3] = bf_hi(Y[nt].y);
            y = MFMA16(R[nt * 2], tf0, y); y = MFMA16(R[nt * 2 + 1], tf1, y);
#pragma unroll
            for (int j = 0; j < 4; ++j) Yraw[(size_t)(c * 32 + 16 * nt + 4 * fq + j) * 512] = y[j]; }
#pragma unroll
        for (int m = 0; m < 4; ++m) { f32x4 t; t[0] = bf_lo(H[m].x); t[1] = bf_hi(H[m].x); t[2] = bf_lo(H[m].y); t[3] = bf_hi(H[m].y);
            t = MFMA16(G[m * 2], tf0, t); t = MFMA16(G[m * 2 + 1], tf1, t); T[m] = t; }
        asm volatile("s_waitcnt lgkmcnt(0)" ::: "memory");
    }
}

__device__ __forceinline__ bf16x8 tr_pair(LAS unsigned char* pa, LAS unsigned char* pb, bool useB) {
    const s16x4 a = __builtin_amdgcn_ds_read_tr16_b64_v4i16((LAS s16x4*)pa);
    s16x4 b2 = (s16x4){0, 0, 0, 0};
    if (useB) b2 = __builtin_amdgcn_ds_read_tr16_b64_v4i16((LAS s16x4*)pb);
    return __builtin_shufflevector(a, b2, 0, 1, 2, 3, 4, 5, 6, 7);
}
__device__ __forceinline__ void phase_dil_attn(const int wv, LAS unsigned char* lds) {
    KParams& p = *kparams();
    const int tid = opaque_tid(wv), wid = tid >> 6, lane = tid & 63, fr = lane & 15, fq = lane >> 4; unsigned char* ws = p.ws;
    const bf16_t* Z = (const bf16_t*)(ws + OFF_Z); float* DILO = (float*)(ws + OFF_DILO); float* LSE = (float*)(ws + OFF_LSE);
    LAS unsigned char* kb = lds; LAS unsigned char* vb = lds + 32768; const float* qn = p.in[15]; const float* kn = p.in[16];
    float qkw[2][8];
#pragma unroll
    for (int ks = 0; ks < 2; ++ks)
#pragma unroll
        for (int j = 0; j < 8; ++j) qkw[ks][j] = qn[ks * 32 + 8 * fq + j] * kn[ks * 32 + 8 * fq + j];
    const bool seqwg = blockIdx.x < 64;
    const int u0 = seqwg ? 4 * (int)blockIdx.x : 256 + (int)blockIdx.x - 64, uend = seqwg ? 4 * (int)blockIdx.x + 4 : 1536, ustep = seqwg ? 1 : 192;
    auto umap = [&](int v) -> int { if (seqwg) return v; const int c2 = (int)blockIdx.x - 64, x = c2 & 7, y = c2 >> 3, i = (v - u0) / 192, k = 24 * i + y; return 256 + (k >> 3) * 64 + 8 * x + (k & 7); };
    const int ki = tid >> 1, half = tid & 1;
    u32x4 kvA[4], vvA[4], qvA[2], kvB[4], vvB[4], qvB[2]; bool kvalidA = false, kvalidB = false;
    auto unit_load = [&](int uv, u32x4 (&kv)[4], u32x4 (&vv)[4], u32x4 (&qv)[2], bool& kvalid) { const int u = umap(uv);
        const int b = u / 192, rem = u % 192, hh = rem >> 4, qb = rem & 15, g = hh >> 2;
        const int dil = g == 0 ? 1 : (g == 1 ? 4 : 16), nbc = 16 / dil, r = qb / nbc, j0 = (qb % nbc) * 128;
        const bf16_t* Zb = Z + (size_t)b * SEQ * INC; const int kj = j0 - 128 + ki; kvalid = kj >= 0;
        { const bf16_t* rowp = Zb + (size_t)((kvalid ? kj : 0) * dil + r) * INC + hh * 64 + half * 32;
#pragma unroll
            for (int i = 0; i < 4; ++i) { kv[i] = *(const u32x4*)(rowp + C_DK + 8 * i); vv[i] = *(const u32x4*)(rowp + C_DV + 8 * i); } }
        const int tq = (j0 + 16 * wid + fr) * dil + r;
#pragma unroll
        for (int ks = 0; ks < 2; ++ks) qv[ks] = *(const u32x4*)(Zb + (size_t)tq * INC + C_DQ + hh * 64 + ks * 32 + 8 * fq); };
    auto do_unit = [&](const int uvv, u32x4 (&kv)[4], u32x4 (&vv)[4], u32x4 (&qv)[2], bool& kvalid) { const int u = umap(uvv); const int uv_ = uvv;
        const int b = u / 192, rem = u % 192, hh = rem >> 4, qb = rem & 15, g = hh >> 2, hg = hh & 3;
        const int dil = g == 0 ? 1 : (g == 1 ? 4 : 16), nbc = 16 / dil, r = qb / nbc, j0 = (qb % nbc) * 128;
        { if (kvalid) {
              float ss = sumsq8(kv[0]) + sumsq8(kv[1]) + sumsq8(kv[2]) + sumsq8(kv[3]); ss += dpp_f<0xB1>(ss);
              const float rs = rsqrtf(ss * (1.0f / 64.0f) + 1e-5f);
#pragma unroll
              for (int i = 0; i < 4; ++i) kv[i] = scale8s(kv[i], rs); }
          else { const u32x4 zu = zero4u();
#pragma unroll
              for (int i = 0; i < 4; ++i) { kv[i] = zu; vv[i] = zu; } }
#pragma unroll
          for (int i = 0; i < 4; ++i) { const int sw = (half * 4 + i) ^ (ki & 7); *(LAS u32x4*)(kb + ki * 128 + sw * 16) = kv[i]; *(LAS u32x4*)(vb + ki * 128 + sw * 16) = vv[i]; } }
        const int qi = 16 * wid + fr, tq = (j0 + qi) * dil + r;
        bf16x8 qf[2];
        { float ss = sumsq8(qv[0]) + sumsq8(qv[1]); ss += sxor(ss, 16); ss += sxor(ss, 32);
          const float rs = rsqrtf(ss * (1.0f / 64.0f) + 1e-5f) * 0.125f;
#pragma unroll
          for (int ks = 0; ks < 2; ++ks) { const u32x4 w = scale8r(qv[ks], rs, qkw[ks]); __builtin_memcpy(&qf[ks], &w, 16); } }
        __syncthreads();
        if (uv_ + 2 * ustep < uend) unit_load(uv_ + 2 * ustep, kv, vv, qv, kvalid);
        f32x4 st[9]; float mx = -1e30f; const f32x4 zq = zero4f();
        LAS unsigned char* kp0 = kb + (16 * wid + fr) * 128 + ((fq ^ (fr & 7)) << 4); LAS unsigned char* kp1 = kb + (16 * wid + fr) * 128 + (((4 + fq) ^ (fr & 7)) << 4);
#pragma unroll
        for (int ti = 0; ti < 9; ++ti) {
            const bf16x8 k0 = *(const LAS bf16x8*)(kp0 + ti * 2048), k1 = *(const LAS bf16x8*)(kp1 + ti * 2048);
            f32x4 s = __builtin_amdgcn_mfma_f32_16x16x32_bf16(k0, qf[0], zq, 0, 0, 0);
            s = __builtin_amdgcn_mfma_f32_16x16x32_bf16(k1, qf[1], s, 0, 0, 0);
#pragma unroll
            for (int j = 0; j < 4; ++j) { const int ki = 16 * (wid + ti) + 4 * fq + j, off = qi + 128 - ki; const bool ok = (off >= 0) && (off <= 128) && (j0 - 128 + ki >= 0);
                s[j] = ok ? s[j] : -1e30f; mx = fmaxf(mx, s[j]); }
            st[ti] = s; }
        mx = fmaxf(mx, sxor(mx, 16)); mx = fmaxf(mx, sxor(mx, 32));
        float den = 0.f;
#pragma unroll
        for (int ti = 0; ti < 9; ++ti)
#pragma unroll
            for (int j = 0; j < 4; ++j) { const float e = __builtin_amdgcn_exp2f((st[ti][j] - mx) * 1.44269504f); st[ti][j] = e; den += e; }
        den += sxor(den, 16); den += sxor(den, 32);
        f32x4 o[4];
#pragma unroll
        for (int dt = 0; dt < 4; ++dt) o[dt] = zq;
        const int q4 = fr >> 2, p4 = fr & 3; const int kl = 4 * fq + q4;
        LAS unsigned char* vp[4];
#pragma unroll
        for (int dt = 0; dt < 4; ++dt) vp[dt] = vb + (16 * wid + kl) * 128 + (((2 * dt + (p4 >> 1)) ^ (kl & 7)) << 4) + (p4 & 1) * 8;
#pragma unroll
        for (int pp = 0; pp < 5; ++pp) { const bool two = pp < 4; const int tA = 2 * pp, tB = two ? 2 * pp + 1 : 2 * pp;
            u32x4 pw; pw.x = cvt_pk_bf16(st[tA][0], st[tA][1]); pw.y = cvt_pk_bf16(st[tA][2], st[tA][3]);
            if (two) { pw.z = cvt_pk_bf16(st[tB][0], st[tB][1]); pw.w = cvt_pk_bf16(st[tB][2], st[tB][3]); } else { pw.z = 0u; pw.w = 0u; }
            bf16x8 pf; __builtin_memcpy(&pf, &pw, 16);
#pragma unroll
            for (int dt = 0; dt < 4; ++dt) { const bf16x8 vf = tr_pair(vp[dt] + tA * 2048, vp[dt] + tB * 2048, two);
                o[dt] = __builtin_amdgcn_mfma_f32_16x16x32_bf16(vf, pf, o[dt], 0, 0, 0); } }
        const float inv = __builtin_amdgcn_rcpf(den); const size_t ob = ((size_t)(g * NTOK + b * SEQ + tq) * 4 + hg);
#pragma unroll
        for (int dt = 0; dt < 4; ++dt) *(f32x4*)(DILO + ob * 64 + 16 * dt + 4 * fq) = o[dt] * inv;
        if (fq == 0) LSE[ob] = mx + __logf(den);
        __syncthreads();
    };
    if (u0 < uend) unit_load(u0, kvA, vvA, qvA, kvalidA);
    if (u0 + ustep < uend) unit_load(u0 + ustep, kvB, vvB, qvB, kvalidB);
    for (int u = u0; u < uend; u += 2 * ustep) {
        do_unit(u, kvA, vvA, qvA, kvalidA);
        if (u + ustep < uend) do_unit(u + ustep, kvB, vvB, qvB, kvalidB);
    }
}

__device__ __forceinline__ void phase_mem_attn(const int wv, LAS unsigned char* lds) {
    KParams& p = *kparams();
    const int tid = opaque_tid(wv), wid = tid >> 6, lane = tid & 63, fr = lane & 15, fq = lane >> 4; unsigned char* ws = p.ws;
    const bf16_t* Z = (const bf16_t*)(ws + OFF_Z); const bf16_t* KV = (const bf16_t*)(ws + OFF_KV); bf16_t* YM = (bf16_t*)(ws + OFF_YCAT) + 768;
    LAS unsigned char* kb = lds; LAS unsigned char* vb = lds + 65536; const float* mqn = p.in[19]; const float* mkn = p.in[20];
    if (blockIdx.x < 64) return;
    float mqk[4][8];
#pragma unroll
    for (int ks = 0; ks < 4; ++ks)
#pragma unroll
        for (int j = 0; j < 8; ++j) mqk[ks][j] = mqn[ks * 32 + 8 * fq + j] * mkn[ks * 32 + 8 * fq + j];
    for (int bhq = (int)blockIdx.x - 64; bhq < 256; bhq += (int)gridDim.x - 64) {
        const int bhm = bhq >> 3, b = bhm >> 2, hm = bhm & 3;
        { const int ki = tid >> 1, half = tid & 1; const bf16_t* rowp = KV + (size_t)(b * 256 + ki) * 1024 + hm * 128 + half * 64;
          u32x4 kv[8], vv[8];
#pragma unroll
          for (int i = 0; i < 8; ++i) { kv[i] = *(const u32x4*)(rowp + 8 * i); vv[i] = *(const u32x4*)(rowp + 512 + 8 * i); }
          { float ss = 0.f;
#pragma unroll
            for (int i = 0; i < 8; ++i) ss += sumsq8(kv[i]);
            ss += dpp_f<0xB1>(ss); const float rs = rsqrtf(ss * (1.0f / 128.0f) + 1e-5f);
#pragma unroll
            for (int i = 0; i < 8; ++i) kv[i] = scale8s(kv[i], rs); }
#pragma unroll
          for (int i = 0; i < 8; ++i) { const int sw = (half * 8 + i) ^ (ki & 15); *(LAS u32x4*)(kb + ki * 256 + sw * 16) = kv[i]; *(LAS u32x4*)(vb + ki * 256 + sw * 16) = vv[i]; } }
        __syncthreads();
        const int q4 = fr >> 2, p4 = fr & 3; const int kl = 4 * fq + q4;
        LAS unsigned char* kp[4]; LAS unsigned char* vp[8];
#pragma unroll
        for (int ks = 0; ks < 4; ++ks) kp[ks] = kb + fr * 256 + (((4 * ks + fq) ^ fr) << 4);
#pragma unroll
        for (int dt = 0; dt < 8; ++dt) vp[dt] = vb + kl * 256 + (((2 * dt + (p4 >> 1)) ^ kl) << 4) + (p4 & 1) * 8;
        for (int qq = 0; qq < 2; ++qq) { const int qblk = (bhq & 7) * 2 + qq; const int tq = b * SEQ + qblk * 128 + 16 * wid + fr;
            bf16x8 qf[4];
#pragma unroll
            for (int ks = 0; ks < 4; ++ks) qf[ks] = *(const bf16x8*)(Z + (size_t)tq * INC + C_MQ + hm * 128 + ks * 32 + 8 * fq);
            { u32x4 qv[4]; float ss = 0.f;
#pragma unroll
              for (int ks = 0; ks < 4; ++ks) { __builtin_memcpy(&qv[ks], &qf[ks], 16); ss += sumsq8(qv[ks]); }
              ss += sxor(ss, 16); ss += sxor(ss, 32); const float rs = rsqrtf(ss * (1.0f / 128.0f) + 1e-5f);
#pragma unroll
              for (int ks = 0; ks < 4; ++ks) { const u32x4 w = scale8r(qv[ks], rs, mqk[ks]); __builtin_memcpy(&qf[ks], &w, 16); } }
            f32x4 st[16]; float mx = -1e30f; const f32x4 zq = zero4f();
#pragma unroll
            for (int ti = 0; ti < 16; ++ti) { f32x4 s = zq;
#pragma unroll
                for (int ks = 0; ks < 4; ++ks) { const bf16x8 kf = *(const LAS bf16x8*)(kp[ks] + ti * 4096); s = __builtin_amdgcn_mfma_f32_16x16x32_bf16(kf, qf[ks], s, 0, 0, 0); }
#pragma unroll
                for (int j = 0; j < 4; ++j) mx = fmaxf(mx, s[j]);
                st[ti] = s; if (ti & 1) asm volatile("" ::: "memory"); }
            mx = fmaxf(mx, sxor(mx, 16)); mx = fmaxf(mx, sxor(mx, 32));
            const float sc = 0.08838834764831845f * 1.44269504f; float den = 0.f;
#pragma unroll
            for (int ti = 0; ti < 16; ++ti)
#pragma unroll
                for (int j = 0; j < 4; ++j) { const float e = __builtin_amdgcn_exp2f((st[ti][j] - mx) * sc); st[ti][j] = e; den += e; }
            den += sxor(den, 16); den += sxor(den, 32);
            f32x4 o[8];
#pragma unroll
            for (int dt = 0; dt < 8; ++dt) o[dt] = zq;
#pragma unroll
            for (int pp = 0; pp < 8; ++pp) { const int tA = 2 * pp, tB = 2 * pp + 1;
                u32x4 pw; pw.x = cvt_pk_bf16(st[tA][0], st[tA][1]); pw.y = cvt_pk_bf16(st[tA][2], st[tA][3]); pw.z = cvt_pk_bf16(st[tB][0], st[tB][1]); pw.w = cvt_pk_bf16(st[tB][2], st[tB][3]);
                bf16x8 pf; __builtin_memcpy(&pf, &pw, 16);
#pragma unroll
                for (int dt = 0; dt < 8; ++dt) { const bf16x8 vf = tr_pair(vp[dt] + tA * 4096, vp[dt] + tB * 4096, true);
                    o[dt] = __builtin_amdgcn_mfma_f32_16x16x32_bf16(vf, pf, o[dt], 0, 0, 0); } }
            const float inv = __builtin_amdgcn_rcpf(den);
#pragma unroll
            for (int dt = 0; dt < 8; ++dt) { u32x2 w; w.x = cvt_pk_bf16(o[dt][0] * inv, o[dt][1] * inv); w.y = cvt_pk_bf16(o[dt][2] * inv, o[dt][3] * inv);
                *(u32x2*)(YM + (size_t)tq * 1280 + hm * 128 + 16 * dt + 4 * fq) = w; } }
        __syncthreads();
    }
}

__device__ __forceinline__ void phase_post(const int wv) {
    KParams& p = *kparams();
    const int gt = blockIdx.x * 512 + opaque_tid(wv), nthr = gridDim.x * 512; unsigned char* ws = p.ws;
    const float* Yraw = (const float*)(ws + OFF_YRAW); const bf16_t* C1 = (const bf16_t*)(ws + OFF_C1); const bf16_t* C2 = (const bf16_t*)(ws + OFF_C2); bf16_t* YR = (bf16_t*)(ws + OFF_YCAT);
    for (int idx = gt; idx < NTOK * 128; idx += nthr) { const int t = idx >> 7, c = ((idx >> 4) & 7) * 64 + 4 * (idx & 15);
        const f32x4 y = *(const f32x4*)(Yraw + (size_t)t * 512 + c);
        const float mean = red16(y[0] + y[1] + y[2] + y[3]) * (1.0f / 64.0f);
        const f32x4 d = y - mean; const float var = red16(d[0] * d[0] + d[1] * d[1] + d[2] * d[2] + d[3] * d[3]) * (1.0f / 64.0f);
        const float rs = rsqrtf(var + 64.0f * 1e-5f);
        float c1[4], c2[4]; unpack4(*(const u32x2*)(C1 + (size_t)t * 512 + c), c1); unpack4(*(const u32x2*)(C2 + (size_t)t * 512 + c), c2);
        u32x2 w; w.x = cvt_pk_bf16(d[0] * rs * c1[0] + c2[0], d[1] * rs * c1[1] + c2[1]); w.y = cvt_pk_bf16(d[2] * rs * c1[2] + c2[2], d[3] * rs * c1[3] + c2[3]);
        *(u32x2*)(YR + (size_t)t * 1280 + c) = w; }
    const float* DILO = (const float*)(ws + OFF_DILO); const float* LSE = (const float*)(ws + OFF_LSE); bf16_t* YD = (bf16_t*)(ws + OFF_YCAT) + 512;
    for (int idx = gt; idx < NTOK * 64; idx += nthr) { const int t = idx >> 6, hg = (idx >> 4) & 3, q = idx & 15;
        const float l0 = LSE[(size_t)t * 4 + hg], l1 = LSE[((size_t)NTOK + t) * 4 + hg], l2 = LSE[((size_t)2 * NTOK + t) * 4 + hg];
        const float m = fmaxf(l0, fmaxf(l1, l2)); const float e0 = __expf(l0 - m), e1 = __expf(l1 - m), e2 = __expf(l2 - m); const float inv = __builtin_amdgcn_rcpf(e0 + e1 + e2);
        const f32x4 o0 = *(const f32x4*)(DILO + ((size_t)t * 4 + hg) * 64 + 4 * q), o1 = *(const f32x4*)(DILO + (((size_t)NTOK + t) * 4 + hg) * 64 + 4 * q), o2 = *(const f32x4*)(DILO + (((size_t)2 * NTOK + t) * 4 + hg) * 64 + 4 * q);
        const f32x4 o = (o0 * e0 + o1 * e1 + o2 * e2) * inv;
        u32x2 w; w.x = cvt_pk_bf16(o[0], o[1]); w.y = cvt_pk_bf16(o[2], o[3]); *(u32x2*)(YD + (size_t)t * 1280 + hg * 64 + 4 * q) = w; }
}

__device__ __forceinline__ void phase_router(const int wv, LAS unsigned char* lds, const bool real = true) {
    KParams& p = *kparams();
    const int tid = opaque_tid(wv), wid = tid >> 6, lane = tid & 63, fr = lane & 15, fq = lane >> 4; unsigned char* ws = p.ws;
    const bf16_t* X1 = (const bf16_t*)(ws + OFF_X1B); const float* ln2 = p.in[25]; const float* br = p.in[27]; const bf16_t* WRT = (const bf16_t*)(ws + OFF_WRT);
    unsigned char* XN2 = ws + OFF_XN2; int* TOPE = (int*)(ws + OFF_TOPE); float* TOPG = (float*)(ws + OFF_TOPG);
    LAS int* hist = (LAS int*)(lds + LX_HIST);
    LAS float* red = (LAS float*)lds;
    LAS float* part = (LAS float*)(lds + 1024);
    if (tid < 32) hist[tid] = 0;
    const int grp = wid >> 2, kq = wid & 3;
    u32x4 xq[2][8];
#pragma unroll
    for (int rd = 0; rd < 2; ++rd) { const bf16_t* xp = X1 + (size_t)((blockIdx.x * 4 + rd * 2 + grp) * 16 + fr) * 1024 + kq * 256 + 8 * fq;
#pragma unroll
        for (int s2 = 0; s2 < 8; ++s2) xq[rd][s2] = __builtin_nontemporal_load((const u32x4*)(xp + 32 * s2)); }
#pragma unroll
    for (int rd = 0; rd < 2; ++rd) { const int t0 = (blockIdx.x * 4 + rd * 2 + grp) * 16;
        f32x4 xa[8], xb[8]; float ss = 0.f;
#pragma unroll
        for (int s2 = 0; s2 < 8; ++s2) { float f[8]; unpack8(xq[rd][s2], f); xa[s2] = (f32x4){f[0], f[1], f[2], f[3]}; xb[s2] = (f32x4){f[4], f[5], f[6], f[7]}; }
#pragma unroll
        for (int s2 = 0; s2 < 8; ++s2) ss += xa[s2][0] * xa[s2][0] + xa[s2][1] * xa[s2][1] + xa[s2][2] * xa[s2][2] + xa[s2][3] * xa[s2][3] + xb[s2][0] * xb[s2][0] + xb[s2][1] * xb[s2][1] + xb[s2][2] * xb[s2][2] + xb[s2][3] * xb[s2][3];
        ss += sxor(ss, 16); ss += sxor(ss, 32);
        __syncthreads();
        if (fq == 0) red[(grp * 4 + kq) * 16 + fr] = ss;
        __syncthreads();
        const float tot = red[(grp * 4 + 0) * 16 + fr] + red[(grp * 4 + 1) * 16 + fr] + red[(grp * 4 + 2) * 16 + fr] + red[(grp * 4 + 3) * 16 + fr];
        const float rs = rsqrtf(tot * (1.0f / 1024.0f) + 1e-5f);
        f32x4 acc[2]; acc[0] = zero4f(); acc[1] = acc[0];
#pragma unroll
        for (int s2 = 0; s2 < 8; ++s2) { const int k = kq * 256 + 32 * s2 + 8 * fq;
            const f32x4 g0 = *(const f32x4*)(ln2 + k), g1 = *(const f32x4*)(ln2 + k + 4);
            float xn[8]; xn[0] = xa[s2][0] * rs * g0[0]; xn[1] = xa[s2][1] * rs * g0[1]; xn[2] = xa[s2][2] * rs * g0[2]; xn[3] = xa[s2][3] * rs * g0[3];
            xn[4] = xb[s2][0] * rs * g1[0]; xn[5] = xb[s2][1] * rs * g1[1]; xn[6] = xb[s2][2] * rs * g1[2]; xn[7] = xb[s2][3] * rs * g1[3];
            const u32x4 hi = pack8(xn); float hf[8]; unpack8(hi, hf);
#pragma unroll
            for (int j = 0; j < 8; ++j) hf[j] = xn[j] - hf[j];
            const u32x4 lo = pack8(hf);
            { u32x2 q8; q8.x = pack4_fp8(xn[0] * 8.0f, xn[1] * 8.0f, xn[2] * 8.0f, xn[3] * 8.0f); q8.y = pack4_fp8(xn[4] * 8.0f, xn[5] * 8.0f, xn[6] * 8.0f, xn[7] * 8.0f); if (real) *(u32x2*)(XN2 + (size_t)(t0 + fr) * 1024 + k) = q8; }
            bf16x8 xh, xl; __builtin_memcpy(&xh, &hi, 16); __builtin_memcpy(&xl, &lo, 16);
#pragma unroll
            for (int m = 0; m < 2; ++m) { const bf16x8 wh = *(const bf16x8*)(WRT + (size_t)(16 * m + fr) * 1024 + k), wl = *(const bf16x8*)(WRT + 32768 + (size_t)(16 * m + fr) * 1024 + k);
                acc[m] = MFMA16(wh, xh, acc[m]); acc[m] = MFMA16(wh, xl, acc[m]); acc[m] = MFMA16(wl, xh, acc[m]); } }
#pragma unroll
        for (int m = 0; m < 2; ++m)
#pragma unroll
            for (int j = 0; j < 4; ++j) part[((grp * 4 + kq) * 32 + 16 * m + 4 * fq + j) * 16 + fr] = acc[m][j];
        __syncthreads();
        if (kq == 0) { float lg[8]; int le[8];
#pragma unroll
            for (int m = 0; m < 2; ++m)
#pragma unroll
                for (int j = 0; j < 4; ++j) { const int e = 16 * m + 4 * fq + j; le[m * 4 + j] = e;
                    lg[m * 4 + j] = part[((grp * 4 + 0) * 32 + e) * 16 + fr] + part[((grp * 4 + 1) * 32 + e) * 16 + fr] + part[((grp * 4 + 2) * 32 + e) * 16 + fr] + part[((grp * 4 + 3) * 32 + e) * 16 + fr] + br[e]; }
            float tv[4]; int te[4];
#pragma unroll
            for (int r = 0; r < 4; ++r) { float bv = lg[0]; int bi = le[0];
#pragma unroll
                for (int q = 1; q < 8; ++q) if (lg[q] > bv) { bv = lg[q]; bi = le[q]; }
#pragma unroll
                for (int sft = 16; sft < 64; sft <<= 1) { const float ov = sxor(bv, sft); const int oi = sxor(bi, sft); if (ov > bv || (ov == bv && oi < bi)) { bv = ov; bi = oi; } }
                tv[r] = bv; te[r] = bi;
#pragma unroll
                for (int q = 0; q < 8; ++q) if (le[q] == bi) lg[q] = -3.0e38f; }
            const float e1 = __expf(tv[1] - tv[0]), e2 = __expf(tv[2] - tv[0]), e3 = __expf(tv[3] - tv[0]); const float inv = 1.0f / (1.0f + e1 + e2 + e3);
            if (fq == 0 && real) { const int t = t0 + fr; *(int4*)(TOPE + (size_t)t * 4) = make_int4(te[0], te[1], te[2], te[3]); *(f32x4*)(TOPG + (size_t)t * 4) = (f32x4){inv, e1 * inv, e2 * inv, e3 * inv};
                atomicAdd((int*)&hist[te[0]], 1); atomicAdd((int*)&hist[te[1]], 1); atomicAdd((int*)&hist[te[2]], 1); atomicAdd((int*)&hist[te[3]], 1); } }
    }
    __syncthreads();
    if (tid < 32 && real) { const int hcount = hist[tid]; if (hcount) atomicAdd((int*)(ws + OFF_CTL + CTL_CNT) + tid, hcount); }
}

__device__ __forceinline__ void build_tables(const int wv, LAS unsigned char* lds) {
    KParams& p = *kparams();
    LAS int* ts = (LAS int*)(lds + LX_TSTART); LAS int* sb = (LAS int*)(lds + LX_SBASE); LAS int* cn = (LAS int*)(lds + LX_CNT);
    if (wv == 0) { const int l = lane_id(); int* gc = (int*)(p.ws + OFF_CTL + CTL_CNT);
        const int c = (l < 32) ? (int)__hip_atomic_load(gc + l, __ATOMIC_RELAXED, __HIP_MEMORY_SCOPE_AGENT) : 0; const int tl = (c + 255) >> 8; int v = tl;
#pragma unroll
        for (int d = 1; d < 32; d <<= 1) { const int o = __builtin_amdgcn_ds_bpermute((l - d) << 2, v); if (l >= d) v += o; }
        if (l < 32) { cn[l] = c; sb[l] = (v - tl) * 256; ts[l + 1] = v; if (l == 0) ts[0] = 0; } }
    __syncthreads();
    { const int tid = (wv << 6) | lane_id(); LAS unsigned char* te = (LAS unsigned char*)(lds + LX_TEXP); const int nt = ts[32];
      if (tid < nt) { int e = 0; while (e < 31 && tid >= ts[e + 1]) ++e; te[tid] = (unsigned char)e; } }
    __syncthreads();
}

__device__ __forceinline__ void phase_dispatch(const int wv, LAS unsigned char* lds, const bool real = true) {
    KParams& p = *kparams();
    const int tid = opaque_tid(wv); unsigned char* ws = p.ws;
    build_tables(wv, lds);
    const LAS int* sb = (const LAS int*)(lds + LX_SBASE); const LAS int* cn = (const LAS int*)(lds + LX_CNT);
    LAS int* hist = (LAS int*)(lds + LX_HIST); LAS int* bbase = (LAS int*)(lds + LX_BBASE);
    const int* TOPE = (const int*)(ws + OFF_TOPE); int* SLOT = (int*)(ws + OFF_SLOT); int* STOK = (int*)(ws + OFF_STOK);
    for (int tb = blockIdx.x; tb < NTOK / 64; tb += gridDim.x) {
        if (tid < 32) hist[tid] = 0;
        __syncthreads();
        int e = 0, lr = 0;
        if (tid < 256) { e = TOPE[(size_t)tb * 256 + tid]; lr = atomicAdd((int*)&hist[e], 1); }
        __syncthreads();
        if (tid < 32) { const int hcount = hist[tid]; bbase[tid] = (hcount && real) ? atomicAdd((int*)(ws + OFF_CTL + CTL_CUR) + tid, hcount) : 0; }
        __syncthreads();
        if (tid < 256 && real) { const int sl = sb[e] + bbase[e] + lr; SLOT[(size_t)tb * 256 + tid] = sl; STOK[sl] = tb * 64 + (tid >> 2); }
        __syncthreads();
    }
    for (int e = blockIdx.x; e < 32; e += gridDim.x) { const int lo = sb[e] + cn[e], hi = sb[e] + ((cn[e] + 255) & ~255);
        for (int rrow = lo + tid; rrow < hi; rrow += 512) STOK[rrow] = 0; }
}

__device__ __forceinline__ void phase_combine(const int wv, const bool real = true) {
    KParams& p = *kparams();
    const int tid = opaque_tid(wv), wid = tid >> 6, lane = tid & 63; unsigned char* ws = p.ws;
    const int* SLOT = (const int*)(ws + OFF_SLOT); const float* TOPG = (const float*)(ws + OFF_TOPG); const bf16_t* YS = (const bf16_t*)(ws + OFF_YS); const bf16_t* X1 = (const bf16_t*)(ws + OFF_X1B); float* out = p.out;
    for (int t0 = (blockIdx.x * 8 + wid) * 8; t0 < NTOK; t0 += gridDim.x * 64) {
        int4 sl[8]; f32x4 gg[8];
#pragma unroll
        for (int i = 0; i < 8; ++i) { sl[i] = *(const int4*)(SLOT + (size_t)(t0 + i) * 4); gg[i] = *(const f32x4*)(TOPG + (size_t)(t0 + i) * 4); }
#pragma unroll
        for (int i = 0; i < 8; ++i) { const int t = t0 + i; const int s4[4] = {sl[i].x, sl[i].y, sl[i].z, sl[i].w};
#pragma unroll
            for (int hf = 0; hf < 2; ++hf) { const int c = hf * 512 + 8 * lane; float acc[8];
                const u32x4 xv = __builtin_nontemporal_load((const u32x4*)(X1 + (size_t)t * 1024 + c));
                u32x4 yv[4];
#pragma unroll
                for (int k = 0; k < 4; ++k) yv[k] = __builtin_nontemporal_load((const u32x4*)(YS + (size_t)s4[k] * 1024 + c));
                unpack8(xv, acc);
#pragma unroll
                for (int k = 0; k < 4; ++k) { float f[8]; unpack8(yv[k], f);
#pragma unroll
                    for (int j = 0; j < 8; ++j) acc[j] = fmaf(gg[i][k], f[j], acc[j]); }
                float* dst = real ? out : (float*)(ws + OFF_ACT);
                *(f32x4*)(dst + (size_t)t * 1024 + c) = (f32x4){acc[0], acc[1], acc[2], acc[3]}; *(f32x4*)(dst + (size_t)t * 1024 + c + 4) = (f32x4){acc[4], acc[5], acc[6], acc[7]}; }
            if (i & 1) asm volatile("" ::: "memory"); }
    }
}

__global__ void __launch_bounds__(512, 2) mk_fwd(Params p) {
    extern __shared__ __attribute__((aligned(16))) unsigned char lds_raw[];
    LAS unsigned char* lds = (LAS unsigned char*)lds_raw;
    unsigned char* ws = p.ws;
    const int wv = __builtin_amdgcn_readfirstlane((int)threadIdx.x >> 6);
    const bool multi = (p.ph_hi - p.ph_lo) > 1;
    XcdBarrier xb; xb.bar = (unsigned*)(ws + OFF_CTL); xb.x = 0; xb.st = (volatile LAS unsigned*)(lds + LDS_X);
    if (multi) {
        if (wv == 0 && lane_id() == 0) { *(LAS u32x4*)(lds + LDS_X) = zero4u(); }
        __syncthreads();
        xb = xcd_barrier_post((unsigned*)(ws + OFF_CTL), (volatile LAS unsigned*)(lds + LDS_X), wv);
    }
#if MFMA_BENCH
    { const int l = lane_id(); unsigned h = (unsigned)l * 2654435761u ^ (unsigned)blockIdx.x * 40503u ^ (unsigned)wv * 977u;
      i32x8 a, b;
#pragma unroll
      for (int j = 0; j < 8; ++j) { h = h * 1664525u + 1013904223u; a[j] = (int)(MFMA_BENCH == 1 ? ((h & 0x00ff00ffu) | 0x3f003f00u) : ((h & 0x0f0f0f0fu) | 0x30303030u));
                                    h = h * 1664525u + 1013904223u; b[j] = (int)(MFMA_BENCH == 1 ? ((h & 0x00ff00ffu) | 0x3f003f00u) : ((h & 0x0f0f0f0fu) | 0x30303030u)); }
      f32x4 c[8]; const f32x4 z0 = zero4f();
#pragma unroll
      for (int j = 0; j < 8; ++j) c[j] = z0;
      const int one_scale = 0x7f7f7f7f;
#pragma clang loop unroll(disable)
      for (int it = 0; it < (MFMA_BENCH == 1 ? 1875 : 938); ++it) {
#pragma unroll
          for (int j = 0; j < 8; ++j) {
              if (MFMA_BENCH == 1) c[j] = (j & 1) ? __builtin_amdgcn_mfma_f32_16x16x32_bf16(pg8::half8<1>(a), pg8::half8<1>(b), c[j], 0, 0, 0) : __builtin_amdgcn_mfma_f32_16x16x32_bf16(pg8::half8<0>(a), pg8::half8<0>(b), c[j], 0, 0, 0);
              else asm volatile("v_mfma_scale_f32_16x16x128_f8f6f4 %0, %1, %2, %0, %3, %3 op_sel_hi:[0,0,0]" : "+v"(c[j]) : "v"(a), "v"(b), "v"(one_scale)); } }
      asm volatile("s_nop 15\n\ts_nop 15" ::: "memory");
      float sm = 0.f;
#pragma unroll
      for (int j = 0; j < 8; ++j) sm += c[j][0] + c[j][1] + c[j][2] + c[j][3];
      if (sm == 1.2345f) *(float*)(ws + OFF_CTL + 8192) = sm; }
#endif
    for (int ph = p.ph_lo; ph < p.ph_hi; ++ph) {
      for (int rep = 0; rep < (((DBL_MASK >> ph) & 1) ? 2 : 1); ++rep) {
        KParams& q = *kparams(); unsigned char* ws = q.ws;
        switch (ph) {
        case 0: phase_prep(wv, lds); break;
        case 1: { { SchedZ S; S.H = (const char*)(ws + OFF_H); S.WinT = (const char*)(ws + OFF_WINT); S.HM = (const char*)(ws + OFF_HM); S.WmkvT = (const char*)(ws + OFF_WMKVT); S.G = gridDim.x; S.c = blockIdx.x;
                    EpiZ E; E.Z = (bf16_t*)(ws + OFF_Z); E.KV = (bf16_t*)(ws + OFF_KV); E.GFp = (bf16_t*)(ws + OFF_GF); E.pn0 = 0; E.scale = 1.0f; pg8::gemm_phase(wv, lds, 1024, S, E); }
                  { SchedZ8 S; S.H8 = (const char*)(ws + OFF_H8); S.WIN8 = (const char*)(ws + OFF_WIN8); S.G = gridDim.x; S.c = blockIdx.x;
                    EpiZ E; E.Z = (bf16_t*)(ws + OFF_Z); E.KV = (bf16_t*)(ws + OFF_KV); E.GFp = (bf16_t*)(ws + OFF_GF); E.pn0 = 7; E.scale = 1.0f / 256.0f; pg8::gemm_phase<EpiZ, SchedZ8, 1>(wv, lds, 1024, S, E); } } break;
        case 2: phase_elem_c(wv); break;
        case 3: { pg8::DenseOrder S; S.init(ws + OFF_ALORA, ws + OFF_LORAT, NTOK, 1536, 256); EpiLora E; E.L = (float*)(ws + OFF_L); E.w0 = q.in[5]; E.a0 = q.in[7]; pg8::gemm_phase(wv, lds, 256, S, E); } break;
        case 4: phase_chunk_pre(wv, lds); break;
        case 5: for (int r2 = 0; r2 < (((DBL_MASK >> 16) & 1) ? 2 : 1); ++r2) phase_scan_seq(wv, lds);
                for (int r2 = 0; r2 < (((DBL_MASK >> 17) & 1) ? 2 : 1); ++r2) phase_dil_attn(wv, lds);
                for (int r2 = 0; r2 < (((DBL_MASK >> 18) & 1) ? 2 : 1); ++r2) phase_mem_attn(wv, lds); break;
        case 6: phase_post(wv); break;
        case 7: { pg8::DenseOrder S; S.init(ws + OFF_YCAT, ws + OFF_PCAT, NTOK, 1024, 1280); EpiMixCat E; E.mixbf = (bf16_t*)(ws + OFF_MIXBF); E.GF = (const bf16_t*)(ws + OFF_GF); E.tid = (wv << 6) | lane_id(); pg8::gemm_phase(wv, lds, 1280, S, E); } break;
        case 8: { pg8::DenseOrder S; S.init(ws + OFF_MIXBF, ws + OFF_WOT, NTOK, 1024, 1024); EpiX1 E; E.x = q.in[0]; E.x1 = (bf16_t*)(ws + OFF_X1B); pg8::gemm_phase(wv, lds, 1024, S, E); } break;
        case 9: phase_router(wv, lds, rep + 1 == (((DBL_MASK >> ph) & 1) ? 2 : 1)); break;
        case 10: phase_dispatch(wv, lds, rep + 1 == (((DBL_MASK >> ph) & 1) ? 2 : 1)); break;
        case 11: { build_tables(wv, lds); SchedMoe<true> S; S.A = (const char*)(ws + OFF_XN2); S.Bt = (const char*)(ws + OFF_W1T); S.tstart = (const LAS int*)(lds + LX_TSTART); S.stok = (const int*)(ws + OFF_STOK); S.lgN = 3; S.total = S.tstart[32] * 8; S.estride = (size_t)2048 * 1024; S.tbytes = (size_t)256 * 1024;
                   EpiSwiglu E; E.act = ws + OFF_ACT; E.b1 = q.in[29]; pg8::gemm_phase<EpiSwiglu, SchedMoe<true>, 1>(wv, lds, 1024, S, E); } break;
        case 12: { build_tables(wv, lds); SchedMoe<false> S; S.A = (const char*)(ws + OFF_ACT); S.Bt = (const char*)(ws + OFF_W2T); S.tstart = (const LAS int*)(lds + LX_TSTART); S.stok = nullptr; S.lgN = 2; S.total = S.tstart[32] * 4; S.estride = (size_t)1024 * 1024; S.tbytes = (size_t)256 * 1024;
                   EpiYs E; E.ys = (bf16_t*)(ws + OFF_YS); E.b2 = q.in[31]; pg8::gemm_phase<EpiYs, SchedMoe<false>, 1>(wv, lds, 1024, S, E); } break;
        case 13: phase_combine(wv, rep + 1 == (((DBL_MASK >> ph) & 1) ? 2 : 1)); break;
        default: break;
        }
      }
        if (ph + 1 < p.ph_hi) xcd_barrier(xb, wv);
        if (((DBL_MASK >> 20) & 1) && ph == 3 && multi) for (int e = 0; e < 10; ++e) xcd_barrier(xb, wv);
    }
}

extern "C" void kernel_launch(void* const* d_in, const int* in_sizes, int n_in, void* d_out, int out_size, void* d_ws, size_t ws_size, hipStream_t stream) {
    static int ready = 0;
    if (ready == 0) {
        if (n_in != 32 || out_size != NTOK * 1024 || ws_size < WS_NEED) { fprintf(stderr, "kernel_launch: unexpected shapes (n_in %d, out %d, ws %zu < %zu)\n", n_in, out_size, ws_size, (size_t)WS_NEED); ready = -1; return; }
        if (hipFuncSetAttribute((const void*)mk_fwd, hipFuncAttributeMaxDynamicSharedMemorySize, LDS_BYTES) != hipSuccess) { fprintf(stderr, "kernel_launch: hipFuncSetAttribute failed\n"); ready = -1; return; }
        int per_cu = 0, dev = 0, cus = 0; hipGetDevice(&dev); hipDeviceGetAttribute(&cus, hipDeviceAttributeMultiprocessorCount, dev);
        hipOccupancyMaxActiveBlocksPerMultiprocessor(&per_cu, (const void*)mk_fwd, 512, LDS_BYTES);
        if (per_cu < 1 || cus < 256) { fprintf(stderr, "kernel_launch: occupancy %d blocks/CU on %d CUs; need >= 1 on 256\n", per_cu, cus); ready = -1; (void)hipGetLastError(); return; }
        ready = 1;
    }
    if (ready < 0) return;
    hipMemsetAsync((char*)d_ws + OFF_CTL, 0, CTL_BYTES, stream);
    Params p{};
    for (int i = 0; i < 32; ++i) p.in[i] = (const float*)d_in[i];
    p.out = (float*)d_out; p.ws = (unsigned char*)d_ws;
#if MK_N_LAUNCH_PER_PHASE
    for (int ph = 0; ph < NPHASE; ++ph) { p.ph_lo = ph; p.ph_hi = ph + 1; hipLaunchKernelGGL(mk_fwd, dim3(256), dim3(512), LDS_BYTES, stream, p); }
#else
    p.ph_lo = 0; p.ph_hi = NPHASE;
    void* args[] = {&p};
    hipError_t e = hipLaunchCooperativeKernel((const void*)mk_fwd, dim3(256), dim3(512), args, LDS_BYTES, stream);
    if (e != hipSuccess) fprintf(stderr, "cooperative launch failed: %s\n", hipGetErrorString(e));
#endif
}
```

```cpp
#include <hip/hip_runtime.h>
#include <cstdio>
#include <cstdint>

#define LAS __attribute__((address_space(3)))
typedef unsigned short bf16_t;
typedef short bf16x8 __attribute__((ext_vector_type(8)));
typedef short s16x4 __attribute__((ext_vector_type(4)));
typedef float f32x4 __attribute__((ext_vector_type(4)));
typedef float f32x2 __attribute__((ext_vector_type(2)));
typedef unsigned u32x4 __attribute__((ext_vector_type(4)));
typedef unsigned u32x2 __attribute__((ext_vector_type(2)));
typedef int i32x8 __attribute__((ext_vector_type(8)));
typedef int i32x4 __attribute__((ext_vector_type(4)));

#ifndef DBL_MASK
#define DBL_MASK 0
#endif
#ifndef MK_N_LAUNCH_PER_PHASE
#define MK_N_LAUNCH_PER_PHASE 0
#endif

constexpr int NTOK = 16384, SEQ = 2048, INC = 7680;
constexpr int C_K = 512, C_V = 1024, C_ZW = 1536, C_DQ = 1792, C_DK = 2560, C_DV = 3328, C_MQ = 4096, C_GATE = 4608;
constexpr int NPHASE = 14;
constexpr int NSLOT_MAX = 65536 + 32 * 256;

constexpr size_t MiB = 1ull << 20;
constexpr size_t OFF_CTL = 0;
constexpr size_t CTL_BYTES = 32768;
constexpr size_t CTL_CNT = 16384;
constexpr size_t CTL_CUR = 16384 + 256;
constexpr size_t CTL_KEEP = 20480;
constexpr size_t OFF_TOPE = 1 * MiB;
constexpr size_t OFF_TOPG = 1 * MiB + 262144;
constexpr size_t OFF_SLOT = 1 * MiB + 524288;
constexpr size_t OFF_STOK = 2 * MiB;
constexpr size_t OFF_WRT = 3 * MiB;
constexpr size_t OFF_WINT = 4 * MiB, OFF_WMKVT = 19 * MiB, OFF_LORAT = 21 * MiB, OFF_PRT = 22 * MiB, OFF_PDT = 23 * MiB, OFF_PMT = 24 * MiB, OFF_WOT = 25 * MiB;
constexpr size_t OFF_WIN8 = 8 * MiB;
constexpr size_t OFF_H8 = 539 * MiB;
constexpr size_t OFF_YCAT = 223 * MiB;
constexpr size_t OFF_PCAT = 22 * MiB;
constexpr size_t OFF_W1T = 27 * MiB, OFF_W2T = 155 * MiB, OFF_KV = 219 * MiB, OFF_YM = 223 * MiB, OFF_YR = 239 * MiB, OFF_YD = 255 * MiB, OFF_Z = 263 * MiB;
constexpr size_t OFF_H = 503 * MiB, OFF_HM = 535 * MiB, OFF_ALORA = 503 * MiB, OFF_L = 511 * MiB, OFF_REC = 607 * MiB;
constexpr size_t OFF_GF = OFF_REC;
constexpr size_t OFF_LW = OFF_REC + 64 * MiB;
constexpr size_t OFF_VB = OFF_REC + 96 * MiB;
constexpr size_t OFF_GTF = OFF_REC + 112 * MiB;
constexpr size_t OFF_RTF = OFF_REC + 144 * MiB;
constexpr size_t OFF_HHF = OFF_REC + 160 * MiB;
constexpr size_t OFF_YLF = OFF_REC + 192 * MiB;
constexpr size_t OFF_C1 = 816 * MiB, OFF_C2 = 832 * MiB, OFF_YRAW = 848 * MiB, OFF_DILO = 880 * MiB, OFF_LSE = 928 * MiB;
constexpr size_t OFF_MIX32 = 503 * MiB, OFF_MIXBF = 567 * MiB, OFF_XN2 = 503 * MiB, OFF_XS = 263 * MiB, OFF_ACT = 607 * MiB, OFF_YS = 407 * MiB;
constexpr size_t OFF_X1B = 263 * MiB;
constexpr size_t WS_NEED = 929 * MiB;

constexpr int LDS_BYTES = 160 * 1024;
constexpr int LDS_X = LDS_BYTES - 4096;
constexpr int LX_TSTART = LDS_X + 64;
constexpr int LX_SBASE = LDS_X + 256;
constexpr int LX_CNT = LDS_X + 512;
constexpr int LX_HIST = LDS_X + 768;
constexpr int LX_BBASE = LDS_X + 1024;
constexpr int LX_SLOTL = LDS_X + 2048;
constexpr int LX_TEXP = LDS_X + 3072;

struct Params { const float* in[32]; float* out; unsigned char* ws; int ph_lo, ph_hi; };
typedef const Params __attribute__((address_space(4))) KParams;
__device__ __forceinline__ KParams* kparams() { KParams* kp = (KParams*)__builtin_amdgcn_kernarg_segment_ptr(); asm volatile("" : "+s"(kp)); return kp; }

typedef __bf16 bf16x2_t __attribute__((ext_vector_type(2)));
__device__ __forceinline__ unsigned cvt_pk_bf16(float lo, float hi) { f32x2 v = {lo, hi}; bf16x2_t b = __builtin_convertvector(v, bf16x2_t); unsigned r; __builtin_memcpy(&r, &b, 4); return r; }
__device__ __forceinline__ unsigned pack4_fp8(float a, float b, float c, float d) { int r = __builtin_amdgcn_cvt_pk_fp8_f32(a, b, 0, false); r = __builtin_amdgcn_cvt_pk_fp8_f32(c, d, r, true); return (unsigned)r; }
__device__ __forceinline__ float bf_lo(unsigned u) { return __uint_as_float(u << 16); }
__device__ __forceinline__ float bf_hi(unsigned u) { return __uint_as_float(u & 0xffff0000u); }
__device__ __forceinline__ int lane_id() { int l; asm volatile("v_mbcnt_lo_u32_b32 %0, -1, 0\n\tv_mbcnt_hi_u32_b32 %0, -1, %0" : "=v"(l)); return l; }
__device__ __forceinline__ int sxor(int x, int m) { return __builtin_amdgcn_ds_bpermute((lane_id() ^ m) << 2, x); }
__device__ __forceinline__ float sxor(float x, int m) { return __int_as_float(__builtin_amdgcn_ds_bpermute((lane_id() ^ m) << 2, __float_as_int(x))); }
template <int CTRL> __device__ __forceinline__ float dpp_f(float x) { return __int_as_float(__builtin_amdgcn_update_dpp(0, __float_as_int(x), CTRL, 0xF, 0xF, true)); }
__device__ __forceinline__ float red4(float x) { x += dpp_f<0xB1>(x); x += dpp_f<0x4E>(x); return x; }
__device__ __forceinline__ float red8(float x) { x = red4(x); x += dpp_f<0x141>(x); return x; }
__device__ __forceinline__ float red16(float x) { x = red8(x); x += dpp_f<0x140>(x); return x; }
__device__ __forceinline__ float red64(float x) { x = red16(x); x += sxor(x, 16); x += sxor(x, 32); return x; }
__device__ __forceinline__ int opaque_tid(const int wv) { int t = (wv << 6) | lane_id(); asm volatile("" : "+v"(t)); return t; }
__device__ __forceinline__ f32x4 zero4f() { float z = 0.f; asm volatile("" : "+v"(z)); return (f32x4){z, z, z, z}; }
__device__ __forceinline__ u32x4 zero4u() { unsigned z = 0u; asm volatile("" : "+v"(z)); return (u32x4){z, z, z, z}; }
__device__ __forceinline__ float sigmoidf_(float x) { return __builtin_amdgcn_rcpf(1.0f + __builtin_amdgcn_exp2f(-1.44269504f * x)); }
__device__ __forceinline__ void unpack8(const u32x4 v, float (&f)[8]) { f[0] = bf_lo(v.x); f[1] = bf_hi(v.x); f[2] = bf_lo(v.y); f[3] = bf_hi(v.y); f[4] = bf_lo(v.z); f[5] = bf_hi(v.z); f[6] = bf_lo(v.w); f[7] = bf_hi(v.w); }
__device__ __forceinline__ u32x4 pack8(const float (&f)[8]) { u32x4 w; w.x = cvt_pk_bf16(f[0], f[1]); w.y = cvt_pk_bf16(f[2], f[3]); w.z = cvt_pk_bf16(f[4], f[5]); w.w = cvt_pk_bf16(f[6], f[7]); return w; }
__device__ __forceinline__ float sumsq8(const u32x4 v) { float f[8]; unpack8(v, f); float s = 0.f;
#pragma unroll
    for (int j = 0; j < 8; ++j) s += f[j] * f[j];
    return s; }
__device__ __forceinline__ u32x4 scale8(const u32x4 v, const float rs, const float* w) { float f[8]; unpack8(v, f); const f32x4 w0 = *(const f32x4*)w, w1 = *(const f32x4*)(w + 4);
    f[0] *= rs * w0[0]; f[1] *= rs * w0[1]; f[2] *= rs * w0[2]; f[3] *= rs * w0[3]; f[4] *= rs * w1[0]; f[5] *= rs * w1[1]; f[6] *= rs * w1[2]; f[7] *= rs * w1[3]; return pack8(f); }
__device__ __forceinline__ u32x4 scale8r(const u32x4 v, const float rs, const float (&w)[8]) { float f[8]; unpack8(v, f);
#pragma unroll
    for (int j = 0; j < 8; ++j) f[j] *= rs * w[j];
    return pack8(f); }
__device__ __forceinline__ u32x4 scale8s(const u32x4 v, const float rs) { float f[8]; unpack8(v, f);
#pragma unroll
    for (int j = 0; j < 8; ++j) f[j] *= rs;
    return pack8(f); }
__device__ __forceinline__ void unpack4(const u32x2 v, float (&f)[4]) { f[0] = bf_lo(v.x); f[1] = bf_hi(v.x); f[2] = bf_lo(v.y); f[3] = bf_hi(v.y); }

#define XB_TMO      128
#define XB_XCNT(j)  (256  + 64 * (j))
#define XB_XSUB(j)  (1280 + 64 * (j))
#define XB_XGEN(j)  (2304 + 64 * (j))
#define XB_TOP      3328
#define XB_TOPGEN   3392
#define XCD_BAR_WORDS 3456
#define XB_SPIN_CAP (1u << 22)
__device__ __forceinline__ unsigned xb_ld(unsigned* p)              { return __hip_atomic_load(p, __ATOMIC_RELAXED, __HIP_MEMORY_SCOPE_AGENT); }
__device__ __forceinline__ unsigned xb_add(unsigned* p, unsigned v) { return __hip_atomic_fetch_add(p, v, __ATOMIC_RELAXED, __HIP_MEMORY_SCOPE_AGENT); }
__device__ __forceinline__ unsigned xb_xcc_id() { return (unsigned)__builtin_amdgcn_s_getreg((3 << 11) | 20) & 0xFu; }
#define XB_SPIN(cond, bar) do { unsigned _sp = 0; while (cond) { __builtin_amdgcn_s_sleep(1); \
    if ((++_sp & 255u) == 0u) { if (xb_ld(&(bar)[XB_TMO])) break; if (_sp > XB_SPIN_CAP) { atomicAdd(&(bar)[XB_TMO], 1u); break; } } } } while (0)
struct XcdBarrier { unsigned* bar; unsigned x; volatile LAS unsigned* st; };
__device__ __forceinline__ XcdBarrier xcd_barrier_post(unsigned* bar, volatile LAS unsigned* st, const int wv) {
    XcdBarrier b; b.bar = bar; b.x = xb_xcc_id(); b.st = st;
    if (wv == 0 && lane_id() == 0) (void)xb_add(&bar[XB_XCNT(b.x)], 1u);
    return b;
}
__device__ __forceinline__ void xcd_barrier_complete(unsigned* bar, unsigned x, unsigned& nloc, unsigned& nx) {
    const unsigned G = gridDim.x * gridDim.y * gridDim.z;
    unsigned sum, cnt, mine, sp = 0u;
    for (;;) {
        sum = 0u; cnt = 0u; mine = 0u;
#pragma unroll
        for (unsigned j = 0; j < 16; ++j) { const unsigned c = xb_ld(&bar[XB_XCNT(j)]); sum += c; cnt += (c > 0u) ? 1u : 0u; mine = (j == x) ? c : mine; }
        if (sum == G) break;
        __builtin_amdgcn_s_sleep(1);
        if ((++sp & 255u) == 0u) { if (xb_ld(&bar[XB_TMO])) break; if (sp > XB_SPIN_CAP) { atomicAdd(&bar[XB_TMO], 1u); break; } }
    }
    nloc = mine > 0u ? mine : 1u; nx = cnt > 0u ? cnt : 1u;
}
__device__ __forceinline__ void xcd_barrier(const XcdBarrier& b, const int wv) {
    asm volatile("s_waitcnt vmcnt(0)" ::: "memory");
    __syncthreads();
    if (wv == 0 && lane_id() == 0) {
        unsigned* bar = b.bar;
        __builtin_amdgcn_s_waitcnt(0);
        unsigned nloc = b.st[0], nx = b.st[1];
        if (nloc == 0u) { xcd_barrier_complete(bar, b.x, nloc, nx); b.st[0] = nloc; b.st[1] = nx; }
        const unsigned old = xb_add(&bar[XB_XSUB(b.x)], 1u);
        const unsigned gen = old / nloc;
        if (old + 1u == (gen + 1u) * nloc) {
            __builtin_amdgcn_fence(__ATOMIC_RELEASE, "agent");
            asm volatile("s_waitcnt vmcnt(0)" ::: "memory");
            const unsigned og = xb_add(&bar[XB_TOP], 1u);
            const unsigned tg = og / nx;
            if (og + 1u == (tg + 1u) * nx) xb_add(&bar[XB_TOPGEN], 1u);
            else XB_SPIN(xb_ld(&bar[XB_TOPGEN]) == tg, bar);
            __builtin_amdgcn_fence(__ATOMIC_ACQUIRE, "agent");
            xb_add(&bar[XB_XGEN(b.x)], 1u);
            asm volatile("s_waitcnt vmcnt(0)" ::: "memory");
        } else {
            XB_SPIN(xb_ld(&bar[XB_XGEN(b.x)]) == gen, bar);
            __builtin_amdgcn_fence(__ATOMIC_ACQUIRE, "agent");
            asm volatile("s_waitcnt vmcnt(0)" ::: "memory");
        }
    }
    __syncthreads();
}

#ifndef MFMA_BENCH
#define MFMA_BENCH 0
#endif
#ifndef EDBL
#define EDBL 0
#endif
#ifndef KMODE
#define KMODE 0
#endif
#ifndef KDBL
#define KDBL 0
#endif
struct EpiSwiglu; struct EpiYs; struct EpiZ; struct EpiMixCat; struct EpiX1;
namespace pg8 {
constexpr int BM = 256, BK = 64, HALF = 128, HTB = HALF * BK * 2, STAGE_BYTES = 8 * HTB, NXCD = 8, WGM = 8;
__host__ __device__ __forceinline__ int lds_byte(int r, int c) { const int st = (r >> 4) * 2 + (c >> 5), rr = r & 15, cc = c & 31, ob = rr * 64 + cc * 2; return st * 1024 + (ob ^ (((ob >> 9) & 1) << 5)); }
__host__ __device__ __forceinline__ void stage_rc(int b, int& R, int& C) { const int st = b / 1024, sb = b % 1024, swz = sb ^ (((sb >> 9) & 1) << 5); R = (st >> 1) * 16 + swz / 64; C = (st & 1) * 32 + (swz % 64) / 2; }
__host__ __device__ __forceinline__ int perm32(int rho) { const int n = rho >> 4, i = rho & 15; return 8 * (i >> 2) + 4 * n + (i & 3); }
struct Unit { int pm, pn, tag; const char* pa; const char* pb; };

__device__ __forceinline__ void static_map(long L, int nM, int nN, int& pm, int& pn) {
    const int nwg = nM * nN; int wgid = (int)L;
    { const int q = nwg / NXCD, r = nwg % NXCD, xcd = wgid % NXCD, off = wgid / NXCD; wgid = (xcd < r ? xcd * (q + 1) : r * (q + 1) + (xcd - r) * q) + off; }
    const int nig = WGM * nN, gid = wgid / nig, fm = gid * WGM, gsz = (nM - fm) < WGM ? (nM - fm) : WGM;
    pm = fm + ((wgid % nig) % gsz); pn = (wgid % nig) / gsz;
}
struct DenseOrder {
    static constexpr bool GATHER = false; __device__ __forceinline__ unsigned a_off(const Unit&, int, int, int, int) const { return 0u; }
    const char* A; const char* Bt; int nM, nN, G, c; size_t tstep;
    __device__ __forceinline__ void init(const void* A_, const void* Bt_, int M, int N, int K) { A = (const char*)A_; Bt = (const char*)Bt_; nM = M / BM; nN = N / BM; G = gridDim.x; c = blockIdx.x; tstep = (size_t)BM * K * 2; }
    __device__ __forceinline__ bool next(int i, Unit& u) const {
        const long L = (long)i * G + c; if (L >= (long)nM * nN) return false;
        static_map(L, nM, nN, u.pm, u.pn); u.tag = 0; u.pa = A + (size_t)u.pm * tstep; u.pb = Bt + (size_t)u.pn * tstep; return true;
    }
};

template <int H> __device__ __forceinline__ bf16x8 half8(const i32x8 v) { const i32x4 x = H ? __builtin_shufflevector(v, v, 4, 5, 6, 7) : __builtin_shufflevector(v, v, 0, 1, 2, 3); bf16x8 r; __builtin_memcpy(&r, &x, 16); return r; }
template <class Epi, class Sched, int ES = 2>
__device__ __forceinline__ void gemm_phase(const int wv, LAS unsigned char* lds, const int K, const Sched& S, const Epi& E) {
    int tid_ = (wv << 6) | lane_id(); asm volatile("" : "+v"(tid_));
    const int tid = tid_, wid = __builtin_amdgcn_readfirstlane(tid >> 6), lane = tid & 63, wr = wid >> 2, wc = wid & 3, fr = lane & 15, fq = lane >> 4;
    const int nt = K * ES / (BK * 2);
    unsigned voffA[2], voffB[2]; int RA[2], CA[2];
#pragma unroll
    for (int i = 0; i < 2; ++i) { int R, C; stage_rc(tid * 16 + i * 8192, R, C); const int Rb = Epi::PERM ? ((R & ~31) + perm32(R & 31)) : R; RA[i] = R; CA[i] = C;
        voffA[i] = (unsigned)(R * K * ES + C * 2); voffB[i] = (unsigned)(Rb * K * ES + C * 2); }
    unsigned vA[2][2][2];
    const size_t kstep = (size_t)(BK * 2);
    const size_t hstep = (size_t)HALF * K * ES;
    const unsigned ldsw = (unsigned)wid * 1024u;
    const int aoff = lds_byte(wr * 64 + fr, fq * 8), boff = lds_byte(wc * 32 + fr, fq * 8);
#define PG8_SA(b, h) (((b) * 2 + (h)) * HTB)
#define PG8_SB(b, h) ((4 + (b) * 2 + (h)) * HTB)
#define PG8_STAGE(bufoff, gbase, voff) do { _Pragma("unroll") for (int _i = 0; _i < 2; ++_i) \
        __builtin_amdgcn_global_load_lds((const unsigned*)((const char*)(gbase) + (voff)[_i]), (LAS unsigned*)(lds + (bufoff) + ldsw + _i * 8192), 16, 0, 0); } while (0)
#define PG8_LDA(dst, b, h) do { _Pragma("unroll") for (int m = 0; m < 4; ++m) { const i32x4 _lo = *(const LAS i32x4*)(lds + PG8_SA(b, h) + aoff + m * 2048), _hi = *(const LAS i32x4*)(lds + PG8_SA(b, h) + aoff + m * 2048 + 1024); dst[m] = __builtin_shufflevector(_lo, _hi, 0, 1, 2, 3, 4, 5, 6, 7); } } while (0)
#define PG8_LDB(dst, b, h) do { _Pragma("unroll") for (int n = 0; n < 2; ++n) { const i32x4 _lo = *(const LAS i32x4*)(lds + PG8_SB(b, h) + boff + n * 2048), _hi = *(const LAS i32x4*)(lds + PG8_SB(b, h) + boff + n * 2048 + 1024); dst[n] = __builtin_shufflevector(_lo, _hi, 0, 1, 2, 3, 4, 5, 6, 7); } } while (0)
#define PG8_MMA(ai, bj, At, Bt) do { __builtin_amdgcn_s_setprio(1); _Pragma("unroll") for (int m = 0; m < 4; ++m) _Pragma("unroll") for (int n = 0; n < 2; ++n) { \
        if (ES == 2) { acc[ai][bj][m][n] = __builtin_amdgcn_mfma_f32_16x16x32_bf16(half8<0>(Bt[n]), half8<0>(At[m]), acc[ai][bj][m][n], 0, 0, 0); \
                       acc[ai][bj][m][n] = __builtin_amdgcn_mfma_f32_16x16x32_bf16(half8<1>(Bt[n]), half8<1>(At[m]), acc[ai][bj][m][n], 0, 0, 0); } \
        else asm volatile("v_mfma_scale_f32_16x16x128_f8f6f4 %0, %1, %2, %0, %3, %3 op_sel_hi:[0,0,0]" : "+v"(acc[ai][bj][m][n]) : "v"(Bt[n]), "v"(At[m]), "v"(one_scale)); } \
        __builtin_amdgcn_s_setprio(0); } while (0)
#define PG8_WAIT_V(n) asm volatile("s_waitcnt vmcnt(" #n ")" ::: "memory")
#define PG8_WAIT_L(n) asm volatile("s_waitcnt lgkmcnt(" #n ")" ::: "memory")
#define PG8_BAR __builtin_amdgcn_s_barrier()
#define PG8_SCHED __builtin_amdgcn_sched_barrier(0)
    constexpr int kd = (KDBL == 1 && (__is_same(Epi, EpiSwiglu) || __is_same(Epi, EpiYs))) || (KDBL == 2 && __is_same(Epi, EpiZ)) || (KDBL == 3 && (__is_same(Epi, EpiMixCat) || __is_same(Epi, EpiX1))) ? 1 : 0;
    Unit cur, nxt; int ui = 0;
    if (!S.next(0, cur)) return;
    f32x4 acc[2][2][4][2]; const f32x4 zz0 = zero4f();
#pragma unroll
    for (int a = 0; a < 2; ++a)
#pragma unroll
        for (int b = 0; b < 2; ++b)
#pragma unroll
            for (int m = 0; m < 4; ++m)
#pragma unroll
                for (int n = 0; n < 2; ++n) acc[a][b][m][n] = zz0;
    i32x8 At[4], B0[2], B1[2];
    const int one_scale = 0x7f7f7f7f;
    const char* cA = cur.pa; const char* cB = cur.pb;
#pragma unroll
    for (int h = 0; h < 2; ++h)
#pragma unroll
        for (int i = 0; i < 2; ++i) vA[0][h][i] = Sched::GATHER ? S.a_off(cur, h, RA[i], CA[i], K * ES) : voffA[i] + (unsigned)(h * hstep);
    if constexpr (kd && KMODE == 1) { cA = S.A; cB = S.Bt;
#pragma unroll
        for (int h = 0; h < 2; ++h)
#pragma unroll
            for (int i = 0; i < 2; ++i) vA[0][h][i] = voffA[i] + (unsigned)(h * hstep); }
    PG8_STAGE(PG8_SB(0, 0), cB, voffB); PG8_STAGE(PG8_SA(0, 0), cA, vA[0][0]); PG8_STAGE(PG8_SB(0, 1), cB + hstep, voffB); PG8_STAGE(PG8_SA(0, 1), cA, vA[0][1]);
    if (wr == 1) PG8_BAR;
    PG8_WAIT_V(4); PG8_BAR;
    PG8_STAGE(PG8_SB(1, 0), cB + kstep, voffB); PG8_STAGE(PG8_SA(1, 0), cA + kstep, vA[0][0]); PG8_STAGE(PG8_SB(1, 1), cB + hstep + kstep, voffB);
    PG8_WAIT_V(6); PG8_BAR;
    for (;;) {
        const bool has_next = S.next((ui + 1) >> kd, nxt);
        const char* nA = has_next ? nxt.pa : cA; const char* nB = has_next ? nxt.pb : cB;
#pragma unroll
        for (int h = 0; h < 2; ++h)
#pragma unroll
            for (int i = 0; i < 2; ++i) vA[1][h][i] = has_next ? (Sched::GATHER ? S.a_off(nxt, h, RA[i], CA[i], K * ES) : voffA[i] + (unsigned)(h * hstep)) : vA[0][h][i];
        if constexpr (kd && KMODE == 1) { if (has_next && (ui & 1)) { nA = S.A; nB = S.Bt;
#pragma unroll
            for (int h = 0; h < 2; ++h)
#pragma unroll
                for (int i = 0; i < 2; ++i) vA[1][h][i] = voffA[i] + (unsigned)(h * hstep); } }
        const bool ld = !(kd && KMODE == 2 && !(ui & 1));
#pragma clang loop unroll(disable)
        for (int t = 0; t < nt; t += 2) {
            if constexpr (Epi::MID) { if (t == 8 || t == 12) E.mid(acc, cur, t, wr, wc, fr, fq); }
            const bool last = (t == nt - 2);
            const char* a1 = cA + (size_t)(t + 1) * kstep;
            const char* a2 = last ? nA : cA + (size_t)(t + 2) * kstep; const char* b2 = last ? nB : cB + (size_t)(t + 2) * kstep;
            const char* a3 = a2 + kstep; const char* b3 = b2 + kstep;
            unsigned w0[2], w1[2];
#pragma unroll
            for (int i = 0; i < 2; ++i) { w0[i] = vA[0][0][i]; w1[i] = vA[0][1][i]; }
            if (last) { asm volatile("" ::: "memory");
#pragma unroll
                for (int i = 0; i < 2; ++i) { w0[i] = vA[1][0][i]; w1[i] = vA[1][1][i]; } }
            PG8_LDB(B0, 0, 0); PG8_SCHED; PG8_LDA(At, 0, 0); if (ld) PG8_STAGE(PG8_SA(1, 1), a1, vA[0][1]);
            PG8_WAIT_L(8); PG8_BAR; PG8_WAIT_L(0); PG8_MMA(0, 0, At, B0); PG8_BAR; PG8_SCHED;
            PG8_LDB(B1, 0, 1); if (ld || last) PG8_STAGE(PG8_SB(0, 0), b2, voffB);
            PG8_BAR; PG8_WAIT_L(0); PG8_MMA(0, 1, At, B1); PG8_BAR;
            PG8_LDA(At, 0, 1); if (ld || last) PG8_STAGE(PG8_SA(0, 0), a2, w0);
            PG8_BAR; PG8_WAIT_L(0); PG8_MMA(1, 0, At, B0); PG8_BAR; PG8_SCHED;
            if (ld || last) PG8_STAGE(PG8_SB(0, 1), b2 + hstep, voffB);
            PG8_WAIT_V(6); PG8_BAR; PG8_MMA(1, 1, At, B1); PG8_BAR;
            PG8_LDB(B0, 1, 0); PG8_SCHED; PG8_LDA(At, 1, 0); if (ld || last) PG8_STAGE(PG8_SA(0, 1), a2, w1);
            PG8_WAIT_L(8); PG8_BAR; PG8_WAIT_L(0); PG8_MMA(0, 0, At, B0); PG8_BAR; PG8_SCHED;
            PG8_LDB(B1, 1, 1); if (ld || last) PG8_STAGE(PG8_SB(1, 0), b3, voffB);
            PG8_BAR; PG8_WAIT_L(0); PG8_MMA(0, 1, At, B1); PG8_BAR;
            PG8_LDA(At, 1, 1); if (ld || last) PG8_STAGE(PG8_SA(1, 0), a3, w0);
            PG8_BAR; PG8_WAIT_L(0); PG8_MMA(1, 0, At, B0); PG8_BAR; PG8_SCHED;
            if (ld || last) PG8_STAGE(PG8_SB(1, 1), b3 + hstep, voffB);
            PG8_WAIT_V(6); PG8_BAR; PG8_MMA(1, 1, At, B1); PG8_BAR;
        }
        if (ES == 1) asm volatile("s_nop 15\n\ts_nop 15" ::: "memory");
        if (!kd || (ui & 1)) E(acc, cur, wr, wc, fr, fq);
        if constexpr (EDBL == 1 && (__is_same(Epi, EpiSwiglu) || __is_same(Epi, EpiYs))) { asm volatile("" ::: "memory"); E(acc, cur, wr, wc, fr, fq); }
        if (!has_next) break;
        const f32x4 zz1 = zero4f();
#pragma unroll
        for (int a = 0; a < 2; ++a)
#pragma unroll
            for (int b = 0; b < 2; ++b)
#pragma unroll
                for (int m = 0; m < 4; ++m)
#pragma unroll
                    for (int n = 0; n < 2; ++n) acc[a][b][m][n] = zz1;
        cur = nxt; cA = nA; cB = nB; ++ui;
#pragma unroll
        for (int h = 0; h < 2; ++h)
#pragma unroll
            for (int i = 0; i < 2; ++i) vA[0][h][i] = vA[1][h][i];
    }
    PG8_WAIT_V(0);
    if (wr == 0) PG8_BAR;
    PG8_BAR;
#undef PG8_SA
#undef PG8_SB
#undef PG8_STAGE
#undef PG8_LDA
#undef PG8_LDB
#undef PG8_MMA
#undef PG8_WAIT_V
#undef PG8_WAIT_L
#undef PG8_BAR
#undef PG8_SCHED
}
}
using pg8::Unit;

struct EpiZ {
    static constexpr bool PERM = true, MID = false;
    bf16_t* Z; bf16_t* KV; bf16_t* GFp; int pn0; float scale;
    __device__ __forceinline__ void operator()(const f32x4 (&acc)[2][2][4][2], const Unit& u, int wr, int wc, int fr, int fq) const {
        const bool kvu = u.pn >= 32; const int pn = (u.pn & 31) + (kvu ? 0 : pn0);
        bf16_t* base = kvu ? KV : Z; const int ldc = kvu ? 1024 : INC; const bool sg = (!kvu) && (pn >= C_GATE / 256);
        if (sg) {
            bf16_t* gf = GFp + ((size_t)(u.pm * 12 + (pn - C_GATE / 256)) * 16) * 4096 + (size_t)((wr * 4 + wc) * 64 + fq * 16 + fr) * 8;
#pragma unroll
            for (int ai = 0; ai < 2; ++ai)
#pragma unroll
                for (int m = 0; m < 4; ++m)
#pragma unroll
                    for (int bj = 0; bj < 2; ++bj) { f32x4 v0 = acc[ai][bj][m][0] * scale, v1 = acc[ai][bj][m][1] * scale;
#pragma unroll
                        for (int j = 0; j < 4; ++j) { v0[j] = sigmoidf_(v0[j]); v1[j] = sigmoidf_(v1[j]); }
                        u32x4 w; w.x = cvt_pk_bf16(v0[0], v0[1]); w.y = cvt_pk_bf16(v0[2], v0[3]); w.z = cvt_pk_bf16(v1[0], v1[1]); w.w = cvt_pk_bf16(v1[2], v1[3]);
                        *(u32x4*)(gf + (size_t)((ai * 4 + m) * 2 + bj) * 4096) = w; }
            return; }
        const int row0 = u.pm * 256 + wr * 64 + fr, col0 = pn * 256 + wc * 32 + 8 * fq;
#pragma unroll
        for (int ai = 0; ai < 2; ++ai)
#pragma unroll
            for (int m = 0; m < 4; ++m) { bf16_t* rowp = base + (size_t)(row0 + ai * 128 + m * 16) * ldc + col0;
#pragma unroll
                for (int bj = 0; bj < 2; ++bj) { f32x4 v0 = acc[ai][bj][m][0] * scale, v1 = acc[ai][bj][m][1] * scale;
                    if (sg) {
#pragma unroll
                        for (int j = 0; j < 4; ++j) { v0[j] = sigmoidf_(v0[j]); v1[j] = sigmoidf_(v1[j]); } }
                    u32x4 w; w.x = cvt_pk_bf16(v0[0], v0[1]); w.y = cvt_pk_bf16(v0[2], v0[3]); w.z = cvt_pk_bf16(v1[0], v1[1]); w.w = cvt_pk_bf16(v1[2], v1[3]);
                    *(u32x4*)(rowp + bj * 128) = w; } }
    }
};
struct SchedZ8 {
    static constexpr bool GATHER = false; __device__ __forceinline__ unsigned a_off(const Unit&, int, int, int, int) const { return 0u; }
    const char* H8; const char* WIN8; int G, c;
    __device__ __forceinline__ bool next(int i, Unit& u) const {
        const long L = (long)i * G + c; if (L >= 64 * 23) return false;
        pg8::static_map(L, 64, 23, u.pm, u.pn); u.tag = 0; u.pa = H8 + (size_t)u.pm * (256 * 1024); u.pb = WIN8 + (size_t)u.pn * (256 * 1024); return true;
    }
};
struct SchedZ {
    static constexpr bool GATHER = false; __device__ __forceinline__ unsigned a_off(const Unit&, int, int, int, int) const { return 0u; }
    const char* H; const char* WinT; const char* HM; const char* WmkvT; int G, c;
    __device__ __forceinline__ bool next(int i, Unit& u) const {
        const long L = (long)i * G + c; if (L >= 480) return false;
        const size_t tstep = (size_t)256 * 1024 * 2;
        if (L < 448) { pg8::static_map(L, 64, 7, u.pm, u.pn); u.tag = 0; u.pa = H + (size_t)u.pm * tstep; u.pb = WinT + (size_t)u.pn * tstep; }
        else { const int q = (int)(L - 448); u.pm = q >> 2; u.pn = 32 + (q & 3); u.tag = 0; u.pa = HM + (size_t)u.pm * tstep; u.pb = WmkvT + (size_t)(q & 3) * tstep; }
        return true;
    }
};
struct EpiLora {
    static constexpr bool PERM = false, MID = false;
    float* L; const float* w0; const float* a0;
    __device__ __forceinline__ void operator()(const f32x4 (&acc)[2][2][4][2], const Unit& u, int wr, int wc, int fr, int fq) const {
        const int row0 = u.pm * 256 + wr * 64 + fr, col0 = u.pn * 256 + wc * 32 + 4 * fq; const int kind = u.pn >> 1; const f32x4 zb = zero4f();
#pragma unroll
        for (int bj = 0; bj < 2; ++bj)
#pragma unroll
            for (int n = 0; n < 2; ++n) { const int c = col0 + bj * 128 + n * 16;
                f32x4 bv = zb;
                if (kind == 0) bv = *(const f32x4*)(w0 + c); else if (kind == 1) bv = *(const f32x4*)(a0 + (c - 512));
#pragma unroll
                for (int ai = 0; ai < 2; ++ai)
#pragma unroll
                    for (int m = 0; m < 4; ++m) { f32x4 v = acc[ai][bj][m][n] + bv;
                        if (kind == 0) {
#pragma unroll
                            for (int j = 0; j < 4; ++j) v[j] = -0.60653066f * sigmoidf_(v[j]); }
                        else if (kind == 1) {
#pragma unroll
                            for (int j = 0; j < 4; ++j) v[j] = sigmoidf_(v[j]); }
                        const size_t row = (size_t)(row0 + ai * 128 + m * 16);
                        if (kind == 0) *(f32x4*)(L + row * 512 + c) = v;
                        else { u32x2 w; w.x = cvt_pk_bf16(v[0], v[1]); w.y = cvt_pk_bf16(v[2], v[3]); *(u32x2*)((bf16_t*)(L + (size_t)NTOK * 512) + row * 1024 + (c - 512)) = w; } } }
    }
};
template <int mode> struct EpiMix {
    static constexpr bool PERM = false, MID = false;
    float* mix32; bf16_t* mixbf; const bf16_t* Z;
    __device__ __forceinline__ void operator()(const f32x4 (&acc)[2][2][4][2], const Unit& u, int wr, int wc, int fr, int fq) const {
        const int row0 = u.pm * 256 + wr * 64 + fr, col0 = u.pn * 256 + wc * 32 + 4 * fq;
#pragma unroll
        for (int ai = 0; ai < 2; ++ai)
#pragma unroll
            for (int m = 0; m < 4; ++m) { const size_t row = (size_t)(row0 + ai * 128 + m * 16);
#pragma unroll
                for (int bj = 0; bj < 2; ++bj)
#pragma unroll
                    for (int n = 0; n < 2; ++n) { const int c = col0 + bj * 128 + n * 16;
                        const u32x2 gz = *(const u32x2*)(Z + row * INC + C_GATE + mode * 1024 + c); float g[4]; unpack4(gz, g);
                        f32x4 v = acc[ai][bj][m][n]; v[0] *= g[0]; v[1] *= g[1]; v[2] *= g[2]; v[3] *= g[3];
                        if (mode > 0) v += *(const f32x4*)(mix32 + row * 1024 + c);
                        if (mode < 2) *(f32x4*)(mix32 + row * 1024 + c) = v;
                        else { u32x2 w; w.x = cvt_pk_bf16(v[0], v[1]); w.y = cvt_pk_bf16(v[2], v[3]); *(u32x2*)(mixbf + row * 1024 + c) = w; } }
                asm volatile("" ::: "memory"); }
    }
};
struct EpiMixCat {
    static constexpr bool PERM = true, MID = true;
    bf16_t* mixbf; const bf16_t* GF; int tid;
    __device__ __forceinline__ const bf16_t* gtile(const Unit& u, int b) const { return GF + ((size_t)(u.pm * 12 + 4 * b + u.pn) * 16) * 4096 + (size_t)tid * 8; }
    __device__ __forceinline__ void mid(f32x4 (&acc)[2][2][4][2], const Unit& u, int t, int wr, int wc, int fr, int fq) const {
        const int ga = (t == 8) ? 0 : 1; int off = 0; asm volatile("" : "+v"(off));
        const bf16_t* pa = gtile(u, ga) + off; const bf16_t* pb = gtile(u, ga + 1) + off;
#pragma unroll
        for (int ai = 0; ai < 2; ++ai) {
#pragma unroll
            for (int m = 0; m < 4; ++m)
#pragma unroll
                for (int bj = 0; bj < 2; ++bj) { float a[8], b[8]; unpack8(*(const u32x4*)(pa + (size_t)((ai * 4 + m) * 2 + bj) * 4096), a); unpack8(*(const u32x4*)(pb + (size_t)((ai * 4 + m) * 2 + bj) * 4096), b);
#pragma unroll
                    for (int j = 0; j < 4; ++j) { acc[ai][bj][m][0][j] *= a[j] * __builtin_amdgcn_rcpf(b[j]); acc[ai][bj][m][1][j] *= a[4 + j] * __builtin_amdgcn_rcpf(b[4 + j]); } }
            asm volatile("" ::: "memory"); }
    }
    __device__ __forceinline__ void operator()(const f32x4 (&acc)[2][2][4][2], const Unit& u, int wr, int wc, int fr, int fq) const {
        const int row0 = u.pm * 256 + wr * 64 + fr, col0 = u.pn * 256 + wc * 32 + 8 * fq; const bf16_t* pg = gtile(u, 2);
#pragma unroll
        for (int ai = 0; ai < 2; ++ai)
#pragma unroll
            for (int m = 0; m < 4; ++m) { bf16_t* rowp = mixbf + (size_t)(row0 + ai * 128 + m * 16) * 1024 + col0;
#pragma unroll
                for (int bj = 0; bj < 2; ++bj) { float g[8]; unpack8(*(const u32x4*)(pg + (size_t)((ai * 4 + m) * 2 + bj) * 4096), g);
                    const f32x4 v0 = acc[ai][bj][m][0], v1 = acc[ai][bj][m][1];
                    u32x4 w; w.x = cvt_pk_bf16(v0[0] * g[0], v0[1] * g[1]); w.y = cvt_pk_bf16(v0[2] * g[2], v0[3] * g[3]); w.z = cvt_pk_bf16(v1[0] * g[4], v1[1] * g[5]); w.w = cvt_pk_bf16(v1[2] * g[6], v1[3] * g[7]);
                    *(u32x4*)(rowp + bj * 128) = w; } }
    }
};
struct EpiX1 {
    static constexpr bool PERM = true, MID = false;
    const float* x; bf16_t* x1;
    __device__ __forceinline__ void operator()(const f32x4 (&acc)[2][2][4][2], const Unit& u, int wr, int wc, int fr, int fq) const {
        const int row0 = u.pm * 256 + wr * 64 + fr, col0 = u.pn * 256 + wc * 32 + 8 * fq;
#pragma unroll
        for (int ai = 0; ai < 2; ++ai)
#pragma unroll
            for (int m = 0; m < 4; ++m) { const size_t off = (size_t)(row0 + ai * 128 + m * 16) * 1024 + col0;
#pragma unroll
                for (int bj = 0; bj < 2; ++bj) { const f32x4 a = __builtin_nontemporal_load((const f32x4*)(x + off + bj * 128)) + acc[ai][bj][m][0], b = __builtin_nontemporal_load((const f32x4*)(x + off + bj * 128 + 4)) + acc[ai][bj][m][1];
                    u32x4 w; w.x = cvt_pk_bf16(a[0], a[1]); w.y = cvt_pk_bf16(a[2], a[3]); w.z = cvt_pk_bf16(b[0], b[1]); w.w = cvt_pk_bf16(b[2], b[3]);
                    *(u32x4*)(x1 + off + bj * 128) = w; }
                if (m & 1) asm volatile("" ::: "memory"); }
    }
};
struct EpiSwiglu {
    static constexpr bool PERM = true, MID = false;
    unsigned char* act; const float* b1;
    __device__ __forceinline__ void operator()(const f32x4 (&acc)[2][2][4][2], const Unit& u, int wr, int wc, int fr, int fq) const {
        const int row0 = u.pm * 256 + wr * 64 + fr; const float* be = b1 + (size_t)u.tag * 2048; const int j = 128 * u.pn + 32 * wc + 8 * fq;
        constexpr float CS = -1.702f * 1.44269504f, ICS = 1.0f / CS;
        float bg[8], bl[8];
#pragma unroll
        for (int q = 0; q < 4; ++q) { const f32x4 t = *(const f32x4*)(be + 2 * j + 4 * q); bg[2 * q] = t[0] * CS; bl[2 * q] = (4.0f * t[1] + 4.0f) * ICS; bg[2 * q + 1] = t[2] * CS; bl[2 * q + 1] = (4.0f * t[3] + 4.0f) * ICS; }
#pragma unroll
        for (int ai = 0; ai < 2; ++ai)
#pragma unroll
            for (int m = 0; m < 4; ++m) { float o[8];
#pragma unroll
                for (int n = 0; n < 2; ++n)
#pragma unroll
                    for (int i = 0; i < 4; ++i) { const float sg = fmaxf(fmaf(acc[ai][0][m][n][i], CS / 256.0f, bg[4 * n + i]), 7.0f * CS);
                        const float ql = __builtin_amdgcn_fmed3f(fmaf(acc[ai][1][m][n][i], 4.0f * ICS / 256.0f, bl[4 * n + i]), -24.0f * ICS, 32.0f * ICS);
                        o[4 * n + i] = sg * __builtin_amdgcn_rcpf(1.0f + __builtin_amdgcn_exp2f(sg)) * ql; }
                u32x2 w; w.x = pack4_fp8(o[0], o[1], o[2], o[3]); w.y = pack4_fp8(o[4], o[5], o[6], o[7]);
                *(u32x2*)(act + (size_t)(row0 + ai * 128 + m * 16) * 1024 + j) = w; }
    }
};
struct EpiYs {
    static constexpr bool PERM = true, MID = false;
    bf16_t* ys; const float* b2;
    __device__ __forceinline__ void operator()(const f32x4 (&acc)[2][2][4][2], const Unit& u, int wr, int wc, int fr, int fq) const {
        const int row0 = u.pm * 256 + wr * 64 + fr, col0 = u.pn * 256 + wc * 32 + 8 * fq; const float* be = b2 + (size_t)u.tag * 1024;
#pragma unroll
        for (int bj = 0; bj < 2; ++bj) { const f32x4 c0 = *(const f32x4*)(be + col0 + bj * 128), c1 = *(const f32x4*)(be + col0 + bj * 128 + 4);
#pragma unroll
            for (int ai = 0; ai < 2; ++ai)
#pragma unroll
                for (int m = 0; m < 4; ++m) { const f32x4 v0 = acc[ai][bj][m][0] * (1.0f / 128.0f) + c0, v1 = acc[ai][bj][m][1] * (1.0f / 128.0f) + c1;
                    u32x4 w; w.x = cvt_pk_bf16(v0[0], v0[1]); w.y = cvt_pk_bf16(v0[2], v0[3]); w.z = cvt_pk_bf16(v1[0], v1[1]); w.w = cvt_pk_bf16(v1[2], v1[3]);
                    *(u32x4*)(ys + (size_t)(row0 + ai * 128 + m * 16) * 1024 + col0 + bj * 128) = w; } }
    }
};
template <bool GATHER_> struct SchedMoe {
    static constexpr bool GATHER = GATHER_;
    const char* A; const char* Bt; const LAS int* tstart; const int* stok; int lgN, total; size_t estride, tbytes;
    __device__ __forceinline__ bool next(int i, Unit& u) const {
        const int c = blockIdx.x; const int un = i * 256 + (c & 7) * 32 + (c >> 3); if (un >= total) return false;
        const int mt = un >> lgN, pn = un & ((1 << lgN) - 1); const int e = ((const LAS unsigned char*)tstart)[(LX_TEXP - LX_TSTART) + mt];
        u.pm = mt; u.pn = pn; u.tag = e; u.pa = GATHER ? A : A + (size_t)mt * tbytes; u.pb = Bt + (size_t)e * estride + (size_t)pn * tbytes; return true;
    }
    __device__ __forceinline__ unsigned a_off(const Unit& u, int h, int R, int C, int rowbytes) const { const int tok = stok[u.pm * 256 + h * 128 + R]; return (unsigned)(tok * rowbytes + C * 2); }
};

__device__ __forceinline__ int w1perm(int c) { const int j = c >> 1, s = c & 1; return ((j >> 7) << 8) | (s << 7) | (j & 127); }
__device__ __forceinline__ void phase_prep(const int wv, LAS unsigned char* lds) {
    KParams& p = *kparams();
    const int tid = opaque_tid(wv); unsigned char* ws = p.ws;
    LAS float* tile = (LAS float*)lds;
    struct TileJob { const float* src; bf16_t* dst; unsigned char* dst8; int K, N, perm, f8, ldd, k0, n0; };
    auto decode = [&](int t) -> TileJob { TileJob j; j.dst = nullptr; j.dst8 = nullptr; j.f8 = 0; j.perm = 0; j.ldd = 0; int lt;
        if (t < 960) { j.src = p.in[3]; j.dst = (bf16_t*)(ws + OFF_WINT); j.K = 1024; j.N = 7680; lt = t; if ((lt % 120) >= 28) { j.f8 = 1; j.dst8 = ws + OFF_WIN8 - (size_t)1792 * 1024; } }
        else if (t < 1088) { j.src = p.in[18]; j.dst = (bf16_t*)(ws + OFF_WMKVT); j.K = 1024; j.N = 1024; lt = t - 960; }
        else if (t < 1152) { j.src = p.in[21]; j.dst = (bf16_t*)(ws + OFF_PCAT); j.K = 512; j.N = 1024; lt = t - 1088; j.ldd = 1280; }
        else if (t < 1184) { j.src = p.in[22]; j.dst = (bf16_t*)(ws + OFF_PCAT) + 512; j.K = 256; j.N = 1024; lt = t - 1152; j.ldd = 1280; }
        else if (t < 1248) { j.src = p.in[23]; j.dst = (bf16_t*)(ws + OFF_PCAT) + 768; j.K = 512; j.N = 1024; lt = t - 1184; j.ldd = 1280; }
        else if (t < 1376) { j.src = p.in[24]; j.dst = (bf16_t*)(ws + OFF_WOT); j.K = 1024; j.N = 1024; lt = t - 1248; }
        else if (t < 9568) { const int q = t - 1376, e = q >> 8; j.src = p.in[28] + (size_t)e * 1024 * 2048; j.dst8 = ws + OFF_W1T + (size_t)e * 2048 * 1024; j.K = 1024; j.N = 2048; j.perm = 1; lt = q & 255; j.f8 = 1; }
        else { const int q = t - 9568, e = q >> 7; j.src = p.in[30] + (size_t)e * 1024 * 1024; j.dst8 = ws + OFF_W2T + (size_t)e * 1024 * 1024; j.K = 1024; j.N = 1024; lt = q & 127; j.f8 = 1; }
        const int tn = j.N >> 6; j.k0 = (lt / tn) * 128; j.n0 = (lt % tn) * 64; return j; };
    { const int G = (int)gridDim.x; int t = 13663 - (int)blockIdx.x;
      auto ldtile = [&](const TileJob& j, f32x4 (&v)[4]) {
#pragma unroll
          for (int i = 0; i < 4; ++i) { const int idx = tid + 512 * i, row = idx >> 4, c4 = idx & 15; v[i] = __builtin_nontemporal_load((const f32x4*)(j.src + (size_t)(j.k0 + row) * j.N + j.n0 + 4 * c4)); } };
      TileJob j0 = decode(t < 0 ? 0 : t), j1 = decode(t - G < 0 ? 0 : t - G); f32x4 v0[4], v1[4];
      if (t >= 0) ldtile(j0, v0);
      if (t - G >= 0) ldtile(j1, v1);
      for (; t >= 0; t -= G) {
#pragma unroll
          for (int i = 0; i < 4; ++i) { const int idx = tid + 512 * i, row = idx >> 4, c4 = idx & 15; LAS float* tp = tile + row * 65 + 4 * c4; tp[0] = v0[i][0]; tp[1] = v0[i][1]; tp[2] = v0[i][2]; tp[3] = v0[i][3]; }
          __syncthreads();
          const TileJob cur = j0; j0 = j1;
#pragma unroll
          for (int i = 0; i < 4; ++i) v0[i] = v1[i];
          if (t - 2 * G >= 0) { j1 = decode(t - 2 * G); ldtile(j1, v1); }
          if (!cur.f8) {
#pragma unroll
              for (int i = 0; i < 2; ++i) { const int kc = (tid & 3) | (((tid >> 8) & 1) << 2) | (i << 3), n = (tid >> 2) & 63; float f[8];
#pragma unroll
                  for (int j = 0; j < 8; ++j) f[j] = tile[(kc * 8 + j) * 65 + n];
                  const int drow = cur.n0 + n;
                  *(u32x4*)(cur.dst + (size_t)drow * (cur.ldd ? cur.ldd : cur.K) + cur.k0 + kc * 8) = pack8(f); }
          } else {
              const int kc = (tid & 3) | (((tid >> 8) & 1) << 2), n = (tid >> 2) & 63; float f[16];
#pragma unroll
              for (int j = 0; j < 16; ++j) f[j] = tile[(kc * 16 + j) * 65 + n] * 32.0f;
              const int drow = cur.perm ? w1perm(cur.n0 + n) : (cur.n0 + n);
              u32x4 w; w.x = pack4_fp8(f[0], f[1], f[2], f[3]); w.y = pack4_fp8(f[4], f[5], f[6], f[7]); w.z = pack4_fp8(f[8], f[9], f[10], f[11]); w.w = pack4_fp8(f[12], f[13], f[14], f[15]);
              *(u32x4*)(cur.dst8 + (size_t)drow * cur.K + cur.k0 + kc * 16) = w; }
          __syncthreads(); } }
    { const float* w2 = p.in[6]; const float* a2 = p.in[8]; const float* g2 = p.in[9]; bf16_t* lt = (bf16_t*)(ws + OFF_LORAT);
      for (int idx = blockIdx.x * 512 + tid; idx < 1536 * 32; idx += gridDim.x * 512) { const int n = idx >> 5, kc = idx & 31; float f[8];
#pragma unroll
          for (int j = 0; j < 8; ++j) { const int k = kc * 8 + j; float val = 0.f;
              if (n < 512) { if (k < 64) val = w2[k * 512 + n]; }
              else if (n < 1024) { if (k >= 64 && k < 128) val = a2[(k - 64) * 512 + (n - 512)]; }
              else { if (k >= 128) val = g2[(k - 128) * 512 + (n - 1024)]; }
              f[j] = val; }
          *(u32x4*)(lt + (size_t)n * 256 + kc * 8) = pack8(f); } }
    { const float* wr = p.in[26]; bf16_t* wt = (bf16_t*)(ws + OFF_WRT);
      for (int idx = blockIdx.x * 512 + tid; idx < 32 * 1024; idx += gridDim.x * 512) { const int e = idx >> 10, k = idx & 1023; const float v = wr[k * 32 + e];
          const unsigned hi = cvt_pk_bf16(v, 0.f) & 0xffffu; const float vh = __uint_as_float(hi << 16); const unsigned lo = cvt_pk_bf16(v - vh, 0.f) & 0xffffu;
          wt[idx] = (bf16_t)hi; wt[32768 + idx] = (bf16_t)lo; } }
    { const int wid = tid >> 6, lane = tid & 63; const int gw = blockIdx.x * 8 + wid, nw = gridDim.x * 8;
      for (int row0 = gw; row0 < NTOK + 2048; row0 += 3 * nw) {
          f32x4 v[3][4];
#pragma unroll
          for (int r3 = 0; r3 < 3; ++r3) { const int row = row0 + r3 * nw; if (row < NTOK + 2048) { const float* src = row >= NTOK ? p.in[1] + (size_t)(row - NTOK) * 1024 : p.in[0] + (size_t)row * 1024;
#pragma unroll
              for (int i = 0; i < 4; ++i) v[r3][i] = __builtin_nontemporal_load((const f32x4*)(src + 4 * lane + 256 * i)); } }
#pragma unroll
          for (int r3 = 0; r3 < 3; ++r3) { const int row = row0 + r3 * nw; if (row >= NTOK + 2048) break;
              const bool ism = row >= NTOK; const float* gain = ism ? p.in[17] : p.in[2]; bf16_t* dst = ism ? (bf16_t*)(ws + OFF_HM) + (size_t)(row - NTOK) * 1024 : (bf16_t*)(ws + OFF_H) + (size_t)row * 1024;
              float ss = 0.f;
#pragma unroll
              for (int i = 0; i < 4; ++i) ss += v[r3][i][0] * v[r3][i][0] + v[r3][i][1] * v[r3][i][1] + v[r3][i][2] * v[r3][i][2] + v[r3][i][3] * v[r3][i][3];
              ss = red64(ss); const float rs = rsqrtf(ss * (1.0f / 1024.0f) + 1e-5f);
#pragma unroll
              for (int i = 0; i < 4; ++i) { const f32x4 g = *(const f32x4*)(gain + 4 * lane + 256 * i); const f32x4 y = v[r3][i] * rs * g;
                  u32x2 w; w.x = cvt_pk_bf16(y[0], y[1]); w.y = cvt_pk_bf16(y[2], y[3]);
                  *(u32x2*)(dst + 4 * lane + 256 * i) = w;
                  if (!ism) *(unsigned*)(ws + OFF_H8 + (size_t)row * 1024 + 4 * lane + 256 * i) = pack4_fp8(y[0] * 8.0f, y[1] * 8.0f, y[2] * 8.0f, y[3] * 8.0f); } } }
    }
}

__device__ __forceinline__ void phase_elem_c(const int wv) {
    KParams& p = *kparams();
    const int gt = blockIdx.x * 512 + opaque_tid(wv), nthr = gridDim.x * 512; unsigned char* ws = p.ws;
    bf16_t* Z = (bf16_t*)(ws + OFF_Z); bf16_t* AL = (bf16_t*)(ws + OFF_ALORA); bf16_t* KV = (bf16_t*)(ws + OFF_KV);
    const float* mu = p.in[4];
    u32x4 za[4], zb[4]; const u32x4 zq0 = zero4u();
#pragma unroll
    for (int k = 0; k < 4; ++k) { const int idx = gt + k * nthr, t = idx >> 5, ch = idx & 31, col = C_ZW + 8 * ch;
        za[k] = *(const u32x4*)(Z + (size_t)t * INC + col);
        zb[k] = zq0; if ((t & (SEQ - 1)) != 0) zb[k] = *(const u32x4*)(Z + (size_t)(t - 1) * INC + col); }
#pragma unroll
    for (int k = 0; k < 4; ++k) { const int idx = gt + k * nthr, t = idx >> 5, ch = idx & 31, col = C_ZW + 8 * ch;
        float a[8], b[8]; unpack8(za[k], a); unpack8(zb[k], b);
        const f32x4 m0 = *(const f32x4*)(mu + col), m1 = *(const f32x4*)(mu + col + 4); const float mm[8] = {m0[0], m0[1], m0[2], m0[3], m1[0], m1[1], m1[2], m1[3]};
#pragma unroll
        for (int j = 0; j < 8; ++j) { float v = a[j] + (b[j] - a[j]) * mm[j]; if (ch < 8) v = tanhf(v); else if (ch >= 16) v = sigmoidf_(v); a[j] = v; }
        *(u32x4*)(AL + (size_t)t * 256 + 8 * ch) = pack8(a); }
}

__device__ __forceinline__ bf16x8 pack_frag(const f32x4 lo, const f32x4 hi) { u32x4 w; w.x = cvt_pk_bf16(lo[0], lo[1]); w.y = cvt_pk_bf16(lo[2], lo[3]); w.z = cvt_pk_bf16(hi[0], hi[1]); w.w = cvt_pk_bf16(hi[2], hi[3]); bf16x8 r; __builtin_memcpy(&r, &w, 16); return r; }
__device__ __forceinline__ bf16x8 tr2(LAS unsigned char* pa, LAS unsigned char* pb) { const s16x4 a = __builtin_amdgcn_ds_read_tr16_b64_v4i16((LAS s16x4*)pa), b = __builtin_amdgcn_ds_read_tr16_b64_v4i16((LAS s16x4*)pb); return __builtin_shufflevector(a, b, 0, 1, 2, 3, 4, 5, 6, 7); }
__device__ __forceinline__ bf16x8 rd2(LAS unsigned char* pa, LAS unsigned char* pb) { const s16x4 a = *(const LAS s16x4*)pa, b = *(const LAS s16x4*)pb; return __builtin_shufflevector(a, b, 0, 1, 2, 3, 4, 5, 6, 7); }
#define MFMA16(a, b, c) __builtin_amdgcn_mfma_f32_16x16x32_bf16((a), (b), (c), 0, 0, 0)
constexpr int CP_XA = 0, CP_XR = 4096, CP_XB = 8192, CP_XK = 12288, CP_VL = 16384, CP_NL = 16384, CP_WAVE = 20480;
__device__ __forceinline__ void phase_chunk_pre(const int wv, LAS unsigned char* lds) {
    KParams& p = *kparams();
    const int tid = opaque_tid(wv), wid = tid >> 6, lane = tid & 63, fr = lane & 15, fq = lane >> 4; unsigned char* ws = p.ws;
    if (tid == 0) { *(u32x4*)(ws + OFF_CTL + CTL_KEEP + blockIdx.x * 16) = *(const LAS u32x4*)(lds + LDS_X); asm volatile("s_waitcnt vmcnt(0)" ::: "memory"); }
    __syncthreads();
    LAS unsigned char* wl = lds + wid * CP_WAVE;
    const bf16_t* Z = (const bf16_t*)(ws + OFF_Z); bf16_t* C1 = (bf16_t*)(ws + OFF_C1); bf16_t* C2 = (bf16_t*)(ws + OFF_C2);
    const float* mu = p.in[4]; const float* k_k = p.in[10]; const float* k_a = p.in[11]; const float* r_k = p.in[12]; const float* ln_w = p.in[13]; const float* ln_b = p.in[14];
    const f32x4 z4 = zero4f();
    const bf16_t* LT = (const bf16_t*)(ws + OFF_LORAT); const float* w0v = p.in[5]; const float* a0v = p.in[7];
    for (int un = blockIdx.x; un < 512; un += gridDim.x) {
        const int b_ = un >> 6, cc = un & 63, h_ = wid; const int pr = ((b_ * 8 + h_) << 6) | cc; const int tok0 = b_ * SEQ + cc * 32;
        float gamC;
        int tidl = tid; asm volatile("" : "+v"(tidl));
        __syncthreads();
        { const int tl = tidl >> 4; const int t = tok0 + tl; u32x4 za[2], zb[2]; const u32x4 zq0 = zero4u();
#pragma unroll
          for (int g2 = 0; g2 < 2; ++g2) { const int col = C_ZW + 8 * ((tidl & 15) * 2 + g2); za[g2] = *(const u32x4*)(Z + (size_t)t * INC + col);
              zb[g2] = zq0; if ((t & (SEQ - 1)) != 0) zb[g2] = *(const u32x4*)(Z + (size_t)(t - 1) * INC + col); }
#pragma unroll
          for (int g2 = 0; g2 < 2; ++g2) { const int ch = (tidl & 15) * 2 + g2, col = C_ZW + 8 * ch; float a[8], b[8]; unpack8(za[g2], a); unpack8(zb[g2], b);
              const f32x4 m0 = *(const f32x4*)(mu + col), m1 = *(const f32x4*)(mu + col + 4); const float mm[8] = {m0[0], m0[1], m0[2], m0[3], m1[0], m1[1], m1[2], m1[3]};
#pragma unroll
              for (int j = 0; j < 8; ++j) { float v = a[j] + (b[j] - a[j]) * mm[j]; if (ch < 8) v = tanhf(v); else if (ch >= 16) v = sigmoidf_(v); a[j] = v; }
              *(LAS u32x4*)(lds + (tl >> 2) * CP_WAVE + CP_VL + (tl & 3) * 528 + ch * 16) = pack8(a); }
          __syncthreads(); }
        { const int fr = tidl & 15, fq = (tidl >> 4) & 3;
#pragma unroll
          for (int kind = 0; kind < 3; ++kind) { const int koff = kind == 0 ? 0 : (kind == 1 ? 64 : 128), nks = kind == 2 ? 4 : 2;
              f32x4 acc[4][2];
#pragma unroll
              for (int mt = 0; mt < 4; ++mt) { acc[mt][0] = z4; acc[mt][1] = z4; }
#pragma unroll
              for (int ks = 0; ks < nks; ++ks) { bf16x8 tf[2];
#pragma unroll
                  for (int nt = 0; nt < 2; ++nt) { const int tt = 16 * nt + fr; tf[nt] = *(const LAS bf16x8*)(lds + (tt >> 2) * CP_WAVE + CP_VL + (tt & 3) * 528 + (koff + 32 * ks + 8 * fq) * 2); }
#pragma unroll
                  for (int mt = 0; mt < 4; ++mt) { const bf16x8 wf = *(const bf16x8*)(LT + (size_t)(kind * 512 + h_ * 64 + 16 * mt + fr) * 256 + koff + 32 * ks + 8 * fq);
                      acc[mt][0] = MFMA16(tf[0], wf, acc[mt][0]); acc[mt][1] = MFMA16(tf[1], wf, acc[mt][1]); } }
#pragma unroll
              for (int mt = 0; mt < 4; ++mt) { const int ch = 16 * mt + fr; float bv = 0.f; if (kind == 0) bv = w0v[h_ * 64 + ch]; else if (kind == 1) bv = a0v[h_ * 64 + ch];
#pragma unroll
                  for (int nt = 0; nt < 2; ++nt) { f32x4 v = acc[mt][nt] + bv; LAS unsigned char* dst = wl + ch * 64 + (16 * nt + 4 * fq) * 2;
                      if (kind == 0) { float hf[4];
#pragma unroll
                          for (int j = 0; j < 4; ++j) v[j] = -0.60653066f * sigmoidf_(v[j]);
                          u32x2 hi; hi.x = cvt_pk_bf16(v[0], v[1]); hi.y = cvt_pk_bf16(v[2], v[3]);
                          hf[0] = v[0] - __uint_as_float(hi.x << 16); hf[1] = v[1] - __uint_as_float(hi.x & 0xffff0000u); hf[2] = v[2] - __uint_as_float(hi.y << 16); hf[3] = v[3] - __uint_as_float(hi.y & 0xffff0000u);
                          u32x2 lo; lo.x = cvt_pk_bf16(hf[0], hf[1]); lo.y = cvt_pk_bf16(hf[2], hf[3]);
                          *(LAS u32x2*)(dst + CP_XR) = hi; *(LAS u32x2*)(dst + CP_XB) = lo; }
                      else { if (kind == 1) {
#pragma unroll
                              for (int j = 0; j < 4; ++j) v[j] = sigmoidf_(v[j]); }
                          u32x2 w; w.x = cvt_pk_bf16(v[0], v[1]); w.y = cvt_pk_bf16(v[2], v[3]); *(LAS u32x2*)(dst + (kind == 1 ? CP_XK : CP_XA)) = w; } } } }
          asm volatile("s_waitcnt lgkmcnt(0)" ::: "memory");
          __syncthreads(); }
        { const int c = h_ * 64 + lane;
          const bf16_t* zp = Z + (size_t)tok0 * INC + c;
          const float mur = mu[c], muk = mu[C_K + c], muv = mu[C_V + c], kk_ = k_k[c], ka_ = k_a[c], rk_ = r_k[c], lnw = ln_w[c], lnb = ln_b[c];
          float pzr = 0.f, pzk = 0.f, pzv = 0.f;
          if (cc != 0) { pzr = __uint_as_float((unsigned)zp[-INC] << 16); pzk = __uint_as_float((unsigned)zp[-INC + C_K] << 16); pzv = __uint_as_float((unsigned)zp[-INC + C_V] << 16); }
          unsigned short zq[2][4][3]; u32x2 sq[2][4];
#pragma unroll
          for (int e = 0; e < 4; ++e) {
#pragma unroll
              for (int q = 0; q < 3; ++q) zq[0][e][q] = zp[(size_t)e * INC + q * 512]; }
#pragma unroll
          for (int r = 0; r < 4; ++r) sq[0][r] = *(const LAS u32x2*)(wl + r * 4096 + lane * 64);
          __builtin_amdgcn_sched_barrier(0);
          float cs = 0.f, g = 1.0f;
#pragma unroll
          for (int t4 = 0; t4 < 8; ++t4) { unsigned pa[2], pr_[2], pb[2], pk[2];
              if (t4 < 7) {
#pragma unroll
                  for (int e = 0; e < 4; ++e) {
#pragma unroll
                      for (int q = 0; q < 3; ++q) zq[(t4 + 1) & 1][e][q] = zp[(size_t)((t4 + 1) * 4 + e) * INC + q * 512]; }
#pragma unroll
                  for (int r = 0; r < 4; ++r) sq[(t4 + 1) & 1][r] = *(const LAS u32x2*)(wl + r * 4096 + lane * 64 + (t4 + 1) * 8); }
              __builtin_amdgcn_sched_barrier(0);
#pragma unroll
              for (int tp = 0; tp < 2; ++tp) { float va[2], vr[2], vb[2], vk[2];
#pragma unroll
                  for (int e = 0; e < 2; ++e) { const int te = tp * 2 + e, t = t4 * 4 + te;
                      const float zr = __uint_as_float((unsigned)zq[t4 & 1][te][0] << 16), zk = __uint_as_float((unsigned)zq[t4 & 1][te][1] << 16), zv = __uint_as_float((unsigned)zq[t4 & 1][te][2] << 16);
                      const float r = zr + (pzr - zr) * mur, k = zk + (pzk - zk) * muk, v = zv + (pzv - zv) * muv; pzr = zr; pzk = zk; pzv = zv;
                      const unsigned wg = sq[t4 & 1][0][te >> 1], wh = sq[t4 & 1][1][te >> 1], wlo = sq[t4 & 1][2][te >> 1], wa = sq[t4 & 1][3][te >> 1];
                      const float lw = __uint_as_float((te & 1) ? (wh & 0xffff0000u) : (wh << 16)) + __uint_as_float((te & 1) ? (wlo & 0xffff0000u) : (wlo << 16));
                      const float al = __uint_as_float((te & 1) ? (wa & 0xffff0000u) : (wa << 16)), gg = __uint_as_float((te & 1) ? (wg & 0xffff0000u) : (wg << 16));
                      const float kk = k * kk_, kp = k * (1.0f + (al - 1.0f) * ka_);
                      const float n2 = red64(kk * kk), bon = red64(r * kp * rk_);
                      const float kn = kk * __builtin_amdgcn_rsqf(fmaxf(n2, 1e-24f));
                      const float gm1 = g; cs += lw; g = __builtin_amdgcn_exp2f(cs * 1.44269504f); const float gi = __builtin_amdgcn_rcpf(g);
                      va[e] = -kn * gm1; vb[e] = kn * al * gi; vk[e] = kp * gi; vr[e] = r * g;
                      *(LAS bf16_t*)(wl + CP_VL + t * 128 + lane * 2) = (bf16_t)(cvt_pk_bf16(v, 0.f) & 0xffffu);
                      const size_t to = (size_t)(tok0 + t) * 512 + c;
                      C1[to] = (bf16_t)(cvt_pk_bf16(lnw * gg, 0.f) & 0xffffu); C2[to] = (bf16_t)(cvt_pk_bf16((lnb + bon * v) * gg, 0.f) & 0xffffu); }
                  pa[tp] = cvt_pk_bf16(va[0], va[1]); pr_[tp] = cvt_pk_bf16(vr[0], vr[1]); pb[tp] = cvt_pk_bf16(vb[0], vb[1]); pk[tp] = cvt_pk_bf16(vk[0], vk[1]); }
              *(LAS u32x2*)(wl + CP_XA + lane * 64 + t4 * 8) = (u32x2){pa[0], pa[1]}; *(LAS u32x2*)(wl + CP_XR + lane * 64 + t4 * 8) = (u32x2){pr_[0], pr_[1]};
              *(LAS u32x2*)(wl + CP_XB + lane * 64 + t4 * 8) = (u32x2){pb[0], pb[1]}; *(LAS u32x2*)(wl + CP_XK + lane * 64 + t4 * 8) = (u32x2){pk[0], pk[1]};
              __builtin_amdgcn_sched_barrier(0); }
          gamC = g; }
        asm volatile("s_waitcnt lgkmcnt(0)" ::: "memory");
        bf16x8 Vf[4];
        { const int vtb = (4 * fq + (fr >> 2)) * 128 + (fr & 3) * 8;
#pragma unroll
          for (int nv = 0; nv < 4; ++nv) { LAS unsigned char* pp = wl + CP_VL + vtb + nv * 32; Vf[nv] = tr2(pp, pp + 2048); } }
        asm volatile("s_waitcnt lgkmcnt(0)" ::: "memory");
        const int trb = (8 * fq + (fr >> 2)) * 64 + (fr & 3) * 8;
        bf16x8 LakF[2], QrbF[2], QrkF[2];
#pragma unroll
        for (int yi = 0; yi < 2; ++yi) {
            bf16x8 fy[2][2];
#pragma unroll
            for (int nt = 0; nt < 2; ++nt)
#pragma unroll
                for (int s2 = 0; s2 < 2; ++s2) { LAS unsigned char* pp = wl + (yi ? CP_XR : CP_XA) + trb + s2 * 2048 + nt * 32; fy[nt][s2] = tr2(pp, pp + 256); }
#pragma unroll
            for (int xi = 0; xi < 2; ++xi) {
                f32x4 d[2][2];
#pragma unroll
                for (int mi = 0; mi < 2; ++mi) { bf16x8 fx[2];
#pragma unroll
                    for (int s2 = 0; s2 < 2; ++s2) { LAS unsigned char* pp = wl + (xi ? CP_XK : CP_XB) + trb + s2 * 2048 + mi * 32; fx[s2] = tr2(pp, pp + 256); }
#pragma unroll
                    for (int nt = 0; nt < 2; ++nt) {
                        if (mi == 1 && nt == 0) { d[mi][nt] = z4; continue; }
                        f32x4 acc = MFMA16(fx[0], fy[nt][0], z4); acc = MFMA16(fx[1], fy[nt][1], acc);
#pragma unroll
                        for (int j = 0; j < 4; ++j) { const int i = 16 * mi + 4 * fq + j, t = 16 * nt + fr; const bool ok = yi ? (i <= t) : (i < t); acc[j] = ok ? acc[j] : 0.f; }
                        d[mi][nt] = acc; } }
                if (yi == 0 && xi == 0) {
#pragma unroll
                    for (int mi = 0; mi < 2; ++mi)
#pragma unroll
                        for (int nt = 0; nt < 2; ++nt)
#pragma unroll
                            for (int j = 0; j < 4; ++j) *(LAS float*)(wl + CP_NL + ((16 * nt + fr) * 32 + 16 * mi + 4 * fq + j) * 4) = d[mi][nt][j];
                } else {
#pragma unroll
                    for (int nt = 0; nt < 2; ++nt) { const bf16x8 f = pack_frag(d[0][nt], d[1][nt]); if (yi == 0) LakF[nt] = f; else if (xi == 0) QrbF[nt] = f; else QrkF[nt] = f; } } } }
        asm volatile("s_waitcnt lgkmcnt(0)" ::: "memory");
        bf16x8 InvF[2];
        { const int c = lane & 31; float X[32];
#pragma unroll
          for (int t = 0; t < 32; ++t) { float a0 = (t == c) ? 1.0f : 0.f, a1 = 0.f;
#pragma unroll
              for (int i4 = 0; i4 < (t + 3) / 4; ++i4) { const f32x4 nv = *(const LAS f32x4*)(wl + CP_NL + (t * 32 + 4 * i4) * 4);
#pragma unroll
                  for (int e = 0; e < 4; ++e) if (4 * i4 + e < t) { if (e & 1) a1 = fmaf(nv[e], X[4 * i4 + e], a1); else a0 = fmaf(nv[e], X[4 * i4 + e], a0); } }
              X[t] = a0 + a1; }
          asm volatile("s_waitcnt lgkmcnt(0)" ::: "memory");
#pragma unroll
          for (int t = 0; t < 32; ++t) *(LAS float*)(wl + CP_NL + (t * 32 + c) * 4) = X[t];
          asm volatile("s_waitcnt lgkmcnt(0)" ::: "memory");
#pragma unroll
          for (int n = 0; n < 2; ++n) { const f32x4 lo = *(const LAS f32x4*)(wl + CP_NL + ((16 * n + fr) * 32 + 4 * fq) * 4), hi = *(const LAS f32x4*)(wl + CP_NL + ((16 * n + fr) * 32 + 16 + 4 * fq) * 4); InvF[n] = pack_frag(lo, hi); } }
        bf16x8 UF[4], AhF[4];
#pragma unroll
        for (int nv = 0; nv < 4; ++nv) { const f32x4 w0 = MFMA16(LakF[0], Vf[nv], z4), w1 = MFMA16(LakF[1], Vf[nv], z4); const bf16x8 wf = pack_frag(w0, w1);
            const f32x4 u0 = MFMA16(InvF[0], wf, z4), u1 = MFMA16(InvF[1], wf, z4); UF[nv] = pack_frag(u0, u1); }
#pragma unroll
        for (int nc = 0; nc < 4; ++nc) { LAS unsigned char* pp = wl + CP_XA + (16 * nc + fr) * 64 + 8 * fq; const bf16x8 af = rd2(pp, pp + 32);
            const f32x4 h0 = MFMA16(InvF[0], af, z4), h1 = MFMA16(InvF[1], af, z4); AhF[nc] = pack_frag(h0, h1); }
        { f32x4 rt[4][2];
#pragma unroll
          for (int mc = 0; mc < 4; ++mc)
#pragma unroll
              for (int nt = 0; nt < 2; ++nt) { const s16x4 rr = __builtin_amdgcn_ds_read_tr16_b64_v4i16((LAS s16x4*)(wl + CP_XR + (16 * mc + 4 * fq + (fr >> 2)) * 64 + (fr & 3) * 8 + nt * 32));
                  f32x4 cin; cin[0] = __uint_as_float((unsigned)(unsigned short)rr[0] << 16); cin[1] = __uint_as_float((unsigned)(unsigned short)rr[1] << 16); cin[2] = __uint_as_float((unsigned)(unsigned short)rr[2] << 16); cin[3] = __uint_as_float((unsigned)(unsigned short)rr[3] << 16);
                  rt[mc][nt] = MFMA16(AhF[mc], QrbF[nt], cin); }
          bf16x8* RTF = (bf16x8*)(ws + OFF_RTF) + (size_t)pr * 256;
#pragma unroll
          for (int nt = 0; nt < 2; ++nt)
#pragma unroll
              for (int s2 = 0; s2 < 2; ++s2) RTF[(nt * 2 + s2) * 64 + lane] = pack_frag(rt[2 * s2][nt], rt[2 * s2 + 1][nt]); }
        { u32x2* YLF = (u32x2*)(ws + OFF_YLF) + (size_t)pr * 512;
#pragma unroll
          for (int nv = 0; nv < 4; ++nv)
#pragma unroll
              for (int mt = 0; mt < 2; ++mt) { f32x4 y = MFMA16(QrbF[mt], UF[nv], z4); y = MFMA16(QrkF[mt], Vf[nv], y);
                  u32x2 w; w.x = cvt_pk_bf16(y[0], y[1]); w.y = cvt_pk_bf16(y[2], y[3]); YLF[(nv * 2 + mt) * 64 + lane] = w; } }
        { bf16x8* GTF = (bf16x8*)(ws + OFF_GTF) + (size_t)pr * 512; u32x2* HHF = (u32x2*)(ws + OFF_HHF) + (size_t)pr * 1024;
#pragma unroll
          for (int nc = 0; nc < 4; ++nc) { LAS unsigned char* pp = wl + CP_XB + (16 * nc + fr) * 64 + 8 * fq; const bf16x8 bf_ = rd2(pp, pp + 32);
              LAS unsigned char* pk = wl + CP_XK + (16 * nc + fr) * 64 + 8 * fq; const bf16x8 kf_ = rd2(pk, pk + 32);
              const float gcol = __int_as_float(__builtin_amdgcn_ds_bpermute((16 * nc + fr) << 2, __float_as_int(gamC)));
              f32x4 gt[4];
#pragma unroll
              for (int mc = 0; mc < 4; ++mc) { f32x4 a = MFMA16(AhF[mc], bf_, z4);
#pragma unroll
                  for (int j = 0; j < 4; ++j) { if (mc == nc && 4 * fq + j == fr) a[j] += 1.0f; a[j] *= gcol; }
                  gt[mc] = a; }
              GTF[(nc * 2 + 0) * 64 + lane] = pack_frag(gt[0], gt[1]); GTF[(nc * 2 + 1) * 64 + lane] = pack_frag(gt[2], gt[3]);
              f32x4 grow;
#pragma unroll
              for (int j = 0; j < 4; ++j) grow[j] = __int_as_float(__builtin_amdgcn_ds_bpermute((16 * nc + 4 * fq + j) << 2, __float_as_int(gamC)));
#pragma unroll
              for (int nv = 0; nv < 4; ++nv) { f32x4 hh = MFMA16(bf_, UF[nv], z4); hh = MFMA16(kf_, Vf[nv], hh); hh = hh * grow;
                  u32x2 w; w.x = cvt_pk_bf16(hh[0], hh[1]); w.y = cvt_pk_bf16(hh[2], hh[3]); HHF[(nv * 4 + nc) * 64 + lane] = w; } } }
        asm volatile("s_waitcnt lgkmcnt(0)" ::: "memory");
    }
    __syncthreads();
    if (tid == 0) *(LAS u32x4*)(lds + LDS_X) = *(const u32x4*)(ws + OFF_CTL + CTL_KEEP + blockIdx.x * 16);
}
__device__ __forceinline__ void phase_scan_seq(const int wv, LAS unsigned char* lds) {
    KParams& p = *kparams();
    const int tid = opaque_tid(wv), wid = __builtin_amdgcn_readfirstlane(tid >> 6), lane = tid & 63, fr = lane & 15, fq = lane >> 4; unsigned char* ws = p.ws;
    if (blockIdx.x >= 64) return;
    const int bh = blockIdx.x, b = bh >> 3, h = bh & 7;
    const char* gG = (const char*)(ws + OFF_GTF) + (size_t)bh * 64 * 8192; const char* gR = (const char*)(ws + OFF_RTF) + (size_t)bh * 64 * 4096;
    const char* gH = (const char*)(ws + OFF_HHF) + (size_t)bh * 64 * 8192; const char* gY = (const char*)(ws + OFF_YLF) + (size_t)bh * 64 * 4096;
    constexpr int SLOT = 24576;
    if (wid >= 4) {
        const int w = wid - 4;
        auto issue = [&](int c) { LAS unsigned char* slot = lds + (c % 5) * SLOT;
#pragma unroll
            for (int i = 0; i < 6; ++i) { const int pc = w + 4 * i;
                const char* src = pc < 8 ? gG + (size_t)c * 8192 + pc * 1024 : pc < 12 ? gR + (size_t)c * 4096 + (pc - 8) * 1024 : pc < 20 ? gH + (size_t)c * 8192 + (pc - 12) * 1024 : gY + (size_t)c * 4096 + (pc - 20) * 1024;
                __builtin_amdgcn_global_load_lds((const unsigned*)(src + lane * 16), (LAS unsigned*)(slot + pc * 1024), 16, 0, 0); } };
        issue(0); issue(1); issue(2); issue(3);
        for (int c = 0; c < 64; ++c) {
            if (c < 60) asm volatile("s_waitcnt vmcnt(18)" ::: "memory"); else asm volatile("s_waitcnt vmcnt(0)" ::: "memory");
            __builtin_amdgcn_s_barrier();
            if (c + 4 < 64) issue(c + 4);
        }
        return; }
    const int nv = wid;
    float* Yraw = (float*)(ws + OFF_YRAW) + (size_t)b * SEQ * 512 + h * 64 + 16 * nv + fr;
    f32x4 T[4]; const f32x4 z4s = zero4f();
#pragma unroll
    for (int m = 0; m < 4; ++m) T[m] = z4s;
    for (int c = 0; c < 64; ++c) {
        __builtin_amdgcn_s_barrier();
        const LAS unsigned char* slot = lds + (c % 5) * SLOT + lane * 16;
        bf16x8 G[8], R[4]; u32x2 H[4], Y[2];
#pragma unroll
        for (int i = 0; i < 8; ++i) G[i] = *(const LAS bf16x8*)(slot + i * 1024);
#pragma unroll
        for (int i = 0; i < 4; ++i) R[i] = *(const LAS bf16x8*)(slot + 8192 + i * 1024);
#pragma unroll
        for (int i = 0; i < 4; ++i) H[i] = *(const LAS u32x2*)(lds + (c % 5) * SLOT + 12288 + (nv * 4 + i) * 512 + lane * 8);
#pragma unroll
        for (int i = 0; i < 2; ++i) Y[i] = *(const LAS u32x2*)(lds + (c % 5) * SLOT + 20480 + (nv * 2 + i) * 512 + lane * 8);
        const bf16x8 tf0 = pack_frag(T[0], T[1]), tf1 = pack_frag(T[2], T[3]);
#pragma unroll
        for (int nt = 0; nt < 2; ++nt) { f32x4 y; y[0] = bf_lo(Y[nt].x); y[1] = bf_hi(Y[nt].x); y[2] = bf_lo(Y[nt].y); y[3] = bf_hi(Y[nt].y);
            y = MFMA16(R[nt * 2], tf0, y); y = MFMA16(R[nt * 2 + 1], tf1, y);
#pragma unroll
            for (int j = 0; j < 4; ++j) Yraw[(size_t)(c * 32 + 16 * nt + 4 * fq + j) * 512] = y[j]; }
#pragma unroll
        for (int m = 0; m < 4; ++m) { f32x4 t; t[0] = bf_lo(H[m].x); t[1] = bf_hi(H[m].x); t[2] = bf_lo(H[m].y); t[3] = bf_hi(H[m].y);
            t = MFMA16(G[m * 2], tf0, t); t = MFMA16(G[m * 2 + 1], tf1, t); T[m] = t; }
        asm volatile("s_waitcnt lgkmcnt(0)" ::: "memory");
    }
}

__device__ __forceinline__ bf16x8 tr_pair(LAS unsigned char* pa, LAS unsigned char* pb, bool useB) {
    const s16x4 a = __builtin_amdgcn_ds_read_tr16_b64_v4i16((LAS s16x4*)pa);
    s16x4 b2 = (s16x4){0, 0, 0, 0};
    if (useB) b2 = __builtin_amdgcn_ds_read_tr16_b64_v4i16((LAS s16x4*)pb);
    return __builtin_shufflevector(a, b2, 0, 1, 2, 3, 4, 5, 6, 7);
}
__device__ __forceinline__ void phase_dil_attn(const int wv, LAS unsigned char* lds) {
    KParams& p = *kparams();
    const int tid = opaque_tid(wv), wid = tid >> 6, lane = tid & 63, fr = lane & 15, fq = lane >> 4; unsigned char* ws = p.ws;
    const bf16_t* Z = (const bf16_t*)(ws + OFF_Z); float* DILO = (float*)(ws + OFF_DILO); float* LSE = (float*)(ws + OFF_LSE);
    LAS unsigned char* kb = lds; LAS unsigned char* vb = lds + 32768; const float* qn = p.in[15]; const float* kn = p.in[16];
    float qkw[2][8];
#pragma unroll
    for (int ks = 0; ks < 2; ++ks)
#pragma unroll
        for (int j = 0; j < 8; ++j) qkw[ks][j] = qn[ks * 32 + 8 * fq + j] * kn[ks * 32 + 8 * fq + j];
    const bool seqwg = blockIdx.x < 64;
    const int u0 = seqwg ? 4 * (int)blockIdx.x : 256 + (int)blockIdx.x - 64, uend = seqwg ? 4 * (int)blockIdx.x + 4 : 1536, ustep = seqwg ? 1 : 192;
    auto umap = [&](int v) -> int { if (seqwg) return v; const int c2 = (int)blockIdx.x - 64, x = c2 & 7, y = c2 >> 3, i = (v - u0) / 192, k = 24 * i + y; return 256 + (k >> 3) * 64 + 8 * x + (k & 7); };
    const int ki = tid >> 1, half = tid & 1;
    u32x4 kvA[4], vvA[4], qvA[2], kvB[4], vvB[4], qvB[2]; bool kvalidA = false, kvalidB = false;
    auto unit_load = [&](int uv, u32x4 (&kv)[4], u32x4 (&vv)[4], u32x4 (&qv)[2], bool& kvalid) { const int u = umap(uv);
        const int b = u / 192, rem = u % 192, hh = rem >> 4, qb = rem & 15, g = hh >> 2;
        const int dil = g == 0 ? 1 : (g == 1 ? 4 : 16), nbc = 16 / dil, r = qb / nbc, j0 = (qb % nbc) * 128;
        const bf16_t* Zb = Z + (size_t)b * SEQ * INC; const int kj = j0 - 128 + ki; kvalid = kj >= 0;
        { const bf16_t* rowp = Zb + (size_t)((kvalid ? kj : 0) * dil + r) * INC + hh * 64 + half * 32;
#pragma unroll
            for (int i = 0; i < 4; ++i) { kv[i] = *(const u32x4*)(rowp + C_DK + 8 * i); vv[i] = *(const u32x4*)(rowp + C_DV + 8 * i); } }
        const int tq = (j0 + 16 * wid + fr) * dil + r;
#pragma unroll
        for (int ks = 0; ks < 2; ++ks) qv[ks] = *(const u32x4*)(Zb + (size_t)tq * INC + C_DQ + hh * 64 + ks * 32 + 8 * fq); };
    auto do_unit = [&](const int uvv, u32x4 (&kv)[4], u32x4 (&vv)[4], u32x4 (&qv)[2], bool& kvalid) { const int u = umap(uvv); const int uv_ = uvv;
        const int b = u / 192, rem = u % 192, hh = rem >> 4, qb = rem & 15, g = hh >> 2, hg = hh & 3;
        const int dil = g == 0 ? 1 : (g == 1 ? 4 : 16), nbc = 16 / dil, r = qb / nbc, j0 = (qb % nbc) * 128;
        { if (kvalid) {
              float ss = sumsq8(kv[0]) + sumsq8(kv[1]) + sumsq8(kv[2]) + sumsq8(kv[3]); ss += dpp_f<0xB1>(ss);
              const float rs = rsqrtf(ss * (1.0f / 64.0f) + 1e-5f);
#pragma unroll
              for (int i = 0; i < 4; ++i) kv[i] = scale8s(kv[i], rs); }
          else { const u32x4 zu = zero4u();
#pragma unroll
              for (int i = 0; i < 4; ++i) { kv[i] = zu; vv[i] = zu; } }
#pragma unroll
          for (int i = 0; i < 4; ++i) { const int sw = (half * 4 + i) ^ (ki & 7); *(LAS u32x4*)(kb + ki * 128 + sw * 16) = kv[i]; *(LAS u32x4*)(vb + ki * 128 + sw * 16) = vv[i]; } }
        const int qi = 16 * wid + fr, tq = (j0 + qi) * dil + r;
        bf16x8 qf[2];
        { float ss = sumsq8(qv[0]) + sumsq8(qv[1]); ss += sxor(ss, 16); ss += sxor(ss, 32);
          const float rs = rsqrtf(ss * (1.0f / 64.0f) + 1e-5f) * 0.125f;
#pragma unroll
          for (int ks = 0; ks < 2; ++ks) { const u32x4 w = scale8r(qv[ks], rs, qkw[ks]); __builtin_memcpy(&qf[ks], &w, 16); } }
        __syncthreads();
        if (uv_ + 2 * ustep < uend) unit_load(uv_ + 2 * ustep, kv, vv, qv, kvalid);
        f32x4 st[9]; float mx = -1e30f; const f32x4 zq = zero4f();
        LAS unsigned char* kp0 = kb + (16 * wid + fr) * 128 + ((fq ^ (fr & 7)) << 4); LAS unsigned char* kp1 = kb + (16 * wid + fr) * 128 + (((4 + fq) ^ (fr & 7)) << 4);
#pragma unroll
        for (int ti = 0; ti < 9; ++ti) {
            const bf16x8 k0 = *(const LAS bf16x8*)(kp0 + ti * 2048), k1 = *(const LAS bf16x8*)(kp1 + ti * 2048);
            f32x4 s = __builtin_amdgcn_mfma_f32_16x16x32_bf16(k0, qf[0], zq, 0, 0, 0);
            s = __builtin_amdgcn_mfma_f32_16x16x32_bf16(k1, qf[1], s, 0, 0, 0);
#pragma unroll
            for (int j = 0; j < 4; ++j) { const int ki = 16 * (wid + ti) + 4 * fq + j, off = qi + 128 - ki; const bool ok = (off >= 0) && (off <= 128) && (j0 - 128 + ki >= 0);
                s[j] = ok ? s[j] : -1e30f; mx = fmaxf(mx, s[j]); }
            st[ti] = s; }
        mx = fmaxf(mx, sxor(mx, 16)); mx = fmaxf(mx, sxor(mx, 32));
        float den = 0.f;
#pragma unroll
        for (int ti = 0; ti < 9; ++ti)
#pragma unroll
            for (int j = 0; j < 4; ++j) { const float e = __builtin_amdgcn_exp2f((st[ti][j] - mx) * 1.44269504f); st[ti][j] = e; den += e; }
        den += sxor(den, 16); den += sxor(den, 32);
        f32x4 o[4];
#pragma unroll
        for (int dt = 0; dt < 4; ++dt) o[dt] = zq;
        const int q4 = fr >> 2, p4 = fr & 3; const int kl = 4 * fq + q4;
        LAS unsigned char* vp[4];
#pragma unroll
        for (int dt = 0; dt < 4; ++dt) vp[dt] = vb + (16 * wid + kl) * 128 + (((2 * dt + (p4 >> 1)) ^ (kl & 7)) << 4) + (p4 & 1) * 8;
#pragma unroll
        for (int pp = 0; pp < 5; ++pp) { const bool two = pp < 4; const int tA = 2 * pp, tB = two ? 2 * pp + 1 : 2 * pp;
            u32x4 pw; pw.x = cvt_pk_bf16(st[tA][0], st[tA][1]); pw.y = cvt_pk_bf16(st[tA][2], st[tA][3]);
            if (two) { pw.z = cvt_pk_bf16(st[tB][0], st[tB][1]); pw.w = cvt_pk_bf16(st[tB][2], st[tB][3]); } else { pw.z = 0u; pw.w = 0u; }
            bf16x8 pf; __builtin_memcpy(&pf, &pw, 16);
#pragma unroll
            for (int dt = 0; dt < 4; ++dt) { const bf16x8 vf = tr_pair(vp[dt] + tA * 2048, vp[dt] + tB * 2048, two);
                o[dt] = __builtin_amdgcn_mfma_f32_16x16x32_bf16(vf, pf, o[dt], 0, 0, 0); } }
        const float inv = __builtin_amdgcn_rcpf(den); const size_t ob = ((size_t)(g * NTOK + b * SEQ + tq) * 4 + hg);
#pragma unroll
        for (int dt = 0; dt < 4; ++dt) *(f32x4*)(DILO + ob * 64 + 16 * dt + 4 * fq) = o[dt] * inv;
        if (fq == 0) LSE[ob] = mx + __logf(den);
        __syncthreads();
    };
    if (u0 < uend) unit_load(u0, kvA, vvA, qvA, kvalidA);
    if (u0 + ustep < uend) unit_load(u0 + ustep, kvB, vvB, qvB, kvalidB);
    for (int u = u0; u < uend; u += 2 * ustep) {
        do_unit(u, kvA, vvA, qvA, kvalidA);
        if (u + ustep < uend) do_unit(u + ustep, kvB, vvB, qvB, kvalidB);
    }
}

__device__ __forceinline__ void phase_mem_attn(const int wv, LAS unsigned char* lds) {
    KParams& p = *kparams();
    const int tid = opaque_tid(wv), wid = tid >> 6, lane = tid & 63, fr = lane & 15, fq = lane >> 4; unsigned char* ws = p.ws;
    const bf16_t* Z = (const bf16_t*)(ws + OFF_Z); const bf16_t* KV = (const bf16_t*)(ws + OFF_KV); bf16_t* YM = (bf16_t*)(ws + OFF_YCAT) + 768;
    LAS unsigned char* kb = lds; LAS unsigned char* vb = lds + 65536; const float* mqn = p.in[19]; const float* mkn = p.in[20];
    if (blockIdx.x < 64) return;
    float mqk[4][8];
#pragma unroll
    for (int ks = 0; ks < 4; ++ks)
#pragma unroll
        for (int j = 0; j < 8; ++j) mqk[ks][j] = mqn[ks * 32 + 8 * fq + j] * mkn[ks * 32 + 8 * fq + j];
    for (int bhq = (int)blockIdx.x - 64; bhq < 256; bhq += (int)gridDim.x - 64) {
        const int bhm = bhq >> 3, b = bhm >> 2, hm = bhm & 3;
        { const int ki = tid >> 1, half = tid & 1; const bf16_t* rowp = KV + (size_t)(b * 256 + ki) * 1024 + hm * 128 + half * 64;
          u32x4 kv[8], vv[8];
#pragma unroll
          for (int i = 0; i < 8; ++i) { kv[i] = *(const u32x4*)(rowp + 8 * i); vv[i] = *(const u32x4*)(rowp + 512 + 8 * i); }
          { float ss = 0.f;
#pragma unroll
            for (int i = 0; i < 8; ++i) ss += sumsq8(kv[i]);
            ss += dpp_f<0xB1>(ss); const float rs = rsqrtf(ss * (1.0f / 128.0f) + 1e-5f);
#pragma unroll
            for (int i = 0; i < 8; ++i) kv[i] = scale8s(kv[i], rs); }
#pragma unroll
          for (int i = 0; i < 8; ++i) { const int sw = (half * 8 + i) ^ (ki & 15); *(LAS u32x4*)(kb + ki * 256 + sw * 16) = kv[i]; *(LAS u32x4*)(vb + ki * 256 + sw * 16) = vv[i]; } }
        __syncthreads();
        const int q4 = fr >> 2, p4 = fr & 3; const int kl = 4 * fq + q4;
        LAS unsigned char* kp[4]; LAS unsigned char* vp[8];
#pragma unroll
        for (int ks = 0; ks < 4; ++ks) kp[ks] = kb + fr * 256 + (((4 * ks + fq) ^ fr) << 4);
#pragma unroll
        for (int dt = 0; dt < 8; ++dt) vp[dt] = vb + kl * 256 + (((2 * dt + (p4 >> 1)) ^ kl) << 4) + (p4 & 1) * 8;
        for (int qq = 0; qq < 2; ++qq) { const int qblk = (bhq & 7) * 2 + qq; const int tq = b * SEQ + qblk * 128 + 16 * wid + fr;
            bf16x8 qf[4];
#pragma unroll
            for (int ks = 0; ks < 4; ++ks) qf[ks] = *(const bf16x8*)(Z + (size_t)tq * INC + C_MQ + hm * 128 + ks * 32 + 8 * fq);
            { u32x4 qv[4]; float ss = 0.f;
#pragma unroll
              for (int ks = 0; ks < 4; ++ks) { __builtin_memcpy(&qv[ks], &qf[ks], 16); ss += sumsq8(qv[ks]); }
              ss += sxor(ss, 16); ss += sxor(ss, 32); const float rs = rsqrtf(ss * (1.0f / 128.0f) + 1e-5f);
#pragma unroll
              for (int ks = 0; ks < 4; ++ks) { const u32x4 w = scale8r(qv[ks], rs, mqk[ks]); __builtin_memcpy(&qf[ks], &w, 16); } }
            f32x4 st[16]; float mx = -1e30f; const f32x4 zq = zero4f();
#pragma unroll
            for (int ti = 0; ti < 16; ++ti) { f32x4 s = zq;
#pragma unroll
                for (int ks = 0; ks < 4; ++ks) { const bf16x8 kf = *(const LAS bf16x8*)(kp[ks] + ti * 4096); s = __builtin_amdgcn_mfma_f32_16x16x32_bf16(kf, qf[ks], s, 0, 0, 0); }
#pragma unroll
                for (int j = 0; j < 4; ++j) mx = fmaxf(mx, s[j]);
                st[ti] = s; if (ti & 1) asm volatile("" ::: "memory"); }
            mx = fmaxf(mx, sxor(mx, 16)); mx = fmaxf(mx, sxor(mx, 32));
            const float sc = 0.08838834764831845f * 1.44269504f; float den = 0.f;
#pragma unroll
            for (int ti = 0; ti < 16; ++ti)
#pragma unroll
                for (int j = 0; j < 4; ++j) { const float e = __builtin_amdgcn_exp2f((st[ti][j] - mx) * sc); st[ti][j] = e; den += e; }
            den += sxor(den, 16); den += sxor(den, 32);
            f32x4 o[8];
#pragma unroll
            for (int dt = 0; dt < 8; ++dt) o[dt] = zq;
#pragma unroll
            for (int pp = 0; pp < 8; ++pp) { const int tA = 2 * pp, tB = 2 * pp + 1;
                u32x4 pw; pw.x = cvt_pk_bf16(st[tA][0], st[tA][1]); pw.y = cvt_pk_bf16(st[tA][2], st[tA][3]); pw.z = cvt_pk_bf16(st[tB][0], st[tB][1]); pw.w = cvt_pk_bf16(st[tB][2], st[tB][3]);
                bf16x8 pf; __builtin_memcpy(&pf, &pw, 16);
#pragma unroll
                for (int dt = 0; dt < 8; ++dt) { const bf16x8 vf = tr_pair(vp[dt] + tA * 4096, vp[dt] + tB * 4096, true);
                    o[dt] = __builtin_amdgcn_mfma_f32_16x16x32_bf16(vf, pf, o[dt], 0, 0, 0); } }
            const float inv = __builtin_amdgcn_rcpf(den);
#pragma unroll
            for (int dt = 0; dt < 8; ++dt) { u32x2 w; w.x = cvt_pk_bf16(o[dt][0] * inv, o[dt][1] * inv); w.y = cvt_pk_bf16(o[dt][2] * inv, o[dt][3] * inv);
                *(u32x2*)(YM + (size_t)tq * 1280 + hm * 128 + 16 * dt + 4 * fq) = w; } }
        __syncthreads();
    }
}

__device__ __forceinline__ void phase_post(const int wv) {
    KParams& p = *kparams();
    const int gt = blockIdx.x * 512 + opaque_tid(wv), nthr = gridDim.x * 512; unsigned char* ws = p.ws;
    const float* Yraw = (const float*)(ws + OFF_YRAW); const bf16_t* C1 = (const bf16_t*)(ws + OFF_C1); const bf16_t* C2 = (const bf16_t*)(ws + OFF_C2); bf16_t* YR = (bf16_t*)(ws + OFF_YCAT);
    for (int idx = gt; idx < NTOK * 128; idx += nthr) { const int t = idx >> 7, c = ((idx >> 4) & 7) * 64 + 4 * (idx & 15);
        const f32x4 y = *(const f32x4*)(Yraw + (size_t)t * 512 + c);
        const float mean = red16(y[0] + y[1] + y[2] + y[3]) * (1.0f / 64.0f);
        const f32x4 d = y - mean; const float var = red16(d[0] * d[0] + d[1] * d[1] + d[2] * d[2] + d[3] * d[3]) * (1.0f / 64.0f);
        const float rs = rsqrtf(var + 64.0f * 1e-5f);
        float c1[4], c2[4]; unpack4(*(const u32x2*)(C1 + (size_t)t * 512 + c), c1); unpack4(*(const u32x2*)(C2 + (size_t)t * 512 + c), c2);
        u32x2 w; w.x = cvt_pk_bf16(d[0] * rs * c1[0] + c2[0], d[1] * rs * c1[1] + c2[1]); w.y = cvt_pk_bf16(d[2] * rs * c1[2] + c2[2], d[3] * rs * c1[3] + c2[3]);
        *(u32x2*)(YR + (size_t)t * 1280 + c) = w; }
    const float* DILO = (const float*)(ws + OFF_DILO); const float* LSE = (const float*)(ws + OFF_LSE); bf16_t* YD = (bf16_t*)(ws + OFF_YCAT) + 512;
    for (int idx = gt; idx < NTOK * 64; idx += nthr) { const int t = idx >> 6, hg = (idx >> 4) & 3, q = idx & 15;
        const float l0 = LSE[(size_t)t * 4 + hg], l1 = LSE[((size_t)NTOK + t) * 4 + hg], l2 = LSE[((size_t)2 * NTOK + t) * 4 + hg];
        const float m = fmaxf(l0, fmaxf(l1, l2)); const float e0 = __expf(l0 - m), e1 = __expf(l1 - m), e2 = __expf(l2 - m); const float inv = __builtin_amdgcn_rcpf(e0 + e1 + e2);
        const f32x4 o0 = *(const f32x4*)(DILO + ((size_t)t * 4 + hg) * 64 + 4 * q), o1 = *(const f32x4*)(DILO + (((size_t)NTOK + t) * 4 + hg) * 64 + 4 * q), o2 = *(const f32x4*)(DILO + (((size_t)2 * NTOK + t) * 4 + hg) * 64 + 4 * q);
        const f32x4 o = (o0 * e0 + o1 * e1 + o2 * e2) * inv;
        u32x2 w; w.x = cvt_pk_bf16(o[0], o[1]); w.y = cvt_pk_bf16(o[2], o[3]); *(u32x2*)(YD + (size_t)t * 1280 + hg * 64 + 4 * q) = w; }
}

__device__ __forceinline__ void phase_router(const int wv, LAS unsigned char* lds, const bool real = true) {
    KParams& p = *kparams();
    const int tid = opaque_tid(wv), wid = tid >> 6, lane = tid & 63, fr = lane & 15, fq = lane >> 4; unsigned char* ws = p.ws;
    const bf16_t* X1 = (const bf16_t*)(ws + OFF_X1B); const float* ln2 = p.in[25]; const float* br = p.in[27]; const bf16_t* WRT = (const bf16_t*)(ws + OFF_WRT);
    unsigned char* XN2 = ws + OFF_XN2; int* TOPE = (int*)(ws + OFF_TOPE); float* TOPG = (float*)(ws + OFF_TOPG);
    LAS int* hist = (LAS int*)(lds + LX_HIST);
    LAS float* red = (LAS float*)lds;
    LAS float* part = (LAS float*)(lds + 1024);
    if (tid < 32) hist[tid] = 0;
    const int grp = wid >> 2, kq = wid & 3;
    u32x4 xq[2][8];
#pragma unroll
    for (int rd = 0; rd < 2; ++rd) { const bf16_t* xp = X1 + (size_t)((blockIdx.x * 4 + rd * 2 + grp) * 16 + fr) * 1024 + kq * 256 + 8 * fq;
#pragma unroll
        for (int s2 = 0; s2 < 8; ++s2) xq[rd][s2] = __builtin_nontemporal_load((const u32x4*)(xp + 32 * s2)); }
#pragma unroll
    for (int rd = 0; rd < 2; ++rd) { const int t0 = (blockIdx.x * 4 + rd * 2 + grp) * 16;
        f32x4 xa[8], xb[8]; float ss = 0.f;
#pragma unroll
        for (int s2 = 0; s2 < 8; ++s2) { float f[8]; unpack8(xq[rd][s2], f); xa[s2] = (f32x4){f[0], f[1], f[2], f[3]}; xb[s2] = (f32x4){f[4], f[5], f[6], f[7]}; }
#pragma unroll
        for (int s2 = 0; s2 < 8; ++s2) ss += xa[s2][0] * xa[s2][0] + xa[s2][1] * xa[s2][1] + xa[s2][2] * xa[s2][2] + xa[s2][3] * xa[s2][3] + xb[s2][0] * xb[s2][0] + xb[s2][1] * xb[s2][1] + xb[s2][2] * xb[s2][2] + xb[s2][3] * xb[s2][3];
        ss += sxor(ss, 16); ss += sxor(ss, 32);
        __syncthreads();
        if (fq == 0) red[(grp * 4 + kq) * 16 + fr] = ss;
        __syncthreads();
        const float tot = red[(grp * 4 + 0) * 16 + fr] + red[(grp * 4 + 1) * 16 + fr] + red[(grp * 4 + 2) * 16 + fr] + red[(grp * 4 + 3) * 16 + fr];
        const float rs = rsqrtf(tot * (1.0f / 1024.0f) + 1e-5f);
        f32x4 acc[2]; acc[0] = zero4f(); acc[1] = acc[0];
#pragma unroll
        for (int s2 = 0; s2 < 8; ++s2) { const int k = kq * 256 + 32 * s2 + 8 * fq;
            const f32x4 g0 = *(const f32x4*)(ln2 + k), g1 = *(const f32x4*)(ln2 + k + 4);
            float xn[8]; xn[0] = xa[s2][0] * rs * g0[0]; xn[1] = xa[s2][1] * rs * g0[1]; xn[2] = xa[s2][2] * rs * g0[2]; xn[3] = xa[s2][3] * rs * g0[3];
            xn[4] = xb[s2][0] * rs * g1[0]; xn[5] = xb[s2][1] * rs * g1[1]; xn[6] = xb[s2][2] * rs * g1[2]; xn[7] = xb[s2][3] * rs * g1[3];
            const u32x4 hi = pack8(xn); float hf[8]; unpack8(hi, hf);
#pragma unroll
            for (int j = 0; j < 8; ++j) hf[j] = xn[j] - hf[j];
            const u32x4 lo = pack8(hf);
            { u32x2 q8; q8.x = pack4_fp8(xn[0] * 8.0f, xn[1] * 8.0f, xn[2] * 8.0f, xn[3] * 8.0f); q8.y = pack4_fp8(xn[4] * 8.0f, xn[5] * 8.0f, xn[6] * 8.0f, xn[7] * 8.0f); if (real) *(u32x2*)(XN2 + (size_t)(t0 + fr) * 1024 + k) = q8; }
            bf16x8 xh, xl; __builtin_memcpy(&xh, &hi, 16); __builtin_memcpy(&xl, &lo, 16);
#pragma unroll
            for (int m = 0; m < 2; ++m) { const bf16x8 wh = *(const bf16x8*)(WRT + (size_t)(16 * m + fr) * 1024 + k), wl = *(const bf16x8*)(WRT + 32768 + (size_t)(16 * m + fr) * 1024 + k);
                acc[m] = MFMA16(wh, xh, acc[m]); acc[m] = MFMA16(wh, xl, acc[m]); acc[m] = MFMA16(wl, xh, acc[m]); } }
#pragma unroll
        for (int m = 0; m < 2; ++m)
#pragma unroll
            for (int j = 0; j < 4; ++j) part[((grp * 4 + kq) * 32 + 16 * m + 4 * fq + j) * 16 + fr] = acc[m][j];
        __syncthreads();
        if (kq == 0) { float lg[8]; int le[8];
#pragma unroll
            for (int m = 0; m < 2; ++m)
#pragma unroll
                for (int j = 0; j < 4; ++j) { const int e = 16 * m + 4 * fq + j; le[m * 4 + j] = e;
                    lg[m * 4 + j] = part[((grp * 4 + 0) * 32 + e) * 16 + fr] + part[((grp * 4 + 1) * 32 + e) * 16 + fr] + part[((grp * 4 + 2) * 32 + e) * 16 + fr] + part[((grp * 4 + 3) * 32 + e) * 16 + fr] + br[e]; }
            float tv[4]; int te[4];
#pragma unroll
            for (int r = 0; r < 4; ++r) { float bv = lg[0]; int bi = le[0];
#pragma unroll
                for (int q = 1; q < 8; ++q) if (lg[q] > bv) { bv = lg[q]; bi = le[q]; }
#pragma unroll
                for (int sft = 16; sft < 64; sft <<= 1) { const float ov = sxor(bv, sft); const int oi = sxor(bi, sft); if (ov > bv || (ov == bv && oi < bi)) { bv = ov; bi = oi; } }
                tv[r] = bv; te[r] = bi;
#pragma unroll
                for (int q = 0; q < 8; ++q) if (le[q] == bi) lg[q] = -3.0e38f; }
            const float e1 = __expf(tv[1] - tv[0]), e2 = __expf(tv[2] - tv[0]), e3 = __expf(tv[3] - tv[0]); const float inv = 1.0f / (1.0f + e1 + e2 + e3);
            if (fq == 0 && real) { const int t = t0 + fr; *(int4*)(TOPE + (size_t)t * 4) = make_int4(te[0], te[1], te[2], te[3]); *(f32x4*)(TOPG + (size_t)t * 4) = (f32x4){inv, e1 * inv, e2 * inv, e3 * inv};
                atomicAdd((int*)&hist[te[0]], 1); atomicAdd((int*)&hist[te[1]], 1); atomicAdd((int*)&hist[te[2]], 1); atomicAdd((int*)&hist[te[3]], 1); } }
    }
    __syncthreads();
    if (tid < 32 && real) { const int hcount = hist[tid]; if (hcount) atomicAdd((int*)(ws + OFF_CTL + CTL_CNT) + tid, hcount); }
}

__device__ __forceinline__ void build_tables(const int wv, LAS unsigned char* lds) {
    KParams& p = *kparams();
    LAS int* ts = (LAS int*)(lds + LX_TSTART); LAS int* sb = (LAS int*)(lds + LX_SBASE); LAS int* cn = (LAS int*)(lds + LX_CNT);
    if (wv == 0) { const int l = lane_id(); int* gc = (int*)(p.ws + OFF_CTL + CTL_CNT);
        const int c = (l < 32) ? (int)__hip_atomic_load(gc + l, __ATOMIC_RELAXED, __HIP_MEMORY_SCOPE_AGENT) : 0; const int tl = (c + 255) >> 8; int v = tl;
#pragma unroll
        for (int d = 1; d < 32; d <<= 1) { const int o = __builtin_amdgcn_ds_bpermute((l - d) << 2, v); if (l >= d) v += o; }
        if (l < 32) { cn[l] = c; sb[l] = (v - tl) * 256; ts[l + 1] = v; if (l == 0) ts[0] = 0; } }
    __syncthreads();
    { const int tid = (wv << 6) | lane_id(); LAS unsigned char* te = (LAS unsigned char*)(lds + LX_TEXP); const int nt = ts[32];
      if (tid < nt) { int e = 0; while (e < 31 && tid >= ts[e + 1]) ++e; te[tid] = (unsigned char)e; } }
    __syncthreads();
}

__device__ __forceinline__ void phase_dispatch(const int wv, LAS unsigned char* lds, const bool real = true) {
    KParams& p = *kparams();
    const int tid = opaque_tid(wv); unsigned char* ws = p.ws;
    build_tables(wv, lds);
    const LAS int* sb = (const LAS int*)(lds + LX_SBASE); const LAS int* cn = (const LAS int*)(lds + LX_CNT);
    LAS int* hist = (LAS int*)(lds + LX_HIST); LAS int* bbase = (LAS int*)(lds + LX_BBASE);
    const int* TOPE = (const int*)(ws + OFF_TOPE); int* SLOT = (int*)(ws + OFF_SLOT); int* STOK = (int*)(ws + OFF_STOK);
    for (int tb = blockIdx.x; tb < NTOK / 64; tb += gridDim.x) {
        if (tid < 32) hist[tid] = 0;
        __syncthreads();
        int e = 0, lr = 0;
        if (tid < 256) { e = TOPE[(size_t)tb * 256 + tid]; lr = atomicAdd((int*)&hist[e], 1); }
        __syncthreads();
        if (tid < 32) { const int hcount = hist[tid]; bbase[tid] = (hcount && real) ? atomicAdd((int*)(ws + OFF_CTL + CTL_CUR) + tid, hcount) : 0; }
        __syncthreads();
        if (tid < 256 && real) { const int sl = sb[e] + bbase[e] + lr; SLOT[(size_t)tb * 256 + tid] = sl; STOK[sl] = tb * 64 + (tid >> 2); }
        __syncthreads();
    }
    for (int e = blockIdx.x; e < 32; e += gridDim.x) { const int lo = sb[e] + cn[e], hi = sb[e] + ((cn[e] + 255) & ~255);
        for (int rrow = lo + tid; rrow < hi; rrow += 512) STOK[rrow] = 0; }
}

__device__ __forceinline__ void phase_combine(const int wv, const bool real = true) {
    KParams& p = *kparams();
    const int tid = opaque_tid(wv), wid = tid >> 6, lane = tid & 63; unsigned char* ws = p.ws;
    const int* SLOT = (const int*)(ws + OFF_SLOT); const float* TOPG = (const float*)(ws + OFF_TOPG); const bf16_t* YS = (const bf16_t*)(ws + OFF_YS); const bf16_t* X1 = (const bf16_t*)(ws + OFF_X1B); float* out = p.out;
    for (int t0 = (blockIdx.x * 8 + wid) * 8; t0 < NTOK; t0 += gridDim.x * 64) {
        int4 sl[8]; f32x4 gg[8];
#pragma unroll
        for (int i = 0; i < 8; ++i) { sl[i] = *(const int4*)(SLOT + (size_t)(t0 + i) * 4); gg[i] = *(const f32x4*)(TOPG + (size_t)(t0 + i) * 4); }
#pragma unroll
        for (int i = 0; i < 8; ++i) { const int t = t0 + i; const int s4[4] = {sl[i].x, sl[i].y, sl[i].z, sl[i].w};
#pragma unroll
            for (int hf = 0; hf < 2; ++hf) { const int c = hf * 512 + 8 * lane; float acc[8];
                const u32x4 xv = __builtin_nontemporal_load((const u32x4*)(X1 + (size_t)t * 1024 + c));
                u32x4 yv[4];
#pragma unroll
                for (int k = 0; k < 4; ++k) yv[k] = __builtin_nontemporal_load((const u32x4*)(YS + (size_t)s4[k] * 1024 + c));
                unpack8(xv, acc);
#pragma unroll
                for (int k = 0; k < 4; ++k) { float f[8]; unpack8(yv[k], f);
#pragma unroll
                    for (int j = 0; j < 8; ++j) acc[j] = fmaf(gg[i][k], f[j], acc[j]); }
                float* dst = real ? out : (float*)(ws + OFF_ACT);
                *(f32x4*)(dst + (size_t)t * 1024 + c) = (f32x4){acc[0], acc[1], acc[2], acc[3]}; *(f32x4*)(dst + (size_t)t * 1024 + c + 4) = (f32x4){acc[4], acc[5], acc[6], acc[7]}; }
            if (i & 1) asm volatile("" ::: "memory"); }
    }
}

__global__ void __launch_bounds__(512, 2) mk_fwd(Params p) {
    extern __shared__ __attribute__((aligned(16))) unsigned char lds_raw[];
    LAS unsigned char* lds = (LAS unsigned char*)lds_raw;
    unsigned char* ws = p.ws;
    const int wv = __builtin_amdgcn_readfirstlane((int)threadIdx.x >> 6);
    const bool multi = (p.ph_hi - p.ph_lo) > 1;
    XcdBarrier xb; xb.bar = (unsigned*)(ws + OFF_CTL); xb.x = 0; xb.st = (volatile LAS unsigned*)(lds + LDS_X);
    if (multi) {
        if (wv == 0 && lane_id() == 0) { *(LAS u32x4*)(lds + LDS_X) = zero4u(); }
        __syncthreads();
        xb = xcd_barrier_post((unsigned*)(ws + OFF_CTL), (volatile LAS unsigned*)(lds + LDS_X), wv);
    }
#if MFMA_BENCH
    { const int l = lane_id(); unsigned h = (unsigned)l * 2654435761u ^ (unsigned)blockIdx.x * 40503u ^ (unsigned)wv * 977u;
      i32x8 a, b;
#pragma unroll
      for (int j = 0; j < 8; ++j) { h = h * 1664525u + 1013904223u; a[j] = (int)(MFMA_BENCH == 1 ? ((h & 0x00ff00ffu) | 0x3f003f00u) : ((h & 0x0f0f0f0fu) | 0x30303030u));
                                    h = h * 1664525u + 1013904223u; b[j] = (int)(MFMA_BENCH == 1 ? ((h & 0x00ff00ffu) | 0x3f003f00u) : ((h & 0x0f0f0f0fu) | 0x30303030u)); }
      f32x4 c[8]; const f32x4 z0 = zero4f();
#pragma unroll
      for (int j = 0; j < 8; ++j) c[j] = z0;
      const int one_scale = 0x7f7f7f7f;
#pragma clang loop unroll(disable)
      for (int it = 0; it < (MFMA_BENCH == 1 ? 1875 : 938); ++it) {
#pragma unroll
          for (int j = 0; j < 8; ++j) {
              if (MFMA_BENCH == 1) c[j] = (j & 1) ? __builtin_amdgcn_mfma_f32_16x16x32_bf16(pg8::half8<1>(a), pg8::half8<1>(b), c[j], 0, 0, 0) : __builtin_amdgcn_mfma_f32_16x16x32_bf16(pg8::half8<0>(a), pg8::half8<0>(b), c[j], 0, 0, 0);
              else asm volatile("v_mfma_scale_f32_16x16x128_f8f6f4 %0, %1, %2, %0, %3, %3 op_sel_hi:[0,0,0]" : "+v"(c[j]) : "v"(a), "v"(b), "v"(one_scale)); } }
      asm volatile("s_nop 15\n\ts_nop 15" ::: "memory");
      float sm = 0.f;
#pragma unroll
      for (int j = 0; j < 8; ++j) sm += c[j][0] + c[j][1] + c[j][2] + c[j][3];
      if (sm == 1.2345f) *(float*)(ws + OFF_CTL + 8192) = sm; }
#endif
    for (int ph = p.ph_lo; ph < p.ph_hi; ++ph) {
      if (ph == 2 || ph == 3) continue;
      for (int rep = 0; rep < (((DBL_MASK >> ph) & 1) ? 2 : 1); ++rep) {
        KParams& q = *kparams(); unsigned char* ws = q.ws;
        switch (ph) {
        case 0: phase_prep(wv, lds); break;
        case 1: { { SchedZ S; S.H = (const char*)(ws + OFF_H); S.WinT = (const char*)(ws + OFF_WINT); S.HM = (const char*)(ws + OFF_HM); S.WmkvT = (const char*)(ws + OFF_WMKVT); S.G = gridDim.x; S.c = blockIdx.x;
                    EpiZ E; E.Z = (bf16_t*)(ws + OFF_Z); E.KV = (bf16_t*)(ws + OFF_KV); E.GFp = (bf16_t*)(ws + OFF_GF); E.pn0 = 0; E.scale = 1.0f; pg8::gemm_phase(wv, lds, 1024, S, E); }
                  { SchedZ8 S; S.H8 = (const char*)(ws + OFF_H8); S.WIN8 = (const char*)(ws + OFF_WIN8); S.G = gridDim.x; S.c = blockIdx.x;
                    EpiZ E; E.Z = (bf16_t*)(ws + OFF_Z); E.KV = (bf16_t*)(ws + OFF_KV); E.GFp = (bf16_t*)(ws + OFF_GF); E.pn0 = 7; E.scale = 1.0f / 256.0f; pg8::gemm_phase<EpiZ, SchedZ8, 1>(wv, lds, 1024, S, E); } } break;
        case 2: phase_elem_c(wv); break;
        case 3: { pg8::DenseOrder S; S.init(ws + OFF_ALORA, ws + OFF_LORAT, NTOK, 1536, 256); EpiLora E; E.L = (float*)(ws + OFF_L); E.w0 = q.in[5]; E.a0 = q.in[7]; pg8::gemm_phase(wv, lds, 256, S, E); } break;
        case 4: phase_chunk_pre(wv, lds); break;
        case 5: for (int r2 = 0; r2 < (((DBL_MASK >> 16) & 1) ? 2 : 1); ++r2) phase_scan_seq(wv, lds);
                for (int r2 = 0; r2 < (((DBL_MASK >> 17) & 1) ? 2 : 1); ++r2) phase_dil_attn(wv, lds);
                for (int r2 = 0; r2 < (((DBL_MASK >> 18) & 1) ? 2 : 1); ++r2) phase_mem_attn(wv, lds); break;
        case 6: phase_post(wv); break;
        case 7: { pg8::DenseOrder S; S.init(ws + OFF_YCAT, ws + OFF_PCAT, NTOK, 1024, 1280); EpiMixCat E; E.mixbf = (bf16_t*)(ws + OFF_MIXBF); E.GF = (const bf16_t*)(ws + OFF_GF); E.tid = (wv << 6) | lane_id(); pg8::gemm_phase(wv, lds, 1280, S, E); } break;
        case 8: { pg8::DenseOrder S; S.init(ws + OFF_MIXBF, ws + OFF_WOT, NTOK, 1024, 1024); EpiX1 E; E.x = q.in[0]; E.x1 = (bf16_t*)(ws + OFF_X1B); pg8::gemm_phase(wv, lds, 1024, S, E); } break;
        case 9: phase_router(wv, lds, rep + 1 == (((DBL_MASK >> ph) & 1) ? 2 : 1)); break;
        case 10: phase_dispatch(wv, lds, rep + 1 == (((DBL_MASK >> ph) & 1) ? 2 : 1)); break;
        case 11: { build_tables(wv, lds); SchedMoe<true> S; S.A = (const char*)(ws + OFF_XN2); S.Bt = (const char*)(ws + OFF_W1T); S.tstart = (const LAS int*)(lds + LX_TSTART); S.stok = (const int*)(ws + OFF_STOK); S.lgN = 3; S.total = S.tstart[32] * 8; S.estride = (size_t)2048 * 1024; S.tbytes = (size_t)256 * 1024;
                   EpiSwiglu E; E.act = ws + OFF_ACT; E.b1 = q.in[29]; pg8::gemm_phase<EpiSwiglu, SchedMoe<true>, 1>(wv, lds, 1024, S, E); } break;
        case 12: { build_tables(wv, lds); SchedMoe<false> S; S.A = (const char*)(ws + OFF_ACT); S.Bt = (const char*)(ws + OFF_W2T); S.tstart = (const LAS int*)(lds + LX_TSTART); S.stok = nullptr; S.lgN = 2; S.total = S.tstart[32] * 4; S.estride = (size_t)1024 * 1024; S.tbytes = (size_t)256 * 1024;
                   EpiYs E; E.ys = (bf16_t*)(ws + OFF_YS); E.b2 = q.in[31]; pg8::gemm_phase<EpiYs, SchedMoe<false>, 1>(wv, lds, 1024, S, E); } break;
        case 13: phase_combine(wv, rep + 1 == (((DBL_MASK >> ph) & 1) ? 2 : 1)); break;
        default: break;
        }
      }
        if (ph + 1 < p.ph_hi) xcd_barrier(xb, wv);
        if (((DBL_MASK >> 20) & 1) && ph == 3 && multi) for (int e = 0; e < 10; ++e) xcd_barrier(xb, wv);
    }
}

extern "C" void kernel_launch(void* const* d_in, const int* in_sizes, int n_in, void* d_out, int out_size, void* d_ws, size_t ws_size, hipStream_t stream) {
    static int ready = 0;
    if (ready == 0) {
        if (n_in != 32 || out_size != NTOK * 1024 || ws_size < WS_NEED) { fprintf(stderr, "kernel_launch: unexpected shapes (n_in %d, out %d, ws %zu < %zu)\n", n_in, out_size, ws_size, (size_t)WS_NEED); ready = -1; return; }
        if (hipFuncSetAttribute((const void*)mk_fwd, hipFuncAttributeMaxDynamicSharedMemorySize, LDS_BYTES) != hipSuccess) { fprintf(stderr, "kernel_launch: hipFuncSetAttribute failed\n"); ready = -1; return; }
        int per_cu = 0, dev = 0, cus = 0; hipGetDevice(&dev); hipDeviceGetAttribute(&cus, hipDeviceAttributeMultiprocessorCount, dev);
        hipOccupancyMaxActiveBlocksPerMultiprocessor(&per_cu, (const void*)mk_fwd, 512, LDS_BYTES);
        if (per_cu < 1 || cus < 256) { fprintf(stderr, "kernel_launch: occupancy %d blocks/CU on %d CUs; need >= 1 on 256\n", per_cu, cus); ready = -1; (void)hipGetLastError(); return; }
        ready = 1;
    }
    if (ready < 0) return;
    hipMemsetAsync((char*)d_ws + OFF_CTL, 0, CTL_BYTES, stream);
    Params p{};
    for (int i = 0; i < 32; ++i) p.in[i] = (const float*)d_in[i];
    p.out = (float*)d_out; p.ws = (unsigned char*)d_ws;
#if MK_N_LAUNCH_PER_PHASE
    for (int ph = 0; ph < NPHASE; ++ph) { p.ph_lo = ph; p.ph_hi = ph + 1; hipLaunchKernelGGL(mk_fwd, dim3(256), dim3(512), LDS_BYTES, stream, p); }
#else
    p.ph_lo = 0; p.ph_hi = NPHASE;
    void* args[] = {&p};
    hipError_t e = hipLaunchCooperativeKernel((const void*)mk_fwd, dim3(256), dim3(512), args, LDS_BYTES, stream);
    if (e != hipSuccess) fprintf(stderr, "cooperative launch failed: %s\n", hipGetErrorString(e));
#endif
}
```

```cpp
#include <hip/hip_runtime.h>
#include <cstdio>
#include <cstdint>

#define LAS __attribute__((address_space(3)))
typedef unsigned short bf16_t;
typedef short bf16x8 __attribute__((ext_vector_type(8)));
typedef short s16x4 __attribute__((ext_vector_type(4)));
typedef float f32x4 __attribute__((ext_vector_type(4)));
typedef float f32x2 __attribute__((ext_vector_type(2)));
typedef unsigned u32x4 __attribute__((ext_vector_type(4)));
typedef unsigned u32x2 __attribute__((ext_vector_type(2)));
typedef int i32x8 __attribute__((ext_vector_type(8)));
typedef int i32x4 __attribute__((ext_vector_type(4)));

#ifndef DBL_MASK
#define DBL_MASK 0
#endif
#ifndef MK_N_LAUNCH_PER_PHASE
#define MK_N_LAUNCH_PER_PHASE 0
#endif

constexpr int NTOK = 16384, SEQ = 2048, INC = 7680;
constexpr int C_K = 512, C_V = 1024, C_ZW = 1536, C_DQ = 1792, C_DK = 2560, C_DV = 3328, C_MQ = 4096, C_GATE = 4608;
constexpr int NPHASE = 14;
constexpr int NSLOT_MAX = 65536 + 32 * 256;

constexpr size_t MiB = 1ull << 20;
constexpr size_t OFF_CTL = 0;
constexpr size_t CTL_BYTES = 32768;
constexpr size_t CTL_CNT = 16384;
constexpr size_t CTL_CUR = 16384 + 256;
constexpr size_t CTL_KEEP = 20480;
constexpr size_t OFF_TOPE = 1 * MiB;
constexpr size_t OFF_TOPG = 1 * MiB + 262144;
constexpr size_t OFF_SLOT = 1 * MiB + 524288;
constexpr size_t OFF_STOK = 2 * MiB;
constexpr size_t OFF_WRT = 3 * MiB;
constexpr size_t OFF_WINT = 4 * MiB, OFF_WMKVT = 19 * MiB, OFF_LORAT = 21 * MiB, OFF_PRT = 22 * MiB, OFF_PDT = 23 * MiB, OFF_PMT = 24 * MiB, OFF_WOT = 25 * MiB;
constexpr size_t OFF_WIN8 = 8 * MiB;
constexpr size_t OFF_H8 = 539 * MiB;
constexpr size_t OFF_YCAT = 223 * MiB;
constexpr size_t OFF_PCAT = 22 * MiB;
constexpr size_t OFF_W1T = 27 * MiB, OFF_W2T = 155 * MiB, OFF_KV = 219 * MiB, OFF_YM = 223 * MiB, OFF_YR = 239 * MiB, OFF_YD = 255 * MiB, OFF_Z = 263 * MiB;
constexpr size_t OFF_H = 503 * MiB, OFF_HM = 535 * MiB, OFF_ALORA = 503 * MiB, OFF_L = 511 * MiB, OFF_REC = 607 * MiB;
constexpr size_t OFF_GF = OFF_REC;
constexpr size_t OFF_LW = OFF_REC + 64 * MiB;
constexpr size_t OFF_VB = OFF_REC + 96 * MiB;
constexpr size_t OFF_GTF = OFF_REC + 112 * MiB;
constexpr size_t OFF_RTF = OFF_REC + 144 * MiB;
constexpr size_t OFF_HHF = OFF_REC + 160 * MiB;
constexpr size_t OFF_YLF = OFF_REC + 192 * MiB;
constexpr size_t OFF_C1 = 816 * MiB, OFF_C2 = 832 * MiB, OFF_YRAW = 848 * MiB, OFF_DILO = 880 * MiB, OFF_LSE = 928 * MiB;
constexpr size_t OFF_MIX32 = 503 * MiB, OFF_MIXBF = 567 * MiB, OFF_XN2 = 503 * MiB, OFF_XS = 263 * MiB, OFF_ACT = 607 * MiB, OFF_YS = 407 * MiB;
constexpr size_t OFF_X1B = 263 * MiB;
constexpr size_t OFF_STOKE = 296 * MiB;
constexpr size_t OFF_POS = 2 * MiB;
constexpr size_t WS_NEED = 929 * MiB;

constexpr int LDS_BYTES = 160 * 1024;
constexpr int LDS_X = LDS_BYTES - 4096;
constexpr int LX_TSTART = LDS_X + 64;
constexpr int LX_SBASE = LDS_X + 256;
constexpr int LX_CNT = LDS_X + 512;
constexpr int LX_HIST = LDS_X + 768;
constexpr int LX_BBASE = LDS_X + 1024;
constexpr int LX_SLOTL = LDS_X + 2048;
constexpr int LX_TEXP = LDS_X + 3072;

struct Params { const float* in[32]; float* out; unsigned char* ws; int ph_lo, ph_hi; };
typedef const Params __attribute__((address_space(4))) KParams;
__device__ __forceinline__ KParams* kparams() { KParams* kp = (KParams*)__builtin_amdgcn_kernarg_segment_ptr(); asm volatile("" : "+s"(kp)); return kp; }

typedef __bf16 bf16x2_t __attribute__((ext_vector_type(2)));
__device__ __forceinline__ unsigned cvt_pk_bf16(float lo, float hi) { f32x2 v = {lo, hi}; bf16x2_t b = __builtin_convertvector(v, bf16x2_t); unsigned r; __builtin_memcpy(&r, &b, 4); return r; }
__device__ __forceinline__ unsigned pack4_fp8(float a, float b, float c, float d) { int r = __builtin_amdgcn_cvt_pk_fp8_f32(a, b, 0, false); r = __builtin_amdgcn_cvt_pk_fp8_f32(c, d, r, true); return (unsigned)r; }
__device__ __forceinline__ float bf_lo(unsigned u) { return __uint_as_float(u << 16); }
__device__ __forceinline__ float bf_hi(unsigned u) { return __uint_as_float(u & 0xffff0000u); }
__device__ __forceinline__ int lane_id() { int l; asm volatile("v_mbcnt_lo_u32_b32 %0, -1, 0\n\tv_mbcnt_hi_u32_b32 %0, -1, %0" : "=v"(l)); return l; }
__device__ __forceinline__ int sxor(int x, int m) { return __builtin_amdgcn_ds_bpermute((lane_id() ^ m) << 2, x); }
__device__ __forceinline__ float sxor(float x, int m) { return __int_as_float(__builtin_amdgcn_ds_bpermute((lane_id() ^ m) << 2, __float_as_int(x))); }
template <int CTRL> __device__ __forceinline__ float dpp_f(float x) { return __int_as_float(__builtin_amdgcn_update_dpp(0, __float_as_int(x), CTRL, 0xF, 0xF, true)); }
__device__ __forceinline__ float red4(float x) { x += dpp_f<0xB1>(x); x += dpp_f<0x4E>(x); return x; }
__device__ __forceinline__ float red8(float x) { x = red4(x); x += dpp_f<0x141>(x); return x; }
__device__ __forceinline__ float red16(float x) { x = red8(x); x += dpp_f<0x140>(x); return x; }
__device__ __forceinline__ float red64(float x) { x = red16(x); x += sxor(x, 16); x += sxor(x, 32); return x; }
__device__ __forceinline__ int opaque_tid(const int wv) { int t = (wv << 6) | lane_id(); asm volatile("" : "+v"(t)); return t; }
__device__ __forceinline__ f32x4 zero4f() { float z = 0.f; asm volatile("" : "+v"(z)); return (f32x4){z, z, z, z}; }
__device__ __forceinline__ u32x4 zero4u() { unsigned z = 0u; asm volatile("" : "+v"(z)); return (u32x4){z, z, z, z}; }
__device__ __forceinline__ float sigmoidf_(float x) { return __builtin_amdgcn_rcpf(1.0f + __builtin_amdgcn_exp2f(-1.44269504f * x)); }
__device__ __forceinline__ void unpack8(const u32x4 v, float (&f)[8]) { f[0] = bf_lo(v.x); f[1] = bf_hi(v.x); f[2] = bf_lo(v.y); f[3] = bf_hi(v.y); f[4] = bf_lo(v.z); f[5] = bf_hi(v.z); f[6] = bf_lo(v.w); f[7] = bf_hi(v.w); }
__device__ __forceinline__ u32x4 pack8(const float (&f)[8]) { u32x4 w; w.x = cvt_pk_bf16(f[0], f[1]); w.y = cvt_pk_bf16(f[2], f[3]); w.z = cvt_pk_bf16(f[4], f[5]); w.w = cvt_pk_bf16(f[6], f[7]); return w; }
__device__ __forceinline__ float sumsq8(const u32x4 v) { float f[8]; unpack8(v, f); float s = 0.f;
#pragma unroll
    for (int j = 0; j < 8; ++j) s += f[j] * f[j];
    return s; }
__device__ __forceinline__ u32x4 scale8(const u32x4 v, const float rs, const float* w) { float f[8]; unpack8(v, f); const f32x4 w0 = *(const f32x4*)w, w1 = *(const f32x4*)(w + 4);
    f[0] *= rs * w0[0]; f[1] *= rs * w0[1]; f[2] *= rs * w0[2]; f[3] *= rs * w0[3]; f[4] *= rs * w1[0]; f[5] *= rs * w1[1]; f[6] *= rs * w1[2]; f[7] *= rs * w1[3]; return pack8(f); }
__device__ __forceinline__ u32x4 scale8r(const u32x4 v, const float rs, const float (&w)[8]) { float f[8]; unpack8(v, f);
#pragma unroll
    for (int j = 0; j < 8; ++j) f[j] *= rs * w[j];
    return pack8(f); }
__device__ __forceinline__ u32x4 scale8s(const u32x4 v, const float rs) { float f[8]; unpack8(v, f);
#pragma unroll
    for (int j = 0; j < 8; ++j) f[j] *= rs;
    return pack8(f); }
__device__ __forceinline__ void unpack4(const u32x2 v, float (&f)[4]) { f[0] = bf_lo(v.x); f[1] = bf_hi(v.x); f[2] = bf_lo(v.y); f[3] = bf_hi(v.y); }

#define XB_TMO      128
#define XB_XCNT(j)  (256  + 64 * (j))
#define XB_XSUB(j)  (1280 + 64 * (j))
#define XB_XGEN(j)  (2304 + 64 * (j))
#define XB_TOP      3328
#define XB_TOPGEN   3392
#define XCD_BAR_WORDS 3456
#define XB_SPIN_CAP (1u << 22)
__device__ __forceinline__ unsigned xb_ld(unsigned* p)              { return __hip_atomic_load(p, __ATOMIC_RELAXED, __HIP_MEMORY_SCOPE_AGENT); }
__device__ __forceinline__ unsigned xb_add(unsigned* p, unsigned v) { return __hip_atomic_fetch_add(p, v, __ATOMIC_RELAXED, __HIP_MEMORY_SCOPE_AGENT); }
__device__ __forceinline__ unsigned xb_xcc_id() { return (unsigned)__builtin_amdgcn_s_getreg((3 << 11) | 20) & 0xFu; }
#define XB_SPIN(cond, bar) do { unsigned _sp = 0; while (cond) { __builtin_amdgcn_s_sleep(1); \
    if ((++_sp & 255u) == 0u) { if (xb_ld(&(bar)[XB_TMO])) break; if (_sp > XB_SPIN_CAP) { atomicAdd(&(bar)[XB_TMO], 1u); break; } } } } while (0)
struct XcdBarrier { unsigned* bar; unsigned x; volatile LAS unsigned* st; };
__device__ __forceinline__ XcdBarrier xcd_barrier_post(unsigned* bar, volatile LAS unsigned* st, const int wv) {
    XcdBarrier b; b.bar = bar; b.x = xb_xcc_id(); b.st = st;
    if (wv == 0 && lane_id() == 0) (void)xb_add(&bar[XB_XCNT(b.x)], 1u);
    return b;
}
__device__ __forceinline__ void xcd_barrier_complete(unsigned* bar, unsigned x, unsigned& nloc, unsigned& nx) {
    const unsigned G = gridDim.x * gridDim.y * gridDim.z;
    unsigned sum, cnt, mine, sp = 0u;
    for (;;) {
        sum = 0u; cnt = 0u; mine = 0u;
#pragma unroll
        for (unsigned j = 0; j < 16; ++j) { const unsigned c = xb_ld(&bar[XB_XCNT(j)]); sum += c; cnt += (c > 0u) ? 1u : 0u; mine = (j == x) ? c : mine; }
        if (sum == G) break;
        __builtin_amdgcn_s_sleep(1);
        if ((++sp & 255u) == 0u) { if (xb_ld(&bar[XB_TMO])) break; if (sp > XB_SPIN_CAP) { atomicAdd(&bar[XB_TMO], 1u); break; } }
    }
    nloc = mine > 0u ? mine : 1u; nx = cnt > 0u ? cnt : 1u;
}
__device__ __forceinline__ void xcd_barrier(const XcdBarrier& b, const int wv) {
    asm volatile("s_waitcnt vmcnt(0)" ::: "memory");
    __syncthreads();
    if (wv == 0 && lane_id() == 0) {
        unsigned* bar = b.bar;
        __builtin_amdgcn_s_waitcnt(0);
        unsigned nloc = b.st[0], nx = b.st[1];
        if (nloc == 0u) { xcd_barrier_complete(bar, b.x, nloc, nx); b.st[0] = nloc; b.st[1] = nx; }
        const unsigned old = xb_add(&bar[XB_XSUB(b.x)], 1u);
        const unsigned gen = old / nloc;
        if (old + 1u == (gen + 1u) * nloc) {
            __builtin_amdgcn_fence(__ATOMIC_RELEASE, "agent");
            asm volatile("s_waitcnt vmcnt(0)" ::: "memory");
            const unsigned og = xb_add(&bar[XB_TOP], 1u);
            const unsigned tg = og / nx;
            if (og + 1u == (tg + 1u) * nx) xb_add(&bar[XB_TOPGEN], 1u);
            else XB_SPIN(xb_ld(&bar[XB_TOPGEN]) == tg, bar);
            __builtin_amdgcn_fence(__ATOMIC_ACQUIRE, "agent");
            xb_add(&bar[XB_XGEN(b.x)], 1u);
            asm volatile("s_waitcnt vmcnt(0)" ::: "memory");
        } else {
            XB_SPIN(xb_ld(&bar[XB_XGEN(b.x)]) == gen, bar);
            __builtin_amdgcn_fence(__ATOMIC_ACQUIRE, "agent");
            asm volatile("s_waitcnt vmcnt(0)" ::: "memory");
        }
    }
    __syncthreads();
}

#ifndef MFMA_BENCH
#define MFMA_BENCH 0
#endif
#ifndef EDBL
#define EDBL 0
#endif
#ifndef KMODE
#define KMODE 0
#endif
#ifndef KDBL
#define KDBL 0
#endif
struct EpiSwiglu; struct EpiYs; struct EpiZ; struct EpiMixCat; struct EpiX1;
namespace pg8 {
constexpr int BM = 256, BK = 64, HALF = 128, HTB = HALF * BK * 2, STAGE_BYTES = 8 * HTB, NXCD = 8, WGM = 8;
__host__ __device__ __forceinline__ int lds_byte(int r, int c) { const int st = (r >> 4) * 2 + (c >> 5), rr = r & 15, cc = c & 31, ob = rr * 64 + cc * 2; return st * 1024 + (ob ^ (((ob >> 9) & 1) << 5)); }
__host__ __device__ __forceinline__ void stage_rc(int b, int& R, int& C) { const int st = b / 1024, sb = b % 1024, swz = sb ^ (((sb >> 9) & 1) << 5); R = (st >> 1) * 16 + swz / 64; C = (st & 1) * 32 + (swz % 64) / 2; }
__host__ __device__ __forceinline__ int perm32(int rho) { const int n = rho >> 4, i = rho & 15; return 8 * (i >> 2) + 4 * n + (i & 3); }
struct Unit { int pm, pn, tag; const char* pa; const char* pb; };

__device__ __forceinline__ void static_map(long L, int nM, int nN, int& pm, int& pn) {
    const int nwg = nM * nN; int wgid = (int)L;
    { const int q = nwg / NXCD, r = nwg % NXCD, xcd = wgid % NXCD, off = wgid / NXCD; wgid = (xcd < r ? xcd * (q + 1) : r * (q + 1) + (xcd - r) * q) + off; }
    const int nig = WGM * nN, gid = wgid / nig, fm = gid * WGM, gsz = (nM - fm) < WGM ? (nM - fm) : WGM;
    pm = fm + ((wgid % nig) % gsz); pn = (wgid % nig) / gsz;
}
struct DenseOrder {
    static constexpr bool GATHER = false; __device__ __forceinline__ unsigned a_off(const Unit&, int, int, int, int) const { return 0u; }
    const char* A; const char* Bt; int nM, nN, G, c; size_t tstep;
    __device__ __forceinline__ void init(const void* A_, const void* Bt_, int M, int N, int K) { A = (const char*)A_; Bt = (const char*)Bt_; nM = M / BM; nN = N / BM; G = gridDim.x; c = blockIdx.x; tstep = (size_t)BM * K * 2; }
    __device__ __forceinline__ bool next(int i, Unit& u) const {
        const long L = (long)i * G + c; if (L >= (long)nM * nN) return false;
        static_map(L, nM, nN, u.pm, u.pn); u.tag = 0; u.pa = A + (size_t)u.pm * tstep; u.pb = Bt + (size_t)u.pn * tstep; return true;
    }
};

template <int H> __device__ __forceinline__ bf16x8 half8(const i32x8 v) { const i32x4 x = H ? __builtin_shufflevector(v, v, 4, 5, 6, 7) : __builtin_shufflevector(v, v, 0, 1, 2, 3); bf16x8 r; __builtin_memcpy(&r, &x, 16); return r; }
template <class Epi, class Sched, int ES = 2>
__device__ __forceinline__ void gemm_phase(const int wv, LAS unsigned char* lds, const int K, const Sched& S, const Epi& E) {
    int tid_ = (wv << 6) | lane_id(); asm volatile("" : "+v"(tid_));
    const int tid = tid_, wid = __builtin_amdgcn_readfirstlane(tid >> 6), lane = tid & 63, wr = wid >> 2, wc = wid & 3, fr = lane & 15, fq = lane >> 4;
    const int nt = K * ES / (BK * 2);
    unsigned voffA[2], voffB[2]; int RA[2], CA[2];
#pragma unroll
    for (int i = 0; i < 2; ++i) { int R, C; stage_rc(tid * 16 + i * 8192, R, C); const int Rb = Epi::PERM ? ((R & ~31) + perm32(R & 31)) : R; RA[i] = R; CA[i] = C;
        voffA[i] = (unsigned)(R * K * ES + C * 2); voffB[i] = (unsigned)(Rb * K * ES + C * 2); }
    unsigned vA[2][2][2];
    const size_t kstep = (size_t)(BK * 2);
    const size_t hstep = (size_t)HALF * K * ES;
    const unsigned ldsw = (unsigned)wid * 1024u;
    const int aoff = lds_byte(wr * 64 + fr, fq * 8), boff = lds_byte(wc * 32 + fr, fq * 8);
#define PG8_SA(b, h) (((b) * 2 + (h)) * HTB)
#define PG8_SB(b, h) ((4 + (b) * 2 + (h)) * HTB)
#define PG8_STAGE(bufoff, gbase, voff) do { _Pragma("unroll") for (int _i = 0; _i < 2; ++_i) \
        __builtin_amdgcn_global_load_lds((const unsigned*)((const char*)(gbase) + (voff)[_i]), (LAS unsigned*)(lds + (bufoff) + ldsw + _i * 8192), 16, 0, 0); } while (0)
#define PG8_LDA(dst, b, h) do { _Pragma("unroll") for (int m = 0; m < 4; ++m) { const i32x4 _lo = *(const LAS i32x4*)(lds + PG8_SA(b, h) + aoff + m * 2048), _hi = *(const LAS i32x4*)(lds + PG8_SA(b, h) + aoff + m * 2048 + 1024); dst[m] = __builtin_shufflevector(_lo, _hi, 0, 1, 2, 3, 4, 5, 6, 7); } } while (0)
#define PG8_LDB(dst, b, h) do { _Pragma("unroll") for (int n = 0; n < 2; ++n) { const i32x4 _lo = *(const LAS i32x4*)(lds + PG8_SB(b, h) + boff + n * 2048), _hi = *(const LAS i32x4*)(lds + PG8_SB(b, h) + boff + n * 2048 + 1024); dst[n] = __builtin_shufflevector(_lo, _hi, 0, 1, 2, 3, 4, 5, 6, 7); } } while (0)
#define PG8_MMA(ai, bj, At, Bt) do { __builtin_amdgcn_s_setprio(1); _Pragma("unroll") for (int m = 0; m < 4; ++m) _Pragma("unroll") for (int n = 0; n < 2; ++n) { \
        if (ES == 2) { acc[ai][bj][m][n] = __builtin_amdgcn_mfma_f32_16x16x32_bf16(half8<0>(Bt[n]), half8<0>(At[m]), acc[ai][bj][m][n], 0, 0, 0); \
                       acc[ai][bj][m][n] = __builtin_amdgcn_mfma_f32_16x16x32_bf16(half8<1>(Bt[n]), half8<1>(At[m]), acc[ai][bj][m][n], 0, 0, 0); } \
        else asm volatile("v_mfma_scale_f32_16x16x128_f8f6f4 %0, %1, %2, %0, %3, %3 op_sel_hi:[0,0,0]" : "+v"(acc[ai][bj][m][n]) : "v"(Bt[n]), "v"(At[m]), "v"(one_scale)); } \
        __builtin_amdgcn_s_setprio(0); } while (0)
#define PG8_WAIT_V(n) asm volatile("s_waitcnt vmcnt(" #n ")" ::: "memory")
#define PG8_WAIT_L(n) asm volatile("s_waitcnt lgkmcnt(" #n ")" ::: "memory")
#define PG8_BAR __builtin_amdgcn_s_barrier()
#define PG8_SCHED __builtin_amdgcn_sched_barrier(0)
    constexpr int kd = (KDBL == 1 && (__is_same(Epi, EpiSwiglu) || __is_same(Epi, EpiYs))) || (KDBL == 2 && __is_same(Epi, EpiZ)) || (KDBL == 3 && (__is_same(Epi, EpiMixCat) || __is_same(Epi, EpiX1))) ? 1 : 0;
    Unit cur, nxt; int ui = 0;
    if (!S.next(0, cur)) return;
    f32x4 acc[2][2][4][2]; const f32x4 zz0 = zero4f();
#pragma unroll
    for (int a = 0; a < 2; ++a)
#pragma unroll
        for (int b = 0; b < 2; ++b)
#pragma unroll
            for (int m = 0; m < 4; ++m)
#pragma unroll
                for (int n = 0; n < 2; ++n) acc[a][b][m][n] = zz0;
    i32x8 At[4], B0[2], B1[2];
    const int one_scale = 0x7f7f7f7f;
    const char* cA = cur.pa; const char* cB = cur.pb;
#pragma unroll
    for (int h = 0; h < 2; ++h)
#pragma unroll
        for (int i = 0; i < 2; ++i) vA[0][h][i] = Sched::GATHER ? S.a_off(cur, h, RA[i], CA[i], K * ES) : voffA[i] + (unsigned)(h * hstep);
    if constexpr (kd && KMODE == 1) { cA = S.A; cB = S.Bt;
#pragma unroll
        for (int h = 0; h < 2; ++h)
#pragma unroll
            for (int i = 0; i < 2; ++i) vA[0][h][i] = voffA[i] + (unsigned)(h * hstep); }
    PG8_STAGE(PG8_SB(0, 0), cB, voffB); PG8_STAGE(PG8_SA(0, 0), cA, vA[0][0]); PG8_STAGE(PG8_SB(0, 1), cB + hstep, voffB); PG8_STAGE(PG8_SA(0, 1), cA, vA[0][1]);
    if (wr == 1) PG8_BAR;
    PG8_WAIT_V(4); PG8_BAR;
    PG8_STAGE(PG8_SB(1, 0), cB + kstep, voffB); PG8_STAGE(PG8_SA(1, 0), cA + kstep, vA[0][0]); PG8_STAGE(PG8_SB(1, 1), cB + hstep + kstep, voffB);
    PG8_WAIT_V(6); PG8_BAR;
    for (;;) {
        const bool has_next = S.next((ui + 1) >> kd, nxt);
        const char* nA = has_next ? nxt.pa : cA; const char* nB = has_next ? nxt.pb : cB;
#pragma unroll
        for (int h = 0; h < 2; ++h)
#pragma unroll
            for (int i = 0; i < 2; ++i) vA[1][h][i] = has_next ? (Sched::GATHER ? S.a_off(nxt, h, RA[i], CA[i], K * ES) : voffA[i] + (unsigned)(h * hstep)) : vA[0][h][i];
        if constexpr (kd && KMODE == 1) { if (has_next && (ui & 1)) { nA = S.A; nB = S.Bt;
#pragma unroll
            for (int h = 0; h < 2; ++h)
#pragma unroll
                for (int i = 0; i < 2; ++i) vA[1][h][i] = voffA[i] + (unsigned)(h * hstep); } }
        const bool ld = !(kd && KMODE == 2 && !(ui & 1));
#pragma clang loop unroll(disable)
        for (int t = 0; t < nt; t += 2) {
            if constexpr (Epi::MID) { if (t == 8 || t == 12) E.mid(acc, cur, t, wr, wc, fr, fq); }
            const bool last = (t == nt - 2);
            const char* a1 = cA + (size_t)(t + 1) * kstep;
            const char* a2 = last ? nA : cA + (size_t)(t + 2) * kstep; const char* b2 = last ? nB : cB + (size_t)(t + 2) * kstep;
            const char* a3 = a2 + kstep; const char* b3 = b2 + kstep;
            unsigned w0[2], w1[2];
#pragma unroll
            for (int i = 0; i < 2; ++i) { w0[i] = vA[0][0][i]; w1[i] = vA[0][1][i]; }
            if (last) { asm volatile("" ::: "memory");
#pragma unroll
                for (int i = 0; i < 2; ++i) { w0[i] = vA[1][0][i]; w1[i] = vA[1][1][i]; } }
            PG8_LDB(B0, 0, 0); PG8_SCHED; PG8_LDA(At, 0, 0); if (ld) PG8_STAGE(PG8_SA(1, 1), a1, vA[0][1]);
            PG8_WAIT_L(8); PG8_BAR; PG8_WAIT_L(0); PG8_MMA(0, 0, At, B0); PG8_BAR; PG8_SCHED;
            PG8_LDB(B1, 0, 1); if (ld || last) PG8_STAGE(PG8_SB(0, 0), b2, voffB);
            PG8_BAR; PG8_WAIT_L(0); PG8_MMA(0, 1, At, B1); PG8_BAR;
            PG8_LDA(At, 0, 1); if (ld || last) PG8_STAGE(PG8_SA(0, 0), a2, w0);
            PG8_BAR; PG8_WAIT_L(0); PG8_MMA(1, 0, At, B0); PG8_BAR; PG8_SCHED;
            if (ld || last) PG8_STAGE(PG8_SB(0, 1), b2 + hstep, voffB);
            PG8_WAIT_V(6); PG8_BAR; PG8_MMA(1, 1, At, B1); PG8_BAR;
            PG8_LDB(B0, 1, 0); PG8_SCHED; PG8_LDA(At, 1, 0); if (ld || last) PG8_STAGE(PG8_SA(0, 1), a2, w1);
            PG8_WAIT_L(8); PG8_BAR; PG8_WAIT_L(0); PG8_MMA(0, 0, At, B0); PG8_BAR; PG8_SCHED;
            PG8_LDB(B1, 1, 1); if (ld || last) PG8_STAGE(PG8_SB(1, 0), b3, voffB);
            PG8_BAR; PG8_WAIT_L(0); PG8_MMA(0, 1, At, B1); PG8_BAR;
            PG8_LDA(At, 1, 1); if (ld || last) PG8_STAGE(PG8_SA(1, 0), a3, w0);
            PG8_BAR; PG8_WAIT_L(0); PG8_MMA(1, 0, At, B0); PG8_BAR; PG8_SCHED;
            if (ld || last) PG8_STAGE(PG8_SB(1, 1), b3 + hstep, voffB);
            PG8_WAIT_V(6); PG8_BAR; PG8_MMA(1, 1, At, B1); PG8_BAR;
        }
        if (ES == 1) asm volatile("s_nop 15\n\ts_nop 15" ::: "memory");
        if (!kd || (ui & 1)) E(acc, cur, wr, wc, fr, fq);
        if constexpr (EDBL == 1 && (__is_same(Epi, EpiSwiglu) || __is_same(Epi, EpiYs))) { asm volatile("" ::: "memory"); E(acc, cur, wr, wc, fr, fq); }
        if (!has_next) break;
        const f32x4 zz1 = zero4f();
#pragma unroll
        for (int a = 0; a < 2; ++a)
#pragma unroll
            for (int b = 0; b < 2; ++b)
#pragma unroll
                for (int m = 0; m < 4; ++m)
#pragma unroll
                    for (int n = 0; n < 2; ++n) acc[a][b][m][n] = zz1;
        cur = nxt; cA = nA; cB = nB; ++ui;
#pragma unroll
        for (int h = 0; h < 2; ++h)
#pragma unroll
            for (int i = 0; i < 2; ++i) vA[0][h][i] = vA[1][h][i];
    }
    PG8_WAIT_V(0);
    if (wr == 0) PG8_BAR;
    PG8_BAR;
#undef PG8_SA
#undef PG8_SB
#undef PG8_STAGE
#undef PG8_LDA
#undef PG8_LDB
#undef PG8_MMA
#undef PG8_WAIT_V
#undef PG8_WAIT_L
#undef PG8_BAR
#undef PG8_SCHED
}
}
using pg8::Unit;

struct EpiZ {
    static constexpr bool PERM = true, MID = false;
    bf16_t* Z; bf16_t* KV; bf16_t* GFp; int pn0; float scale;
    __device__ __forceinline__ void operator()(const f32x4 (&acc)[2][2][4][2], const Unit& u, int wr, int wc, int fr, int fq) const {
        const bool kvu = u.pn >= 32; const int pn = (u.pn & 31) + (kvu ? 0 : pn0);
        bf16_t* base = kvu ? KV : Z; const int ldc = kvu ? 1024 : INC; const bool sg = (!kvu) && (pn >= C_GATE / 256);
        if (sg) {
            bf16_t* gf = GFp + ((size_t)(u.pm * 12 + (pn - C_GATE / 256)) * 16) * 4096 + (size_t)((wr * 4 + wc) * 64 + fq * 16 + fr) * 8;
#pragma unroll
            for (int ai = 0; ai < 2; ++ai)
#pragma unroll
                for (int m = 0; m < 4; ++m)
#pragma unroll
                    for (int bj = 0; bj < 2; ++bj) { f32x4 v0 = acc[ai][bj][m][0] * scale, v1 = acc[ai][bj][m][1] * scale;
#pragma unroll
                        for (int j = 0; j < 4; ++j) { v0[j] = sigmoidf_(v0[j]); v1[j] = sigmoidf_(v1[j]); }
                        u32x4 w; w.x = cvt_pk_bf16(v0[0], v0[1]); w.y = cvt_pk_bf16(v0[2], v0[3]); w.z = cvt_pk_bf16(v1[0], v1[1]); w.w = cvt_pk_bf16(v1[2], v1[3]);
                        *(u32x4*)(gf + (size_t)((ai * 4 + m) * 2 + bj) * 4096) = w; }
            return; }
        const int row0 = u.pm * 256 + wr * 64 + fr, col0 = pn * 256 + wc * 32 + 8 * fq;
#pragma unroll
        for (int ai = 0; ai < 2; ++ai)
#pragma unroll
            for (int m = 0; m < 4; ++m) { bf16_t* rowp = base + (size_t)(row0 + ai * 128 + m * 16) * ldc + col0;
#pragma unroll
                for (int bj = 0; bj < 2; ++bj) { f32x4 v0 = acc[ai][bj][m][0] * scale, v1 = acc[ai][bj][m][1] * scale;
                    if (sg) {
#pragma unroll
                        for (int j = 0; j < 4; ++j) { v0[j] = sigmoidf_(v0[j]); v1[j] = sigmoidf_(v1[j]); } }
                    u32x4 w; w.x = cvt_pk_bf16(v0[0], v0[1]); w.y = cvt_pk_bf16(v0[2], v0[3]); w.z = cvt_pk_bf16(v1[0], v1[1]); w.w = cvt_pk_bf16(v1[2], v1[3]);
                    *(u32x4*)(rowp + bj * 128) = w; } }
    }
};
struct SchedZ8 {
    static constexpr bool GATHER = false; __device__ __forceinline__ unsigned a_off(const Unit&, int, int, int, int) const { return 0u; }
    const char* H8; const char* WIN8; int G, c;
    __device__ __forceinline__ bool next(int i, Unit& u) const {
        const long L = (long)i * G + c; if (L >= 64 * 23) return false;
        pg8::static_map(L, 64, 23, u.pm, u.pn); u.tag = 0; u.pa = H8 + (size_t)u.pm * (256 * 1024); u.pb = WIN8 + (size_t)u.pn * (256 * 1024); return true;
    }
};
struct SchedZ {
    static constexpr bool GATHER = false; __device__ __forceinline__ unsigned a_off(const Unit&, int, int, int, int) const { return 0u; }
    const char* H; const char* WinT; const char* HM; const char* WmkvT; int G, c;
    __device__ __forceinline__ bool next(int i, Unit& u) const {
        const long L = (long)i * G + c; if (L >= 480) return false;
        const size_t tstep = (size_t)256 * 1024 * 2;
        if (L < 448) { pg8::static_map(L, 64, 7, u.pm, u.pn); u.tag = 0; u.pa = H + (size_t)u.pm * tstep; u.pb = WinT + (size_t)u.pn * tstep; }
        else { const int q = (int)(L - 448); u.pm = q >> 2; u.pn = 32 + (q & 3); u.tag = 0; u.pa = HM + (size_t)u.pm * tstep; u.pb = WmkvT + (size_t)(q & 3) * tstep; }
        return true;
    }
};
struct EpiLora {
    static constexpr bool PERM = false, MID = false;
    float* L; const float* w0; const float* a0;
    __device__ __forceinline__ void operator()(const f32x4 (&acc)[2][2][4][2], const Unit& u, int wr, int wc, int fr, int fq) const {
        const int row0 = u.pm * 256 + wr * 64 + fr, col0 = u.pn * 256 + wc * 32 + 4 * fq; const int kind = u.pn >> 1; const f32x4 zb = zero4f();
#pragma unroll
        for (int bj = 0; bj < 2; ++bj)
#pragma unroll
            for (int n = 0; n < 2; ++n) { const int c = col0 + bj * 128 + n * 16;
                f32x4 bv = zb;
                if (kind == 0) bv = *(const f32x4*)(w0 + c); else if (kind == 1) bv = *(const f32x4*)(a0 + (c - 512));
#pragma unroll
                for (int ai = 0; ai < 2; ++ai)
#pragma unroll
                    for (int m = 0; m < 4; ++m) { f32x4 v = acc[ai][bj][m][n] + bv;
                        if (kind == 0) {
#pragma unroll
                            for (int j = 0; j < 4; ++j) v[j] = -0.60653066f * sigmoidf_(v[j]); }
                        else if (kind == 1) {
#pragma unroll
                            for (int j = 0; j < 4; ++j) v[j] = sigmoidf_(v[j]); }
                        const size_t row = (size_t)(row0 + ai * 128 + m * 16);
                        if (kind == 0) *(f32x4*)(L + row * 512 + c) = v;
                        else { u32x2 w; w.x = cvt_pk_bf16(v[0], v[1]); w.y = cvt_pk_bf16(v[2], v[3]); *(u32x2*)((bf16_t*)(L + (size_t)NTOK * 512) + row * 1024 + (c - 512)) = w; } } }
    }
};
template <int mode> struct EpiMix {
    static constexpr bool PERM = false, MID = false;
    float* mix32; bf16_t* mixbf; const bf16_t* Z;
    __device__ __forceinline__ void operator()(const f32x4 (&acc)[2][2][4][2], const Unit& u, int wr, int wc, int fr, int fq) const {
        const int row0 = u.pm * 256 + wr * 64 + fr, col0 = u.pn * 256 + wc * 32 + 4 * fq;
#pragma unroll
        for (int ai = 0; ai < 2; ++ai)
#pragma unroll
            for (int m = 0; m < 4; ++m) { const size_t row = (size_t)(row0 + ai * 128 + m * 16);
#pragma unroll
                for (int bj = 0; bj < 2; ++bj)
#pragma unroll
                    for (int n = 0; n < 2; ++n) { const int c = col0 + bj * 128 + n * 16;
                        const u32x2 gz = *(const u32x2*)(Z + row * INC + C_GATE + mode * 1024 + c); float g[4]; unpack4(gz, g);
                        f32x4 v = acc[ai][bj][m][n]; v[0] *= g[0]; v[1] *= g[1]; v[2] *= g[2]; v[3] *= g[3];
                        if (mode > 0) v += *(const f32x4*)(mix32 + row * 1024 + c);
                        if (mode < 2) *(f32x4*)(mix32 + row * 1024 + c) = v;
                        else { u32x2 w; w.x = cvt_pk_bf16(v[0], v[1]); w.y = cvt_pk_bf16(v[2], v[3]); *(u32x2*)(mixbf + row * 1024 + c) = w; } }
                asm volatile("" ::: "memory"); }
    }
};
struct EpiMixCat {
    static constexpr bool PERM = true, MID = true;
    bf16_t* mixbf; const bf16_t* GF; int tid;
    __device__ __forceinline__ const bf16_t* gtile(const Unit& u, int b) const { return GF + ((size_t)(u.pm * 12 + 4 * b + u.pn) * 16) * 4096 + (size_t)tid * 8; }
    __device__ __forceinline__ void mid(f32x4 (&acc)[2][2][4][2], const Unit& u, int t, int wr, int wc, int fr, int fq) const {
        const int ga = (t == 8) ? 0 : 1; int off = 0; asm volatile("" : "+v"(off));
        const bf16_t* pa = gtile(u, ga) + off; const bf16_t* pb = gtile(u, ga + 1) + off;
#pragma unroll
        for (int ai = 0; ai < 2; ++ai) {
#pragma unroll
            for (int m = 0; m < 4; ++m)
#pragma unroll
                for (int bj = 0; bj < 2; ++bj) { float a[8], b[8]; unpack8(*(const u32x4*)(pa + (size_t)((ai * 4 + m) * 2 + bj) * 4096), a); unpack8(*(const u32x4*)(pb + (size_t)((ai * 4 + m) * 2 + bj) * 4096), b);
#pragma unroll
                    for (int j = 0; j < 4; ++j) { acc[ai][bj][m][0][j] *= a[j] * __builtin_amdgcn_rcpf(b[j]); acc[ai][bj][m][1][j] *= a[4 + j] * __builtin_amdgcn_rcpf(b[4 + j]); } }
            asm volatile("" ::: "memory"); }
    }
    __device__ __forceinline__ void operator()(const f32x4 (&acc)[2][2][4][2], const Unit& u, int wr, int wc, int fr, int fq) const {
        const int row0 = u.pm * 256 + wr * 64 + fr, col0 = u.pn * 256 + wc * 32 + 8 * fq; const bf16_t* pg = gtile(u, 2);
#pragma unroll
        for (int ai = 0; ai < 2; ++ai)
#pragma unroll
            for (int m = 0; m < 4; ++m) { bf16_t* rowp = mixbf + (size_t)(row0 + ai * 128 + m * 16) * 1024 + col0;
#pragma unroll
                for (int bj = 0; bj < 2; ++bj) { float g[8]; unpack8(*(const u32x4*)(pg + (size_t)((ai * 4 + m) * 2 + bj) * 4096), g);
                    const f32x4 v0 = acc[ai][bj][m][0], v1 = acc[ai][bj][m][1];
                    u32x4 w; w.x = cvt_pk_bf16(v0[0] * g[0], v0[1] * g[1]); w.y = cvt_pk_bf16(v0[2] * g[2], v0[3] * g[3]); w.z = cvt_pk_bf16(v1[0] * g[4], v1[1] * g[5]); w.w = cvt_pk_bf16(v1[2] * g[6], v1[3] * g[7]);
                    *(u32x4*)(rowp + bj * 128) = w; } }
    }
};
struct EpiX1 {
    static constexpr bool PERM = true, MID = false;
    const float* x; bf16_t* x1;
    __device__ __forceinline__ void operator()(const f32x4 (&acc)[2][2][4][2], const Unit& u, int wr, int wc, int fr, int fq) const {
        const int row0 = u.pm * 256 + wr * 64 + fr, col0 = u.pn * 256 + wc * 32 + 8 * fq;
#pragma unroll
        for (int ai = 0; ai < 2; ++ai)
#pragma unroll
            for (int m = 0; m < 4; ++m) { const size_t off = (size_t)(row0 + ai * 128 + m * 16) * 1024 + col0;
#pragma unroll
                for (int bj = 0; bj < 2; ++bj) { const f32x4 a = __builtin_nontemporal_load((const f32x4*)(x + off + bj * 128)) + acc[ai][bj][m][0], b = __builtin_nontemporal_load((const f32x4*)(x + off + bj * 128 + 4)) + acc[ai][bj][m][1];
                    u32x4 w; w.x = cvt_pk_bf16(a[0], a[1]); w.y = cvt_pk_bf16(a[2], a[3]); w.z = cvt_pk_bf16(b[0], b[1]); w.w = cvt_pk_bf16(b[2], b[3]);
                    *(u32x4*)(x1 + off + bj * 128) = w; }
                if (m & 1) asm volatile("" ::: "memory"); }
    }
};
struct EpiSwiglu {
    static constexpr bool PERM = true, MID = false;
    unsigned char* act; const float* b1;
    __device__ __forceinline__ void operator()(const f32x4 (&acc)[2][2][4][2], const Unit& u, int wr, int wc, int fr, int fq) const {
        const int row0 = u.pm * 256 + wr * 64 + fr; const float* be = b1 + (size_t)u.tag * 2048; const int j = 128 * u.pn + 32 * wc + 8 * fq;
        constexpr float CS = -1.702f * 1.44269504f, ICS = 1.0f / CS;
        float bg[8], bl[8];
#pragma unroll
        for (int q = 0; q < 4; ++q) { const f32x4 t = *(const f32x4*)(be + 2 * j + 4 * q); bg[2 * q] = t[0] * CS; bl[2 * q] = (4.0f * t[1] + 4.0f) * ICS; bg[2 * q + 1] = t[2] * CS; bl[2 * q + 1] = (4.0f * t[3] + 4.0f) * ICS; }
#pragma unroll
        for (int ai = 0; ai < 2; ++ai)
#pragma unroll
            for (int m = 0; m < 4; ++m) { float o[8];
#pragma unroll
                for (int n = 0; n < 2; ++n)
#pragma unroll
                    for (int i = 0; i < 4; ++i) { const float sg = fmaxf(fmaf(acc[ai][0][m][n][i], CS / 256.0f, bg[4 * n + i]), 7.0f * CS);
                        const float ql = __builtin_amdgcn_fmed3f(fmaf(acc[ai][1][m][n][i], 4.0f * ICS / 256.0f, bl[4 * n + i]), -24.0f * ICS, 32.0f * ICS);
                        o[4 * n + i] = sg * __builtin_amdgcn_rcpf(1.0f + __builtin_amdgcn_exp2f(sg)) * ql; }
                u32x2 w; w.x = pack4_fp8(o[0], o[1], o[2], o[3]); w.y = pack4_fp8(o[4], o[5], o[6], o[7]);
                *(u32x2*)(act + (size_t)(row0 + ai * 128 + m * 16) * 1024 + j) = w; }
    }
};
struct EpiYs {
    static constexpr bool PERM = true, MID = false;
    bf16_t* ys; const float* b2;
    __device__ __forceinline__ void operator()(const f32x4 (&acc)[2][2][4][2], const Unit& u, int wr, int wc, int fr, int fq) const {
        const int row0 = u.pm * 256 + wr * 64 + fr, col0 = u.pn * 256 + wc * 32 + 8 * fq; const float* be = b2 + (size_t)u.tag * 1024;
#pragma unroll
        for (int bj = 0; bj < 2; ++bj) { const f32x4 c0 = *(const f32x4*)(be + col0 + bj * 128), c1 = *(const f32x4*)(be + col0 + bj * 128 + 4);
#pragma unroll
            for (int ai = 0; ai < 2; ++ai)
#pragma unroll
                for (int m = 0; m < 4; ++m) { const f32x4 v0 = acc[ai][bj][m][0] * (1.0f / 128.0f) + c0, v1 = acc[ai][bj][m][1] * (1.0f / 128.0f) + c1;
                    u32x4 w; w.x = cvt_pk_bf16(v0[0], v0[1]); w.y = cvt_pk_bf16(v0[2], v0[3]); w.z = cvt_pk_bf16(v1[0], v1[1]); w.w = cvt_pk_bf16(v1[2], v1[3]);
                    *(u32x4*)(ys + (size_t)(row0 + ai * 128 + m * 16) * 1024 + col0 + bj * 128) = w; } }
    }
};
template <bool GATHER_> struct SchedMoe {
    static constexpr bool GATHER = GATHER_;
    const char* A; const char* Bt; const LAS int* tstart; const int* stok; int lgN, total; size_t estride, tbytes;
    __device__ __forceinline__ bool next(int i, Unit& u) const {
        const int c = blockIdx.x; const int un = i * 256 + (c & 7) * 32 + (c >> 3); if (un >= total) return false;
        const int mt = un >> lgN, pn = un & ((1 << lgN) - 1); const int e = ((const LAS unsigned char*)tstart)[(LX_TEXP - LX_TSTART) + mt];
        u.pm = mt; u.pn = pn; u.tag = e; u.pa = GATHER ? A : A + (size_t)mt * tbytes; u.pb = Bt + (size_t)e * estride + (size_t)pn * tbytes; return true;
    }
    __device__ __forceinline__ unsigned a_off(const Unit& u, int h, int R, int C, int rowbytes) const { const int e = u.tag, ps = u.pm * 256 + h * 128 + R - tstart[(LX_SBASE - LX_TSTART) / 4 + e];
        const int tok = ps < tstart[(LX_CNT - LX_TSTART) / 4 + e] ? stok[(size_t)e * NTOK + ps] : 0; return (unsigned)(tok * rowbytes + C * 2); }
};

__device__ __forceinline__ int w1perm(int c) { const int j = c >> 1, s = c & 1; return ((j >> 7) << 8) | (s << 7) | (j & 127); }
__device__ __forceinline__ void phase_prep(const int wv, LAS unsigned char* lds) {
    KParams& p = *kparams();
    const int tid = opaque_tid(wv); unsigned char* ws = p.ws;
    LAS float* tile = (LAS float*)lds;
    struct TileJob { const float* src; bf16_t* dst; unsigned char* dst8; int K, N, perm, f8, ldd, k0, n0; };
    auto decode = [&](int t) -> TileJob { TileJob j; j.dst = nullptr; j.dst8 = nullptr; j.f8 = 0; j.perm = 0; j.ldd = 0; int lt;
        if (t < 960) { j.src = p.in[3]; j.dst = (bf16_t*)(ws + OFF_WINT); j.K = 1024; j.N = 7680; lt = t; if ((lt % 120) >= 28) { j.f8 = 1; j.dst8 = ws + OFF_WIN8 - (size_t)1792 * 1024; } }
        else if (t < 1088) { j.src = p.in[18]; j.dst = (bf16_t*)(ws + OFF_WMKVT); j.K = 1024; j.N = 1024; lt = t - 960; }
        else if (t < 1152) { j.src = p.in[21]; j.dst = (bf16_t*)(ws + OFF_PCAT); j.K = 512; j.N = 1024; lt = t - 1088; j.ldd = 1280; }
        else if (t < 1184) { j.src = p.in[22]; j.dst = (bf16_t*)(ws + OFF_PCAT) + 512; j.K = 256; j.N = 1024; lt = t - 1152; j.ldd = 1280; }
        else if (t < 1248) { j.src = p.in[23]; j.dst = (bf16_t*)(ws + OFF_PCAT) + 768; j.K = 512; j.N = 1024; lt = t - 1184; j.ldd = 1280; }
        else if (t < 1376) { j.src = p.in[24]; j.dst = (bf16_t*)(ws + OFF_WOT); j.K = 1024; j.N = 1024; lt = t - 1248; }
        else if (t < 9568) { const int q = t - 1376, e = q >> 8; j.src = p.in[28] + (size_t)e * 1024 * 2048; j.dst8 = ws + OFF_W1T + (size_t)e * 2048 * 1024; j.K = 1024; j.N = 2048; j.perm = 1; lt = q & 255; j.f8 = 1; }
        else { const int q = t - 9568, e = q >> 7; j.src = p.in[30] + (size_t)e * 1024 * 1024; j.dst8 = ws + OFF_W2T + (size_t)e * 1024 * 1024; j.K = 1024; j.N = 1024; lt = q & 127; j.f8 = 1; }
        const int tn = j.N >> 6; j.k0 = (lt / tn) * 128; j.n0 = (lt % tn) * 64; return j; };
    { const int G = (int)gridDim.x; int t = 13663 - (int)blockIdx.x;
      auto ldtile = [&](const TileJob& j, f32x4 (&v)[4]) {
#pragma unroll
          for (int i = 0; i < 4; ++i) { const int idx = tid + 512 * i, row = idx >> 4, c4 = idx & 15; v[i] = __builtin_nontemporal_load((const f32x4*)(j.src + (size_t)(j.k0 + row) * j.N + j.n0 + 4 * c4)); } };
      TileJob j0 = decode(t < 0 ? 0 : t), j1 = decode(t - G < 0 ? 0 : t - G); f32x4 v0[4], v1[4];
      if (t >= 0) ldtile(j0, v0);
      if (t - G >= 0) ldtile(j1, v1);
      for (; t >= 0; t -= G) {
#pragma unroll
          for (int i = 0; i < 4; ++i) { const int idx = tid + 512 * i, row = idx >> 4, c4 = idx & 15; LAS float* tp = tile + row * 65 + 4 * c4; tp[0] = v0[i][0]; tp[1] = v0[i][1]; tp[2] = v0[i][2]; tp[3] = v0[i][3]; }
          __syncthreads();
          const TileJob cur = j0; j0 = j1;
#pragma unroll
          for (int i = 0; i < 4; ++i) v0[i] = v1[i];
          if (t - 2 * G >= 0) { j1 = decode(t - 2 * G); ldtile(j1, v1); }
          if (!cur.f8) {
#pragma unroll
              for (int i = 0; i < 2; ++i) { const int kc = (tid & 3) | (((tid >> 8) & 1) << 2) | (i << 3), n = (tid >> 2) & 63; float f[8];
#pragma unroll
                  for (int j = 0; j < 8; ++j) f[j] = tile[(kc * 8 + j) * 65 + n];
                  const int drow = cur.n0 + n;
                  *(u32x4*)(cur.dst + (size_t)drow * (cur.ldd ? cur.ldd : cur.K) + cur.k0 + kc * 8) = pack8(f); }
          } else {
              const int kc = (tid & 3) | (((tid >> 8) & 1) << 2), n = (tid >> 2) & 63; float f[16];
#pragma unroll
              for (int j = 0; j < 16; ++j) f[j] = tile[(kc * 16 + j) * 65 + n] * 32.0f;
              const int drow = cur.perm ? w1perm(cur.n0 + n) : (cur.n0 + n);
              u32x4 w; w.x = pack4_fp8(f[0], f[1], f[2], f[3]); w.y = pack4_fp8(f[4], f[5], f[6], f[7]); w.z = pack4_fp8(f[8], f[9], f[10], f[11]); w.w = pack4_fp8(f[12], f[13], f[14], f[15]);
              *(u32x4*)(cur.dst8 + (size_t)drow * cur.K + cur.k0 + kc * 16) = w; }
          __syncthreads(); } }
    { const float* w2 = p.in[6]; const float* a2 = p.in[8]; const float* g2 = p.in[9]; bf16_t* lt = (bf16_t*)(ws + OFF_LORAT);
      for (int idx = blockIdx.x * 512 + tid; idx < 1536 * 32; idx += gridDim.x * 512) { const int n = idx >> 5, kc = idx & 31; float f[8];
#pragma unroll
          for (int j = 0; j < 8; ++j) { const int k = kc * 8 + j; float val = 0.f;
              if (n < 512) { if (k < 64) val = w2[k * 512 + n]; }
              else if (n < 1024) { if (k >= 64 && k < 128) val = a2[(k - 64) * 512 + (n - 512)]; }
              else { if (k >= 128) val = g2[(k - 128) * 512 + (n - 1024)]; }
              f[j] = val; }
          *(u32x4*)(lt + (size_t)n * 256 + kc * 8) = pack8(f); } }
    { const float* wr = p.in[26]; bf16_t* wt = (bf16_t*)(ws + OFF_WRT);
      for (int idx = blockIdx.x * 512 + tid; idx < 32 * 1024; idx += gridDim.x * 512) { const int e = idx >> 10, k = idx & 1023; const float v = wr[k * 32 + e];
          const unsigned hi = cvt_pk_bf16(v, 0.f) & 0xffffu; const float vh = __uint_as_float(hi << 16); const unsigned lo = cvt_pk_bf16(v - vh, 0.f) & 0xffffu;
          wt[idx] = (bf16_t)hi; wt[32768 + idx] = (bf16_t)lo; } }
    { const int wid = tid >> 6, lane = tid & 63; const int gw = blockIdx.x * 8 + wid, nw = gridDim.x * 8;
      for (int row0 = gw; row0 < NTOK + 2048; row0 += 3 * nw) {
          f32x4 v[3][4];
#pragma unroll
          for (int r3 = 0; r3 < 3; ++r3) { const int row = row0 + r3 * nw; if (row < NTOK + 2048) { const float* src = row >= NTOK ? p.in[1] + (size_t)(row - NTOK) * 1024 : p.in[0] + (size_t)row * 1024;
#pragma unroll
              for (int i = 0; i < 4; ++i) v[r3][i] = __builtin_nontemporal_load((const f32x4*)(src + 4 * lane + 256 * i)); } }
#pragma unroll
          for (int r3 = 0; r3 < 3; ++r3) { const int row = row0 + r3 * nw; if (row >= NTOK + 2048) break;
              const bool ism = row >= NTOK; const float* gain = ism ? p.in[17] : p.in[2]; bf16_t* dst = ism ? (bf16_t*)(ws + OFF_HM) + (size_t)(row - NTOK) * 1024 : (bf16_t*)(ws + OFF_H) + (size_t)row * 1024;
              float ss = 0.f;
#pragma unroll
              for (int i = 0; i < 4; ++i) ss += v[r3][i][0] * v[r3][i][0] + v[r3][i][1] * v[r3][i][1] + v[r3][i][2] * v[r3][i][2] + v[r3][i][3] * v[r3][i][3];
              ss = red64(ss); const float rs = rsqrtf(ss * (1.0f / 1024.0f) + 1e-5f);
#pragma unroll
              for (int i = 0; i < 4; ++i) { const f32x4 g = *(const f32x4*)(gain + 4 * lane + 256 * i); const f32x4 y = v[r3][i] * rs * g;
                  u32x2 w; w.x = cvt_pk_bf16(y[0], y[1]); w.y = cvt_pk_bf16(y[2], y[3]);
                  *(u32x2*)(dst + 4 * lane + 256 * i) = w;
                  if (!ism) *(unsigned*)(ws + OFF_H8 + (size_t)row * 1024 + 4 * lane + 256 * i) = pack4_fp8(y[0] * 8.0f, y[1] * 8.0f, y[2] * 8.0f, y[3] * 8.0f); } } }
    }
}

__device__ __forceinline__ void phase_elem_c(const int wv) {
    KParams& p = *kparams();
    const int gt = blockIdx.x * 512 + opaque_tid(wv), nthr = gridDim.x * 512; unsigned char* ws = p.ws;
    bf16_t* Z = (bf16_t*)(ws + OFF_Z); bf16_t* AL = (bf16_t*)(ws + OFF_ALORA); bf16_t* KV = (bf16_t*)(ws + OFF_KV);
    const float* mu = p.in[4];
    u32x4 za[4], zb[4]; const u32x4 zq0 = zero4u();
#pragma unroll
    for (int k = 0; k < 4; ++k) { const int idx = gt + k * nthr, t = idx >> 5, ch = idx & 31, col = C_ZW + 8 * ch;
        za[k] = *(const u32x4*)(Z + (size_t)t * INC + col);
        zb[k] = zq0; if ((t & (SEQ - 1)) != 0) zb[k] = *(const u32x4*)(Z + (size_t)(t - 1) * INC + col); }
#pragma unroll
    for (int k = 0; k < 4; ++k) { const int idx = gt + k * nthr, t = idx >> 5, ch = idx & 31, col = C_ZW + 8 * ch;
        float a[8], b[8]; unpack8(za[k], a); unpack8(zb[k], b);
        const f32x4 m0 = *(const f32x4*)(mu + col), m1 = *(const f32x4*)(mu + col + 4); const float mm[8] = {m0[0], m0[1], m0[2], m0[3], m1[0], m1[1], m1[2], m1[3]};
#pragma unroll
        for (int j = 0; j < 8; ++j) { float v = a[j] + (b[j] - a[j]) * mm[j]; if (ch < 8) v = tanhf(v); else if (ch >= 16) v = sigmoidf_(v); a[j] = v; }
        *(u32x4*)(AL + (size_t)t * 256 + 8 * ch) = pack8(a); }
}

__device__ __forceinline__ bf16x8 pack_frag(const f32x4 lo, const f32x4 hi) { u32x4 w; w.x = cvt_pk_bf16(lo[0], lo[1]); w.y = cvt_pk_bf16(lo[2], lo[3]); w.z = cvt_pk_bf16(hi[0], hi[1]); w.w = cvt_pk_bf16(hi[2], hi[3]); bf16x8 r; __builtin_memcpy(&r, &w, 16); return r; }
__device__ __forceinline__ bf16x8 tr2(LAS unsigned char* pa, LAS unsigned char* pb) { const s16x4 a = __builtin_amdgcn_ds_read_tr16_b64_v4i16((LAS s16x4*)pa), b = __builtin_amdgcn_ds_read_tr16_b64_v4i16((LAS s16x4*)pb); return __builtin_shufflevector(a, b, 0, 1, 2, 3, 4, 5, 6, 7); }
__device__ __forceinline__ bf16x8 rd2(LAS unsigned char* pa, LAS unsigned char* pb) { const s16x4 a = *(const LAS s16x4*)pa, b = *(const LAS s16x4*)pb; return __builtin_shufflevector(a, b, 0, 1, 2, 3, 4, 5, 6, 7); }
#define MFMA16(a, b, c) __builtin_amdgcn_mfma_f32_16x16x32_bf16((a), (b), (c), 0, 0, 0)
constexpr int CP_XA = 0, CP_XR = 4096, CP_XB = 8192, CP_XK = 12288, CP_VL = 16384, CP_NL = 16384, CP_WAVE = 20480;
__device__ __forceinline__ void phase_chunk_pre(const int wv, LAS unsigned char* lds) {
    KParams& p = *kparams();
    const int tid = opaque_tid(wv), wid = tid >> 6, lane = tid & 63, fr = lane & 15, fq = lane >> 4; unsigned char* ws = p.ws;
    if (tid == 0) { *(u32x4*)(ws + OFF_CTL + CTL_KEEP + blockIdx.x * 16) = *(const LAS u32x4*)(lds + LDS_X); asm volatile("s_waitcnt vmcnt(0)" ::: "memory"); }
    __syncthreads();
    LAS unsigned char* wl = lds + wid * CP_WAVE;
    const bf16_t* Z = (const bf16_t*)(ws + OFF_Z); bf16_t* C1 = (bf16_t*)(ws + OFF_C1); bf16_t* C2 = (bf16_t*)(ws + OFF_C2);
    const float* mu = p.in[4]; const float* k_k = p.in[10]; const float* k_a = p.in[11]; const float* r_k = p.in[12]; const float* ln_w = p.in[13]; const float* ln_b = p.in[14];
    const f32x4 z4 = zero4f();
    const bf16_t* LT = (const bf16_t*)(ws + OFF_LORAT); const float* w0v = p.in[5]; const float* a0v = p.in[7];
    for (int un = blockIdx.x; un < 512; un += gridDim.x) {
        const int b_ = un >> 6, cc = un & 63, h_ = wid; const int pr = ((b_ * 8 + h_) << 6) | cc; const int tok0 = b_ * SEQ + cc * 32;
        float gamC;
        int tidl = tid; asm volatile("" : "+v"(tidl));
        __syncthreads();
        { const int tl = tidl >> 4; const int t = tok0 + tl; u32x4 za[2], zb[2]; const u32x4 zq0 = zero4u();
#pragma unroll
          for (int g2 = 0; g2 < 2; ++g2) { const int col = C_ZW + 8 * ((tidl & 15) * 2 + g2); za[g2] = *(const u32x4*)(Z + (size_t)t * INC + col);
              zb[g2] = zq0; if ((t & (SEQ - 1)) != 0) zb[g2] = *(const u32x4*)(Z + (size_t)(t - 1) * INC + col); }
#pragma unroll
          for (int g2 = 0; g2 < 2; ++g2) { const int ch = (tidl & 15) * 2 + g2, col = C_ZW + 8 * ch; float a[8], b[8]; unpack8(za[g2], a); unpack8(zb[g2], b);
              const f32x4 m0 = *(const f32x4*)(mu + col), m1 = *(const f32x4*)(mu + col + 4); const float mm[8] = {m0[0], m0[1], m0[2], m0[3], m1[0], m1[1], m1[2], m1[3]};
#pragma unroll
              for (int j = 0; j < 8; ++j) { float v = a[j] + (b[j] - a[j]) * mm[j]; if (ch < 8) v = tanhf(v); else if (ch >= 16) v = sigmoidf_(v); a[j] = v; }
              *(LAS u32x4*)(lds + (tl >> 2) * CP_WAVE + CP_VL + (tl & 3) * 528 + ch * 16) = pack8(a); }
          __syncthreads(); }
        { const int fr = tidl & 15, fq = (tidl >> 4) & 3;
#pragma unroll
          for (int kind = 0; kind < 3; ++kind) { const int koff = kind == 0 ? 0 : (kind == 1 ? 64 : 128), nks = kind == 2 ? 4 : 2;
              f32x4 acc[4][2];
#pragma unroll
              for (int mt = 0; mt < 4; ++mt) { acc[mt][0] = z4; acc[mt][1] = z4; }
#pragma unroll
              for (int ks = 0; ks < nks; ++ks) { bf16x8 tf[2];
#pragma unroll
                  for (int nt = 0; nt < 2; ++nt) { const int tt = 16 * nt + fr; tf[nt] = *(const LAS bf16x8*)(lds + (tt >> 2) * CP_WAVE + CP_VL + (tt & 3) * 528 + (koff + 32 * ks + 8 * fq) * 2); }
#pragma unroll
                  for (int mt = 0; mt < 4; ++mt) { const bf16x8 wf = *(const bf16x8*)(LT + (size_t)(kind * 512 + h_ * 64 + 16 * mt + fr) * 256 + koff + 32 * ks + 8 * fq);
                      acc[mt][0] = MFMA16(tf[0], wf, acc[mt][0]); acc[mt][1] = MFMA16(tf[1], wf, acc[mt][1]); } }
#pragma unroll
              for (int mt = 0; mt < 4; ++mt) { const int ch = 16 * mt + fr; float bv = 0.f; if (kind == 0) bv = w0v[h_ * 64 + ch]; else if (kind == 1) bv = a0v[h_ * 64 + ch];
#pragma unroll
                  for (int nt = 0; nt < 2; ++nt) { f32x4 v = acc[mt][nt] + bv; LAS unsigned char* dst = wl + ch * 64 + (16 * nt + 4 * fq) * 2;
                      if (kind == 0) { float hf[4];
#pragma unroll
                          for (int j = 0; j < 4; ++j) v[j] = -0.60653066f * sigmoidf_(v[j]);
                          u32x2 hi; hi.x = cvt_pk_bf16(v[0], v[1]); hi.y = cvt_pk_bf16(v[2], v[3]);
                          hf[0] = v[0] - __uint_as_float(hi.x << 16); hf[1] = v[1] - __uint_as_float(hi.x & 0xffff0000u); hf[2] = v[2] - __uint_as_float(hi.y << 16); hf[3] = v[3] - __uint_as_float(hi.y & 0xffff0000u);
                          u32x2 lo; lo.x = cvt_pk_bf16(hf[0], hf[1]); lo.y = cvt_pk_bf16(hf[2], hf[3]);
                          *(LAS u32x2*)(dst + CP_XR) = hi; *(LAS u32x2*)(dst + CP_XB) = lo; }
                      else { if (kind == 1) {
#pragma unroll
                              for (int j = 0; j < 4; ++j) v[j] = sigmoidf_(v[j]); }
                          u32x2 w; w.x = cvt_pk_bf16(v[0], v[1]); w.y = cvt_pk_bf16(v[2], v[3]); *(LAS u32x2*)(dst + (kind == 1 ? CP_XK : CP_XA)) = w; } } } }
          asm volatile("s_waitcnt lgkmcnt(0)" ::: "memory");
          __syncthreads(); }
        { const int c = h_ * 64 + lane;
          const bf16_t* zp = Z + (size_t)tok0 * INC + c;
          const float mur = mu[c], muk = mu[C_K + c], muv = mu[C_V + c], kk_ = k_k[c], ka_ = k_a[c], rk_ = r_k[c], lnw = ln_w[c], lnb = ln_b[c];
          float pzr = 0.f, pzk = 0.f, pzv = 0.f;
          if (cc != 0) { pzr = __uint_as_float((unsigned)zp[-INC] << 16); pzk = __uint_as_float((unsigned)zp[-INC + C_K] << 16); pzv = __uint_as_float((unsigned)zp[-INC + C_V] << 16); }
          unsigned short zq[2][4][3]; u32x2 sq[2][4];
#pragma unroll
          for (int e = 0; e < 4; ++e) {
#pragma unroll
              for (int q = 0; q < 3; ++q) zq[0][e][q] = zp[(size_t)e * INC + q * 512]; }
#pragma unroll
          for (int r = 0; r < 4; ++r) sq[0][r] = *(const LAS u32x2*)(wl + r * 4096 + lane * 64);
          __builtin_amdgcn_sched_barrier(0);
          float cs = 0.f, g = 1.0f;
#pragma unroll
          for (int t4 = 0; t4 < 8; ++t4) { unsigned pa[2], pr_[2], pb[2], pk[2];
              if (t4 < 7) {
#pragma unroll
                  for (int e = 0; e < 4; ++e) {
#pragma unroll
                      for (int q = 0; q < 3; ++q) zq[(t4 + 1) & 1][e][q] = zp[(size_t)((t4 + 1) * 4 + e) * INC + q * 512]; }
#pragma unroll
                  for (int r = 0; r < 4; ++r) sq[(t4 + 1) & 1][r] = *(const LAS u32x2*)(wl + r * 4096 + lane * 64 + (t4 + 1) * 8); }
              __builtin_amdgcn_sched_barrier(0);
#pragma unroll
              for (int tp = 0; tp < 2; ++tp) { float va[2], vr[2], vb[2], vk[2];
#pragma unroll
                  for (int e = 0; e < 2; ++e) { const int te = tp * 2 + e, t = t4 * 4 + te;
                      const float zr = __uint_as_float((unsigned)zq[t4 & 1][te][0] << 16), zk = __uint_as_float((unsigned)zq[t4 & 1][te][1] << 16), zv = __uint_as_float((unsigned)zq[t4 & 1][te][2] << 16);
                      const float r = zr + (pzr - zr) * mur, k = zk + (pzk - zk) * muk, v = zv + (pzv - zv) * muv; pzr = zr; pzk = zk; pzv = zv;
                      const unsigned wg = sq[t4 & 1][0][te >> 1], wh = sq[t4 & 1][1][te >> 1], wlo = sq[t4 & 1][2][te >> 1], wa = sq[t4 & 1][3][te >> 1];
                      const float lw = __uint_as_float((te & 1) ? (wh & 0xffff0000u) : (wh << 16)) + __uint_as_float((te & 1) ? (wlo & 0xffff0000u) : (wlo << 16));
                      const float al = __uint_as_float((te & 1) ? (wa & 0xffff0000u) : (wa << 16)), gg = __uint_as_float((te & 1) ? (wg & 0xffff0000u) : (wg << 16));
                      const float kk = k * kk_, kp = k * (1.0f + (al - 1.0f) * ka_);
                      const float n2 = red64(kk * kk), bon = red64(r * kp * rk_);
                      const float kn = kk * __builtin_amdgcn_rsqf(fmaxf(n2, 1e-24f));
                      const float gm1 = g; cs += lw; g = __builtin_amdgcn_exp2f(cs * 1.44269504f); const float gi = __builtin_amdgcn_rcpf(g);
                      va[e] = -kn * gm1; vb[e] = kn * al * gi; vk[e] = kp * gi; vr[e] = r * g;
                      *(LAS bf16_t*)(wl + CP_VL + t * 128 + lane * 2) = (bf16_t)(cvt_pk_bf16(v, 0.f) & 0xffffu);
                      const size_t to = (size_t)(tok0 + t) * 512 + c;
                      C1[to] = (bf16_t)(cvt_pk_bf16(lnw * gg, 0.f) & 0xffffu); C2[to] = (bf16_t)(cvt_pk_bf16((lnb + bon * v) * gg, 0.f) & 0xffffu); }
                  pa[tp] = cvt_pk_bf16(va[0], va[1]); pr_[tp] = cvt_pk_bf16(vr[0], vr[1]); pb[tp] = cvt_pk_bf16(vb[0], vb[1]); pk[tp] = cvt_pk_bf16(vk[0], vk[1]); }
              *(LAS u32x2*)(wl + CP_XA + lane * 64 + t4 * 8) = (u32x2){pa[0], pa[1]}; *(LAS u32x2*)(wl + CP_XR + lane * 64 + t4 * 8) = (u32x2){pr_[0], pr_[1]};
              *(LAS u32x2*)(wl + CP_XB + lane * 64 + t4 * 8) = (u32x2){pb[0], pb[1]}; *(LAS u32x2*)(wl + CP_XK + lane * 64 + t4 * 8) = (u32x2){pk[0], pk[1]};
              __builtin_amdgcn_sched_barrier(0); }
          gamC = g; }
        asm volatile("s_waitcnt lgkmcnt(0)" ::: "memory");
        bf16x8 Vf[4];
        { const int vtb = (4 * fq + (fr >> 2)) * 128 + (fr & 3) * 8;
#pragma unroll
          for (int nv = 0; nv < 4; ++nv) { LAS unsigned char* pp = wl + CP_VL + vtb + nv * 32; Vf[nv] = tr2(pp, pp + 2048); } }
        asm volatile("s_waitcnt lgkmcnt(0)" ::: "memory");
        const int trb = (8 * fq + (fr >> 2)) * 64 + (fr & 3) * 8;
        bf16x8 LakF[2], QrbF[2], QrkF[2];
#pragma unroll
        for (int yi = 0; yi < 2; ++yi) {
            bf16x8 fy[2][2];
#pragma unroll
            for (int nt = 0; nt < 2; ++nt)
#pragma unroll
                for (int s2 = 0; s2 < 2; ++s2) { LAS unsigned char* pp = wl + (yi ? CP_XR : CP_XA) + trb + s2 * 2048 + nt * 32; fy[nt][s2] = tr2(pp, pp + 256); }
#pragma unroll
            for (int xi = 0; xi < 2; ++xi) {
                f32x4 d[2][2];
#pragma unroll
                for (int mi = 0; mi < 2; ++mi) { bf16x8 fx[2];
#pragma unroll
                    for (int s2 = 0; s2 < 2; ++s2) { LAS unsigned char* pp = wl + (xi ? CP_XK : CP_XB) + trb + s2 * 2048 + mi * 32; fx[s2] = tr2(pp, pp + 256); }
#pragma unroll
                    for (int nt = 0; nt < 2; ++nt) {
                        if (mi == 1 && nt == 0) { d[mi][nt] = z4; continue; }
                        f32x4 acc = MFMA16(fx[0], fy[nt][0], z4); acc = MFMA16(fx[1], fy[nt][1], acc);
#pragma unroll
                        for (int j = 0; j < 4; ++j) { const int i = 16 * mi + 4 * fq + j, t = 16 * nt + fr; const bool ok = yi ? (i <= t) : (i < t); acc[j] = ok ? acc[j] : 0.f; }
                        d[mi][nt] = acc; } }
                if (yi == 0 && xi == 0) {
#pragma unroll
                    for (int mi = 0; mi < 2; ++mi)
#pragma unroll
                        for (int nt = 0; nt < 2; ++nt)
#pragma unroll
                            for (int j = 0; j < 4; ++j) *(LAS float*)(wl + CP_NL + ((16 * nt + fr) * 32 + 16 * mi + 4 * fq + j) * 4) = d[mi][nt][j];
                } else {
#pragma unroll
                    for (int nt = 0; nt < 2; ++nt) { const bf16x8 f = pack_frag(d[0][nt], d[1][nt]); if (yi == 0) LakF[nt] = f; else if (xi == 0) QrbF[nt] = f; else QrkF[nt] = f; } } } }
        asm volatile("s_waitcnt lgkmcnt(0)" ::: "memory");
        bf16x8 InvF[2];
        { const int c = lane & 31; float X[32];
#pragma unroll
          for (int t = 0; t < 32; ++t) { float a0 = (t == c) ? 1.0f : 0.f, a1 = 0.f;
#pragma unroll
              for (int i4 = 0; i4 < (t + 3) / 4; ++i4) { const f32x4 nv = *(const LAS f32x4*)(wl + CP_NL + (t * 32 + 4 * i4) * 4);
#pragma unroll
                  for (int e = 0; e < 4; ++e) if (4 * i4 + e < t) { if (e & 1) a1 = fmaf(nv[e], X[4 * i4 + e], a1); else a0 = fmaf(nv[e], X[4 * i4 + e], a0); } }
              X[t] = a0 + a1; }
          asm volatile("s_waitcnt lgkmcnt(0)" ::: "memory");
#pragma unroll
          for (int t = 0; t < 32; ++t) *(LAS float*)(wl + CP_NL + (t * 32 + c) * 4) = X[t];
          asm volatile("s_waitcnt lgkmcnt(0)" ::: "memory");
#pragma unroll
          for (int n = 0; n < 2; ++n) { const f32x4 lo = *(const LAS f32x4*)(wl + CP_NL + ((16 * n + fr) * 32 + 4 * fq) * 4), hi = *(const LAS f32x4*)(wl + CP_NL + ((16 * n + fr) * 32 + 16 + 4 * fq) * 4); InvF[n] = pack_frag(lo, hi); } }
        bf16x8 UF[4], AhF[4];
#pragma unroll
        for (int nv = 0; nv < 4; ++nv) { const f32x4 w0 = MFMA16(LakF[0], Vf[nv], z4), w1 = MFMA16(LakF[1], Vf[nv], z4); const bf16x8 wf = pack_frag(w0, w1);
            const f32x4 u0 = MFMA16(InvF[0], wf, z4), u1 = MFMA16(InvF[1], wf, z4); UF[nv] = pack_frag(u0, u1); }
#pragma unroll
        for (int nc = 0; nc < 4; ++nc) { LAS unsigned char* pp = wl + CP_XA + (16 * nc + fr) * 64 + 8 * fq; const bf16x8 af = rd2(pp, pp + 32);
            const f32x4 h0 = MFMA16(InvF[0], af, z4), h1 = MFMA16(InvF[1], af, z4); AhF[nc] = pack_frag(h0, h1); }
        { f32x4 rt[4][2];
#pragma unroll
          for (int mc = 0; mc < 4; ++mc)
#pragma unroll
              for (int nt = 0; nt < 2; ++nt) { const s16x4 rr = __builtin_amdgcn_ds_read_tr16_b64_v4i16((LAS s16x4*)(wl + CP_XR + (16 * mc + 4 * fq + (fr >> 2)) * 64 + (fr & 3) * 8 + nt * 32));
                  f32x4 cin; cin[0] = __uint_as_float((unsigned)(unsigned short)rr[0] << 16); cin[1] = __uint_as_float((unsigned)(unsigned short)rr[1] << 16); cin[2] = __uint_as_float((unsigned)(unsigned short)rr[2] << 16); cin[3] = __uint_as_float((unsigned)(unsigned short)rr[3] << 16);
                  rt[mc][nt] = MFMA16(AhF[mc], QrbF[nt], cin); }
          bf16x8* RTF = (bf16x8*)(ws + OFF_RTF) + (size_t)pr * 256;
#pragma unroll
          for (int nt = 0; nt < 2; ++nt)
#pragma unroll
              for (int s2 = 0; s2 < 2; ++s2) RTF[(nt * 2 + s2) * 64 + lane] = pack_frag(rt[2 * s2][nt], rt[2 * s2 + 1][nt]); }
        { u32x2* YLF = (u32x2*)(ws + OFF_YLF) + (size_t)pr * 512;
#pragma unroll
          for (int nv = 0; nv < 4; ++nv)
#pragma unroll
              for (int mt = 0; mt < 2; ++mt) { f32x4 y = MFMA16(QrbF[mt], UF[nv], z4); y = MFMA16(QrkF[mt], Vf[nv], y);
                  u32x2 w; w.x = cvt_pk_bf16(y[0], y[1]); w.y = cvt_pk_bf16(y[2], y[3]); YLF[(nv * 2 + mt) * 64 + lane] = w; } }
        { bf16x8* GTF = (bf16x8*)(ws + OFF_GTF) + (size_t)pr * 512; u32x2* HHF = (u32x2*)(ws + OFF_HHF) + (size_t)pr * 1024;
#pragma unroll
          for (int nc = 0; nc < 4; ++nc) { LAS unsigned char* pp = wl + CP_XB + (16 * nc + fr) * 64 + 8 * fq; const bf16x8 bf_ = rd2(pp, pp + 32);
              LAS unsigned char* pk = wl + CP_XK + (16 * nc + fr) * 64 + 8 * fq; const bf16x8 kf_ = rd2(pk, pk + 32);
              const float gcol = __int_as_float(__builtin_amdgcn_ds_bpermute((16 * nc + fr) << 2, __float_as_int(gamC)));
              f32x4 gt[4];
#pragma unroll
              for (int mc = 0; mc < 4; ++mc) { f32x4 a = MFMA16(AhF[mc], bf_, z4);
#pragma unroll
                  for (int j = 0; j < 4; ++j) { if (mc == nc && 4 * fq + j == fr) a[j] += 1.0f; a[j] *= gcol; }
                  gt[mc] = a; }
              GTF[(nc * 2 + 0) * 64 + lane] = pack_frag(gt[0], gt[1]); GTF[(nc * 2 + 1) * 64 + lane] = pack_frag(gt[2], gt[3]);
              f32x4 grow;
#pragma unroll
              for (int j = 0; j < 4; ++j) grow[j] = __int_as_float(__builtin_amdgcn_ds_bpermute((16 * nc + 4 * fq + j) << 2, __float_as_int(gamC)));
#pragma unroll
              for (int nv = 0; nv < 4; ++nv) { f32x4 hh = MFMA16(bf_, UF[nv], z4); hh = MFMA16(kf_, Vf[nv], hh); hh = hh * grow;
                  u32x2 w; w.x = cvt_pk_bf16(hh[0], hh[1]); w.y = cvt_pk_bf16(hh[2], hh[3]); HHF[(nv * 4 + nc) * 64 + lane] = w; } } }
        asm volatile("s_waitcnt lgkmcnt(0)" ::: "memory");
    }
    __syncthreads();
    if (tid == 0) *(LAS u32x4*)(lds + LDS_X) = *(const u32x4*)(ws + OFF_CTL + CTL_KEEP + blockIdx.x * 16);
}
__device__ __forceinline__ void phase_scan_seq(const int wv, LAS unsigned char* lds) {
    KParams& p = *kparams();
    const int tid = opaque_tid(wv), wid = __builtin_amdgcn_readfirstlane(tid >> 6), lane = tid & 63, fr = lane & 15, fq = lane >> 4; unsigned char* ws = p.ws;
    if (blockIdx.x >= 64) return;
    const int bh = blockIdx.x, b = bh >> 3, h = bh & 7;
    const char* gG = (const char*)(ws + OFF_GTF) + (size_t)bh * 64 * 8192; const char* gR = (const char*)(ws + OFF_RTF) + (size_t)bh * 64 * 4096;
    const char* gH = (const char*)(ws + OFF_HHF) + (size_t)bh * 64 * 8192; const char* gY = (const char*)(ws + OFF_YLF) + (size_t)bh * 64 * 4096;
    constexpr int SLOT = 24576;
    if (wid >= 4) {
        const int w = wid - 4;
        auto issue = [&](int c) { LAS unsigned char* slot = lds + (c % 5) * SLOT;
#pragma unroll
            for (int i = 0; i < 6; ++i) { const int pc = w + 4 * i;
                const char* src = pc < 8 ? gG + (size_t)c * 8192 + pc * 1024 : pc < 12 ? gR + (size_t)c * 4096 + (pc - 8) * 1024 : pc < 20 ? gH + (size_t)c * 8192 + (pc - 12) * 1024 : gY + (size_t)c * 4096 + (pc - 20) * 1024;
                __builtin_amdgcn_global_load_lds((const unsigned*)(src + lane * 16), (LAS unsigned*)(slot + pc * 1024), 16, 0, 0); } };
        issue(0); issue(1); issue(2); issue(3);
        for (int c = 0; c < 64; ++c) {
            if (c < 60) asm volatile("s_waitcnt vmcnt(18)" ::: "memory"); else asm volatile("s_waitcnt vmcnt(0)" ::: "memory");
            __builtin_amdgcn_s_barrier();
            if (c + 4 < 64) issue(c + 4);
        }
        return; }
    const int nv = wid;
    float* Yraw = (float*)(ws + OFF_YRAW) + (size_t)b * SEQ * 512 + h * 64 + 16 * nv + fr;
    f32x4 T[4]; const f32x4 z4s = zero4f();
#pragma unroll
    for (int m = 0; m < 4; ++m) T[m] = z4s;
    for (int c = 0; c < 64; ++c) {
        __builtin_amdgcn_s_barrier();
        const LAS unsigned char* slot = lds + (c % 5) * SLOT + lane * 16;
        bf16x8 G[8], R[4]; u32x2 H[4], Y[2];
#pragma unroll
        for (int i = 0; i < 8; ++i) G[i] = *(const LAS bf16x8*)(slot + i * 1024);
#pragma unroll
        for (int i = 0; i < 4; ++i) R[i] = *(const LAS bf16x8*)(slot + 8192 + i * 1024);
#pragma unroll
        for (int i = 0; i < 4; ++i) H[i] = *(const LAS u32x2*)(lds + (c % 5) * SLOT + 12288 + (nv * 4 + i) * 512 + lane * 8);
#pragma unroll
        for (int i = 0; i < 2; ++i) Y[i] = *(const LAS u32x2*)(lds + (c % 5) * SLOT + 20480 + (nv * 2 + i) * 512 + lane * 8);
        const bf16x8 tf0 = pack_frag(T[0], T[1]), tf1 = pack_frag(T[2], T[3]);
#pragma unroll
        for (int nt = 0; nt < 2; ++nt) { f32x4 y; y[0] = bf_lo(Y[nt].x); y[1] = bf_hi(Y[nt].x); y[2] = bf_lo(Y[nt].y); y[3] = bf_hi(Y[nt].y);
            y = MFMA16(R[nt * 2], tf0, y); y = MFMA16(R[nt * 2 + 1], tf1, y);
#pragma unroll
            for (int j = 0; j < 4; ++j) Yraw[(size_t)(c * 32 + 16 * nt + 4 * fq + j) * 512] = y[j]; }
#pragma unroll
        for (int m = 0; m < 4; ++m) { f32x4 t; t[0] = bf_lo(H[m].x); t[1] = bf_hi(H[m].x); t[2] = bf_lo(H[m].y); t[3] = bf_hi(H[m].y);
            t = MFMA16(G[m * 2], tf0, t); t = MFMA16(G[m * 2 + 1], tf1, t); T[m] = t; }
        asm volatile("s_waitcnt lgkmcnt(0)" ::: "memory");
    }
}

__device__ __forceinline__ bf16x8 tr_pair(LAS unsigned char* pa, LAS unsigned char* pb, bool useB) {
    const s16x4 a = __builtin_amdgcn_ds_read_tr16_b64_v4i16((LAS s16x4*)pa);
    s16x4 b2 = (s16x4){0, 0, 0, 0};
    if (useB) b2 = __builtin_amdgcn_ds_read_tr16_b64_v4i16((LAS s16x4*)pb);
    return __builtin_shufflevector(a, b2, 0, 1, 2, 3, 4, 5, 6, 7);
}
__device__ __forceinline__ void phase_dil_attn(const int wv, LAS unsigned char* lds) {
    KParams& p = *kparams();
    const int tid = opaque_tid(wv), wid = tid >> 6, lane = tid & 63, fr = lane & 15, fq = lane >> 4; unsigned char* ws = p.ws;
    const bf16_t* Z = (const bf16_t*)(ws + OFF_Z); float* DILO = (float*)(ws + OFF_DILO); float* LSE = (float*)(ws + OFF_LSE);
    LAS unsigned char* kb = lds; LAS unsigned char* vb = lds + 32768; const float* qn = p.in[15]; const float* kn = p.in[16];
    float qkw[2][8];
#pragma unroll
    for (int ks = 0; ks < 2; ++ks)
#pragma unroll
        for (int j = 0; j < 8; ++j) qkw[ks][j] = qn[ks * 32 + 8 * fq + j] * kn[ks * 32 + 8 * fq + j];
    const bool seqwg = blockIdx.x < 64;
    const int u0 = seqwg ? 4 * (int)blockIdx.x : 256 + (int)blockIdx.x - 64, uend = seqwg ? 4 * (int)blockIdx.x + 4 : 1536, ustep = seqwg ? 1 : 192;
    auto umap = [&](int v) -> int { if (seqwg) return v; const int c2 = (int)blockIdx.x - 64, x = c2 & 7, y = c2 >> 3, i = (v - u0) / 192, k = 24 * i + y; return 256 + (k >> 3) * 64 + 8 * x + (k & 7); };
    const int ki = tid >> 1, half = tid & 1;
    u32x4 kvA[4], vvA[4], qvA[2], kvB[4], vvB[4], qvB[2]; bool kvalidA = false, kvalidB = false;
    auto unit_load = [&](int uv, u32x4 (&kv)[4], u32x4 (&vv)[4], u32x4 (&qv)[2], bool& kvalid) { const int u = umap(uv);
        const int b = u / 192, rem = u % 192, hh = rem >> 4, qb = rem & 15, g = hh >> 2;
        const int dil = g == 0 ? 1 : (g == 1 ? 4 : 16), nbc = 16 / dil, r = qb / nbc, j0 = (qb % nbc) * 128;
        const bf16_t* Zb = Z + (size_t)b * SEQ * INC; const int kj = j0 - 128 + ki; kvalid = kj >= 0;
        { const bf16_t* rowp = Zb + (size_t)((kvalid ? kj : 0) * dil + r) * INC + hh * 64 + half * 32;
#pragma unroll
            for (int i = 0; i < 4; ++i) { kv[i] = *(const u32x4*)(rowp + C_DK + 8 * i); vv[i] = *(const u32x4*)(rowp + C_DV + 8 * i); } }
        const int tq = (j0 + 16 * wid + fr) * dil + r;
#pragma unroll
        for (int ks = 0; ks < 2; ++ks) qv[ks] = *(const u32x4*)(Zb + (size_t)tq * INC + C_DQ + hh * 64 + ks * 32 + 8 * fq); };
    auto do_unit = [&](const int uvv, u32x4 (&kv)[4], u32x4 (&vv)[4], u32x4 (&qv)[2], bool& kvalid) { const int u = umap(uvv); const int uv_ = uvv;
        const int b = u / 192, rem = u % 192, hh = rem >> 4, qb = rem & 15, g = hh >> 2, hg = hh & 3;
        const int dil = g == 0 ? 1 : (g == 1 ? 4 : 16), nbc = 16 / dil, r = qb / nbc, j0 = (qb % nbc) * 128;
        { if (kvalid) {
              float ss = sumsq8(kv[0]) + sumsq8(kv[1]) + sumsq8(kv[2]) + sumsq8(kv[3]); ss += dpp_f<0xB1>(ss);
              const float rs = rsqrtf(ss * (1.0f / 64.0f) + 1e-5f);
#pragma unroll
              for (int i = 0; i < 4; ++i) kv[i] = scale8s(kv[i], rs); }
          else { const u32x4 zu = zero4u();
#pragma unroll
              for (int i = 0; i < 4; ++i) { kv[i] = zu; vv[i] = zu; } }
#pragma unroll
          for (int i = 0; i < 4; ++i) { const int sw = (half * 4 + i) ^ (ki & 7); *(LAS u32x4*)(kb + ki * 128 + sw * 16) = kv[i]; *(LAS u32x4*)(vb + ki * 128 + sw * 16) = vv[i]; } }
        const int qi = 16 * wid + fr, tq = (j0 + qi) * dil + r;
        bf16x8 qf[2];
        { float ss = sumsq8(qv[0]) + sumsq8(qv[1]); ss += sxor(ss, 16); ss += sxor(ss, 32);
          const float rs = rsqrtf(ss * (1.0f / 64.0f) + 1e-5f) * 0.125f;
#pragma unroll
          for (int ks = 0; ks < 2; ++ks) { const u32x4 w = scale8r(qv[ks], rs, qkw[ks]); __builtin_memcpy(&qf[ks], &w, 16); } }
        __syncthreads();
        if (uv_ + 2 * ustep < uend) unit_load(uv_ + 2 * ustep, kv, vv, qv, kvalid);
        f32x4 st[9]; float mx = -1e30f; const f32x4 zq = zero4f();
        LAS unsigned char* kp0 = kb + (16 * wid + fr) * 128 + ((fq ^ (fr & 7)) << 4); LAS unsigned char* kp1 = kb + (16 * wid + fr) * 128 + (((4 + fq) ^ (fr & 7)) << 4);
#pragma unroll
        for (int ti = 0; ti < 9; ++ti) {
            const bf16x8 k0 = *(const LAS bf16x8*)(kp0 + ti * 2048), k1 = *(const LAS bf16x8*)(kp1 + ti * 2048);
            f32x4 s = __builtin_amdgcn_mfma_f32_16x16x32_bf16(k0, qf[0], zq, 0, 0, 0);
            s = __builtin_amdgcn_mfma_f32_16x16x32_bf16(k1, qf[1], s, 0, 0, 0);
#pragma unroll
            for (int j = 0; j < 4; ++j) { const int ki = 16 * (wid + ti) + 4 * fq + j, off = qi + 128 - ki; const bool ok = (off >= 0) && (off <= 128) && (j0 - 128 + ki >= 0);
                s[j] = ok ? s[j] : -1e30f; mx = fmaxf(mx, s[j]); }
            st[ti] = s; }
        mx = fmaxf(mx, sxor(mx, 16)); mx = fmaxf(mx, sxor(mx, 32));
        float den = 0.f;
#pragma unroll
        for (int ti = 0; ti < 9; ++ti)
#pragma unroll
            for (int j = 0; j < 4; ++j) { const float e = __builtin_amdgcn_exp2f((st[ti][j] - mx) * 1.44269504f); st[ti][j] = e; den += e; }
        den += sxor(den, 16); den += sxor(den, 32);
        f32x4 o[4];
#pragma unroll
        for (int dt = 0; dt < 4; ++dt) o[dt] = zq;
        const int q4 = fr >> 2, p4 = fr & 3; const int kl = 4 * fq + q4;
        LAS unsigned char* vp[4];
#pragma unroll
        for (int dt = 0; dt < 4; ++dt) vp[dt] = vb + (16 * wid + kl) * 128 + (((2 * dt + (p4 >> 1)) ^ (kl & 7)) << 4) + (p4 & 1) * 8;
#pragma unroll
        for (int pp = 0; pp < 5; ++pp) { const bool two = pp < 4; const int tA = 2 * pp, tB = two ? 2 * pp + 1 : 2 * pp;
            u32x4 pw; pw.x = cvt_pk_bf16(st[tA][0], st[tA][1]); pw.y = cvt_pk_bf16(st[tA][2], st[tA][3]);
            if (two) { pw.z = cvt_pk_bf16(st[tB][0], st[tB][1]); pw.w = cvt_pk_bf16(st[tB][2], st[tB][3]); } else { pw.z = 0u; pw.w = 0u; }
            bf16x8 pf; __builtin_memcpy(&pf, &pw, 16);
#pragma unroll
            for (int dt = 0; dt < 4; ++dt) { const bf16x8 vf = tr_pair(vp[dt] + tA * 2048, vp[dt] + tB * 2048, two);
                o[dt] = __builtin_amdgcn_mfma_f32_16x16x32_bf16(vf, pf, o[dt], 0, 0, 0); } }
        const float inv = __builtin_amdgcn_rcpf(den); const size_t ob = ((size_t)(g * NTOK + b * SEQ + tq) * 4 + hg);
#pragma unroll
        for (int dt = 0; dt < 4; ++dt) *(f32x4*)(DILO + ob * 64 + 16 * dt + 4 * fq) = o[dt] * inv;
        if (fq == 0) LSE[ob] = mx + __logf(den);
        __syncthreads();
    };
    if (u0 < uend) unit_load(u0, kvA, vvA, qvA, kvalidA);
    if (u0 + ustep < uend) unit_load(u0 + ustep, kvB, vvB, qvB, kvalidB);
    for (int u = u0; u < uend; u += 2 * ustep) {
        do_unit(u, kvA, vvA, qvA, kvalidA);
        if (u + ustep < uend) do_unit(u + ustep, kvB, vvB, qvB, kvalidB);
    }
}

__device__ __forceinline__ void phase_mem_attn(const int wv, LAS unsigned char* lds) {
    KParams& p = *kparams();
    const int tid = opaque_tid(wv), wid = tid >> 6, lane = tid & 63, fr = lane & 15, fq = lane >> 4; unsigned char* ws = p.ws;
    const bf16_t* Z = (const bf16_t*)(ws + OFF_Z); const bf16_t* KV = (const bf16_t*)(ws + OFF_KV); bf16_t* YM = (bf16_t*)(ws + OFF_YCAT) + 768;
    LAS unsigned char* kb = lds; LAS unsigned char* vb = lds + 65536; const float* mqn = p.in[19]; const float* mkn = p.in[20];
    if (blockIdx.x < 64) return;
    float mqk[4][8];
#pragma unroll
    for (int ks = 0; ks < 4; ++ks)
#pragma unroll
        for (int j = 0; j < 8; ++j) mqk[ks][j] = mqn[ks * 32 + 8 * fq + j] * mkn[ks * 32 + 8 * fq + j];
    for (int bhq = (int)blockIdx.x - 64; bhq < 256; bhq += (int)gridDim.x - 64) {
        const int bhm = bhq >> 3, b = bhm >> 2, hm = bhm & 3;
        { const int ki = tid >> 1, half = tid & 1; const bf16_t* rowp = KV + (size_t)(b * 256 + ki) * 1024 + hm * 128 + half * 64;
          u32x4 kv[8], vv[8];
#pragma unroll
          for (int i = 0; i < 8; ++i) { kv[i] = *(const u32x4*)(rowp + 8 * i); vv[i] = *(const u32x4*)(rowp + 512 + 8 * i); }
          { float ss = 0.f;
#pragma unroll
            for (int i = 0; i < 8; ++i) ss += sumsq8(kv[i]);
            ss += dpp_f<0xB1>(ss); const float rs = rsqrtf(ss * (1.0f / 128.0f) + 1e-5f);
#pragma unroll
            for (int i = 0; i < 8; ++i) kv[i] = scale8s(kv[i], rs); }
#pragma unroll
          for (int i = 0; i < 8; ++i) { const int sw = (half * 8 + i) ^ (ki & 15); *(LAS u32x4*)(kb + ki * 256 + sw * 16) = kv[i]; *(LAS u32x4*)(vb + ki * 256 + sw * 16) = vv[i]; } }
        __syncthreads();
        const int q4 = fr >> 2, p4 = fr & 3; const int kl = 4 * fq + q4;
        LAS unsigned char* kp[4]; LAS unsigned char* vp[8];
#pragma unroll
        for (int ks = 0; ks < 4; ++ks) kp[ks] = kb + fr * 256 + (((4 * ks + fq) ^ fr) << 4);
#pragma unroll
        for (int dt = 0; dt < 8; ++dt) vp[dt] = vb + kl * 256 + (((2 * dt + (p4 >> 1)) ^ kl) << 4) + (p4 & 1) * 8;
        for (int qq = 0; qq < 2; ++qq) { const int qblk = (bhq & 7) * 2 + qq; const int tq = b * SEQ + qblk * 128 + 16 * wid + fr;
            bf16x8 qf[4];
#pragma unroll
            for (int ks = 0; ks < 4; ++ks) qf[ks] = *(const bf16x8*)(Z + (size_t)tq * INC + C_MQ + hm * 128 + ks * 32 + 8 * fq);
            { u32x4 qv[4]; float ss = 0.f;
#pragma unroll
              for (int ks = 0; ks < 4; ++ks) { __builtin_memcpy(&qv[ks], &qf[ks], 16); ss += sumsq8(qv[ks]); }
              ss += sxor(ss, 16); ss += sxor(ss, 32); const float rs = rsqrtf(ss * (1.0f / 128.0f) + 1e-5f);
#pragma unroll
              for (int ks = 0; ks < 4; ++ks) { const u32x4 w = scale8r(qv[ks], rs, mqk[ks]); __builtin_memcpy(&qf[ks], &w, 16); } }
            f32x4 st[16]; float mx = -1e30f; const f32x4 zq = zero4f();
#pragma unroll
            for (int ti = 0; ti < 16; ++ti) { f32x4 s = zq;
#pragma unroll
                for (int ks = 0; ks < 4; ++ks) { const bf16x8 kf = *(const LAS bf16x8*)(kp[ks] + ti * 4096); s = __builtin_amdgcn_mfma_f32_16x16x32_bf16(kf, qf[ks], s, 0, 0, 0); }
#pragma unroll
                for (int j = 0; j < 4; ++j) mx = fmaxf(mx, s[j]);
                st[ti] = s; if (ti & 1) asm volatile("" ::: "memory"); }
            mx = fmaxf(mx, sxor(mx, 16)); mx = fmaxf(mx, sxor(mx, 32));
            const float sc = 0.08838834764831845f * 1.44269504f; float den = 0.f;
#pragma unroll
            for (int ti = 0; ti < 16; ++ti)
#pragma unroll
                for (int j = 0; j < 4; ++j) { const float e = __builtin_amdgcn_exp2f((st[ti][j] - mx) * sc); st[ti][j] = e; den += e; }
            den += sxor(den, 16); den += sxor(den, 32);
            f32x4 o[8];
#pragma unroll
            for (int dt = 0; dt < 8; ++dt) o[dt] = zq;
#pragma unroll
            for (int pp = 0; pp < 8; ++pp) { const int tA = 2 * pp, tB = 2 * pp + 1;
                u32x4 pw; pw.x = cvt_pk_bf16(st[tA][0], st[tA][1]); pw.y = cvt_pk_bf16(st[tA][2], st[tA][3]); pw.z = cvt_pk_bf16(st[tB][0], st[tB][1]); pw.w = cvt_pk_bf16(st[tB][2], st[tB][3]);
                bf16x8 pf; __builtin_memcpy(&pf, &pw, 16);
#pragma unroll
                for (int dt = 0; dt < 8; ++dt) { const bf16x8 vf = tr_pair(vp[dt] + tA * 4096, vp[dt] + tB * 4096, true);
                    o[dt] = __builtin_amdgcn_mfma_f32_16x16x32_bf16(vf, pf, o[dt], 0, 0, 0); } }
            const float inv = __builtin_amdgcn_rcpf(den);
#pragma unroll
            for (int dt = 0; dt < 8; ++dt) { u32x2 w; w.x = cvt_pk_bf16(o[dt][0] * inv, o[dt][1] * inv); w.y = cvt_pk_bf16(o[dt][2] * inv, o[dt][3] * inv);
                *(u32x2*)(YM + (size_t)tq * 1280 + hm * 128 + 16 * dt + 4 * fq) = w; } }
        __syncthreads();
    }
}

__device__ __forceinline__ void phase_post(const int wv) {
    KParams& p = *kparams();
    const int gt = blockIdx.x * 512 + opaque_tid(wv), nthr = gridDim.x * 512; unsigned char* ws = p.ws;
    const float* Yraw = (const float*)(ws + OFF_YRAW); const bf16_t* C1 = (const bf16_t*)(ws + OFF_C1); const bf16_t* C2 = (const bf16_t*)(ws + OFF_C2); bf16_t* YR = (bf16_t*)(ws + OFF_YCAT);
    for (int idx = gt; idx < NTOK * 128; idx += nthr) { const int t = idx >> 7, c = ((idx >> 4) & 7) * 64 + 4 * (idx & 15);
        const f32x4 y = *(const f32x4*)(Yraw + (size_t)t * 512 + c);
        const float mean = red16(y[0] + y[1] + y[2] + y[3]) * (1.0f / 64.0f);
        const f32x4 d = y - mean; const float var = red16(d[0] * d[0] + d[1] * d[1] + d[2] * d[2] + d[3] * d[3]) * (1.0f / 64.0f);
        const float rs = rsqrtf(var + 64.0f * 1e-5f);
        float c1[4], c2[4]; unpack4(*(const u32x2*)(C1 + (size_t)t * 512 + c), c1); unpack4(*(const u32x2*)(C2 + (size_t)t * 512 + c), c2);
        u32x2 w; w.x = cvt_pk_bf16(d[0] * rs * c1[0] + c2[0], d[1] * rs * c1[1] + c2[1]); w.y = cvt_pk_bf16(d[2] * rs * c1[2] + c2[2], d[3] * rs * c1[3] + c2[3]);
        *(u32x2*)(YR + (size_t)t * 1280 + c) = w; }
    const float* DILO = (const float*)(ws + OFF_DILO); const float* LSE = (const float*)(ws + OFF_LSE); bf16_t* YD = (bf16_t*)(ws + OFF_YCAT) + 512;
    for (int idx = gt; idx < NTOK * 64; idx += nthr) { const int t = idx >> 6, hg = (idx >> 4) & 3, q = idx & 15;
        const float l0 = LSE[(size_t)t * 4 + hg], l1 = LSE[((size_t)NTOK + t) * 4 + hg], l2 = LSE[((size_t)2 * NTOK + t) * 4 + hg];
        const float m = fmaxf(l0, fmaxf(l1, l2)); const float e0 = __expf(l0 - m), e1 = __expf(l1 - m), e2 = __expf(l2 - m); const float inv = __builtin_amdgcn_rcpf(e0 + e1 + e2);
        const f32x4 o0 = *(const f32x4*)(DILO + ((size_t)t * 4 + hg) * 64 + 4 * q), o1 = *(const f32x4*)(DILO + (((size_t)NTOK + t) * 4 + hg) * 64 + 4 * q), o2 = *(const f32x4*)(DILO + (((size_t)2 * NTOK + t) * 4 + hg) * 64 + 4 * q);
        const f32x4 o = (o0 * e0 + o1 * e1 + o2 * e2) * inv;
        u32x2 w; w.x = cvt_pk_bf16(o[0], o[1]); w.y = cvt_pk_bf16(o[2], o[3]); *(u32x2*)(YD + (size_t)t * 1280 + hg * 64 + 4 * q) = w; }
}

__device__ __forceinline__ void phase_router(const int wv, LAS unsigned char* lds, const bool real = true) {
    KParams& p = *kparams();
    const int tid = opaque_tid(wv), wid = tid >> 6, lane = tid & 63, fr = lane & 15, fq = lane >> 4; unsigned char* ws = p.ws;
    const bf16_t* X1 = (const bf16_t*)(ws + OFF_X1B); const float* ln2 = p.in[25]; const float* br = p.in[27]; const bf16_t* WRT = (const bf16_t*)(ws + OFF_WRT);
    unsigned char* XN2 = ws + OFF_XN2; int* TOPE = (int*)(ws + OFF_TOPE); float* TOPG = (float*)(ws + OFF_TOPG);
    LAS int* hist = (LAS int*)(lds + LX_HIST);
    LAS float* red = (LAS float*)lds;
    LAS float* part = (LAS float*)(lds + 1024);
    if (tid < 32) hist[tid] = 0;
    const int grp = wid >> 2, kq = wid & 3;
    int tek[2][4] = {{0, 0, 0, 0}, {0, 0, 0, 0}}, lrk[2][4] = {{0, 0, 0, 0}, {0, 0, 0, 0}};
    u32x4 xq[2][8];
#pragma unroll
    for (int rd = 0; rd < 2; ++rd) { const bf16_t* xp = X1 + (size_t)((blockIdx.x * 4 + rd * 2 + grp) * 16 + fr) * 1024 + kq * 256 + 8 * fq;
#pragma unroll
        for (int s2 = 0; s2 < 8; ++s2) xq[rd][s2] = __builtin_nontemporal_load((const u32x4*)(xp + 32 * s2)); }
#pragma unroll
    for (int rd = 0; rd < 2; ++rd) { const int t0 = (blockIdx.x * 4 + rd * 2 + grp) * 16;
        f32x4 xa[8], xb[8]; float ss = 0.f;
#pragma unroll
        for (int s2 = 0; s2 < 8; ++s2) { float f[8]; unpack8(xq[rd][s2], f); xa[s2] = (f32x4){f[0], f[1], f[2], f[3]}; xb[s2] = (f32x4){f[4], f[5], f[6], f[7]}; }
#pragma unroll
        for (int s2 = 0; s2 < 8; ++s2) ss += xa[s2][0] * xa[s2][0] + xa[s2][1] * xa[s2][1] + xa[s2][2] * xa[s2][2] + xa[s2][3] * xa[s2][3] + xb[s2][0] * xb[s2][0] + xb[s2][1] * xb[s2][1] + xb[s2][2] * xb[s2][2] + xb[s2][3] * xb[s2][3];
        ss += sxor(ss, 16); ss += sxor(ss, 32);
        __syncthreads();
        if (fq == 0) red[(grp * 4 + kq) * 16 + fr] = ss;
        __syncthreads();
        const float tot = red[(grp * 4 + 0) * 16 + fr] + red[(grp * 4 + 1) * 16 + fr] + red[(grp * 4 + 2) * 16 + fr] + red[(grp * 4 + 3) * 16 + fr];
        const float rs = rsqrtf(tot * (1.0f / 1024.0f) + 1e-5f);
        f32x4 acc[2]; acc[0] = zero4f(); acc[1] = acc[0];
#pragma unroll
        for (int s2 = 0; s2 < 8; ++s2) { const int k = kq * 256 + 32 * s2 + 8 * fq;
            const f32x4 g0 = *(const f32x4*)(ln2 + k), g1 = *(const f32x4*)(ln2 + k + 4);
            float xn[8]; xn[0] = xa[s2][0] * rs * g0[0]; xn[1] = xa[s2][1] * rs * g0[1]; xn[2] = xa[s2][2] * rs * g0[2]; xn[3] = xa[s2][3] * rs * g0[3];
            xn[4] = xb[s2][0] * rs * g1[0]; xn[5] = xb[s2][1] * rs * g1[1]; xn[6] = xb[s2][2] * rs * g1[2]; xn[7] = xb[s2][3] * rs * g1[3];
            const u32x4 hi = pack8(xn); float hf[8]; unpack8(hi, hf);
#pragma unroll
            for (int j = 0; j < 8; ++j) hf[j] = xn[j] - hf[j];
            const u32x4 lo = pack8(hf);
            { u32x2 q8; q8.x = pack4_fp8(xn[0] * 8.0f, xn[1] * 8.0f, xn[2] * 8.0f, xn[3] * 8.0f); q8.y = pack4_fp8(xn[4] * 8.0f, xn[5] * 8.0f, xn[6] * 8.0f, xn[7] * 8.0f); if (real) *(u32x2*)(XN2 + (size_t)(t0 + fr) * 1024 + k) = q8; }
            bf16x8 xh, xl; __builtin_memcpy(&xh, &hi, 16); __builtin_memcpy(&xl, &lo, 16);
#pragma unroll
            for (int m = 0; m < 2; ++m) { const bf16x8 wh = *(const bf16x8*)(WRT + (size_t)(16 * m + fr) * 1024 + k), wl = *(const bf16x8*)(WRT + 32768 + (size_t)(16 * m + fr) * 1024 + k);
                acc[m] = MFMA16(wh, xh, acc[m]); acc[m] = MFMA16(wh, xl, acc[m]); acc[m] = MFMA16(wl, xh, acc[m]); } }
#pragma unroll
        for (int m = 0; m < 2; ++m)
#pragma unroll
            for (int j = 0; j < 4; ++j) part[((grp * 4 + kq) * 32 + 16 * m + 4 * fq + j) * 16 + fr] = acc[m][j];
        __syncthreads();
        if (kq == 0) { float lg[8]; int le[8];
#pragma unroll
            for (int m = 0; m < 2; ++m)
#pragma unroll
                for (int j = 0; j < 4; ++j) { const int e = 16 * m + 4 * fq + j; le[m * 4 + j] = e;
                    lg[m * 4 + j] = part[((grp * 4 + 0) * 32 + e) * 16 + fr] + part[((grp * 4 + 1) * 32 + e) * 16 + fr] + part[((grp * 4 + 2) * 32 + e) * 16 + fr] + part[((grp * 4 + 3) * 32 + e) * 16 + fr] + br[e]; }
            float tv[4]; int te[4];
#pragma unroll
            for (int r = 0; r < 4; ++r) { float bv = lg[0]; int bi = le[0];
#pragma unroll
                for (int q = 1; q < 8; ++q) if (lg[q] > bv) { bv = lg[q]; bi = le[q]; }
#pragma unroll
                for (int sft = 16; sft < 64; sft <<= 1) { const float ov = sxor(bv, sft); const int oi = sxor(bi, sft); if (ov > bv || (ov == bv && oi < bi)) { bv = ov; bi = oi; } }
                tv[r] = bv; te[r] = bi;
#pragma unroll
                for (int q = 0; q < 8; ++q) if (le[q] == bi) lg[q] = -3.0e38f; }
            const float e1 = __expf(tv[1] - tv[0]), e2 = __expf(tv[2] - tv[0]), e3 = __expf(tv[3] - tv[0]); const float inv = 1.0f / (1.0f + e1 + e2 + e3);
            if (fq == 0 && real) { const int t = t0 + fr; *(int4*)(TOPE + (size_t)t * 4) = make_int4(te[0], te[1], te[2], te[3]); *(f32x4*)(TOPG + (size_t)t * 4) = (f32x4){inv, e1 * inv, e2 * inv, e3 * inv};
#pragma unroll
                for (int k = 0; k < 4; ++k) { tek[rd][k] = te[k]; lrk[rd][k] = atomicAdd((int*)&hist[te[k]], 1); } } }
    }
    LAS int* bbase = (LAS int*)(lds + LX_BBASE);
    __syncthreads();
    if (tid < 32) { const int hcount = hist[tid]; bbase[tid] = (hcount && real) ? atomicAdd((int*)(ws + OFF_CTL + CTL_CUR) + tid, hcount) : 0; }
    __syncthreads();
    if (kq == 0 && fq == 0 && real) { int* POS = (int*)(ws + OFF_POS); int* STOKE = (int*)(ws + OFF_STOKE);
#pragma unroll
        for (int rd = 0; rd < 2; ++rd) { const int t = (blockIdx.x * 4 + rd * 2 + grp) * 16 + fr; int ps[4];
#pragma unroll
            for (int k = 0; k < 4; ++k) { ps[k] = bbase[tek[rd][k]] + lrk[rd][k]; STOKE[(size_t)tek[rd][k] * NTOK + ps[k]] = t; }
            *(int4*)(POS + (size_t)t * 4) = make_int4(ps[0], ps[1], ps[2], ps[3]); } }
}

__device__ __forceinline__ void build_tables(const int wv, LAS unsigned char* lds) {
    KParams& p = *kparams();
    LAS int* ts = (LAS int*)(lds + LX_TSTART); LAS int* sb = (LAS int*)(lds + LX_SBASE); LAS int* cn = (LAS int*)(lds + LX_CNT);
    if (wv == 0) { const int l = lane_id(); int* gc = (int*)(p.ws + OFF_CTL + CTL_CUR);
        const int c = (l < 32) ? (int)__hip_atomic_load(gc + l, __ATOMIC_RELAXED, __HIP_MEMORY_SCOPE_AGENT) : 0; const int tl = (c + 255) >> 8; int v = tl;
#pragma unroll
        for (int d = 1; d < 32; d <<= 1) { const int o = __builtin_amdgcn_ds_bpermute((l - d) << 2, v); if (l >= d) v += o; }
        if (l < 32) { cn[l] = c; sb[l] = (v - tl) * 256; ts[l + 1] = v; if (l == 0) ts[0] = 0; } }
    __syncthreads();
    { const int tid = (wv << 6) | lane_id(); LAS unsigned char* te = (LAS unsigned char*)(lds + LX_TEXP); const int nt = ts[32];
      if (tid < nt) { int e = 0; while (e < 31 && tid >= ts[e + 1]) ++e; te[tid] = (unsigned char)e; } }
    __syncthreads();
}

__device__ __forceinline__ void phase_combine(const int wv, const bool real = true) {
    KParams& p = *kparams();
    const int tid = opaque_tid(wv), wid = tid >> 6, lane = tid & 63; unsigned char* ws = p.ws;
    const int* SLOT = (const int*)(ws + OFF_SLOT); const float* TOPG = (const float*)(ws + OFF_TOPG); const bf16_t* YS = (const bf16_t*)(ws + OFF_YS); const bf16_t* X1 = (const bf16_t*)(ws + OFF_X1B); float* out = p.out;
    for (int t0 = (blockIdx.x * 8 + wid) * 8; t0 < NTOK; t0 += gridDim.x * 64) {
        int4 sl[8]; f32x4 gg[8];
#pragma unroll
        for (int i = 0; i < 8; ++i) { sl[i] = *(const int4*)(SLOT + (size_t)(t0 + i) * 4); gg[i] = *(const f32x4*)(TOPG + (size_t)(t0 + i) * 4); }
#pragma unroll
        for (int i = 0; i < 8; ++i) { const int t = t0 + i; const int s4[4] = {sl[i].x, sl[i].y, sl[i].z, sl[i].w};
#pragma unroll
            for (int hf = 0; hf < 2; ++hf) { const int c = hf * 512 + 8 * lane; float acc[8];
                const u32x4 xv = __builtin_nontemporal_load((const u32x4*)(X1 + (size_t)t * 1024 + c));
                u32x4 yv[4];
#pragma unroll
                for (int k = 0; k < 4; ++k) yv[k] = __builtin_nontemporal_load((const u32x4*)(YS + (size_t)s4[k] * 1024 + c));
                unpack8(xv, acc);
#pragma unroll
                for (int k = 0; k < 4; ++k) { float f[8]; unpack8(yv[k], f);
#pragma unroll
                    for (int j = 0; j < 8; ++j) acc[j] = fmaf(gg[i][k], f[j], acc[j]); }
                float* dst = real ? out : (float*)(ws + OFF_ACT);
                *(f32x4*)(dst + (size_t)t * 1024 + c) = (f32x4){acc[0], acc[1], acc[2], acc[3]}; *(f32x4*)(dst + (size_t)t * 1024 + c + 4) = (f32x4){acc[4], acc[5], acc[6], acc[7]}; }
            if (i & 1) asm volatile("" ::: "memory"); }
    }
}

__global__ void __launch_bounds__(512, 2) mk_fwd(Params p) {
    extern __shared__ __attribute__((aligned(16))) unsigned char lds_raw[];
    LAS unsigned char* lds = (LAS unsigned char*)lds_raw;
    unsigned char* ws = p.ws;
    const int wv = __builtin_amdgcn_readfirstlane((int)threadIdx.x >> 6);
    const bool multi = (p.ph_hi - p.ph_lo) > 1;
    XcdBarrier xb; xb.bar = (unsigned*)(ws + OFF_CTL); xb.x = 0; xb.st = (volatile LAS unsigned*)(lds + LDS_X);
    if (multi) {
        if (wv == 0 && lane_id() == 0) { *(LAS u32x4*)(lds + LDS_X) = zero4u(); }
        __syncthreads();
        xb = xcd_barrier_post((unsigned*)(ws + OFF_CTL), (volatile LAS unsigned*)(lds + LDS_X), wv);
    }
#if MFMA_BENCH
    { const int l = lane_id(); unsigned h = (unsigned)l * 2654435761u ^ (unsigned)blockIdx.x * 40503u ^ (unsigned)wv * 977u;
      i32x8 a, b;
#pragma unroll
      for (int j = 0; j < 8; ++j) { h = h * 1664525u + 1013904223u; a[j] = (int)(MFMA_BENCH == 1 ? ((h & 0x00ff00ffu) | 0x3f003f00u) : ((h & 0x0f0f0f0fu) | 0x30303030u));
                                    h = h * 1664525u + 1013904223u; b[j] = (int)(MFMA_BENCH == 1 ? ((h & 0x00ff00ffu) | 0x3f003f00u) : ((h & 0x0f0f0f0fu) | 0x30303030u)); }
      f32x4 c[8]; const f32x4 z0 = zero4f();
#pragma unroll
      for (int j = 0; j < 8; ++j) c[j] = z0;
      const int one_scale = 0x7f7f7f7f;
#pragma clang loop unroll(disable)
      for (int it = 0; it < (MFMA_BENCH == 1 ? 1875 : 938); ++it) {
#pragma unroll
          for (int j = 0; j < 8; ++j) {
              if (MFMA_BENCH == 1) c[j] = (j & 1) ? __builtin_amdgcn_mfma_f32_16x16x32_bf16(pg8::half8<1>(a), pg8::half8<1>(b), c[j], 0, 0, 0) : __builtin_amdgcn_mfma_f32_16x16x32_bf16(pg8::half8<0>(a), pg8::half8<0>(b), c[j], 0, 0, 0);
              else asm volatile("v_mfma_scale_f32_16x16x128_f8f6f4 %0, %1, %2, %0, %3, %3 op_sel_hi:[0,0,0]" : "+v"(c[j]) : "v"(a), "v"(b), "v"(one_scale)); } }
      asm volatile("s_nop 15\n\ts_nop 15" ::: "memory");
      float sm = 0.f;
#pragma unroll
      for (int j = 0; j < 8; ++j) sm += c[j][0] + c[j][1] + c[j][2] + c[j][3];
      if (sm == 1.2345f) *(float*)(ws + OFF_CTL + 8192) = sm; }
#endif
    for (int ph = p.ph_lo; ph < p.ph_hi; ++ph) {
      if (ph == 2 || ph == 3 || ph == 10) continue;
      for (int rep = 0; rep < (((DBL_MASK >> ph) & 1) ? 2 : 1); ++rep) {
        KParams& q = *kparams(); unsigned char* ws = q.ws;
        switch (ph) {
        case 0: phase_prep(wv, lds); break;
        case 1: { { SchedZ S; S.H = (const char*)(ws + OFF_H); S.WinT = (const char*)(ws + OFF_WINT); S.HM = (const char*)(ws + OFF_HM); S.WmkvT = (const char*)(ws + OFF_WMKVT); S.G = gridDim.x; S.c = blockIdx.x;
                    EpiZ E; E.Z = (bf16_t*)(ws + OFF_Z); E.KV = (bf16_t*)(ws + OFF_KV); E.GFp = (bf16_t*)(ws + OFF_GF); E.pn0 = 0; E.scale = 1.0f; pg8::gemm_phase(wv, lds, 1024, S, E); }
                  { SchedZ8 S; S.H8 = (const char*)(ws + OFF_H8); S.WIN8 = (const char*)(ws + OFF_WIN8); S.G = gridDim.x; S.c = blockIdx.x;
                    EpiZ E; E.Z = (bf16_t*)(ws + OFF_Z); E.KV = (bf16_t*)(ws + OFF_KV); E.GFp = (bf16_t*)(ws + OFF_GF); E.pn0 = 7; E.scale = 1.0f / 256.0f; pg8::gemm_phase<EpiZ, SchedZ8, 1>(wv, lds, 1024, S, E); } } break;
        case 2: phase_elem_c(wv); break;
        case 3: { pg8::DenseOrder S; S.init(ws + OFF_ALORA, ws + OFF_LORAT, NTOK, 1536, 256); EpiLora E; E.L = (float*)(ws + OFF_L); E.w0 = q.in[5]; E.a0 = q.in[7]; pg8::gemm_phase(wv, lds, 256, S, E); } break;
        case 4: phase_chunk_pre(wv, lds); break;
        case 5: for (int r2 = 0; r2 < (((DBL_MASK >> 16) & 1) ? 2 : 1); ++r2) phase_scan_seq(wv, lds);
                for (int r2 = 0; r2 < (((DBL_MASK >> 17) & 1) ? 2 : 1); ++r2) phase_dil_attn(wv, lds);
                for (int r2 = 0; r2 < (((DBL_MASK >> 18) & 1) ? 2 : 1); ++r2) phase_mem_attn(wv, lds); break;
        case 6: phase_post(wv); break;
        case 7: { pg8::DenseOrder S; S.init(ws + OFF_YCAT, ws + OFF_PCAT, NTOK, 1024, 1280); EpiMixCat E; E.mixbf = (bf16_t*)(ws + OFF_MIXBF); E.GF = (const bf16_t*)(ws + OFF_GF); E.tid = (wv << 6) | lane_id(); pg8::gemm_phase(wv, lds, 1280, S, E); } break;
        case 8: { pg8::DenseOrder S; S.init(ws + OFF_MIXBF, ws + OFF_WOT, NTOK, 1024, 1024); EpiX1 E; E.x = q.in[0]; E.x1 = (bf16_t*)(ws + OFF_X1B); pg8::gemm_phase(wv, lds, 1024, S, E); } break;
        case 9: phase_router(wv, lds, rep + 1 == (((DBL_MASK >> ph) & 1) ? 2 : 1)); break;
        case 11: { build_tables(wv, lds);
                   { const int* TOPE = (const int*)(ws + OFF_TOPE); const int* POS = (const int*)(ws + OFF_POS); int* SLOT = (int*)(ws + OFF_SLOT); const LAS int* sb = (const LAS int*)(lds + LX_SBASE);
                     for (int i = blockIdx.x * 512 + ((wv << 6) | lane_id()); i < NTOK * 4; i += gridDim.x * 512) SLOT[i] = sb[TOPE[i]] + POS[i]; }
                   SchedMoe<true> S; S.A = (const char*)(ws + OFF_XN2); S.Bt = (const char*)(ws + OFF_W1T); S.tstart = (const LAS int*)(lds + LX_TSTART); S.stok = (const int*)(ws + OFF_STOKE); S.lgN = 3; S.total = S.tstart[32] * 8; S.estride = (size_t)2048 * 1024; S.tbytes = (size_t)256 * 1024;
                   EpiSwiglu E; E.act = ws + OFF_ACT; E.b1 = q.in[29]; pg8::gemm_phase<EpiSwiglu, SchedMoe<true>, 1>(wv, lds, 1024, S, E); } break;
        case 12: { build_tables(wv, lds); SchedMoe<false> S; S.A = (const char*)(ws + OFF_ACT); S.Bt = (const char*)(ws + OFF_W2T); S.tstart = (const LAS int*)(lds + LX_TSTART); S.stok = nullptr; S.lgN = 2; S.total = S.tstart[32] * 4; S.estride = (size_t)1024 * 1024; S.tbytes = (size_t)256 * 1024;
                   EpiYs E; E.ys = (bf16_t*)(ws + OFF_YS); E.b2 = q.in[31]; pg8::gemm_phase<EpiYs, SchedMoe<false>, 1>(wv, lds, 1024, S, E); } break;
        case 13: phase_combine(wv, rep + 1 == (((DBL_MASK >> ph) & 1) ? 2 : 1)); break;
        default: break;
        }
      }
        if (ph + 1 < p.ph_hi) xcd_barrier(xb, wv);
        if (((DBL_MASK >> 20) & 1) && ph == 3 && multi) for (int e = 0; e < 10; ++e) xcd_barrier(xb, wv);
    }
}

extern "C" void kernel_launch(void* const* d_in, const int* in_sizes, int n_in, void* d_out, int out_size, void* d_ws, size_t ws_size, hipStream_t stream) {
    static int ready = 0;
    if (ready == 0) {
        if (n_in != 32 || out_size != NTOK * 1024 || ws_size < WS_NEED) { fprintf(stderr, "kernel_launch: unexpected shapes (n_in %d, out %d, ws %zu < %zu)\n", n_in, out_size, ws_size, (size_t)WS_NEED); ready = -1; return; }
        if (hipFuncSetAttribute((const void*)mk_fwd, hipFuncAttributeMaxDynamicSharedMemorySize, LDS_BYTES) != hipSuccess) { fprintf(stderr, "kernel_launch: hipFuncSetAttribute failed\n"); ready = -1; return; }
        int per_cu = 0, dev = 0, cus = 0; hipGetDevice(&dev); hipDeviceGetAttribute(&cus, hipDeviceAttributeMultiprocessorCount, dev);
        hipOccupancyMaxActiveBlocksPerMultiprocessor(&per_cu, (const void*)mk_fwd, 512, LDS_BYTES);
        if (per_cu < 1 || cus < 256) { fprintf(stderr, "kernel_launch: occupancy %d blocks/CU on %d CUs; need >= 1 on 256\n", per_cu, cus); ready = -1; (void)hipGetLastError(); return; }
        ready = 1;
    }
    if (ready < 0) return;
    hipMemsetAsync((char*)d_ws + OFF_CTL, 0, CTL_BYTES, stream);
    Params p{};
    for (int i = 0; i < 32; ++i) p.in[i] = (const float*)d_in[i];
    p.out = (float*)d_out; p.ws = (unsigned char*)d_ws;
#if MK_N_LAUNCH_PER_PHASE
    for (int ph = 0; ph < NPHASE; ++ph) { p.ph_lo = ph; p.ph_hi = ph + 1; hipLaunchKernelGGL(mk_fwd, dim3(256), dim3(512), LDS_BYTES, stream, p); }
#else
    p.ph_lo = 0; p.ph_hi = NPHASE;
    void* args[] = {&p};
    hipError_t e = hipLaunchCooperativeKernel((const void*)mk_fwd, dim3(256), dim3(512), args, LDS_BYTES, stream);
    if (e != hipSuccess) fprintf(stderr, "cooperative launch failed: %s\n", hipGetErrorString(e));
#endif
}
```

```cpp
#include <hip/hip_runtime.h>
#include <cstdio>
#include <cstdint>

#define LAS __attribute__((address_space(3)))
typedef unsigned short bf16_t;
typedef short bf16x8 __attribute__((ext_vector_type(8)));
typedef short s16x4 __attribute__((ext_vector_type(4)));
typedef float f32x4 __attribute__((ext_vector_type(4)));
typedef float f32x2 __attribute__((ext_vector_type(2)));
typedef unsigned u32x4 __attribute__((ext_vector_type(4)));
typedef unsigned u32x2 __attribute__((ext_vector_type(2)));
typedef int i32x8 __attribute__((ext_vector_type(8)));
typedef int i32x4 __attribute__((ext_vector_type(4)));

#ifndef DBL_MASK
#define DBL_MASK 0
#endif
#ifndef MK_N_LAUNCH_PER_PHASE
#define MK_N_LAUNCH_PER_PHASE 0
#endif

constexpr int NTOK = 16384, SEQ = 2048, INC = 7680;
constexpr int C_K = 512, C_V = 1024, C_ZW = 1536, C_DQ = 1792, C_DK = 2560, C_DV = 3328, C_MQ = 4096, C_GATE = 4608;
constexpr int NPHASE = 14;
constexpr int NSLOT_MAX = 65536 + 32 * 256;

constexpr size_t MiB = 1ull << 20;
constexpr size_t OFF_CTL = 0;
constexpr size_t CTL_BYTES = 32768;
constexpr size_t CTL_CNT = 16384;
constexpr size_t CTL_CUR = 16384 + 256;
constexpr size_t CTL_KEEP = 20480;
constexpr size_t OFF_TOPE = 1 * MiB;
constexpr size_t OFF_TOPG = 1 * MiB + 262144;
constexpr size_t OFF_SLOT = 1 * MiB + 524288;
constexpr size_t OFF_STOK = 2 * MiB;
constexpr size_t OFF_WRT = 3 * MiB;
constexpr size_t OFF_WINT = 4 * MiB, OFF_WMKVT = 19 * MiB, OFF_LORAT = 21 * MiB, OFF_PRT = 22 * MiB, OFF_PDT = 23 * MiB, OFF_PMT = 24 * MiB, OFF_WOT = 25 * MiB;
constexpr size_t OFF_WIN8 = 8 * MiB;
constexpr size_t OFF_H8 = 539 * MiB;
constexpr size_t OFF_YCAT = 223 * MiB;
constexpr size_t OFF_PCAT = 22 * MiB;
constexpr size_t OFF_W1T = 27 * MiB, OFF_W2T = 155 * MiB, OFF_KV = 219 * MiB, OFF_YM = 223 * MiB, OFF_YR = 239 * MiB, OFF_YD = 255 * MiB, OFF_Z = 263 * MiB;
constexpr size_t OFF_H = 503 * MiB, OFF_HM = 535 * MiB, OFF_ALORA = 503 * MiB, OFF_L = 511 * MiB, OFF_REC = 607 * MiB;
constexpr size_t OFF_GF = OFF_REC;
constexpr size_t OFF_LW = OFF_REC + 64 * MiB;
constexpr size_t OFF_VB = OFF_REC + 96 * MiB;
constexpr size_t OFF_GTF = OFF_REC + 112 * MiB;
constexpr size_t OFF_RTF = OFF_REC + 144 * MiB;
constexpr size_t OFF_HHF = OFF_REC + 160 * MiB;
constexpr size_t OFF_YLF = OFF_REC + 192 * MiB;
constexpr size_t OFF_C1 = 816 * MiB, OFF_C2 = 832 * MiB, OFF_YRAW = 848 * MiB, OFF_DILO = 880 * MiB, OFF_LSE = 928 * MiB;
constexpr size_t OFF_MIX32 = 503 * MiB, OFF_MIXBF = 567 * MiB, OFF_XN2 = 503 * MiB, OFF_XS = 263 * MiB, OFF_ACT = 607 * MiB, OFF_YS = 407 * MiB;
constexpr size_t OFF_X1B = 263 * MiB;
constexpr size_t OFF_STOKE = 296 * MiB;
constexpr size_t OFF_POS = 2 * MiB;
constexpr size_t WS_NEED = 929 * MiB;

constexpr int LDS_BYTES = 160 * 1024;
constexpr int LDS_X = LDS_BYTES - 4096;
constexpr int LX_TSTART = LDS_X + 64;
constexpr int LX_SBASE = LDS_X + 256;
constexpr int LX_CNT = LDS_X + 512;
constexpr int LX_HIST = LDS_X + 768;
constexpr int LX_BBASE = LDS_X + 1024;
constexpr int LX_SLOTL = LDS_X + 2048;
constexpr int LX_TEXP = LDS_X + 3072;

struct Params { const float* in[32]; float* out; unsigned char* ws; int ph_lo, ph_hi; };
typedef const Params __attribute__((address_space(4))) KParams;
__device__ __forceinline__ KParams* kparams() { KParams* kp = (KParams*)__builtin_amdgcn_kernarg_segment_ptr(); asm volatile("" : "+s"(kp)); return kp; }

typedef __bf16 bf16x2_t __attribute__((ext_vector_type(2)));
__device__ __forceinline__ unsigned cvt_pk_bf16(float lo, float hi) { f32x2 v = {lo, hi}; bf16x2_t b = __builtin_convertvector(v, bf16x2_t); unsigned r; __builtin_memcpy(&r, &b, 4); return r; }
__device__ __forceinline__ unsigned pack4_fp8(float a, float b, float c, float d) { int r = __builtin_amdgcn_cvt_pk_fp8_f32(a, b, 0, false); r = __builtin_amdgcn_cvt_pk_fp8_f32(c, d, r, true); return (unsigned)r; }
__device__ __forceinline__ float bf_lo(unsigned u) { return __uint_as_float(u << 16); }
__device__ __forceinline__ float bf_hi(unsigned u) { return __uint_as_float(u & 0xffff0000u); }
__device__ __forceinline__ int lane_id() { int l; asm volatile("v_mbcnt_lo_u32_b32 %0, -1, 0\n\tv_mbcnt_hi_u32_b32 %0, -1, %0" : "=v"(l)); return l; }
__device__ __forceinline__ int sxor(int x, int m) { return __builtin_amdgcn_ds_bpermute((lane_id() ^ m) << 2, x); }
__device__ __forceinline__ float sxor(float x, int m) { return __int_as_float(__builtin_amdgcn_ds_bpermute((lane_id() ^ m) << 2, __float_as_int(x))); }
template <int CTRL> __device__ __forceinline__ float dpp_f(float x) { return __int_as_float(__builtin_amdgcn_update_dpp(0, __float_as_int(x), CTRL, 0xF, 0xF, true)); }
__device__ __forceinline__ float red4(float x) { x += dpp_f<0xB1>(x); x += dpp_f<0x4E>(x); return x; }
__device__ __forceinline__ float red8(float x) { x = red4(x); x += dpp_f<0x141>(x); return x; }
__device__ __forceinline__ float red16(float x) { x = red8(x); x += dpp_f<0x140>(x); return x; }
__device__ __forceinline__ float red64(float x) { x = red16(x); x += sxor(x, 16); x += sxor(x, 32); return x; }
__device__ __forceinline__ int opaque_tid(const int wv) { int t = (wv << 6) | lane_id(); asm volatile("" : "+v"(t)); return t; }
__device__ __forceinline__ f32x4 zero4f() { float z = 0.f; asm volatile("" : "+v"(z)); return (f32x4){z, z, z, z}; }
__device__ __forceinline__ u32x4 zero4u() { unsigned z = 0u; asm volatile("" : "+v"(z)); return (u32x4){z, z, z, z}; }
__device__ __forceinline__ float sigmoidf_(float x) { return __builtin_amdgcn_rcpf(1.0f + __builtin_amdgcn_exp2f(-1.44269504f * x)); }
__device__ __forceinline__ void unpack8(const u32x4 v, float (&f)[8]) { f[0] = bf_lo(v.x); f[1] = bf_hi(v.x); f[2] = bf_lo(v.y); f[3] = bf_hi(v.y); f[4] = bf_lo(v.z); f[5] = bf_hi(v.z); f[6] = bf_lo(v.w); f[7] = bf_hi(v.w); }
__device__ __forceinline__ u32x4 pack8(const float (&f)[8]) { u32x4 w; w.x = cvt_pk_bf16(f[0], f[1]); w.y = cvt_pk_bf16(f[2], f[3]); w.z = cvt_pk_bf16(f[4], f[5]); w.w = cvt_pk_bf16(f[6], f[7]); return w; }
__device__ __forceinline__ float sumsq8(const u32x4 v) { float f[8]; unpack8(v, f); float s = 0.f;
#pragma unroll
    for (int j = 0; j < 8; ++j) s += f[j] * f[j];
    return s; }
__device__ __forceinline__ u32x4 scale8(const u32x4 v, const float rs, const float* w) { float f[8]; unpack8(v, f); const f32x4 w0 = *(const f32x4*)w, w1 = *(const f32x4*)(w + 4);
    f[0] *= rs * w0[0]; f[1] *= rs * w0[1]; f[2] *= rs * w0[2]; f[3] *= rs * w0[3]; f[4] *= rs * w1[0]; f[5] *= rs * w1[1]; f[6] *= rs * w1[2]; f[7] *= rs * w1[3]; return pack8(f); }
__device__ __forceinline__ u32x4 scale8r(const u32x4 v, const float rs, const float (&w)[8]) { float f[8]; unpack8(v, f);
#pragma unroll
    for (int j = 0; j < 8; ++j) f[j] *= rs * w[j];
    return pack8(f); }
__device__ __forceinline__ u32x4 scale8s(const u32x4 v, const float rs) { float f[8]; unpack8(v, f);
#pragma unroll
    for (int j = 0; j < 8; ++j) f[j] *= rs;
    return pack8(f); }
__device__ __forceinline__ void unpack4(const u32x2 v, float (&f)[4]) { f[0] = bf_lo(v.x); f[1] = bf_hi(v.x); f[2] = bf_lo(v.y); f[3] = bf_hi(v.y); }

#define XB_TMO      128
#define XB_XCNT(j)  (256  + 64 * (j))
#define XB_XSUB(j)  (1280 + 64 * (j))
#define XB_XGEN(j)  (2304 + 64 * (j))
#define XB_TOP      3328
#define XB_TOPGEN   3392
#define XCD_BAR_WORDS 3456
#define XB_SPIN_CAP (1u << 22)
__device__ __forceinline__ unsigned xb_ld(unsigned* p)              { return __hip_atomic_load(p, __ATOMIC_RELAXED, __HIP_MEMORY_SCOPE_AGENT); }
__device__ __forceinline__ unsigned xb_add(unsigned* p, unsigned v) { return __hip_atomic_fetch_add(p, v, __ATOMIC_RELAXED, __HIP_MEMORY_SCOPE_AGENT); }
__device__ __forceinline__ unsigned xb_xcc_id() { return (unsigned)__builtin_amdgcn_s_getreg((3 << 11) | 20) & 0xFu; }
#define XB_SPIN(cond, bar) do { unsigned _sp = 0; while (cond) { __builtin_amdgcn_s_sleep(1); \
    if ((++_sp & 255u) == 0u) { if (xb_ld(&(bar)[XB_TMO])) break; if (_sp > XB_SPIN_CAP) { atomicAdd(&(bar)[XB_TMO], 1u); break; } } } } while (0)
struct XcdBarrier { unsigned* bar; unsigned x; volatile LAS unsigned* st; };
__device__ __forceinline__ XcdBarrier xcd_barrier_post(unsigned* bar, volatile LAS unsigned* st, const int wv) {
    XcdBarrier b; b.bar = bar; b.x = xb_xcc_id(); b.st = st;
    if (wv == 0 && lane_id() == 0) (void)xb_add(&bar[XB_XCNT(b.x)], 1u);
    return b;
}
__device__ __forceinline__ void xcd_barrier_complete(unsigned* bar, unsigned x, unsigned& nloc, unsigned& nx) {
    const unsigned G = gridDim.x * gridDim.y * gridDim.z;
    unsigned sum, cnt, mine, sp = 0u;
    for (;;) {
        sum = 0u; cnt = 0u; mine = 0u;
#pragma unroll
        for (unsigned j = 0; j < 16; ++j) { const unsigned c = xb_ld(&bar[XB_XCNT(j)]); sum += c; cnt += (c > 0u) ? 1u : 0u; mine = (j == x) ? c : mine; }
        if (sum == G) break;
        __builtin_amdgcn_s_sleep(1);
        if ((++sp & 255u) == 0u) { if (xb_ld(&bar[XB_TMO])) break; if (sp > XB_SPIN_CAP) { atomicAdd(&bar[XB_TMO], 1u); break; } }
    }
    nloc = mine > 0u ? mine : 1u; nx = cnt > 0u ? cnt : 1u;
}
__device__ __forceinline__ void xcd_barrier(const XcdBarrier& b, const int wv) {
    asm volatile("s_waitcnt vmcnt(0)" ::: "memory");
    __syncthreads();
    if (wv == 0 && lane_id() == 0) {
        unsigned* bar = b.bar;
        __builtin_amdgcn_s_waitcnt(0);
        unsigned nloc = b.st[0], nx = b.st[1];
        if (nloc == 0u) { xcd_barrier_complete(bar, b.x, nloc, nx); b.st[0] = nloc; b.st[1] = nx; }
        const unsigned old = xb_add(&bar[XB_XSUB(b.x)], 1u);
        const unsigned gen = old / nloc;
        if (old + 1u == (gen + 1u) * nloc) {
            __builtin_amdgcn_fence(__ATOMIC_RELEASE, "agent");
            asm volatile("s_waitcnt vmcnt(0)" ::: "memory");
            const unsigned og = xb_add(&bar[XB_TOP], 1u);
            const unsigned tg = og / nx;
            if (og + 1u == (tg + 1u) * nx) xb_add(&bar[XB_TOPGEN], 1u);
            else XB_SPIN(xb_ld(&bar[XB_TOPGEN]) == tg, bar);
            __builtin_amdgcn_fence(__ATOMIC_ACQUIRE, "agent");
            xb_add(&bar[XB_XGEN(b.x)], 1u);
            asm volatile("s_waitcnt vmcnt(0)" ::: "memory");
        } else {
            XB_SPIN(xb_ld(&bar[XB_XGEN(b.x)]) == gen, bar);
            __builtin_amdgcn_fence(__ATOMIC_ACQUIRE, "agent");
            asm volatile("s_waitcnt vmcnt(0)" ::: "memory");
        }
    }
    __syncthreads();
}

#ifndef MFMA_BENCH
#define MFMA_BENCH 0
#endif
#ifndef EDBL
#define EDBL 0
#endif
#ifndef KMODE
#define KMODE 0
#endif
#ifndef KDBL
#define KDBL 0
#endif
struct EpiSwiglu; struct EpiYs; struct EpiZ; struct EpiMixCat; struct EpiX1;
namespace pg8 {
constexpr int BM = 256, BK = 64, HALF = 128, HTB = HALF * BK * 2, STAGE_BYTES = 8 * HTB, NXCD = 8, WGM = 8;
__host__ __device__ __forceinline__ int lds_byte(int r, int c) { const int st = (r >> 4) * 2 + (c >> 5), rr = r & 15, cc = c & 31, ob = rr * 64 + cc * 2; return st * 1024 + (ob ^ (((ob >> 9) & 1) << 5)); }
__host__ __device__ __forceinline__ void stage_rc(int b, int& R, int& C) { const int st = b / 1024, sb = b % 1024, swz = sb ^ (((sb >> 9) & 1) << 5); R = (st >> 1) * 16 + swz / 64; C = (st & 1) * 32 + (swz % 64) / 2; }
__host__ __device__ __forceinline__ int perm32(int rho) { const int n = rho >> 4, i = rho & 15; return 8 * (i >> 2) + 4 * n + (i & 3); }
struct Unit { int pm, pn, tag; const char* pa; const char* pb; };

__device__ __forceinline__ void static_map(long L, int nM, int nN, int& pm, int& pn) {
    const int nwg = nM * nN; int wgid = (int)L;
    { const int q = nwg / NXCD, r = nwg % NXCD, xcd = wgid % NXCD, off = wgid / NXCD; wgid = (xcd < r ? xcd * (q + 1) : r * (q + 1) + (xcd - r) * q) + off; }
    const int nig = WGM * nN, gid = wgid / nig, fm = gid * WGM, gsz = (nM - fm) < WGM ? (nM - fm) : WGM;
    pm = fm + ((wgid % nig) % gsz); pn = (wgid % nig) / gsz;
}
struct DenseOrder {
    static constexpr bool GATHER = false; __device__ __forceinline__ unsigned a_off(const Unit&, int, int, int, int) const { return 0u; }
    const char* A; const char* Bt; int nM, nN, G, c; size_t tstep;
    __device__ __forceinline__ void init(const void* A_, const void* Bt_, int M, int N, int K) { A = (const char*)A_; Bt = (const char*)Bt_; nM = M / BM; nN = N / BM; G = gridDim.x; c = blockIdx.x; tstep = (size_t)BM * K * 2; }
    __device__ __forceinline__ bool next(int i, Unit& u) const {
        const long L = (long)i * G + c; if (L >= (long)nM * nN) return false;
        static_map(L, nM, nN, u.pm, u.pn); u.tag = 0; u.pa = A + (size_t)u.pm * tstep; u.pb = Bt + (size_t)u.pn * tstep; return true;
    }
};

template <int H> __device__ __forceinline__ bf16x8 half8(const i32x8 v) { const i32x4 x = H ? __builtin_shufflevector(v, v, 4, 5, 6, 7) : __builtin_shufflevector(v, v, 0, 1, 2, 3); bf16x8 r; __builtin_memcpy(&r, &x, 16); return r; }
template <class Epi, class Sched, int ES = 2>
__device__ __forceinline__ void gemm_phase(const int wv, LAS unsigned char* lds, const int K, const Sched& S, const Epi& E) {
    int tid_ = (wv << 6) | lane_id(); asm volatile("" : "+v"(tid_));
    const int tid = tid_, wid = __builtin_amdgcn_readfirstlane(tid >> 6), lane = tid & 63, wr = wid >> 2, wc = wid & 3, fr = lane & 15, fq = lane >> 4;
    const int nt = K * ES / (BK * 2);
    unsigned voffA[2], voffB[2]; int RA[2], CA[2];
#pragma unroll
    for (int i = 0; i < 2; ++i) { int R, C; stage_rc(tid * 16 + i * 8192, R, C); const int Rb = Epi::PERM ? ((R & ~31) + perm32(R & 31)) : R; RA[i] = R; CA[i] = C;
        voffA[i] = (unsigned)(R * K * ES + C * 2); voffB[i] = (unsigned)(Rb * K * ES + C * 2); }
    unsigned vA[2][2][2];
    const size_t kstep = (size_t)(BK * 2);
    const size_t hstep = (size_t)HALF * K * ES;
    const unsigned ldsw = (unsigned)wid * 1024u;
    const int aoff = lds_byte(wr * 64 + fr, fq * 8), boff = lds_byte(wc * 32 + fr, fq * 8);
#define PG8_SA(b, h) (((b) * 2 + (h)) * HTB)
#define PG8_SB(b, h) ((4 + (b) * 2 + (h)) * HTB)
#define PG8_STAGE(bufoff, gbase, voff) do { _Pragma("unroll") for (int _i = 0; _i < 2; ++_i) \
        __builtin_amdgcn_global_load_lds((const unsigned*)((const char*)(gbase) + (voff)[_i]), (LAS unsigned*)(lds + (bufoff) + ldsw + _i * 8192), 16, 0, 0); } while (0)
#define PG8_LDA(dst, b, h) do { _Pragma("unroll") for (int m = 0; m < 4; ++m) { const i32x4 _lo = *(const LAS i32x4*)(lds + PG8_SA(b, h) + aoff + m * 2048), _hi = *(const LAS i32x4*)(lds + PG8_SA(b, h) + aoff + m * 2048 + 1024); dst[m] = __builtin_shufflevector(_lo, _hi, 0, 1, 2, 3, 4, 5, 6, 7); } } while (0)
#define PG8_LDB(dst, b, h) do { _Pragma("unroll") for (int n = 0; n < 2; ++n) { const i32x4 _lo = *(const LAS i32x4*)(lds + PG8_SB(b, h) + boff + n * 2048), _hi = *(const LAS i32x4*)(lds + PG8_SB(b, h) + boff + n * 2048 + 1024); dst[n] = __builtin_shufflevector(_lo, _hi, 0, 1, 2, 3, 4, 5, 6, 7); } } while (0)
#define PG8_MMA(ai, bj, At, Bt) do { __builtin_amdgcn_s_setprio(1); _Pragma("unroll") for (int m = 0; m < 4; ++m) _Pragma("unroll") for (int n = 0; n < 2; ++n) { \
        if (ES == 2) { acc[ai][bj][m][n] = __builtin_amdgcn_mfma_f32_16x16x32_bf16(half8<0>(Bt[n]), half8<0>(At[m]), acc[ai][bj][m][n], 0, 0, 0); \
                       acc[ai][bj][m][n] = __builtin_amdgcn_mfma_f32_16x16x32_bf16(half8<1>(Bt[n]), half8<1>(At[m]), acc[ai][bj][m][n], 0, 0, 0); } \
        else asm volatile("v_mfma_scale_f32_16x16x128_f8f6f4 %0, %1, %2, %0, %3, %3 op_sel_hi:[0,0,0]" : "+v"(acc[ai][bj][m][n]) : "v"(Bt[n]), "v"(At[m]), "v"(one_scale)); } \
        __builtin_amdgcn_s_setprio(0); } while (0)
#define PG8_WAIT_V(n) asm volatile("s_waitcnt vmcnt(" #n ")" ::: "memory")
#define PG8_WAIT_L(n) asm volatile("s_waitcnt lgkmcnt(" #n ")" ::: "memory")
#define PG8_BAR __builtin_amdgcn_s_barrier()
#define PG8_SCHED __builtin_amdgcn_sched_barrier(0)
    constexpr int kd = (KDBL == 1 && (__is_same(Epi, EpiSwiglu) || __is_same(Epi, EpiYs))) || (KDBL == 2 && __is_same(Epi, EpiZ)) || (KDBL == 3 && (__is_same(Epi, EpiMixCat) || __is_same(Epi, EpiX1))) ? 1 : 0;
    Unit cur, nxt; int ui = 0;
    if (!S.next(0, cur)) return;
    f32x4 acc[2][2][4][2]; const f32x4 zz0 = zero4f();
#pragma unroll
    for (int a = 0; a < 2; ++a)
#pragma unroll
        for (int b = 0; b < 2; ++b)
#pragma unroll
            for (int m = 0; m < 4; ++m)
#pragma unroll
                for (int n = 0; n < 2; ++n) acc[a][b][m][n] = zz0;
    i32x8 At[4], B0[2], B1[2];
    const int one_scale = 0x7f7f7f7f;
    const char* cA = cur.pa; const char* cB = cur.pb;
#pragma unroll
    for (int h = 0; h < 2; ++h)
#pragma unroll
        for (int i = 0; i < 2; ++i) vA[0][h][i] = Sched::GATHER ? S.a_off(cur, h, RA[i], CA[i], K * ES) : voffA[i] + (unsigned)(h * hstep);
    if constexpr (kd && KMODE == 1) { cA = S.A; cB = S.Bt;
#pragma unroll
        for (int h = 0; h < 2; ++h)
#pragma unroll
            for (int i = 0; i < 2; ++i) vA[0][h][i] = voffA[i] + (unsigned)(h * hstep); }
    PG8_STAGE(PG8_SB(0, 0), cB, voffB); PG8_STAGE(PG8_SA(0, 0), cA, vA[0][0]); PG8_STAGE(PG8_SB(0, 1), cB + hstep, voffB); PG8_STAGE(PG8_SA(0, 1), cA, vA[0][1]);
    if (wr == 1) PG8_BAR;
    PG8_WAIT_V(4); PG8_BAR;
    PG8_STAGE(PG8_SB(1, 0), cB + kstep, voffB); PG8_STAGE(PG8_SA(1, 0), cA + kstep, vA[0][0]); PG8_STAGE(PG8_SB(1, 1), cB + hstep + kstep, voffB);
    PG8_WAIT_V(6); PG8_BAR;
    for (;;) {
        const bool has_next = S.next((ui + 1) >> kd, nxt);
        const char* nA = has_next ? nxt.pa : cA; const char* nB = has_next ? nxt.pb : cB;
#pragma unroll
        for (int h = 0; h < 2; ++h)
#pragma unroll
            for (int i = 0; i < 2; ++i) vA[1][h][i] = has_next ? (Sched::GATHER ? S.a_off(nxt, h, RA[i], CA[i], K * ES) : voffA[i] + (unsigned)(h * hstep)) : vA[0][h][i];
        if constexpr (kd && KMODE == 1) { if (has_next && (ui & 1)) { nA = S.A; nB = S.Bt;
#pragma unroll
            for (int h = 0; h < 2; ++h)
#pragma unroll
                for (int i = 0; i < 2; ++i) vA[1][h][i] = voffA[i] + (unsigned)(h * hstep); } }
        const bool ld = !(kd && KMODE == 2 && !(ui & 1));
#pragma clang loop unroll(disable)
        for (int t = 0; t < nt; t += 2) {
            if constexpr (Epi::MID) { if (t == 8 || t == 12) E.mid(acc, cur, t, wr, wc, fr, fq); }
            const bool last = (t == nt - 2);
            const char* a1 = cA + (size_t)(t + 1) * kstep;
            const char* a2 = last ? nA : cA + (size_t)(t + 2) * kstep; const char* b2 = last ? nB : cB + (size_t)(t + 2) * kstep;
            const char* a3 = a2 + kstep; const char* b3 = b2 + kstep;
            unsigned w0[2], w1[2];
#pragma unroll
            for (int i = 0; i < 2; ++i) { w0[i] = vA[0][0][i]; w1[i] = vA[0][1][i]; }
            if (last) { asm volatile("" ::: "memory");
#pragma unroll
                for (int i = 0; i < 2; ++i) { w0[i] = vA[1][0][i]; w1[i] = vA[1][1][i]; } }
            PG8_LDB(B0, 0, 0); PG8_SCHED; PG8_LDA(At, 0, 0); if (ld) PG8_STAGE(PG8_SA(1, 1), a1, vA[0][1]);
            PG8_WAIT_L(8); PG8_BAR; PG8_WAIT_L(0); PG8_MMA(0, 0, At, B0); PG8_BAR; PG8_SCHED;
            PG8_LDB(B1, 0, 1); if (ld || last) PG8_STAGE(PG8_SB(0, 0), b2, voffB);
            PG8_BAR; PG8_WAIT_L(0); PG8_MMA(0, 1, At, B1); PG8_BAR;
            PG8_LDA(At, 0, 1); if (ld || last) PG8_STAGE(PG8_SA(0, 0), a2, w0);
            PG8_BAR; PG8_WAIT_L(0); PG8_MMA(1, 0, At, B0); PG8_BAR; PG8_SCHED;
            if (ld || last) PG8_STAGE(PG8_SB(0, 1), b2 + hstep, voffB);
            PG8_WAIT_V(6); PG8_BAR; PG8_MMA(1, 1, At, B1); PG8_BAR;
            PG8_LDB(B0, 1, 0); PG8_SCHED; PG8_LDA(At, 1, 0); if (ld || last) PG8_STAGE(PG8_SA(0, 1), a2, w1);
            PG8_WAIT_L(8); PG8_BAR; PG8_WAIT_L(0); PG8_MMA(0, 0, At, B0); PG8_BAR; PG8_SCHED;
            PG8_LDB(B1, 1, 1); if (ld || last) PG8_STAGE(PG8_SB(1, 0), b3, voffB);
            PG8_BAR; PG8_WAIT_L(0); PG8_MMA(0, 1, At, B1); PG8_BAR;
            PG8_LDA(At, 1, 1); if (ld || last) PG8_STAGE(PG8_SA(1, 0), a3, w0);
            PG8_BAR; PG8_WAIT_L(0); PG8_MMA(1, 0, At, B0); PG8_BAR; PG8_SCHED;
            if (ld || last) PG8_STAGE(PG8_SB(1, 1), b3 + hstep, voffB);
            PG8_WAIT_V(6); PG8_BAR; PG8_MMA(1, 1, At, B1); PG8_BAR;
        }
        if (ES == 1) asm volatile("s_nop 15\n\ts_nop 15" ::: "memory");
        if (!kd || (ui & 1)) E(acc, cur, wr, wc, fr, fq);
        if constexpr (EDBL == 1 && (__is_same(Epi, EpiSwiglu) || __is_same(Epi, EpiYs))) { asm volatile("" ::: "memory"); E(acc, cur, wr, wc, fr, fq); }
        if (!has_next) break;
        const f32x4 zz1 = zero4f();
#pragma unroll
        for (int a = 0; a < 2; ++a)
#pragma unroll
            for (int b = 0; b < 2; ++b)
#pragma unroll
                for (int m = 0; m < 4; ++m)
#pragma unroll
                    for (int n = 0; n < 2; ++n) acc[a][b][m][n] = zz1;
        cur = nxt; cA = nA; cB = nB; ++ui;
#pragma unroll
        for (int h = 0; h < 2; ++h)
#pragma unroll
            for (int i = 0; i < 2; ++i) vA[0][h][i] = vA[1][h][i];
    }
    PG8_WAIT_V(0);
    if (wr == 0) PG8_BAR;
    PG8_BAR;
#undef PG8_SA
#undef PG8_SB
#undef PG8_STAGE
#undef PG8_LDA
#undef PG8_LDB
#undef PG8_MMA
#undef PG8_WAIT_V
#undef PG8_WAIT_L
#undef PG8_BAR
#undef PG8_SCHED
}
}
using pg8::Unit;

struct EpiZ {
    static constexpr bool PERM = true, MID = false;
    bf16_t* Z; bf16_t* KV; bf16_t* GFp; int pn0; float scale;
    __device__ __forceinline__ void operator()(const f32x4 (&acc)[2][2][4][2], const Unit& u, int wr, int wc, int fr, int fq) const {
        const bool kvu = u.pn >= 32; const int pn = (u.pn & 31) + (kvu ? 0 : pn0);
        bf16_t* base = kvu ? KV : Z; const int ldc = kvu ? 1024 : INC; const bool sg = (!kvu) && (pn >= C_GATE / 256);
        if (sg) {
            bf16_t* gf = GFp + ((size_t)(u.pm * 12 + (pn - C_GATE / 256)) * 16) * 4096 + (size_t)((wr * 4 + wc) * 64 + fq * 16 + fr) * 8;
#pragma unroll
            for (int ai = 0; ai < 2; ++ai)
#pragma unroll
                for (int m = 0; m < 4; ++m)
#pragma unroll
                    for (int bj = 0; bj < 2; ++bj) { f32x4 v0 = acc[ai][bj][m][0] * scale, v1 = acc[ai][bj][m][1] * scale;
#pragma unroll
                        for (int j = 0; j < 4; ++j) { v0[j] = sigmoidf_(v0[j]); v1[j] = sigmoidf_(v1[j]); }
                        u32x4 w; w.x = cvt_pk_bf16(v0[0], v0[1]); w.y = cvt_pk_bf16(v0[2], v0[3]); w.z = cvt_pk_bf16(v1[0], v1[1]); w.w = cvt_pk_bf16(v1[2], v1[3]);
                        *(u32x4*)(gf + (size_t)((ai * 4 + m) * 2 + bj) * 4096) = w; }
            return; }
        const int row0 = u.pm * 256 + wr * 64 + fr, col0 = pn * 256 + wc * 32 + 8 * fq;
#pragma unroll
        for (int ai = 0; ai < 2; ++ai)
#pragma unroll
            for (int m = 0; m < 4; ++m) { bf16_t* rowp = base + (size_t)(row0 + ai * 128 + m * 16) * ldc + col0;
#pragma unroll
                for (int bj = 0; bj < 2; ++bj) { f32x4 v0 = acc[ai][bj][m][0] * scale, v1 = acc[ai][bj][m][1] * scale;
                    if (sg) {
#pragma unroll
                        for (int j = 0; j < 4; ++j) { v0[j] = sigmoidf_(v0[j]); v1[j] = sigmoidf_(v1[j]); } }
                    u32x4 w; w.x = cvt_pk_bf16(v0[0], v0[1]); w.y = cvt_pk_bf16(v0[2], v0[3]); w.z = cvt_pk_bf16(v1[0], v1[1]); w.w = cvt_pk_bf16(v1[2], v1[3]);
                    *(u32x4*)(rowp + bj * 128) = w; } }
    }
};
struct SchedZ8 {
    static constexpr bool GATHER = false; __device__ __forceinline__ unsigned a_off(const Unit&, int, int, int, int) const { return 0u; }
    const char* H8; const char* WIN8; int G, c;
    __device__ __forceinline__ bool next(int i, Unit& u) const {
        const long L = (long)i * G + c; if (L >= 64 * 23) return false;
        pg8::static_map(L, 64, 23, u.pm, u.pn); u.tag = 0; u.pa = H8 + (size_t)u.pm * (256 * 1024); u.pb = WIN8 + (size_t)u.pn * (256 * 1024); return true;
    }
};
struct SchedZ {
    static constexpr bool GATHER = false; __device__ __forceinline__ unsigned a_off(const Unit&, int, int, int, int) const { return 0u; }
    const char* H; const char* WinT; const char* HM; const char* WmkvT; int G, c;
    __device__ __forceinline__ bool next(int i, Unit& u) const {
        const long L = (long)i * G + c; if (L >= 480) return false;
        const size_t tstep = (size_t)256 * 1024 * 2;
        if (L < 448) { pg8::static_map(L, 64, 7, u.pm, u.pn); u.tag = 0; u.pa = H + (size_t)u.pm * tstep; u.pb = WinT + (size_t)u.pn * tstep; }
        else { const int q = (int)(L - 448); u.pm = q >> 2; u.pn = 32 + (q & 3); u.tag = 0; u.pa = HM + (size_t)u.pm * tstep; u.pb = WmkvT + (size_t)(q & 3) * tstep; }
        return true;
    }
};
struct EpiLora {
    static constexpr bool PERM = false, MID = false;
    float* L; const float* w0; const float* a0;
    __device__ __forceinline__ void operator()(const f32x4 (&acc)[2][2][4][2], const Unit& u, int wr, int wc, int fr, int fq) const {
        const int row0 = u.pm * 256 + wr * 64 + fr, col0 = u.pn * 256 + wc * 32 + 4 * fq; const int kind = u.pn >> 1; const f32x4 zb = zero4f();
#pragma unroll
        for (int bj = 0; bj < 2; ++bj)
#pragma unroll
            for (int n = 0; n < 2; ++n) { const int c = col0 + bj * 128 + n * 16;
                f32x4 bv = zb;
                if (kind == 0) bv = *(const f32x4*)(w0 + c); else if (kind == 1) bv = *(const f32x4*)(a0 + (c - 512));
#pragma unroll
                for (int ai = 0; ai < 2; ++ai)
#pragma unroll
                    for (int m = 0; m < 4; ++m) { f32x4 v = acc[ai][bj][m][n] + bv;
                        if (kind == 0) {
#pragma unroll
                            for (int j = 0; j < 4; ++j) v[j] = -0.60653066f * sigmoidf_(v[j]); }
                        else if (kind == 1) {
#pragma unroll
                            for (int j = 0; j < 4; ++j) v[j] = sigmoidf_(v[j]); }
                        const size_t row = (size_t)(row0 + ai * 128 + m * 16);
                        if (kind == 0) *(f32x4*)(L + row * 512 + c) = v;
                        else { u32x2 w; w.x = cvt_pk_bf16(v[0], v[1]); w.y = cvt_pk_bf16(v[2], v[3]); *(u32x2*)((bf16_t*)(L + (size_t)NTOK * 512) + row * 1024 + (c - 512)) = w; } } }
    }
};
template <int mode> struct EpiMix {
    static constexpr bool PERM = false, MID = false;
    float* mix32; bf16_t* mixbf; const bf16_t* Z;
    __device__ __forceinline__ void operator()(const f32x4 (&acc)[2][2][4][2], const Unit& u, int wr, int wc, int fr, int fq) const {
        const int row0 = u.pm * 256 + wr * 64 + fr, col0 = u.pn * 256 + wc * 32 + 4 * fq;
#pragma unroll
        for (int ai = 0; ai < 2; ++ai)
#pragma unroll
            for (int m = 0; m < 4; ++m) { const size_t row = (size_t)(row0 + ai * 128 + m * 16);
#pragma unroll
                for (int bj = 0; bj < 2; ++bj)
#pragma unroll
                    for (int n = 0; n < 2; ++n) { const int c = col0 + bj * 128 + n * 16;
                        const u32x2 gz = *(const u32x2*)(Z + row * INC + C_GATE + mode * 1024 + c); float g[4]; unpack4(gz, g);
                        f32x4 v = acc[ai][bj][m][n]; v[0] *= g[0]; v[1] *= g[1]; v[2] *= g[2]; v[3] *= g[3];
                        if (mode > 0) v += *(const f32x4*)(mix32 + row * 1024 + c);
                        if (mode < 2) *(f32x4*)(mix32 + row * 1024 + c) = v;
                        else { u32x2 w; w.x = cvt_pk_bf16(v[0], v[1]); w.y = cvt_pk_bf16(v[2], v[3]); *(u32x2*)(mixbf + row * 1024 + c) = w; } }
                asm volatile("" ::: "memory"); }
    }
};
struct EpiMixCat {
    static constexpr bool PERM = true, MID = true;
    bf16_t* mixbf; const bf16_t* GF; int tid;
    __device__ __forceinline__ const bf16_t* gtile(const Unit& u, int b) const { return GF + ((size_t)(u.pm * 12 + 4 * b + u.pn) * 16) * 4096 + (size_t)tid * 8; }
    __device__ __forceinline__ void mid(f32x4 (&acc)[2][2][4][2], const Unit& u, int t, int wr, int wc, int fr, int fq) const {
        const int ga = (t == 8) ? 0 : 1; int off = 0; asm volatile("" : "+v"(off));
        const bf16_t* pa = gtile(u, ga) + off; const bf16_t* pb = gtile(u, ga + 1) + off;
#pragma unroll
        for (int ai = 0; ai < 2; ++ai) {
#pragma unroll
            for (int m = 0; m < 4; ++m)
#pragma unroll
                for (int bj = 0; bj < 2; ++bj) { float a[8], b[8]; unpack8(*(const u32x4*)(pa + (size_t)((ai * 4 + m) * 2 + bj) * 4096), a); unpack8(*(const u32x4*)(pb + (size_t)((ai * 4 + m) * 2 + bj) * 4096), b);
#pragma unroll
                    for (int j = 0; j < 4; ++j) { acc[ai][bj][m][0][j] *= a[j] * __builtin_amdgcn_rcpf(b[j]); acc[ai][bj][m][1][j] *= a[4 + j] * __builtin_amdgcn_rcpf(b[4 + j]); } }
            asm volatile("" ::: "memory"); }
    }
    __device__ __forceinline__ void operator()(const f32x4 (&acc)[2][2][4][2], const Unit& u, int wr, int wc, int fr, int fq) const {
        const int row0 = u.pm * 256 + wr * 64 + fr, col0 = u.pn * 256 + wc * 32 + 8 * fq; const bf16_t* pg = gtile(u, 2);
#pragma unroll
        for (int ai = 0; ai < 2; ++ai)
#pragma unroll
            for (int m = 0; m < 4; ++m) { bf16_t* rowp = mixbf + (size_t)(row0 + ai * 128 + m * 16) * 1024 + col0;
#pragma unroll
                for (int bj = 0; bj < 2; ++bj) { float g[8]; unpack8(*(const u32x4*)(pg + (size_t)((ai * 4 + m) * 2 + bj) * 4096), g);
                    const f32x4 v0 = acc[ai][bj][m][0], v1 = acc[ai][bj][m][1];
                    u32x4 w; w.x = cvt_pk_bf16(v0[0] * g[0], v0[1] * g[1]); w.y = cvt_pk_bf16(v0[2] * g[2], v0[3] * g[3]); w.z = cvt_pk_bf16(v1[0] * g[4], v1[1] * g[5]); w.w = cvt_pk_bf16(v1[2] * g[6], v1[3] * g[7]);
                    *(u32x4*)(rowp + bj * 128) = w; } }
    }
};
struct EpiX1 {
    static constexpr bool PERM = true, MID = false;
    const float* x; bf16_t* x1;
    __device__ __forceinline__ void operator()(const f32x4 (&acc)[2][2][4][2], const Unit& u, int wr, int wc, int fr, int fq) const {
        const int row0 = u.pm * 256 + wr * 64 + fr, col0 = u.pn * 256 + wc * 32 + 8 * fq;
#pragma unroll
        for (int ai = 0; ai < 2; ++ai)
#pragma unroll
            for (int m = 0; m < 4; ++m) { const size_t off = (size_t)(row0 + ai * 128 + m * 16) * 1024 + col0;
#pragma unroll
                for (int bj = 0; bj < 2; ++bj) { const f32x4 a = __builtin_nontemporal_load((const f32x4*)(x + off + bj * 128)) + acc[ai][bj][m][0], b = __builtin_nontemporal_load((const f32x4*)(x + off + bj * 128 + 4)) + acc[ai][bj][m][1];
                    u32x4 w; w.x = cvt_pk_bf16(a[0], a[1]); w.y = cvt_pk_bf16(a[2], a[3]); w.z = cvt_pk_bf16(b[0], b[1]); w.w = cvt_pk_bf16(b[2], b[3]);
                    *(u32x4*)(x1 + off + bj * 128) = w; }
                if (m & 1) asm volatile("" ::: "memory"); }
    }
};
struct EpiSwiglu {
    static constexpr bool PERM = true, MID = false;
    unsigned char* act; const float* b1;
    __device__ __forceinline__ void operator()(const f32x4 (&acc)[2][2][4][2], const Unit& u, int wr, int wc, int fr, int fq) const {
        const int row0 = u.pm * 256 + wr * 64 + fr; const float* be = b1 + (size_t)u.tag * 2048; const int j = 128 * u.pn + 32 * wc + 8 * fq;
        constexpr float CS = -1.702f * 1.44269504f, ICS = 1.0f / CS;
        float bg[8], bl[8];
#pragma unroll
        for (int q = 0; q < 4; ++q) { const f32x4 t = *(const f32x4*)(be + 2 * j + 4 * q); bg[2 * q] = t[0] * CS; bl[2 * q] = (4.0f * t[1] + 4.0f) * ICS; bg[2 * q + 1] = t[2] * CS; bl[2 * q + 1] = (4.0f * t[3] + 4.0f) * ICS; }
#pragma unroll
        for (int ai = 0; ai < 2; ++ai)
#pragma unroll
            for (int m = 0; m < 4; ++m) { float o[8];
#pragma unroll
                for (int n = 0; n < 2; ++n)
#pragma unroll
                    for (int i = 0; i < 4; ++i) { const float sg = fmaxf(fmaf(acc[ai][0][m][n][i], CS / 256.0f, bg[4 * n + i]), 7.0f * CS);
                        const float ql = __builtin_amdgcn_fmed3f(fmaf(acc[ai][1][m][n][i], 4.0f * ICS / 256.0f, bl[4 * n + i]), -24.0f * ICS, 32.0f * ICS);
                        o[4 * n + i] = sg * __builtin_amdgcn_rcpf(1.0f + __builtin_amdgcn_exp2f(sg)) * ql; }
                u32x2 w; w.x = pack4_fp8(o[0], o[1], o[2], o[3]); w.y = pack4_fp8(o[4], o[5], o[6], o[7]);
                *(u32x2*)(act + (size_t)(row0 + ai * 128 + m * 16) * 1024 + j) = w; }
    }
};
struct EpiYs {
    static constexpr bool PERM = true, MID = false;
    bf16_t* ys; const float* b2;
    __device__ __forceinline__ void operator()(const f32x4 (&acc)[2][2][4][2], const Unit& u, int wr, int wc, int fr, int fq) const {
        const int row0 = u.pm * 256 + wr * 64 + fr, col0 = u.pn * 256 + wc * 32 + 8 * fq; const float* be = b2 + (size_t)u.tag * 1024;
#pragma unroll
        for (int bj = 0; bj < 2; ++bj) { const f32x4 c0 = *(const f32x4*)(be + col0 + bj * 128), c1 = *(const f32x4*)(be + col0 + bj * 128 + 4);
#pragma unroll
            for (int ai = 0; ai < 2; ++ai)
#pragma unroll
                for (int m = 0; m < 4; ++m) { const f32x4 v0 = acc[ai][bj][m][0] * (1.0f / 128.0f) + c0, v1 = acc[ai][bj][m][1] * (1.0f / 128.0f) + c1;
                    u32x4 w; w.x = cvt_pk_bf16(v0[0], v0[1]); w.y = cvt_pk_bf16(v0[2], v0[3]); w.z = cvt_pk_bf16(v1[0], v1[1]); w.w = cvt_pk_bf16(v1[2], v1[3]);
                    *(u32x4*)(ys + (size_t)(row0 + ai * 128 + m * 16) * 1024 + col0 + bj * 128) = w; } }
    }
};
template <bool GATHER_> struct SchedMoe {
    static constexpr bool GATHER = GATHER_;
    const char* A; const char* Bt; const LAS int* tstart; const int* stok; int lgN, total; size_t estride, tbytes;
    __device__ __forceinline__ bool next(int i, Unit& u) const {
        const int c = blockIdx.x; const int un = i * 256 + (c & 7) * 32 + (c >> 3); if (un >= total) return false;
        const int mt = un >> lgN, pn = un & ((1 << lgN) - 1); const int e = ((const LAS unsigned char*)tstart)[(LX_TEXP - LX_TSTART) + mt];
        u.pm = mt; u.pn = pn; u.tag = e; u.pa = GATHER ? A : A + (size_t)mt * tbytes; u.pb = Bt + (size_t)e * estride + (size_t)pn * tbytes; return true;
    }
    __device__ __forceinline__ unsigned a_off(const Unit& u, int h, int R, int C, int rowbytes) const { const int e = u.tag, ps = u.pm * 256 + h * 128 + R - tstart[(LX_SBASE - LX_TSTART) / 4 + e];
        const int tok = ps < tstart[(LX_CNT - LX_TSTART) / 4 + e] ? stok[(size_t)e * NTOK + ps] : 0; return (unsigned)(tok * rowbytes + C * 2); }
};

__device__ __forceinline__ int w1perm(int c) { const int j = c >> 1, s = c & 1; return ((j >> 7) << 8) | (s << 7) | (j & 127); }
constexpr int NTILE = 13664, TAIL1_A = 6, TAIL1_B = 20, TAIL6 = 8, NRES1 = 32 * TAIL1_A + 32 * TAIL1_B, NRES = NRES1 + 128 * TAIL6;
template <class F> __device__ __forceinline__ void prep_tiles(const int wv, LAS unsigned char* lds, const int cnt, F tile_of) {
    KParams& p = *kparams();
    const int tid = opaque_tid(wv); unsigned char* ws = p.ws;
    LAS float* tile = (LAS float*)lds;
    if (cnt <= 0) return;
    struct TileJob { const float* src; bf16_t* dst; unsigned char* dst8; int K, N, perm, f8, ldd, k0, n0; };
    auto decode = [&](int t) -> TileJob { TileJob j; j.dst = nullptr; j.dst8 = nullptr; j.f8 = 0; j.perm = 0; j.ldd = 0; int lt;
        if (t < 960) { j.src = p.in[3]; j.dst = (bf16_t*)(ws + OFF_WINT); j.K = 1024; j.N = 7680; lt = t; if ((lt % 120) >= 28) { j.f8 = 1; j.dst8 = ws + OFF_WIN8 - (size_t)1792 * 1024; } }
        else if (t < 1088) { j.src = p.in[18]; j.dst = (bf16_t*)(ws + OFF_WMKVT); j.K = 1024; j.N = 1024; lt = t - 960; }
        else if (t < 1152) { j.src = p.in[21]; j.dst = (bf16_t*)(ws + OFF_PCAT); j.K = 512; j.N = 1024; lt = t - 1088; j.ldd = 1280; }
        else if (t < 1184) { j.src = p.in[22]; j.dst = (bf16_t*)(ws + OFF_PCAT) + 512; j.K = 256; j.N = 1024; lt = t - 1152; j.ldd = 1280; }
        else if (t < 1248) { j.src = p.in[23]; j.dst = (bf16_t*)(ws + OFF_PCAT) + 768; j.K = 512; j.N = 1024; lt = t - 1184; j.ldd = 1280; }
        else if (t < 1376) { j.src = p.in[24]; j.dst = (bf16_t*)(ws + OFF_WOT); j.K = 1024; j.N = 1024; lt = t - 1248; }
        else if (t < 9568) { const int q = t - 1376, e = q >> 8; j.src = p.in[28] + (size_t)e * 1024 * 2048; j.dst8 = ws + OFF_W1T + (size_t)e * 2048 * 1024; j.K = 1024; j.N = 2048; j.perm = 1; lt = q & 255; j.f8 = 1; }
        else { const int q = t - 9568, e = q >> 7; j.src = p.in[30] + (size_t)e * 1024 * 1024; j.dst8 = ws + OFF_W2T + (size_t)e * 1024 * 1024; j.K = 1024; j.N = 1024; lt = q & 127; j.f8 = 1; }
        const int tn = j.N >> 6; j.k0 = (lt / tn) * 128; j.n0 = (lt % tn) * 64; return j; };
    { auto ldtile = [&](const TileJob& j, f32x4 (&v)[4]) {
#pragma unroll
          for (int i = 0; i < 4; ++i) { const int idx = tid + 512 * i, row = idx >> 4, c4 = idx & 15; v[i] = __builtin_nontemporal_load((const f32x4*)(j.src + (size_t)(j.k0 + row) * j.N + j.n0 + 4 * c4)); } };
      TileJob j0 = decode(tile_of(0)), j1 = decode(tile_of(cnt > 1 ? 1 : 0)); f32x4 v0[4], v1[4];
      ldtile(j0, v0);
      if (cnt > 1) ldtile(j1, v1);
      for (int n = 0; n < cnt; ++n) {
#pragma unroll
          for (int i = 0; i < 4; ++i) { const int idx = tid + 512 * i, row = idx >> 4, c4 = idx & 15; LAS float* tp = tile + row * 65 + 4 * c4; tp[0] = v0[i][0]; tp[1] = v0[i][1]; tp[2] = v0[i][2]; tp[3] = v0[i][3]; }
          __syncthreads();
          const TileJob cur = j0; j0 = j1;
#pragma unroll
          for (int i = 0; i < 4; ++i) v0[i] = v1[i];
          if (n + 2 < cnt) { j1 = decode(tile_of(n + 2)); ldtile(j1, v1); }
          if (!cur.f8) {
#pragma unroll
              for (int i = 0; i < 2; ++i) { const int kc = (tid & 3) | (((tid >> 8) & 1) << 2) | (i << 3), n = (tid >> 2) & 63; float f[8];
#pragma unroll
                  for (int j = 0; j < 8; ++j) f[j] = tile[(kc * 8 + j) * 65 + n];
                  const int drow = cur.n0 + n;
                  *(u32x4*)(cur.dst + (size_t)drow * (cur.ldd ? cur.ldd : cur.K) + cur.k0 + kc * 8) = pack8(f); }
          } else {
              const int kc = (tid & 3) | (((tid >> 8) & 1) << 2), n = (tid >> 2) & 63; float f[16];
#pragma unroll
              for (int j = 0; j < 16; ++j) f[j] = tile[(kc * 16 + j) * 65 + n] * 32.0f;
              const int drow = cur.perm ? w1perm(cur.n0 + n) : (cur.n0 + n);
              u32x4 w; w.x = pack4_fp8(f[0], f[1], f[2], f[3]); w.y = pack4_fp8(f[4], f[5], f[6], f[7]); w.z = pack4_fp8(f[8], f[9], f[10], f[11]); w.w = pack4_fp8(f[12], f[13], f[14], f[15]);
              *(u32x4*)(cur.dst8 + (size_t)drow * cur.K + cur.k0 + kc * 16) = w; }
          __syncthreads(); } }
}
__device__ __forceinline__ void phase_prep(const int wv, LAS unsigned char* lds) {
    KParams& p = *kparams();
    const int tid = opaque_tid(wv); unsigned char* ws = p.ws;
    { const int G = (int)gridDim.x, top = NTILE - NRES - 1 - (int)blockIdx.x; prep_tiles(wv, lds, top >= 0 ? top / G + 1 : 0, [&](int n) { return top - n * G; }); }
    { const float* w2 = p.in[6]; const float* a2 = p.in[8]; const float* g2 = p.in[9]; bf16_t* lt = (bf16_t*)(ws + OFF_LORAT);
      for (int idx = blockIdx.x * 512 + tid; idx < 1536 * 32; idx += gridDim.x * 512) { const int n = idx >> 5, kc = idx & 31; float f[8];
#pragma unroll
          for (int j = 0; j < 8; ++j) { const int k = kc * 8 + j; float val = 0.f;
              if (n < 512) { if (k < 64) val = w2[k * 512 + n]; }
              else if (n < 1024) { if (k >= 64 && k < 128) val = a2[(k - 64) * 512 + (n - 512)]; }
              else { if (k >= 128) val = g2[(k - 128) * 512 + (n - 1024)]; }
              f[j] = val; }
          *(u32x4*)(lt + (size_t)n * 256 + kc * 8) = pack8(f); } }
    { const float* wr = p.in[26]; bf16_t* wt = (bf16_t*)(ws + OFF_WRT);
      for (int idx = blockIdx.x * 512 + tid; idx < 32 * 1024; idx += gridDim.x * 512) { const int e = idx >> 10, k = idx & 1023; const float v = wr[k * 32 + e];
          const unsigned hi = cvt_pk_bf16(v, 0.f) & 0xffffu; const float vh = __uint_as_float(hi << 16); const unsigned lo = cvt_pk_bf16(v - vh, 0.f) & 0xffffu;
          wt[idx] = (bf16_t)hi; wt[32768 + idx] = (bf16_t)lo; } }
    { const int wid = tid >> 6, lane = tid & 63; const int gw = blockIdx.x * 8 + wid, nw = gridDim.x * 8;
      for (int row0 = gw; row0 < NTOK + 2048; row0 += 3 * nw) {
          f32x4 v[3][4];
#pragma unroll
          for (int r3 = 0; r3 < 3; ++r3) { const int row = row0 + r3 * nw; if (row < NTOK + 2048) { const float* src = row >= NTOK ? p.in[1] + (size_t)(row - NTOK) * 1024 : p.in[0] + (size_t)row * 1024;
#pragma unroll
              for (int i = 0; i < 4; ++i) v[r3][i] = __builtin_nontemporal_load((const f32x4*)(src + 4 * lane + 256 * i)); } }
#pragma unroll
          for (int r3 = 0; r3 < 3; ++r3) { const int row = row0 + r3 * nw; if (row >= NTOK + 2048) break;
              const bool ism = row >= NTOK; const float* gain = ism ? p.in[17] : p.in[2]; bf16_t* dst = ism ? (bf16_t*)(ws + OFF_HM) + (size_t)(row - NTOK) * 1024 : (bf16_t*)(ws + OFF_H) + (size_t)row * 1024;
              float ss = 0.f;
#pragma unroll
              for (int i = 0; i < 4; ++i) ss += v[r3][i][0] * v[r3][i][0] + v[r3][i][1] * v[r3][i][1] + v[r3][i][2] * v[r3][i][2] + v[r3][i][3] * v[r3][i][3];
              ss = red64(ss); const float rs = rsqrtf(ss * (1.0f / 1024.0f) + 1e-5f);
#pragma unroll
              for (int i = 0; i < 4; ++i) { const f32x4 g = *(const f32x4*)(gain + 4 * lane + 256 * i); const f32x4 y = v[r3][i] * rs * g;
                  u32x2 w; w.x = cvt_pk_bf16(y[0], y[1]); w.y = cvt_pk_bf16(y[2], y[3]);
                  *(u32x2*)(dst + 4 * lane + 256 * i) = w;
                  if (!ism) *(unsigned*)(ws + OFF_H8 + (size_t)row * 1024 + 4 * lane + 256 * i) = pack4_fp8(y[0] * 8.0f, y[1] * 8.0f, y[2] * 8.0f, y[3] * 8.0f); } } }
    }
}

__device__ __forceinline__ void phase_elem_c(const int wv) {
    KParams& p = *kparams();
    const int gt = blockIdx.x * 512 + opaque_tid(wv), nthr = gridDim.x * 512; unsigned char* ws = p.ws;
    bf16_t* Z = (bf16_t*)(ws + OFF_Z); bf16_t* AL = (bf16_t*)(ws + OFF_ALORA); bf16_t* KV = (bf16_t*)(ws + OFF_KV);
    const float* mu = p.in[4];
    u32x4 za[4], zb[4]; const u32x4 zq0 = zero4u();
#pragma unroll
    for (int k = 0; k < 4; ++k) { const int idx = gt + k * nthr, t = idx >> 5, ch = idx & 31, col = C_ZW + 8 * ch;
        za[k] = *(const u32x4*)(Z + (size_t)t * INC + col);
        zb[k] = zq0; if ((t & (SEQ - 1)) != 0) zb[k] = *(const u32x4*)(Z + (size_t)(t - 1) * INC + col); }
#pragma unroll
    for (int k = 0; k < 4; ++k) { const int idx = gt + k * nthr, t = idx >> 5, ch = idx & 31, col = C_ZW + 8 * ch;
        float a[8], b[8]; unpack8(za[k], a); unpack8(zb[k], b);
        const f32x4 m0 = *(const f32x4*)(mu + col), m1 = *(const f32x4*)(mu + col + 4); const float mm[8] = {m0[0], m0[1], m0[2], m0[3], m1[0], m1[1], m1[2], m1[3]};
#pragma unroll
        for (int j = 0; j < 8; ++j) { float v = a[j] + (b[j] - a[j]) * mm[j]; if (ch < 8) v = tanhf(v); else if (ch >= 16) v = sigmoidf_(v); a[j] = v; }
        *(u32x4*)(AL + (size_t)t * 256 + 8 * ch) = pack8(a); }
}

__device__ __forceinline__ bf16x8 pack_frag(const f32x4 lo, const f32x4 hi) { u32x4 w; w.x = cvt_pk_bf16(lo[0], lo[1]); w.y = cvt_pk_bf16(lo[2], lo[3]); w.z = cvt_pk_bf16(hi[0], hi[1]); w.w = cvt_pk_bf16(hi[2], hi[3]); bf16x8 r; __builtin_memcpy(&r, &w, 16); return r; }
__device__ __forceinline__ bf16x8 tr2(LAS unsigned char* pa, LAS unsigned char* pb) { const s16x4 a = __builtin_amdgcn_ds_read_tr16_b64_v4i16((LAS s16x4*)pa), b = __builtin_amdgcn_ds_read_tr16_b64_v4i16((LAS s16x4*)pb); return __builtin_shufflevector(a, b, 0, 1, 2, 3, 4, 5, 6, 7); }
__device__ __forceinline__ bf16x8 rd2(LAS unsigned char* pa, LAS unsigned char* pb) { const s16x4 a = *(const LAS s16x4*)pa, b = *(const LAS s16x4*)pb; return __builtin_shufflevector(a, b, 0, 1, 2, 3, 4, 5, 6, 7); }
#define MFMA16(a, b, c) __builtin_amdgcn_mfma_f32_16x16x32_bf16((a), (b), (c), 0, 0, 0)
constexpr int CP_XA = 0, CP_XR = 4096, CP_XB = 8192, CP_XK = 12288, CP_VL = 16384, CP_NL = 16384, CP_WAVE = 20480;
__device__ __forceinline__ void phase_chunk_pre(const int wv, LAS unsigned char* lds) {
    KParams& p = *kparams();
    const int tid = opaque_tid(wv), wid = tid >> 6, lane = tid & 63, fr = lane & 15, fq = lane >> 4; unsigned char* ws = p.ws;
    if (tid == 0) { *(u32x4*)(ws + OFF_CTL + CTL_KEEP + blockIdx.x * 16) = *(const LAS u32x4*)(lds + LDS_X); asm volatile("s_waitcnt vmcnt(0)" ::: "memory"); }
    __syncthreads();
    LAS unsigned char* wl = lds + wid * CP_WAVE;
    const bf16_t* Z = (const bf16_t*)(ws + OFF_Z); bf16_t* C1 = (bf16_t*)(ws + OFF_C1); bf16_t* C2 = (bf16_t*)(ws + OFF_C2);
    const float* mu = p.in[4]; const float* k_k = p.in[10]; const float* k_a = p.in[11]; const float* r_k = p.in[12]; const float* ln_w = p.in[13]; const float* ln_b = p.in[14];
    const f32x4 z4 = zero4f();
    const bf16_t* LT = (const bf16_t*)(ws + OFF_LORAT); const float* w0v = p.in[5]; const float* a0v = p.in[7];
    for (int un = blockIdx.x; un < 512; un += gridDim.x) {
        const int b_ = un >> 6, cc = un & 63, h_ = wid; const int pr = ((b_ * 8 + h_) << 6) | cc; const int tok0 = b_ * SEQ + cc * 32;
        float gamC;
        int tidl = tid; asm volatile("" : "+v"(tidl));
        __syncthreads();
        { const int tl = tidl >> 4; const int t = tok0 + tl; u32x4 za[2], zb[2]; const u32x4 zq0 = zero4u();
#pragma unroll
          for (int g2 = 0; g2 < 2; ++g2) { const int col = C_ZW + 8 * ((tidl & 15) * 2 + g2); za[g2] = *(const u32x4*)(Z + (size_t)t * INC + col);
              zb[g2] = zq0; if ((t & (SEQ - 1)) != 0) zb[g2] = *(const u32x4*)(Z + (size_t)(t - 1) * INC + col); }
#pragma unroll
          for (int g2 = 0; g2 < 2; ++g2) { const int ch = (tidl & 15) * 2 + g2, col = C_ZW + 8 * ch; float a[8], b[8]; unpack8(za[g2], a); unpack8(zb[g2], b);
              const f32x4 m0 = *(const f32x4*)(mu + col), m1 = *(const f32x4*)(mu + col + 4); const float mm[8] = {m0[0], m0[1], m0[2], m0[3], m1[0], m1[1], m1[2], m1[3]};
#pragma unroll
              for (int j = 0; j < 8; ++j) { float v = a[j] + (b[j] - a[j]) * mm[j]; if (ch < 8) v = tanhf(v); else if (ch >= 16) v = sigmoidf_(v); a[j] = v; }
              *(LAS u32x4*)(lds + (tl >> 2) * CP_WAVE + CP_VL + (tl & 3) * 528 + ch * 16) = pack8(a); }
          __syncthreads(); }
        { const int fr = tidl & 15, fq = (tidl >> 4) & 3;
#pragma unroll
          for (int kind = 0; kind < 3; ++kind) { const int koff = kind == 0 ? 0 : (kind == 1 ? 64 : 128), nks = kind == 2 ? 4 : 2;
              f32x4 acc[4][2];
#pragma unroll
              for (int mt = 0; mt < 4; ++mt) { acc[mt][0] = z4; acc[mt][1] = z4; }
#pragma unroll
              for (int ks = 0; ks < nks; ++ks) { bf16x8 tf[2];
#pragma unroll
                  for (int nt = 0; nt < 2; ++nt) { const int tt = 16 * nt + fr; tf[nt] = *(const LAS bf16x8*)(lds + (tt >> 2) * CP_WAVE + CP_VL + (tt & 3) * 528 + (koff + 32 * ks + 8 * fq) * 2); }
#pragma unroll
                  for (int mt = 0; mt < 4; ++mt) { const bf16x8 wf = *(const bf16x8*)(LT + (size_t)(kind * 512 + h_ * 64 + 16 * mt + fr) * 256 + koff + 32 * ks + 8 * fq);
                      acc[mt][0] = MFMA16(tf[0], wf, acc[mt][0]); acc[mt][1] = MFMA16(tf[1], wf, acc[mt][1]); } }
#pragma unroll
              for (int mt = 0; mt < 4; ++mt) { const int ch = 16 * mt + fr; float bv = 0.f; if (kind == 0) bv = w0v[h_ * 64 + ch]; else if (kind == 1) bv = a0v[h_ * 64 + ch];
#pragma unroll
                  for (int nt = 0; nt < 2; ++nt) { f32x4 v = acc[mt][nt] + bv; LAS unsigned char* dst = wl + ch * 64 + (16 * nt + 4 * fq) * 2;
                      if (kind == 0) { float hf[4];
#pragma unroll
                          for (int j = 0; j < 4; ++j) v[j] = -0.60653066f * sigmoidf_(v[j]);
                          u32x2 hi; hi.x = cvt_pk_bf16(v[0], v[1]); hi.y = cvt_pk_bf16(v[2], v[3]);
                          hf[0] = v[0] - __uint_as_float(hi.x << 16); hf[1] = v[1] - __uint_as_float(hi.x & 0xffff0000u); hf[2] = v[2] - __uint_as_float(hi.y << 16); hf[3] = v[3] - __uint_as_float(hi.y & 0xffff0000u);
                          u32x2 lo; lo.x = cvt_pk_bf16(hf[0], hf[1]); lo.y = cvt_pk_bf16(hf[2], hf[3]);
                          *(LAS u32x2*)(dst + CP_XR) = hi; *(LAS u32x2*)(dst + CP_XB) = lo; }
                      else { if (kind == 1) {
#pragma unroll
                              for (int j = 0; j < 4; ++j) v[j] = sigmoidf_(v[j]); }
                          u32x2 w; w.x = cvt_pk_bf16(v[0], v[1]); w.y = cvt_pk_bf16(v[2], v[3]); *(LAS u32x2*)(dst + (kind == 1 ? CP_XK : CP_XA)) = w; } } } }
          asm volatile("s_waitcnt lgkmcnt(0)" ::: "memory");
          __syncthreads(); }
        { const int c = h_ * 64 + lane;
          const bf16_t* zp = Z + (size_t)tok0 * INC + c;
          const float mur = mu[c], muk = mu[C_K + c], muv = mu[C_V + c], kk_ = k_k[c], ka_ = k_a[c], rk_ = r_k[c], lnw = ln_w[c], lnb = ln_b[c];
          float pzr = 0.f, pzk = 0.f, pzv = 0.f;
          if (cc != 0) { pzr = __uint_as_float((unsigned)zp[-INC] << 16); pzk = __uint_as_float((unsigned)zp[-INC + C_K] << 16); pzv = __uint_as_float((unsigned)zp[-INC + C_V] << 16); }
          unsigned short zq[2][4][3]; u32x2 sq[2][4];
#pragma unroll
          for (int e = 0; e < 4; ++e) {
#pragma unroll
              for (int q = 0; q < 3; ++q) zq[0][e][q] = zp[(size_t)e * INC + q * 512]; }
#pragma unroll
          for (int r = 0; r < 4; ++r) sq[0][r] = *(const LAS u32x2*)(wl + r * 4096 + lane * 64);
          __builtin_amdgcn_sched_barrier(0);
          float cs = 0.f, g = 1.0f;
#pragma unroll
          for (int t4 = 0; t4 < 8; ++t4) { unsigned pa[2], pr_[2], pb[2], pk[2];
              if (t4 < 7) {
#pragma unroll
                  for (int e = 0; e < 4; ++e) {
#pragma unroll
                      for (int q = 0; q < 3; ++q) zq[(t4 + 1) & 1][e][q] = zp[(size_t)((t4 + 1) * 4 + e) * INC + q * 512]; }
#pragma unroll
                  for (int r = 0; r < 4; ++r) sq[(t4 + 1) & 1][r] = *(const LAS u32x2*)(wl + r * 4096 + lane * 64 + (t4 + 1) * 8); }
              __builtin_amdgcn_sched_barrier(0);
#pragma unroll
              for (int tp = 0; tp < 2; ++tp) { float va[2], vr[2], vb[2], vk[2];
#pragma unroll
                  for (int e = 0; e < 2; ++e) { const int te = tp * 2 + e, t = t4 * 4 + te;
                      const float zr = __uint_as_float((unsigned)zq[t4 & 1][te][0] << 16), zk = __uint_as_float((unsigned)zq[t4 & 1][te][1] << 16), zv = __uint_as_float((unsigned)zq[t4 & 1][te][2] << 16);
                      const float r = zr + (pzr - zr) * mur, k = zk + (pzk - zk) * muk, v = zv + (pzv - zv) * muv; pzr = zr; pzk = zk; pzv = zv;
                      const unsigned wg = sq[t4 & 1][0][te >> 1], wh = sq[t4 & 1][1][te >> 1], wlo = sq[t4 & 1][2][te >> 1], wa = sq[t4 & 1][3][te >> 1];
                      const float lw = __uint_as_float((te & 1) ? (wh & 0xffff0000u) : (wh << 16)) + __uint_as_float((te & 1) ? (wlo & 0xffff0000u) : (wlo << 16));
                      const float al = __uint_as_float((te & 1) ? (wa & 0xffff0000u) : (wa << 16)), gg = __uint_as_float((te & 1) ? (wg & 0xffff0000u) : (wg << 16));
                      const float kk = k * kk_, kp = k * (1.0f + (al - 1.0f) * ka_);
                      const float n2 = red64(kk * kk), bon = red64(r * kp * rk_);
                      const float kn = kk * __builtin_amdgcn_rsqf(fmaxf(n2, 1e-24f));
                      const float gm1 = g; cs += lw; g = __builtin_amdgcn_exp2f(cs * 1.44269504f); const float gi = __builtin_amdgcn_rcpf(g);
                      va[e] = -kn * gm1; vb[e] = kn * al * gi; vk[e] = kp * gi; vr[e] = r * g;
                      *(LAS bf16_t*)(wl + CP_VL + t * 128 + lane * 2) = (bf16_t)(cvt_pk_bf16(v, 0.f) & 0xffffu);
                      const size_t to = (size_t)(tok0 + t) * 512 + c;
                      C1[to] = (bf16_t)(cvt_pk_bf16(lnw * gg, 0.f) & 0xffffu); C2[to] = (bf16_t)(cvt_pk_bf16((lnb + bon * v) * gg, 0.f) & 0xffffu); }
                  pa[tp] = cvt_pk_bf16(va[0], va[1]); pr_[tp] = cvt_pk_bf16(vr[0], vr[1]); pb[tp] = cvt_pk_bf16(vb[0], vb[1]); pk[tp] = cvt_pk_bf16(vk[0], vk[1]); }
              *(LAS u32x2*)(wl + CP_XA + lane * 64 + t4 * 8) = (u32x2){pa[0], pa[1]}; *(LAS u32x2*)(wl + CP_XR + lane * 64 + t4 * 8) = (u32x2){pr_[0], pr_[1]};
              *(LAS u32x2*)(wl + CP_XB + lane * 64 + t4 * 8) = (u32x2){pb[0], pb[1]}; *(LAS u32x2*)(wl + CP_XK + lane * 64 + t4 * 8) = (u32x2){pk[0], pk[1]};
              __builtin_amdgcn_sched_barrier(0); }
          gamC = g; }
        asm volatile("s_waitcnt lgkmcnt(0)" ::: "memory");
        bf16x8 Vf[4];
        { const int vtb = (4 * fq + (fr >> 2)) * 128 + (fr & 3) * 8;
#pragma unroll
          for (int nv = 0; nv < 4; ++nv) { LAS unsigned char* pp = wl + CP_VL + vtb + nv * 32; Vf[nv] = tr2(pp, pp + 2048); } }
        asm volatile("s_waitcnt lgkmcnt(0)" ::: "memory");
        const int trb = (8 * fq + (fr >> 2)) * 64 + (fr & 3) * 8;
        bf16x8 LakF[2], QrbF[2], QrkF[2];
#pragma unroll
        for (int yi = 0; yi < 2; ++yi) {
            bf16x8 fy[2][2];
#pragma unroll
            for (int nt = 0; nt < 2; ++nt)
#pragma unroll
                for (int s2 = 0; s2 < 2; ++s2) { LAS unsigned char* pp = wl + (yi ? CP_XR : CP_XA) + trb + s2 * 2048 + nt * 32; fy[nt][s2] = tr2(pp, pp + 256); }
#pragma unroll
            for (int xi = 0; xi < 2; ++xi) {
                f32x4 d[2][2];
#pragma unroll
                for (int mi = 0; mi < 2; ++mi) { bf16x8 fx[2];
#pragma unroll
                    for (int s2 = 0; s2 < 2; ++s2) { LAS unsigned char* pp = wl + (xi ? CP_XK : CP_XB) + trb + s2 * 2048 + mi * 32; fx[s2] = tr2(pp, pp + 256); }
#pragma unroll
                    for (int nt = 0; nt < 2; ++nt) {
                        if (mi == 1 && nt == 0) { d[mi][nt] = z4; continue; }
                        f32x4 acc = MFMA16(fx[0], fy[nt][0], z4); acc = MFMA16(fx[1], fy[nt][1], acc);
#pragma unroll
                        for (int j = 0; j < 4; ++j) { const int i = 16 * mi + 4 * fq + j, t = 16 * nt + fr; const bool ok = yi ? (i <= t) : (i < t); acc[j] = ok ? acc[j] : 0.f; }
                        d[mi][nt] = acc; } }
                if (yi == 0 && xi == 0) {
#pragma unroll
                    for (int mi = 0; mi < 2; ++mi)
#pragma unroll
                        for (int nt = 0; nt < 2; ++nt)
#pragma unroll
                            for (int j = 0; j < 4; ++j) *(LAS float*)(wl + CP_NL + ((16 * nt + fr) * 32 + 16 * mi + 4 * fq + j) * 4) = d[mi][nt][j];
                } else {
#pragma unroll
                    for (int nt = 0; nt < 2; ++nt) { const bf16x8 f = pack_frag(d[0][nt], d[1][nt]); if (yi == 0) LakF[nt] = f; else if (xi == 0) QrbF[nt] = f; else QrkF[nt] = f; } } } }
        asm volatile("s_waitcnt lgkmcnt(0)" ::: "memory");
        bf16x8 InvF[2];
        { const int c = lane & 31; float X[32];
#pragma unroll
          for (int t = 0; t < 32; ++t) { float a0 = (t == c) ? 1.0f : 0.f, a1 = 0.f;
#pragma unroll
              for (int i4 = 0; i4 < (t + 3) / 4; ++i4) { const f32x4 nv = *(const LAS f32x4*)(wl + CP_NL + (t * 32 + 4 * i4) * 4);
#pragma unroll
                  for (int e = 0; e < 4; ++e) if (4 * i4 + e < t) { if (e & 1) a1 = fmaf(nv[e], X[4 * i4 + e], a1); else a0 = fmaf(nv[e], X[4 * i4 + e], a0); } }
              X[t] = a0 + a1; }
          asm volatile("s_waitcnt lgkmcnt(0)" ::: "memory");
#pragma unroll
          for (int t = 0; t < 32; ++t) *(LAS float*)(wl + CP_NL + (t * 32 + c) * 4) = X[t];
          asm volatile("s_waitcnt lgkmcnt(0)" ::: "memory");
#pragma unroll
          for (int n = 0; n < 2; ++n) { const f32x4 lo = *(const LAS f32x4*)(wl + CP_NL + ((16 * n + fr) * 32 + 4 * fq) * 4), hi = *(const LAS f32x4*)(wl + CP_NL + ((16 * n + fr) * 32 + 16 + 4 * fq) * 4); InvF[n] = pack_frag(lo, hi); } }
        bf16x8 UF[4], AhF[4];
#pragma unroll
        for (int nv = 0; nv < 4; ++nv) { const f32x4 w0 = MFMA16(LakF[0], Vf[nv], z4), w1 = MFMA16(LakF[1], Vf[nv], z4); const bf16x8 wf = pack_frag(w0, w1);
            const f32x4 u0 = MFMA16(InvF[0], wf, z4), u1 = MFMA16(InvF[1], wf, z4); UF[nv] = pack_frag(u0, u1); }
#pragma unroll
        for (int nc = 0; nc < 4; ++nc) { LAS unsigned char* pp = wl + CP_XA + (16 * nc + fr) * 64 + 8 * fq; const bf16x8 af = rd2(pp, pp + 32);
            const f32x4 h0 = MFMA16(InvF[0], af, z4), h1 = MFMA16(InvF[1], af, z4); AhF[nc] = pack_frag(h0, h1); }
        { f32x4 rt[4][2];
#pragma unroll
          for (int mc = 0; mc < 4; ++mc)
#pragma unroll
              for (int nt = 0; nt < 2; ++nt) { const s16x4 rr = __builtin_amdgcn_ds_read_tr16_b64_v4i16((LAS s16x4*)(wl + CP_XR + (16 * mc + 4 * fq + (fr >> 2)) * 64 + (fr & 3) * 8 + nt * 32));
                  f32x4 cin; cin[0] = __uint_as_float((unsigned)(unsigned short)rr[0] << 16); cin[1] = __uint_as_float((unsigned)(unsigned short)rr[1] << 16); cin[2] = __uint_as_float((unsigned)(unsigned short)rr[2] << 16); cin[3] = __uint_as_float((unsigned)(unsigned short)rr[3] << 16);
                  rt[mc][nt] = MFMA16(AhF[mc], QrbF[nt], cin); }
          bf16x8* RTF = (bf16x8*)(ws + OFF_RTF) + (size_t)pr * 256;
#pragma unroll
          for (int nt = 0; nt < 2; ++nt)
#pragma unroll
              for (int s2 = 0; s2 < 2; ++s2) RTF[(nt * 2 + s2) * 64 + lane] = pack_frag(rt[2 * s2][nt], rt[2 * s2 + 1][nt]); }
        { u32x2* YLF = (u32x2*)(ws + OFF_YLF) + (size_t)pr * 512;
#pragma unroll
          for (int nv = 0; nv < 4; ++nv)
#pragma unroll
              for (int mt = 0; mt < 2; ++mt) { f32x4 y = MFMA16(QrbF[mt], UF[nv], z4); y = MFMA16(QrkF[mt], Vf[nv], y);
                  u32x2 w; w.x = cvt_pk_bf16(y[0], y[1]); w.y = cvt_pk_bf16(y[2], y[3]); YLF[(nv * 2 + mt) * 64 + lane] = w; } }
        { bf16x8* GTF = (bf16x8*)(ws + OFF_GTF) + (size_t)pr * 512; u32x2* HHF = (u32x2*)(ws + OFF_HHF) + (size_t)pr * 1024;
#pragma unroll
          for (int nc = 0; nc < 4; ++nc) { LAS unsigned char* pp = wl + CP_XB + (16 * nc + fr) * 64 + 8 * fq; const bf16x8 bf_ = rd2(pp, pp + 32);
              LAS unsigned char* pk = wl + CP_XK + (16 * nc + fr) * 64 + 8 * fq; const bf16x8 kf_ = rd2(pk, pk + 32);
              const float gcol = __int_as_float(__builtin_amdgcn_ds_bpermute((16 * nc + fr) << 2, __float_as_int(gamC)));
              f32x4 gt[4];
#pragma unroll
              for (int mc = 0; mc < 4; ++mc) { f32x4 a = MFMA16(AhF[mc], bf_, z4);
#pragma unroll
                  for (int j = 0; j < 4; ++j) { if (mc == nc && 4 * fq + j == fr) a[j] += 1.0f; a[j] *= gcol; }
                  gt[mc] = a; }
              GTF[(nc * 2 + 0) * 64 + lane] = pack_frag(gt[0], gt[1]); GTF[(nc * 2 + 1) * 64 + lane] = pack_frag(gt[2], gt[3]);
              f32x4 grow;
#pragma unroll
              for (int j = 0; j < 4; ++j) grow[j] = __int_as_float(__builtin_amdgcn_ds_bpermute((16 * nc + 4 * fq + j) << 2, __float_as_int(gamC)));
#pragma unroll
              for (int nv = 0; nv < 4; ++nv) { f32x4 hh = MFMA16(bf_, UF[nv], z4); hh = MFMA16(kf_, Vf[nv], hh); hh = hh * grow;
                  u32x2 w; w.x = cvt_pk_bf16(hh[0], hh[1]); w.y = cvt_pk_bf16(hh[2], hh[3]); HHF[(nv * 4 + nc) * 64 + lane] = w; } } }
        asm volatile("s_waitcnt lgkmcnt(0)" ::: "memory");
    }
    __syncthreads();
    if (tid == 0) *(LAS u32x4*)(lds + LDS_X) = *(const u32x4*)(ws + OFF_CTL + CTL_KEEP + blockIdx.x * 16);
}
__device__ __forceinline__ void phase_scan_seq(const int wv, LAS unsigned char* lds) {
    KParams& p = *kparams();
    const int tid = opaque_tid(wv), wid = __builtin_amdgcn_readfirstlane(tid >> 6), lane = tid & 63, fr = lane & 15, fq = lane >> 4; unsigned char* ws = p.ws;
    if (blockIdx.x >= 64) return;
    const int bh = blockIdx.x, b = bh >> 3, h = bh & 7;
    const char* gG = (const char*)(ws + OFF_GTF) + (size_t)bh * 64 * 8192; const char* gR = (const char*)(ws + OFF_RTF) + (size_t)bh * 64 * 4096;
    const char* gH = (const char*)(ws + OFF_HHF) + (size_t)bh * 64 * 8192; const char* gY = (const char*)(ws + OFF_YLF) + (size_t)bh * 64 * 4096;
    constexpr int SLOT = 24576;
    if (wid >= 4) {
        const int w = wid - 4;
        auto issue = [&](int c) { LAS unsigned char* slot = lds + (c % 5) * SLOT;
#pragma unroll
            for (int i = 0; i < 6; ++i) { const int pc = w + 4 * i;
                const char* src = pc < 8 ? gG + (size_t)c * 8192 + pc * 1024 : pc < 12 ? gR + (size_t)c * 4096 + (pc - 8) * 1024 : pc < 20 ? gH + (size_t)c * 8192 + (pc - 12) * 1024 : gY + (size_t)c * 4096 + (pc - 20) * 1024;
                __builtin_amdgcn_global_load_lds((const unsigned*)(src + lane * 16), (LAS unsigned*)(slot + pc * 1024), 16, 0, 0); } };
        issue(0); issue(1); issue(2); issue(3);
        for (int c = 0; c < 64; ++c) {
            if (c < 60) asm volatile("s_waitcnt vmcnt(18)" ::: "memory"); else asm volatile("s_waitcnt vmcnt(0)" ::: "memory");
            __builtin_amdgcn_s_barrier();
            if (c + 4 < 64) issue(c + 4);
        }
        return; }
    const int nv = wid;
    float* Yraw = (float*)(ws + OFF_YRAW) + (size_t)b * SEQ * 512 + h * 64 + 16 * nv + fr;
    f32x4 T[4]; const f32x4 z4s = zero4f();
#pragma unroll
    for (int m = 0; m < 4; ++m) T[m] = z4s;
    for (int c = 0; c < 64; ++c) {
        __builtin_amdgcn_s_barrier();
        const LAS unsigned char* slot = lds + (c % 5) * SLOT + lane * 16;
        bf16x8 G[8], R[4]; u32x2 H[4], Y[2];
#pragma unroll
        for (int i = 0; i < 8; ++i) G[i] = *(const LAS bf16x8*)(slot + i * 1024);
#pragma unroll
        for (int i = 0; i < 4; ++i) R[i] = *(const LAS bf16x8*)(slot + 8192 + i * 1024);
#pragma unroll
        for (int i = 0; i < 4; ++i) H[i] = *(const LAS u32x2*)(lds + (c % 5) * SLOT + 12288 + (nv * 4 + i) * 512 + lane * 8);
#pragma unroll
        for (int i = 0; i < 2; ++i) Y[i] = *(const LAS u32x2*)(lds + (c % 5) * SLOT + 20480 + (nv * 2 + i) * 512 + lane * 8);
        const bf16x8 tf0 = pack_frag(T[0], T[1]), tf1 = pack_frag(T[2], T[3]);
#pragma unroll
        for (int nt = 0; nt < 2; ++nt) { f32x4 y; y[0] = bf_lo(Y[nt].x); y[1] = bf_hi(Y[nt].x); y[2] = bf_lo(Y[nt].y); y[3] = bf_hi(Y[nt].y);
            y = MFMA16(R[nt * 2], tf0, y); y = MFMA16(R[nt * 2 + 1], tf1, y);
#pragma unroll
            for (int j = 0; j < 4; ++j) Yraw[(size_t)(c * 32 + 16 * nt + 4 * fq + j) * 512] = y[j]; }
#pragma unroll
        for (int m = 0; m < 4; ++m) { f32x4 t; t[0] = bf_lo(H[m].x); t[1] = bf_hi(H[m].x); t[2] = bf_lo(H[m].y); t[3] = bf_hi(H[m].y);
            t = MFMA16(G[m * 2], tf0, t); t = MFMA16(G[m * 2 + 1], tf1, t); T[m] = t; }
        asm volatile("s_waitcnt lgkmcnt(0)" ::: "memory");
    }
}

__device__ __forceinline__ bf16x8 tr_pair(LAS unsigned char* pa, LAS unsigned char* pb, bool useB) {
    const s16x4 a = __builtin_amdgcn_ds_read_tr16_b64_v4i16((LAS s16x4*)pa);
    s16x4 b2 = (s16x4){0, 0, 0, 0};
    if (useB) b2 = __builtin_amdgcn_ds_read_tr16_b64_v4i16((LAS s16x4*)pb);
    return __builtin_shufflevector(a, b2, 0, 1, 2, 3, 4, 5, 6, 7);
}
__device__ __forceinline__ void phase_dil_attn(const int wv, LAS unsigned char* lds) {
    KParams& p = *kparams();
    const int tid = opaque_tid(wv), wid = tid >> 6, lane = tid & 63, fr = lane & 15, fq = lane >> 4; unsigned char* ws = p.ws;
    const bf16_t* Z = (const bf16_t*)(ws + OFF_Z); float* DILO = (float*)(ws + OFF_DILO); float* LSE = (float*)(ws + OFF_LSE);
    LAS unsigned char* kb = lds; LAS unsigned char* vb = lds + 32768; const float* qn = p.in[15]; const float* kn = p.in[16];
    float qkw[2][8];
#pragma unroll
    for (int ks = 0; ks < 2; ++ks)
#pragma unroll
        for (int j = 0; j < 8; ++j) qkw[ks][j] = qn[ks * 32 + 8 * fq + j] * kn[ks * 32 + 8 * fq + j];
    const bool seqwg = blockIdx.x < 64;
    const int u0 = seqwg ? 4 * (int)blockIdx.x : 256 + (int)blockIdx.x - 64, uend = seqwg ? 4 * (int)blockIdx.x + 4 : 1536, ustep = seqwg ? 1 : 192;
    auto umap = [&](int v) -> int { if (seqwg) return v; const int c2 = (int)blockIdx.x - 64, x = c2 & 7, y = c2 >> 3, i = (v - u0) / 192, k = 24 * i + y; return 256 + (k >> 3) * 64 + 8 * x + (k & 7); };
    const int ki = tid >> 1, half = tid & 1;
    u32x4 kvA[4], vvA[4], qvA[2], kvB[4], vvB[4], qvB[2]; bool kvalidA = false, kvalidB = false;
    auto unit_load = [&](int uv, u32x4 (&kv)[4], u32x4 (&vv)[4], u32x4 (&qv)[2], bool& kvalid) { const int u = umap(uv);
        const int b = u / 192, rem = u % 192, hh = rem >> 4, qb = rem & 15, g = hh >> 2;
        const int dil = g == 0 ? 1 : (g == 1 ? 4 : 16), nbc = 16 / dil, r = qb / nbc, j0 = (qb % nbc) * 128;
        const bf16_t* Zb = Z + (size_t)b * SEQ * INC; const int kj = j0 - 128 + ki; kvalid = kj >= 0;
        { const bf16_t* rowp = Zb + (size_t)((kvalid ? kj : 0) * dil + r) * INC + hh * 64 + half * 32;
#pragma unroll
            for (int i = 0; i < 4; ++i) { kv[i] = *(const u32x4*)(rowp + C_DK + 8 * i); vv[i] = *(const u32x4*)(rowp + C_DV + 8 * i); } }
        const int tq = (j0 + 16 * wid + fr) * dil + r;
#pragma unroll
        for (int ks = 0; ks < 2; ++ks) qv[ks] = *(const u32x4*)(Zb + (size_t)tq * INC + C_DQ + hh * 64 + ks * 32 + 8 * fq); };
    auto do_unit = [&](const int uvv, u32x4 (&kv)[4], u32x4 (&vv)[4], u32x4 (&qv)[2], bool& kvalid) { const int u = umap(uvv); const int uv_ = uvv;
        const int b = u / 192, rem = u % 192, hh = rem >> 4, qb = rem & 15, g = hh >> 2, hg = hh & 3;
        const int dil = g == 0 ? 1 : (g == 1 ? 4 : 16), nbc = 16 / dil, r = qb / nbc, j0 = (qb % nbc) * 128;
        { if (kvalid) {
              float ss = sumsq8(kv[0]) + sumsq8(kv[1]) + sumsq8(kv[2]) + sumsq8(kv[3]); ss += dpp_f<0xB1>(ss);
              const float rs = rsqrtf(ss * (1.0f / 64.0f) + 1e-5f);
#pragma unroll
              for (int i = 0; i < 4; ++i) kv[i] = scale8s(kv[i], rs); }
          else { const u32x4 zu = zero4u();
#pragma unroll
              for (int i = 0; i < 4; ++i) { kv[i] = zu; vv[i] = zu; } }
#pragma unroll
          for (int i = 0; i < 4; ++i) { const int sw = (half * 4 + i) ^ (ki & 7); *(LAS u32x4*)(kb + ki * 128 + sw * 16) = kv[i]; *(LAS u32x4*)(vb + ki * 128 + sw * 16) = vv[i]; } }
        const int qi = 16 * wid + fr, tq = (j0 + qi) * dil + r;
        bf16x8 qf[2];
        { float ss = sumsq8(qv[0]) + sumsq8(qv[1]); ss += sxor(ss, 16); ss += sxor(ss, 32);
          const float rs = rsqrtf(ss * (1.0f / 64.0f) + 1e-5f) * 0.125f;
#pragma unroll
          for (int ks = 0; ks < 2; ++ks) { const u32x4 w = scale8r(qv[ks], rs, qkw[ks]); __builtin_memcpy(&qf[ks], &w, 16); } }
        __syncthreads();
        if (uv_ + 2 * ustep < uend) unit_load(uv_ + 2 * ustep, kv, vv, qv, kvalid);
        f32x4 st[9]; float mx = -1e30f; const f32x4 zq = zero4f();
        LAS unsigned char* kp0 = kb + (16 * wid + fr) * 128 + ((fq ^ (fr & 7)) << 4); LAS unsigned char* kp1 = kb + (16 * wid + fr) * 128 + (((4 + fq) ^ (fr & 7)) << 4);
#pragma unroll
        for (int ti = 0; ti < 9; ++ti) {
            const bf16x8 k0 = *(const LAS bf16x8*)(kp0 + ti * 2048), k1 = *(const LAS bf16x8*)(kp1 + ti * 2048);
            f32x4 s = __builtin_amdgcn_mfma_f32_16x16x32_bf16(k0, qf[0], zq, 0, 0, 0);
            s = __builtin_amdgcn_mfma_f32_16x16x32_bf16(k1, qf[1], s, 0, 0, 0);
#pragma unroll
            for (int j = 0; j < 4; ++j) { const int ki = 16 * (wid + ti) + 4 * fq + j, off = qi + 128 - ki; const bool ok = (off >= 0) && (off <= 128) && (j0 - 128 + ki >= 0);
                s[j] = ok ? s[j] : -1e30f; mx = fmaxf(mx, s[j]); }
            st[ti] = s; }
        mx = fmaxf(mx, sxor(mx, 16)); mx = fmaxf(mx, sxor(mx, 32));
        float den = 0.f;
#pragma unroll
        for (int ti = 0; ti < 9; ++ti)
#pragma unroll
            for (int j = 0; j < 4; ++j) { const float e = __builtin_amdgcn_exp2f((st[ti][j] - mx) * 1.44269504f); st[ti][j] = e; den += e; }
        den += sxor(den, 16); den += sxor(den, 32);
        f32x4 o[4];
#pragma unroll
        for (int dt = 0; dt < 4; ++dt) o[dt] = zq;
        const int q4 = fr >> 2, p4 = fr & 3; const int kl = 4 * fq + q4;
        LAS unsigned char* vp[4];
#pragma unroll
        for (int dt = 0; dt < 4; ++dt) vp[dt] = vb + (16 * wid + kl) * 128 + (((2 * dt + (p4 >> 1)) ^ (kl & 7)) << 4) + (p4 & 1) * 8;
#pragma unroll
        for (int pp = 0; pp < 5; ++pp) { const bool two = pp < 4; const int tA = 2 * pp, tB = two ? 2 * pp + 1 : 2 * pp;
            u32x4 pw; pw.x = cvt_pk_bf16(st[tA][0], st[tA][1]); pw.y = cvt_pk_bf16(st[tA][2], st[tA][3]);
            if (two) { pw.z = cvt_pk_bf16(st[tB][0], st[tB][1]); pw.w = cvt_pk_bf16(st[tB][2], st[tB][3]); } else { pw.z = 0u; pw.w = 0u; }
            bf16x8 pf; __builtin_memcpy(&pf, &pw, 16);
#pragma unroll
            for (int dt = 0; dt < 4; ++dt) { const bf16x8 vf = tr_pair(vp[dt] + tA * 2048, vp[dt] + tB * 2048, two);
                o[dt] = __builtin_amdgcn_mfma_f32_16x16x32_bf16(vf, pf, o[dt], 0, 0, 0); } }
        const float inv = __builtin_amdgcn_rcpf(den); const size_t ob = ((size_t)(g * NTOK + b * SEQ + tq) * 4 + hg);
#pragma unroll
        for (int dt = 0; dt < 4; ++dt) *(f32x4*)(DILO + ob * 64 + 16 * dt + 4 * fq) = o[dt] * inv;
        if (fq == 0) LSE[ob] = mx + __logf(den);
        __syncthreads();
    };
    if (u0 < uend) unit_load(u0, kvA, vvA, qvA, kvalidA);
    if (u0 + ustep < uend) unit_load(u0 + ustep, kvB, vvB, qvB, kvalidB);
    for (int u = u0; u < uend; u += 2 * ustep) {
        do_unit(u, kvA, vvA, qvA, kvalidA);
        if (u + ustep < uend) do_unit(u + ustep, kvB, vvB, qvB, kvalidB);
    }
}

__device__ __forceinline__ void phase_mem_attn(const int wv, LAS unsigned char* lds) {
    KParams& p = *kparams();
    const int tid = opaque_tid(wv), wid = tid >> 6, lane = tid & 63, fr = lane & 15, fq = lane >> 4; unsigned char* ws = p.ws;
    const bf16_t* Z = (const bf16_t*)(ws + OFF_Z); const bf16_t* KV = (const bf16_t*)(ws + OFF_KV); bf16_t* YM = (bf16_t*)(ws + OFF_YCAT) + 768;
    LAS unsigned char* kb = lds; LAS unsigned char* vb = lds + 65536; const float* mqn = p.in[19]; const float* mkn = p.in[20];
    if (blockIdx.x < 64) return;
    float mqk[4][8];
#pragma unroll
    for (int ks = 0; ks < 4; ++ks)
#pragma unroll
        for (int j = 0; j < 8; ++j) mqk[ks][j] = mqn[ks * 32 + 8 * fq + j] * mkn[ks * 32 + 8 * fq + j];
    for (int bhq = (int)blockIdx.x - 64; bhq < 256; bhq += (int)gridDim.x - 64) {
        const int bhm = bhq >> 3, b = bhm >> 2, hm = bhm & 3;
        { const int ki = tid >> 1, half = tid & 1; const bf16_t* rowp = KV + (size_t)(b * 256 + ki) * 1024 + hm * 128 + half * 64;
          u32x4 kv[8], vv[8];
#pragma unroll
          for (int i = 0; i < 8; ++i) { kv[i] = *(const u32x4*)(rowp + 8 * i); vv[i] = *(const u32x4*)(rowp + 512 + 8 * i); }
          { float ss = 0.f;
#pragma unroll
            for (int i = 0; i < 8; ++i) ss += sumsq8(kv[i]);
            ss += dpp_f<0xB1>(ss); const float rs = rsqrtf(ss * (1.0f / 128.0f) + 1e-5f);
#pragma unroll
            for (int i = 0; i < 8; ++i) kv[i] = scale8s(kv[i], rs); }
#pragma unroll
          for (int i = 0; i < 8; ++i) { const int sw = (half * 8 + i) ^ (ki & 15); *(LAS u32x4*)(kb + ki * 256 + sw * 16) = kv[i]; *(LAS u32x4*)(vb + ki * 256 + sw * 16) = vv[i]; } }
        __syncthreads();
        const int q4 = fr >> 2, p4 = fr & 3; const int kl = 4 * fq + q4;
        LAS unsigned char* kp[4]; LAS unsigned char* vp[8];
#pragma unroll
        for (int ks = 0; ks < 4; ++ks) kp[ks] = kb + fr * 256 + (((4 * ks + fq) ^ fr) << 4);
#pragma unroll
        for (int dt = 0; dt < 8; ++dt) vp[dt] = vb + kl * 256 + (((2 * dt + (p4 >> 1)) ^ kl) << 4) + (p4 & 1) * 8;
        for (int qq = 0; qq < 2; ++qq) { const int qblk = (bhq & 7) * 2 + qq; const int tq = b * SEQ + qblk * 128 + 16 * wid + fr;
            bf16x8 qf[4];
#pragma unroll
            for (int ks = 0; ks < 4; ++ks) qf[ks] = *(const bf16x8*)(Z + (size_t)tq * INC + C_MQ + hm * 128 + ks * 32 + 8 * fq);
            { u32x4 qv[4]; float ss = 0.f;
#pragma unroll
              for (int ks = 0; ks < 4; ++ks) { __builtin_memcpy(&qv[ks], &qf[ks], 16); ss += sumsq8(qv[ks]); }
              ss += sxor(ss, 16); ss += sxor(ss, 32); const float rs = rsqrtf(ss * (1.0f / 128.0f) + 1e-5f);
#pragma unroll
              for (int ks = 0; ks < 4; ++ks) { const u32x4 w = scale8r(qv[ks], rs, mqk[ks]); __builtin_memcpy(&qf[ks], &w, 16); } }
            f32x4 st[16]; float mx = -1e30f; const f32x4 zq = zero4f();
#pragma unroll
            for (int ti = 0; ti < 16; ++ti) { f32x4 s = zq;
#pragma unroll
                for (int ks = 0; ks < 4; ++ks) { const bf16x8 kf = *(const LAS bf16x8*)(kp[ks] + ti * 4096); s = __builtin_amdgcn_mfma_f32_16x16x32_bf16(kf, qf[ks], s, 0, 0, 0); }
#pragma unroll
                for (int j = 0; j < 4; ++j) mx = fmaxf(mx, s[j]);
                st[ti] = s; if (ti & 1) asm volatile("" ::: "memory"); }
            mx = fmaxf(mx, sxor(mx, 16)); mx = fmaxf(mx, sxor(mx, 32));
            const float sc = 0.08838834764831845f * 1.44269504f; float den = 0.f;
#pragma unroll
            for (int ti = 0; ti < 16; ++ti)
#pragma unroll
                for (int j = 0; j < 4; ++j) { const float e = __builtin_amdgcn_exp2f((st[ti][j] - mx) * sc); st[ti][j] = e; den += e; }
            den += sxor(den, 16); den += sxor(den, 32);
            f32x4 o[8];
#pragma unroll
            for (int dt = 0; dt < 8; ++dt) o[dt] = zq;
#pragma unroll
            for (int pp = 0; pp < 8; ++pp) { const int tA = 2 * pp, tB = 2 * pp + 1;
                u32x4 pw; pw.x = cvt_pk_bf16(st[tA][0], st[tA][1]); pw.y = cvt_pk_bf16(st[tA][2], st[tA][3]); pw.z = cvt_pk_bf16(st[tB][0], st[tB][1]); pw.w = cvt_pk_bf16(st[tB][2], st[tB][3]);
                bf16x8 pf; __builtin_memcpy(&pf, &pw, 16);
#pragma unroll
                for (int dt = 0; dt < 8; ++dt) { const bf16x8 vf = tr_pair(vp[dt] + tA * 4096, vp[dt] + tB * 4096, true);
                    o[dt] = __builtin_amdgcn_mfma_f32_16x16x32_bf16(vf, pf, o[dt], 0, 0, 0); } }
            const float inv = __builtin_amdgcn_rcpf(den);
#pragma unroll
            for (int dt = 0; dt < 8; ++dt) { u32x2 w; w.x = cvt_pk_bf16(o[dt][0] * inv, o[dt][1] * inv); w.y = cvt_pk_bf16(o[dt][2] * inv, o[dt][3] * inv);
                *(u32x2*)(YM + (size_t)tq * 1280 + hm * 128 + 16 * dt + 4 * fq) = w; } }
        __syncthreads();
    }
}

__device__ __forceinline__ void phase_post(const int wv) {
    KParams& p = *kparams();
    const int gt = blockIdx.x * 512 + opaque_tid(wv), nthr = gridDim.x * 512; unsigned char* ws = p.ws;
    const float* Yraw = (const float*)(ws + OFF_YRAW); const bf16_t* C1 = (const bf16_t*)(ws + OFF_C1); const bf16_t* C2 = (const bf16_t*)(ws + OFF_C2); bf16_t* YR = (bf16_t*)(ws + OFF_YCAT);
    for (int idx = gt; idx < NTOK * 128; idx += nthr) { const int t = idx >> 7, c = ((idx >> 4) & 7) * 64 + 4 * (idx & 15);
        const f32x4 y = *(const f32x4*)(Yraw + (size_t)t * 512 + c);
        const float mean = red16(y[0] + y[1] + y[2] + y[3]) * (1.0f / 64.0f);
        const f32x4 d = y - mean; const float var = red16(d[0] * d[0] + d[1] * d[1] + d[2] * d[2] + d[3] * d[3]) * (1.0f / 64.0f);
        const float rs = rsqrtf(var + 64.0f * 1e-5f);
        float c1[4], c2[4]; unpack4(*(const u32x2*)(C1 + (size_t)t * 512 + c), c1); unpack4(*(const u32x2*)(C2 + (size_t)t * 512 + c), c2);
        u32x2 w; w.x = cvt_pk_bf16(d[0] * rs * c1[0] + c2[0], d[1] * rs * c1[1] + c2[1]); w.y = cvt_pk_bf16(d[2] * rs * c1[2] + c2[2], d[3] * rs * c1[3] + c2[3]);
        *(u32x2*)(YR + (size_t)t * 1280 + c) = w; }
    const float* DILO = (const float*)(ws + OFF_DILO); const float* LSE = (const float*)(ws + OFF_LSE); bf16_t* YD = (bf16_t*)(ws + OFF_YCAT) + 512;
    for (int idx = gt; idx < NTOK * 64; idx += nthr) { const int t = idx >> 6, hg = (idx >> 4) & 3, q = idx & 15;
        const float l0 = LSE[(size_t)t * 4 + hg], l1 = LSE[((size_t)NTOK + t) * 4 + hg], l2 = LSE[((size_t)2 * NTOK + t) * 4 + hg];
        const float m = fmaxf(l0, fmaxf(l1, l2)); const float e0 = __expf(l0 - m), e1 = __expf(l1 - m), e2 = __expf(l2 - m); const float inv = __builtin_amdgcn_rcpf(e0 + e1 + e2);
        const f32x4 o0 = *(const f32x4*)(DILO + ((size_t)t * 4 + hg) * 64 + 4 * q), o1 = *(const f32x4*)(DILO + (((size_t)NTOK + t) * 4 + hg) * 64 + 4 * q), o2 = *(const f32x4*)(DILO + (((size_t)2 * NTOK + t) * 4 + hg) * 64 + 4 * q);
        const f32x4 o = (o0 * e0 + o1 * e1 + o2 * e2) * inv;
        u32x2 w; w.x = cvt_pk_bf16(o[0], o[1]); w.y = cvt_pk_bf16(o[2], o[3]); *(u32x2*)(YD + (size_t)t * 1280 + hg * 64 + 4 * q) = w; }
}

__device__ __forceinline__ void phase_router(const int wv, LAS unsigned char* lds, const bool real = true) {
    KParams& p = *kparams();
    const int tid = opaque_tid(wv), wid = tid >> 6, lane = tid & 63, fr = lane & 15, fq = lane >> 4; unsigned char* ws = p.ws;
    const bf16_t* X1 = (const bf16_t*)(ws + OFF_X1B); const float* ln2 = p.in[25]; const float* br = p.in[27]; const bf16_t* WRT = (const bf16_t*)(ws + OFF_WRT);
    unsigned char* XN2 = ws + OFF_XN2; int* TOPE = (int*)(ws + OFF_TOPE); float* TOPG = (float*)(ws + OFF_TOPG);
    LAS int* hist = (LAS int*)(lds + LX_HIST);
    LAS float* red = (LAS float*)lds;
    LAS float* part = (LAS float*)(lds + 1024);
    if (tid < 32) hist[tid] = 0;
    const int grp = wid >> 2, kq = wid & 3;
    int tek[2][4] = {{0, 0, 0, 0}, {0, 0, 0, 0}}, lrk[2][4] = {{0, 0, 0, 0}, {0, 0, 0, 0}};
    u32x4 xq[2][8];
#pragma unroll
    for (int rd = 0; rd < 2; ++rd) { const bf16_t* xp = X1 + (size_t)((blockIdx.x * 4 + rd * 2 + grp) * 16 + fr) * 1024 + kq * 256 + 8 * fq;
#pragma unroll
        for (int s2 = 0; s2 < 8; ++s2) xq[rd][s2] = __builtin_nontemporal_load((const u32x4*)(xp + 32 * s2)); }
#pragma unroll
    for (int rd = 0; rd < 2; ++rd) { const int t0 = (blockIdx.x * 4 + rd * 2 + grp) * 16;
        f32x4 xa[8], xb[8]; float ss = 0.f;
#pragma unroll
        for (int s2 = 0; s2 < 8; ++s2) { float f[8]; unpack8(xq[rd][s2], f); xa[s2] = (f32x4){f[0], f[1], f[2], f[3]}; xb[s2] = (f32x4){f[4], f[5], f[6], f[7]}; }
#pragma unroll
        for (int s2 = 0; s2 < 8; ++s2) ss += xa[s2][0] * xa[s2][0] + xa[s2][1] * xa[s2][1] + xa[s2][2] * xa[s2][2] + xa[s2][3] * xa[s2][3] + xb[s2][0] * xb[s2][0] + xb[s2][1] * xb[s2][1] + xb[s2][2] * xb[s2][2] + xb[s2][3] * xb[s2][3];
        ss += sxor(ss, 16); ss += sxor(ss, 32);
        __syncthreads();
        if (fq == 0) red[(grp * 4 + kq) * 16 + fr] = ss;
        __syncthreads();
        const float tot = red[(grp * 4 + 0) * 16 + fr] + red[(grp * 4 + 1) * 16 + fr] + red[(grp * 4 + 2) * 16 + fr] + red[(grp * 4 + 3) * 16 + fr];
        const float rs = rsqrtf(tot * (1.0f / 1024.0f) + 1e-5f);
        f32x4 acc[2]; acc[0] = zero4f(); acc[1] = acc[0];
#pragma unroll
        for (int s2 = 0; s2 < 8; ++s2) { const int k = kq * 256 + 32 * s2 + 8 * fq;
            const f32x4 g0 = *(const f32x4*)(ln2 + k), g1 = *(const f32x4*)(ln2 + k + 4);
            float xn[8]; xn[0] = xa[s2][0] * rs * g0[0]; xn[1] = xa[s2][1] * rs * g0[1]; xn[2] = xa[s2][2] * rs * g0[2]; xn[3] = xa[s2][3] * rs * g0[3];
            xn[4] = xb[s2][0] * rs * g1[0]; xn[5] = xb[s2][1] * rs * g1[1]; xn[6] = xb[s2][2] * rs * g1[2]; xn[7] = xb[s2][3] * rs * g1[3];
            const u32x4 hi = pack8(xn); float hf[8]; unpack8(hi, hf);
#pragma unroll
            for (int j = 0; j < 8; ++j) hf[j] = xn[j] - hf[j];
            const u32x4 lo = pack8(hf);
            { u32x2 q8; q8.x = pack4_fp8(xn[0] * 8.0f, xn[1] * 8.0f, xn[2] * 8.0f, xn[3] * 8.0f); q8.y = pack4_fp8(xn[4] * 8.0f, xn[5] * 8.0f, xn[6] * 8.0f, xn[7] * 8.0f); if (real) *(u32x2*)(XN2 + (size_t)(t0 + fr) * 1024 + k) = q8; }
            bf16x8 xh, xl; __builtin_memcpy(&xh, &hi, 16); __builtin_memcpy(&xl, &lo, 16);
#pragma unroll
            for (int m = 0; m < 2; ++m) { const bf16x8 wh = *(const bf16x8*)(WRT + (size_t)(16 * m + fr) * 1024 + k), wl = *(const bf16x8*)(WRT + 32768 + (size_t)(16 * m + fr) * 1024 + k);
                acc[m] = MFMA16(wh, xh, acc[m]); acc[m] = MFMA16(wh, xl, acc[m]); acc[m] = MFMA16(wl, xh, acc[m]); } }
#pragma unroll
        for (int m = 0; m < 2; ++m)
#pragma unroll
            for (int j = 0; j < 4; ++j) part[((grp * 4 + kq) * 32 + 16 * m + 4 * fq + j) * 16 + fr] = acc[m][j];
        __syncthreads();
        if (kq == 0) { float lg[8]; int le[8];
#pragma unroll
            for (int m = 0; m < 2; ++m)
#pragma unroll
                for (int j = 0; j < 4; ++j) { const int e = 16 * m + 4 * fq + j; le[m * 4 + j] = e;
                    lg[m * 4 + j] = part[((grp * 4 + 0) * 32 + e) * 16 + fr] + part[((grp * 4 + 1) * 32 + e) * 16 + fr] + part[((grp * 4 + 2) * 32 + e) * 16 + fr] + part[((grp * 4 + 3) * 32 + e) * 16 + fr] + br[e]; }
            float tv[4]; int te[4];
#pragma unroll
            for (int r = 0; r < 4; ++r) { float bv = lg[0]; int bi = le[0];
#pragma unroll
                for (int q = 1; q < 8; ++q) if (lg[q] > bv) { bv = lg[q]; bi = le[q]; }
#pragma unroll
                for (int sft = 16; sft < 64; sft <<= 1) { const float ov = sxor(bv, sft); const int oi = sxor(bi, sft); if (ov > bv || (ov == bv && oi < bi)) { bv = ov; bi = oi; } }
                tv[r] = bv; te[r] = bi;
#pragma unroll
                for (int q = 0; q < 8; ++q) if (le[q] == bi) lg[q] = -3.0e38f; }
            const float e1 = __expf(tv[1] - tv[0]), e2 = __expf(tv[2] - tv[0]), e3 = __expf(tv[3] - tv[0]); const float inv = 1.0f / (1.0f + e1 + e2 + e3);
            if (fq == 0 && real) { const int t = t0 + fr; *(int4*)(TOPE + (size_t)t * 4) = make_int4(te[0], te[1], te[2], te[3]); *(f32x4*)(TOPG + (size_t)t * 4) = (f32x4){inv, e1 * inv, e2 * inv, e3 * inv};
#pragma unroll
                for (int k = 0; k < 4; ++k) { tek[rd][k] = te[k]; lrk[rd][k] = atomicAdd((int*)&hist[te[k]], 1); } } }
    }
    LAS int* bbase = (LAS int*)(lds + LX_BBASE);
    __syncthreads();
    if (tid < 32) { const int hcount = hist[tid]; bbase[tid] = (hcount && real) ? atomicAdd((int*)(ws + OFF_CTL + CTL_CUR) + tid, hcount) : 0; }
    __syncthreads();
    if (kq == 0 && fq == 0 && real) { int* POS = (int*)(ws + OFF_POS); int* STOKE = (int*)(ws + OFF_STOKE);
#pragma unroll
        for (int rd = 0; rd < 2; ++rd) { const int t = (blockIdx.x * 4 + rd * 2 + grp) * 16 + fr; int ps[4];
#pragma unroll
            for (int k = 0; k < 4; ++k) { ps[k] = bbase[tek[rd][k]] + lrk[rd][k]; STOKE[(size_t)tek[rd][k] * NTOK + ps[k]] = t; }
            *(int4*)(POS + (size_t)t * 4) = make_int4(ps[0], ps[1], ps[2], ps[3]); } }
}

__device__ __forceinline__ void build_tables(const int wv, LAS unsigned char* lds) {
    KParams& p = *kparams();
    LAS int* ts = (LAS int*)(lds + LX_TSTART); LAS int* sb = (LAS int*)(lds + LX_SBASE); LAS int* cn = (LAS int*)(lds + LX_CNT);
    if (wv == 0) { const int l = lane_id(); int* gc = (int*)(p.ws + OFF_CTL + CTL_CUR);
        const int c = (l < 32) ? (int)__hip_atomic_load(gc + l, __ATOMIC_RELAXED, __HIP_MEMORY_SCOPE_AGENT) : 0; const int tl = (c + 255) >> 8; int v = tl;
#pragma unroll
        for (int d = 1; d < 32; d <<= 1) { const int o = __builtin_amdgcn_ds_bpermute((l - d) << 2, v); if (l >= d) v += o; }
        if (l < 32) { cn[l] = c; sb[l] = (v - tl) * 256; ts[l + 1] = v; if (l == 0) ts[0] = 0; } }
    __syncthreads();
    { const int tid = (wv << 6) | lane_id(); LAS unsigned char* te = (LAS unsigned char*)(lds + LX_TEXP); const int nt = ts[32];
      if (tid < nt) { int e = 0; while (e < 31 && tid >= ts[e + 1]) ++e; te[tid] = (unsigned char)e; } }
    __syncthreads();
}

__device__ __forceinline__ void phase_combine(const int wv, const bool real = true) {
    KParams& p = *kparams();
    const int tid = opaque_tid(wv), wid = tid >> 6, lane = tid & 63; unsigned char* ws = p.ws;
    const int* SLOT = (const int*)(ws + OFF_SLOT); const float* TOPG = (const float*)(ws + OFF_TOPG); const bf16_t* YS = (const bf16_t*)(ws + OFF_YS); const bf16_t* X1 = (const bf16_t*)(ws + OFF_X1B); float* out = p.out;
    for (int t0 = (blockIdx.x * 8 + wid) * 8; t0 < NTOK; t0 += gridDim.x * 64) {
        int4 sl[8]; f32x4 gg[8];
#pragma unroll
        for (int i = 0; i < 8; ++i) { sl[i] = *(const int4*)(SLOT + (size_t)(t0 + i) * 4); gg[i] = *(const f32x4*)(TOPG + (size_t)(t0 + i) * 4); }
#pragma unroll
        for (int i = 0; i < 8; ++i) { const int t = t0 + i; const int s4[4] = {sl[i].x, sl[i].y, sl[i].z, sl[i].w};
#pragma unroll
            for (int hf = 0; hf < 2; ++hf) { const int c = hf * 512 + 8 * lane; float acc[8];
                const u32x4 xv = __builtin_nontemporal_load((const u32x4*)(X1 + (size_t)t * 1024 + c));
                u32x4 yv[4];
#pragma unroll
                for (int k = 0; k < 4; ++k) yv[k] = __builtin_nontemporal_load((const u32x4*)(YS + (size_t)s4[k] * 1024 + c));
                unpack8(xv, acc);
#pragma unroll
                for (int k = 0; k < 4; ++k) { float f[8]; unpack8(yv[k], f);
#pragma unroll
                    for (int j = 0; j < 8; ++j) acc[j] = fmaf(gg[i][k], f[j], acc[j]); }
                float* dst = real ? out : (float*)(ws + OFF_ACT);
                *(f32x4*)(dst + (size_t)t * 1024 + c) = (f32x4){acc[0], acc[1], acc[2], acc[3]}; *(f32x4*)(dst + (size_t)t * 1024 + c + 4) = (f32x4){acc[4], acc[5], acc[6], acc[7]}; }
            if (i & 1) asm volatile("" ::: "memory"); }
    }
}

__global__ void __launch_bounds__(512, 2) mk_fwd(Params p) {
    extern __shared__ __attribute__((aligned(16))) unsigned char lds_raw[];
    LAS unsigned char* lds = (LAS unsigned char*)lds_raw;
    unsigned char* ws = p.ws;
    const int wv = __builtin_amdgcn_readfirstlane((int)threadIdx.x >> 6);
    const bool multi = (p.ph_hi - p.ph_lo) > 1;
    XcdBarrier xb; xb.bar = (unsigned*)(ws + OFF_CTL); xb.x = 0; xb.st = (volatile LAS unsigned*)(lds + LDS_X);
    if (multi) {
        if (wv == 0 && lane_id() == 0) { *(LAS u32x4*)(lds + LDS_X) = zero4u(); }
        __syncthreads();
        xb = xcd_barrier_post((unsigned*)(ws + OFF_CTL), (volatile LAS unsigned*)(lds + LDS_X), wv);
    }
#if MFMA_BENCH
    { const int l = lane_id(); unsigned h = (unsigned)l * 2654435761u ^ (unsigned)blockIdx.x * 40503u ^ (unsigned)wv * 977u;
      i32x8 a, b;
#pragma unroll
      for (int j = 0; j < 8; ++j) { h = h * 1664525u + 1013904223u; a[j] = (int)(MFMA_BENCH == 1 ? ((h & 0x00ff00ffu) | 0x3f003f00u) : ((h & 0x0f0f0f0fu) | 0x30303030u));
                                    h = h * 1664525u + 1013904223u; b[j] = (int)(MFMA_BENCH == 1 ? ((h & 0x00ff00ffu) | 0x3f003f00u) : ((h & 0x0f0f0f0fu) | 0x30303030u)); }
      f32x4 c[8]; const f32x4 z0 = zero4f();
#pragma unroll
      for (int j = 0; j < 8; ++j) c[j] = z0;
      const int one_scale = 0x7f7f7f7f;
#pragma clang loop unroll(disable)
      for (int it = 0; it < (MFMA_BENCH == 1 ? 1875 : 938); ++it) {
#pragma unroll
          for (int j = 0; j < 8; ++j) {
              if (MFMA_BENCH == 1) c[j] = (j & 1) ? __builtin_amdgcn_mfma_f32_16x16x32_bf16(pg8::half8<1>(a), pg8::half8<1>(b), c[j], 0, 0, 0) : __builtin_amdgcn_mfma_f32_16x16x32_bf16(pg8::half8<0>(a), pg8::half8<0>(b), c[j], 0, 0, 0);
              else asm volatile("v_mfma_scale_f32_16x16x128_f8f6f4 %0, %1, %2, %0, %3, %3 op_sel_hi:[0,0,0]" : "+v"(c[j]) : "v"(a), "v"(b), "v"(one_scale)); } }
      asm volatile("s_nop 15\n\ts_nop 15" ::: "memory");
      float sm = 0.f;
#pragma unroll
      for (int j = 0; j < 8; ++j) sm += c[j][0] + c[j][1] + c[j][2] + c[j][3];
      if (sm == 1.2345f) *(float*)(ws + OFF_CTL + 8192) = sm; }
#endif
    for (int ph = p.ph_lo; ph < p.ph_hi; ++ph) {
      if (ph == 2 || ph == 3 || ph == 10) continue;
      for (int rep = 0; rep < (((DBL_MASK >> ph) & 1) ? 2 : 1); ++rep) {
        KParams& q = *kparams(); unsigned char* ws = q.ws;
        switch (ph) {
        case 0: phase_prep(wv, lds); break;
        case 1: { { SchedZ S; S.H = (const char*)(ws + OFF_H); S.WinT = (const char*)(ws + OFF_WINT); S.HM = (const char*)(ws + OFF_HM); S.WmkvT = (const char*)(ws + OFF_WMKVT); S.G = gridDim.x; S.c = blockIdx.x;
                    EpiZ E; E.Z = (bf16_t*)(ws + OFF_Z); E.KV = (bf16_t*)(ws + OFF_KV); E.GFp = (bf16_t*)(ws + OFF_GF); E.pn0 = 0; E.scale = 1.0f; pg8::gemm_phase(wv, lds, 1024, S, E); }
                  { SchedZ8 S; S.H8 = (const char*)(ws + OFF_H8); S.WIN8 = (const char*)(ws + OFF_WIN8); S.G = gridDim.x; S.c = blockIdx.x;
                    EpiZ E; E.Z = (bf16_t*)(ws + OFF_Z); E.KV = (bf16_t*)(ws + OFF_KV); E.GFp = (bf16_t*)(ws + OFF_GF); E.pn0 = 7; E.scale = 1.0f / 256.0f; pg8::gemm_phase<EpiZ, SchedZ8, 1>(wv, lds, 1024, S, E); }
                  { const int c = blockIdx.x; if (c >= 192) { const int r0 = c < 224 ? (c - 192) * TAIL1_A : 32 * TAIL1_A + (c - 224) * TAIL1_B;
                        prep_tiles(wv, lds, c < 224 ? TAIL1_A : TAIL1_B, [&](int n) { return NTILE - NRES + r0 + n; }); } } } break;
        case 2: phase_elem_c(wv); break;
        case 3: { pg8::DenseOrder S; S.init(ws + OFF_ALORA, ws + OFF_LORAT, NTOK, 1536, 256); EpiLora E; E.L = (float*)(ws + OFF_L); E.w0 = q.in[5]; E.a0 = q.in[7]; pg8::gemm_phase(wv, lds, 256, S, E); } break;
        case 4: phase_chunk_pre(wv, lds); break;
        case 5: for (int r2 = 0; r2 < (((DBL_MASK >> 16) & 1) ? 2 : 1); ++r2) phase_scan_seq(wv, lds);
                for (int r2 = 0; r2 < (((DBL_MASK >> 17) & 1) ? 2 : 1); ++r2) phase_dil_attn(wv, lds);
                for (int r2 = 0; r2 < (((DBL_MASK >> 18) & 1) ? 2 : 1); ++r2) phase_mem_attn(wv, lds); break;
        case 6: phase_post(wv); break;
        case 7: { pg8::DenseOrder S; S.init(ws + OFF_YCAT, ws + OFF_PCAT, NTOK, 1024, 1280); EpiMixCat E; E.mixbf = (bf16_t*)(ws + OFF_MIXBF); E.GF = (const bf16_t*)(ws + OFF_GF); E.tid = (wv << 6) | lane_id(); pg8::gemm_phase(wv, lds, 1280, S, E); } break;
        case 8: { pg8::DenseOrder S; S.init(ws + OFF_MIXBF, ws + OFF_WOT, NTOK, 1024, 1024); EpiX1 E; E.x = q.in[0]; E.x1 = (bf16_t*)(ws + OFF_X1B); pg8::gemm_phase(wv, lds, 1024, S, E); } break;
        case 9: phase_router(wv, lds, rep + 1 == (((DBL_MASK >> ph) & 1) ? 2 : 1)); break;
        case 11: { build_tables(wv, lds);
                   { const int* TOPE = (const int*)(ws + OFF_TOPE); const int* POS = (const int*)(ws + OFF_POS); int* SLOT = (int*)(ws + OFF_SLOT); const LAS int* sb = (const LAS int*)(lds + LX_SBASE);
                     for (int i = blockIdx.x * 512 + ((wv << 6) | lane_id()); i < NTOK * 4; i += gridDim.x * 512) SLOT[i] = sb[TOPE[i]] + POS[i]; }
                   SchedMoe<true> S; S.A = (const char*)(ws + OFF_XN2); S.Bt = (const char*)(ws + OFF_W1T); S.tstart = (const LAS int*)(lds + LX_TSTART); S.stok = (const int*)(ws + OFF_STOKE); S.lgN = 3; S.total = S.tstart[32] * 8; S.estride = (size_t)2048 * 1024; S.tbytes = (size_t)256 * 1024;
                   EpiSwiglu E; E.act = ws + OFF_ACT; E.b1 = q.in[29]; pg8::gemm_phase<EpiSwiglu, SchedMoe<true>, 1>(wv, lds, 1024, S, E);
                   { const int c = blockIdx.x, rem = S.total & 255, nearly = rem ? 256 - rem : 0, j = ((c & 7) * 32 + (c >> 3)) - rem;
                     if (rem && j >= 0 && j < 128) prep_tiles(wv, lds, TAIL6, [&](int n) { return NTILE - NRES + NRES1 + n * 128 + j; });
                     const int m = 128 - (nearly < 128 ? nearly : 128);
                     if (m > 0) { const int nf = m * TAIL6, top = nf - 1 - c; prep_tiles(wv, lds, top >= 0 ? top / (int)gridDim.x + 1 : 0, [&](int n) { const int f = top - n * (int)gridDim.x; return NTILE - NRES + NRES1 + (f / m) * 128 + nearly + (f % m); }); } } } break;
        case 12: { build_tables(wv, lds); SchedMoe<false> S; S.A = (const char*)(ws + OFF_ACT); S.Bt = (const char*)(ws + OFF_W2T); S.tstart = (const LAS int*)(lds + LX_TSTART); S.stok = nullptr; S.lgN = 2; S.total = S.tstart[32] * 4; S.estride = (size_t)1024 * 1024; S.tbytes = (size_t)256 * 1024;
                   EpiYs E; E.ys = (bf16_t*)(ws + OFF_YS); E.b2 = q.in[31]; pg8::gemm_phase<EpiYs, SchedMoe<false>, 1>(wv, lds, 1024, S, E); } break;
        case 13: phase_combine(wv, rep + 1 == (((DBL_MASK >> ph) & 1) ? 2 : 1)); break;
        default: break;
        }
      }
        if (ph + 1 < p.ph_hi) xcd_barrier(xb, wv);
        if (((DBL_MASK >> 20) & 1) && ph == 3 && multi) for (int e = 0; e < 10; ++e) xcd_barrier(xb, wv);
    }
}

extern "C" void kernel_launch(void* const* d_in, const int* in_sizes, int n_in, void* d_out, int out_size, void* d_ws, size_t ws_size, hipStream_t stream) {
    static int ready = 0;
    if (ready == 0) {
        if (n_in != 32 || out_size != NTOK * 1024 || ws_size < WS_NEED) { fprintf(stderr, "kernel_launch: unexpected shapes (n_in %d, out %d, ws %zu < %zu)\n", n_in, out_size, ws_size, (size_t)WS_NEED); ready = -1; return; }
        if (hipFuncSetAttribute((const void*)mk_fwd, hipFuncAttributeMaxDynamicSharedMemorySize, LDS_BYTES) != hipSuccess) { fprintf(stderr, "kernel_launch: hipFuncSetAttribute failed\n"); ready = -1; return; }
        int per_cu = 0, dev = 0, cus = 0; hipGetDevice(&dev); hipDeviceGetAttribute(&cus, hipDeviceAttributeMultiprocessorCount, dev);
        hipOccupancyMaxActiveBlocksPerMultiprocessor(&per_cu, (const void*)mk_fwd, 512, LDS_BYTES);
        if (per_cu < 1 || cus < 256) { fprintf(stderr, "kernel_launch: occupancy %d blocks/CU on %d CUs; need >= 1 on 256\n", per_cu, cus); ready = -1; (void)hipGetLastError(); return; }
        ready = 1;
    }
    if (ready < 0) return;
    hipMemsetAsync((char*)d_ws + OFF_CTL, 0, CTL_BYTES, stream);
    Params p{};
    for (int i = 0; i < 32; ++i) p.in[i] = (const float*)d_in[i];
    p.out = (float*)d_out; p.ws = (unsigned char*)d_ws;
#if MK_N_LAUNCH_PER_PHASE
    for (int ph = 0; ph < NPHASE; ++ph) { p.ph_lo = ph; p.ph_hi = ph + 1; hipLaunchKernelGGL(mk_fwd, dim3(256), dim3(512), LDS_BYTES, stream, p); }
#else
    p.ph_lo = 0; p.ph_hi = NPHASE;
    void* args[] = {&p};
    hipError_t e = hipLaunchCooperativeKernel((const void*)mk_fwd, dim3(256), dim3(512), args, LDS_BYTES, stream);
    if (e != hipSuccess) fprintf(stderr, "cooperative launch failed: %s\n", hipGetErrorString(e));
#endif
}
```

```cpp
#include <hip/hip_runtime.h>
#include <cstdio>
#include <cstdint>

#define LAS __attribute__((address_space(3)))
typedef unsigned short bf16_t;
typedef short bf16x8 __attribute__((ext_vector_type(8)));
typedef short s16x4 __attribute__((ext_vector_type(4)));
typedef float f32x4 __attribute__((ext_vector_type(4)));
typedef float f32x2 __attribute__((ext_vector_type(2)));
typedef unsigned u32x4 __attribute__((ext_vector_type(4)));
typedef unsigned u32x2 __attribute__((ext_vector_type(2)));
typedef int i32x8 __attribute__((ext_vector_type(8)));
typedef int i32x4 __attribute__((ext_vector_type(4)));

#ifndef DBL_MASK
#define DBL_MASK 0
#endif
#ifndef MK_N_LAUNCH_PER_PHASE
#define MK_N_LAUNCH_PER_PHASE 0
#endif

constexpr int NTOK = 16384, SEQ = 2048, INC = 7680;
constexpr int C_K = 512, C_V = 1024, C_ZW = 1536, C_DQ = 1792, C_DK = 2560, C_DV = 3328, C_MQ = 4096, C_GATE = 4608;
constexpr int NPHASE = 14;
constexpr int NSLOT_MAX = 65536 + 32 * 256;

constexpr size_t MiB = 1ull << 20;
constexpr size_t OFF_CTL = 0;
constexpr size_t CTL_BYTES = 32768;
constexpr size_t CTL_CNT = 16384;
constexpr size_t CTL_CUR = 16384 + 256;
constexpr size_t CTL_KEEP = 20480;
constexpr size_t OFF_TOPE = 1 * MiB;
constexpr size_t OFF_TOPG = 1 * MiB + 262144;
constexpr size_t OFF_SLOT = 1 * MiB + 524288;
constexpr size_t OFF_STOK = 2 * MiB;
constexpr size_t OFF_WRT = 3 * MiB;
constexpr size_t OFF_WINT = 4 * MiB, OFF_WMKVT = 19 * MiB, OFF_LORAT = 21 * MiB, OFF_PRT = 22 * MiB, OFF_PDT = 23 * MiB, OFF_PMT = 24 * MiB, OFF_WOT = 25 * MiB;
constexpr size_t OFF_WIN8 = 8 * MiB;
constexpr size_t OFF_H8 = 539 * MiB;
constexpr size_t OFF_YCAT = 223 * MiB;
constexpr size_t OFF_PCAT = 22 * MiB;
constexpr size_t OFF_W1T = 27 * MiB, OFF_W2T = 155 * MiB, OFF_KV = 219 * MiB, OFF_YM = 223 * MiB, OFF_YR = 239 * MiB, OFF_YD = 255 * MiB, OFF_Z = 263 * MiB;
constexpr size_t OFF_H = 503 * MiB, OFF_HM = 535 * MiB, OFF_ALORA = 503 * MiB, OFF_L = 511 * MiB, OFF_REC = 607 * MiB;
constexpr size_t OFF_GF = OFF_REC;
constexpr size_t OFF_LW = OFF_REC + 64 * MiB;
constexpr size_t OFF_VB = OFF_REC + 96 * MiB;
constexpr size_t OFF_GTF = OFF_REC + 112 * MiB;
constexpr size_t OFF_RTF = OFF_REC + 144 * MiB;
constexpr size_t OFF_HHF = OFF_REC + 160 * MiB;
constexpr size_t OFF_YLF = OFF_REC + 192 * MiB;
constexpr size_t OFF_C1 = 816 * MiB, OFF_C2 = 832 * MiB, OFF_YRAW = 848 * MiB, OFF_DILO = 880 * MiB, OFF_LSE = 928 * MiB;
constexpr size_t OFF_MIX32 = 503 * MiB, OFF_MIXBF = 567 * MiB, OFF_XN2 = 503 * MiB, OFF_XS = 263 * MiB, OFF_ACT = 607 * MiB, OFF_YS = 407 * MiB;
constexpr size_t OFF_X1B = 263 * MiB;
constexpr size_t OFF_STOKE = 296 * MiB;
constexpr size_t OFF_POS = 2 * MiB;
constexpr size_t WS_NEED = 929 * MiB;

constexpr int LDS_BYTES = 160 * 1024;
constexpr int LDS_X = LDS_BYTES - 4096;
constexpr int LX_TSTART = LDS_X + 64;
constexpr int LX_SBASE = LDS_X + 256;
constexpr int LX_CNT = LDS_X + 512;
constexpr int LX_HIST = LDS_X + 768;
constexpr int LX_BBASE = LDS_X + 1024;
constexpr int LX_SLOTL = LDS_X + 2048;
constexpr int LX_TEXP = LDS_X + 3072;

struct Params { const float* in[32]; float* out; unsigned char* ws; int ph_lo, ph_hi; };
typedef const Params __attribute__((address_space(4))) KParams;
__device__ __forceinline__ KParams* kparams() { KParams* kp = (KParams*)__builtin_amdgcn_kernarg_segment_ptr(); asm volatile("" : "+s"(kp)); return kp; }

typedef __bf16 bf16x2_t __attribute__((ext_vector_type(2)));
__device__ __forceinline__ unsigned cvt_pk_bf16(float lo, float hi) { f32x2 v = {lo, hi}; bf16x2_t b = __builtin_convertvector(v, bf16x2_t); unsigned r; __builtin_memcpy(&r, &b, 4); return r; }
__device__ __forceinline__ unsigned pack4_fp8(float a, float b, float c, float d) { int r = __builtin_amdgcn_cvt_pk_fp8_f32(a, b, 0, false); r = __builtin_amdgcn_cvt_pk_fp8_f32(c, d, r, true); return (unsigned)r; }
__device__ __forceinline__ float bf_lo(unsigned u) { return __uint_as_float(u << 16); }
__device__ __forceinline__ float bf_hi(unsigned u) { return __uint_as_float(u & 0xffff0000u); }
__device__ __forceinline__ int lane_id() { int l; asm volatile("v_mbcnt_lo_u32_b32 %0, -1, 0\n\tv_mbcnt_hi_u32_b32 %0, -1, %0" : "=v"(l)); return l; }
__device__ __forceinline__ int sxor(int x, int m) { return __builtin_amdgcn_ds_bpermute((lane_id() ^ m) << 2, x); }
__device__ __forceinline__ float sxor(float x, int m) { return __int_as_float(__builtin_amdgcn_ds_bpermute((lane_id() ^ m) << 2, __float_as_int(x))); }
template <int CTRL> __device__ __forceinline__ float dpp_f(float x) { return __int_as_float(__builtin_amdgcn_update_dpp(0, __float_as_int(x), CTRL, 0xF, 0xF, true)); }
__device__ __forceinline__ float red4(float x) { x += dpp_f<0xB1>(x); x += dpp_f<0x4E>(x); return x; }
__device__ __forceinline__ float red8(float x) { x = red4(x); x += dpp_f<0x141>(x); return x; }
__device__ __forceinline__ float red16(float x) { x = red8(x); x += dpp_f<0x140>(x); return x; }
__device__ __forceinline__ float red64(float x) { x = red16(x); x += sxor(x, 16); x += sxor(x, 32); return x; }
__device__ __forceinline__ int opaque_tid(const int wv) { int t = (wv << 6) | lane_id(); asm volatile("" : "+v"(t)); return t; }
__device__ __forceinline__ f32x4 zero4f() { float z = 0.f; asm volatile("" : "+v"(z)); return (f32x4){z, z, z, z}; }
__device__ __forceinline__ u32x4 zero4u() { unsigned z = 0u; asm volatile("" : "+v"(z)); return (u32x4){z, z, z, z}; }
__device__ __forceinline__ float sigmoidf_(float x) { return __builtin_amdgcn_rcpf(1.0f + __builtin_amdgcn_exp2f(-1.44269504f * x)); }
__device__ __forceinline__ void unpack8(const u32x4 v, float (&f)[8]) { f[0] = bf_lo(v.x); f[1] = bf_hi(v.x); f[2] = bf_lo(v.y); f[3] = bf_hi(v.y); f[4] = bf_lo(v.z); f[5] = bf_hi(v.z); f[6] = bf_lo(v.w); f[7] = bf_hi(v.w); }
__device__ __forceinline__ u32x4 pack8(const float (&f)[8]) { u32x4 w; w.x = cvt_pk_bf16(f[0], f[1]); w.y = cvt_pk_bf16(f[2], f[3]); w.z = cvt_pk_bf16(f[4], f[5]); w.w = cvt_pk_bf16(f[6], f[7]); return w; }
__device__ __forceinline__ float sumsq8(const u32x4 v) { float f[8]; unpack8(v, f); float s = 0.f;
#pragma unroll
    for (int j = 0; j < 8; ++j) s += f[j] * f[j];
    return s; }
__device__ __forceinline__ u32x4 scale8(const u32x4 v, const float rs, const float* w) { float f[8]; unpack8(v, f); const f32x4 w0 = *(const f32x4*)w, w1 = *(const f32x4*)(w + 4);
    f[0] *= rs * w0[0]; f[1] *= rs * w0[1]; f[2] *= rs * w0[2]; f[3] *= rs * w0[3]; f[4] *= rs * w1[0]; f[5] *= rs * w1[1]; f[6] *= rs * w1[2]; f[7] *= rs * w1[3]; return pack8(f); }
__device__ __forceinline__ u32x4 scale8r(const u32x4 v, const float rs, const float (&w)[8]) { float f[8]; unpack8(v, f);
#pragma unroll
    for (int j = 0; j < 8; ++j) f[j] *= rs * w[j];
    return pack8(f); }
__device__ __forceinline__ u32x4 scale8s(const u32x4 v, const float rs) { float f[8]; unpack8(v, f);
#pragma unroll
    for (int j = 0; j < 8; ++j) f[j] *= rs;
    return pack8(f); }
__device__ __forceinline__ void unpack4(const u32x2 v, float (&f)[4]) { f[0] = bf_lo(v.x); f[1] = bf_hi(v.x); f[2] = bf_lo(v.y); f[3] = bf_hi(v.y); }

#define XB_TMO      128
#define XB_XCNT(j)  (256  + 64 * (j))
#define XB_XSUB(j)  (1280 + 64 * (j))
#define XB_XGEN(j)  (2304 + 64 * (j))
#define XB_TOP      3328
#define XB_TOPGEN   3392
#define XCD_BAR_WORDS 3456
#define XB_SPIN_CAP (1u << 22)
__device__ __forceinline__ unsigned xb_ld(unsigned* p)              { return __hip_atomic_load(p, __ATOMIC_RELAXED, __HIP_MEMORY_SCOPE_AGENT); }
__device__ __forceinline__ unsigned xb_add(unsigned* p, unsigned v) { return __hip_atomic_fetch_add(p, v, __ATOMIC_RELAXED, __HIP_MEMORY_SCOPE_AGENT); }
__device__ __forceinline__ unsigned xb_xcc_id() { return (unsigned)__builtin_amdgcn_s_getreg((3 << 11) | 20) & 0xFu; }
#define XB_SPIN(cond, bar) do { unsigned _sp = 0; while (cond) { __builtin_amdgcn_s_sleep(1); \
    if ((++_sp & 255u) == 0u) { if (xb_ld(&(bar)[XB_TMO])) break; if (_sp > XB_SPIN_CAP) { atomicAdd(&(bar)[XB_TMO], 1u); break; } } } } while (0)
struct XcdBarrier { unsigned* bar; unsigned x; volatile LAS unsigned* st; };
__device__ __forceinline__ XcdBarrier xcd_barrier_post(unsigned* bar, volatile LAS unsigned* st, const int wv) {
    XcdBarrier b; b.bar = bar; b.x = xb_xcc_id(); b.st = st;
    if (wv == 0 && lane_id() == 0) (void)xb_add(&bar[XB_XCNT(b.x)], 1u);
    return b;
}
__device__ __forceinline__ void xcd_barrier_complete(unsigned* bar, unsigned x, unsigned& nloc, unsigned& nx) {
    const unsigned G = gridDim.x * gridDim.y * gridDim.z;
    unsigned sum, cnt, mine, sp = 0u;
    for (;;) {
        sum = 0u; cnt = 0u; mine = 0u;
#pragma unroll
        for (unsigned j = 0; j < 16; ++j) { const unsigned c = xb_ld(&bar[XB_XCNT(j)]); sum += c; cnt += (c > 0u) ? 1u : 0u; mine = (j == x) ? c : mine; }
        if (sum == G) break;
        __builtin_amdgcn_s_sleep(1);
        if ((++sp & 255u) == 0u) { if (xb_ld(&bar[XB_TMO])) break; if (sp > XB_SPIN_CAP) { atomicAdd(&bar[XB_TMO], 1u); break; } }
    }
    nloc = mine > 0u ? mine : 1u; nx = cnt > 0u ? cnt : 1u;
}
__device__ __forceinline__ void xcd_barrier(const XcdBarrier& b, const int wv) {
    asm volatile("s_waitcnt vmcnt(0)" ::: "memory");
    __syncthreads();
    if (wv == 0 && lane_id() == 0) {
        unsigned* bar = b.bar;
        __builtin_amdgcn_s_waitcnt(0);
        unsigned nloc = b.st[0], nx = b.st[1];
        if (nloc == 0u) { xcd_barrier_complete(bar, b.x, nloc, nx); b.st[0] = nloc; b.st[1] = nx; }
        const unsigned old = xb_add(&bar[XB_XSUB(b.x)], 1u);
        const unsigned gen = old / nloc;
        if (old + 1u == (gen + 1u) * nloc) {
            __builtin_amdgcn_fence(__ATOMIC_RELEASE, "agent");
            asm volatile("s_waitcnt vmcnt(0)" ::: "memory");
            const unsigned og = xb_add(&bar[XB_TOP], 1u);
            const unsigned tg = og / nx;
            if (og + 1u == (tg + 1u) * nx) xb_add(&bar[XB_TOPGEN], 1u);
            else XB_SPIN(xb_ld(&bar[XB_TOPGEN]) == tg, bar);
            __builtin_amdgcn_fence(__ATOMIC_ACQUIRE, "agent");
            xb_add(&bar[XB_XGEN(b.x)], 1u);
            asm volatile("s_waitcnt vmcnt(0)" ::: "memory");
        } else {
            XB_SPIN(xb_ld(&bar[XB_XGEN(b.x)]) == gen, bar);
            __builtin_amdgcn_fence(__ATOMIC_ACQUIRE, "agent");
            asm volatile("s_waitcnt vmcnt(0)" ::: "memory");
        }
    }
    __syncthreads();
}

#ifndef MFMA_BENCH
#define MFMA_BENCH 0
#endif
#ifndef EDBL
#define EDBL 0
#endif
#ifndef KMODE
#define KMODE 0
#endif
#ifndef KDBL
#define KDBL 0
#endif
struct EpiSwiglu; struct EpiYs; struct EpiZ; struct EpiMixCat; struct EpiX1;
namespace pg8 {
constexpr int BM = 256, BK = 64, HALF = 128, HTB = HALF * BK * 2, STAGE_BYTES = 8 * HTB, NXCD = 8, WGM = 8;
__host__ __device__ __forceinline__ int lds_byte(int r, int c) { const int st = (r >> 4) * 2 + (c >> 5), rr = r & 15, cc = c & 31, ob = rr * 64 + cc * 2; return st * 1024 + (ob ^ (((ob >> 9) & 1) << 5)); }
__host__ __device__ __forceinline__ void stage_rc(int b, int& R, int& C) { const int st = b / 1024, sb = b % 1024, swz = sb ^ (((sb >> 9) & 1) << 5); R = (st >> 1) * 16 + swz / 64; C = (st & 1) * 32 + (swz % 64) / 2; }
__host__ __device__ __forceinline__ int perm32(int rho) { const int n = rho >> 4, i = rho & 15; return 8 * (i >> 2) + 4 * n + (i & 3); }
struct Unit { int pm, pn, tag, aux; const char* pa; const char* pb; };
template <class E, class = void> struct HasPre { static constexpr bool value = false; };
template <class E> struct HasPre<E, decltype((void)E::PRE)> { static constexpr bool value = true; };

__device__ __forceinline__ void static_map(long L, int nM, int nN, int& pm, int& pn) {
    const int nwg = nM * nN; int wgid = (int)L;
    { const int q = nwg / NXCD, r = nwg % NXCD, xcd = wgid % NXCD, off = wgid / NXCD; wgid = (xcd < r ? xcd * (q + 1) : r * (q + 1) + (xcd - r) * q) + off; }
    const int nig = WGM * nN, gid = wgid / nig, fm = gid * WGM, gsz = (nM - fm) < WGM ? (nM - fm) : WGM;
    pm = fm + ((wgid % nig) % gsz); pn = (wgid % nig) / gsz;
}
struct DenseOrder {
    static constexpr bool GATHER = false; __device__ __forceinline__ unsigned a_off(const Unit&, int, int, int, int) const { return 0u; }
    const char* A; const char* Bt; int nM, nN, G, c; size_t tstep;
    __device__ __forceinline__ void init(const void* A_, const void* Bt_, int M, int N, int K) { A = (const char*)A_; Bt = (const char*)Bt_; nM = M / BM; nN = N / BM; G = gridDim.x; c = blockIdx.x; tstep = (size_t)BM * K * 2; }
    __device__ __forceinline__ bool next(int i, Unit& u) const {
        const long L = (long)i * G + c; if (L >= (long)nM * nN) return false;
        static_map(L, nM, nN, u.pm, u.pn); u.tag = 0; u.pa = A + (size_t)u.pm * tstep; u.pb = Bt + (size_t)u.pn * tstep; return true;
    }
};

template <int H> __device__ __forceinline__ bf16x8 half8(const i32x8 v) { const i32x4 x = H ? __builtin_shufflevector(v, v, 4, 5, 6, 7) : __builtin_shufflevector(v, v, 0, 1, 2, 3); bf16x8 r; __builtin_memcpy(&r, &x, 16); return r; }
template <class Epi, class Sched, int ES = 2>
__device__ __forceinline__ void gemm_phase(const int wv, LAS unsigned char* lds, const int K, const Sched& S, const Epi& E) {
    int tid_ = (wv << 6) | lane_id(); asm volatile("" : "+v"(tid_));
    const int tid = tid_, wid = __builtin_amdgcn_readfirstlane(tid >> 6), lane = tid & 63, wr = wid >> 2, wc = wid & 3, fr = lane & 15, fq = lane >> 4;
    const int nt = K * ES / (BK * 2);
    unsigned voffA[2], voffB[2]; int RA[2], CA[2];
#pragma unroll
    for (int i = 0; i < 2; ++i) { int R, C; stage_rc(tid * 16 + i * 8192, R, C); const int Rb = Epi::PERM ? ((R & ~31) + perm32(R & 31)) : R; RA[i] = R; CA[i] = C;
        voffA[i] = (unsigned)(R * K * ES + C * 2); voffB[i] = (unsigned)(Rb * K * ES + C * 2); }
    unsigned vA[2][2][2];
    const size_t kstep = (size_t)(BK * 2);
    const size_t hstep = (size_t)HALF * K * ES;
    const unsigned ldsw = (unsigned)wid * 1024u;
    const int aoff = lds_byte(wr * 64 + fr, fq * 8), boff = lds_byte(wc * 32 + fr, fq * 8);
#define PG8_SA(b, h) (((b) * 2 + (h)) * HTB)
#define PG8_SB(b, h) ((4 + (b) * 2 + (h)) * HTB)
#define PG8_STAGE(bufoff, gbase, voff) do { _Pragma("unroll") for (int _i = 0; _i < 2; ++_i) \
        __builtin_amdgcn_global_load_lds((const unsigned*)((const char*)(gbase) + (voff)[_i]), (LAS unsigned*)(lds + (bufoff) + ldsw + _i * 8192), 16, 0, 0); } while (0)
#define PG8_LDA(dst, b, h) do { _Pragma("unroll") for (int m = 0; m < 4; ++m) { const i32x4 _lo = *(const LAS i32x4*)(lds + PG8_SA(b, h) + aoff + m * 2048), _hi = *(const LAS i32x4*)(lds + PG8_SA(b, h) + aoff + m * 2048 + 1024); dst[m] = __builtin_shufflevector(_lo, _hi, 0, 1, 2, 3, 4, 5, 6, 7); } } while (0)
#define PG8_LDB(dst, b, h) do { _Pragma("unroll") for (int n = 0; n < 2; ++n) { const i32x4 _lo = *(const LAS i32x4*)(lds + PG8_SB(b, h) + boff + n * 2048), _hi = *(const LAS i32x4*)(lds + PG8_SB(b, h) + boff + n * 2048 + 1024); dst[n] = __builtin_shufflevector(_lo, _hi, 0, 1, 2, 3, 4, 5, 6, 7); } } while (0)
#define PG8_MMA(ai, bj, At, Bt) do { __builtin_amdgcn_s_setprio(1); _Pragma("unroll") for (int m = 0; m < 4; ++m) _Pragma("unroll") for (int n = 0; n < 2; ++n) { \
        if (ES == 2) { acc[ai][bj][m][n] = __builtin_amdgcn_mfma_f32_16x16x32_bf16(half8<0>(Bt[n]), half8<0>(At[m]), acc[ai][bj][m][n], 0, 0, 0); \
                       acc[ai][bj][m][n] = __builtin_amdgcn_mfma_f32_16x16x32_bf16(half8<1>(Bt[n]), half8<1>(At[m]), acc[ai][bj][m][n], 0, 0, 0); } \
        else asm volatile("v_mfma_scale_f32_16x16x128_f8f6f4 %0, %1, %2, %0, %3, %3 op_sel_hi:[0,0,0]" : "+v"(acc[ai][bj][m][n]) : "v"(Bt[n]), "v"(At[m]), "v"(one_scale)); } \
        __builtin_amdgcn_s_setprio(0); } while (0)
#define PG8_WAIT_V(n) asm volatile("s_waitcnt vmcnt(" #n ")" ::: "memory")
#define PG8_WAIT_L(n) asm volatile("s_waitcnt lgkmcnt(" #n ")" ::: "memory")
#define PG8_BAR __builtin_amdgcn_s_barrier()
#define PG8_SCHED __builtin_amdgcn_sched_barrier(0)
    constexpr int kd = (KDBL == 1 && (__is_same(Epi, EpiSwiglu) || __is_same(Epi, EpiYs))) || (KDBL == 2 && __is_same(Epi, EpiZ)) || (KDBL == 3 && (__is_same(Epi, EpiMixCat) || __is_same(Epi, EpiX1))) ? 1 : 0;
    Unit cur, nxt; int ui = 0;
    if (!S.next(0, cur)) return;
    cur.aux = 0; if constexpr (HasPre<Epi>::value) E.pre(cur, wid, wc, lane);
    f32x4 acc[2][2][4][2]; const f32x4 zz0 = zero4f();
#pragma unroll
    for (int a = 0; a < 2; ++a)
#pragma unroll
        for (int b = 0; b < 2; ++b)
#pragma unroll
            for (int m = 0; m < 4; ++m)
#pragma unroll
                for (int n = 0; n < 2; ++n) acc[a][b][m][n] = zz0;
    i32x8 At[4], B0[2], B1[2];
    const int one_scale = 0x7f7f7f7f;
    const char* cA = cur.pa; const char* cB = cur.pb;
#pragma unroll
    for (int h = 0; h < 2; ++h)
#pragma unroll
        for (int i = 0; i < 2; ++i) vA[0][h][i] = Sched::GATHER ? S.a_off(cur, h, RA[i], CA[i], K * ES) : voffA[i] + (unsigned)(h * hstep);
    if constexpr (kd && KMODE == 1) { cA = S.A; cB = S.Bt;
#pragma unroll
        for (int h = 0; h < 2; ++h)
#pragma unroll
            for (int i = 0; i < 2; ++i) vA[0][h][i] = voffA[i] + (unsigned)(h * hstep); }
    PG8_STAGE(PG8_SB(0, 0), cB, voffB); PG8_STAGE(PG8_SA(0, 0), cA, vA[0][0]); PG8_STAGE(PG8_SB(0, 1), cB + hstep, voffB); PG8_STAGE(PG8_SA(0, 1), cA, vA[0][1]);
    if (wr == 1) PG8_BAR;
    PG8_WAIT_V(4); PG8_BAR;
    PG8_STAGE(PG8_SB(1, 0), cB + kstep, voffB); PG8_STAGE(PG8_SA(1, 0), cA + kstep, vA[0][0]); PG8_STAGE(PG8_SB(1, 1), cB + hstep + kstep, voffB);
    PG8_WAIT_V(6); PG8_BAR;
    for (;;) {
        const bool has_next = S.next((ui + 1) >> kd, nxt);
        const char* nA = has_next ? nxt.pa : cA; const char* nB = has_next ? nxt.pb : cB;
#pragma unroll
        for (int h = 0; h < 2; ++h)
#pragma unroll
            for (int i = 0; i < 2; ++i) vA[1][h][i] = has_next ? (Sched::GATHER ? S.a_off(nxt, h, RA[i], CA[i], K * ES) : voffA[i] + (unsigned)(h * hstep)) : vA[0][h][i];
        if constexpr (kd && KMODE == 1) { if (has_next && (ui & 1)) { nA = S.A; nB = S.Bt;
#pragma unroll
            for (int h = 0; h < 2; ++h)
#pragma unroll
                for (int i = 0; i < 2; ++i) vA[1][h][i] = voffA[i] + (unsigned)(h * hstep); } }
        const bool ld = !(kd && KMODE == 2 && !(ui & 1));
#pragma clang loop unroll(disable)
        for (int t = 0; t < nt; t += 2) {
            if constexpr (Epi::MID) { if (t == 8 || t == 12) E.mid(acc, cur, t, wr, wc, fr, fq); }
            const bool last = (t == nt - 2);
            const char* a1 = cA + (size_t)(t + 1) * kstep;
            const char* a2 = last ? nA : cA + (size_t)(t + 2) * kstep; const char* b2 = last ? nB : cB + (size_t)(t + 2) * kstep;
            const char* a3 = a2 + kstep; const char* b3 = b2 + kstep;
            unsigned w0[2], w1[2];
#pragma unroll
            for (int i = 0; i < 2; ++i) { w0[i] = vA[0][0][i]; w1[i] = vA[0][1][i]; }
            if (last) { asm volatile("" ::: "memory");
#pragma unroll
                for (int i = 0; i < 2; ++i) { w0[i] = vA[1][0][i]; w1[i] = vA[1][1][i]; } }
            PG8_LDB(B0, 0, 0); PG8_SCHED; PG8_LDA(At, 0, 0); if (ld) PG8_STAGE(PG8_SA(1, 1), a1, vA[0][1]);
            PG8_WAIT_L(8); PG8_BAR; PG8_WAIT_L(0); PG8_MMA(0, 0, At, B0); PG8_BAR; PG8_SCHED;
            PG8_LDB(B1, 0, 1); if (ld || last) PG8_STAGE(PG8_SB(0, 0), b2, voffB);
            PG8_BAR; PG8_WAIT_L(0); PG8_MMA(0, 1, At, B1); PG8_BAR;
            PG8_LDA(At, 0, 1); if (ld || last) PG8_STAGE(PG8_SA(0, 0), a2, w0);
            PG8_BAR; PG8_WAIT_L(0); PG8_MMA(1, 0, At, B0); PG8_BAR; PG8_SCHED;
            if (ld || last) PG8_STAGE(PG8_SB(0, 1), b2 + hstep, voffB);
            PG8_WAIT_V(6); PG8_BAR; PG8_MMA(1, 1, At, B1); PG8_BAR;
            PG8_LDB(B0, 1, 0); PG8_SCHED; PG8_LDA(At, 1, 0); if (ld || last) PG8_STAGE(PG8_SA(0, 1), a2, w1);
            PG8_WAIT_L(8); PG8_BAR; PG8_WAIT_L(0); PG8_MMA(0, 0, At, B0); PG8_BAR; PG8_SCHED;
            PG8_LDB(B1, 1, 1); if (ld || last) PG8_STAGE(PG8_SB(1, 0), b3, voffB);
            PG8_BAR; PG8_WAIT_L(0); PG8_MMA(0, 1, At, B1); PG8_BAR;
            PG8_LDA(At, 1, 1); if (ld || last) PG8_STAGE(PG8_SA(1, 0), a3, w0);
            PG8_BAR; PG8_WAIT_L(0); PG8_MMA(1, 0, At, B0); PG8_BAR; PG8_SCHED;
            if (ld || last) PG8_STAGE(PG8_SB(1, 1), b3 + hstep, voffB);
            PG8_WAIT_V(6); PG8_BAR; PG8_MMA(1, 1, At, B1); PG8_BAR;
        }
        if (ES == 1) asm volatile("s_nop 15\n\ts_nop 15" ::: "memory");
        if (!kd || (ui & 1)) E(acc, cur, wr, wc, fr, fq);
        if constexpr (EDBL == 1 && (__is_same(Epi, EpiSwiglu) || __is_same(Epi, EpiYs))) { asm volatile("" ::: "memory"); E(acc, cur, wr, wc, fr, fq); }
        if (!has_next) break;
        const f32x4 zz1 = zero4f();
#pragma unroll
        for (int a = 0; a < 2; ++a)
#pragma unroll
            for (int b = 0; b < 2; ++b)
#pragma unroll
                for (int m = 0; m < 4; ++m)
#pragma unroll
                    for (int n = 0; n < 2; ++n) acc[a][b][m][n] = zz1;
        cur = nxt; cA = nA; cB = nB; ++ui;
        cur.aux = ui & 1; if constexpr (HasPre<Epi>::value) E.pre(cur, wid, wc, lane);
#pragma unroll
        for (int h = 0; h < 2; ++h)
#pragma unroll
            for (int i = 0; i < 2; ++i) vA[0][h][i] = vA[1][h][i];
    }
    PG8_WAIT_V(0);
    if (wr == 0) PG8_BAR;
    PG8_BAR;
#undef PG8_SA
#undef PG8_SB
#undef PG8_STAGE
#undef PG8_LDA
#undef PG8_LDB
#undef PG8_MMA
#undef PG8_WAIT_V
#undef PG8_WAIT_L
#undef PG8_BAR
#undef PG8_SCHED
}
}
using pg8::Unit;

struct EpiZ {
    static constexpr bool PERM = true, MID = false;
    bf16_t* Z; bf16_t* KV; bf16_t* GFp; int pn0; float scale;
    __device__ __forceinline__ void operator()(const f32x4 (&acc)[2][2][4][2], const Unit& u, int wr, int wc, int fr, int fq) const {
        const bool kvu = u.pn >= 32; const int pn = (u.pn & 31) + (kvu ? 0 : pn0);
        bf16_t* base = kvu ? KV : Z; const int ldc = kvu ? 1024 : INC; const bool sg = (!kvu) && (pn >= C_GATE / 256);
        if (sg) {
            bf16_t* gf = GFp + ((size_t)(u.pm * 12 + (pn - C_GATE / 256)) * 16) * 4096 + (size_t)((wr * 4 + wc) * 64 + fq * 16 + fr) * 8;
#pragma unroll
            for (int ai = 0; ai < 2; ++ai)
#pragma unroll
                for (int m = 0; m < 4; ++m)
#pragma unroll
                    for (int bj = 0; bj < 2; ++bj) { f32x4 v0 = acc[ai][bj][m][0] * scale, v1 = acc[ai][bj][m][1] * scale;
#pragma unroll
                        for (int j = 0; j < 4; ++j) { v0[j] = sigmoidf_(v0[j]); v1[j] = sigmoidf_(v1[j]); }
                        u32x4 w; w.x = cvt_pk_bf16(v0[0], v0[1]); w.y = cvt_pk_bf16(v0[2], v0[3]); w.z = cvt_pk_bf16(v1[0], v1[1]); w.w = cvt_pk_bf16(v1[2], v1[3]);
                        *(u32x4*)(gf + (size_t)((ai * 4 + m) * 2 + bj) * 4096) = w; }
            return; }
        const int row0 = u.pm * 256 + wr * 64 + fr, col0 = pn * 256 + wc * 32 + 8 * fq;
#pragma unroll
        for (int ai = 0; ai < 2; ++ai)
#pragma unroll
            for (int m = 0; m < 4; ++m) { bf16_t* rowp = base + (size_t)(row0 + ai * 128 + m * 16) * ldc + col0;
#pragma unroll
                for (int bj = 0; bj < 2; ++bj) { f32x4 v0 = acc[ai][bj][m][0] * scale, v1 = acc[ai][bj][m][1] * scale;
                    if (sg) {
#pragma unroll
                        for (int j = 0; j < 4; ++j) { v0[j] = sigmoidf_(v0[j]); v1[j] = sigmoidf_(v1[j]); } }
                    u32x4 w; w.x = cvt_pk_bf16(v0[0], v0[1]); w.y = cvt_pk_bf16(v0[2], v0[3]); w.z = cvt_pk_bf16(v1[0], v1[1]); w.w = cvt_pk_bf16(v1[2], v1[3]);
                    *(u32x4*)(rowp + bj * 128) = w; } }
    }
};
struct SchedZ8 {
    static constexpr bool GATHER = false; __device__ __forceinline__ unsigned a_off(const Unit&, int, int, int, int) const { return 0u; }
    const char* H8; const char* WIN8; int G, c;
    __device__ __forceinline__ bool next(int i, Unit& u) const {
        const long L = (long)i * G + c; if (L >= 64 * 23) return false;
        pg8::static_map(L, 64, 23, u.pm, u.pn); u.tag = 0; u.pa = H8 + (size_t)u.pm * (256 * 1024); u.pb = WIN8 + (size_t)u.pn * (256 * 1024); return true;
    }
};
struct SchedZ {
    static constexpr bool GATHER = false; __device__ __forceinline__ unsigned a_off(const Unit&, int, int, int, int) const { return 0u; }
    const char* H; const char* WinT; const char* HM; const char* WmkvT; int G, c;
    __device__ __forceinline__ bool next(int i, Unit& u) const {
        const long L = (long)i * G + c; if (L >= 480) return false;
        const size_t tstep = (size_t)256 * 1024 * 2;
        if (L < 448) { pg8::static_map(L, 64, 7, u.pm, u.pn); u.tag = 0; u.pa = H + (size_t)u.pm * tstep; u.pb = WinT + (size_t)u.pn * tstep; }
        else { const int q = (int)(L - 448); u.pm = q >> 2; u.pn = 32 + (q & 3); u.tag = 0; u.pa = HM + (size_t)u.pm * tstep; u.pb = WmkvT + (size_t)(q & 3) * tstep; }
        return true;
    }
};
struct EpiLora {
    static constexpr bool PERM = false, MID = false;
    float* L; const float* w0; const float* a0;
    __device__ __forceinline__ void operator()(const f32x4 (&acc)[2][2][4][2], const Unit& u, int wr, int wc, int fr, int fq) const {
        const int row0 = u.pm * 256 + wr * 64 + fr, col0 = u.pn * 256 + wc * 32 + 4 * fq; const int kind = u.pn >> 1; const f32x4 zb = zero4f();
#pragma unroll
        for (int bj = 0; bj < 2; ++bj)
#pragma unroll
            for (int n = 0; n < 2; ++n) { const int c = col0 + bj * 128 + n * 16;
                f32x4 bv = zb;
                if (kind == 0) bv = *(const f32x4*)(w0 + c); else if (kind == 1) bv = *(const f32x4*)(a0 + (c - 512));
#pragma unroll
                for (int ai = 0; ai < 2; ++ai)
#pragma unroll
                    for (int m = 0; m < 4; ++m) { f32x4 v = acc[ai][bj][m][n] + bv;
                        if (kind == 0) {
#pragma unroll
                            for (int j = 0; j < 4; ++j) v[j] = -0.60653066f * sigmoidf_(v[j]); }
                        else if (kind == 1) {
#pragma unroll
                            for (int j = 0; j < 4; ++j) v[j] = sigmoidf_(v[j]); }
                        const size_t row = (size_t)(row0 + ai * 128 + m * 16);
                        if (kind == 0) *(f32x4*)(L + row * 512 + c) = v;
                        else { u32x2 w; w.x = cvt_pk_bf16(v[0], v[1]); w.y = cvt_pk_bf16(v[2], v[3]); *(u32x2*)((bf16_t*)(L + (size_t)NTOK * 512) + row * 1024 + (c - 512)) = w; } } }
    }
};
template <int mode> struct EpiMix {
    static constexpr bool PERM = false, MID = false;
    float* mix32; bf16_t* mixbf; const bf16_t* Z;
    __device__ __forceinline__ void operator()(const f32x4 (&acc)[2][2][4][2], const Unit& u, int wr, int wc, int fr, int fq) const {
        const int row0 = u.pm * 256 + wr * 64 + fr, col0 = u.pn * 256 + wc * 32 + 4 * fq;
#pragma unroll
        for (int ai = 0; ai < 2; ++ai)
#pragma unroll
            for (int m = 0; m < 4; ++m) { const size_t row = (size_t)(row0 + ai * 128 + m * 16);
#pragma unroll
                for (int bj = 0; bj < 2; ++bj)
#pragma unroll
                    for (int n = 0; n < 2; ++n) { const int c = col0 + bj * 128 + n * 16;
                        const u32x2 gz = *(const u32x2*)(Z + row * INC + C_GATE + mode * 1024 + c); float g[4]; unpack4(gz, g);
                        f32x4 v = acc[ai][bj][m][n]; v[0] *= g[0]; v[1] *= g[1]; v[2] *= g[2]; v[3] *= g[3];
                        if (mode > 0) v += *(const f32x4*)(mix32 + row * 1024 + c);
                        if (mode < 2) *(f32x4*)(mix32 + row * 1024 + c) = v;
                        else { u32x2 w; w.x = cvt_pk_bf16(v[0], v[1]); w.y = cvt_pk_bf16(v[2], v[3]); *(u32x2*)(mixbf + row * 1024 + c) = w; } }
                asm volatile("" ::: "memory"); }
    }
};
struct EpiMixCat {
    static constexpr bool PERM = true, MID = true;
    bf16_t* mixbf; const bf16_t* GF; int tid;
    __device__ __forceinline__ const bf16_t* gtile(const Unit& u, int b) const { return GF + ((size_t)(u.pm * 12 + 4 * b + u.pn) * 16) * 4096 + (size_t)tid * 8; }
    __device__ __forceinline__ void mid(f32x4 (&acc)[2][2][4][2], const Unit& u, int t, int wr, int wc, int fr, int fq) const {
        const int ga = (t == 8) ? 0 : 1; int off = 0; asm volatile("" : "+v"(off));
        const bf16_t* pa = gtile(u, ga) + off; const bf16_t* pb = gtile(u, ga + 1) + off;
#pragma unroll
        for (int ai = 0; ai < 2; ++ai) {
#pragma unroll
            for (int m = 0; m < 4; ++m)
#pragma unroll
                for (int bj = 0; bj < 2; ++bj) { float a[8], b[8]; unpack8(*(const u32x4*)(pa + (size_t)((ai * 4 + m) * 2 + bj) * 4096), a); unpack8(*(const u32x4*)(pb + (size_t)((ai * 4 + m) * 2 + bj) * 4096), b);
#pragma unroll
                    for (int j = 0; j < 4; ++j) { acc[ai][bj][m][0][j] *= a[j] * __builtin_amdgcn_rcpf(b[j]); acc[ai][bj][m][1][j] *= a[4 + j] * __builtin_amdgcn_rcpf(b[4 + j]); } }
            asm volatile("" ::: "memory"); }
    }
    __device__ __forceinline__ void operator()(const f32x4 (&acc)[2][2][4][2], const Unit& u, int wr, int wc, int fr, int fq) const {
        const int row0 = u.pm * 256 + wr * 64 + fr, col0 = u.pn * 256 + wc * 32 + 8 * fq; const bf16_t* pg = gtile(u, 2);
#pragma unroll
        for (int ai = 0; ai < 2; ++ai)
#pragma unroll
            for (int m = 0; m < 4; ++m) { bf16_t* rowp = mixbf + (size_t)(row0 + ai * 128 + m * 16) * 1024 + col0;
#pragma unroll
                for (int bj = 0; bj < 2; ++bj) { float g[8]; unpack8(*(const u32x4*)(pg + (size_t)((ai * 4 + m) * 2 + bj) * 4096), g);
                    const f32x4 v0 = acc[ai][bj][m][0], v1 = acc[ai][bj][m][1];
                    u32x4 w; w.x = cvt_pk_bf16(v0[0] * g[0], v0[1] * g[1]); w.y = cvt_pk_bf16(v0[2] * g[2], v0[3] * g[3]); w.z = cvt_pk_bf16(v1[0] * g[4], v1[1] * g[5]); w.w = cvt_pk_bf16(v1[2] * g[6], v1[3] * g[7]);
                    *(u32x4*)(rowp + bj * 128) = w; } }
    }
};
struct EpiX1 {
    static constexpr bool PERM = true, MID = false;
    const float* x; bf16_t* x1;
    __device__ __forceinline__ void operator()(const f32x4 (&acc)[2][2][4][2], const Unit& u, int wr, int wc, int fr, int fq) const {
        const int row0 = u.pm * 256 + wr * 64 + fr, col0 = u.pn * 256 + wc * 32 + 8 * fq;
#pragma unroll
        for (int ai = 0; ai < 2; ++ai)
#pragma unroll
            for (int m = 0; m < 4; ++m) { const size_t off = (size_t)(row0 + ai * 128 + m * 16) * 1024 + col0;
#pragma unroll
                for (int bj = 0; bj < 2; ++bj) { const f32x4 a = __builtin_nontemporal_load((const f32x4*)(x + off + bj * 128)) + acc[ai][bj][m][0], b = __builtin_nontemporal_load((const f32x4*)(x + off + bj * 128 + 4)) + acc[ai][bj][m][1];
                    u32x4 w; w.x = cvt_pk_bf16(a[0], a[1]); w.y = cvt_pk_bf16(a[2], a[3]); w.z = cvt_pk_bf16(b[0], b[1]); w.w = cvt_pk_bf16(b[2], b[3]);
                    *(u32x4*)(x1 + off + bj * 128) = w; }
                if (m & 1) asm volatile("" ::: "memory"); }
    }
};
struct EpiSwiglu {
    static constexpr bool PERM = true, MID = false;
    static constexpr bool PRE = true;
    unsigned char* act; const float* b1; LAS unsigned char* lds;
    __device__ __forceinline__ void pre(const Unit& u, int wid, int wc, int lane) const {
        __builtin_amdgcn_global_load_lds((const unsigned*)(b1 + (size_t)u.tag * 2048 + 256 * u.pn + 64 * wc + lane), (LAS unsigned*)(lds + 131072 + u.aux * 2048 + wid * 256), 4, 0, 0); }
    __device__ __forceinline__ void operator()(const f32x4 (&acc)[2][2][4][2], const Unit& u, int wr, int wc, int fr, int fq) const {
        const int row0 = u.pm * 256 + wr * 64 + fr; const LAS float* be = (const LAS float*)(lds + 131072 + u.aux * 2048 + (wr * 4 + wc) * 256) + 16 * fq; const int j = 128 * u.pn + 32 * wc + 8 * fq;
        constexpr float CS = -1.702f * 1.44269504f, ICS = 1.0f / CS;
        float bg[8], bl[8];
#pragma unroll
        for (int q = 0; q < 4; ++q) { const f32x4 t = *(const LAS f32x4*)(be + 4 * q); bg[2 * q] = t[0] * CS; bl[2 * q] = (4.0f * t[1] + 4.0f) * ICS; bg[2 * q + 1] = t[2] * CS; bl[2 * q + 1] = (4.0f * t[3] + 4.0f) * ICS; }
#pragma unroll
        for (int ai = 0; ai < 2; ++ai)
#pragma unroll
            for (int m = 0; m < 4; ++m) { float o[8];
#pragma unroll
                for (int n = 0; n < 2; ++n)
#pragma unroll
                    for (int i = 0; i < 4; ++i) { const float sg = fmaxf(fmaf(acc[ai][0][m][n][i], CS / 256.0f, bg[4 * n + i]), 7.0f * CS);
                        const float ql = __builtin_amdgcn_fmed3f(fmaf(acc[ai][1][m][n][i], 4.0f * ICS / 256.0f, bl[4 * n + i]), -24.0f * ICS, 32.0f * ICS);
                        o[4 * n + i] = sg * __builtin_amdgcn_rcpf(1.0f + __builtin_amdgcn_exp2f(sg)) * ql; }
                u32x2 w; w.x = pack4_fp8(o[0], o[1], o[2], o[3]); w.y = pack4_fp8(o[4], o[5], o[6], o[7]);
                *(u32x2*)(act + (size_t)(row0 + ai * 128 + m * 16) * 1024 + j) = w; }
    }
};
struct EpiYs {
    static constexpr bool PERM = true, MID = false;
    static constexpr bool PRE = true;
    bf16_t* ys; const float* b2; LAS unsigned char* lds;
    __device__ __forceinline__ void pre(const Unit& u, int wid, int wc, int lane) const {
        __builtin_amdgcn_global_load_lds((const unsigned*)(b2 + (size_t)u.tag * 1024 + 256 * u.pn + (lane >> 5) * 128 + 32 * wc + (lane & 31)), (LAS unsigned*)(lds + 131072 + u.aux * 2048 + wid * 256), 4, 0, 0); }
    __device__ __forceinline__ void operator()(const f32x4 (&acc)[2][2][4][2], const Unit& u, int wr, int wc, int fr, int fq) const {
        const int row0 = u.pm * 256 + wr * 64 + fr, col0 = u.pn * 256 + wc * 32 + 8 * fq; const LAS float* be = (const LAS float*)(lds + 131072 + u.aux * 2048 + (wr * 4 + wc) * 256) + 8 * fq;
#pragma unroll
        for (int bj = 0; bj < 2; ++bj) { const f32x4 c0 = *(const LAS f32x4*)(be + bj * 32), c1 = *(const LAS f32x4*)(be + bj * 32 + 4);
#pragma unroll
            for (int ai = 0; ai < 2; ++ai)
#pragma unroll
                for (int m = 0; m < 4; ++m) { const f32x4 v0 = acc[ai][bj][m][0] * (1.0f / 128.0f) + c0, v1 = acc[ai][bj][m][1] * (1.0f / 128.0f) + c1;
                    u32x4 w; w.x = cvt_pk_bf16(v0[0], v0[1]); w.y = cvt_pk_bf16(v0[2], v0[3]); w.z = cvt_pk_bf16(v1[0], v1[1]); w.w = cvt_pk_bf16(v1[2], v1[3]);
                    *(u32x4*)(ys + (size_t)(row0 + ai * 128 + m * 16) * 1024 + col0 + bj * 128) = w; } }
    }
};
template <bool GATHER_> struct SchedMoe {
    static constexpr bool GATHER = GATHER_;
    const char* A; const char* Bt; const LAS int* tstart; const int* stok; int lgN, total; size_t estride, tbytes;
    __device__ __forceinline__ bool next(int i, Unit& u) const {
        const int c = blockIdx.x; const int un = i * 256 + (c & 7) * 32 + (c >> 3); if (un >= total) return false;
        const int mt = un >> lgN, pn = un & ((1 << lgN) - 1); const int e = ((const LAS unsigned char*)tstart)[(LX_TEXP - LX_TSTART) + mt];
        u.pm = mt; u.pn = pn; u.tag = e; u.pa = GATHER ? A : A + (size_t)mt * tbytes; u.pb = Bt + (size_t)e * estride + (size_t)pn * tbytes; return true;
    }
    __device__ __forceinline__ unsigned a_off(const Unit& u, int h, int R, int C, int rowbytes) const { const int e = u.tag, ps = u.pm * 256 + h * 128 + R - tstart[(LX_SBASE - LX_TSTART) / 4 + e];
        const int tok = ps < tstart[(LX_CNT - LX_TSTART) / 4 + e] ? stok[(size_t)e * NTOK + ps] : 0; return (unsigned)(tok * rowbytes + C * 2); }
};

__device__ __forceinline__ int w1perm(int c) { const int j = c >> 1, s = c & 1; return ((j >> 7) << 8) | (s << 7) | (j & 127); }
constexpr int NTILE = 13664, TAIL1_A = 6, TAIL1_B = 20, TAIL6 = 8, NRES1 = 32 * TAIL1_A + 32 * TAIL1_B, NRES = NRES1 + 128 * TAIL6;
template <class F> __device__ __forceinline__ void prep_tiles(const int wv, LAS unsigned char* lds, const int cnt, F tile_of) {
    KParams& p = *kparams();
    const int tid = opaque_tid(wv); unsigned char* ws = p.ws;
    LAS float* tile = (LAS float*)lds;
    if (cnt <= 0) return;
    struct TileJob { const float* src; bf16_t* dst; unsigned char* dst8; int K, N, perm, f8, ldd, k0, n0; };
    auto decode = [&](int t) -> TileJob { TileJob j; j.dst = nullptr; j.dst8 = nullptr; j.f8 = 0; j.perm = 0; j.ldd = 0; int lt;
        if (t < 960) { j.src = p.in[3]; j.dst = (bf16_t*)(ws + OFF_WINT); j.K = 1024; j.N = 7680; lt = t; if ((lt % 120) >= 28) { j.f8 = 1; j.dst8 = ws + OFF_WIN8 - (size_t)1792 * 1024; } }
        else if (t < 1088) { j.src = p.in[18]; j.dst = (bf16_t*)(ws + OFF_WMKVT); j.K = 1024; j.N = 1024; lt = t - 960; }
        else if (t < 1152) { j.src = p.in[21]; j.dst = (bf16_t*)(ws + OFF_PCAT); j.K = 512; j.N = 1024; lt = t - 1088; j.ldd = 1280; }
        else if (t < 1184) { j.src = p.in[22]; j.dst = (bf16_t*)(ws + OFF_PCAT) + 512; j.K = 256; j.N = 1024; lt = t - 1152; j.ldd = 1280; }
        else if (t < 1248) { j.src = p.in[23]; j.dst = (bf16_t*)(ws + OFF_PCAT) + 768; j.K = 512; j.N = 1024; lt = t - 1184; j.ldd = 1280; }
        else if (t < 1376) { j.src = p.in[24]; j.dst = (bf16_t*)(ws + OFF_WOT); j.K = 1024; j.N = 1024; lt = t - 1248; }
        else if (t < 9568) { const int q = t - 1376, e = q >> 8; j.src = p.in[28] + (size_t)e * 1024 * 2048; j.dst8 = ws + OFF_W1T + (size_t)e * 2048 * 1024; j.K = 1024; j.N = 2048; j.perm = 1; lt = q & 255; j.f8 = 1; }
        else { const int q = t - 9568, e = q >> 7; j.src = p.in[30] + (size_t)e * 1024 * 1024; j.dst8 = ws + OFF_W2T + (size_t)e * 1024 * 1024; j.K = 1024; j.N = 1024; lt = q & 127; j.f8 = 1; }
        const int tn = j.N >> 6; j.k0 = (lt / tn) * 128; j.n0 = (lt % tn) * 64; return j; };
    { auto ldtile = [&](const TileJob& j, f32x4 (&v)[4]) {
#pragma unroll
          for (int i = 0; i < 4; ++i) { const int idx = tid + 512 * i, row = idx >> 4, c4 = idx & 15; v[i] = __builtin_nontemporal_load((const f32x4*)(j.src + (size_t)(j.k0 + row) * j.N + j.n0 + 4 * c4)); } };
      TileJob j0 = decode(tile_of(0)), j1 = decode(tile_of(cnt > 1 ? 1 : 0)); f32x4 v0[4], v1[4];
      ldtile(j0, v0);
      if (cnt > 1) ldtile(j1, v1);
      for (int n = 0; n < cnt; ++n) {
#pragma unroll
          for (int i = 0; i < 4; ++i) { const int idx = tid + 512 * i, row = idx >> 4, c4 = idx & 15; LAS float* tp = tile + row * 65 + 4 * c4; tp[0] = v0[i][0]; tp[1] = v0[i][1]; tp[2] = v0[i][2]; tp[3] = v0[i][3]; }
          __syncthreads();
          const TileJob cur = j0; j0 = j1;
#pragma unroll
          for (int i = 0; i < 4; ++i) v0[i] = v1[i];
          if (n + 2 < cnt) { j1 = decode(tile_of(n + 2)); ldtile(j1, v1); }
          if (!cur.f8) {
#pragma unroll
              for (int i = 0; i < 2; ++i) { const int kc = (tid & 3) | (((tid >> 8) & 1) << 2) | (i << 3), n = (tid >> 2) & 63; float f[8];
#pragma unroll
                  for (int j = 0; j < 8; ++j) f[j] = tile[(kc * 8 + j) * 65 + n];
                  const int drow = cur.n0 + n;
                  *(u32x4*)(cur.dst + (size_t)drow * (cur.ldd ? cur.ldd : cur.K) + cur.k0 + kc * 8) = pack8(f); }
          } else {
              const int kc = (tid & 3) | (((tid >> 8) & 1) << 2), n = (tid >> 2) & 63; float f[16];
#pragma unroll
              for (int j = 0; j < 16; ++j) f[j] = tile[(kc * 16 + j) * 65 + n] * 32.0f;
              const int drow = cur.perm ? w1perm(cur.n0 + n) : (cur.n0 + n);
              u32x4 w; w.x = pack4_fp8(f[0], f[1], f[2], f[3]); w.y = pack4_fp8(f[4], f[5], f[6], f[7]); w.z = pack4_fp8(f[8], f[9], f[10], f[11]); w.w = pack4_fp8(f[12], f[13], f[14], f[15]);
              *(u32x4*)(cur.dst8 + (size_t)drow * cur.K + cur.k0 + kc * 16) = w; }
          __syncthreads(); } }
}
__device__ __forceinline__ void phase_prep(const int wv, LAS unsigned char* lds) {
    KParams& p = *kparams();
    const int tid = opaque_tid(wv); unsigned char* ws = p.ws;
    { const int G = (int)gridDim.x, top = NTILE - NRES - 1 - (int)blockIdx.x; prep_tiles(wv, lds, top >= 0 ? top / G + 1 : 0, [&](int n) { return top - n * G; }); }
    { const float* w2 = p.in[6]; const float* a2 = p.in[8]; const float* g2 = p.in[9]; bf16_t* lt = (bf16_t*)(ws + OFF_LORAT);
      for (int idx = blockIdx.x * 512 + tid; idx < 1536 * 32; idx += gridDim.x * 512) { const int n = idx >> 5, kc = idx & 31; float f[8];
#pragma unroll
          for (int j = 0; j < 8; ++j) { const int k = kc * 8 + j; float val = 0.f;
              if (n < 512) { if (k < 64) val = w2[k * 512 + n]; }
              else if (n < 1024) { if (k >= 64 && k < 128) val = a2[(k - 64) * 512 + (n - 512)]; }
              else { if (k >= 128) val = g2[(k - 128) * 512 + (n - 1024)]; }
              f[j] = val; }
          *(u32x4*)(lt + (size_t)n * 256 + kc * 8) = pack8(f); } }
    { const float* wr = p.in[26]; bf16_t* wt = (bf16_t*)(ws + OFF_WRT);
      for (int idx = blockIdx.x * 512 + tid; idx < 32 * 1024; idx += gridDim.x * 512) { const int e = idx >> 10, k = idx & 1023; const float v = wr[k * 32 + e];
          const unsigned hi = cvt_pk_bf16(v, 0.f) & 0xffffu; const float vh = __uint_as_float(hi << 16); const unsigned lo = cvt_pk_bf16(v - vh, 0.f) & 0xffffu;
          wt[idx] = (bf16_t)hi; wt[32768 + idx] = (bf16_t)lo; } }
    { const int wid = tid >> 6, lane = tid & 63; const int gw = blockIdx.x * 8 + wid, nw = gridDim.x * 8;
      for (int row0 = gw; row0 < NTOK + 2048; row0 += 3 * nw) {
          f32x4 v[3][4];
#pragma unroll
          for (int r3 = 0; r3 < 3; ++r3) { const int row = row0 + r3 * nw; if (row < NTOK + 2048) { const float* src = row >= NTOK ? p.in[1] + (size_t)(row - NTOK) * 1024 : p.in[0] + (size_t)row * 1024;
#pragma unroll
              for (int i = 0; i < 4; ++i) v[r3][i] = __builtin_nontemporal_load((const f32x4*)(src + 4 * lane + 256 * i)); } }
#pragma unroll
          for (int r3 = 0; r3 < 3; ++r3) { const int row = row0 + r3 * nw; if (row >= NTOK + 2048) break;
              const bool ism = row >= NTOK; const float* gain = ism ? p.in[17] : p.in[2]; bf16_t* dst = ism ? (bf16_t*)(ws + OFF_HM) + (size_t)(row - NTOK) * 1024 : (bf16_t*)(ws + OFF_H) + (size_t)row * 1024;
              float ss = 0.f;
#pragma unroll
              for (int i = 0; i < 4; ++i) ss += v[r3][i][0] * v[r3][i][0] + v[r3][i][1] * v[r3][i][1] + v[r3][i][2] * v[r3][i][2] + v[r3][i][3] * v[r3][i][3];
              ss = red64(ss); const float rs = rsqrtf(ss * (1.0f / 1024.0f) + 1e-5f);
#pragma unroll
              for (int i = 0; i < 4; ++i) { const f32x4 g = *(const f32x4*)(gain + 4 * lane + 256 * i); const f32x4 y = v[r3][i] * rs * g;
                  u32x2 w; w.x = cvt_pk_bf16(y[0], y[1]); w.y = cvt_pk_bf16(y[2], y[3]);
                  *(u32x2*)(dst + 4 * lane + 256 * i) = w;
                  if (!ism) *(unsigned*)(ws + OFF_H8 + (size_t)row * 1024 + 4 * lane + 256 * i) = pack4_fp8(y[0] * 8.0f, y[1] * 8.0f, y[2] * 8.0f, y[3] * 8.0f); } } }
    }
}

__device__ __forceinline__ void phase_elem_c(const int wv) {
    KParams& p = *kparams();
    const int gt = blockIdx.x * 512 + opaque_tid(wv), nthr = gridDim.x * 512; unsigned char* ws = p.ws;
    bf16_t* Z = (bf16_t*)(ws + OFF_Z); bf16_t* AL = (bf16_t*)(ws + OFF_ALORA); bf16_t* KV = (bf16_t*)(ws + OFF_KV);
    const float* mu = p.in[4];
    u32x4 za[4], zb[4]; const u32x4 zq0 = zero4u();
#pragma unroll
    for (int k = 0; k < 4; ++k) { const int idx = gt + k * nthr, t = idx >> 5, ch = idx & 31, col = C_ZW + 8 * ch;
        za[k] = *(const u32x4*)(Z + (size_t)t * INC + col);
        zb[k] = zq0; if ((t & (SEQ - 1)) != 0) zb[k] = *(const u32x4*)(Z + (size_t)(t - 1) * INC + col); }
#pragma unroll
    for (int k = 0; k < 4; ++k) { const int idx = gt + k * nthr, t = idx >> 5, ch = idx & 31, col = C_ZW + 8 * ch;
        float a[8], b[8]; unpack8(za[k], a); unpack8(zb[k], b);
        const f32x4 m0 = *(const f32x4*)(mu + col), m1 = *(const f32x4*)(mu + col + 4); const float mm[8] = {m0[0], m0[1], m0[2], m0[3], m1[0], m1[1], m1[2], m1[3]};
#pragma unroll
        for (int j = 0; j < 8; ++j) { float v = a[j] + (b[j] - a[j]) * mm[j]; if (ch < 8) v = tanhf(v); else if (ch >= 16) v = sigmoidf_(v); a[j] = v; }
        *(u32x4*)(AL + (size_t)t * 256 + 8 * ch) = pack8(a); }
}

__device__ __forceinline__ bf16x8 pack_frag(const f32x4 lo, const f32x4 hi) { u32x4 w; w.x = cvt_pk_bf16(lo[0], lo[1]); w.y = cvt_pk_bf16(lo[2], lo[3]); w.z = cvt_pk_bf16(hi[0], hi[1]); w.w = cvt_pk_bf16(hi[2], hi[3]); bf16x8 r; __builtin_memcpy(&r, &w, 16); return r; }
__device__ __forceinline__ bf16x8 tr2(LAS unsigned char* pa, LAS unsigned char* pb) { const s16x4 a = __builtin_amdgcn_ds_read_tr16_b64_v4i16((LAS s16x4*)pa), b = __builtin_amdgcn_ds_read_tr16_b64_v4i16((LAS s16x4*)pb); return __builtin_shufflevector(a, b, 0, 1, 2, 3, 4, 5, 6, 7); }
__device__ __forceinline__ bf16x8 rd2(LAS unsigned char* pa, LAS unsigned char* pb) { const s16x4 a = *(const LAS s16x4*)pa, b = *(const LAS s16x4*)pb; return __builtin_shufflevector(a, b, 0, 1, 2, 3, 4, 5, 6, 7); }
#define MFMA16(a, b, c) __builtin_amdgcn_mfma_f32_16x16x32_bf16((a), (b), (c), 0, 0, 0)
constexpr int CP_XA = 0, CP_XR = 4096, CP_XB = 8192, CP_XK = 12288, CP_VL = 16384, CP_NL = 16384, CP_WAVE = 20480;
__device__ __forceinline__ void phase_chunk_pre(const int wv, LAS unsigned char* lds) {
    KParams& p = *kparams();
    const int tid = opaque_tid(wv), wid = tid >> 6, lane = tid & 63, fr = lane & 15, fq = lane >> 4; unsigned char* ws = p.ws;
    if (tid == 0) { *(u32x4*)(ws + OFF_CTL + CTL_KEEP + blockIdx.x * 16) = *(const LAS u32x4*)(lds + LDS_X); asm volatile("s_waitcnt vmcnt(0)" ::: "memory"); }
    __syncthreads();
    LAS unsigned char* wl = lds + wid * CP_WAVE;
    const bf16_t* Z = (const bf16_t*)(ws + OFF_Z); bf16_t* C1 = (bf16_t*)(ws + OFF_C1); bf16_t* C2 = (bf16_t*)(ws + OFF_C2);
    const float* mu = p.in[4]; const float* k_k = p.in[10]; const float* k_a = p.in[11]; const float* r_k = p.in[12]; const float* ln_w = p.in[13]; const float* ln_b = p.in[14];
    const f32x4 z4 = zero4f();
    const bf16_t* LT = (const bf16_t*)(ws + OFF_LORAT); const float* w0v = p.in[5]; const float* a0v = p.in[7];
    for (int un = blockIdx.x; un < 512; un += gridDim.x) {
        const int b_ = un >> 6, cc = un & 63, h_ = wid; const int pr = ((b_ * 8 + h_) << 6) | cc; const int tok0 = b_ * SEQ + cc * 32;
        float gamC;
        int tidl = tid; asm volatile("" : "+v"(tidl));
        __syncthreads();
        { const int tl = tidl >> 4; const int t = tok0 + tl; u32x4 za[2], zb[2]; const u32x4 zq0 = zero4u();
#pragma unroll
          for (int g2 = 0; g2 < 2; ++g2) { const int col = C_ZW + 8 * ((tidl & 15) * 2 + g2); za[g2] = *(const u32x4*)(Z + (size_t)t * INC + col);
              zb[g2] = zq0; if ((t & (SEQ - 1)) != 0) zb[g2] = *(const u32x4*)(Z + (size_t)(t - 1) * INC + col); }
#pragma unroll
          for (int g2 = 0; g2 < 2; ++g2) { const int ch = (tidl & 15) * 2 + g2, col = C_ZW + 8 * ch; float a[8], b[8]; unpack8(za[g2], a); unpack8(zb[g2], b);
              const f32x4 m0 = *(const f32x4*)(mu + col), m1 = *(const f32x4*)(mu + col + 4); const float mm[8] = {m0[0], m0[1], m0[2], m0[3], m1[0], m1[1], m1[2], m1[3]};
#pragma unroll
              for (int j = 0; j < 8; ++j) { float v = a[j] + (b[j] - a[j]) * mm[j]; if (ch < 8) v = tanhf(v); else if (ch >= 16) v = sigmoidf_(v); a[j] = v; }
              *(LAS u32x4*)(lds + (tl >> 2) * CP_WAVE + CP_VL + (tl & 3) * 528 + ch * 16) = pack8(a); }
          __syncthreads(); }
        { const int fr = tidl & 15, fq = (tidl >> 4) & 3;
#pragma unroll
          for (int kind = 0; kind < 3; ++kind) { const int koff = kind == 0 ? 0 : (kind == 1 ? 64 : 128), nks = kind == 2 ? 4 : 2;
              f32x4 acc[4][2];
#pragma unroll
              for (int mt = 0; mt < 4; ++mt) { acc[mt][0] = z4; acc[mt][1] = z4; }
#pragma unroll
              for (int ks = 0; ks < nks; ++ks) { bf16x8 tf[2];
#pragma unroll
                  for (int nt = 0; nt < 2; ++nt) { const int tt = 16 * nt + fr; tf[nt] = *(const LAS bf16x8*)(lds + (tt >> 2) * CP_WAVE + CP_VL + (tt & 3) * 528 + (koff + 32 * ks + 8 * fq) * 2); }
#pragma unroll
                  for (int mt = 0; mt < 4; ++mt) { const bf16x8 wf = *(const bf16x8*)(LT + (size_t)(kind * 512 + h_ * 64 + 16 * mt + fr) * 256 + koff + 32 * ks + 8 * fq);
                      acc[mt][0] = MFMA16(tf[0], wf, acc[mt][0]); acc[mt][1] = MFMA16(tf[1], wf, acc[mt][1]); } }
#pragma unroll
              for (int mt = 0; mt < 4; ++mt) { const int ch = 16 * mt + fr; float bv = 0.f; if (kind == 0) bv = w0v[h_ * 64 + ch]; else if (kind == 1) bv = a0v[h_ * 64 + ch];
#pragma unroll
                  for (int nt = 0; nt < 2; ++nt) { f32x4 v = acc[mt][nt] + bv; LAS unsigned char* dst = wl + ch * 64 + (16 * nt + 4 * fq) * 2;
                      if (kind == 0) { float hf[4];
#pragma unroll
                          for (int j = 0; j < 4; ++j) v[j] = -0.60653066f * sigmoidf_(v[j]);
                          u32x2 hi; hi.x = cvt_pk_bf16(v[0], v[1]); hi.y = cvt_pk_bf16(v[2], v[3]);
                          hf[0] = v[0] - __uint_as_float(hi.x << 16); hf[1] = v[1] - __uint_as_float(hi.x & 0xffff0000u); hf[2] = v[2] - __uint_as_float(hi.y << 16); hf[3] = v[3] - __uint_as_float(hi.y & 0xffff0000u);
                          u32x2 lo; lo.x = cvt_pk_bf16(hf[0], hf[1]); lo.y = cvt_pk_bf16(hf[2], hf[3]);
                          *(LAS u32x2*)(dst + CP_XR) = hi; *(LAS u32x2*)(dst + CP_XB) = lo; }
                      else { if (kind == 1) {
#pragma unroll
                              for (int j = 0; j < 4; ++j) v[j] = sigmoidf_(v[j]); }
                          u32x2 w; w.x = cvt_pk_bf16(v[0], v[1]); w.y = cvt_pk_bf16(v[2], v[3]); *(LAS u32x2*)(dst + (kind == 1 ? CP_XK : CP_XA)) = w; } } } }
          asm volatile("s_waitcnt lgkmcnt(0)" ::: "memory");
          __syncthreads(); }
        { const int c = h_ * 64 + lane;
          const bf16_t* zp = Z + (size_t)tok0 * INC + c;
          const float mur = mu[c], muk = mu[C_K + c], muv = mu[C_V + c], kk_ = k_k[c], ka_ = k_a[c], rk_ = r_k[c], lnw = ln_w[c], lnb = ln_b[c];
          float pzr = 0.f, pzk = 0.f, pzv = 0.f;
          if (cc != 0) { pzr = __uint_as_float((unsigned)zp[-INC] << 16); pzk = __uint_as_float((unsigned)zp[-INC + C_K] << 16); pzv = __uint_as_float((unsigned)zp[-INC + C_V] << 16); }
          unsigned short zq[2][4][3]; u32x2 sq[2][4];
#pragma unroll
          for (int e = 0; e < 4; ++e) {
#pragma unroll
              for (int q = 0; q < 3; ++q) zq[0][e][q] = zp[(size_t)e * INC + q * 512]; }
#pragma unroll
          for (int r = 0; r < 4; ++r) sq[0][r] = *(const LAS u32x2*)(wl + r * 4096 + lane * 64);
          __builtin_amdgcn_sched_barrier(0);
          float cs = 0.f, g = 1.0f;
#pragma unroll
          for (int t4 = 0; t4 < 8; ++t4) { unsigned pa[2], pr_[2], pb[2], pk[2];
              if (t4 < 7) {
#pragma unroll
                  for (int e = 0; e < 4; ++e) {
#pragma unroll
                      for (int q = 0; q < 3; ++q) zq[(t4 + 1) & 1][e][q] = zp[(size_t)((t4 + 1) * 4 + e) * INC + q * 512]; }
#pragma unroll
                  for (int r = 0; r < 4; ++r) sq[(t4 + 1) & 1][r] = *(const LAS u32x2*)(wl + r * 4096 + lane * 64 + (t4 + 1) * 8); }
              __builtin_amdgcn_sched_barrier(0);
#pragma unroll
              for (int tp = 0; tp < 2; ++tp) { float va[2], vr[2], vb[2], vk[2];
#pragma unroll
                  for (int e = 0; e < 2; ++e) { const int te = tp * 2 + e, t = t4 * 4 + te;
                      const float zr = __uint_as_float((unsigned)zq[t4 & 1][te][0] << 16), zk = __uint_as_float((unsigned)zq[t4 & 1][te][1] << 16), zv = __uint_as_float((unsigned)zq[t4 & 1][te][2] << 16);
                      const float r = zr + (pzr - zr) * mur, k = zk + (pzk - zk) * muk, v = zv + (pzv - zv) * muv; pzr = zr; pzk = zk; pzv = zv;
                      const unsigned wg = sq[t4 & 1][0][te >> 1], wh = sq[t4 & 1][1][te >> 1], wlo = sq[t4 & 1][2][te >> 1], wa = sq[t4 & 1][3][te >> 1];
                      const float lw = __uint_as_float((te & 1) ? (wh & 0xffff0000u) : (wh << 16)) + __uint_as_float((te & 1) ? (wlo & 0xffff0000u) : (wlo << 16));
                      const float al = __uint_as_float((te & 1) ? (wa & 0xffff0000u) : (wa << 16)), gg = __uint_as_float((te & 1) ? (wg & 0xffff0000u) : (wg << 16));
                      const float kk = k * kk_, kp = k * (1.0f + (al - 1.0f) * ka_);
                      const float n2 = red64(kk * kk), bon = red64(r * kp * rk_);
                      const float kn = kk * __builtin_amdgcn_rsqf(fmaxf(n2, 1e-24f));
                      const float gm1 = g; cs += lw; g = __builtin_amdgcn_exp2f(cs * 1.44269504f); const float gi = __builtin_amdgcn_rcpf(g);
                      va[e] = -kn * gm1; vb[e] = kn * al * gi; vk[e] = kp * gi; vr[e] = r * g;
                      *(LAS bf16_t*)(wl + CP_VL + t * 128 + lane * 2) = (bf16_t)(cvt_pk_bf16(v, 0.f) & 0xffffu);
                      const size_t to = (size_t)(tok0 + t) * 512 + c;
                      C1[to] = (bf16_t)(cvt_pk_bf16(lnw * gg, 0.f) & 0xffffu); C2[to] = (bf16_t)(cvt_pk_bf16((lnb + bon * v) * gg, 0.f) & 0xffffu); }
                  pa[tp] = cvt_pk_bf16(va[0], va[1]); pr_[tp] = cvt_pk_bf16(vr[0], vr[1]); pb[tp] = cvt_pk_bf16(vb[0], vb[1]); pk[tp] = cvt_pk_bf16(vk[0], vk[1]); }
              *(LAS u32x2*)(wl + CP_XA + lane * 64 + t4 * 8) = (u32x2){pa[0], pa[1]}; *(LAS u32x2*)(wl + CP_XR + lane * 64 + t4 * 8) = (u32x2){pr_[0], pr_[1]};
              *(LAS u32x2*)(wl + CP_XB + lane * 64 + t4 * 8) = (u32x2){pb[0], pb[1]}; *(LAS u32x2*)(wl + CP_XK + lane * 64 + t4 * 8) = (u32x2){pk[0], pk[1]};
              __builtin_amdgcn_sched_barrier(0); }
          gamC = g; }
        asm volatile("s_waitcnt lgkmcnt(0)" ::: "memory");
        bf16x8 Vf[4];
        { const int vtb = (4 * fq + (fr >> 2)) * 128 + (fr & 3) * 8;
#pragma unroll
          for (int nv = 0; nv < 4; ++nv) { LAS unsigned char* pp = wl + CP_VL + vtb + nv * 32; Vf[nv] = tr2(pp, pp + 2048); } }
        asm volatile("s_waitcnt lgkmcnt(0)" ::: "memory");
        const int trb = (8 * fq + (fr >> 2)) * 64 + (fr & 3) * 8;
        bf16x8 LakF[2], QrbF[2], QrkF[2];
#pragma unroll
        for (int yi = 0; yi < 2; ++yi) {
            bf16x8 fy[2][2];
#pragma unroll
            for (int nt = 0; nt < 2; ++nt)
#pragma unroll
                for (int s2 = 0; s2 < 2; ++s2) { LAS unsigned char* pp = wl + (yi ? CP_XR : CP_XA) + trb + s2 * 2048 + nt * 32; fy[nt][s2] = tr2(pp, pp + 256); }
#pragma unroll
            for (int xi = 0; xi < 2; ++xi) {
                f32x4 d[2][2];
#pragma unroll
                for (int mi = 0; mi < 2; ++mi) { bf16x8 fx[2];
#pragma unroll
                    for (int s2 = 0; s2 < 2; ++s2) { LAS unsigned char* pp = wl + (xi ? CP_XK : CP_XB) + trb + s2 * 2048 + mi * 32; fx[s2] = tr2(pp, pp + 256); }
#pragma unroll
                    for (int nt = 0; nt < 2; ++nt) {
                        if (mi == 1 && nt == 0) { d[mi][nt] = z4; continue; }
                        f32x4 acc = MFMA16(fx[0], fy[nt][0], z4); acc = MFMA16(fx[1], fy[nt][1], acc);
#pragma unroll
                        for (int j = 0; j < 4; ++j) { const int i = 16 * mi + 4 * fq + j, t = 16 * nt + fr; const bool ok = yi ? (i <= t) : (i < t); acc[j] = ok ? acc[j] : 0.f; }
                        d[mi][nt] = acc; } }
                if (yi == 0 && xi == 0) {
#pragma unroll
                    for (int mi = 0; mi < 2; ++mi)
#pragma unroll
                        for (int nt = 0; nt < 2; ++nt)
#pragma unroll
                            for (int j = 0; j < 4; ++j) *(LAS float*)(wl + CP_NL + ((16 * nt + fr) * 32 + 16 * mi + 4 * fq + j) * 4) = d[mi][nt][j];
                } else {
#pragma unroll
                    for (int nt = 0; nt < 2; ++nt) { const bf16x8 f = pack_frag(d[0][nt], d[1][nt]); if (yi == 0) LakF[nt] = f; else if (xi == 0) QrbF[nt] = f; else QrkF[nt] = f; } } } }
        asm volatile("s_waitcnt lgkmcnt(0)" ::: "memory");
        bf16x8 InvF[2];
        { const int c = lane & 31; float X[32];
#pragma unroll
          for (int t = 0; t < 32; ++t) { float a0 = (t == c) ? 1.0f : 0.f, a1 = 0.f;
#pragma unroll
              for (int i4 = 0; i4 < (t + 3) / 4; ++i4) { const f32x4 nv = *(const LAS f32x4*)(wl + CP_NL + (t * 32 + 4 * i4) * 4);
#pragma unroll
                  for (int e = 0; e < 4; ++e) if (4 * i4 + e < t) { if (e & 1) a1 = fmaf(nv[e], X[4 * i4 + e], a1); else a0 = fmaf(nv[e], X[4 * i4 + e], a0); } }
              X[t] = a0 + a1; }
          asm volatile("s_waitcnt lgkmcnt(0)" ::: "memory");
#pragma unroll
          for (int t = 0; t < 32; ++t) *(LAS float*)(wl + CP_NL + (t * 32 + c) * 4) = X[t];
          asm volatile("s_waitcnt lgkmcnt(0)" ::: "memory");
#pragma unroll
          for (int n = 0; n < 2; ++n) { const f32x4 lo = *(const LAS f32x4*)(wl + CP_NL + ((16 * n + fr) * 32 + 4 * fq) * 4), hi = *(const LAS f32x4*)(wl + CP_NL + ((16 * n + fr) * 32 + 16 + 4 * fq) * 4); InvF[n] = pack_frag(lo, hi); } }
        bf16x8 UF[4], AhF[4];
#pragma unroll
        for (int nv = 0; nv < 4; ++nv) { const f32x4 w0 = MFMA16(LakF[0], Vf[nv], z4), w1 = MFMA16(LakF[1], Vf[nv], z4); const bf16x8 wf = pack_frag(w0, w1);
            const f32x4 u0 = MFMA16(InvF[0], wf, z4), u1 = MFMA16(InvF[1], wf, z4); UF[nv] = pack_frag(u0, u1); }
#pragma unroll
        for (int nc = 0; nc < 4; ++nc) { LAS unsigned char* pp = wl + CP_XA + (16 * nc + fr) * 64 + 8 * fq; const bf16x8 af = rd2(pp, pp + 32);
            const f32x4 h0 = MFMA16(InvF[0], af, z4), h1 = MFMA16(InvF[1], af, z4); AhF[nc] = pack_frag(h0, h1); }
        { f32x4 rt[4][2];
#pragma unroll
          for (int mc = 0; mc < 4; ++mc)
#pragma unroll
              for (int nt = 0; nt < 2; ++nt) { const s16x4 rr = __builtin_amdgcn_ds_read_tr16_b64_v4i16((LAS s16x4*)(wl + CP_XR + (16 * mc + 4 * fq + (fr >> 2)) * 64 + (fr & 3) * 8 + nt * 32));
                  f32x4 cin; cin[0] = __uint_as_float((unsigned)(unsigned short)rr[0] << 16); cin[1] = __uint_as_float((unsigned)(unsigned short)rr[1] << 16); cin[2] = __uint_as_float((unsigned)(unsigned short)rr[2] << 16); cin[3] = __uint_as_float((unsigned)(unsigned short)rr[3] << 16);
                  rt[mc][nt] = MFMA16(AhF[mc], QrbF[nt], cin); }
          bf16x8* RTF = (bf16x8*)(ws + OFF_RTF) + (size_t)pr * 256;
#pragma unroll
          for (int nt = 0; nt < 2; ++nt)
#pragma unroll
              for (int s2 = 0; s2 < 2; ++s2) RTF[(nt * 2 + s2) * 64 + lane] = pack_frag(rt[2 * s2][nt], rt[2 * s2 + 1][nt]); }
        { u32x2* YLF = (u32x2*)(ws + OFF_YLF) + (size_t)pr * 512;
#pragma unroll
          for (int nv = 0; nv < 4; ++nv)
#pragma unroll
              for (int mt = 0; mt < 2; ++mt) { f32x4 y = MFMA16(QrbF[mt], UF[nv], z4); y = MFMA16(QrkF[mt], Vf[nv], y);
                  u32x2 w; w.x = cvt_pk_bf16(y[0], y[1]); w.y = cvt_pk_bf16(y[2], y[3]); YLF[(nv * 2 + mt) * 64 + lane] = w; } }
        { bf16x8* GTF = (bf16x8*)(ws + OFF_GTF) + (size_t)pr * 512; u32x2* HHF = (u32x2*)(ws + OFF_HHF) + (size_t)pr * 1024;
#pragma unroll
          for (int nc = 0; nc < 4; ++nc) { LAS unsigned char* pp = wl + CP_XB + (16 * nc + fr) * 64 + 8 * fq; const bf16x8 bf_ = rd2(pp, pp + 32);
              LAS unsigned char* pk = wl + CP_XK + (16 * nc + fr) * 64 + 8 * fq; const bf16x8 kf_ = rd2(pk, pk + 32);
              const float gcol = __int_as_float(__builtin_amdgcn_ds_bpermute((16 * nc + fr) << 2, __float_as_int(gamC)));
              f32x4 gt[4];
#pragma unroll
              for (int mc = 0; mc < 4; ++mc) { f32x4 a = MFMA16(AhF[mc], bf_, z4);
#pragma unroll
                  for (int j = 0; j < 4; ++j) { if (mc == nc && 4 * fq + j == fr) a[j] += 1.0f; a[j] *= gcol; }
                  gt[mc] = a; }
              GTF[(nc * 2 + 0) * 64 + lane] = pack_frag(gt[0], gt[1]); GTF[(nc * 2 + 1) * 64 + lane] = pack_frag(gt[2], gt[3]);
              f32x4 grow;
#pragma unroll
              for (int j = 0; j < 4; ++j) grow[j] = __int_as_float(__builtin_amdgcn_ds_bpermute((16 * nc + 4 * fq + j) << 2, __float_as_int(gamC)));
#pragma unroll
              for (int nv = 0; nv < 4; ++nv) { f32x4 hh = MFMA16(bf_, UF[nv], z4); hh = MFMA16(kf_, Vf[nv], hh); hh = hh * grow;
                  u32x2 w; w.x = cvt_pk_bf16(hh[0], hh[1]); w.y = cvt_pk_bf16(hh[2], hh[3]); HHF[(nv * 4 + nc) * 64 + lane] = w; } } }
        asm volatile("s_waitcnt lgkmcnt(0)" ::: "memory");
    }
    __syncthreads();
    if (tid == 0) *(LAS u32x4*)(lds + LDS_X) = *(const u32x4*)(ws + OFF_CTL + CTL_KEEP + blockIdx.x * 16);
}
__device__ __forceinline__ void phase_scan_seq(const int wv, LAS unsigned char* lds) {
    KParams& p = *kparams();
    const int tid = opaque_tid(wv), wid = __builtin_amdgcn_readfirstlane(tid >> 6), lane = tid & 63, fr = lane & 15, fq = lane >> 4; unsigned char* ws = p.ws;
    if (blockIdx.x >= 64) return;
    const int bh = blockIdx.x, b = bh >> 3, h = bh & 7;
    const char* gG = (const char*)(ws + OFF_GTF) + (size_t)bh * 64 * 8192; const char* gR = (const char*)(ws + OFF_RTF) + (size_t)bh * 64 * 4096;
    const char* gH = (const char*)(ws + OFF_HHF) + (size_t)bh * 64 * 8192; const char* gY = (const char*)(ws + OFF_YLF) + (size_t)bh * 64 * 4096;
    constexpr int SLOT = 24576;
    if (wid >= 4) {
        const int w = wid - 4;
        auto issue = [&](int c) { LAS unsigned char* slot = lds + (c % 5) * SLOT;
#pragma unroll
            for (int i = 0; i < 6; ++i) { const int pc = w + 4 * i;
                const char* src = pc < 8 ? gG + (size_t)c * 8192 + pc * 1024 : pc < 12 ? gR + (size_t)c * 4096 + (pc - 8) * 1024 : pc < 20 ? gH + (size_t)c * 8192 + (pc - 12) * 1024 : gY + (size_t)c * 4096 + (pc - 20) * 1024;
                __builtin_amdgcn_global_load_lds((const unsigned*)(src + lane * 16), (LAS unsigned*)(slot + pc * 1024), 16, 0, 0); } };
        issue(0); issue(1); issue(2); issue(3);
        for (int c = 0; c < 64; ++c) {
            if (c < 60) asm volatile("s_waitcnt vmcnt(18)" ::: "memory"); else asm volatile("s_waitcnt vmcnt(0)" ::: "memory");
            __builtin_amdgcn_s_barrier();
            if (c + 4 < 64) issue(c + 4);
        }
        return; }
    const int nv = wid;
    float* Yraw = (float*)(ws + OFF_YRAW) + (size_t)b * SEQ * 512 + h * 64 + 16 * nv + fr;
    f32x4 T[4]; const f32x4 z4s = zero4f();
#pragma unroll
    for (int m = 0; m < 4; ++m) T[m] = z4s;
    for (int c = 0; c < 64; ++c) {
        __builtin_amdgcn_s_barrier();
        const LAS unsigned char* slot = lds + (c % 5) * SLOT + lane * 16;
        bf16x8 G[8], R[4]; u32x2 H[4], Y[2];
#pragma unroll
        for (int i = 0; i < 8; ++i) G[i] = *(const LAS bf16x8*)(slot + i * 1024);
#pragma unroll
        for (int i = 0; i < 4; ++i) R[i] = *(const LAS bf16x8*)(slot + 8192 + i * 1024);
#pragma unroll
        for (int i = 0; i < 4; ++i) H[i] = *(const LAS u32x2*)(lds + (c % 5) * SLOT + 12288 + (nv * 4 + i) * 512 + lane * 8);
#pragma unroll
        for (int i = 0; i < 2; ++i) Y[i] = *(const LAS u32x2*)(lds + (c % 5) * SLOT + 20480 + (nv * 2 + i) * 512 + lane * 8);
        const bf16x8 tf0 = pack_frag(T[0], T[1]), tf1 = pack_frag(T[2], T[3]);
#pragma unroll
        for (int nt = 0; nt < 2; ++nt) { f32x4 y; y[0] = bf_lo(Y[nt].x); y[1] = bf_hi(Y[nt].x); y[2] = bf_lo(Y[nt].y); y[3] = bf_hi(Y[nt].y);
            y = MFMA16(R[nt * 2], tf0, y); y = MFMA16(R[nt * 2 + 1], tf1, y);
#pragma unroll
            for (int j = 0; j < 4; ++j) Yraw[(size_t)(c * 32 + 16 * nt + 4 * fq + j) * 512] = y[j]; }
#pragma unroll
        for (int m = 0; m < 4; ++m) { f32x4 t; t[0] = bf_lo(H[m].x); t[1] = bf_hi(H[m].x); t[2] = bf_lo(H[m].y); t[3] = bf_hi(H[m].y);
            t = MFMA16(G[m * 2], tf0, t); t = MFMA16(G[m * 2 + 1], tf1, t); T[m] = t; }
        asm volatile("s_waitcnt lgkmcnt(0)" ::: "memory");
    }
}

__device__ __forceinline__ bf16x8 tr_pair(LAS unsigned char* pa, LAS unsigned char* pb, bool useB) {
    const s16x4 a = __builtin_amdgcn_ds_read_tr16_b64_v4i16((LAS s16x4*)pa);
    s16x4 b2 = (s16x4){0, 0, 0, 0};
    if (useB) b2 = __builtin_amdgcn_ds_read_tr16_b64_v4i16((LAS s16x4*)pb);
    return __builtin_shufflevector(a, b2, 0, 1, 2, 3, 4, 5, 6, 7);
}
__device__ __forceinline__ void phase_dil_attn(const int wv, LAS unsigned char* lds) {
    KParams& p = *kparams();
    const int tid = opaque_tid(wv), wid = tid >> 6, lane = tid & 63, fr = lane & 15, fq = lane >> 4; unsigned char* ws = p.ws;
    const bf16_t* Z = (const bf16_t*)(ws + OFF_Z); float* DILO = (float*)(ws + OFF_DILO); float* LSE = (float*)(ws + OFF_LSE);
    LAS unsigned char* kb = lds; LAS unsigned char* vb = lds + 32768; const float* qn = p.in[15]; const float* kn = p.in[16];
    float qkw[2][8];
#pragma unroll
    for (int ks = 0; ks < 2; ++ks)
#pragma unroll
        for (int j = 0; j < 8; ++j) qkw[ks][j] = qn[ks * 32 + 8 * fq + j] * kn[ks * 32 + 8 * fq + j];
    const bool seqwg = blockIdx.x < 64;
    const int u0 = seqwg ? 4 * (int)blockIdx.x : 256 + (int)blockIdx.x - 64, uend = seqwg ? 4 * (int)blockIdx.x + 4 : 1536, ustep = seqwg ? 1 : 192;
    auto umap = [&](int v) -> int { if (seqwg) return v; const int c2 = (int)blockIdx.x - 64, x = c2 & 7, y = c2 >> 3, i = (v - u0) / 192, k = 24 * i + y; return 256 + (k >> 3) * 64 + 8 * x + (k & 7); };
    const int ki = tid >> 1, half = tid & 1;
    u32x4 kvA[4], vvA[4], qvA[2], kvB[4], vvB[4], qvB[2]; bool kvalidA = false, kvalidB = false;
    auto unit_load = [&](int uv, u32x4 (&kv)[4], u32x4 (&vv)[4], u32x4 (&qv)[2], bool& kvalid) { const int u = umap(uv);
        const int b = u / 192, rem = u % 192, hh = rem >> 4, qb = rem & 15, g = hh >> 2;
        const int dil = g == 0 ? 1 : (g == 1 ? 4 : 16), nbc = 16 / dil, r = qb / nbc, j0 = (qb % nbc) * 128;
        const bf16_t* Zb = Z + (size_t)b * SEQ * INC; const int kj = j0 - 128 + ki; kvalid = kj >= 0;
        { const bf16_t* rowp = Zb + (size_t)((kvalid ? kj : 0) * dil + r) * INC + hh * 64 + half * 32;
#pragma unroll
            for (int i = 0; i < 4; ++i) { kv[i] = *(const u32x4*)(rowp + C_DK + 8 * i); vv[i] = *(const u32x4*)(rowp + C_DV + 8 * i); } }
        const int tq = (j0 + 16 * wid + fr) * dil + r;
#pragma unroll
        for (int ks = 0; ks < 2; ++ks) qv[ks] = *(const u32x4*)(Zb + (size_t)tq * INC + C_DQ + hh * 64 + ks * 32 + 8 * fq); };
    auto do_unit = [&](const int uvv, u32x4 (&kv)[4], u32x4 (&vv)[4], u32x4 (&qv)[2], bool& kvalid) { const int u = umap(uvv); const int uv_ = uvv;
        const int b = u / 192, rem = u % 192, hh = rem >> 4, qb = rem & 15, g = hh >> 2, hg = hh & 3;
        const int dil = g == 0 ? 1 : (g == 1 ? 4 : 16), nbc = 16 / dil, r = qb / nbc, j0 = (qb % nbc) * 128;
        { if (kvalid) {
              float ss = sumsq8(kv[0]) + sumsq8(kv[1]) + sumsq8(kv[2]) + sumsq8(kv[3]); ss += dpp_f<0xB1>(ss);
              const float rs = rsqrtf(ss * (1.0f / 64.0f) + 1e-5f);
#pragma unroll
              for (int i = 0; i < 4; ++i) kv[i] = scale8s(kv[i], rs); }
          else { const u32x4 zu = zero4u();
#pragma unroll
              for (int i = 0; i < 4; ++i) { kv[i] = zu; vv[i] = zu; } }
#pragma unroll
          for (int i = 0; i < 4; ++i) { const int sw = (half * 4 + i) ^ (ki & 7); *(LAS u32x4*)(kb + ki * 128 + sw * 16) = kv[i]; *(LAS u32x4*)(vb + ki * 128 + sw * 16) = vv[i]; } }
        const int qi = 16 * wid + fr, tq = (j0 + qi) * dil + r;
        bf16x8 qf[2];
        { float ss = sumsq8(qv[0]) + sumsq8(qv[1]); ss += sxor(ss, 16); ss += sxor(ss, 32);
          const float rs = rsqrtf(ss * (1.0f / 64.0f) + 1e-5f) * 0.125f;
#pragma unroll
          for (int ks = 0; ks < 2; ++ks) { const u32x4 w = scale8r(qv[ks], rs, qkw[ks]); __builtin_memcpy(&qf[ks], &w, 16); } }
        __syncthreads();
        if (uv_ + 2 * ustep < uend) unit_load(uv_ + 2 * ustep, kv, vv, qv, kvalid);
        f32x4 st[9]; float mx = -1e30f; const f32x4 zq = zero4f();
        LAS unsigned char* kp0 = kb + (16 * wid + fr) * 128 + ((fq ^ (fr & 7)) << 4); LAS unsigned char* kp1 = kb + (16 * wid + fr) * 128 + (((4 + fq) ^ (fr & 7)) << 4);
#pragma unroll
        for (int ti = 0; ti < 9; ++ti) {
            const bf16x8 k0 = *(const LAS bf16x8*)(kp0 + ti * 2048), k1 = *(const LAS bf16x8*)(kp1 + ti * 2048);
            f32x4 s = __builtin_amdgcn_mfma_f32_16x16x32_bf16(k0, qf[0], zq, 0, 0, 0);
            s = __builtin_amdgcn_mfma_f32_16x16x32_bf16(k1, qf[1], s, 0, 0, 0);
#pragma unroll
            for (int j = 0; j < 4; ++j) { const int ki = 16 * (wid + ti) + 4 * fq + j, off = qi + 128 - ki; const bool ok = (off >= 0) && (off <= 128) && (j0 - 128 + ki >= 0);
                s[j] = ok ? s[j] : -1e30f; mx = fmaxf(mx, s[j]); }
            st[ti] = s; }
        mx = fmaxf(mx, sxor(mx, 16)); mx = fmaxf(mx, sxor(mx, 32));
        float den = 0.f;
#pragma unroll
        for (int ti = 0; ti < 9; ++ti)
#pragma unroll
            for (int j = 0; j < 4; ++j) { const float e = __builtin_amdgcn_exp2f((st[ti][j] - mx) * 1.44269504f); st[ti][j] = e; den += e; }
        den += sxor(den, 16); den += sxor(den, 32);
        f32x4 o[4];
#pragma unroll
        for (int dt = 0; dt < 4; ++dt) o[dt] = zq;
        const int q4 = fr >> 2, p4 = fr & 3; const int kl = 4 * fq + q4;
        LAS unsigned char* vp[4];
#pragma unroll
        for (int dt = 0; dt < 4; ++dt) vp[dt] = vb + (16 * wid + kl) * 128 + (((2 * dt + (p4 >> 1)) ^ (kl & 7)) << 4) + (p4 & 1) * 8;
#pragma unroll
        for (int pp = 0; pp < 5; ++pp) { const bool two = pp < 4; const int tA = 2 * pp, tB = two ? 2 * pp + 1 : 2 * pp;
            u32x4 pw; pw.x = cvt_pk_bf16(st[tA][0], st[tA][1]); pw.y = cvt_pk_bf16(st[tA][2], st[tA][3]);
            if (two) { pw.z = cvt_pk_bf16(st[tB][0], st[tB][1]); pw.w = cvt_pk_bf16(st[tB][2], st[tB][3]); } else { pw.z = 0u; pw.w = 0u; }
            bf16x8 pf; __builtin_memcpy(&pf, &pw, 16);
#pragma unroll
            for (int dt = 0; dt < 4; ++dt) { const bf16x8 vf = tr_pair(vp[dt] + tA * 2048, vp[dt] + tB * 2048, two);
                o[dt] = __builtin_amdgcn_mfma_f32_16x16x32_bf16(vf, pf, o[dt], 0, 0, 0); } }
        const float inv = __builtin_amdgcn_rcpf(den); const size_t ob = ((size_t)(g * NTOK + b * SEQ + tq) * 4 + hg);
#pragma unroll
        for (int dt = 0; dt < 4; ++dt) *(f32x4*)(DILO + ob * 64 + 16 * dt + 4 * fq) = o[dt] * inv;
        if (fq == 0) LSE[ob] = mx + __logf(den);
        __syncthreads();
    };
    if (u0 < uend) unit_load(u0, kvA, vvA, qvA, kvalidA);
    if (u0 + ustep < uend) unit_load(u0 + ustep, kvB, vvB, qvB, kvalidB);
    for (int u = u0; u < uend; u += 2 * ustep) {
        do_unit(u, kvA, vvA, qvA, kvalidA);
        if (u + ustep < uend) do_unit(u + ustep, kvB, vvB, qvB, kvalidB);
    }
}

__device__ __forceinline__ void phase_mem_attn(const int wv, LAS unsigned char* lds) {
    KParams& p = *kparams();
    const int tid = opaque_tid(wv), wid = tid >> 6, lane = tid & 63, fr = lane & 15, fq = lane >> 4; unsigned char* ws = p.ws;
    const bf16_t* Z = (const bf16_t*)(ws + OFF_Z); const bf16_t* KV = (const bf16_t*)(ws + OFF_KV); bf16_t* YM = (bf16_t*)(ws + OFF_YCAT) + 768;
    LAS unsigned char* kb = lds; LAS unsigned char* vb = lds + 65536; const float* mqn = p.in[19]; const float* mkn = p.in[20];
    if (blockIdx.x < 64) return;
    float mqk[4][8];
#pragma unroll
    for (int ks = 0; ks < 4; ++ks)
#pragma unroll
        for (int j = 0; j < 8; ++j) mqk[ks][j] = mqn[ks * 32 + 8 * fq + j] * mkn[ks * 32 + 8 * fq + j];
    for (int bhq = (int)blockIdx.x - 64; bhq < 256; bhq += (int)gridDim.x - 64) {
        const int bhm = bhq >> 3, b = bhm >> 2, hm = bhm & 3;
        { const int ki = tid >> 1, half = tid & 1; const bf16_t* rowp = KV + (size_t)(b * 256 + ki) * 1024 + hm * 128 + half * 64;
          u32x4 kv[8], vv[8];
#pragma unroll
          for (int i = 0; i < 8; ++i) { kv[i] = *(const u32x4*)(rowp + 8 * i); vv[i] = *(const u32x4*)(rowp + 512 + 8 * i); }
          { float ss = 0.f;
#pragma unroll
            for (int i = 0; i < 8; ++i) ss += sumsq8(kv[i]);
            ss += dpp_f<0xB1>(ss); const float rs = rsqrtf(ss * (1.0f / 128.0f) + 1e-5f);
#pragma unroll
            for (int i = 0; i < 8; ++i) kv[i] = scale8s(kv[i], rs); }
#pragma unroll
          for (int i = 0; i < 8; ++i) { const int sw = (half * 8 + i) ^ (ki & 15); *(LAS u32x4*)(kb + ki * 256 + sw * 16) = kv[i]; *(LAS u32x4*)(vb + ki * 256 + sw * 16) = vv[i]; } }
        __syncthreads();
        const int q4 = fr >> 2, p4 = fr & 3; const int kl = 4 * fq + q4;
        LAS unsigned char* kp[4]; LAS unsigned char* vp[8];
#pragma unroll
        for (int ks = 0; ks < 4; ++ks) kp[ks] = kb + fr * 256 + (((4 * ks + fq) ^ fr) << 4);
#pragma unroll
        for (int dt = 0; dt < 8; ++dt) vp[dt] = vb + kl * 256 + (((2 * dt + (p4 >> 1)) ^ kl) << 4) + (p4 & 1) * 8;
        for (int qq = 0; qq < 2; ++qq) { const int qblk = (bhq & 7) * 2 + qq; const int tq = b * SEQ + qblk * 128 + 16 * wid + fr;
            bf16x8 qf[4];
#pragma unroll
            for (int ks = 0; ks < 4; ++ks) qf[ks] = *(const bf16x8*)(Z + (size_t)tq * INC + C_MQ + hm * 128 + ks * 32 + 8 * fq);
            { u32x4 qv[4]; float ss = 0.f;
#pragma unroll
              for (int ks = 0; ks < 4; ++ks) { __builtin_memcpy(&qv[ks], &qf[ks], 16); ss += sumsq8(qv[ks]); }
              ss += sxor(ss, 16); ss += sxor(ss, 32); const float rs = rsqrtf(ss * (1.0f / 128.0f) + 1e-5f);
#pragma unroll
              for (int ks = 0; ks < 4; ++ks) { const u32x4 w = scale8r(qv[ks], rs, mqk[ks]); __builtin_memcpy(&qf[ks], &w, 16); } }
            f32x4 st[16]; float mx = -1e30f; const f32x4 zq = zero4f();
#pragma unroll
            for (int ti = 0; ti < 16; ++ti) { f32x4 s = zq;
#pragma unroll
                for (int ks = 0; ks < 4; ++ks) { const bf16x8 kf = *(const LAS bf16x8*)(kp[ks] + ti * 4096); s = __builtin_amdgcn_mfma_f32_16x16x32_bf16(kf, qf[ks], s, 0, 0, 0); }
#pragma unroll
                for (int j = 0; j < 4; ++j) mx = fmaxf(mx, s[j]);
                st[ti] = s; if (ti & 1) asm volatile("" ::: "memory"); }
            mx = fmaxf(mx, sxor(mx, 16)); mx = fmaxf(mx, sxor(mx, 32));
            const float sc = 0.08838834764831845f * 1.44269504f; float den = 0.f;
#pragma unroll
            for (int ti = 0; ti < 16; ++ti)
#pragma unroll
                for (int j = 0; j < 4; ++j) { const float e = __builtin_amdgcn_exp2f((st[ti][j] - mx) * sc); st[ti][j] = e; den += e; }
            den += sxor(den, 16); den += sxor(den, 32);
            f32x4 o[8];
#pragma unroll
            for (int dt = 0; dt < 8; ++dt) o[dt] = zq;
#pragma unroll
            for (int pp = 0; pp < 8; ++pp) { const int tA = 2 * pp, tB = 2 * pp + 1;
                u32x4 pw; pw.x = cvt_pk_bf16(st[tA][0], st[tA][1]); pw.y = cvt_pk_bf16(st[tA][2], st[tA][3]); pw.z = cvt_pk_bf16(st[tB][0], st[tB][1]); pw.w = cvt_pk_bf16(st[tB][2], st[tB][3]);
                bf16x8 pf; __builtin_memcpy(&pf, &pw, 16);
#pragma unroll
                for (int dt = 0; dt < 8; ++dt) { const bf16x8 vf = tr_pair(vp[dt] + tA * 4096, vp[dt] + tB * 4096, true);
                    o[dt] = __builtin_amdgcn_mfma_f32_16x16x32_bf16(vf, pf, o[dt], 0, 0, 0); } }
            const float inv = __builtin_amdgcn_rcpf(den);
#pragma unroll
            for (int dt = 0; dt < 8; ++dt) { u32x2 w; w.x = cvt_pk_bf16(o[dt][0] * inv, o[dt][1] * inv); w.y = cvt_pk_bf16(o[dt][2] * inv, o[dt][3] * inv);
                *(u32x2*)(YM + (size_t)tq * 1280 + hm * 128 + 16 * dt + 4 * fq) = w; } }
        __syncthreads();
    }
}

__device__ __forceinline__ void phase_post(const int wv) {
    KParams& p = *kparams();
    const int gt = blockIdx.x * 512 + opaque_tid(wv), nthr = gridDim.x * 512; unsigned char* ws = p.ws;
    const float* Yraw = (const float*)(ws + OFF_YRAW); const bf16_t* C1 = (const bf16_t*)(ws + OFF_C1); const bf16_t* C2 = (const bf16_t*)(ws + OFF_C2); bf16_t* YR = (bf16_t*)(ws + OFF_YCAT);
    for (int idx = gt; idx < NTOK * 128; idx += nthr) { const int t = idx >> 7, c = ((idx >> 4) & 7) * 64 + 4 * (idx & 15);
        const f32x4 y = *(const f32x4*)(Yraw + (size_t)t * 512 + c);
        const float mean = red16(y[0] + y[1] + y[2] + y[3]) * (1.0f / 64.0f);
        const f32x4 d = y - mean; const float var = red16(d[0] * d[0] + d[1] * d[1] + d[2] * d[2] + d[3] * d[3]) * (1.0f / 64.0f);
        const float rs = rsqrtf(var + 64.0f * 1e-5f);
        float c1[4], c2[4]; unpack4(*(const u32x2*)(C1 + (size_t)t * 512 + c), c1); unpack4(*(const u32x2*)(C2 + (size_t)t * 512 + c), c2);
        u32x2 w; w.x = cvt_pk_bf16(d[0] * rs * c1[0] + c2[0], d[1] * rs * c1[1] + c2[1]); w.y = cvt_pk_bf16(d[2] * rs * c1[2] + c2[2], d[3] * rs * c1[3] + c2[3]);
        *(u32x2*)(YR + (size_t)t * 1280 + c) = w; }
    const float* DILO = (const float*)(ws + OFF_DILO); const float* LSE = (const float*)(ws + OFF_LSE); bf16_t* YD = (bf16_t*)(ws + OFF_YCAT) + 512;
    for (int idx = gt; idx < NTOK * 64; idx += nthr) { const int t = idx >> 6, hg = (idx >> 4) & 3, q = idx & 15;
        const float l0 = LSE[(size_t)t * 4 + hg], l1 = LSE[((size_t)NTOK + t) * 4 + hg], l2 = LSE[((size_t)2 * NTOK + t) * 4 + hg];
        const float m = fmaxf(l0, fmaxf(l1, l2)); const float e0 = __expf(l0 - m), e1 = __expf(l1 - m), e2 = __expf(l2 - m); const float inv = __builtin_amdgcn_rcpf(e0 + e1 + e2);
        const f32x4 o0 = *(const f32x4*)(DILO + ((size_t)t * 4 + hg) * 64 + 4 * q), o1 = *(const f32x4*)(DILO + (((size_t)NTOK + t) * 4 + hg) * 64 + 4 * q), o2 = *(const f32x4*)(DILO + (((size_t)2 * NTOK + t) * 4 + hg) * 64 + 4 * q);
        const f32x4 o = (o0 * e0 + o1 * e1 + o2 * e2) * inv;
        u32x2 w; w.x = cvt_pk_bf16(o[0], o[1]); w.y = cvt_pk_bf16(o[2], o[3]); *(u32x2*)(YD + (size_t)t * 1280 + hg * 64 + 4 * q) = w; }
}

__device__ __forceinline__ void phase_router(const int wv, LAS unsigned char* lds, const bool real = true) {
    KParams& p = *kparams();
    const int tid = opaque_tid(wv), wid = tid >> 6, lane = tid & 63, fr = lane & 15, fq = lane >> 4; unsigned char* ws = p.ws;
    const bf16_t* X1 = (const bf16_t*)(ws + OFF_X1B); const float* ln2 = p.in[25]; const float* br = p.in[27]; const bf16_t* WRT = (const bf16_t*)(ws + OFF_WRT);
    unsigned char* XN2 = ws + OFF_XN2; int* TOPE = (int*)(ws + OFF_TOPE); float* TOPG = (float*)(ws + OFF_TOPG);
    LAS int* hist = (LAS int*)(lds + LX_HIST);
    LAS float* red = (LAS float*)lds;
    LAS float* part = (LAS float*)(lds + 1024);
    if (tid < 32) hist[tid] = 0;
    const int grp = wid >> 2, kq = wid & 3;
    int tek[2][4] = {{0, 0, 0, 0}, {0, 0, 0, 0}}, lrk[2][4] = {{0, 0, 0, 0}, {0, 0, 0, 0}};
    u32x4 xq[2][8];
#pragma unroll
    for (int rd = 0; rd < 2; ++rd) { const bf16_t* xp = X1 + (size_t)((blockIdx.x * 4 + rd * 2 + grp) * 16 + fr) * 1024 + kq * 256 + 8 * fq;
#pragma unroll
        for (int s2 = 0; s2 < 8; ++s2) xq[rd][s2] = __builtin_nontemporal_load((const u32x4*)(xp + 32 * s2)); }
#pragma unroll
    for (int rd = 0; rd < 2; ++rd) { const int t0 = (blockIdx.x * 4 + rd * 2 + grp) * 16;
        f32x4 xa[8], xb[8]; float ss = 0.f;
#pragma unroll
        for (int s2 = 0; s2 < 8; ++s2) { float f[8]; unpack8(xq[rd][s2], f); xa[s2] = (f32x4){f[0], f[1], f[2], f[3]}; xb[s2] = (f32x4){f[4], f[5], f[6], f[7]}; }
#pragma unroll
        for (int s2 = 0; s2 < 8; ++s2) ss += xa[s2][0] * xa[s2][0] + xa[s2][1] * xa[s2][1] + xa[s2][2] * xa[s2][2] + xa[s2][3] * xa[s2][3] + xb[s2][0] * xb[s2][0] + xb[s2][1] * xb[s2][1] + xb[s2][2] * xb[s2][2] + xb[s2][3] * xb[s2][3];
        ss += sxor(ss, 16); ss += sxor(ss, 32);
        __syncthreads();
        if (fq == 0) red[(grp * 4 + kq) * 16 + fr] = ss;
        __syncthreads();
        const float tot = red[(grp * 4 + 0) * 16 + fr] + red[(grp * 4 + 1) * 16 + fr] + red[(grp * 4 + 2) * 16 + fr] + red[(grp * 4 + 3) * 16 + fr];
        const float rs = rsqrtf(tot * (1.0f / 1024.0f) + 1e-5f);
        f32x4 acc[2]; acc[0] = zero4f(); acc[1] = acc[0];
#pragma unroll
        for (int s2 = 0; s2 < 8; ++s2) { const int k = kq * 256 + 32 * s2 + 8 * fq;
            const f32x4 g0 = *(const f32x4*)(ln2 + k), g1 = *(const f32x4*)(ln2 + k + 4);
            float xn[8]; xn[0] = xa[s2][0] * rs * g0[0]; xn[1] = xa[s2][1] * rs * g0[1]; xn[2] = xa[s2][2] * rs * g0[2]; xn[3] = xa[s2][3] * rs * g0[3];
            xn[4] = xb[s2][0] * rs * g1[0]; xn[5] = xb[s2][1] * rs * g1[1]; xn[6] = xb[s2][2] * rs * g1[2]; xn[7] = xb[s2][3] * rs * g1[3];
            const u32x4 hi = pack8(xn); float hf[8]; unpack8(hi, hf);
#pragma unroll
            for (int j = 0; j < 8; ++j) hf[j] = xn[j] - hf[j];
            const u32x4 lo = pack8(hf);
            { u32x2 q8; q8.x = pack4_fp8(xn[0] * 8.0f, xn[1] * 8.0f, xn[2] * 8.0f, xn[3] * 8.0f); q8.y = pack4_fp8(xn[4] * 8.0f, xn[5] * 8.0f, xn[6] * 8.0f, xn[7] * 8.0f); if (real) *(u32x2*)(XN2 + (size_t)(t0 + fr) * 1024 + k) = q8; }
            bf16x8 xh, xl; __builtin_memcpy(&xh, &hi, 16); __builtin_memcpy(&xl, &lo, 16);
#pragma unroll
            for (int m = 0; m < 2; ++m) { const bf16x8 wh = *(const bf16x8*)(WRT + (size_t)(16 * m + fr) * 1024 + k), wl = *(const bf16x8*)(WRT + 32768 + (size_t)(16 * m + fr) * 1024 + k);
                acc[m] = MFMA16(wh, xh, acc[m]); acc[m] = MFMA16(wh, xl, acc[m]); acc[m] = MFMA16(wl, xh, acc[m]); } }
#pragma unroll
        for (int m = 0; m < 2; ++m)
#pragma unroll
            for (int j = 0; j < 4; ++j) part[((grp * 4 + kq) * 32 + 16 * m + 4 * fq + j) * 16 + fr] = acc[m][j];
        __syncthreads();
        if (kq == 0) { float lg[8]; int le[8];
#pragma unroll
            for (int m = 0; m < 2; ++m)
#pragma unroll
                for (int j = 0; j < 4; ++j) { const int e = 16 * m + 4 * fq + j; le[m * 4 + j] = e;
                    lg[m * 4 + j] = part[((grp * 4 + 0) * 32 + e) * 16 + fr] + part[((grp * 4 + 1) * 32 + e) * 16 + fr] + part[((grp * 4 + 2) * 32 + e) * 16 + fr] + part[((grp * 4 + 3) * 32 + e) * 16 + fr] + br[e]; }
            float tv[4]; int te[4];
#pragma unroll
            for (int r = 0; r < 4; ++r) { float bv = lg[0]; int bi = le[0];
#pragma unroll
                for (int q = 1; q < 8; ++q) if (lg[q] > bv) { bv = lg[q]; bi = le[q]; }
#pragma unroll
                for (int sft = 16; sft < 64; sft <<= 1) { const float ov = sxor(bv, sft); const int oi = sxor(bi, sft); if (ov > bv || (ov == bv && oi < bi)) { bv = ov; bi = oi; } }
                tv[r] = bv; te[r] = bi;
#pragma unroll
                for (int q = 0; q < 8; ++q) if (le[q] == bi) lg[q] = -3.0e38f; }
            const float e1 = __expf(tv[1] - tv[0]), e2 = __expf(tv[2] - tv[0]), e3 = __expf(tv[3] - tv[0]); const float inv = 1.0f / (1.0f + e1 + e2 + e3);
            if (fq == 0 && real) { const int t = t0 + fr; *(int4*)(TOPE + (size_t)t * 4) = make_int4(te[0], te[1], te[2], te[3]); *(f32x4*)(TOPG + (size_t)t * 4) = (f32x4){inv, e1 * inv, e2 * inv, e3 * inv};
#pragma unroll
                for (int k = 0; k < 4; ++k) { tek[rd][k] = te[k]; lrk[rd][k] = atomicAdd((int*)&hist[te[k]], 1); } } }
    }
    LAS int* bbase = (LAS int*)(lds + LX_BBASE);
    __syncthreads();
    if (tid < 32) { const int hcount = hist[tid]; bbase[tid] = (hcount && real) ? atomicAdd((int*)(ws + OFF_CTL + CTL_CUR) + tid, hcount) : 0; }
    __syncthreads();
    if (kq == 0 && fq == 0 && real) { int* POS = (int*)(ws + OFF_POS); int* STOKE = (int*)(ws + OFF_STOKE);
#pragma unroll
        for (int rd = 0; rd < 2; ++rd) { const int t = (blockIdx.x * 4 + rd * 2 + grp) * 16 + fr; int ps[4];
#pragma unroll
            for (int k = 0; k < 4; ++k) { ps[k] = bbase[tek[rd][k]] + lrk[rd][k]; STOKE[(size_t)tek[rd][k] * NTOK + ps[k]] = t; }
            *(int4*)(POS + (size_t)t * 4) = make_int4(ps[0], ps[1], ps[2], ps[3]); } }
}

__device__ __forceinline__ void build_tables(const int wv, LAS unsigned char* lds) {
    KParams& p = *kparams();
    LAS int* ts = (LAS int*)(lds + LX_TSTART); LAS int* sb = (LAS int*)(lds + LX_SBASE); LAS int* cn = (LAS int*)(lds + LX_CNT);
    if (wv == 0) { const int l = lane_id(); int* gc = (int*)(p.ws + OFF_CTL + CTL_CUR);
        const int c = (l < 32) ? (int)__hip_atomic_load(gc + l, __ATOMIC_RELAXED, __HIP_MEMORY_SCOPE_AGENT) : 0; const int tl = (c + 255) >> 8; int v = tl;
#pragma unroll
        for (int d = 1; d < 32; d <<= 1) { const int o = __builtin_amdgcn_ds_bpermute((l - d) << 2, v); if (l >= d) v += o; }
        if (l < 32) { cn[l] = c; sb[l] = (v - tl) * 256; ts[l + 1] = v; if (l == 0) ts[0] = 0; } }
    __syncthreads();
    { const int tid = (wv << 6) | lane_id(); LAS unsigned char* te = (LAS unsigned char*)(lds + LX_TEXP); const int nt = ts[32];
      if (tid < nt) { int e = 0; while (e < 31 && tid >= ts[e + 1]) ++e; te[tid] = (unsigned char)e; } }
    __syncthreads();
}

__device__ __forceinline__ void phase_combine(const int wv, const bool real = true) {
    KParams& p = *kparams();
    const int tid = opaque_tid(wv), wid = tid >> 6, lane = tid & 63; unsigned char* ws = p.ws;
    const int* SLOT = (const int*)(ws + OFF_SLOT); const float* TOPG = (const float*)(ws + OFF_TOPG); const bf16_t* YS = (const bf16_t*)(ws + OFF_YS); const bf16_t* X1 = (const bf16_t*)(ws + OFF_X1B); float* out = p.out;
    for (int t0 = (blockIdx.x * 8 + wid) * 8; t0 < NTOK; t0 += gridDim.x * 64) {
        int4 sl[8]; f32x4 gg[8];
#pragma unroll
        for (int i = 0; i < 8; ++i) { sl[i] = *(const int4*)(SLOT + (size_t)(t0 + i) * 4); gg[i] = *(const f32x4*)(TOPG + (size_t)(t0 + i) * 4); }
#pragma unroll
        for (int i = 0; i < 8; ++i) { const int t = t0 + i; const int s4[4] = {sl[i].x, sl[i].y, sl[i].z, sl[i].w};
#pragma unroll
            for (int hf = 0; hf < 2; ++hf) { const int c = hf * 512 + 8 * lane; float acc[8];
                const u32x4 xv = __builtin_nontemporal_load((const u32x4*)(X1 + (size_t)t * 1024 + c));
                u32x4 yv[4];
#pragma unroll
                for (int k = 0; k < 4; ++k) yv[k] = __builtin_nontemporal_load((const u32x4*)(YS + (size_t)s4[k] * 1024 + c));
                unpack8(xv, acc);
#pragma unroll
                for (int k = 0; k < 4; ++k) { float f[8]; unpack8(yv[k], f);
#pragma unroll
                    for (int j = 0; j < 8; ++j) acc[j] = fmaf(gg[i][k], f[j], acc[j]); }
                float* dst = real ? out : (float*)(ws + OFF_ACT);
                *(f32x4*)(dst + (size_t)t * 1024 + c) = (f32x4){acc[0], acc[1], acc[2], acc[3]}; *(f32x4*)(dst + (size_t)t * 1024 + c + 4) = (f32x4){acc[4], acc[5], acc[6], acc[7]}; }
            if (i & 1) asm volatile("" ::: "memory"); }
    }
}

__global__ void __launch_bounds__(512, 2) mk_fwd(Params p) {
    extern __shared__ __attribute__((aligned(16))) unsigned char lds_raw[];
    LAS unsigned char* lds = (LAS unsigned char*)lds_raw;
    unsigned char* ws = p.ws;
    const int wv = __builtin_amdgcn_readfirstlane((int)threadIdx.x >> 6);
    const bool multi = (p.ph_hi - p.ph_lo) > 1;
    XcdBarrier xb; xb.bar = (unsigned*)(ws + OFF_CTL); xb.x = 0; xb.st = (volatile LAS unsigned*)(lds + LDS_X);
    if (multi) {
        if (wv == 0 && lane_id() == 0) { *(LAS u32x4*)(lds + LDS_X) = zero4u(); }
        __syncthreads();
        xb = xcd_barrier_post((unsigned*)(ws + OFF_CTL), (volatile LAS unsigned*)(lds + LDS_X), wv);
    }
#if MFMA_BENCH
    { const int l = lane_id(); unsigned h = (unsigned)l * 2654435761u ^ (unsigned)blockIdx.x * 40503u ^ (unsigned)wv * 977u;
      i32x8 a, b;
#pragma unroll
      for (int j = 0; j < 8; ++j) { h = h * 1664525u + 1013904223u; a[j] = (int)(MFMA_BENCH == 1 ? ((h & 0x00ff00ffu) | 0x3f003f00u) : ((h & 0x0f0f0f0fu) | 0x30303030u));
                                    h = h * 1664525u + 1013904223u; b[j] = (int)(MFMA_BENCH == 1 ? ((h & 0x00ff00ffu) | 0x3f003f00u) : ((h & 0x0f0f0f0fu) | 0x30303030u)); }
      f32x4 c[8]; const f32x4 z0 = zero4f();
#pragma unroll
      for (int j = 0; j < 8; ++j) c[j] = z0;
      const int one_scale = 0x7f7f7f7f;
#pragma clang loop unroll(disable)
      for (int it = 0; it < (MFMA_BENCH == 1 ? 1875 : 938); ++it) {
#pragma unroll
          for (int j = 0; j < 8; ++j) {
              if (MFMA_BENCH == 1) c[j] = (j & 1) ? __builtin_amdgcn_mfma_f32_16x16x32_bf16(pg8::half8<1>(a), pg8::half8<1>(b), c[j], 0, 0, 0) : __builtin_amdgcn_mfma_f32_16x16x32_bf16(pg8::half8<0>(a), pg8::half8<0>(b), c[j], 0, 0, 0);
              else asm volatile("v_mfma_scale_f32_16x16x128_f8f6f4 %0, %1, %2, %0, %3, %3 op_sel_hi:[0,0,0]" : "+v"(c[j]) : "v"(a), "v"(b), "v"(one_scale)); } }
      asm volatile("s_nop 15\n\ts_nop 15" ::: "memory");
      float sm = 0.f;
#pragma unroll
      for (int j = 0; j < 8; ++j) sm += c[j][0] + c[j][1] + c[j][2] + c[j][3];
      if (sm == 1.2345f) *(float*)(ws + OFF_CTL + 8192) = sm; }
#endif
    for (int ph = p.ph_lo; ph < p.ph_hi; ++ph) {
      if (ph == 2 || ph == 3 || ph == 10) continue;
      for (int rep = 0; rep < (((DBL_MASK >> ph) & 1) ? 2 : 1); ++rep) {
        KParams& q = *kparams(); unsigned char* ws = q.ws;
        switch (ph) {
        case 0: phase_prep(wv, lds); break;
        case 1: { { SchedZ S; S.H = (const char*)(ws + OFF_H); S.WinT = (const char*)(ws + OFF_WINT); S.HM = (const char*)(ws + OFF_HM); S.WmkvT = (const char*)(ws + OFF_WMKVT); S.G = gridDim.x; S.c = blockIdx.x;
                    EpiZ E; E.Z = (bf16_t*)(ws + OFF_Z); E.KV = (bf16_t*)(ws + OFF_KV); E.GFp = (bf16_t*)(ws + OFF_GF); E.pn0 = 0; E.scale = 1.0f; pg8::gemm_phase(wv, lds, 1024, S, E); }
                  { SchedZ8 S; S.H8 = (const char*)(ws + OFF_H8); S.WIN8 = (const char*)(ws + OFF_WIN8); S.G = gridDim.x; S.c = blockIdx.x;
                    EpiZ E; E.Z = (bf16_t*)(ws + OFF_Z); E.KV = (bf16_t*)(ws + OFF_KV); E.GFp = (bf16_t*)(ws + OFF_GF); E.pn0 = 7; E.scale = 1.0f / 256.0f; pg8::gemm_phase<EpiZ, SchedZ8, 1>(wv, lds, 1024, S, E); }
                  { const int c = blockIdx.x; if (c >= 192) { const int r0 = c < 224 ? (c - 192) * TAIL1_A : 32 * TAIL1_A + (c - 224) * TAIL1_B;
                        prep_tiles(wv, lds, c < 224 ? TAIL1_A : TAIL1_B, [&](int n) { return NTILE - NRES + r0 + n; }); } } } break;
        case 2: phase_elem_c(wv); break;
        case 3: { pg8::DenseOrder S; S.init(ws + OFF_ALORA, ws + OFF_LORAT, NTOK, 1536, 256); EpiLora E; E.L = (float*)(ws + OFF_L); E.w0 = q.in[5]; E.a0 = q.in[7]; pg8::gemm_phase(wv, lds, 256, S, E); } break;
        case 4: phase_chunk_pre(wv, lds); break;
        case 5: for (int r2 = 0; r2 < (((DBL_MASK >> 16) & 1) ? 2 : 1); ++r2) phase_scan_seq(wv, lds);
                for (int r2 = 0; r2 < (((DBL_MASK >> 17) & 1) ? 2 : 1); ++r2) phase_dil_attn(wv, lds);
                for (int r2 = 0; r2 < (((DBL_MASK >> 18) & 1) ? 2 : 1); ++r2) phase_mem_attn(wv, lds); break;
        case 6: phase_post(wv); break;
        case 7: { pg8::DenseOrder S; S.init(ws + OFF_YCAT, ws + OFF_PCAT, NTOK, 1024, 1280); EpiMixCat E; E.mixbf = (bf16_t*)(ws + OFF_MIXBF); E.GF = (const bf16_t*)(ws + OFF_GF); E.tid = (wv << 6) | lane_id(); pg8::gemm_phase(wv, lds, 1280, S, E); } break;
        case 8: { pg8::DenseOrder S; S.init(ws + OFF_MIXBF, ws + OFF_WOT, NTOK, 1024, 1024); EpiX1 E; E.x = q.in[0]; E.x1 = (bf16_t*)(ws + OFF_X1B); pg8::gemm_phase(wv, lds, 1024, S, E); } break;
        case 9: phase_router(wv, lds, rep + 1 == (((DBL_MASK >> ph) & 1) ? 2 : 1)); break;
        case 11: { build_tables(wv, lds);
                   { const int* TOPE = (const int*)(ws + OFF_TOPE); const int* POS = (const int*)(ws + OFF_POS); int* SLOT = (int*)(ws + OFF_SLOT); const LAS int* sb = (const LAS int*)(lds + LX_SBASE);
                     for (int i = blockIdx.x * 512 + ((wv << 6) | lane_id()); i < NTOK * 4; i += gridDim.x * 512) SLOT[i] = sb[TOPE[i]] + POS[i]; }
                   SchedMoe<true> S; S.A = (const char*)(ws + OFF_XN2); S.Bt = (const char*)(ws + OFF_W1T); S.tstart = (const LAS int*)(lds + LX_TSTART); S.stok = (const int*)(ws + OFF_STOKE); S.lgN = 3; S.total = S.tstart[32] * 8; S.estride = (size_t)2048 * 1024; S.tbytes = (size_t)256 * 1024;
                   EpiSwiglu E; E.act = ws + OFF_ACT; E.b1 = q.in[29]; E.lds = lds; pg8::gemm_phase<EpiSwiglu, SchedMoe<true>, 1>(wv, lds, 1024, S, E);
                   { const int c = blockIdx.x, rem = S.total & 255, nearly = rem ? 256 - rem : 0, j = ((c & 7) * 32 + (c >> 3)) - rem;
                     if (rem && j >= 0 && j < 128) prep_tiles(wv, lds, TAIL6, [&](int n) { return NTILE - NRES + NRES1 + n * 128 + j; });
                     const int m = 128 - (nearly < 128 ? nearly : 128);
                     if (m > 0) { const int nf = m * TAIL6, top = nf - 1 - c; prep_tiles(wv, lds, top >= 0 ? top / (int)gridDim.x + 1 : 0, [&](int n) { const int f = top - n * (int)gridDim.x; return NTILE - NRES + NRES1 + (f / m) * 128 + nearly + (f % m); }); } } } break;
        case 12: { build_tables(wv, lds); SchedMoe<false> S; S.A = (const char*)(ws + OFF_ACT); S.Bt = (const char*)(ws + OFF_W2T); S.tstart = (const LAS int*)(lds + LX_TSTART); S.stok = nullptr; S.lgN = 2; S.total = S.tstart[32] * 4; S.estride = (size_t)1024 * 1024; S.tbytes = (size_t)256 * 1024;
                   EpiYs E; E.ys = (bf16_t*)(ws + OFF_YS); E.b2 = q.in[31]; E.lds = lds; pg8::gemm_phase<EpiYs, SchedMoe<false>, 1>(wv, lds, 1024, S, E); } break;
        case 13: phase_combine(wv, rep + 1 == (((DBL_MASK >> ph) & 1) ? 2 : 1)); break;
        default: break;
        }
      }
        if (ph + 1 < p.ph_hi) xcd_barrier(xb, wv);
        if (((DBL_MASK >> 20) & 1) && ph == 3 && multi) for (int e = 0; e < 10; ++e) xcd_barrier(xb, wv);
    }
}

extern "C" void kernel_launch(void* const* d_in, const int* in_sizes, int n_in, void* d_out, int out_size, void* d_ws, size_t ws_size, hipStream_t stream) {
    static int ready = 0;
    if (ready == 0) {
        if (n_in != 32 || out_size != NTOK * 1024 || ws_size < WS_NEED) { fprintf(stderr, "kernel_launch: unexpected shapes (n_in %d, out %d, ws %zu < %zu)\n", n_in, out_size, ws_size, (size_t)WS_NEED); ready = -1; return; }
        if (hipFuncSetAttribute((const void*)mk_fwd, hipFuncAttributeMaxDynamicSharedMemorySize, LDS_BYTES) != hipSuccess) { fprintf(stderr, "kernel_launch: hipFuncSetAttribute failed\n"); ready = -1; return; }
        int per_cu = 0, dev = 0, cus = 0; hipGetDevice(&dev); hipDeviceGetAttribute(&cus, hipDeviceAttributeMultiprocessorCount, dev);
        hipOccupancyMaxActiveBlocksPerMultiprocessor(&per_cu, (const void*)mk_fwd, 512, LDS_BYTES);
        if (per_cu < 1 || cus < 256) { fprintf(stderr, "kernel_launch: occupancy %d blocks/CU on %d CUs; need >= 1 on 256\n", per_cu, cus); ready = -1; (void)hipGetLastError(); return; }
        ready = 1;
    }
    if (ready < 0) return;
    hipMemsetAsync((char*)d_ws + OFF_CTL, 0, CTL_BYTES, stream);
    Params p{};
    for (int i = 0; i < 32; ++i) p.in[i] = (const float*)d_in[i];
    p.out = (float*)d_out; p.ws = (unsigned char*)d_ws;
#if MK_N_LAUNCH_PER_PHASE
    for (int ph = 0; ph < NPHASE; ++ph) { p.ph_lo = ph; p.ph_hi = ph + 1; hipLaunchKernelGGL(mk_fwd, dim3(256), dim3(512), LDS_BYTES, stream, p); }
#else
    p.ph_lo = 0; p.ph_hi = NPHASE;
    void* args[] = {&p};
    hipError_t e = hipLaunchCooperativeKernel((const void*)mk_fwd, dim3(256), dim3(512), args, LDS_BYTES, stream);
    if (e != hipSuccess) fprintf(stderr, "cooperative launch failed: %s\n", hipGetErrorString(e));
#endif
}
```

```cpp
#include <hip/hip_runtime.h>
#include <cstdio>
#include <cstdint>

#define LAS __attribute__((address_space(3)))
typedef unsigned short bf16_t;
typedef short bf16x8 __attribute__((ext_vector_type(8)));
typedef short s16x4 __attribute__((ext_vector_type(4)));
typedef float f32x4 __attribute__((ext_vector_type(4)));
typedef float f32x2 __attribute__((ext_vector_type(2)));
typedef unsigned u32x4 __attribute__((ext_vector_type(4)));
typedef unsigned u32x2 __attribute__((ext_vector_type(2)));
typedef int i32x8 __attribute__((ext_vector_type(8)));
typedef int i32x4 __attribute__((ext_vector_type(4)));

#ifndef DBL_MASK
#define DBL_MASK 0
#endif
#ifndef MK_N_LAUNCH_PER_PHASE
#define MK_N_LAUNCH_PER_PHASE 0
#endif

constexpr int NTOK = 16384, SEQ = 2048, INC = 7680;
constexpr int C_K = 512, C_V = 1024, C_ZW = 1536, C_DQ = 1792, C_DK = 2560, C_DV = 3328, C_MQ = 4096, C_GATE = 4608;
constexpr int NPHASE = 14;
constexpr int NSLOT_MAX = 65536 + 32 * 256;

constexpr size_t MiB = 1ull << 20;
constexpr size_t OFF_CTL = 0;
constexpr size_t CTL_BYTES = 32768;
constexpr size_t CTL_CNT = 16384;
constexpr size_t CTL_CUR = 16384 + 256;
constexpr size_t CTL_KEEP = 20480;
constexpr size_t OFF_TOPE = 1 * MiB;
constexpr size_t OFF_TOPG = 1 * MiB + 262144;
constexpr size_t OFF_SLOT = 1 * MiB + 524288;
constexpr size_t OFF_STOK = 2 * MiB;
constexpr size_t OFF_WRT = 3 * MiB;
constexpr size_t OFF_WINT = 4 * MiB, OFF_WMKVT = 19 * MiB, OFF_LORAT = 21 * MiB, OFF_PRT = 22 * MiB, OFF_PDT = 23 * MiB, OFF_PMT = 24 * MiB, OFF_WOT = 25 * MiB;
constexpr size_t OFF_WIN8 = 8 * MiB;
constexpr size_t OFF_H8 = 539 * MiB;
constexpr size_t OFF_YCAT = 223 * MiB;
constexpr size_t OFF_PCAT = 22 * MiB;
constexpr size_t OFF_W1T = 27 * MiB, OFF_W2T = 155 * MiB, OFF_KV = 219 * MiB, OFF_YM = 223 * MiB, OFF_YR = 239 * MiB, OFF_YD = 255 * MiB, OFF_Z = 263 * MiB;
constexpr size_t OFF_H = 503 * MiB, OFF_HM = 535 * MiB, OFF_ALORA = 503 * MiB, OFF_L = 511 * MiB, OFF_REC = 607 * MiB;
constexpr size_t OFF_GF = OFF_REC;
constexpr size_t OFF_LW = OFF_REC + 64 * MiB;
constexpr size_t OFF_VB = OFF_REC + 96 * MiB;
constexpr size_t OFF_GTF = OFF_REC + 112 * MiB;
constexpr size_t OFF_RTF = OFF_REC + 144 * MiB;
constexpr size_t OFF_HHF = OFF_REC + 160 * MiB;
constexpr size_t OFF_YLF = OFF_REC + 192 * MiB;
constexpr size_t OFF_C1 = 816 * MiB, OFF_C2 = 832 * MiB, OFF_YRAW = 848 * MiB, OFF_DILO = 880 * MiB, OFF_LSE = 928 * MiB;
constexpr size_t OFF_MIX32 = 503 * MiB, OFF_MIXBF = 567 * MiB, OFF_XN2 = 503 * MiB, OFF_XS = 263 * MiB, OFF_ACT = 607 * MiB, OFF_YS = 407 * MiB;
constexpr size_t OFF_X1B = 263 * MiB;
constexpr size_t OFF_STOKE = 296 * MiB;
constexpr size_t OFF_POS = 2 * MiB;
constexpr size_t WS_NEED = 929 * MiB;

constexpr int LDS_BYTES = 160 * 1024;
constexpr int LDS_X = LDS_BYTES - 4096;
constexpr int LX_TSTART = LDS_X + 64;
constexpr int LX_SBASE = LDS_X + 256;
constexpr int LX_CNT = LDS_X + 512;
constexpr int LX_HIST = LDS_X + 768;
constexpr int LX_BBASE = LDS_X + 1024;
constexpr int LX_SLOTL = LDS_X + 2048;
constexpr int LX_TEXP = LDS_X + 3072;

struct Params { const float* in[32]; float* out; unsigned char* ws; int ph_lo, ph_hi; };
typedef const Params __attribute__((address_space(4))) KParams;
__device__ __forceinline__ KParams* kparams() { KParams* kp = (KParams*)__builtin_amdgcn_kernarg_segment_ptr(); asm volatile("" : "+s"(kp)); return kp; }

typedef __bf16 bf16x2_t __attribute__((ext_vector_type(2)));
__device__ __forceinline__ unsigned cvt_pk_bf16(float lo, float hi) { f32x2 v = {lo, hi}; bf16x2_t b = __builtin_convertvector(v, bf16x2_t); unsigned r; __builtin_memcpy(&r, &b, 4); return r; }
__device__ __forceinline__ unsigned pack4_fp8(float a, float b, float c, float d) { int r = __builtin_amdgcn_cvt_pk_fp8_f32(a, b, 0, false); r = __builtin_amdgcn_cvt_pk_fp8_f32(c, d, r, true); return (unsigned)r; }
__device__ __forceinline__ float bf_lo(unsigned u) { return __uint_as_float(u << 16); }
__device__ __forceinline__ float bf_hi(unsigned u) { return __uint_as_float(u & 0xffff0000u); }
__device__ __forceinline__ int lane_id() { int l; asm volatile("v_mbcnt_lo_u32_b32 %0, -1, 0\n\tv_mbcnt_hi_u32_b32 %0, -1, %0" : "=v"(l)); return l; }
__device__ __forceinline__ int sxor(int x, int m) { return __builtin_amdgcn_ds_bpermute((lane_id() ^ m) << 2, x); }
__device__ __forceinline__ float sxor(float x, int m) { return __int_as_float(__builtin_amdgcn_ds_bpermute((lane_id() ^ m) << 2, __float_as_int(x))); }
template <int CTRL> __device__ __forceinline__ float dpp_f(float x) { return __int_as_float(__builtin_amdgcn_update_dpp(0, __float_as_int(x), CTRL, 0xF, 0xF, true)); }
__device__ __forceinline__ float red4(float x) { x += dpp_f<0xB1>(x); x += dpp_f<0x4E>(x); return x; }
__device__ __forceinline__ float red8(float x) { x = red4(x); x += dpp_f<0x141>(x); return x; }
__device__ __forceinline__ float red16(float x) { x = red8(x); x += dpp_f<0x140>(x); return x; }
__device__ __forceinline__ float red64(float x) { x = red16(x); x += sxor(x, 16); x += sxor(x, 32); return x; }
__device__ __forceinline__ int opaque_tid(const int wv) { int t = (wv << 6) | lane_id(); asm volatile("" : "+v"(t)); return t; }
__device__ __forceinline__ f32x4 zero4f() { float z = 0.f; asm volatile("" : "+v"(z)); return (f32x4){z, z, z, z}; }
__device__ __forceinline__ u32x4 zero4u() { unsigned z = 0u; asm volatile("" : "+v"(z)); return (u32x4){z, z, z, z}; }
__device__ __forceinline__ float sigmoidf_(float x) { return __builtin_amdgcn_rcpf(1.0f + __builtin_amdgcn_exp2f(-1.44269504f * x)); }
__device__ __forceinline__ void unpack8(const u32x4 v, float (&f)[8]) { f[0] = bf_lo(v.x); f[1] = bf_hi(v.x); f[2] = bf_lo(v.y); f[3] = bf_hi(v.y); f[4] = bf_lo(v.z); f[5] = bf_hi(v.z); f[6] = bf_lo(v.w); f[7] = bf_hi(v.w); }
__device__ __forceinline__ u32x4 pack8(const float (&f)[8]) { u32x4 w; w.x = cvt_pk_bf16(f[0], f[1]); w.y = cvt_pk_bf16(f[2], f[3]); w.z = cvt_pk_bf16(f[4], f[5]); w.w = cvt_pk_bf16(f[6], f[7]); return w; }
__device__ __forceinline__ float sumsq8(const u32x4 v) { float f[8]; unpack8(v, f); float s = 0.f;
#pragma unroll
    for (int j = 0; j < 8; ++j) s += f[j] * f[j];
    return s; }
__device__ __forceinline__ u32x4 scale8(const u32x4 v, const float rs, const float* w) { float f[8]; unpack8(v, f); const f32x4 w0 = *(const f32x4*)w, w1 = *(const f32x4*)(w + 4);
    f[0] *= rs * w0[0]; f[1] *= rs * w0[1]; f[2] *= rs * w0[2]; f[3] *= rs * w0[3]; f[4] *= rs * w1[0]; f[5] *= rs * w1[1]; f[6] *= rs * w1[2]; f[7] *= rs * w1[3]; return pack8(f); }
__device__ __forceinline__ u32x4 scale8r(const u32x4 v, const float rs, const float (&w)[8]) { float f[8]; unpack8(v, f);
#pragma unroll
    for (int j = 0; j < 8; ++j) f[j] *= rs * w[j];
    return pack8(f); }
__device__ __forceinline__ u32x4 scale8s(const u32x4 v, const float rs) { float f[8]; unpack8(v, f);
#pragma unroll
    for (int j = 0; j < 8; ++j) f[j] *= rs;
    return pack8(f); }
__device__ __forceinline__ void unpack4(const u32x2 v, float (&f)[4]) { f[0] = bf_lo(v.x); f[1] = bf_hi(v.x); f[2] = bf_lo(v.y); f[3] = bf_hi(v.y); }

#define XB_TMO      128
#define XB_XCNT(j)  (256  + 64 * (j))
#define XB_XSUB(j)  (1280 + 64 * (j))
#define XB_XGEN(j)  (2304 + 64 * (j))
#define XB_TOP      3328
#define XB_TOPGEN   3392
#define XCD_BAR_WORDS 3456
#define XB_SPIN_CAP (1u << 22)
__device__ __forceinline__ unsigned xb_ld(unsigned* p)              { return __hip_atomic_load(p, __ATOMIC_RELAXED, __HIP_MEMORY_SCOPE_AGENT); }
__device__ __forceinline__ unsigned xb_add(unsigned* p, unsigned v) { return __hip_atomic_fetch_add(p, v, __ATOMIC_RELAXED, __HIP_MEMORY_SCOPE_AGENT); }
__device__ __forceinline__ unsigned xb_xcc_id() { return (unsigned)__builtin_amdgcn_s_getreg((3 << 11) | 20) & 0xFu; }
#define XB_SPIN(cond, bar) do { unsigned _sp = 0; while (cond) { __builtin_amdgcn_s_sleep(1); \
    if ((++_sp & 255u) == 0u) { if (xb_ld(&(bar)[XB_TMO])) break; if (_sp > XB_SPIN_CAP) { atomicAdd(&(bar)[XB_TMO], 1u); break; } } } } while (0)
struct XcdBarrier { unsigned* bar; unsigned x; volatile LAS unsigned* st; };
__device__ __forceinline__ XcdBarrier xcd_barrier_post(unsigned* bar, volatile LAS unsigned* st, const int wv) {
    XcdBarrier b; b.bar = bar; b.x = xb_xcc_id(); b.st = st;
    if (wv == 0 && lane_id() == 0) (void)xb_add(&bar[XB_XCNT(b.x)], 1u);
    return b;
}
__device__ __forceinline__ void xcd_barrier_complete(unsigned* bar, unsigned x, unsigned& nloc, unsigned& nx) {
    const unsigned G = gridDim.x * gridDim.y * gridDim.z;
    unsigned sum, cnt, mine, sp = 0u;
    for (;;) {
        sum = 0u; cnt = 0u; mine = 0u;
#pragma unroll
        for (unsigned j = 0; j < 16; ++j) { const unsigned c = xb_ld(&bar[XB_XCNT(j)]); sum += c; cnt += (c > 0u) ? 1u : 0u; mine = (j == x) ? c : mine; }
        if (sum == G) break;
        __builtin_amdgcn_s_sleep(1);
        if ((++sp & 255u) == 0u) { if (xb_ld(&bar[XB_TMO])) break; if (sp > XB_SPIN_CAP) { atomicAdd(&bar[XB_TMO], 1u); break; } }
    }
    nloc = mine > 0u ? mine : 1u; nx = cnt > 0u ? cnt : 1u;
}
__device__ __forceinline__ void xcd_barrier(const XcdBarrier& b, const int wv) {
    asm volatile("s_waitcnt vmcnt(0)" ::: "memory");
    __syncthreads();
    if (wv == 0 && lane_id() == 0) {
        unsigned* bar = b.bar;
        __builtin_amdgcn_s_waitcnt(0);
        unsigned nloc = b.st[0], nx = b.st[1];
        if (nloc == 0u) { xcd_barrier_complete(bar, b.x, nloc, nx); b.st[0] = nloc; b.st[1] = nx; }
        const unsigned old = xb_add(&bar[XB_XSUB(b.x)], 1u);
        const unsigned gen = old / nloc;
        if (old + 1u == (gen + 1u) * nloc) {
            __builtin_amdgcn_fence(__ATOMIC_RELEASE, "agent");
            asm volatile("s_waitcnt vmcnt(0)" ::: "memory");
            const unsigned og = xb_add(&bar[XB_TOP], 1u);
            const unsigned tg = og / nx;
            if (og + 1u == (tg + 1u) * nx) xb_add(&bar[XB_TOPGEN], 1u);
            else XB_SPIN(xb_ld(&bar[XB_TOPGEN]) == tg, bar);
            __builtin_amdgcn_fence(__ATOMIC_ACQUIRE, "agent");
            xb_add(&bar[XB_XGEN(b.x)], 1u);
            asm volatile("s_waitcnt vmcnt(0)" ::: "memory");
        } else {
            XB_SPIN(xb_ld(&bar[XB_XGEN(b.x)]) == gen, bar);
            __builtin_amdgcn_fence(__ATOMIC_ACQUIRE, "agent");
            asm volatile("s_waitcnt vmcnt(0)" ::: "memory");
        }
    }
    __syncthreads();
}

#ifndef MFMA_BENCH
#define MFMA_BENCH 0
#endif
#ifndef EDBL
#define EDBL 0
#endif
#ifndef KMODE
#define KMODE 0
#endif
#ifndef KDBL
#define KDBL 0
#endif
struct EpiSwiglu; struct EpiYs; struct EpiZ; struct EpiMixCat; struct EpiX1;
namespace pg8 {
constexpr int BM = 256, BK = 64, HALF = 128, HTB = HALF * BK * 2, STAGE_BYTES = 8 * HTB, NXCD = 8, WGM = 8;
__host__ __device__ __forceinline__ int lds_byte(int r, int c) { const int st = (r >> 4) * 2 + (c >> 5), rr = r & 15, cc = c & 31, ob = rr * 64 + cc * 2; return st * 1024 + (ob ^ (((ob >> 9) & 1) << 5)); }
__host__ __device__ __forceinline__ void stage_rc(int b, int& R, int& C) { const int st = b / 1024, sb = b % 1024, swz = sb ^ (((sb >> 9) & 1) << 5); R = (st >> 1) * 16 + swz / 64; C = (st & 1) * 32 + (swz % 64) / 2; }
__host__ __device__ __forceinline__ int perm32(int rho) { const int n = rho >> 4, i = rho & 15; return 8 * (i >> 2) + 4 * n + (i & 3); }
struct Unit { int pm, pn, tag, aux; const char* pa; const char* pb; };
template <class E, class = void> struct HasPre { static constexpr bool value = false; };
template <class E> struct HasPre<E, decltype((void)E::PRE)> { static constexpr bool value = true; };

__device__ __forceinline__ void static_map(long L, int nM, int nN, int& pm, int& pn) {
    const int nwg = nM * nN; int wgid = (int)L;
    { const int q = nwg / NXCD, r = nwg % NXCD, xcd = wgid % NXCD, off = wgid / NXCD; wgid = (xcd < r ? xcd * (q + 1) : r * (q + 1) + (xcd - r) * q) + off; }
    const int nig = WGM * nN, gid = wgid / nig, fm = gid * WGM, gsz = (nM - fm) < WGM ? (nM - fm) : WGM;
    pm = fm + ((wgid % nig) % gsz); pn = (wgid % nig) / gsz;
}
struct DenseOrder {
    static constexpr bool GATHER = false; __device__ __forceinline__ unsigned a_off(const Unit&, int, int, int, int) const { return 0u; }
    const char* A; const char* Bt; int nM, nN, G, c; size_t tstep;
    __device__ __forceinline__ void init(const void* A_, const void* Bt_, int M, int N, int K) { A = (const char*)A_; Bt = (const char*)Bt_; nM = M / BM; nN = N / BM; G = gridDim.x; c = blockIdx.x; tstep = (size_t)BM * K * 2; }
    __device__ __forceinline__ bool next(int i, Unit& u) const {
        const long L = (long)i * G + c; if (L >= (long)nM * nN) return false;
        static_map(L, nM, nN, u.pm, u.pn); u.tag = 0; u.pa = A + (size_t)u.pm * tstep; u.pb = Bt + (size_t)u.pn * tstep; return true;
    }
};

template <int H> __device__ __forceinline__ bf16x8 half8(const i32x8 v) { const i32x4 x = H ? __builtin_shufflevector(v, v, 4, 5, 6, 7) : __builtin_shufflevector(v, v, 0, 1, 2, 3); bf16x8 r; __builtin_memcpy(&r, &x, 16); return r; }
template <class Epi, class Sched, int ES = 2>
__device__ __forceinline__ void gemm_phase(const int wv, LAS unsigned char* lds, const int K, const Sched& S, const Epi& E) {
    int tid_ = (wv << 6) | lane_id(); asm volatile("" : "+v"(tid_));
    const int tid = tid_, wid = __builtin_amdgcn_readfirstlane(tid >> 6), lane = tid & 63, wr = wid >> 2, wc = wid & 3, fr = lane & 15, fq = lane >> 4;
    const int nt = K * ES / (BK * 2);
    unsigned voffA[2], voffB[2]; int RA[2], CA[2];
#pragma unroll
    for (int i = 0; i < 2; ++i) { int R, C; stage_rc(tid * 16 + i * 8192, R, C); const int Rb = Epi::PERM ? ((R & ~31) + perm32(R & 31)) : R; RA[i] = R; CA[i] = C;
        voffA[i] = (unsigned)(R * K * ES + C * 2); voffB[i] = (unsigned)(Rb * K * ES + C * 2); }
    unsigned vA[2][2][2];
    const size_t kstep = (size_t)(BK * 2);
    const size_t hstep = (size_t)HALF * K * ES;
    const unsigned ldsw = (unsigned)wid * 1024u;
    const int aoff = lds_byte(wr * 64 + fr, fq * 8), boff = lds_byte(wc * 32 + fr, fq * 8);
#define PG8_SA(b, h) (((b) * 2 + (h)) * HTB)
#define PG8_SB(b, h) ((4 + (b) * 2 + (h)) * HTB)
#define PG8_STAGE(bufoff, gbase, voff) do { _Pragma("unroll") for (int _i = 0; _i < 2; ++_i) \
        __builtin_amdgcn_global_load_lds((const unsigned*)((const char*)(gbase) + (voff)[_i]), (LAS unsigned*)(lds + (bufoff) + ldsw + _i * 8192), 16, 0, 0); } while (0)
#define PG8_LDA(dst, b, h) do { _Pragma("unroll") for (int m = 0; m < 4; ++m) { const i32x4 _lo = *(const LAS i32x4*)(lds + PG8_SA(b, h) + aoff + m * 2048), _hi = *(const LAS i32x4*)(lds + PG8_SA(b, h) + aoff + m * 2048 + 1024); dst[m] = __builtin_shufflevector(_lo, _hi, 0, 1, 2, 3, 4, 5, 6, 7); } } while (0)
#define PG8_LDB(dst, b, h) do { _Pragma("unroll") for (int n = 0; n < 2; ++n) { const i32x4 _lo = *(const LAS i32x4*)(lds + PG8_SB(b, h) + boff + n * 2048), _hi = *(const LAS i32x4*)(lds + PG8_SB(b, h) + boff + n * 2048 + 1024); dst[n] = __builtin_shufflevector(_lo, _hi, 0, 1, 2, 3, 4, 5, 6, 7); } } while (0)
#define PG8_MMA(ai, bj, At, Bt) do { __builtin_amdgcn_s_setprio(1); _Pragma("unroll") for (int m = 0; m < 4; ++m) _Pragma("unroll") for (int n = 0; n < 2; ++n) { \
        if (ES == 2) { acc[ai][bj][m][n] = __builtin_amdgcn_mfma_f32_16x16x32_bf16(half8<0>(Bt[n]), half8<0>(At[m]), acc[ai][bj][m][n], 0, 0, 0); \
                       acc[ai][bj][m][n] = __builtin_amdgcn_mfma_f32_16x16x32_bf16(half8<1>(Bt[n]), half8<1>(At[m]), acc[ai][bj][m][n], 0, 0, 0); } \
        else asm volatile("v_mfma_scale_f32_16x16x128_f8f6f4 %0, %1, %2, %0, %3, %3 op_sel_hi:[0,0,0]" : "+v"(acc[ai][bj][m][n]) : "v"(Bt[n]), "v"(At[m]), "v"(one_scale)); } \
        __builtin_amdgcn_s_setprio(0); } while (0)
#define PG8_WAIT_V(n) asm volatile("s_waitcnt vmcnt(" #n ")" ::: "memory")
#define PG8_WAIT_L(n) asm volatile("s_waitcnt lgkmcnt(" #n ")" ::: "memory")
#define PG8_BAR __builtin_amdgcn_s_barrier()
#define PG8_SCHED __builtin_amdgcn_sched_barrier(0)
    constexpr int kd = (KDBL == 1 && (__is_same(Epi, EpiSwiglu) || __is_same(Epi, EpiYs))) || (KDBL == 2 && __is_same(Epi, EpiZ)) || (KDBL == 3 && (__is_same(Epi, EpiMixCat) || __is_same(Epi, EpiX1))) ? 1 : 0;
    Unit cur, nxt; int ui = 0;
    if (!S.next(0, cur)) return;
    cur.aux = 0; if constexpr (HasPre<Epi>::value) E.pre(cur, wid, wc, lane);
    f32x4 acc[2][2][4][2]; const f32x4 zz0 = zero4f();
#pragma unroll
    for (int a = 0; a < 2; ++a)
#pragma unroll
        for (int b = 0; b < 2; ++b)
#pragma unroll
            for (int m = 0; m < 4; ++m)
#pragma unroll
                for (int n = 0; n < 2; ++n) acc[a][b][m][n] = zz0;
    i32x8 At[4], B0[2], B1[2];
    const int one_scale = 0x7f7f7f7f;
    const char* cA = cur.pa; const char* cB = cur.pb;
#pragma unroll
    for (int h = 0; h < 2; ++h)
#pragma unroll
        for (int i = 0; i < 2; ++i) vA[0][h][i] = Sched::GATHER ? S.a_off(cur, h, RA[i], CA[i], K * ES) : voffA[i] + (unsigned)(h * hstep);
    if constexpr (kd && KMODE == 1) { cA = S.A; cB = S.Bt;
#pragma unroll
        for (int h = 0; h < 2; ++h)
#pragma unroll
            for (int i = 0; i < 2; ++i) vA[0][h][i] = voffA[i] + (unsigned)(h * hstep); }
    PG8_STAGE(PG8_SB(0, 0), cB, voffB); PG8_STAGE(PG8_SA(0, 0), cA, vA[0][0]); PG8_STAGE(PG8_SB(0, 1), cB + hstep, voffB); PG8_STAGE(PG8_SA(0, 1), cA, vA[0][1]);
    if (wr == 1) PG8_BAR;
    PG8_WAIT_V(4); PG8_BAR;
    PG8_STAGE(PG8_SB(1, 0), cB + kstep, voffB); PG8_STAGE(PG8_SA(1, 0), cA + kstep, vA[0][0]); PG8_STAGE(PG8_SB(1, 1), cB + hstep + kstep, voffB);
    PG8_WAIT_V(6); PG8_BAR;
    for (;;) {
        const bool has_next = S.next((ui + 1) >> kd, nxt);
        const char* nA = has_next ? nxt.pa : cA; const char* nB = has_next ? nxt.pb : cB;
#pragma unroll
        for (int h = 0; h < 2; ++h)
#pragma unroll
            for (int i = 0; i < 2; ++i) vA[1][h][i] = has_next ? (Sched::GATHER ? S.a_off(nxt, h, RA[i], CA[i], K * ES) : voffA[i] + (unsigned)(h * hstep)) : vA[0][h][i];
        if constexpr (kd && KMODE == 1) { if (has_next && (ui & 1)) { nA = S.A; nB = S.Bt;
#pragma unroll
            for (int h = 0; h < 2; ++h)
#pragma unroll
                for (int i = 0; i < 2; ++i) vA[1][h][i] = voffA[i] + (unsigned)(h * hstep); } }
        const bool ld = !(kd && KMODE == 2 && !(ui & 1));
#pragma clang loop unroll(disable)
        for (int t = 0; t < nt; t += 2) {
            if constexpr (Epi::MID) { if (t == 8 || t == 12) E.mid(acc, cur, t, wr, wc, fr, fq); }
            const bool last = (t == nt - 2);
            const char* a1 = cA + (size_t)(t + 1) * kstep;
            const char* a2 = last ? nA : cA + (size_t)(t + 2) * kstep; const char* b2 = last ? nB : cB + (size_t)(t + 2) * kstep;
            const char* a3 = a2 + kstep; const char* b3 = b2 + kstep;
            unsigned w0[2], w1[2];
#pragma unroll
            for (int i = 0; i < 2; ++i) { w0[i] = vA[0][0][i]; w1[i] = vA[0][1][i]; }
            if (last) { asm volatile("" ::: "memory");
#pragma unroll
                for (int i = 0; i < 2; ++i) { w0[i] = vA[1][0][i]; w1[i] = vA[1][1][i]; } }
            PG8_LDB(B0, 0, 0); PG8_SCHED; PG8_LDA(At, 0, 0); if (ld) PG8_STAGE(PG8_SA(1, 1), a1, vA[0][1]);
            PG8_WAIT_L(8); PG8_BAR; PG8_WAIT_L(0); PG8_MMA(0, 0, At, B0); PG8_BAR; PG8_SCHED;
            PG8_LDB(B1, 0, 1); if (ld || last) PG8_STAGE(PG8_SB(0, 0), b2, voffB);
            PG8_BAR; PG8_WAIT_L(0); PG8_MMA(0, 1, At, B1); PG8_BAR;
            PG8_LDA(At, 0, 1); if (ld || last) PG8_STAGE(PG8_SA(0, 0), a2, w0);
            PG8_BAR; PG8_WAIT_L(0); PG8_MMA(1, 0, At, B0); PG8_BAR; PG8_SCHED;
            if (ld || last) PG8_STAGE(PG8_SB(0, 1), b2 + hstep, voffB);
            PG8_WAIT_V(6); PG8_BAR; PG8_MMA(1, 1, At, B1); PG8_BAR;
            PG8_LDB(B0, 1, 0); PG8_SCHED; PG8_LDA(At, 1, 0); if (ld || last) PG8_STAGE(PG8_SA(0, 1), a2, w1);
            PG8_WAIT_L(8); PG8_BAR; PG8_WAIT_L(0); PG8_MMA(0, 0, At, B0); PG8_BAR; PG8_SCHED;
            PG8_LDB(B1, 1, 1); if (ld || last) PG8_STAGE(PG8_SB(1, 0), b3, voffB);
            PG8_BAR; PG8_WAIT_L(0); PG8_MMA(0, 1, At, B1); PG8_BAR;
            PG8_LDA(At, 1, 1); if (ld || last) PG8_STAGE(PG8_SA(1, 0), a3, w0);
            PG8_BAR; PG8_WAIT_L(0); PG8_MMA(1, 0, At, B0); PG8_BAR; PG8_SCHED;
            if (ld || last) PG8_STAGE(PG8_SB(1, 1), b3 + hstep, voffB);
            PG8_WAIT_V(6); PG8_BAR; PG8_MMA(1, 1, At, B1); PG8_BAR;
        }
        if (ES == 1) asm volatile("s_nop 15\n\ts_nop 15" ::: "memory");
        if (!kd || (ui & 1)) E(acc, cur, wr, wc, fr, fq);
        if constexpr (EDBL == 1 && (__is_same(Epi, EpiSwiglu) || __is_same(Epi, EpiYs))) { asm volatile("" ::: "memory"); E(acc, cur, wr, wc, fr, fq); }
        if (!has_next) break;
        const f32x4 zz1 = zero4f();
#pragma unroll
        for (int a = 0; a < 2; ++a)
#pragma unroll
            for (int b = 0; b < 2; ++b)
#pragma unroll
                for (int m = 0; m < 4; ++m)
#pragma unroll
                    for (int n = 0; n < 2; ++n) acc[a][b][m][n] = zz1;
        cur = nxt; cA = nA; cB = nB; ++ui;
        cur.aux = ui & 1; if constexpr (HasPre<Epi>::value) E.pre(cur, wid, wc, lane);
#pragma unroll
        for (int h = 0; h < 2; ++h)
#pragma unroll
            for (int i = 0; i < 2; ++i) vA[0][h][i] = vA[1][h][i];
    }
    PG8_WAIT_V(0);
    if (wr == 0) PG8_BAR;
    PG8_BAR;
#undef PG8_SA
#undef PG8_SB
#undef PG8_STAGE
#undef PG8_LDA
#undef PG8_LDB
#undef PG8_MMA
#undef PG8_WAIT_V
#undef PG8_WAIT_L
#undef PG8_BAR
#undef PG8_SCHED
}
}
using pg8::Unit;

struct EpiZ {
    static constexpr bool PERM = true, MID = false;
    bf16_t* Z; bf16_t* KV; bf16_t* GFp; int pn0; float scale;
    __device__ __forceinline__ void operator()(const f32x4 (&acc)[2][2][4][2], const Unit& u, int wr, int wc, int fr, int fq) const {
        const bool kvu = u.pn >= 32; const int pn = (u.pn & 31) + (kvu ? 0 : pn0);
        bf16_t* base = kvu ? KV : Z; const int ldc = kvu ? 1024 : INC; const bool sg = (!kvu) && (pn >= C_GATE / 256);
        if (sg) {
            bf16_t* gf = GFp + ((size_t)(u.pm * 12 + (pn - C_GATE / 256)) * 16) * 4096 + (size_t)((wr * 4 + wc) * 64 + fq * 16 + fr) * 8;
#pragma unroll
            for (int ai = 0; ai < 2; ++ai)
#pragma unroll
                for (int m = 0; m < 4; ++m)
#pragma unroll
                    for (int bj = 0; bj < 2; ++bj) { f32x4 v0 = acc[ai][bj][m][0] * scale, v1 = acc[ai][bj][m][1] * scale;
#pragma unroll
                        for (int j = 0; j < 4; ++j) { v0[j] = sigmoidf_(v0[j]); v1[j] = sigmoidf_(v1[j]); }
                        u32x4 w; w.x = cvt_pk_bf16(v0[0], v0[1]); w.y = cvt_pk_bf16(v0[2], v0[3]); w.z = cvt_pk_bf16(v1[0], v1[1]); w.w = cvt_pk_bf16(v1[2], v1[3]);
                        *(u32x4*)(gf + (size_t)((ai * 4 + m) * 2 + bj) * 4096) = w; }
            return; }
        const int row0 = u.pm * 256 + wr * 64 + fr, col0 = pn * 256 + wc * 32 + 8 * fq;
#pragma unroll
        for (int ai = 0; ai < 2; ++ai)
#pragma unroll
            for (int m = 0; m < 4; ++m) { bf16_t* rowp = base + (size_t)(row0 + ai * 128 + m * 16) * ldc + col0;
#pragma unroll
                for (int bj = 0; bj < 2; ++bj) { f32x4 v0 = acc[ai][bj][m][0] * scale, v1 = acc[ai][bj][m][1] * scale;
                    if (sg) {
#pragma unroll
                        for (int j = 0; j < 4; ++j) { v0[j] = sigmoidf_(v0[j]); v1[j] = sigmoidf_(v1[j]); } }
                    u32x4 w; w.x = cvt_pk_bf16(v0[0], v0[1]); w.y = cvt_pk_bf16(v0[2], v0[3]); w.z = cvt_pk_bf16(v1[0], v1[1]); w.w = cvt_pk_bf16(v1[2], v1[3]);
                    *(u32x4*)(rowp + bj * 128) = w; } }
    }
};
struct SchedZ8 {
    static constexpr bool GATHER = false; __device__ __forceinline__ unsigned a_off(const Unit&, int, int, int, int) const { return 0u; }
    const char* H8; const char* WIN8; int G, c;
    __device__ __forceinline__ bool next(int i, Unit& u) const {
        const long L = (long)i * G + c; if (L >= 64 * 23) return false;
        pg8::static_map(L, 64, 23, u.pm, u.pn); u.tag = 0; u.pa = H8 + (size_t)u.pm * (256 * 1024); u.pb = WIN8 + (size_t)u.pn * (256 * 1024); return true;
    }
};
struct SchedZ {
    static constexpr bool GATHER = false; __device__ __forceinline__ unsigned a_off(const Unit&, int, int, int, int) const { return 0u; }
    const char* H; const char* WinT; const char* HM; const char* WmkvT; int G, c;
    __device__ __forceinline__ bool next(int i, Unit& u) const {
        const long L = (long)i * G + c; if (L >= 480) return false;
        const size_t tstep = (size_t)256 * 1024 * 2;
        if (L < 448) { pg8::static_map(L, 64, 7, u.pm, u.pn); u.tag = 0; u.pa = H + (size_t)u.pm * tstep; u.pb = WinT + (size_t)u.pn * tstep; }
        else { const int q = (int)(L - 448); u.pm = q >> 2; u.pn = 32 + (q & 3); u.tag = 0; u.pa = HM + (size_t)u.pm * tstep; u.pb = WmkvT + (size_t)(q & 3) * tstep; }
        return true;
    }
};
struct EpiLora {
    static constexpr bool PERM = false, MID = false;
    float* L; const float* w0; const float* a0;
    __device__ __forceinline__ void operator()(const f32x4 (&acc)[2][2][4][2], const Unit& u, int wr, int wc, int fr, int fq) const {
        const int row0 = u.pm * 256 + wr * 64 + fr, col0 = u.pn * 256 + wc * 32 + 4 * fq; const int kind = u.pn >> 1; const f32x4 zb = zero4f();
#pragma unroll
        for (int bj = 0; bj < 2; ++bj)
#pragma unroll
            for (int n = 0; n < 2; ++n) { const int c = col0 + bj * 128 + n * 16;
                f32x4 bv = zb;
                if (kind == 0) bv = *(const f32x4*)(w0 + c); else if (kind == 1) bv = *(const f32x4*)(a0 + (c - 512));
#pragma unroll
                for (int ai = 0; ai < 2; ++ai)
#pragma unroll
                    for (int m = 0; m < 4; ++m) { f32x4 v = acc[ai][bj][m][n] + bv;
                        if (kind == 0) {
#pragma unroll
                            for (int j = 0; j < 4; ++j) v[j] = -0.60653066f * sigmoidf_(v[j]); }
                        else if (kind == 1) {
#pragma unroll
                            for (int j = 0; j < 4; ++j) v[j] = sigmoidf_(v[j]); }
                        const size_t row = (size_t)(row0 + ai * 128 + m * 16);
                        if (kind == 0) *(f32x4*)(L + row * 512 + c) = v;
                        else { u32x2 w; w.x = cvt_pk_bf16(v[0], v[1]); w.y = cvt_pk_bf16(v[2], v[3]); *(u32x2*)((bf16_t*)(L + (size_t)NTOK * 512) + row * 1024 + (c - 512)) = w; } } }
    }
};
template <int mode> struct EpiMix {
    static constexpr bool PERM = false, MID = false;
    float* mix32; bf16_t* mixbf; const bf16_t* Z;
    __device__ __forceinline__ void operator()(const f32x4 (&acc)[2][2][4][2], const Unit& u, int wr, int wc, int fr, int fq) const {
        const int row0 = u.pm * 256 + wr * 64 + fr, col0 = u.pn * 256 + wc * 32 + 4 * fq;
#pragma unroll
        for (int ai = 0; ai < 2; ++ai)
#pragma unroll
            for (int m = 0; m < 4; ++m) { const size_t row = (size_t)(row0 + ai * 128 + m * 16);
#pragma unroll
                for (int bj = 0; bj < 2; ++bj)
#pragma unroll
                    for (int n = 0; n < 2; ++n) { const int c = col0 + bj * 128 + n * 16;
                        const u32x2 gz = *(const u32x2*)(Z + row * INC + C_GATE + mode * 1024 + c); float g[4]; unpack4(gz, g);
                        f32x4 v = acc[ai][bj][m][n]; v[0] *= g[0]; v[1] *= g[1]; v[2] *= g[2]; v[3] *= g[3];
                        if (mode > 0) v += *(const f32x4*)(mix32 + row * 1024 + c);
                        if (mode < 2) *(f32x4*)(mix32 + row * 1024 + c) = v;
                        else { u32x2 w; w.x = cvt_pk_bf16(v[0], v[1]); w.y = cvt_pk_bf16(v[2], v[3]); *(u32x2*)(mixbf + row * 1024 + c) = w; } }
                asm volatile("" ::: "memory"); }
    }
};
struct EpiMixCat {
    static constexpr bool PERM = true, MID = true;
    bf16_t* mixbf; const bf16_t* GF; int tid;
    __device__ __forceinline__ const bf16_t* gtile(const Unit& u, int b) const { return GF + ((size_t)(u.pm * 12 + 4 * b + u.pn) * 16) * 4096 + (size_t)tid * 8; }
    __device__ __forceinline__ void mid(f32x4 (&acc)[2][2][4][2], const Unit& u, int t, int wr, int wc, int fr, int fq) const {
        const int ga = (t == 8) ? 0 : 1; int off = 0; asm volatile("" : "+v"(off));
        const bf16_t* pa = gtile(u, ga) + off; const bf16_t* pb = gtile(u, ga + 1) + off;
#pragma unroll
        for (int ai = 0; ai < 2; ++ai) {
#pragma unroll
            for (int m = 0; m < 4; ++m)
#pragma unroll
                for (int bj = 0; bj < 2; ++bj) { float a[8], b[8]; unpack8(*(const u32x4*)(pa + (size_t)((ai * 4 + m) * 2 + bj) * 4096), a); unpack8(*(const u32x4*)(pb + (size_t)((ai * 4 + m) * 2 + bj) * 4096), b);
#pragma unroll
                    for (int j = 0; j < 4; ++j) { acc[ai][bj][m][0][j] *= a[j] * __builtin_amdgcn_rcpf(b[j]); acc[ai][bj][m][1][j] *= a[4 + j] * __builtin_amdgcn_rcpf(b[4 + j]); } }
            asm volatile("" ::: "memory"); }
    }
    __device__ __forceinline__ void operator()(const f32x4 (&acc)[2][2][4][2], const Unit& u, int wr, int wc, int fr, int fq) const {
        const int row0 = u.pm * 256 + wr * 64 + fr, col0 = u.pn * 256 + wc * 32 + 8 * fq; const bf16_t* pg = gtile(u, 2);
#pragma unroll
        for (int ai = 0; ai < 2; ++ai)
#pragma unroll
            for (int m = 0; m < 4; ++m) { bf16_t* rowp = mixbf + (size_t)(row0 + ai * 128 + m * 16) * 1024 + col0;
#pragma unroll
                for (int bj = 0; bj < 2; ++bj) { float g[8]; unpack8(*(const u32x4*)(pg + (size_t)((ai * 4 + m) * 2 + bj) * 4096), g);
                    const f32x4 v0 = acc[ai][bj][m][0], v1 = acc[ai][bj][m][1];
                    u32x4 w; w.x = cvt_pk_bf16(v0[0] * g[0], v0[1] * g[1]); w.y = cvt_pk_bf16(v0[2] * g[2], v0[3] * g[3]); w.z = cvt_pk_bf16(v1[0] * g[4], v1[1] * g[5]); w.w = cvt_pk_bf16(v1[2] * g[6], v1[3] * g[7]);
                    *(u32x4*)(rowp + bj * 128) = w; } }
    }
};
struct EpiX1 {
    static constexpr bool PERM = true, MID = false;
    const float* x; bf16_t* x1;
    __device__ __forceinline__ void operator()(const f32x4 (&acc)[2][2][4][2], const Unit& u, int wr, int wc, int fr, int fq) const {
        const int row0 = u.pm * 256 + wr * 64 + fr, col0 = u.pn * 256 + wc * 32 + 8 * fq;
#pragma unroll
        for (int ai = 0; ai < 2; ++ai)
#pragma unroll
            for (int m = 0; m < 4; ++m) { const size_t off = (size_t)(row0 + ai * 128 + m * 16) * 1024 + col0;
#pragma unroll
                for (int bj = 0; bj < 2; ++bj) { const f32x4 a = __builtin_nontemporal_load((const f32x4*)(x + off + bj * 128)) + acc[ai][bj][m][0], b = __builtin_nontemporal_load((const f32x4*)(x + off + bj * 128 + 4)) + acc[ai][bj][m][1];
                    u32x4 w; w.x = cvt_pk_bf16(a[0], a[1]); w.y = cvt_pk_bf16(a[2], a[3]); w.z = cvt_pk_bf16(b[0], b[1]); w.w = cvt_pk_bf16(b[2], b[3]);
                    *(u32x4*)(x1 + off + bj * 128) = w; }
                if (m & 1) asm volatile("" ::: "memory"); }
    }
};
struct EpiSwiglu {
    static constexpr bool PERM = true, MID = false;
    static constexpr bool PRE = true;
    unsigned char* act; const float* b1; LAS unsigned char* lds;
    __device__ __forceinline__ void pre(const Unit& u, int wid, int wc, int lane) const {
        __builtin_amdgcn_global_load_lds((const unsigned*)(b1 + (size_t)u.tag * 2048 + 256 * u.pn + 64 * wc + lane), (LAS unsigned*)(lds + 131072 + u.aux * 2048 + wid * 256), 4, 0, 0); }
    __device__ __forceinline__ void operator()(const f32x4 (&acc)[2][2][4][2], const Unit& u, int wr, int wc, int fr, int fq) const {
        const int row0 = u.pm * 256 + wr * 64 + fr; const LAS float* be = (const LAS float*)(lds + 131072 + u.aux * 2048 + (wr * 4 + wc) * 256) + 16 * fq; const int j = 128 * u.pn + 32 * wc + 8 * fq;
        constexpr float CS = -1.702f * 1.44269504f, ICS = 1.0f / CS;
        float bg[8], bl[8];
#pragma unroll
        for (int q = 0; q < 4; ++q) { const f32x4 t = *(const LAS f32x4*)(be + 4 * q); bg[2 * q] = t[0] * CS; bl[2 * q] = (4.0f * t[1] + 4.0f) * ICS; bg[2 * q + 1] = t[2] * CS; bl[2 * q + 1] = (4.0f * t[3] + 4.0f) * ICS; }
#pragma unroll
        for (int ai = 0; ai < 2; ++ai)
#pragma unroll
            for (int m = 0; m < 4; ++m) { float o[8];
#pragma unroll
                for (int n = 0; n < 2; ++n)
#pragma unroll
                    for (int i = 0; i < 4; ++i) { const float sg = fmaxf(fmaf(acc[ai][0][m][n][i], CS / 256.0f, bg[4 * n + i]), 7.0f * CS);
                        const float ql = __builtin_amdgcn_fmed3f(fmaf(acc[ai][1][m][n][i], 4.0f * ICS / 256.0f, bl[4 * n + i]), -24.0f * ICS, 32.0f * ICS);
                        o[4 * n + i] = sg * __builtin_amdgcn_rcpf(1.0f + __builtin_amdgcn_exp2f(sg)) * ql; }
                u32x2 w; w.x = pack4_fp8(o[0], o[1], o[2], o[3]); w.y = pack4_fp8(o[4], o[5], o[6], o[7]);
                *(u32x2*)(act + (size_t)(row0 + ai * 128 + m * 16) * 1024 + j) = w; }
    }
};
struct EpiYs {
    static constexpr bool PERM = true, MID = false;
    static constexpr bool PRE = true;
    bf16_t* ys; const float* b2; LAS unsigned char* lds;
    __device__ __forceinline__ void pre(const Unit& u, int wid, int wc, int lane) const {
        __builtin_amdgcn_global_load_lds((const unsigned*)(b2 + (size_t)u.tag * 1024 + 256 * u.pn + (lane >> 5) * 128 + 32 * wc + (lane & 31)), (LAS unsigned*)(lds + 131072 + u.aux * 2048 + wid * 256), 4, 0, 0); }
    __device__ __forceinline__ void operator()(const f32x4 (&acc)[2][2][4][2], const Unit& u, int wr, int wc, int fr, int fq) const {
        const int row0 = u.pm * 256 + wr * 64 + fr, col0 = u.pn * 256 + wc * 32 + 8 * fq; const LAS float* be = (const LAS float*)(lds + 131072 + u.aux * 2048 + (wr * 4 + wc) * 256) + 8 * fq;
#pragma unroll
        for (int bj = 0; bj < 2; ++bj) { const f32x4 c0 = *(const LAS f32x4*)(be + bj * 32), c1 = *(const LAS f32x4*)(be + bj * 32 + 4);
#pragma unroll
            for (int ai = 0; ai < 2; ++ai)
#pragma unroll
                for (int m = 0; m < 4; ++m) { const f32x4 v0 = acc[ai][bj][m][0] * (1.0f / 128.0f) + c0, v1 = acc[ai][bj][m][1] * (1.0f / 128.0f) + c1;
                    u32x4 w; w.x = cvt_pk_bf16(v0[0], v0[1]); w.y = cvt_pk_bf16(v0[2], v0[3]); w.z = cvt_pk_bf16(v1[0], v1[1]); w.w = cvt_pk_bf16(v1[2], v1[3]);
                    *(u32x4*)(ys + (size_t)(row0 + ai * 128 + m * 16) * 1024 + col0 + bj * 128) = w; } }
    }
};
template <bool GATHER_> struct SchedMoe {
    static constexpr bool GATHER = GATHER_;
    const char* A; const char* Bt; const LAS int* tstart; const int* stok; int lgN, total; size_t estride, tbytes;
    __device__ __forceinline__ bool next(int i, Unit& u) const {
        const int c = blockIdx.x; const int un = i * 256 + (c & 7) * 32 + (c >> 3); if (un >= total) return false;
        const int mt = un >> lgN, pn = un & ((1 << lgN) - 1); const int e = ((const LAS unsigned char*)tstart)[(LX_TEXP - LX_TSTART) + mt];
        u.pm = mt; u.pn = pn; u.tag = e; u.pa = GATHER ? A : A + (size_t)mt * tbytes; u.pb = Bt + (size_t)e * estride + (size_t)pn * tbytes; return true;
    }
    __device__ __forceinline__ unsigned a_off(const Unit& u, int h, int R, int C, int rowbytes) const { const int e = u.tag, ps = u.pm * 256 + h * 128 + R - tstart[(LX_SBASE - LX_TSTART) / 4 + e];
        const int tok = ps < tstart[(LX_CNT - LX_TSTART) / 4 + e] ? stok[(size_t)e * NTOK + ps] : 0; return (unsigned)(tok * rowbytes + C * 2); }
};

__device__ __forceinline__ int w1perm(int c) { const int j = c >> 1, s = c & 1; return ((j >> 7) << 8) | (s << 7) | (j & 127); }
constexpr int NTILE = 13664, TAIL1_A = 6, TAIL1_B = 20, TAIL6 = 8, NRES1 = 32 * TAIL1_A + 32 * TAIL1_B, NRES = NRES1 + 128 * TAIL6;
template <class F> __device__ __forceinline__ void prep_tiles(const int wv, LAS unsigned char* lds, const int cnt, F tile_of) {
    KParams& p = *kparams();
    const int tid = opaque_tid(wv); unsigned char* ws = p.ws;
    LAS float* tile = (LAS float*)lds;
    if (cnt <= 0) return;
    struct TileJob { const float* src; bf16_t* dst; unsigned char* dst8; int K, N, perm, f8, ldd, k0, n0; };
    auto decode = [&](int t) -> TileJob { TileJob j; j.dst = nullptr; j.dst8 = nullptr; j.f8 = 0; j.perm = 0; j.ldd = 0; int lt;
        if (t < 960) { j.src = p.in[3]; j.dst = (bf16_t*)(ws + OFF_WINT); j.K = 1024; j.N = 7680; lt = t; if ((lt % 120) >= 28) { j.f8 = 1; j.dst8 = ws + OFF_WIN8 - (size_t)1792 * 1024; } }
        else if (t < 1088) { j.src = p.in[18]; j.dst = (bf16_t*)(ws + OFF_WMKVT); j.K = 1024; j.N = 1024; lt = t - 960; }
        else if (t < 1152) { j.src = p.in[21]; j.dst = (bf16_t*)(ws + OFF_PCAT); j.K = 512; j.N = 1024; lt = t - 1088; j.ldd = 1280; }
        else if (t < 1184) { j.src = p.in[22]; j.dst = (bf16_t*)(ws + OFF_PCAT) + 512; j.K = 256; j.N = 1024; lt = t - 1152; j.ldd = 1280; }
        else if (t < 1248) { j.src = p.in[23]; j.dst = (bf16_t*)(ws + OFF_PCAT) + 768; j.K = 512; j.N = 1024; lt = t - 1184; j.ldd = 1280; }
        else if (t < 1376) { j.src = p.in[24]; j.dst = (bf16_t*)(ws + OFF_WOT); j.K = 1024; j.N = 1024; lt = t - 1248; }
        else if (t < 9568) { const int q = t - 1376, e = q >> 8; j.src = p.in[28] + (size_t)e * 1024 * 2048; j.dst8 = ws + OFF_W1T + (size_t)e * 2048 * 1024; j.K = 1024; j.N = 2048; j.perm = 1; lt = q & 255; j.f8 = 1; }
        else { const int q = t - 9568, e = q >> 7; j.src = p.in[30] + (size_t)e * 1024 * 1024; j.dst8 = ws + OFF_W2T + (size_t)e * 1024 * 1024; j.K = 1024; j.N = 1024; lt = q & 127; j.f8 = 1; }
        const int tn = j.N >> 6; j.k0 = (lt / tn) * 128; j.n0 = (lt % tn) * 64; return j; };
    { auto ldtile = [&](const TileJob& j, f32x4 (&v)[4]) {
#pragma unroll
          for (int i = 0; i < 4; ++i) { const int idx = tid + 512 * i, row = idx >> 4, c4 = idx & 15; v[i] = __builtin_nontemporal_load((const f32x4*)(j.src + (size_t)(j.k0 + row) * j.N + j.n0 + 4 * c4)); } };
      TileJob j0 = decode(tile_of(0)), j1 = decode(tile_of(cnt > 1 ? 1 : 0)); f32x4 v0[4], v1[4];
      ldtile(j0, v0);
      if (cnt > 1) ldtile(j1, v1);
      for (int n = 0; n < cnt; ++n) {
#pragma unroll
          for (int i = 0; i < 4; ++i) { const int idx = tid + 512 * i, row = idx >> 4, c4 = idx & 15; LAS float* tp = tile + row * 65 + 4 * c4; tp[0] = v0[i][0]; tp[1] = v0[i][1]; tp[2] = v0[i][2]; tp[3] = v0[i][3]; }
          __syncthreads();
          const TileJob cur = j0; j0 = j1;
#pragma unroll
          for (int i = 0; i < 4; ++i) v0[i] = v1[i];
          if (n + 2 < cnt) { j1 = decode(tile_of(n + 2)); ldtile(j1, v1); }
          if (!cur.f8) {
#pragma unroll
              for (int i = 0; i < 2; ++i) { const int kc = (tid & 3) | (((tid >> 8) & 1) << 2) | (i << 3), n = (tid >> 2) & 63; float f[8];
#pragma unroll
                  for (int j = 0; j < 8; ++j) f[j] = tile[(kc * 8 + j) * 65 + n];
                  const int drow = cur.n0 + n;
                  *(u32x4*)(cur.dst + (size_t)drow * (cur.ldd ? cur.ldd : cur.K) + cur.k0 + kc * 8) = pack8(f); }
          } else {
              const int kc = (tid & 3) | (((tid >> 8) & 1) << 2), n = (tid >> 2) & 63; float f[16];
#pragma unroll
              for (int j = 0; j < 16; ++j) f[j] = tile[(kc * 16 + j) * 65 + n] * 32.0f;
              const int drow = cur.perm ? w1perm(cur.n0 + n) : (cur.n0 + n);
              u32x4 w; w.x = pack4_fp8(f[0], f[1], f[2], f[3]); w.y = pack4_fp8(f[4], f[5], f[6], f[7]); w.z = pack4_fp8(f[8], f[9], f[10], f[11]); w.w = pack4_fp8(f[12], f[13], f[14], f[15]);
              *(u32x4*)(cur.dst8 + (size_t)drow * cur.K + cur.k0 + kc * 16) = w; }
          __syncthreads(); } }
}
__device__ __forceinline__ void phase_prep(const int wv, LAS unsigned char* lds) {
    KParams& p = *kparams();
    const int tid = opaque_tid(wv); unsigned char* ws = p.ws;
    { const int G = (int)gridDim.x, top = NTILE - NRES - 1 - (int)blockIdx.x; prep_tiles(wv, lds, top >= 0 ? top / G + 1 : 0, [&](int n) { return top - n * G; }); }
    { const float* w2 = p.in[6]; const float* a2 = p.in[8]; const float* g2 = p.in[9]; bf16_t* lt = (bf16_t*)(ws + OFF_LORAT);
      for (int idx = blockIdx.x * 512 + tid; idx < 1536 * 32; idx += gridDim.x * 512) { const int n = idx >> 5, kc = idx & 31; float f[8];
#pragma unroll
          for (int j = 0; j < 8; ++j) { const int k = kc * 8 + j; float val = 0.f;
              if (n < 512) { if (k < 64) val = w2[k * 512 + n]; }
              else if (n < 1024) { if (k >= 64 && k < 128) val = a2[(k - 64) * 512 + (n - 512)]; }
              else { if (k >= 128) val = g2[(k - 128) * 512 + (n - 1024)]; }
              f[j] = val; }
          *(u32x4*)(lt + (size_t)n * 256 + kc * 8) = pack8(f); } }
    { const float* wr = p.in[26]; bf16_t* wt = (bf16_t*)(ws + OFF_WRT);
      for (int idx = blockIdx.x * 512 + tid; idx < 32 * 1024; idx += gridDim.x * 512) { const int e = idx >> 10, k = idx & 1023; const float v = wr[k * 32 + e];
          const unsigned hi = cvt_pk_bf16(v, 0.f) & 0xffffu; const float vh = __uint_as_float(hi << 16); const unsigned lo = cvt_pk_bf16(v - vh, 0.f) & 0xffffu;
          wt[idx] = (bf16_t)hi; wt[32768 + idx] = (bf16_t)lo; } }
    { const int wid = tid >> 6, lane = tid & 63; const int gw = blockIdx.x * 8 + wid, nw = gridDim.x * 8;
      for (int row0 = gw; row0 < NTOK + 2048; row0 += 3 * nw) {
          f32x4 v[3][4];
#pragma unroll
          for (int r3 = 0; r3 < 3; ++r3) { const int row = row0 + r3 * nw; if (row < NTOK + 2048) { const float* src = row >= NTOK ? p.in[1] + (size_t)(row - NTOK) * 1024 : p.in[0] + (size_t)row * 1024;
#pragma unroll
              for (int i = 0; i < 4; ++i) v[r3][i] = __builtin_nontemporal_load((const f32x4*)(src + 4 * lane + 256 * i)); } }
#pragma unroll
          for (int r3 = 0; r3 < 3; ++r3) { const int row = row0 + r3 * nw; if (row >= NTOK + 2048) break;
              const bool ism = row >= NTOK; const float* gain = ism ? p.in[17] : p.in[2]; bf16_t* dst = ism ? (bf16_t*)(ws + OFF_HM) + (size_t)(row - NTOK) * 1024 : (bf16_t*)(ws + OFF_H) + (size_t)row * 1024;
              float ss = 0.f;
#pragma unroll
              for (int i = 0; i < 4; ++i) ss += v[r3][i][0] * v[r3][i][0] + v[r3][i][1] * v[r3][i][1] + v[r3][i][2] * v[r3][i][2] + v[r3][i][3] * v[r3][i][3];
              ss = red64(ss); const float rs = rsqrtf(ss * (1.0f / 1024.0f) + 1e-5f);
#pragma unroll
              for (int i = 0; i < 4; ++i) { const f32x4 g = *(const f32x4*)(gain + 4 * lane + 256 * i); const f32x4 y = v[r3][i] * rs * g;
                  u32x2 w; w.x = cvt_pk_bf16(y[0], y[1]); w.y = cvt_pk_bf16(y[2], y[3]);
                  *(u32x2*)(dst + 4 * lane + 256 * i) = w;
                  if (!ism) *(unsigned*)(ws + OFF_H8 + (size_t)row * 1024 + 4 * lane + 256 * i) = pack4_fp8(y[0] * 8.0f, y[1] * 8.0f, y[2] * 8.0f, y[3] * 8.0f); } } }
    }
}

__device__ __forceinline__ void phase_elem_c(const int wv) {
    KParams& p = *kparams();
    const int gt = blockIdx.x * 512 + opaque_tid(wv), nthr = gridDim.x * 512; unsigned char* ws = p.ws;
    bf16_t* Z = (bf16_t*)(ws + OFF_Z); bf16_t* AL = (bf16_t*)(ws + OFF_ALORA); bf16_t* KV = (bf16_t*)(ws + OFF_KV);
    const float* mu = p.in[4];
    u32x4 za[4], zb[4]; const u32x4 zq0 = zero4u();
#pragma unroll
    for (int k = 0; k < 4; ++k) { const int idx = gt + k * nthr, t = idx >> 5, ch = idx & 31, col = C_ZW + 8 * ch;
        za[k] = *(const u32x4*)(Z + (size_t)t * INC + col);
        zb[k] = zq0; if ((t & (SEQ - 1)) != 0) zb[k] = *(const u32x4*)(Z + (size_t)(t - 1) * INC + col); }
#pragma unroll
    for (int k = 0; k < 4; ++k) { const int idx = gt + k * nthr, t = idx >> 5, ch = idx & 31, col = C_ZW + 8 * ch;
        float a[8], b[8]; unpack8(za[k], a); unpack8(zb[k], b);
        const f32x4 m0 = *(const f32x4*)(mu + col), m1 = *(const f32x4*)(mu + col + 4); const float mm[8] = {m0[0], m0[1], m0[2], m0[3], m1[0], m1[1], m1[2], m1[3]};
#pragma unroll
        for (int j = 0; j < 8; ++j) { float v = a[j] + (b[j] - a[j]) * mm[j]; if (ch < 8) v = tanhf(v); else if (ch >= 16) v = sigmoidf_(v); a[j] = v; }
        *(u32x4*)(AL + (size_t)t * 256 + 8 * ch) = pack8(a); }
}

__device__ __forceinline__ bf16x8 pack_frag(const f32x4 lo, const f32x4 hi) { u32x4 w; w.x = cvt_pk_bf16(lo[0], lo[1]); w.y = cvt_pk_bf16(lo[2], lo[3]); w.z = cvt_pk_bf16(hi[0], hi[1]); w.w = cvt_pk_bf16(hi[2], hi[3]); bf16x8 r; __builtin_memcpy(&r, &w, 16); return r; }
__device__ __forceinline__ bf16x8 tr2(LAS unsigned char* pa, LAS unsigned char* pb) { const s16x4 a = __builtin_amdgcn_ds_read_tr16_b64_v4i16((LAS s16x4*)pa), b = __builtin_amdgcn_ds_read_tr16_b64_v4i16((LAS s16x4*)pb); return __builtin_shufflevector(a, b, 0, 1, 2, 3, 4, 5, 6, 7); }
__device__ __forceinline__ bf16x8 rd2(LAS unsigned char* pa, LAS unsigned char* pb) { const s16x4 a = *(const LAS s16x4*)pa, b = *(const LAS s16x4*)pb; return __builtin_shufflevector(a, b, 0, 1, 2, 3, 4, 5, 6, 7); }
#define MFMA16(a, b, c) __builtin_amdgcn_mfma_f32_16x16x32_bf16((a), (b), (c), 0, 0, 0)
constexpr int CP_XA = 0, CP_XR = 4096, CP_XB = 8192, CP_XK = 12288, CP_VL = 16384, CP_NL = 16384, CP_WAVE = 20480;
__device__ __forceinline__ void phase_chunk_pre(const int wv, LAS unsigned char* lds) {
    KParams& p = *kparams();
    const int tid = opaque_tid(wv), wid = tid >> 6, lane = tid & 63, fr = lane & 15, fq = lane >> 4; unsigned char* ws = p.ws;
    if (tid == 0) { *(u32x4*)(ws + OFF_CTL + CTL_KEEP + blockIdx.x * 16) = *(const LAS u32x4*)(lds + LDS_X); asm volatile("s_waitcnt vmcnt(0)" ::: "memory"); }
    __syncthreads();
    LAS unsigned char* wl = lds + wid * CP_WAVE;
    const bf16_t* Z = (const bf16_t*)(ws + OFF_Z); bf16_t* C1 = (bf16_t*)(ws + OFF_C1); bf16_t* C2 = (bf16_t*)(ws + OFF_C2);
    const float* mu = p.in[4]; const float* k_k = p.in[10]; const float* k_a = p.in[11]; const float* r_k = p.in[12]; const float* ln_w = p.in[13]; const float* ln_b = p.in[14];
    const f32x4 z4 = zero4f();
    const bf16_t* LT = (const bf16_t*)(ws + OFF_LORAT); const float* w0v = p.in[5]; const float* a0v = p.in[7];
    for (int un = blockIdx.x; un < 512; un += gridDim.x) {
        const int b_ = un >> 6, cc = un & 63, h_ = wid; const int pr = ((b_ * 8 + h_) << 6) | cc; const int tok0 = b_ * SEQ + cc * 32;
        float gamC;
        int tidl = tid; asm volatile("" : "+v"(tidl));
        __syncthreads();
        { const int tl = tidl >> 4; const int t = tok0 + tl; u32x4 za[2], zb[2]; const u32x4 zq0 = zero4u();
#pragma unroll
          for (int g2 = 0; g2 < 2; ++g2) { const int col = C_ZW + 8 * ((tidl & 15) * 2 + g2); za[g2] = *(const u32x4*)(Z + (size_t)t * INC + col);
              zb[g2] = zq0; if ((t & (SEQ - 1)) != 0) zb[g2] = *(const u32x4*)(Z + (size_t)(t - 1) * INC + col); }
#pragma unroll
          for (int g2 = 0; g2 < 2; ++g2) { const int ch = (tidl & 15) * 2 + g2, col = C_ZW + 8 * ch; float a[8], b[8]; unpack8(za[g2], a); unpack8(zb[g2], b);
              const f32x4 m0 = *(const f32x4*)(mu + col), m1 = *(const f32x4*)(mu + col + 4); const float mm[8] = {m0[0], m0[1], m0[2], m0[3], m1[0], m1[1], m1[2], m1[3]};
#pragma unroll
              for (int j = 0; j < 8; ++j) { float v = a[j] + (b[j] - a[j]) * mm[j]; if (ch < 8) v = tanhf(v); else if (ch >= 16) v = sigmoidf_(v); a[j] = v; }
              *(LAS u32x4*)(lds + (tl >> 2) * CP_WAVE + CP_VL + (tl & 3) * 528 + ch * 16) = pack8(a); }
          __syncthreads(); }
        { const int fr = tidl & 15, fq = (tidl >> 4) & 3;
#pragma unroll
          for (int kind = 0; kind < 3; ++kind) { const int koff = kind == 0 ? 0 : (kind == 1 ? 64 : 128), nks = kind == 2 ? 4 : 2;
              f32x4 acc[4][2];
#pragma unroll
              for (int mt = 0; mt < 4; ++mt) { acc[mt][0] = z4; acc[mt][1] = z4; }
#pragma unroll
              for (int ks = 0; ks < nks; ++ks) { bf16x8 tf[2];
#pragma unroll
                  for (int nt = 0; nt < 2; ++nt) { const int tt = 16 * nt + fr; tf[nt] = *(const LAS bf16x8*)(lds + (tt >> 2) * CP_WAVE + CP_VL + (tt & 3) * 528 + (koff + 32 * ks + 8 * fq) * 2); }
#pragma unroll
                  for (int mt = 0; mt < 4; ++mt) { const bf16x8 wf = *(const bf16x8*)(LT + (size_t)(kind * 512 + h_ * 64 + 16 * mt + fr) * 256 + koff + 32 * ks + 8 * fq);
                      acc[mt][0] = MFMA16(tf[0], wf, acc[mt][0]); acc[mt][1] = MFMA16(tf[1], wf, acc[mt][1]); } }
#pragma unroll
              for (int mt = 0; mt < 4; ++mt) { const int ch = 16 * mt + fr; float bv = 0.f; if (kind == 0) bv = w0v[h_ * 64 + ch]; else if (kind == 1) bv = a0v[h_ * 64 + ch];
#pragma unroll
                  for (int nt = 0; nt < 2; ++nt) { f32x4 v = acc[mt][nt] + bv; LAS unsigned char* dst = wl + ch * 64 + (16 * nt + 4 * fq) * 2;
                      if (kind == 0) { float hf[4];
#pragma unroll
                          for (int j = 0; j < 4; ++j) v[j] = -0.60653066f * sigmoidf_(v[j]);
                          u32x2 hi; hi.x = cvt_pk_bf16(v[0], v[1]); hi.y = cvt_pk_bf16(v[2], v[3]);
                          hf[0] = v[0] - __uint_as_float(hi.x << 16); hf[1] = v[1] - __uint_as_float(hi.x & 0xffff0000u); hf[2] = v[2] - __uint_as_float(hi.y << 16); hf[3] = v[3] - __uint_as_float(hi.y & 0xffff0000u);
                          u32x2 lo; lo.x = cvt_pk_bf16(hf[0], hf[1]); lo.y = cvt_pk_bf16(hf[2], hf[3]);
                          *(LAS u32x2*)(dst + CP_XR) = hi; *(LAS u32x2*)(dst + CP_XB) = lo; }
                      else { if (kind == 1) {
#pragma unroll
                              for (int j = 0; j < 4; ++j) v[j] = sigmoidf_(v[j]); }
                          u32x2 w; w.x = cvt_pk_bf16(v[0], v[1]); w.y = cvt_pk_bf16(v[2], v[3]); *(LAS u32x2*)(dst + (kind == 1 ? CP_XK : CP_XA)) = w; } } } }
          asm volatile("s_waitcnt lgkmcnt(0)" ::: "memory");
          __syncthreads(); }
        { const int c = h_ * 64 + lane;
          const bf16_t* zp = Z + (size_t)tok0 * INC + c;
          const float mur = mu[c], muk = mu[C_K + c], muv = mu[C_V + c], kk_ = k_k[c], ka_ = k_a[c], rk_ = r_k[c], lnw = ln_w[c], lnb = ln_b[c];
          float pzr = 0.f, pzk = 0.f, pzv = 0.f;
          if (cc != 0) { pzr = __uint_as_float((unsigned)zp[-INC] << 16); pzk = __uint_as_float((unsigned)zp[-INC + C_K] << 16); pzv = __uint_as_float((unsigned)zp[-INC + C_V] << 16); }
          unsigned short zq[2][4][3]; u32x2 sq[2][4];
#pragma unroll
          for (int e = 0; e < 4; ++e) {
#pragma unroll
              for (int q = 0; q < 3; ++q) zq[0][e][q] = zp[(size_t)e * INC + q * 512]; }
#pragma unroll
          for (int r = 0; r < 4; ++r) sq[0][r] = *(const LAS u32x2*)(wl + r * 4096 + lane * 64);
          __builtin_amdgcn_sched_barrier(0);
          float cs = 0.f, g = 1.0f;
#pragma unroll
          for (int t4 = 0; t4 < 8; ++t4) { unsigned pa[2], pr_[2], pb[2], pk[2];
              if (t4 < 7) {
#pragma unroll
                  for (int e = 0; e < 4; ++e) {
#pragma unroll
                      for (int q = 0; q < 3; ++q) zq[(t4 + 1) & 1][e][q] = zp[(size_t)((t4 + 1) * 4 + e) * INC + q * 512]; }
#pragma unroll
                  for (int r = 0; r < 4; ++r) sq[(t4 + 1) & 1][r] = *(const LAS u32x2*)(wl + r * 4096 + lane * 64 + (t4 + 1) * 8); }
              __builtin_amdgcn_sched_barrier(0);
#pragma unroll
              for (int tp = 0; tp < 2; ++tp) { float va[2], vr[2], vb[2], vk[2];
#pragma unroll
                  for (int e = 0; e < 2; ++e) { const int te = tp * 2 + e, t = t4 * 4 + te;
                      const float zr = __uint_as_float((unsigned)zq[t4 & 1][te][0] << 16), zk = __uint_as_float((unsigned)zq[t4 & 1][te][1] << 16), zv = __uint_as_float((unsigned)zq[t4 & 1][te][2] << 16);
                      const float r = zr + (pzr - zr) * mur, k = zk + (pzk - zk) * muk, v = zv + (pzv - zv) * muv; pzr = zr; pzk = zk; pzv = zv;
                      const unsigned wg = sq[t4 & 1][0][te >> 1], wh = sq[t4 & 1][1][te >> 1], wlo = sq[t4 & 1][2][te >> 1], wa = sq[t4 & 1][3][te >> 1];
                      const float lw = __uint_as_float((te & 1) ? (wh & 0xffff0000u) : (wh << 16)) + __uint_as_float((te & 1) ? (wlo & 0xffff0000u) : (wlo << 16));
                      const float al = __uint_as_float((te & 1) ? (wa & 0xffff0000u) : (wa << 16)), gg = __uint_as_float((te & 1) ? (wg & 0xffff0000u) : (wg << 16));
                      const float kk = k * kk_, kp = k * (1.0f + (al - 1.0f) * ka_);
                      const float n2 = red64(kk * kk), bon = red64(r * kp * rk_);
                      const float kn = kk * __builtin_amdgcn_rsqf(fmaxf(n2, 1e-24f));
                      const float gm1 = g; cs += lw; g = __builtin_amdgcn_exp2f(cs * 1.44269504f); const float gi = __builtin_amdgcn_rcpf(g);
                      va[e] = -kn * gm1; vb[e] = kn * al * gi; vk[e] = kp * gi; vr[e] = r * g;
                      *(LAS bf16_t*)(wl + CP_VL + t * 128 + lane * 2) = (bf16_t)(cvt_pk_bf16(v, 0.f) & 0xffffu);
                      const size_t to = (size_t)(tok0 + t) * 512 + c;
                      C1[to] = (bf16_t)(cvt_pk_bf16(lnw * gg, 0.f) & 0xffffu); C2[to] = (bf16_t)(cvt_pk_bf16((lnb + bon * v) * gg, 0.f) & 0xffffu); }
                  pa[tp] = cvt_pk_bf16(va[0], va[1]); pr_[tp] = cvt_pk_bf16(vr[0], vr[1]); pb[tp] = cvt_pk_bf16(vb[0], vb[1]); pk[tp] = cvt_pk_bf16(vk[0], vk[1]); }
              *(LAS u32x2*)(wl + CP_XA + lane * 64 + t4 * 8) = (u32x2){pa[0], pa[1]}; *(LAS u32x2*)(wl + CP_XR + lane * 64 + t4 * 8) = (u32x2){pr_[0], pr_[1]};
              *(LAS u32x2*)(wl + CP_XB + lane * 64 + t4 * 8) = (u32x2){pb[0], pb[1]}; *(LAS u32x2*)(wl + CP_XK + lane * 64 + t4 * 8) = (u32x2){pk[0], pk[1]};
              __builtin_amdgcn_sched_barrier(0); }
          gamC = g; }
        asm volatile("s_waitcnt lgkmcnt(0)" ::: "memory");
        bf16x8 Vf[4];
        { const int vtb = (4 * fq + (fr >> 2)) * 128 + (fr & 3) * 8;
#pragma unroll
          for (int nv = 0; nv < 4; ++nv) { LAS unsigned char* pp = wl + CP_VL + vtb + nv * 32; Vf[nv] = tr2(pp, pp + 2048); } }
        asm volatile("s_waitcnt lgkmcnt(0)" ::: "memory");
        const int trb = (8 * fq + (fr >> 2)) * 64 + (fr & 3) * 8;
        bf16x8 LakF[2], QrbF[2], QrkF[2];
#pragma unroll
        for (int yi = 0; yi < 2; ++yi) {
            bf16x8 fy[2][2];
#pragma unroll
            for (int nt = 0; nt < 2; ++nt)
#pragma unroll
                for (int s2 = 0; s2 < 2; ++s2) { LAS unsigned char* pp = wl + (yi ? CP_XR : CP_XA) + trb + s2 * 2048 + nt * 32; fy[nt][s2] = tr2(pp, pp + 256); }
#pragma unroll
            for (int xi = 0; xi < 2; ++xi) {
                f32x4 d[2][2];
#pragma unroll
                for (int mi = 0; mi < 2; ++mi) { bf16x8 fx[2];
#pragma unroll
                    for (int s2 = 0; s2 < 2; ++s2) { LAS unsigned char* pp = wl + (xi ? CP_XK : CP_XB) + trb + s2 * 2048 + mi * 32; fx[s2] = tr2(pp, pp + 256); }
#pragma unroll
                    for (int nt = 0; nt < 2; ++nt) {
                        if (mi == 1 && nt == 0) { d[mi][nt] = z4; continue; }
                        f32x4 acc = MFMA16(fx[0], fy[nt][0], z4); acc = MFMA16(fx[1], fy[nt][1], acc);
#pragma unroll
                        for (int j = 0; j < 4; ++j) { const int i = 16 * mi + 4 * fq + j, t = 16 * nt + fr; const bool ok = yi ? (i <= t) : (i < t); acc[j] = ok ? acc[j] : 0.f; }
                        d[mi][nt] = acc; } }
                if (yi == 0 && xi == 0) {
#pragma unroll
                    for (int mi = 0; mi < 2; ++mi)
#pragma unroll
                        for (int nt = 0; nt < 2; ++nt)
#pragma unroll
                            for (int j = 0; j < 4; ++j) *(LAS float*)(wl + CP_NL + ((16 * nt + fr) * 32 + 16 * mi + 4 * fq + j) * 4) = d[mi][nt][j];
                } else {
#pragma unroll
                    for (int nt = 0; nt < 2; ++nt) { const bf16x8 f = pack_frag(d[0][nt], d[1][nt]); if (yi == 0) LakF[nt] = f; else if (xi == 0) QrbF[nt] = f; else QrkF[nt] = f; } } } }
        asm volatile("s_waitcnt lgkmcnt(0)" ::: "memory");
        bf16x8 InvF[2];
        { const int c = lane & 31; float X[32];
#pragma unroll
          for (int t = 0; t < 32; ++t) { float a0 = (t == c) ? 1.0f : 0.f, a1 = 0.f;
#pragma unroll
              for (int i4 = 0; i4 < (t + 3) / 4; ++i4) { const f32x4 nv = *(const LAS f32x4*)(wl + CP_NL + (t * 32 + 4 * i4) * 4);
#pragma unroll
                  for (int e = 0; e < 4; ++e) if (4 * i4 + e < t) { if (e & 1) a1 = fmaf(nv[e], X[4 * i4 + e], a1); else a0 = fmaf(nv[e], X[4 * i4 + e], a0); } }
              X[t] = a0 + a1; }
          asm volatile("s_waitcnt lgkmcnt(0)" ::: "memory");
#pragma unroll
          for (int t = 0; t < 32; ++t) *(LAS float*)(wl + CP_NL + (t * 32 + c) * 4) = X[t];
          asm volatile("s_waitcnt lgkmcnt(0)" ::: "memory");
#pragma unroll
          for (int n = 0; n < 2; ++n) { const f32x4 lo = *(const LAS f32x4*)(wl + CP_NL + ((16 * n + fr) * 32 + 4 * fq) * 4), hi = *(const LAS f32x4*)(wl + CP_NL + ((16 * n + fr) * 32 + 16 + 4 * fq) * 4); InvF[n] = pack_frag(lo, hi); } }
        bf16x8 UF[4], AhF[4];
#pragma unroll
        for (int nv = 0; nv < 4; ++nv) { const f32x4 w0 = MFMA16(LakF[0], Vf[nv], z4), w1 = MFMA16(LakF[1], Vf[nv], z4); const bf16x8 wf = pack_frag(w0, w1);
            const f32x4 u0 = MFMA16(InvF[0], wf, z4), u1 = MFMA16(InvF[1], wf, z4); UF[nv] = pack_frag(u0, u1); }
#pragma unroll
        for (int nc = 0; nc < 4; ++nc) { LAS unsigned char* pp = wl + CP_XA + (16 * nc + fr) * 64 + 8 * fq; const bf16x8 af = rd2(pp, pp + 32);
            const f32x4 h0 = MFMA16(InvF[0], af, z4), h1 = MFMA16(InvF[1], af, z4); AhF[nc] = pack_frag(h0, h1); }
        { f32x4 rt[4][2];
#pragma unroll
          for (int mc = 0; mc < 4; ++mc)
#pragma unroll
              for (int nt = 0; nt < 2; ++nt) { const s16x4 rr = __builtin_amdgcn_ds_read_tr16_b64_v4i16((LAS s16x4*)(wl + CP_XR + (16 * mc + 4 * fq + (fr >> 2)) * 64 + (fr & 3) * 8 + nt * 32));
                  f32x4 cin; cin[0] = __uint_as_float((unsigned)(unsigned short)rr[0] << 16); cin[1] = __uint_as_float((unsigned)(unsigned short)rr[1] << 16); cin[2] = __uint_as_float((unsigned)(unsigned short)rr[2] << 16); cin[3] = __uint_as_float((unsigned)(unsigned short)rr[3] << 16);
                  rt[mc][nt] = MFMA16(AhF[mc], QrbF[nt], cin); }
          bf16x8* RTF = (bf16x8*)(ws + OFF_RTF) + (size_t)pr * 256;
#pragma unroll
          for (int nt = 0; nt < 2; ++nt)
#pragma unroll
              for (int s2 = 0; s2 < 2; ++s2) RTF[(nt * 2 + s2) * 64 + lane] = pack_frag(rt[2 * s2][nt], rt[2 * s2 + 1][nt]); }
        { u32x2* YLF = (u32x2*)(ws + OFF_YLF) + (size_t)pr * 512;
#pragma unroll
          for (int nv = 0; nv < 4; ++nv)
#pragma unroll
              for (int mt = 0; mt < 2; ++mt) { f32x4 y = MFMA16(QrbF[mt], UF[nv], z4); y = MFMA16(QrkF[mt], Vf[nv], y);
                  u32x2 w; w.x = cvt_pk_bf16(y[0], y[1]); w.y = cvt_pk_bf16(y[2], y[3]); YLF[(nv * 2 + mt) * 64 + lane] = w; } }
        { bf16x8* GTF = (bf16x8*)(ws + OFF_GTF) + (size_t)pr * 512; u32x2* HHF = (u32x2*)(ws + OFF_HHF) + (size_t)pr * 1024;
#pragma unroll
          for (int nc = 0; nc < 4; ++nc) { LAS unsigned char* pp = wl + CP_XB + (16 * nc + fr) * 64 + 8 * fq; const bf16x8 bf_ = rd2(pp, pp + 32);
              LAS unsigned char* pk = wl + CP_XK + (16 * nc + fr) * 64 + 8 * fq; const bf16x8 kf_ = rd2(pk, pk + 32);
              const float gcol = __int_as_float(__builtin_amdgcn_ds_bpermute((16 * nc + fr) << 2, __float_as_int(gamC)));
              f32x4 gt[4];
#pragma unroll
              for (int mc = 0; mc < 4; ++mc) { f32x4 a = MFMA16(AhF[mc], bf_, z4);
#pragma unroll
                  for (int j = 0; j < 4; ++j) { if (mc == nc && 4 * fq + j == fr) a[j] += 1.0f; a[j] *= gcol; }
                  gt[mc] = a; }
              GTF[(nc * 2 + 0) * 64 + lane] = pack_frag(gt[0], gt[1]); GTF[(nc * 2 + 1) * 64 + lane] = pack_frag(gt[2], gt[3]);
              f32x4 grow;
#pragma unroll
              for (int j = 0; j < 4; ++j) grow[j] = __int_as_float(__builtin_amdgcn_ds_bpermute((16 * nc + 4 * fq + j) << 2, __float_as_int(gamC)));
#pragma unroll
              for (int nv = 0; nv < 4; ++nv) { f32x4 hh = MFMA16(bf_, UF[nv], z4); hh = MFMA16(kf_, Vf[nv], hh); hh = hh * grow;
                  u32x2 w; w.x = cvt_pk_bf16(hh[0], hh[1]); w.y = cvt_pk_bf16(hh[2], hh[3]); HHF[(nv * 4 + nc) * 64 + lane] = w; } } }
        asm volatile("s_waitcnt lgkmcnt(0)" ::: "memory");
    }
    __syncthreads();
    if (tid == 0) *(LAS u32x4*)(lds + LDS_X) = *(const u32x4*)(ws + OFF_CTL + CTL_KEEP + blockIdx.x * 16);
}
__device__ __forceinline__ void phase_scan_seq(const int wv, LAS unsigned char* lds) {
    KParams& p = *kparams();
    const int tid = opaque_tid(wv), wid = __builtin_amdgcn_readfirstlane(tid >> 6), lane = tid & 63, fr = lane & 15, fq = lane >> 4; unsigned char* ws = p.ws;
    if (blockIdx.x >= 64) return;
    const int bh = blockIdx.x, b = bh >> 3, h = bh & 7;
    const char* gG = (const char*)(ws + OFF_GTF) + (size_t)bh * 64 * 8192; const char* gR = (const char*)(ws + OFF_RTF) + (size_t)bh * 64 * 4096;
    const char* gH = (const char*)(ws + OFF_HHF) + (size_t)bh * 64 * 8192; const char* gY = (const char*)(ws + OFF_YLF) + (size_t)bh * 64 * 4096;
    constexpr int SLOT = 24576;
    if (wid >= 4) {
        const int w = wid - 4;
        auto issue = [&](int c) { LAS unsigned char* slot = lds + (c % 5) * SLOT;
#pragma unroll
            for (int i = 0; i < 6; ++i) { const int pc = w + 4 * i;
                const char* src = pc < 8 ? gG + (size_t)c * 8192 + pc * 1024 : pc < 12 ? gR + (size_t)c * 4096 + (pc - 8) * 1024 : pc < 20 ? gH + (size_t)c * 8192 + (pc - 12) * 1024 : gY + (size_t)c * 4096 + (pc - 20) * 1024;
                __builtin_amdgcn_global_load_lds((const unsigned*)(src + lane * 16), (LAS unsigned*)(slot + pc * 1024), 16, 0, 0); } };
        issue(0); issue(1); issue(2); issue(3);
        for (int c = 0; c < 64; ++c) {
            if (c < 60) asm volatile("s_waitcnt vmcnt(18)" ::: "memory"); else asm volatile("s_waitcnt vmcnt(0)" ::: "memory");
            __builtin_amdgcn_s_barrier();
            if (c + 4 < 64) issue(c + 4);
        }
        return; }
    const int nv = wid;
    float* Yraw = (float*)(ws + OFF_YRAW) + (size_t)b * SEQ * 512 + h * 64 + 16 * nv + fr;
    f32x4 T[4]; const f32x4 z4s = zero4f();
#pragma unroll
    for (int m = 0; m < 4; ++m) T[m] = z4s;
    for (int c = 0; c < 64; ++c) {
        __builtin_amdgcn_s_barrier();
        const LAS unsigned char* slot = lds + (c % 5) * SLOT + lane * 16;
        bf16x8 G[8], R[4]; u32x2 H[4], Y[2];
#pragma unroll
        for (int i = 0; i < 8; ++i) G[i] = *(const LAS bf16x8*)(slot + i * 1024);
#pragma unroll
        for (int i = 0; i < 4; ++i) R[i] = *(const LAS bf16x8*)(slot + 8192 + i * 1024);
#pragma unroll
        for (int i = 0; i < 4; ++i) H[i] = *(const LAS u32x2*)(lds + (c % 5) * SLOT + 12288 + (nv * 4 + i) * 512 + lane * 8);
#pragma unroll
        for (int i = 0; i < 2; ++i) Y[i] = *(const LAS u32x2*)(lds + (c % 5) * SLOT + 20480 + (nv * 2 + i) * 512 + lane * 8);
        const bf16x8 tf0 = pack_frag(T[0], T[1]), tf1 = pack_frag(T[2], T[3]);
#pragma unroll
        for (int nt = 0; nt < 2; ++nt) { f32x4 y; y[0] = bf_lo(Y[nt].x); y[1] = bf_hi(Y[nt].x); y[2] = bf_lo(Y[nt].y); y[3] = bf_hi(Y[nt].y);
            y = MFMA16(R[nt * 2], tf0, y); y = MFMA16(R[nt * 2 + 1], tf1, y);
#pragma unroll
            for (int j = 0; j < 4; ++j) Yraw[(size_t)(c * 32 + 16 * nt + 4 * fq + j) * 512] = y[j]; }
#pragma unroll
        for (int m = 0; m < 4; ++m) { f32x4 t; t[0] = bf_lo(H[m].x); t[1] = bf_hi(H[m].x); t[2] = bf_lo(H[m].y); t[3] = bf_hi(H[m].y);
            t = MFMA16(G[m * 2], tf0, t); t = MFMA16(G[m * 2 + 1], tf1, t); T[m] = t; }
        asm volatile("s_waitcnt lgkmcnt(0)" ::: "memory");
    }
}

__device__ __forceinline__ bf16x8 tr_pair(LAS unsigned char* pa, LAS unsigned char* pb, bool useB) {
    const s16x4 a = __builtin_amdgcn_ds_read_tr16_b64_v4i16((LAS s16x4*)pa);
    s16x4 b2 = (s16x4){0, 0, 0, 0};
    if (useB) b2 = __builtin_amdgcn_ds_read_tr16_b64_v4i16((LAS s16x4*)pb);
    return __builtin_shufflevector(a, b2, 0, 1, 2, 3, 4, 5, 6, 7);
}
__device__ __forceinline__ void phase_dil_attn(const int wv, LAS unsigned char* lds) {
    KParams& p = *kparams();
    const int tid = opaque_tid(wv), wid = tid >> 6, lane = tid & 63, fr = lane & 15, fq = lane >> 4; unsigned char* ws = p.ws;
    const bf16_t* Z = (const bf16_t*)(ws + OFF_Z); float* DILO = (float*)(ws + OFF_DILO); float* LSE = (float*)(ws + OFF_LSE);
    LAS unsigned char* kb = lds; LAS unsigned char* vb = lds + 32768; const float* qn = p.in[15]; const float* kn = p.in[16];
    float qkw[2][8];
#pragma unroll
    for (int ks = 0; ks < 2; ++ks)
#pragma unroll
        for (int j = 0; j < 8; ++j) qkw[ks][j] = qn[ks * 32 + 8 * fq + j] * kn[ks * 32 + 8 * fq + j];
    const bool seqwg = blockIdx.x < 64;
    const int ynd = ((int)blockIdx.x - 64) >> 3, ndil = ynd < 8 ? 5 : (ynd < 16 ? 8 : 7);
    const int u0 = seqwg ? 4 * (int)blockIdx.x : 256 + (int)blockIdx.x - 64, uend = seqwg ? 4 * (int)blockIdx.x + 4 : u0 + 192 * ndil, ustep = seqwg ? 1 : 192;
    auto umap = [&](int v) -> int { if (seqwg) return v; const int c2 = (int)blockIdx.x - 64, x = c2 & 7, y = c2 >> 3, i = (v - u0) / 192, k = i < 5 ? 24 * i + y : (y < 16 ? 120 + (y - 8) * 3 + (i - 5) : 144 + (y - 16) * 2 + (i - 5)); return 256 + (k >> 3) * 64 + 8 * x + (k & 7); };
    const int ki = tid >> 1, half = tid & 1;
    u32x4 kvA[4], vvA[4], qvA[2], kvB[4], vvB[4], qvB[2]; bool kvalidA = false, kvalidB = false;
    auto unit_load = [&](int uv, u32x4 (&kv)[4], u32x4 (&vv)[4], u32x4 (&qv)[2], bool& kvalid) { const int u = umap(uv);
        const int b = u / 192, rem = u % 192, hh = rem >> 4, qb = rem & 15, g = hh >> 2;
        const int dil = g == 0 ? 1 : (g == 1 ? 4 : 16), nbc = 16 / dil, r = qb / nbc, j0 = (qb % nbc) * 128;
        const bf16_t* Zb = Z + (size_t)b * SEQ * INC; const int kj = j0 - 128 + ki; kvalid = kj >= 0;
        { const bf16_t* rowp = Zb + (size_t)((kvalid ? kj : 0) * dil + r) * INC + hh * 64 + half * 32;
#pragma unroll
            for (int i = 0; i < 4; ++i) { kv[i] = *(const u32x4*)(rowp + C_DK + 8 * i); vv[i] = *(const u32x4*)(rowp + C_DV + 8 * i); } }
        const int tq = (j0 + 16 * wid + fr) * dil + r;
#pragma unroll
        for (int ks = 0; ks < 2; ++ks) qv[ks] = *(const u32x4*)(Zb + (size_t)tq * INC + C_DQ + hh * 64 + ks * 32 + 8 * fq); };
    auto do_unit = [&](const int uvv, u32x4 (&kv)[4], u32x4 (&vv)[4], u32x4 (&qv)[2], bool& kvalid) { const int u = umap(uvv); const int uv_ = uvv;
        const int b = u / 192, rem = u % 192, hh = rem >> 4, qb = rem & 15, g = hh >> 2, hg = hh & 3;
        const int dil = g == 0 ? 1 : (g == 1 ? 4 : 16), nbc = 16 / dil, r = qb / nbc, j0 = (qb % nbc) * 128;
        { if (kvalid) {
              float ss = sumsq8(kv[0]) + sumsq8(kv[1]) + sumsq8(kv[2]) + sumsq8(kv[3]); ss += dpp_f<0xB1>(ss);
              const float rs = rsqrtf(ss * (1.0f / 64.0f) + 1e-5f);
#pragma unroll
              for (int i = 0; i < 4; ++i) kv[i] = scale8s(kv[i], rs); }
          else { const u32x4 zu = zero4u();
#pragma unroll
              for (int i = 0; i < 4; ++i) { kv[i] = zu; vv[i] = zu; } }
#pragma unroll
          for (int i = 0; i < 4; ++i) { const int sw = (half * 4 + i) ^ (ki & 7); *(LAS u32x4*)(kb + ki * 128 + sw * 16) = kv[i]; *(LAS u32x4*)(vb + ki * 128 + sw * 16) = vv[i]; } }
        const int qi = 16 * wid + fr, tq = (j0 + qi) * dil + r;
        bf16x8 qf[2];
        { float ss = sumsq8(qv[0]) + sumsq8(qv[1]); ss += sxor(ss, 16); ss += sxor(ss, 32);
          const float rs = rsqrtf(ss * (1.0f / 64.0f) + 1e-5f) * 0.125f;
#pragma unroll
          for (int ks = 0; ks < 2; ++ks) { const u32x4 w = scale8r(qv[ks], rs, qkw[ks]); __builtin_memcpy(&qf[ks], &w, 16); } }
        __syncthreads();
        if (uv_ + 2 * ustep < uend) unit_load(uv_ + 2 * ustep, kv, vv, qv, kvalid);
        f32x4 st[9]; float mx = -1e30f; const f32x4 zq = zero4f();
        LAS unsigned char* kp0 = kb + (16 * wid + fr) * 128 + ((fq ^ (fr & 7)) << 4); LAS unsigned char* kp1 = kb + (16 * wid + fr) * 128 + (((4 + fq) ^ (fr & 7)) << 4);
#pragma unroll
        for (int ti = 0; ti < 9; ++ti) {
            const bf16x8 k0 = *(const LAS bf16x8*)(kp0 + ti * 2048), k1 = *(const LAS bf16x8*)(kp1 + ti * 2048);
            f32x4 s = __builtin_amdgcn_mfma_f32_16x16x32_bf16(k0, qf[0], zq, 0, 0, 0);
            s = __builtin_amdgcn_mfma_f32_16x16x32_bf16(k1, qf[1], s, 0, 0, 0);
#pragma unroll
            for (int j = 0; j < 4; ++j) { const int ki = 16 * (wid + ti) + 4 * fq + j, off = qi + 128 - ki; const bool ok = (off >= 0) && (off <= 128) && (j0 - 128 + ki >= 0);
                s[j] = ok ? s[j] : -1e30f; mx = fmaxf(mx, s[j]); }
            st[ti] = s; }
        mx = fmaxf(mx, sxor(mx, 16)); mx = fmaxf(mx, sxor(mx, 32));
        float den = 0.f;
#pragma unroll
        for (int ti = 0; ti < 9; ++ti)
#pragma unroll
            for (int j = 0; j < 4; ++j) { const float e = __builtin_amdgcn_exp2f((st[ti][j] - mx) * 1.44269504f); st[ti][j] = e; den += e; }
        den += sxor(den, 16); den += sxor(den, 32);
        f32x4 o[4];
#pragma unroll
        for (int dt = 0; dt < 4; ++dt) o[dt] = zq;
        const int q4 = fr >> 2, p4 = fr & 3; const int kl = 4 * fq + q4;
        LAS unsigned char* vp[4];
#pragma unroll
        for (int dt = 0; dt < 4; ++dt) vp[dt] = vb + (16 * wid + kl) * 128 + (((2 * dt + (p4 >> 1)) ^ (kl & 7)) << 4) + (p4 & 1) * 8;
#pragma unroll
        for (int pp = 0; pp < 5; ++pp) { const bool two = pp < 4; const int tA = 2 * pp, tB = two ? 2 * pp + 1 : 2 * pp;
            u32x4 pw; pw.x = cvt_pk_bf16(st[tA][0], st[tA][1]); pw.y = cvt_pk_bf16(st[tA][2], st[tA][3]);
            if (two) { pw.z = cvt_pk_bf16(st[tB][0], st[tB][1]); pw.w = cvt_pk_bf16(st[tB][2], st[tB][3]); } else { pw.z = 0u; pw.w = 0u; }
            bf16x8 pf; __builtin_memcpy(&pf, &pw, 16);
#pragma unroll
            for (int dt = 0; dt < 4; ++dt) { const bf16x8 vf = tr_pair(vp[dt] + tA * 2048, vp[dt] + tB * 2048, two);
                o[dt] = __builtin_amdgcn_mfma_f32_16x16x32_bf16(vf, pf, o[dt], 0, 0, 0); } }
        const float inv = __builtin_amdgcn_rcpf(den); const size_t ob = ((size_t)(g * NTOK + b * SEQ + tq) * 4 + hg);
#pragma unroll
        for (int dt = 0; dt < 4; ++dt) *(f32x4*)(DILO + ob * 64 + 16 * dt + 4 * fq) = o[dt] * inv;
        if (fq == 0) LSE[ob] = mx + __logf(den);
        __syncthreads();
    };
    if (u0 < uend) unit_load(u0, kvA, vvA, qvA, kvalidA);
    if (u0 + ustep < uend) unit_load(u0 + ustep, kvB, vvB, qvB, kvalidB);
    for (int u = u0; u < uend; u += 2 * ustep) {
        do_unit(u, kvA, vvA, qvA, kvalidA);
        if (u + ustep < uend) do_unit(u + ustep, kvB, vvB, qvB, kvalidB);
    }
}

__device__ __forceinline__ void phase_mem_attn(const int wv, LAS unsigned char* lds) {
    KParams& p = *kparams();
    const int tid = opaque_tid(wv), wid = tid >> 6, lane = tid & 63, fr = lane & 15, fq = lane >> 4; unsigned char* ws = p.ws;
    const bf16_t* Z = (const bf16_t*)(ws + OFF_Z); const bf16_t* KV = (const bf16_t*)(ws + OFF_KV); bf16_t* YM = (bf16_t*)(ws + OFF_YCAT) + 768;
    LAS unsigned char* kb = lds; LAS unsigned char* vb = lds + 65536; const float* mqn = p.in[19]; const float* mkn = p.in[20];
    if (blockIdx.x < 64) return;
    float mqk[4][8];
#pragma unroll
    for (int ks = 0; ks < 4; ++ks)
#pragma unroll
        for (int j = 0; j < 8; ++j) mqk[ks][j] = mqn[ks * 32 + 8 * fq + j] * mkn[ks * 32 + 8 * fq + j];
    for (int bhq = (int)blockIdx.x - 64; bhq < 256; bhq += (int)gridDim.x - 64) {
        const int bhm = bhq >> 3, b = bhm >> 2, hm = bhm & 3;
        { const int ki = tid >> 1, half = tid & 1; const bf16_t* rowp = KV + (size_t)(b * 256 + ki) * 1024 + hm * 128 + half * 64;
          u32x4 kv[8], vv[8];
#pragma unroll
          for (int i = 0; i < 8; ++i) { kv[i] = *(const u32x4*)(rowp + 8 * i); vv[i] = *(const u32x4*)(rowp + 512 + 8 * i); }
          { float ss = 0.f;
#pragma unroll
            for (int i = 0; i < 8; ++i) ss += sumsq8(kv[i]);
            ss += dpp_f<0xB1>(ss); const float rs = rsqrtf(ss * (1.0f / 128.0f) + 1e-5f);
#pragma unroll
            for (int i = 0; i < 8; ++i) kv[i] = scale8s(kv[i], rs); }
#pragma unroll
          for (int i = 0; i < 8; ++i) { const int sw = (half * 8 + i) ^ (ki & 15); *(LAS u32x4*)(kb + ki * 256 + sw * 16) = kv[i]; *(LAS u32x4*)(vb + ki * 256 + sw * 16) = vv[i]; } }
        __syncthreads();
        const int q4 = fr >> 2, p4 = fr & 3; const int kl = 4 * fq + q4;
        LAS unsigned char* kp[4]; LAS unsigned char* vp[8];
#pragma unroll
        for (int ks = 0; ks < 4; ++ks) kp[ks] = kb + fr * 256 + (((4 * ks + fq) ^ fr) << 4);
#pragma unroll
        for (int dt = 0; dt < 8; ++dt) vp[dt] = vb + kl * 256 + (((2 * dt + (p4 >> 1)) ^ kl) << 4) + (p4 & 1) * 8;
        for (int qq = 0; qq < 2; ++qq) { const int qblk = (bhq & 7) * 2 + qq; const int tq = b * SEQ + qblk * 128 + 16 * wid + fr;
            bf16x8 qf[4];
#pragma unroll
            for (int ks = 0; ks < 4; ++ks) qf[ks] = *(const bf16x8*)(Z + (size_t)tq * INC + C_MQ + hm * 128 + ks * 32 + 8 * fq);
            { u32x4 qv[4]; float ss = 0.f;
#pragma unroll
              for (int ks = 0; ks < 4; ++ks) { __builtin_memcpy(&qv[ks], &qf[ks], 16); ss += sumsq8(qv[ks]); }
              ss += sxor(ss, 16); ss += sxor(ss, 32); const float rs = rsqrtf(ss * (1.0f / 128.0f) + 1e-5f);
#pragma unroll
              for (int ks = 0; ks < 4; ++ks) { const u32x4 w = scale8r(qv[ks], rs, mqk[ks]); __builtin_memcpy(&qf[ks], &w, 16); } }
            f32x4 st[16]; float mx = -1e30f; const f32x4 zq = zero4f();
#pragma unroll
            for (int ti = 0; ti < 16; ++ti) { f32x4 s = zq;
#pragma unroll
                for (int ks = 0; ks < 4; ++ks) { const bf16x8 kf = *(const LAS bf16x8*)(kp[ks] + ti * 4096); s = __builtin_amdgcn_mfma_f32_16x16x32_bf16(kf, qf[ks], s, 0, 0, 0); }
#pragma unroll
                for (int j = 0; j < 4; ++j) mx = fmaxf(mx, s[j]);
                st[ti] = s; if (ti & 1) asm volatile("" ::: "memory"); }
            mx = fmaxf(mx, sxor(mx, 16)); mx = fmaxf(mx, sxor(mx, 32));
            const float sc = 0.08838834764831845f * 1.44269504f; float den = 0.f;
#pragma unroll
            for (int ti = 0; ti < 16; ++ti)
#pragma unroll
                for (int j = 0; j < 4; ++j) { const float e = __builtin_amdgcn_exp2f((st[ti][j] - mx) * sc); st[ti][j] = e; den += e; }
            den += sxor(den, 16); den += sxor(den, 32);
            f32x4 o[8];
#pragma unroll
            for (int dt = 0; dt < 8; ++dt) o[dt] = zq;
#pragma unroll
            for (int pp = 0; pp < 8; ++pp) { const int tA = 2 * pp, tB = 2 * pp + 1;
                u32x4 pw; pw.x = cvt_pk_bf16(st[tA][0], st[tA][1]); pw.y = cvt_pk_bf16(st[tA][2], st[tA][3]); pw.z = cvt_pk_bf16(st[tB][0], st[tB][1]); pw.w = cvt_pk_bf16(st[tB][2], st[tB][3]);
                bf16x8 pf; __builtin_memcpy(&pf, &pw, 16);
#pragma unroll
                for (int dt = 0; dt < 8; ++dt) { const bf16x8 vf = tr_pair(vp[dt] + tA * 4096, vp[dt] + tB * 4096, true);
                    o[dt] = __builtin_amdgcn_mfma_f32_16x16x32_bf16(vf, pf, o[dt], 0, 0, 0); } }
            const float inv = __builtin_amdgcn_rcpf(den);
#pragma unroll
            for (int dt = 0; dt < 8; ++dt) { u32x2 w; w.x = cvt_pk_bf16(o[dt][0] * inv, o[dt][1] * inv); w.y = cvt_pk_bf16(o[dt][2] * inv, o[dt][3] * inv);
                *(u32x2*)(YM + (size_t)tq * 1280 + hm * 128 + 16 * dt + 4 * fq) = w; } }
        __syncthreads();
    }
}

__device__ __forceinline__ void phase_post(const int wv) {
    KParams& p = *kparams();
    const int gt = blockIdx.x * 512 + opaque_tid(wv), nthr = gridDim.x * 512; unsigned char* ws = p.ws;
    const float* Yraw = (const float*)(ws + OFF_YRAW); const bf16_t* C1 = (const bf16_t*)(ws + OFF_C1); const bf16_t* C2 = (const bf16_t*)(ws + OFF_C2); bf16_t* YR = (bf16_t*)(ws + OFF_YCAT);
    for (int idx = gt; idx < NTOK * 128; idx += nthr) { const int t = idx >> 7, c = ((idx >> 4) & 7) * 64 + 4 * (idx & 15);
        const f32x4 y = *(const f32x4*)(Yraw + (size_t)t * 512 + c);
        const float mean = red16(y[0] + y[1] + y[2] + y[3]) * (1.0f / 64.0f);
        const f32x4 d = y - mean; const float var = red16(d[0] * d[0] + d[1] * d[1] + d[2] * d[2] + d[3] * d[3]) * (1.0f / 64.0f);
        const float rs = rsqrtf(var + 64.0f * 1e-5f);
        float c1[4], c2[4]; unpack4(*(const u32x2*)(C1 + (size_t)t * 512 + c), c1); unpack4(*(const u32x2*)(C2 + (size_t)t * 512 + c), c2);
        u32x2 w; w.x = cvt_pk_bf16(d[0] * rs * c1[0] + c2[0], d[1] * rs * c1[1] + c2[1]); w.y = cvt_pk_bf16(d[2] * rs * c1[2] + c2[2], d[3] * rs * c1[3] + c2[3]);
        *(u32x2*)(YR + (size_t)t * 1280 + c) = w; }
    const float* DILO = (const float*)(ws + OFF_DILO); const float* LSE = (const float*)(ws + OFF_LSE); bf16_t* YD = (bf16_t*)(ws + OFF_YCAT) + 512;
    for (int idx = gt; idx < NTOK * 64; idx += nthr) { const int t = idx >> 6, hg = (idx >> 4) & 3, q = idx & 15;
        const float l0 = LSE[(size_t)t * 4 + hg], l1 = LSE[((size_t)NTOK + t) * 4 + hg], l2 = LSE[((size_t)2 * NTOK + t) * 4 + hg];
        const float m = fmaxf(l0, fmaxf(l1, l2)); const float e0 = __expf(l0 - m), e1 = __expf(l1 - m), e2 = __expf(l2 - m); const float inv = __builtin_amdgcn_rcpf(e0 + e1 + e2);
        const f32x4 o0 = *(const f32x4*)(DILO + ((size_t)t * 4 + hg) * 64 + 4 * q), o1 = *(const f32x4*)(DILO + (((size_t)NTOK + t) * 4 + hg) * 64 + 4 * q), o2 = *(const f32x4*)(DILO + (((size_t)2 * NTOK + t) * 4 + hg) * 64 + 4 * q);
        const f32x4 o = (o0 * e0 + o1 * e1 + o2 * e2) * inv;
        u32x2 w; w.x = cvt_pk_bf16(o[0], o[1]); w.y = cvt_pk_bf16(o[2], o[3]); *(u32x2*)(YD + (size_t)t * 1280 + hg * 64 + 4 * q) = w; }
}

__device__ __forceinline__ void phase_router(const int wv, LAS unsigned char* lds, const bool real = true) {
    KParams& p = *kparams();
    const int tid = opaque_tid(wv), wid = tid >> 6, lane = tid & 63, fr = lane & 15, fq = lane >> 4; unsigned char* ws = p.ws;
    const bf16_t* X1 = (const bf16_t*)(ws + OFF_X1B); const float* ln2 = p.in[25]; const float* br = p.in[27]; const bf16_t* WRT = (const bf16_t*)(ws + OFF_WRT);
    unsigned char* XN2 = ws + OFF_XN2; int* TOPE = (int*)(ws + OFF_TOPE); float* TOPG = (float*)(ws + OFF_TOPG);
    LAS int* hist = (LAS int*)(lds + LX_HIST);
    LAS float* red = (LAS float*)lds;
    LAS float* part = (LAS float*)(lds + 1024);
    if (tid < 32) hist[tid] = 0;
    const int grp = wid >> 2, kq = wid & 3;
    int tek[2][4] = {{0, 0, 0, 0}, {0, 0, 0, 0}}, lrk[2][4] = {{0, 0, 0, 0}, {0, 0, 0, 0}};
    u32x4 xq[2][8];
#pragma unroll
    for (int rd = 0; rd < 2; ++rd) { const bf16_t* xp = X1 + (size_t)((blockIdx.x * 4 + rd * 2 + grp) * 16 + fr) * 1024 + kq * 256 + 8 * fq;
#pragma unroll
        for (int s2 = 0; s2 < 8; ++s2) xq[rd][s2] = __builtin_nontemporal_load((const u32x4*)(xp + 32 * s2)); }
#pragma unroll
    for (int rd = 0; rd < 2; ++rd) { const int t0 = (blockIdx.x * 4 + rd * 2 + grp) * 16;
        f32x4 xa[8], xb[8]; float ss = 0.f;
#pragma unroll
        for (int s2 = 0; s2 < 8; ++s2) { float f[8]; unpack8(xq[rd][s2], f); xa[s2] = (f32x4){f[0], f[1], f[2], f[3]}; xb[s2] = (f32x4){f[4], f[5], f[6], f[7]}; }
#pragma unroll
        for (int s2 = 0; s2 < 8; ++s2) ss += xa[s2][0] * xa[s2][0] + xa[s2][1] * xa[s2][1] + xa[s2][2] * xa[s2][2] + xa[s2][3] * xa[s2][3] + xb[s2][0] * xb[s2][0] + xb[s2][1] * xb[s2][1] + xb[s2][2] * xb[s2][2] + xb[s2][3] * xb[s2][3];
        ss += sxor(ss, 16); ss += sxor(ss, 32);
        __syncthreads();
        if (fq == 0) red[(grp * 4 + kq) * 16 + fr] = ss;
        __syncthreads();
        const float tot = red[(grp * 4 + 0) * 16 + fr] + red[(grp * 4 + 1) * 16 + fr] + red[(grp * 4 + 2) * 16 + fr] + red[(grp * 4 + 3) * 16 + fr];
        const float rs = rsqrtf(tot * (1.0f / 1024.0f) + 1e-5f);
        f32x4 acc[2]; acc[0] = zero4f(); acc[1] = acc[0];
#pragma unroll
        for (int s2 = 0; s2 < 8; ++s2) { const int k = kq * 256 + 32 * s2 + 8 * fq;
            const f32x4 g0 = *(const f32x4*)(ln2 + k), g1 = *(const f32x4*)(ln2 + k + 4);
            float xn[8]; xn[0] = xa[s2][0] * rs * g0[0]; xn[1] = xa[s2][1] * rs * g0[1]; xn[2] = xa[s2][2] * rs * g0[2]; xn[3] = xa[s2][3] * rs * g0[3];
            xn[4] = xb[s2][0] * rs * g1[0]; xn[5] = xb[s2][1] * rs * g1[1]; xn[6] = xb[s2][2] * rs * g1[2]; xn[7] = xb[s2][3] * rs * g1[3];
            const u32x4 hi = pack8(xn); float hf[8]; unpack8(hi, hf);
#pragma unroll
            for (int j = 0; j < 8; ++j) hf[j] = xn[j] - hf[j];
            const u32x4 lo = pack8(hf);
            { u32x2 q8; q8.x = pack4_fp8(xn[0] * 8.0f, xn[1] * 8.0f, xn[2] * 8.0f, xn[3] * 8.0f); q8.y = pack4_fp8(xn[4] * 8.0f, xn[5] * 8.0f, xn[6] * 8.0f, xn[7] * 8.0f); if (real) *(u32x2*)(XN2 + (size_t)(t0 + fr) * 1024 + k) = q8; }
            bf16x8 xh, xl; __builtin_memcpy(&xh, &hi, 16); __builtin_memcpy(&xl, &lo, 16);
#pragma unroll
            for (int m = 0; m < 2; ++m) { const bf16x8 wh = *(const bf16x8*)(WRT + (size_t)(16 * m + fr) * 1024 + k), wl = *(const bf16x8*)(WRT + 32768 + (size_t)(16 * m + fr) * 1024 + k);
                acc[m] = MFMA16(wh, xh, acc[m]); acc[m] = MFMA16(wh, xl, acc[m]); acc[m] = MFMA16(wl, xh, acc[m]); } }
#pragma unroll
        for (int m = 0; m < 2; ++m)
#pragma unroll
            for (int j = 0; j < 4; ++j) part[((grp * 4 + kq) * 32 + 16 * m + 4 * fq + j) * 16 + fr] = acc[m][j];
        __syncthreads();
        if (kq == 0) { float lg[8]; int le[8];
#pragma unroll
            for (int m = 0; m < 2; ++m)
#pragma unroll
                for (int j = 0; j < 4; ++j) { const int e = 16 * m + 4 * fq + j; le[m * 4 + j] = e;
                    lg[m * 4 + j] = part[((grp * 4 + 0) * 32 + e) * 16 + fr] + part[((grp * 4 + 1) * 32 + e) * 16 + fr] + part[((grp * 4 + 2) * 32 + e) * 16 + fr] + part[((grp * 4 + 3) * 32 + e) * 16 + fr] + br[e]; }
            float tv[4]; int te[4];
#pragma unroll
            for (int r = 0; r < 4; ++r) { float bv = lg[0]; int bi = le[0];
#pragma unroll
                for (int q = 1; q < 8; ++q) if (lg[q] > bv) { bv = lg[q]; bi = le[q]; }
#pragma unroll
                for (int sft = 16; sft < 64; sft <<= 1) { const float ov = sxor(bv, sft); const int oi = sxor(bi, sft); if (ov > bv || (ov == bv && oi < bi)) { bv = ov; bi = oi; } }
                tv[r] = bv; te[r] = bi;
#pragma unroll
                for (int q = 0; q < 8; ++q) if (le[q] == bi) lg[q] = -3.0e38f; }
            const float e1 = __expf(tv[1] - tv[0]), e2 = __expf(tv[2] - tv[0]), e3 = __expf(tv[3] - tv[0]); const float inv = 1.0f / (1.0f + e1 + e2 + e3);
            if (fq == 0 && real) { const int t = t0 + fr; *(int4*)(TOPE + (size_t)t * 4) = make_int4(te[0], te[1], te[2], te[3]); *(f32x4*)(TOPG + (size_t)t * 4) = (f32x4){inv, e1 * inv, e2 * inv, e3 * inv};
#pragma unroll
                for (int k = 0; k < 4; ++k) { tek[rd][k] = te[k]; lrk[rd][k] = atomicAdd((int*)&hist[te[k]], 1); } } }
    }
    LAS int* bbase = (LAS int*)(lds + LX_BBASE);
    __syncthreads();
    if (tid < 32) { const int hcount = hist[tid]; bbase[tid] = (hcount && real) ? atomicAdd((int*)(ws + OFF_CTL + CTL_CUR) + tid, hcount) : 0; }
    __syncthreads();
    if (kq == 0 && fq == 0 && real) { int* POS = (int*)(ws + OFF_POS); int* STOKE = (int*)(ws + OFF_STOKE);
#pragma unroll
        for (int rd = 0; rd < 2; ++rd) { const int t = (blockIdx.x * 4 + rd * 2 + grp) * 16 + fr; int ps[4];
#pragma unroll
            for (int k = 0; k < 4; ++k) { ps[k] = bbase[tek[rd][k]] + lrk[rd][k]; STOKE[(size_t)tek[rd][k] * NTOK + ps[k]] = t; }
            *(int4*)(POS + (size_t)t * 4) = make_int4(ps[0], ps[1], ps[2], ps[3]); } }
}

__device__ __forceinline__ void build_tables(const int wv, LAS unsigned char* lds) {
    KParams& p = *kparams();
    LAS int* ts = (LAS int*)(lds + LX_TSTART); LAS int* sb = (LAS int*)(lds + LX_SBASE); LAS int* cn = (LAS int*)(lds + LX_CNT);
    if (wv == 0) { const int l = lane_id(); int* gc = (int*)(p.ws + OFF_CTL + CTL_CUR);
        const int c = (l < 32) ? (int)__hip_atomic_load(gc + l, __ATOMIC_RELAXED, __HIP_MEMORY_SCOPE_AGENT) : 0; const int tl = (c + 255) >> 8; int v = tl;
#pragma unroll
        for (int d = 1; d < 32; d <<= 1) { const int o = __builtin_amdgcn_ds_bpermute((l - d) << 2, v); if (l >= d) v += o; }
        if (l < 32) { cn[l] = c; sb[l] = (v - tl) * 256; ts[l + 1] = v; if (l == 0) ts[0] = 0; } }
    __syncthreads();
    { const int tid = (wv << 6) | lane_id(); LAS unsigned char* te = (LAS unsigned char*)(lds + LX_TEXP); const int nt = ts[32];
      if (tid < nt) { int e = 0; while (e < 31 && tid >= ts[e + 1]) ++e; te[tid] = (unsigned char)e; } }
    __syncthreads();
}

__device__ __forceinline__ void phase_combine(const int wv, const bool real = true) {
    KParams& p = *kparams();
    const int tid = opaque_tid(wv), wid = tid >> 6, lane = tid & 63; unsigned char* ws = p.ws;
    const int* SLOT = (const int*)(ws + OFF_SLOT); const float* TOPG = (const float*)(ws + OFF_TOPG); const bf16_t* YS = (const bf16_t*)(ws + OFF_YS); const bf16_t* X1 = (const bf16_t*)(ws + OFF_X1B); float* out = p.out;
    for (int t0 = (blockIdx.x * 8 + wid) * 8; t0 < NTOK; t0 += gridDim.x * 64) {
        int4 sl[8]; f32x4 gg[8];
#pragma unroll
        for (int i = 0; i < 8; ++i) { sl[i] = *(const int4*)(SLOT + (size_t)(t0 + i) * 4); gg[i] = *(const f32x4*)(TOPG + (size_t)(t0 + i) * 4); }
#pragma unroll
        for (int i = 0; i < 8; ++i) { const int t = t0 + i; const int s4[4] = {sl[i].x, sl[i].y, sl[i].z, sl[i].w};
#pragma unroll
            for (int hf = 0; hf < 2; ++hf) { const int c = hf * 512 + 8 * lane; float acc[8];
                const u32x4 xv = __builtin_nontemporal_load((const u32x4*)(X1 + (size_t)t * 1024 + c));
                u32x4 yv[4];
#pragma unroll
                for (int k = 0; k < 4; ++k) yv[k] = __builtin_nontemporal_load((const u32x4*)(YS + (size_t)s4[k] * 1024 + c));
                unpack8(xv, acc);
#pragma unroll
                for (int k = 0; k < 4; ++k) { float f[8]; unpack8(yv[k], f);
#pragma unroll
                    for (int j = 0; j < 8; ++j) acc[j] = fmaf(gg[i][k], f[j], acc[j]); }
                float* dst = real ? out : (float*)(ws + OFF_ACT);
                *(f32x4*)(dst + (size_t)t * 1024 + c) = (f32x4){acc[0], acc[1], acc[2], acc[3]}; *(f32x4*)(dst + (size_t)t * 1024 + c + 4) = (f32x4){acc[4], acc[5], acc[6], acc[7]}; }
            if (i & 1) asm volatile("" ::: "memory"); }
    }
}

__global__ void __launch_bounds__(512, 2) mk_fwd(Params p) {
    extern __shared__ __attribute__((aligned(16))) unsigned char lds_raw[];
    LAS unsigned char* lds = (LAS unsigned char*)lds_raw;
    unsigned char* ws = p.ws;
    const int wv = __builtin_amdgcn_readfirstlane((int)threadIdx.x >> 6);
    const bool multi = (p.ph_hi - p.ph_lo) > 1;
    XcdBarrier xb; xb.bar = (unsigned*)(ws + OFF_CTL); xb.x = 0; xb.st = (volatile LAS unsigned*)(lds + LDS_X);
    if (multi) {
        if (wv == 0 && lane_id() == 0) { *(LAS u32x4*)(lds + LDS_X) = zero4u(); }
        __syncthreads();
        xb = xcd_barrier_post((unsigned*)(ws + OFF_CTL), (volatile LAS unsigned*)(lds + LDS_X), wv);
    }
#if MFMA_BENCH
    { const int l = lane_id(); unsigned h = (unsigned)l * 2654435761u ^ (unsigned)blockIdx.x * 40503u ^ (unsigned)wv * 977u;
      i32x8 a, b;
#pragma unroll
      for (int j = 0; j < 8; ++j) { h = h * 1664525u + 1013904223u; a[j] = (int)(MFMA_BENCH == 1 ? ((h & 0x00ff00ffu) | 0x3f003f00u) : ((h & 0x0f0f0f0fu) | 0x30303030u));
                                    h = h * 1664525u + 1013904223u; b[j] = (int)(MFMA_BENCH == 1 ? ((h & 0x00ff00ffu) | 0x3f003f00u) : ((h & 0x0f0f0f0fu) | 0x30303030u)); }
      f32x4 c[8]; const f32x4 z0 = zero4f();
#pragma unroll
      for (int j = 0; j < 8; ++j) c[j] = z0;
      const int one_scale = 0x7f7f7f7f;
#pragma clang loop unroll(disable)
      for (int it = 0; it < (MFMA_BENCH == 1 ? 1875 : 938); ++it) {
#pragma unroll
          for (int j = 0; j < 8; ++j) {
              if (MFMA_BENCH == 1) c[j] = (j & 1) ? __builtin_amdgcn_mfma_f32_16x16x32_bf16(pg8::half8<1>(a), pg8::half8<1>(b), c[j], 0, 0, 0) : __builtin_amdgcn_mfma_f32_16x16x32_bf16(pg8::half8<0>(a), pg8::half8<0>(b), c[j], 0, 0, 0);
              else asm volatile("v_mfma_scale_f32_16x16x128_f8f6f4 %0, %1, %2, %0, %3, %3 op_sel_hi:[0,0,0]" : "+v"(c[j]) : "v"(a), "v"(b), "v"(one_scale)); } }
      asm volatile("s_nop 15\n\ts_nop 15" ::: "memory");
      float sm = 0.f;
#pragma unroll
      for (int j = 0; j < 8; ++j) sm += c[j][0] + c[j][1] + c[j][2] + c[j][3];
      if (sm == 1.2345f) *(float*)(ws + OFF_CTL + 8192) = sm; }
#endif
    for (int ph = p.ph_lo; ph < p.ph_hi; ++ph) {
      if (ph == 2 || ph == 3 || ph == 10) continue;
      for (int rep = 0; rep < (((DBL_MASK >> ph) & 1) ? 2 : 1); ++rep) {
        KParams& q = *kparams(); unsigned char* ws = q.ws;
        switch (ph) {
        case 0: phase_prep(wv, lds); break;
        case 1: { { SchedZ S; S.H = (const char*)(ws + OFF_H); S.WinT = (const char*)(ws + OFF_WINT); S.HM = (const char*)(ws + OFF_HM); S.WmkvT = (const char*)(ws + OFF_WMKVT); S.G = gridDim.x; S.c = blockIdx.x;
                    EpiZ E; E.Z = (bf16_t*)(ws + OFF_Z); E.KV = (bf16_t*)(ws + OFF_KV); E.GFp = (bf16_t*)(ws + OFF_GF); E.pn0 = 0; E.scale = 1.0f; pg8::gemm_phase(wv, lds, 1024, S, E); }
                  { SchedZ8 S; S.H8 = (const char*)(ws + OFF_H8); S.WIN8 = (const char*)(ws + OFF_WIN8); S.G = gridDim.x; S.c = blockIdx.x;
                    EpiZ E; E.Z = (bf16_t*)(ws + OFF_Z); E.KV = (bf16_t*)(ws + OFF_KV); E.GFp = (bf16_t*)(ws + OFF_GF); E.pn0 = 7; E.scale = 1.0f / 256.0f; pg8::gemm_phase<EpiZ, SchedZ8, 1>(wv, lds, 1024, S, E); }
                  { const int c = blockIdx.x; if (c >= 192) { const int r0 = c < 224 ? (c - 192) * TAIL1_A : 32 * TAIL1_A + (c - 224) * TAIL1_B;
                        prep_tiles(wv, lds, c < 224 ? TAIL1_A : TAIL1_B, [&](int n) { return NTILE - NRES + r0 + n; }); } } } break;
        case 2: phase_elem_c(wv); break;
        case 3: { pg8::DenseOrder S; S.init(ws + OFF_ALORA, ws + OFF_LORAT, NTOK, 1536, 256); EpiLora E; E.L = (float*)(ws + OFF_L); E.w0 = q.in[5]; E.a0 = q.in[7]; pg8::gemm_phase(wv, lds, 256, S, E); } break;
        case 4: phase_chunk_pre(wv, lds); break;
        case 5: for (int r2 = 0; r2 < (((DBL_MASK >> 16) & 1) ? 2 : 1); ++r2) phase_scan_seq(wv, lds);
                for (int r2 = 0; r2 < (((DBL_MASK >> 17) & 1) ? 2 : 1); ++r2) phase_dil_attn(wv, lds);
                for (int r2 = 0; r2 < (((DBL_MASK >> 18) & 1) ? 2 : 1); ++r2) phase_mem_attn(wv, lds); break;
        case 6: phase_post(wv); break;
        case 7: { pg8::DenseOrder S; S.init(ws + OFF_YCAT, ws + OFF_PCAT, NTOK, 1024, 1280); EpiMixCat E; E.mixbf = (bf16_t*)(ws + OFF_MIXBF); E.GF = (const bf16_t*)(ws + OFF_GF); E.tid = (wv << 6) | lane_id(); pg8::gemm_phase(wv, lds, 1280, S, E); } break;
        case 8: { pg8::DenseOrder S; S.init(ws + OFF_MIXBF, ws + OFF_WOT, NTOK, 1024, 1024); EpiX1 E; E.x = q.in[0]; E.x1 = (bf16_t*)(ws + OFF_X1B); pg8::gemm_phase(wv, lds, 1024, S, E); } break;
        case 9: phase_router(wv, lds, rep + 1 == (((DBL_MASK >> ph) & 1) ? 2 : 1)); break;
        case 11: { build_tables(wv, lds);
                   { const int* TOPE = (const int*)(ws + OFF_TOPE); const int* POS = (const int*)(ws + OFF_POS); int* SLOT = (int*)(ws + OFF_SLOT); const LAS int* sb = (const LAS int*)(lds + LX_SBASE);
                     for (int i = blockIdx.x * 512 + ((wv << 6) | lane_id()); i < NTOK * 4; i += gridDim.x * 512) SLOT[i] = sb[TOPE[i]] + POS[i]; }
                   SchedMoe<true> S; S.A = (const char*)(ws + OFF_XN2); S.Bt = (const char*)(ws + OFF_W1T); S.tstart = (const LAS int*)(lds + LX_TSTART); S.stok = (const int*)(ws + OFF_STOKE); S.lgN = 3; S.total = S.tstart[32] * 8; S.estride = (size_t)2048 * 1024; S.tbytes = (size_t)256 * 1024;
                   EpiSwiglu E; E.act = ws + OFF_ACT; E.b1 = q.in[29]; E.lds = lds; pg8::gemm_phase<EpiSwiglu, SchedMoe<true>, 1>(wv, lds, 1024, S, E);
                   { const int c = blockIdx.x, rem = S.total & 255, nearly = rem ? 256 - rem : 0, j = ((c & 7) * 32 + (c >> 3)) - rem;
                     if (rem && j >= 0 && j < 128) prep_tiles(wv, lds, TAIL6, [&](int n) { return NTILE - NRES + NRES1 + n * 128 + j; });
                     const int m = 128 - (nearly < 128 ? nearly : 128);
                     if (m > 0) { const int nf = m * TAIL6, top = nf - 1 - c; prep_tiles(wv, lds, top >= 0 ? top / (int)gridDim.x + 1 : 0, [&](int n) { const int f = top - n * (int)gridDim.x; return NTILE - NRES + NRES1 + (f / m) * 128 + nearly + (f % m); }); } } } break;
        case 12: { build_tables(wv, lds); SchedMoe<false> S; S.A = (const char*)(ws + OFF_ACT); S.Bt = (const char*)(ws + OFF_W2T); S.tstart = (const LAS int*)(lds + LX_TSTART); S.stok = nullptr; S.lgN = 2; S.total = S.tstart[32] * 4; S.estride = (size_t)1024 * 1024; S.tbytes = (size_t)256 * 1024;
                   EpiYs E; E.ys = (bf16_t*)(ws + OFF_YS); E.b2 = q.in[31]; E.lds = lds; pg8::gemm_phase<EpiYs, SchedMoe<false>, 1>(wv, lds, 1024, S, E); } break;
        case 13: phase_combine(wv, rep + 1 == (((DBL_MASK >> ph) & 1) ? 2 : 1)); break;
        default: break;
        }
      }
        if (ph + 1 < p.ph_hi) xcd_barrier(xb, wv);
        if (((DBL_MASK >> 20) & 1) && ph == 3 && multi) for (int e = 0; e < 10; ++e) xcd_barrier(xb, wv);
    }
}

extern "C" void kernel_launch(void* const* d_in, const int* in_sizes, int n_in, void* d_out, int out_size, void* d_ws, size_t ws_size, hipStream_t stream) {
    static int ready = 0;
    if (ready == 0) {
        if (n_in != 32 || out_size != NTOK * 1024 || ws_size < WS_NEED) { fprintf(stderr, "kernel_launch: unexpected shapes (n_in %d, out %d, ws %zu < %zu)\n", n_in, out_size, ws_size, (size_t)WS_NEED); ready = -1; return; }
        if (hipFuncSetAttribute((const void*)mk_fwd, hipFuncAttributeMaxDynamicSharedMemorySize, LDS_BYTES) != hipSuccess) { fprintf(stderr, "kernel_launch: hipFuncSetAttribute failed\n"); ready = -1; return; }
        int per_cu = 0, dev = 0, cus = 0; hipGetDevice(&dev); hipDeviceGetAttribute(&cus, hipDeviceAttributeMultiprocessorCount, dev);
        hipOccupancyMaxActiveBlocksPerMultiprocessor(&per_cu, (const void*)mk_fwd, 512, LDS_BYTES);
        if (per_cu < 1 || cus < 256) { fprintf(stderr, "kernel_launch: occupancy %d blocks/CU on %d CUs; need >= 1 on 256\n", per_cu, cus); ready = -1; (void)hipGetLastError(); return; }
        ready = 1;
    }
    if (ready < 0) return;
    hipMemsetAsync((char*)d_ws + OFF_CTL, 0, CTL_BYTES, stream);
    Params p{};
    for (int i = 0; i < 32; ++i) p.in[i] = (const float*)d_in[i];
    p.out = (float*)d_out; p.ws = (unsigned char*)d_ws;
#if MK_N_LAUNCH_PER_PHASE
    for (int ph = 0; ph < NPHASE; ++ph) { p.ph_lo = ph; p.ph_hi = ph + 1; hipLaunchKernelGGL(mk_fwd, dim3(256), dim3(512), LDS_BYTES, stream, p); }
#else
    p.ph_lo = 0; p.ph_hi = NPHASE;
    void* args[] = {&p};
    hipError_t e = hipLaunchCooperativeKernel((const void*)mk_fwd, dim3(256), dim3(512), args, LDS_BYTES, stream);
    if (e != hipSuccess) fprintf(stderr, "cooperative launch failed: %s\n", hipGetErrorString(e));
#endif
}
```

```cpp
#include <hip/hip_runtime.h>
#include <cstdio>
#include <cstdint>

#define LAS __attribute__((address_space(3)))
typedef unsigned short bf16_t;
typedef short bf16x8 __attribute__((ext_vector_type(8)));
typedef short s16x4 __attribute__((ext_vector_type(4)));
typedef float f32x4 __attribute__((ext_vector_type(4)));
typedef float f32x2 __attribute__((ext_vector_type(2)));
typedef unsigned u32x4 __attribute__((ext_vector_type(4)));
typedef unsigned u32x2 __attribute__((ext_vector_type(2)));
typedef int i32x8 __attribute__((ext_vector_type(8)));
typedef int i32x4 __attribute__((ext_vector_type(4)));

#ifndef DBL_MASK
#define DBL_MASK 0
#endif
#ifndef MK_N_LAUNCH_PER_PHASE
#define MK_N_LAUNCH_PER_PHASE 0
#endif

constexpr int NTOK = 16384, SEQ = 2048, INC = 7680;
constexpr int C_K = 512, C_V = 1024, C_ZW = 1536, C_DQ = 1792, C_DK = 2560, C_DV = 3328, C_MQ = 4096, C_GATE = 4608;
constexpr int NPHASE = 14;
constexpr int NSLOT_MAX = 65536 + 32 * 256;

constexpr size_t MiB = 1ull << 20;
constexpr size_t OFF_CTL = 0;
constexpr size_t CTL_BYTES = 32768;
constexpr size_t CTL_CNT = 16384;
constexpr size_t CTL_CUR = 16384 + 256;
constexpr size_t CTL_KEEP = 20480;
constexpr size_t OFF_TOPE = 1 * MiB;
constexpr size_t OFF_TOPG = 1 * MiB + 262144;
constexpr size_t OFF_SLOT = 1 * MiB + 524288;
constexpr size_t OFF_STOK = 2 * MiB;
constexpr size_t OFF_WRT = 3 * MiB;
constexpr size_t OFF_WINT = 4 * MiB, OFF_WMKVT = 19 * MiB, OFF_LORAT = 21 * MiB, OFF_PRT = 22 * MiB, OFF_PDT = 23 * MiB, OFF_PMT = 24 * MiB, OFF_WOT = 25 * MiB;
constexpr size_t OFF_WIN8 = 8 * MiB;
constexpr size_t OFF_H8 = 539 * MiB;
constexpr size_t OFF_YCAT = 223 * MiB;
constexpr size_t OFF_PCAT = 22 * MiB;
constexpr size_t OFF_W1T = 27 * MiB, OFF_W2T = 155 * MiB, OFF_KV = 219 * MiB, OFF_YM = 223 * MiB, OFF_YR = 239 * MiB, OFF_YD = 255 * MiB, OFF_Z = 263 * MiB;
constexpr size_t OFF_H = 503 * MiB, OFF_HM = 535 * MiB, OFF_ALORA = 503 * MiB, OFF_L = 511 * MiB, OFF_REC = 607 * MiB;
constexpr size_t OFF_GF = OFF_REC;
constexpr size_t OFF_LW = OFF_REC + 64 * MiB;
constexpr size_t OFF_VB = OFF_REC + 96 * MiB;
constexpr size_t OFF_GTF = OFF_REC + 112 * MiB;
constexpr size_t OFF_RTF = OFF_REC + 144 * MiB;
constexpr size_t OFF_HHF = OFF_REC + 160 * MiB;
constexpr size_t OFF_YLF = OFF_REC + 192 * MiB;
constexpr size_t OFF_C1 = 816 * MiB, OFF_C2 = 832 * MiB, OFF_YRAW = 848 * MiB, OFF_DILO = 880 * MiB, OFF_LSE = 928 * MiB;
constexpr size_t OFF_MIX32 = 503 * MiB, OFF_MIXBF = 567 * MiB, OFF_XN2 = 503 * MiB, OFF_XS = 263 * MiB, OFF_ACT = 607 * MiB, OFF_YS = 407 * MiB;
constexpr size_t OFF_X1B = 263 * MiB;
constexpr size_t OFF_STOKE = 296 * MiB;
constexpr size_t OFF_POS = 2 * MiB;
constexpr size_t WS_NEED = 929 * MiB;

constexpr int LDS_BYTES = 160 * 1024;
constexpr int LDS_X = LDS_BYTES - 4096;
constexpr int LX_TSTART = LDS_X + 64;
constexpr int LX_SBASE = LDS_X + 256;
constexpr int LX_CNT = LDS_X + 512;
constexpr int LX_HIST = LDS_X + 768;
constexpr int LX_BBASE = LDS_X + 1024;
constexpr int LX_SLOTL = LDS_X + 2048;
constexpr int LX_TEXP = LDS_X + 3072;

struct Params { const float* in[32]; float* out; unsigned char* ws; int ph_lo, ph_hi; };
typedef const Params __attribute__((address_space(4))) KParams;
__device__ __forceinline__ KParams* kparams() { KParams* kp = (KParams*)__builtin_amdgcn_kernarg_segment_ptr(); asm volatile("" : "+s"(kp)); return kp; }

typedef __bf16 bf16x2_t __attribute__((ext_vector_type(2)));
__device__ __forceinline__ unsigned cvt_pk_bf16(float lo, float hi) { f32x2 v = {lo, hi}; bf16x2_t b = __builtin_convertvector(v, bf16x2_t); unsigned r; __builtin_memcpy(&r, &b, 4); return r; }
__device__ __forceinline__ unsigned pack4_fp8(float a, float b, float c, float d) { int r = __builtin_amdgcn_cvt_pk_fp8_f32(a, b, 0, false); r = __builtin_amdgcn_cvt_pk_fp8_f32(c, d, r, true); return (unsigned)r; }
__device__ __forceinline__ float bf_lo(unsigned u) { return __uint_as_float(u << 16); }
__device__ __forceinline__ float bf_hi(unsigned u) { return __uint_as_float(u & 0xffff0000u); }
__device__ __forceinline__ int lane_id() { int l; asm volatile("v_mbcnt_lo_u32_b32 %0, -1, 0\n\tv_mbcnt_hi_u32_b32 %0, -1, %0" : "=v"(l)); return l; }
__device__ __forceinline__ int sxor(int x, int m) { return __builtin_amdgcn_ds_bpermute((lane_id() ^ m) << 2, x); }
__device__ __forceinline__ float sxor(float x, int m) { return __int_as_float(__builtin_amdgcn_ds_bpermute((lane_id() ^ m) << 2, __float_as_int(x))); }
template <int CTRL> __device__ __forceinline__ float dpp_f(float x) { return __int_as_float(__builtin_amdgcn_update_dpp(0, __float_as_int(x), CTRL, 0xF, 0xF, true)); }
__device__ __forceinline__ float red4(float x) { x += dpp_f<0xB1>(x); x += dpp_f<0x4E>(x); return x; }
__device__ __forceinline__ float red8(float x) { x = red4(x); x += dpp_f<0x141>(x); return x; }
__device__ __forceinline__ float red16(float x) { x = red8(x); x += dpp_f<0x140>(x); return x; }
__device__ __forceinline__ float red64(float x) { x = red16(x); x += sxor(x, 16); x += sxor(x, 32); return x; }
__device__ __forceinline__ int opaque_tid(const int wv) { int t = (wv << 6) | lane_id(); asm volatile("" : "+v"(t)); return t; }
__device__ __forceinline__ f32x4 zero4f() { float z = 0.f; asm volatile("" : "+v"(z)); return (f32x4){z, z, z, z}; }
__device__ __forceinline__ u32x4 zero4u() { unsigned z = 0u; asm volatile("" : "+v"(z)); return (u32x4){z, z, z, z}; }
__device__ __forceinline__ float sigmoidf_(float x) { return __builtin_amdgcn_rcpf(1.0f + __builtin_amdgcn_exp2f(-1.44269504f * x)); }
__device__ __forceinline__ void unpack8(const u32x4 v, float (&f)[8]) { f[0] = bf_lo(v.x); f[1] = bf_hi(v.x); f[2] = bf_lo(v.y); f[3] = bf_hi(v.y); f[4] = bf_lo(v.z); f[5] = bf_hi(v.z); f[6] = bf_lo(v.w); f[7] = bf_hi(v.w); }
__device__ __forceinline__ u32x4 pack8(const float (&f)[8]) { u32x4 w; w.x = cvt_pk_bf16(f[0], f[1]); w.y = cvt_pk_bf16(f[2], f[3]); w.z = cvt_pk_bf16(f[4], f[5]); w.w = cvt_pk_bf16(f[6], f[7]); return w; }
__device__ __forceinline__ float sumsq8(const u32x4 v) { float f[8]; unpack8(v, f); float s = 0.f;
#pragma unroll
    for (int j = 0; j < 8; ++j) s += f[j] * f[j];
    return s; }
__device__ __forceinline__ u32x4 scale8(const u32x4 v, const float rs, const float* w) { float f[8]; unpack8(v, f); const f32x4 w0 = *(const f32x4*)w, w1 = *(const f32x4*)(w + 4);
    f[0] *= rs * w0[0]; f[1] *= rs * w0[1]; f[2] *= rs * w0[2]; f[3] *= rs * w0[3]; f[4] *= rs * w1[0]; f[5] *= rs * w1[1]; f[6] *= rs * w1[2]; f[7] *= rs * w1[3]; return pack8(f); }
__device__ __forceinline__ u32x4 scale8r(const u32x4 v, const float rs, const float (&w)[8]) { float f[8]; unpack8(v, f);
#pragma unroll
    for (int j = 0; j < 8; ++j) f[j] *= rs * w[j];
    return pack8(f); }
__device__ __forceinline__ u32x4 scale8s(const u32x4 v, const float rs) { float f[8]; unpack8(v, f);
#pragma unroll
    for (int j = 0; j < 8; ++j) f[j] *= rs;
    return pack8(f); }
__device__ __forceinline__ void unpack4(const u32x2 v, float (&f)[4]) { f[0] = bf_lo(v.x); f[1] = bf_hi(v.x); f[2] = bf_lo(v.y); f[3] = bf_hi(v.y); }

#define XB_TMO      128
#define XB_XCNT(j)  (256  + 64 * (j))
#define XB_XSUB(j)  (1280 + 64 * (j))
#define XB_XGEN(j)  (2304 + 64 * (j))
#define XB_TOP      3328
#define XB_TOPGEN   3392
#define XCD_BAR_WORDS 3456
#define XB_SPIN_CAP (1u << 22)
__device__ __forceinline__ unsigned xb_ld(unsigned* p)              { return __hip_atomic_load(p, __ATOMIC_RELAXED, __HIP_MEMORY_SCOPE_AGENT); }
__device__ __forceinline__ unsigned xb_add(unsigned* p, unsigned v) { return __hip_atomic_fetch_add(p, v, __ATOMIC_RELAXED, __HIP_MEMORY_SCOPE_AGENT); }
__device__ __forceinline__ unsigned xb_xcc_id() { return (unsigned)__builtin_amdgcn_s_getreg((3 << 11) | 20) & 0xFu; }
#define XB_SPIN(cond, bar) do { unsigned _sp = 0; while (cond) { __builtin_amdgcn_s_sleep(1); \
    if ((++_sp & 255u) == 0u) { if (xb_ld(&(bar)[XB_TMO])) break; if (_sp > XB_SPIN_CAP) { atomicAdd(&(bar)[XB_TMO], 1u); break; } } } } while (0)
struct XcdBarrier { unsigned* bar; unsigned x; volatile LAS unsigned* st; };
__device__ __forceinline__ XcdBarrier xcd_barrier_post(unsigned* bar, volatile LAS unsigned* st, const int wv) {
    XcdBarrier b; b.bar = bar; b.x = xb_xcc_id(); b.st = st;
    if (wv == 0 && lane_id() == 0) (void)xb_add(&bar[XB_XCNT(b.x)], 1u);
    return b;
}
__device__ __forceinline__ void xcd_barrier_complete(unsigned* bar, unsigned x, unsigned& nloc, unsigned& nx) {
    const unsigned G = gridDim.x * gridDim.y * gridDim.z;
    unsigned sum, cnt, mine, sp = 0u;
    for (;;) {
        sum = 0u; cnt = 0u; mine = 0u;
#pragma unroll
        for (unsigned j = 0; j < 16; ++j) { const unsigned c = xb_ld(&bar[XB_XCNT(j)]); sum += c; cnt += (c > 0u) ? 1u : 0u; mine = (j == x) ? c : mine; }
        if (sum == G) break;
        __builtin_amdgcn_s_sleep(1);
        if ((++sp & 255u) == 0u) { if (xb_ld(&bar[XB_TMO])) break; if (sp > XB_SPIN_CAP) { atomicAdd(&bar[XB_TMO], 1u); break; } }
    }
    nloc = mine > 0u ? mine : 1u; nx = cnt > 0u ? cnt : 1u;
}
__device__ __forceinline__ void xcd_barrier(const XcdBarrier& b, const int wv) {
    asm volatile("s_waitcnt vmcnt(0)" ::: "memory");
    __syncthreads();
    if (wv == 0 && lane_id() == 0) {
        unsigned* bar = b.bar;
        __builtin_amdgcn_s_waitcnt(0);
        unsigned nloc = b.st[0], nx = b.st[1];
        if (nloc == 0u) { xcd_barrier_complete(bar, b.x, nloc, nx); b.st[0] = nloc; b.st[1] = nx; }
        const unsigned old = xb_add(&bar[XB_XSUB(b.x)], 1u);
        const unsigned gen = old / nloc;
        if (old + 1u == (gen + 1u) * nloc) {
            __builtin_amdgcn_fence(__ATOMIC_RELEASE, "agent");
            asm volatile("s_waitcnt vmcnt(0)" ::: "memory");
            const unsigned og = xb_add(&bar[XB_TOP], 1u);
            const unsigned tg = og / nx;
            if (og + 1u == (tg + 1u) * nx) xb_add(&bar[XB_TOPGEN], 1u);
            else XB_SPIN(xb_ld(&bar[XB_TOPGEN]) == tg, bar);
            __builtin_amdgcn_fence(__ATOMIC_ACQUIRE, "agent");
            xb_add(&bar[XB_XGEN(b.x)], 1u);
            asm volatile("s_waitcnt vmcnt(0)" ::: "memory");
        } else {
            XB_SPIN(xb_ld(&bar[XB_XGEN(b.x)]) == gen, bar);
            __builtin_amdgcn_fence(__ATOMIC_ACQUIRE, "agent");
            asm volatile("s_waitcnt vmcnt(0)" ::: "memory");
        }
    }
    __syncthreads();
}

#ifndef MFMA_BENCH
#define MFMA_BENCH 0
#endif
#ifndef EDBL
#define EDBL 0
#endif
#ifndef KMODE
#define KMODE 0
#endif
#ifndef KDBL
#define KDBL 0
#endif
struct EpiSwiglu; struct EpiYs; struct EpiZ; struct EpiMixCat; struct EpiX1;
namespace pg8 {
constexpr int BM = 256, BK = 64, HALF = 128, HTB = HALF * BK * 2, STAGE_BYTES = 8 * HTB, NXCD = 8, WGM = 8;
__host__ __device__ __forceinline__ int lds_byte(int r, int c) { const int st = (r >> 4) * 2 + (c >> 5), rr = r & 15, cc = c & 31, ob = rr * 64 + cc * 2; return st * 1024 + (ob ^ (((ob >> 9) & 1) << 5)); }
__host__ __device__ __forceinline__ void stage_rc(int b, int& R, int& C) { const int st = b / 1024, sb = b % 1024, swz = sb ^ (((sb >> 9) & 1) << 5); R = (st >> 1) * 16 + swz / 64; C = (st & 1) * 32 + (swz % 64) / 2; }
__host__ __device__ __forceinline__ int perm32(int rho) { const int n = rho >> 4, i = rho & 15; return 8 * (i >> 2) + 4 * n + (i & 3); }
struct Unit { int pm, pn, tag, aux; const char* pa; const char* pb; };
template <class E, class = void> struct HasPre { static constexpr bool value = false; };
template <class E> struct HasPre<E, decltype((void)E::PRE)> { static constexpr bool value = true; };

__device__ __forceinline__ void static_map(long L, int nM, int nN, int& pm, int& pn) {
    const int nwg = nM * nN; int wgid = (int)L;
    { const int q = nwg / NXCD, r = nwg % NXCD, xcd = wgid % NXCD, off = wgid / NXCD; wgid = (xcd < r ? xcd * (q + 1) : r * (q + 1) + (xcd - r) * q) + off; }
    const int nig = WGM * nN, gid = wgid / nig, fm = gid * WGM, gsz = (nM - fm) < WGM ? (nM - fm) : WGM;
    pm = fm + ((wgid % nig) % gsz); pn = (wgid % nig) / gsz;
}
struct DenseOrder {
    static constexpr bool GATHER = false; __device__ __forceinline__ unsigned a_off(const Unit&, int, int, int, int) const { return 0u; }
    const char* A; const char* Bt; int nM, nN, G, c; size_t tstep;
    __device__ __forceinline__ void init(const void* A_, const void* Bt_, int M, int N, int K) { A = (const char*)A_; Bt = (const char*)Bt_; nM = M / BM; nN = N / BM; G = gridDim.x; c = blockIdx.x; tstep = (size_t)BM * K * 2; }
    __device__ __forceinline__ bool next(int i, Unit& u) const {
        const long L = (long)i * G + c; if (L >= (long)nM * nN) return false;
        static_map(L, nM, nN, u.pm, u.pn); u.tag = 0; u.pa = A + (size_t)u.pm * tstep; u.pb = Bt + (size_t)u.pn * tstep; return true;
    }
};

template <int H> __device__ __forceinline__ bf16x8 half8(const i32x8 v) { const i32x4 x = H ? __builtin_shufflevector(v, v, 4, 5, 6, 7) : __builtin_shufflevector(v, v, 0, 1, 2, 3); bf16x8 r; __builtin_memcpy(&r, &x, 16); return r; }
template <class Epi, class Sched, int ES = 2>
__device__ __forceinline__ void gemm_phase(const int wv, LAS unsigned char* lds, const int K, const Sched& S, const Epi& E) {
    int tid_ = (wv << 6) | lane_id(); asm volatile("" : "+v"(tid_));
    const int tid = tid_, wid = __builtin_amdgcn_readfirstlane(tid >> 6), lane = tid & 63, wr = wid >> 2, wc = wid & 3, fr = lane & 15, fq = lane >> 4;
    const int nt = K * ES / (BK * 2);
    unsigned voffA[2], voffB[2]; int RA[2], CA[2];
#pragma unroll
    for (int i = 0; i < 2; ++i) { int R, C; stage_rc(tid * 16 + i * 8192, R, C); const int Rb = Epi::PERM ? ((R & ~31) + perm32(R & 31)) : R; RA[i] = R; CA[i] = C;
        voffA[i] = (unsigned)(R * K * ES + C * 2); voffB[i] = (unsigned)(Rb * K * ES + C * 2); }
    unsigned vA[2][2][2];
    const size_t kstep = (size_t)(BK * 2);
    const size_t hstep = (size_t)HALF * K * ES;
    const unsigned ldsw = (unsigned)wid * 1024u;
    const int aoff = lds_byte(wr * 64 + fr, fq * 8), boff = lds_byte(wc * 32 + fr, fq * 8);
#define PG8_SA(b, h) (((b) * 2 + (h)) * HTB)
#define PG8_SB(b, h) ((4 + (b) * 2 + (h)) * HTB)
#define PG8_STAGE(bufoff, gbase, voff) do { _Pragma("unroll") for (int _i = 0; _i < 2; ++_i) \
        __builtin_amdgcn_global_load_lds((const unsigned*)((const char*)(gbase) + (voff)[_i]), (LAS unsigned*)(lds + (bufoff) + ldsw + _i * 8192), 16, 0, 0); } while (0)
#define PG8_LDA(dst, b, h) do { _Pragma("unroll") for (int m = 0; m < 4; ++m) { const i32x4 _lo = *(const LAS i32x4*)(lds + PG8_SA(b, h) + aoff + m * 2048), _hi = *(const LAS i32x4*)(lds + PG8_SA(b, h) + aoff + m * 2048 + 1024); dst[m] = __builtin_shufflevector(_lo, _hi, 0, 1, 2, 3, 4, 5, 6, 7); } } while (0)
#define PG8_LDB(dst, b, h) do { _Pragma("unroll") for (int n = 0; n < 2; ++n) { const i32x4 _lo = *(const LAS i32x4*)(lds + PG8_SB(b, h) + boff + n * 2048), _hi = *(const LAS i32x4*)(lds + PG8_SB(b, h) + boff + n * 2048 + 1024); dst[n] = __builtin_shufflevector(_lo, _hi, 0, 1, 2, 3, 4, 5, 6, 7); } } while (0)
#define PG8_MMA(ai, bj, At, Bt) do { __builtin_amdgcn_s_setprio(1); _Pragma("unroll") for (int m = 0; m < 4; ++m) _Pragma("unroll") for (int n = 0; n < 2; ++n) { \
        if (ES == 2) { acc[ai][bj][m][n] = __builtin_amdgcn_mfma_f32_16x16x32_bf16(half8<0>(Bt[n]), half8<0>(At[m]), acc[ai][bj][m][n], 0, 0, 0); \
                       acc[ai][bj][m][n] = __builtin_amdgcn_mfma_f32_16x16x32_bf16(half8<1>(Bt[n]), half8<1>(At[m]), acc[ai][bj][m][n], 0, 0, 0); } \
        else asm volatile("v_mfma_scale_f32_16x16x128_f8f6f4 %0, %1, %2, %0, %3, %3 op_sel_hi:[0,0,0]" : "+v"(acc[ai][bj][m][n]) : "v"(Bt[n]), "v"(At[m]), "v"(one_scale)); } \
        __builtin_amdgcn_s_setprio(0); } while (0)
#define PG8_WAIT_V(n) asm volatile("s_waitcnt vmcnt(" #n ")" ::: "memory")
#define PG8_WAIT_L(n) asm volatile("s_waitcnt lgkmcnt(" #n ")" ::: "memory")
#define PG8_BAR __builtin_amdgcn_s_barrier()
#define PG8_SCHED __builtin_amdgcn_sched_barrier(0)
    constexpr int kd = (KDBL == 1 && (__is_same(Epi, EpiSwiglu) || __is_same(Epi, EpiYs))) || (KDBL == 2 && __is_same(Epi, EpiZ)) || (KDBL == 3 && (__is_same(Epi, EpiMixCat) || __is_same(Epi, EpiX1))) ? 1 : 0;
    Unit cur, nxt; int ui = 0;
    if (!S.next(0, cur)) return;
    cur.aux = 0; if constexpr (HasPre<Epi>::value) E.pre(cur, wid, wc, lane);
    f32x4 acc[2][2][4][2]; const f32x4 zz0 = zero4f();
#pragma unroll
    for (int a = 0; a < 2; ++a)
#pragma unroll
        for (int b = 0; b < 2; ++b)
#pragma unroll
            for (int m = 0; m < 4; ++m)
#pragma unroll
                for (int n = 0; n < 2; ++n) acc[a][b][m][n] = zz0;
    i32x8 At[4], B0[2], B1[2];
    const int one_scale = 0x7f7f7f7f;
    const char* cA = cur.pa; const char* cB = cur.pb;
#pragma unroll
    for (int h = 0; h < 2; ++h)
#pragma unroll
        for (int i = 0; i < 2; ++i) vA[0][h][i] = Sched::GATHER ? S.a_off(cur, h, RA[i], CA[i], K * ES) : voffA[i] + (unsigned)(h * hstep);
    if constexpr (kd && KMODE == 1) { cA = S.A; cB = S.Bt;
#pragma unroll
        for (int h = 0; h < 2; ++h)
#pragma unroll
            for (int i = 0; i < 2; ++i) vA[0][h][i] = voffA[i] + (unsigned)(h * hstep); }
    PG8_STAGE(PG8_SB(0, 0), cB, voffB); PG8_STAGE(PG8_SA(0, 0), cA, vA[0][0]); PG8_STAGE(PG8_SB(0, 1), cB + hstep, voffB); PG8_STAGE(PG8_SA(0, 1), cA, vA[0][1]);
    if (wr == 1) PG8_BAR;
    PG8_WAIT_V(4); PG8_BAR;
    PG8_STAGE(PG8_SB(1, 0), cB + kstep, voffB); PG8_STAGE(PG8_SA(1, 0), cA + kstep, vA[0][0]); PG8_STAGE(PG8_SB(1, 1), cB + hstep + kstep, voffB);
    PG8_WAIT_V(6); PG8_BAR;
    for (;;) {
        const bool has_next = S.next((ui + 1) >> kd, nxt);
        const char* nA = has_next ? nxt.pa : cA; const char* nB = has_next ? nxt.pb : cB;
#pragma unroll
        for (int h = 0; h < 2; ++h)
#pragma unroll
            for (int i = 0; i < 2; ++i) vA[1][h][i] = has_next ? (Sched::GATHER ? S.a_off(nxt, h, RA[i], CA[i], K * ES) : voffA[i] + (unsigned)(h * hstep)) : vA[0][h][i];
        if constexpr (kd && KMODE == 1) { if (has_next && (ui & 1)) { nA = S.A; nB = S.Bt;
#pragma unroll
            for (int h = 0; h < 2; ++h)
#pragma unroll
                for (int i = 0; i < 2; ++i) vA[1][h][i] = voffA[i] + (unsigned)(h * hstep); } }
        const bool ld = !(kd && KMODE == 2 && !(ui & 1));
#pragma clang loop unroll(disable)
        for (int t = 0; t < nt; t += 2) {
            if constexpr (Epi::MID) { if (t == 8 || t == 12) E.mid(acc, cur, t, wr, wc, fr, fq); }
            const bool last = (t == nt - 2);
            const char* a1 = cA + (size_t)(t + 1) * kstep;
            const char* a2 = last ? nA : cA + (size_t)(t + 2) * kstep; const char* b2 = last ? nB : cB + (size_t)(t + 2) * kstep;
            const char* a3 = a2 + kstep; const char* b3 = b2 + kstep;
            unsigned w0[2], w1[2];
#pragma unroll
            for (int i = 0; i < 2; ++i) { w0[i] = vA[0][0][i]; w1[i] = vA[0][1][i]; }
            if (last) { asm volatile("" ::: "memory");
#pragma unroll
                for (int i = 0; i < 2; ++i) { w0[i] = vA[1][0][i]; w1[i] = vA[1][1][i]; } }
            PG8_LDB(B0, 0, 0); PG8_SCHED; PG8_LDA(At, 0, 0); if (ld) PG8_STAGE(PG8_SA(1, 1), a1, vA[0][1]);
            PG8_WAIT_L(8); PG8_BAR; PG8_WAIT_L(0); PG8_MMA(0, 0, At, B0); PG8_BAR; PG8_SCHED;
            PG8_LDB(B1, 0, 1); if (ld || last) PG8_STAGE(PG8_SB(0, 0), b2, voffB);
            PG8_BAR; PG8_WAIT_L(0); PG8_MMA(0, 1, At, B1); PG8_BAR;
            PG8_LDA(At, 0, 1); if (ld || last) PG8_STAGE(PG8_SA(0, 0), a2, w0);
            PG8_BAR; PG8_WAIT_L(0); PG8_MMA(1, 0, At, B0); PG8_BAR; PG8_SCHED;
            if (ld || last) PG8_STAGE(PG8_SB(0, 1), b2 + hstep, voffB);
            PG8_WAIT_V(6); PG8_BAR; PG8_MMA(1, 1, At, B1); PG8_BAR;
            PG8_LDB(B0, 1, 0); PG8_SCHED; PG8_LDA(At, 1, 0); if (ld || last) PG8_STAGE(PG8_SA(0, 1), a2, w1);
            PG8_WAIT_L(8); PG8_BAR; PG8_WAIT_L(0); PG8_MMA(0, 0, At, B0); PG8_BAR; PG8_SCHED;
            PG8_LDB(B1, 1, 1); if (ld || last) PG8_STAGE(PG8_SB(1, 0), b3, voffB);
            PG8_BAR; PG8_WAIT_L(0); PG8_MMA(0, 1, At, B1); PG8_BAR;
            PG8_LDA(At, 1, 1); if (ld || last) PG8_STAGE(PG8_SA(1, 0), a3, w0);
            PG8_BAR; PG8_WAIT_L(0); PG8_MMA(1, 0, At, B0); PG8_BAR; PG8_SCHED;
            if (ld || last) PG8_STAGE(PG8_SB(1, 1), b3 + hstep, voffB);
            PG8_WAIT_V(6); PG8_BAR; PG8_MMA(1, 1, At, B1); PG8_BAR;
        }
        if (ES == 1) asm volatile("s_nop 15\n\ts_nop 15" ::: "memory");
        if (!kd || (ui & 1)) E(acc, cur, wr, wc, fr, fq);
        if constexpr (EDBL == 1 && (__is_same(Epi, EpiSwiglu) || __is_same(Epi, EpiYs))) { asm volatile("" ::: "memory"); E(acc, cur, wr, wc, fr, fq); }
        if (!has_next) break;
        const f32x4 zz1 = zero4f();
#pragma unroll
        for (int a = 0; a < 2; ++a)
#pragma unroll
            for (int b = 0; b < 2; ++b)
#pragma unroll
                for (int m = 0; m < 4; ++m)
#pragma unroll
                    for (int n = 0; n < 2; ++n) acc[a][b][m][n] = zz1;
        cur = nxt; cA = nA; cB = nB; ++ui;
        cur.aux = ui & 1; if constexpr (HasPre<Epi>::value) E.pre(cur, wid, wc, lane);
#pragma unroll
        for (int h = 0; h < 2; ++h)
#pragma unroll
            for (int i = 0; i < 2; ++i) vA[0][h][i] = vA[1][h][i];
    }
    PG8_WAIT_V(0);
    if (wr == 0) PG8_BAR;
    PG8_BAR;
#undef PG8_SA
#undef PG8_SB
#undef PG8_STAGE
#undef PG8_LDA
#undef PG8_LDB
#undef PG8_MMA
#undef PG8_WAIT_V
#undef PG8_WAIT_L
#undef PG8_BAR
#undef PG8_SCHED
}
}
using pg8::Unit;

struct EpiZ {
    static constexpr bool PERM = true, MID = false;
    bf16_t* Z; bf16_t* KV; bf16_t* GFp; int pn0; float scale;
    __device__ __forceinline__ void operator()(const f32x4 (&acc)[2][2][4][2], const Unit& u, int wr, int wc, int fr, int fq) const {
        const bool kvu = u.pn >= 32; const int pn = (u.pn & 31) + (kvu ? 0 : pn0);
        bf16_t* base = kvu ? KV : Z; const int ldc = kvu ? 1024 : INC; const bool sg = (!kvu) && (pn >= C_GATE / 256);
        if (sg) {
            bf16_t* gf = GFp + ((size_t)(u.pm * 12 + (pn - C_GATE / 256)) * 16) * 4096 + (size_t)((wr * 4 + wc) * 64 + fq * 16 + fr) * 8;
#pragma unroll
            for (int ai = 0; ai < 2; ++ai)
#pragma unroll
                for (int m = 0; m < 4; ++m)
#pragma unroll
                    for (int bj = 0; bj < 2; ++bj) { f32x4 v0 = acc[ai][bj][m][0] * scale, v1 = acc[ai][bj][m][1] * scale;
#pragma unroll
                        for (int j = 0; j < 4; ++j) { v0[j] = sigmoidf_(v0[j]); v1[j] = sigmoidf_(v1[j]); }
                        u32x4 w; w.x = cvt_pk_bf16(v0[0], v0[1]); w.y = cvt_pk_bf16(v0[2], v0[3]); w.z = cvt_pk_bf16(v1[0], v1[1]); w.w = cvt_pk_bf16(v1[2], v1[3]);
                        *(u32x4*)(gf + (size_t)((ai * 4 + m) * 2 + bj) * 4096) = w; }
            return; }
        const int row0 = u.pm * 256 + wr * 64 + fr, col0 = pn * 256 + wc * 32 + 8 * fq;
#pragma unroll
        for (int ai = 0; ai < 2; ++ai)
#pragma unroll
            for (int m = 0; m < 4; ++m) { bf16_t* rowp = base + (size_t)(row0 + ai * 128 + m * 16) * ldc + col0;
#pragma unroll
                for (int bj = 0; bj < 2; ++bj) { f32x4 v0 = acc[ai][bj][m][0] * scale, v1 = acc[ai][bj][m][1] * scale;
                    if (sg) {
#pragma unroll
                        for (int j = 0; j < 4; ++j) { v0[j] = sigmoidf_(v0[j]); v1[j] = sigmoidf_(v1[j]); } }
                    u32x4 w; w.x = cvt_pk_bf16(v0[0], v0[1]); w.y = cvt_pk_bf16(v0[2], v0[3]); w.z = cvt_pk_bf16(v1[0], v1[1]); w.w = cvt_pk_bf16(v1[2], v1[3]);
                    *(u32x4*)(rowp + bj * 128) = w; } }
    }
};
struct SchedZ8 {
    static constexpr bool GATHER = false; __device__ __forceinline__ unsigned a_off(const Unit&, int, int, int, int) const { return 0u; }
    const char* H8; const char* WIN8; int G, c;
    __device__ __forceinline__ bool next(int i, Unit& u) const {
        const long L = (long)i * G + c; if (L >= 64 * 23) return false;
        pg8::static_map(L, 64, 23, u.pm, u.pn); u.tag = 0; u.pa = H8 + (size_t)u.pm * (256 * 1024); u.pb = WIN8 + (size_t)u.pn * (256 * 1024); return true;
    }
};
struct SchedZ {
    static constexpr bool GATHER = false; __device__ __forceinline__ unsigned a_off(const Unit&, int, int, int, int) const { return 0u; }
    const char* H; const char* WinT; const char* HM; const char* WmkvT; int G, c;
    __device__ __forceinline__ bool next(int i, Unit& u) const {
        const long L = (long)i * G + c; if (L >= 480) return false;
        const size_t tstep = (size_t)256 * 1024 * 2;
        if (L < 448) { pg8::static_map(L, 64, 7, u.pm, u.pn); u.tag = 0; u.pa = H + (size_t)u.pm * tstep; u.pb = WinT + (size_t)u.pn * tstep; }
        else { const int q = (int)(L - 448); u.pm = q >> 2; u.pn = 32 + (q & 3); u.tag = 0; u.pa = HM + (size_t)u.pm * tstep; u.pb = WmkvT + (size_t)(q & 3) * tstep; }
        return true;
    }
};
struct EpiLora {
    static constexpr bool PERM = false, MID = false;
    float* L; const float* w0; const float* a0;
    __device__ __forceinline__ void operator()(const f32x4 (&acc)[2][2][4][2], const Unit& u, int wr, int wc, int fr, int fq) const {
        const int row0 = u.pm * 256 + wr * 64 + fr, col0 = u.pn * 256 + wc * 32 + 4 * fq; const int kind = u.pn >> 1; const f32x4 zb = zero4f();
#pragma unroll
        for (int bj = 0; bj < 2; ++bj)
#pragma unroll
            for (int n = 0; n < 2; ++n) { const int c = col0 + bj * 128 + n * 16;
                f32x4 bv = zb;
                if (kind == 0) bv = *(const f32x4*)(w0 + c); else if (kind == 1) bv = *(const f32x4*)(a0 + (c - 512));
#pragma unroll
                for (int ai = 0; ai < 2; ++ai)
#pragma unroll
                    for (int m = 0; m < 4; ++m) { f32x4 v = acc[ai][bj][m][n] + bv;
                        if (kind == 0) {
#pragma unroll
                            for (int j = 0; j < 4; ++j) v[j] = -0.60653066f * sigmoidf_(v[j]); }
                        else if (kind == 1) {
#pragma unroll
                            for (int j = 0; j < 4; ++j) v[j] = sigmoidf_(v[j]); }
                        const size_t row = (size_t)(row0 + ai * 128 + m * 16);
                        if (kind == 0) *(f32x4*)(L + row * 512 + c) = v;
                        else { u32x2 w; w.x = cvt_pk_bf16(v[0], v[1]); w.y = cvt_pk_bf16(v[2], v[3]); *(u32x2*)((bf16_t*)(L + (size_t)NTOK * 512) + row * 1024 + (c - 512)) = w; } } }
    }
};
template <int mode> struct EpiMix {
    static constexpr bool PERM = false, MID = false;
    float* mix32; bf16_t* mixbf; const bf16_t* Z;
    __device__ __forceinline__ void operator()(const f32x4 (&acc)[2][2][4][2], const Unit& u, int wr, int wc, int fr, int fq) const {
        const int row0 = u.pm * 256 + wr * 64 + fr, col0 = u.pn * 256 + wc * 32 + 4 * fq;
#pragma unroll
        for (int ai = 0; ai < 2; ++ai)
#pragma unroll
            for (int m = 0; m < 4; ++m) { const size_t row = (size_t)(row0 + ai * 128 + m * 16);
#pragma unroll
                for (int bj = 0; bj < 2; ++bj)
#pragma unroll
                    for (int n = 0; n < 2; ++n) { const int c = col0 + bj * 128 + n * 16;
                        const u32x2 gz = *(const u32x2*)(Z + row * INC + C_GATE + mode * 1024 + c); float g[4]; unpack4(gz, g);
                        f32x4 v = acc[ai][bj][m][n]; v[0] *= g[0]; v[1] *= g[1]; v[2] *= g[2]; v[3] *= g[3];
                        if (mode > 0) v += *(const f32x4*)(mix32 + row * 1024 + c);
                        if (mode < 2) *(f32x4*)(mix32 + row * 1024 + c) = v;
                        else { u32x2 w; w.x = cvt_pk_bf16(v[0], v[1]); w.y = cvt_pk_bf16(v[2], v[3]); *(u32x2*)(mixbf + row * 1024 + c) = w; } }
                asm volatile("" ::: "memory"); }
    }
};
struct EpiMixCat {
    static constexpr bool PERM = true, MID = true;
    bf16_t* mixbf; const bf16_t* GF; int tid;
    __device__ __forceinline__ const bf16_t* gtile(const Unit& u, int b) const { return GF + ((size_t)(u.pm * 12 + 4 * b + u.pn) * 16) * 4096 + (size_t)tid * 8; }
    __device__ __forceinline__ void mid(f32x4 (&acc)[2][2][4][2], const Unit& u, int t, int wr, int wc, int fr, int fq) const {
        const int ga = (t == 8) ? 0 : 1; int off = 0; asm volatile("" : "+v"(off));
        const bf16_t* pa = gtile(u, ga) + off; const bf16_t* pb = gtile(u, ga + 1) + off;
#pragma unroll
        for (int ai = 0; ai < 2; ++ai) {
#pragma unroll
            for (int m = 0; m < 4; ++m)
#pragma unroll
                for (int bj = 0; bj < 2; ++bj) { float a[8], b[8]; unpack8(*(const u32x4*)(pa + (size_t)((ai * 4 + m) * 2 + bj) * 4096), a); unpack8(*(const u32x4*)(pb + (size_t)((ai * 4 + m) * 2 + bj) * 4096), b);
#pragma unroll
                    for (int j = 0; j < 4; ++j) { acc[ai][bj][m][0][j] *= a[j] * __builtin_amdgcn_rcpf(b[j]); acc[ai][bj][m][1][j] *= a[4 + j] * __builtin_amdgcn_rcpf(b[4 + j]); } }
            asm volatile("" ::: "memory"); }
    }
    __device__ __forceinline__ void operator()(const f32x4 (&acc)[2][2][4][2], const Unit& u, int wr, int wc, int fr, int fq) const {
        const int row0 = u.pm * 256 + wr * 64 + fr, col0 = u.pn * 256 + wc * 32 + 8 * fq; const bf16_t* pg = gtile(u, 2);
#pragma unroll
        for (int ai = 0; ai < 2; ++ai)
#pragma unroll
            for (int m = 0; m < 4; ++m) { bf16_t* rowp = mixbf + (size_t)(row0 + ai * 128 + m * 16) * 1024 + col0;
#pragma unroll
                for (int bj = 0; bj < 2; ++bj) { float g[8]; unpack8(*(const u32x4*)(pg + (size_t)((ai * 4 + m) * 2 + bj) * 4096), g);
                    const f32x4 v0 = acc[ai][bj][m][0], v1 = acc[ai][bj][m][1];
                    u32x4 w; w.x = cvt_pk_bf16(v0[0] * g[0], v0[1] * g[1]); w.y = cvt_pk_bf16(v0[2] * g[2], v0[3] * g[3]); w.z = cvt_pk_bf16(v1[0] * g[4], v1[1] * g[5]); w.w = cvt_pk_bf16(v1[2] * g[6], v1[3] * g[7]);
                    *(u32x4*)(rowp + bj * 128) = w; } }
    }
};
struct EpiX1 {
    static constexpr bool PERM = true, MID = false;
    const float* x; bf16_t* x1;
    __device__ __forceinline__ void operator()(const f32x4 (&acc)[2][2][4][2], const Unit& u, int wr, int wc, int fr, int fq) const {
        const int row0 = u.pm * 256 + wr * 64 + fr, col0 = u.pn * 256 + wc * 32 + 8 * fq;
#pragma unroll
        for (int ai = 0; ai < 2; ++ai)
#pragma unroll
            for (int m = 0; m < 4; ++m) { const size_t off = (size_t)(row0 + ai * 128 + m * 16) * 1024 + col0;
#pragma unroll
                for (int bj = 0; bj < 2; ++bj) { const f32x4 a = __builtin_nontemporal_load((const f32x4*)(x + off + bj * 128)) + acc[ai][bj][m][0], b = __builtin_nontemporal_load((const f32x4*)(x + off + bj * 128 + 4)) + acc[ai][bj][m][1];
                    u32x4 w; w.x = cvt_pk_bf16(a[0], a[1]); w.y = cvt_pk_bf16(a[2], a[3]); w.z = cvt_pk_bf16(b[0], b[1]); w.w = cvt_pk_bf16(b[2], b[3]);
                    *(u32x4*)(x1 + off + bj * 128) = w; }
                if (m & 1) asm volatile("" ::: "memory"); }
    }
};
struct EpiSwiglu {
    static constexpr bool PERM = true, MID = false;
    static constexpr bool PRE = true;
    unsigned char* act; const float* b1; LAS unsigned char* lds;
    __device__ __forceinline__ void pre(const Unit& u, int wid, int wc, int lane) const {
        __builtin_amdgcn_global_load_lds((const unsigned*)(b1 + (size_t)u.tag * 2048 + 256 * u.pn + 64 * wc + lane), (LAS unsigned*)(lds + 131072 + u.aux * 2048 + wid * 256), 4, 0, 0); }
    __device__ __forceinline__ void operator()(const f32x4 (&acc)[2][2][4][2], const Unit& u, int wr, int wc, int fr, int fq) const {
        const int row0 = u.pm * 256 + wr * 64 + fr; const LAS float* be = (const LAS float*)(lds + 131072 + u.aux * 2048 + (wr * 4 + wc) * 256) + 16 * fq; const int j = 128 * u.pn + 32 * wc + 8 * fq;
        constexpr float CS = -1.702f * 1.44269504f, ICS = 1.0f / CS;
        float bg[8], bl[8];
#pragma unroll
        for (int q = 0; q < 4; ++q) { const f32x4 t = *(const LAS f32x4*)(be + 4 * q); bg[2 * q] = t[0] * CS; bl[2 * q] = (4.0f * t[1] + 4.0f) * ICS; bg[2 * q + 1] = t[2] * CS; bl[2 * q + 1] = (4.0f * t[3] + 4.0f) * ICS; }
#pragma unroll
        for (int ai = 0; ai < 2; ++ai)
#pragma unroll
            for (int m = 0; m < 4; ++m) { float o[8];
#pragma unroll
                for (int n = 0; n < 2; ++n)
#pragma unroll
                    for (int i = 0; i < 4; ++i) { const float sg = fmaxf(fmaf(acc[ai][0][m][n][i], CS / 256.0f, bg[4 * n + i]), 7.0f * CS);
                        const float ql = __builtin_amdgcn_fmed3f(fmaf(acc[ai][1][m][n][i], 4.0f * ICS / 256.0f, bl[4 * n + i]), -24.0f * ICS, 32.0f * ICS);
                        o[4 * n + i] = sg * __builtin_amdgcn_rcpf(1.0f + __builtin_amdgcn_exp2f(sg)) * ql; }
                u32x2 w; w.x = pack4_fp8(o[0], o[1], o[2], o[3]); w.y = pack4_fp8(o[4], o[5], o[6], o[7]);
                *(u32x2*)(act + (size_t)(row0 + ai * 128 + m * 16) * 1024 + j) = w; }
    }
};
struct EpiYs {
    static constexpr bool PERM = true, MID = false;
    static constexpr bool PRE = true;
    bf16_t* ys; const float* b2; LAS unsigned char* lds;
    __device__ __forceinline__ void pre(const Unit& u, int wid, int wc, int lane) const {
        __builtin_amdgcn_global_load_lds((const unsigned*)(b2 + (size_t)u.tag * 1024 + 256 * u.pn + (lane >> 5) * 128 + 32 * wc + (lane & 31)), (LAS unsigned*)(lds + 131072 + u.aux * 2048 + wid * 256), 4, 0, 0); }
    __device__ __forceinline__ void operator()(const f32x4 (&acc)[2][2][4][2], const Unit& u, int wr, int wc, int fr, int fq) const {
        const int row0 = u.pm * 256 + wr * 64 + fr, col0 = u.pn * 256 + wc * 32 + 8 * fq; const LAS float* be = (const LAS float*)(lds + 131072 + u.aux * 2048 + (wr * 4 + wc) * 256) + 8 * fq;
#pragma unroll
        for (int bj = 0; bj < 2; ++bj) { const f32x4 c0 = *(const LAS f32x4*)(be + bj * 32), c1 = *(const LAS f32x4*)(be + bj * 32 + 4);
#pragma unroll
            for (int ai = 0; ai < 2; ++ai)
#pragma unroll
                for (int m = 0; m < 4; ++m) { const f32x4 v0 = acc[ai][bj][m][0] * (1.0f / 128.0f) + c0, v1 = acc[ai][bj][m][1] * (1.0f / 128.0f) + c1;
                    u32x4 w; w.x = cvt_pk_bf16(v0[0], v0[1]); w.y = cvt_pk_bf16(v0[2], v0[3]); w.z = cvt_pk_bf16(v1[0], v1[1]); w.w = cvt_pk_bf16(v1[2], v1[3]);
                    *(u32x4*)(ys + (size_t)(row0 + ai * 128 + m * 16) * 1024 + col0 + bj * 128) = w; } }
    }
};
template <bool GATHER_> struct SchedMoe {
    static constexpr bool GATHER = GATHER_;
    const char* A; const char* Bt; const LAS int* tstart; const int* stok; int lgN, total; size_t estride, tbytes;
    __device__ __forceinline__ bool next(int i, Unit& u) const {
        const int c = blockIdx.x; const int un = i * 256 + (c & 7) * 32 + (c >> 3); if (un >= total) return false;
        const int mt = un >> lgN, pn = un & ((1 << lgN) - 1); const int e = ((const LAS unsigned char*)tstart)[(LX_TEXP - LX_TSTART) + mt];
        u.pm = mt; u.pn = pn; u.tag = e; u.pa = GATHER ? A : A + (size_t)mt * tbytes; u.pb = Bt + (size_t)e * estride + (size_t)pn * tbytes; return true;
    }
    __device__ __forceinline__ unsigned a_off(const Unit& u, int h, int R, int C, int rowbytes) const { const int e = u.tag, ps = u.pm * 256 + h * 128 + R - tstart[(LX_SBASE - LX_TSTART) / 4 + e];
        const int tok = ps < tstart[(LX_CNT - LX_TSTART) / 4 + e] ? stok[(size_t)e * NTOK + ps] : 0; return (unsigned)(tok * rowbytes + C * 2); }
};

__device__ __forceinline__ int w1perm(int c) { const int j = c >> 1, s = c & 1; return ((j >> 7) << 8) | (s << 7) | (j & 127); }
constexpr int NTILE = 13664, TAIL1_A = 6, TAIL1_B = 20, TAIL6 = 8, NRES1 = 32 * TAIL1_A + 32 * TAIL1_B, NRES = NRES1 + 128 * TAIL6;
template <class F> __device__ __forceinline__ void prep_tiles(const int wv, LAS unsigned char* lds, const int cnt, F tile_of) {
    KParams& p = *kparams();
    const int tid = opaque_tid(wv); unsigned char* ws = p.ws;
    LAS float* tile = (LAS float*)lds;
    if (cnt <= 0) return;
    struct TileJob { const float* src; bf16_t* dst; unsigned char* dst8; int K, N, perm, f8, ldd, k0, n0; };
    auto decode = [&](int t) -> TileJob { TileJob j; j.dst = nullptr; j.dst8 = nullptr; j.f8 = 0; j.perm = 0; j.ldd = 0; int lt;
        if (t < 960) { j.src = p.in[3]; j.dst = (bf16_t*)(ws + OFF_WINT); j.K = 1024; j.N = 7680; lt = t; if ((lt % 120) >= 28) { j.f8 = 1; j.dst8 = ws + OFF_WIN8 - (size_t)1792 * 1024; } }
        else if (t < 1088) { j.src = p.in[18]; j.dst = (bf16_t*)(ws + OFF_WMKVT); j.K = 1024; j.N = 1024; lt = t - 960; }
        else if (t < 1152) { j.src = p.in[21]; j.dst = (bf16_t*)(ws + OFF_PCAT); j.K = 512; j.N = 1024; lt = t - 1088; j.ldd = 1280; }
        else if (t < 1184) { j.src = p.in[22]; j.dst = (bf16_t*)(ws + OFF_PCAT) + 512; j.K = 256; j.N = 1024; lt = t - 1152; j.ldd = 1280; }
        else if (t < 1248) { j.src = p.in[23]; j.dst = (bf16_t*)(ws + OFF_PCAT) + 768; j.K = 512; j.N = 1024; lt = t - 1184; j.ldd = 1280; }
        else if (t < 1376) { j.src = p.in[24]; j.dst = (bf16_t*)(ws + OFF_WOT); j.K = 1024; j.N = 1024; lt = t - 1248; }
        else if (t < 9568) { const int q = t - 1376, e = q >> 8; j.src = p.in[28] + (size_t)e * 1024 * 2048; j.dst8 = ws + OFF_W1T + (size_t)e * 2048 * 1024; j.K = 1024; j.N = 2048; j.perm = 1; lt = q & 255; j.f8 = 1; }
        else { const int q = t - 9568, e = q >> 7; j.src = p.in[30] + (size_t)e * 1024 * 1024; j.dst8 = ws + OFF_W2T + (size_t)e * 1024 * 1024; j.K = 1024; j.N = 1024; lt = q & 127; j.f8 = 1; }
        const int tn = j.N >> 6; j.k0 = (lt / tn) * 128; j.n0 = (lt % tn) * 64; return j; };
    { auto ldtile = [&](const TileJob& j, f32x4 (&v)[4]) {
#pragma unroll
          for (int i = 0; i < 4; ++i) { const int idx = tid + 512 * i, row = idx >> 4, c4 = idx & 15; v[i] = __builtin_nontemporal_load((const f32x4*)(j.src + (size_t)(j.k0 + row) * j.N + j.n0 + 4 * c4)); } };
      TileJob j0 = decode(tile_of(0)), j1 = decode(tile_of(cnt > 1 ? 1 : 0)); f32x4 v0[4], v1[4];
      ldtile(j0, v0);
      if (cnt > 1) ldtile(j1, v1);
      for (int n = 0; n < cnt; ++n) {
#pragma unroll
          for (int i = 0; i < 4; ++i) { const int idx = tid + 512 * i, row = idx >> 4, c4 = idx & 15; LAS float* tp = tile + row * 65 + 4 * c4; tp[0] = v0[i][0]; tp[1] = v0[i][1]; tp[2] = v0[i][2]; tp[3] = v0[i][3]; }
          __syncthreads();
          const TileJob cur = j0; j0 = j1;
#pragma unroll
          for (int i = 0; i < 4; ++i) v0[i] = v1[i];
          if (n + 2 < cnt) { j1 = decode(tile_of(n + 2)); ldtile(j1, v1); }
          if (!cur.f8) {
#pragma unroll
              for (int i = 0; i < 2; ++i) { const int kc = (tid & 3) | (((tid >> 8) & 1) << 2) | (i << 3), n = (tid >> 2) & 63; float f[8];
#pragma unroll
                  for (int j = 0; j < 8; ++j) f[j] = tile[(kc * 8 + j) * 65 + n];
                  const int drow = cur.n0 + n;
                  *(u32x4*)(cur.dst + (size_t)drow * (cur.ldd ? cur.ldd : cur.K) + cur.k0 + kc * 8) = pack8(f); }
          } else {
              const int kc = (tid & 3) | (((tid >> 8) & 1) << 2), n = (tid >> 2) & 63; float f[16];
#pragma unroll
              for (int j = 0; j < 16; ++j) f[j] = tile[(kc * 16 + j) * 65 + n] * 32.0f;
              const int drow = cur.perm ? w1perm(cur.n0 + n) : (cur.n0 + n);
              u32x4 w; w.x = pack4_fp8(f[0], f[1], f[2], f[3]); w.y = pack4_fp8(f[4], f[5], f[6], f[7]); w.z = pack4_fp8(f[8], f[9], f[10], f[11]); w.w = pack4_fp8(f[12], f[13], f[14], f[15]);
              *(u32x4*)(cur.dst8 + (size_t)drow * cur.K + cur.k0 + kc * 16) = w; }
          __syncthreads(); } }
}
__device__ __forceinline__ void phase_prep(const int wv, LAS unsigned char* lds) {
    KParams& p = *kparams();
    const int tid = opaque_tid(wv); unsigned char* ws = p.ws;
    { const int G = (int)gridDim.x, top = NTILE - NRES - 1 - (int)blockIdx.x; prep_tiles(wv, lds, top >= 0 ? top / G + 1 : 0, [&](int n) { return top - n * G; }); }
    { const float* w2 = p.in[6]; const float* a2 = p.in[8]; const float* g2 = p.in[9]; bf16_t* lt = (bf16_t*)(ws + OFF_LORAT);
      for (int idx = blockIdx.x * 512 + tid; idx < 1536 * 32; idx += gridDim.x * 512) { const int n = idx >> 5, kc = idx & 31; float f[8];
#pragma unroll
          for (int j = 0; j < 8; ++j) { const int k = kc * 8 + j; float val = 0.f;
              if (n < 512) { if (k < 64) val = w2[k * 512 + n]; }
              else if (n < 1024) { if (k >= 64 && k < 128) val = a2[(k - 64) * 512 + (n - 512)]; }
              else { if (k >= 128) val = g2[(k - 128) * 512 + (n - 1024)]; }
              f[j] = val; }
          *(u32x4*)(lt + (size_t)n * 256 + kc * 8) = pack8(f); } }
    { const float* wr = p.in[26]; bf16_t* wt = (bf16_t*)(ws + OFF_WRT);
      for (int idx = blockIdx.x * 512 + tid; idx < 32 * 1024; idx += gridDim.x * 512) { const int e = idx >> 10, k = idx & 1023; const float v = wr[k * 32 + e];
          const unsigned hi = cvt_pk_bf16(v, 0.f) & 0xffffu; const float vh = __uint_as_float(hi << 16); const unsigned lo = cvt_pk_bf16(v - vh, 0.f) & 0xffffu;
          wt[idx] = (bf16_t)hi; wt[32768 + idx] = (bf16_t)lo; } }
    { const int wid = tid >> 6, lane = tid & 63; const int gw = blockIdx.x * 8 + wid, nw = gridDim.x * 8;
      for (int row0 = gw; row0 < NTOK + 2048; row0 += 3 * nw) {
          f32x4 v[3][4];
#pragma unroll
          for (int r3 = 0; r3 < 3; ++r3) { const int row = row0 + r3 * nw; if (row < NTOK + 2048) { const float* src = row >= NTOK ? p.in[1] + (size_t)(row - NTOK) * 1024 : p.in[0] + (size_t)row * 1024;
#pragma unroll
              for (int i = 0; i < 4; ++i) v[r3][i] = __builtin_nontemporal_load((const f32x4*)(src + 4 * lane + 256 * i)); } }
#pragma unroll
          for (int r3 = 0; r3 < 3; ++r3) { const int row = row0 + r3 * nw; if (row >= NTOK + 2048) break;
              const bool ism = row >= NTOK; const float* gain = ism ? p.in[17] : p.in[2]; bf16_t* dst = ism ? (bf16_t*)(ws + OFF_HM) + (size_t)(row - NTOK) * 1024 : (bf16_t*)(ws + OFF_H) + (size_t)row * 1024;
              float ss = 0.f;
#pragma unroll
              for (int i = 0; i < 4; ++i) ss += v[r3][i][0] * v[r3][i][0] + v[r3][i][1] * v[r3][i][1] + v[r3][i][2] * v[r3][i][2] + v[r3][i][3] * v[r3][i][3];
              ss = red64(ss); const float rs = rsqrtf(ss * (1.0f / 1024.0f) + 1e-5f);
#pragma unroll
              for (int i = 0; i < 4; ++i) { const f32x4 g = *(const f32x4*)(gain + 4 * lane + 256 * i); const f32x4 y = v[r3][i] * rs * g;
                  u32x2 w; w.x = cvt_pk_bf16(y[0], y[1]); w.y = cvt_pk_bf16(y[2], y[3]);
                  *(u32x2*)(dst + 4 * lane + 256 * i) = w;
                  if (!ism) *(unsigned*)(ws + OFF_H8 + (size_t)row * 1024 + 4 * lane + 256 * i) = pack4_fp8(y[0] * 8.0f, y[1] * 8.0f, y[2] * 8.0f, y[3] * 8.0f); } } }
    }
}

__device__ __forceinline__ void phase_elem_c(const int wv) {
    KParams& p = *kparams();
    const int gt = blockIdx.x * 512 + opaque_tid(wv), nthr = gridDim.x * 512; unsigned char* ws = p.ws;
    bf16_t* Z = (bf16_t*)(ws + OFF_Z); bf16_t* AL = (bf16_t*)(ws + OFF_ALORA); bf16_t* KV = (bf16_t*)(ws + OFF_KV);
    const float* mu = p.in[4];
    u32x4 za[4], zb[4]; const u32x4 zq0 = zero4u();
#pragma unroll
    for (int k = 0; k < 4; ++k) { const int idx = gt + k * nthr, t = idx >> 5, ch = idx & 31, col = C_ZW + 8 * ch;
        za[k] = *(const u32x4*)(Z + (size_t)t * INC + col);
        zb[k] = zq0; if ((t & (SEQ - 1)) != 0) zb[k] = *(const u32x4*)(Z + (size_t)(t - 1) * INC + col); }
#pragma unroll
    for (int k = 0; k < 4; ++k) { const int idx = gt + k * nthr, t = idx >> 5, ch = idx & 31, col = C_ZW + 8 * ch;
        float a[8], b[8]; unpack8(za[k], a); unpack8(zb[k], b);
        const f32x4 m0 = *(const f32x4*)(mu + col), m1 = *(const f32x4*)(mu + col + 4); const float mm[8] = {m0[0], m0[1], m0[2], m0[3], m1[0], m1[1], m1[2], m1[3]};
#pragma unroll
        for (int j = 0; j < 8; ++j) { float v = a[j] + (b[j] - a[j]) * mm[j]; if (ch < 8) v = tanhf(v); else if (ch >= 16) v = sigmoidf_(v); a[j] = v; }
        *(u32x4*)(AL + (size_t)t * 256 + 8 * ch) = pack8(a); }
}

__device__ __forceinline__ bf16x8 pack_frag(const f32x4 lo, const f32x4 hi) { u32x4 w; w.x = cvt_pk_bf16(lo[0], lo[1]); w.y = cvt_pk_bf16(lo[2], lo[3]); w.z = cvt_pk_bf16(hi[0], hi[1]); w.w = cvt_pk_bf16(hi[2], hi[3]); bf16x8 r; __builtin_memcpy(&r, &w, 16); return r; }
__device__ __forceinline__ bf16x8 tr2(LAS unsigned char* pa, LAS unsigned char* pb) { const s16x4 a = __builtin_amdgcn_ds_read_tr16_b64_v4i16((LAS s16x4*)pa), b = __builtin_amdgcn_ds_read_tr16_b64_v4i16((LAS s16x4*)pb); return __builtin_shufflevector(a, b, 0, 1, 2, 3, 4, 5, 6, 7); }
__device__ __forceinline__ bf16x8 rd2(LAS unsigned char* pa, LAS unsigned char* pb) { const s16x4 a = *(const LAS s16x4*)pa, b = *(const LAS s16x4*)pb; return __builtin_shufflevector(a, b, 0, 1, 2, 3, 4, 5, 6, 7); }
#define MFMA16(a, b, c) __builtin_amdgcn_mfma_f32_16x16x32_bf16((a), (b), (c), 0, 0, 0)
constexpr int CP_XA = 0, CP_XR = 4096, CP_XB = 8192, CP_XK = 12288, CP_VL = 16384, CP_NL = 16384, CP_WAVE = 20480;
__device__ __forceinline__ void phase_chunk_pre(const int wv, LAS unsigned char* lds) {
    KParams& p = *kparams();
    const int tid = opaque_tid(wv), wid = tid >> 6, lane = tid & 63, fr = lane & 15, fq = lane >> 4; unsigned char* ws = p.ws;
    if (tid == 0) { *(u32x4*)(ws + OFF_CTL + CTL_KEEP + blockIdx.x * 16) = *(const LAS u32x4*)(lds + LDS_X); asm volatile("s_waitcnt vmcnt(0)" ::: "memory"); }
    __syncthreads();
    LAS unsigned char* wl = lds + wid * CP_WAVE;
    const bf16_t* Z = (const bf16_t*)(ws + OFF_Z); bf16_t* C1 = (bf16_t*)(ws + OFF_C1); bf16_t* C2 = (bf16_t*)(ws + OFF_C2);
    const float* mu = p.in[4]; const float* k_k = p.in[10]; const float* k_a = p.in[11]; const float* r_k = p.in[12]; const float* ln_w = p.in[13]; const float* ln_b = p.in[14];
    const f32x4 z4 = zero4f();
    const bf16_t* LT = (const bf16_t*)(ws + OFF_LORAT); const float* w0v = p.in[5]; const float* a0v = p.in[7];
    bf16_t* AL = (bf16_t*)(ws + OFF_ALORA);
    { int tida = tid; asm volatile("" : "+v"(tida));
      for (int un = blockIdx.x; un < 512; un += gridDim.x) { const int tok0 = (un >> 6) * SEQ + (un & 63) * 32; const int t = tok0 + (tida >> 4); u32x4 za[2], zb[2]; const u32x4 zq0 = zero4u();
#pragma unroll
          for (int g2 = 0; g2 < 2; ++g2) { const int col = C_ZW + 8 * ((tida & 15) * 2 + g2); za[g2] = *(const u32x4*)(Z + (size_t)t * INC + col);
              zb[g2] = zq0; if ((t & (SEQ - 1)) != 0) zb[g2] = *(const u32x4*)(Z + (size_t)(t - 1) * INC + col); }
#pragma unroll
          for (int g2 = 0; g2 < 2; ++g2) { const int ch = (tida & 15) * 2 + g2, col = C_ZW + 8 * ch; float a[8], b[8]; unpack8(za[g2], a); unpack8(zb[g2], b);
              const f32x4 m0 = *(const f32x4*)(mu + col), m1 = *(const f32x4*)(mu + col + 4); const float mm[8] = {m0[0], m0[1], m0[2], m0[3], m1[0], m1[1], m1[2], m1[3]};
#pragma unroll
              for (int j = 0; j < 8; ++j) { float v = a[j] + (b[j] - a[j]) * mm[j]; if (ch < 8) v = 1.0f - 2.0f * __builtin_amdgcn_rcpf(1.0f + __builtin_amdgcn_exp2f(2.88539008f * v)); else if (ch >= 16) v = sigmoidf_(v); a[j] = v; }
              *(u32x4*)(AL + (size_t)t * 256 + 8 * ch) = pack8(a); } }
      asm volatile("s_waitcnt vmcnt(0)" ::: "memory");
      __syncthreads(); }
    for (int un = blockIdx.x; un < 512; un += gridDim.x) {
        const int b_ = un >> 6, cc = un & 63, h_ = wid; const int pr = ((b_ * 8 + h_) << 6) | cc; const int tok0 = b_ * SEQ + cc * 32;
        float gamC;
        int tidl = tid; asm volatile("" : "+v"(tidl));
        { const int fr = tidl & 15, fq = (tidl >> 4) & 3;
          bf16x8 wfa[16], tfa[8];
          float bw[4], ba[4];
#pragma unroll
          for (int mt = 0; mt < 4; ++mt) { bw[mt] = w0v[h_ * 64 + 16 * mt + fr]; ba[mt] = a0v[h_ * 64 + 16 * mt + fr]; }
#pragma unroll
          for (int kind = 0; kind < 2; ++kind)
#pragma unroll
              for (int ks = 0; ks < 2; ++ks) {
#pragma unroll
                  for (int nt = 0; nt < 2; ++nt) tfa[(kind * 2 + ks) * 2 + nt] = *(const bf16x8*)(AL + (size_t)(tok0 + 16 * nt + fr) * 256 + kind * 64 + 32 * ks + 8 * fq);
#pragma unroll
                  for (int mt = 0; mt < 4; ++mt) wfa[(kind * 2 + ks) * 4 + mt] = *(const bf16x8*)(LT + (size_t)(kind * 512 + h_ * 64 + 16 * mt + fr) * 256 + kind * 64 + 32 * ks + 8 * fq); }
          bf16x8 wfg[16], tfg[8];
#pragma unroll
          for (int kind = 0; kind < 3; ++kind) { const int nks = kind == 2 ? 4 : 2;
              if (kind == 1) { asm volatile("" ::: "memory");
#pragma unroll
                  for (int ks = 0; ks < 4; ++ks) {
#pragma unroll
                      for (int nt = 0; nt < 2; ++nt) tfg[ks * 2 + nt] = *(const bf16x8*)(AL + (size_t)(tok0 + 16 * nt + fr) * 256 + 128 + 32 * ks + 8 * fq);
#pragma unroll
                      for (int mt = 0; mt < 4; ++mt) wfg[ks * 4 + mt] = *(const bf16x8*)(LT + (size_t)(1024 + h_ * 64 + 16 * mt + fr) * 256 + 128 + 32 * ks + 8 * fq); }
                  asm volatile("" ::: "memory"); }
              f32x4 acc[4][2];
#pragma unroll
              for (int mt = 0; mt < 4; ++mt) { acc[mt][0] = z4; acc[mt][1] = z4; }
#pragma unroll
              for (int ks = 0; ks < nks; ++ks) { const bf16x8 tf0 = kind == 2 ? tfg[ks * 2] : tfa[(kind * 2 + ks) * 2], tf1 = kind == 2 ? tfg[ks * 2 + 1] : tfa[(kind * 2 + ks) * 2 + 1];
#pragma unroll
                  for (int mt = 0; mt < 4; ++mt) { const bf16x8 wf = kind == 2 ? wfg[ks * 4 + mt] : wfa[(kind * 2 + ks) * 4 + mt];
                      acc[mt][0] = MFMA16(tf0, wf, acc[mt][0]); acc[mt][1] = MFMA16(tf1, wf, acc[mt][1]); } }
#pragma unroll
              for (int mt = 0; mt < 4; ++mt) { const int ch = 16 * mt + fr; const float bv = kind == 0 ? bw[mt] : (kind == 1 ? ba[mt] : 0.f);
#pragma unroll
                  for (int nt = 0; nt < 2; ++nt) { f32x4 v = acc[mt][nt] + bv; LAS unsigned char* dst = wl + ch * 64 + (16 * nt + 4 * fq) * 2;
                      if (kind == 0) { float hf[4];
#pragma unroll
                          for (int j = 0; j < 4; ++j) v[j] = -0.60653066f * sigmoidf_(v[j]);
                          u32x2 hi; hi.x = cvt_pk_bf16(v[0], v[1]); hi.y = cvt_pk_bf16(v[2], v[3]);
                          hf[0] = v[0] - __uint_as_float(hi.x << 16); hf[1] = v[1] - __uint_as_float(hi.x & 0xffff0000u); hf[2] = v[2] - __uint_as_float(hi.y << 16); hf[3] = v[3] - __uint_as_float(hi.y & 0xffff0000u);
                          u32x2 lo; lo.x = cvt_pk_bf16(hf[0], hf[1]); lo.y = cvt_pk_bf16(hf[2], hf[3]);
                          *(LAS u32x2*)(dst + CP_XR) = hi; *(LAS u32x2*)(dst + CP_XB) = lo; }
                      else { if (kind == 1) {
#pragma unroll
                              for (int j = 0; j < 4; ++j) v[j] = sigmoidf_(v[j]); }
                          u32x2 w; w.x = cvt_pk_bf16(v[0], v[1]); w.y = cvt_pk_bf16(v[2], v[3]); *(LAS u32x2*)(dst + (kind == 1 ? CP_XK : CP_XA)) = w; } } } }
          asm volatile("s_waitcnt lgkmcnt(0)" ::: "memory"); }
        { const int c = h_ * 64 + (tidl & 63);
          const bf16_t* zp = Z + (size_t)tok0 * INC + c;
          const float mur = mu[c], muk = mu[C_K + c], muv = mu[C_V + c], kk_ = k_k[c], ka_ = k_a[c], rk_ = r_k[c], lnw = ln_w[c], lnb = ln_b[c];
          float pzr = 0.f, pzk = 0.f, pzv = 0.f;
          if (cc != 0) { pzr = __uint_as_float((unsigned)zp[-INC] << 16); pzk = __uint_as_float((unsigned)zp[-INC + C_K] << 16); pzv = __uint_as_float((unsigned)zp[-INC + C_V] << 16); }
          unsigned short zq[2][4][3]; u32x2 sq[2][4];
#pragma unroll
          for (int e = 0; e < 4; ++e) {
#pragma unroll
              for (int q = 0; q < 3; ++q) zq[0][e][q] = zp[(size_t)e * INC + q * 512]; }
#pragma unroll
          for (int r = 0; r < 4; ++r) sq[0][r] = *(const LAS u32x2*)(wl + r * 4096 + lane * 64);
          __builtin_amdgcn_sched_barrier(0);
          float cs = 0.f, g = 1.0f;
#pragma unroll
          for (int t4 = 0; t4 < 8; ++t4) { unsigned pa[2], pr_[2], pb[2], pk[2];
              if (t4 < 7) {
#pragma unroll
                  for (int e = 0; e < 4; ++e) {
#pragma unroll
                      for (int q = 0; q < 3; ++q) zq[(t4 + 1) & 1][e][q] = zp[(size_t)((t4 + 1) * 4 + e) * INC + q * 512]; }
#pragma unroll
                  for (int r = 0; r < 4; ++r) sq[(t4 + 1) & 1][r] = *(const LAS u32x2*)(wl + r * 4096 + lane * 64 + (t4 + 1) * 8); }
              __builtin_amdgcn_sched_barrier(0);
#pragma unroll
              for (int tp = 0; tp < 2; ++tp) { float va[2], vr[2], vb[2], vk[2];
#pragma unroll
                  for (int e = 0; e < 2; ++e) { const int te = tp * 2 + e, t = t4 * 4 + te;
                      const float zr = __uint_as_float((unsigned)zq[t4 & 1][te][0] << 16), zk = __uint_as_float((unsigned)zq[t4 & 1][te][1] << 16), zv = __uint_as_float((unsigned)zq[t4 & 1][te][2] << 16);
                      const float r = zr + (pzr - zr) * mur, k = zk + (pzk - zk) * muk, v = zv + (pzv - zv) * muv; pzr = zr; pzk = zk; pzv = zv;
                      const unsigned wg = sq[t4 & 1][0][te >> 1], wh = sq[t4 & 1][1][te >> 1], wlo = sq[t4 & 1][2][te >> 1], wa = sq[t4 & 1][3][te >> 1];
                      const float lw = __uint_as_float((te & 1) ? (wh & 0xffff0000u) : (wh << 16)) + __uint_as_float((te & 1) ? (wlo & 0xffff0000u) : (wlo << 16));
                      const float al = __uint_as_float((te & 1) ? (wa & 0xffff0000u) : (wa << 16)), gg = __uint_as_float((te & 1) ? (wg & 0xffff0000u) : (wg << 16));
                      const float kk = k * kk_, kp = k * (1.0f + (al - 1.0f) * ka_);
                      const float n2 = red64(kk * kk), bon = red64(r * kp * rk_);
                      const float kn = kk * __builtin_amdgcn_rsqf(fmaxf(n2, 1e-24f));
                      const float gm1 = g; cs += lw; g = __builtin_amdgcn_exp2f(cs * 1.44269504f); const float gi = __builtin_amdgcn_rcpf(g);
                      va[e] = -kn * gm1; vb[e] = kn * al * gi; vk[e] = kp * gi; vr[e] = r * g;
                      *(LAS bf16_t*)(wl + CP_VL + t * 128 + lane * 2) = (bf16_t)(cvt_pk_bf16(v, 0.f) & 0xffffu);
                      const size_t to = (size_t)(tok0 + t) * 512 + c;
                      C1[to] = (bf16_t)(cvt_pk_bf16(lnw * gg, 0.f) & 0xffffu); C2[to] = (bf16_t)(cvt_pk_bf16((lnb + bon * v) * gg, 0.f) & 0xffffu); }
                  pa[tp] = cvt_pk_bf16(va[0], va[1]); pr_[tp] = cvt_pk_bf16(vr[0], vr[1]); pb[tp] = cvt_pk_bf16(vb[0], vb[1]); pk[tp] = cvt_pk_bf16(vk[0], vk[1]); }
              *(LAS u32x2*)(wl + CP_XA + lane * 64 + t4 * 8) = (u32x2){pa[0], pa[1]}; *(LAS u32x2*)(wl + CP_XR + lane * 64 + t4 * 8) = (u32x2){pr_[0], pr_[1]};
              *(LAS u32x2*)(wl + CP_XB + lane * 64 + t4 * 8) = (u32x2){pb[0], pb[1]}; *(LAS u32x2*)(wl + CP_XK + lane * 64 + t4 * 8) = (u32x2){pk[0], pk[1]};
              __builtin_amdgcn_sched_barrier(0); }
          gamC = g; }
        asm volatile("s_waitcnt lgkmcnt(0)" ::: "memory");
        bf16x8 Vf[4];
        { const int vtb = (4 * fq + (fr >> 2)) * 128 + (fr & 3) * 8;
#pragma unroll
          for (int nv = 0; nv < 4; ++nv) { LAS unsigned char* pp = wl + CP_VL + vtb + nv * 32; Vf[nv] = tr2(pp, pp + 2048); } }
        asm volatile("s_waitcnt lgkmcnt(0)" ::: "memory");
        const int trb = (8 * fq + (fr >> 2)) * 64 + (fr & 3) * 8;
        bf16x8 LakF[2], QrbF[2], QrkF[2];
#pragma unroll
        for (int yi = 0; yi < 2; ++yi) {
            bf16x8 fy[2][2];
#pragma unroll
            for (int nt = 0; nt < 2; ++nt)
#pragma unroll
                for (int s2 = 0; s2 < 2; ++s2) { LAS unsigned char* pp = wl + (yi ? CP_XR : CP_XA) + trb + s2 * 2048 + nt * 32; fy[nt][s2] = tr2(pp, pp + 256); }
#pragma unroll
            for (int xi = 0; xi < 2; ++xi) {
                f32x4 d[2][2];
#pragma unroll
                for (int mi = 0; mi < 2; ++mi) { bf16x8 fx[2];
#pragma unroll
                    for (int s2 = 0; s2 < 2; ++s2) { LAS unsigned char* pp = wl + (xi ? CP_XK : CP_XB) + trb + s2 * 2048 + mi * 32; fx[s2] = tr2(pp, pp + 256); }
#pragma unroll
                    for (int nt = 0; nt < 2; ++nt) {
                        if (mi == 1 && nt == 0) { d[mi][nt] = z4; continue; }
                        f32x4 acc = MFMA16(fx[0], fy[nt][0], z4); acc = MFMA16(fx[1], fy[nt][1], acc);
#pragma unroll
                        for (int j = 0; j < 4; ++j) { const int i = 16 * mi + 4 * fq + j, t = 16 * nt + fr; const bool ok = yi ? (i <= t) : (i < t); acc[j] = ok ? acc[j] : 0.f; }
                        d[mi][nt] = acc; } }
                if (yi == 0 && xi == 0) {
#pragma unroll
                    for (int mi = 0; mi < 2; ++mi)
#pragma unroll
                        for (int nt = 0; nt < 2; ++nt)
#pragma unroll
                            for (int j = 0; j < 4; ++j) *(LAS float*)(wl + CP_NL + ((16 * nt + fr) * 32 + 16 * mi + 4 * fq + j) * 4) = d[mi][nt][j];
                } else {
#pragma unroll
                    for (int nt = 0; nt < 2; ++nt) { const bf16x8 f = pack_frag(d[0][nt], d[1][nt]); if (yi == 0) LakF[nt] = f; else if (xi == 0) QrbF[nt] = f; else QrkF[nt] = f; } } } }
        asm volatile("s_waitcnt lgkmcnt(0)" ::: "memory");
        bf16x8 InvF[2];
        { const int c = lane & 31; float X[32];
#pragma unroll
          for (int t = 0; t < 32; ++t) { float a0 = (t == c) ? 1.0f : 0.f, a1 = 0.f;
#pragma unroll
              for (int i4 = 0; i4 < (t + 3) / 4; ++i4) { const f32x4 nv = *(const LAS f32x4*)(wl + CP_NL + (t * 32 + 4 * i4) * 4);
#pragma unroll
                  for (int e = 0; e < 4; ++e) if (4 * i4 + e < t) { if (e & 1) a1 = fmaf(nv[e], X[4 * i4 + e], a1); else a0 = fmaf(nv[e], X[4 * i4 + e], a0); } }
              X[t] = a0 + a1; }
          asm volatile("s_waitcnt lgkmcnt(0)" ::: "memory");
#pragma unroll
          for (int t = 0; t < 32; ++t) *(LAS float*)(wl + CP_NL + (t * 32 + c) * 4) = X[t];
          asm volatile("s_waitcnt lgkmcnt(0)" ::: "memory");
#pragma unroll
          for (int n = 0; n < 2; ++n) { const f32x4 lo = *(const LAS f32x4*)(wl + CP_NL + ((16 * n + fr) * 32 + 4 * fq) * 4), hi = *(const LAS f32x4*)(wl + CP_NL + ((16 * n + fr) * 32 + 16 + 4 * fq) * 4); InvF[n] = pack_frag(lo, hi); } }
        bf16x8 UF[4], AhF[4];
#pragma unroll
        for (int nv = 0; nv < 4; ++nv) { const f32x4 w0 = MFMA16(LakF[0], Vf[nv], z4), w1 = MFMA16(LakF[1], Vf[nv], z4); const bf16x8 wf = pack_frag(w0, w1);
            const f32x4 u0 = MFMA16(InvF[0], wf, z4), u1 = MFMA16(InvF[1], wf, z4); UF[nv] = pack_frag(u0, u1); }
#pragma unroll
        for (int nc = 0; nc < 4; ++nc) { LAS unsigned char* pp = wl + CP_XA + (16 * nc + fr) * 64 + 8 * fq; const bf16x8 af = rd2(pp, pp + 32);
            const f32x4 h0 = MFMA16(InvF[0], af, z4), h1 = MFMA16(InvF[1], af, z4); AhF[nc] = pack_frag(h0, h1); }
        { f32x4 rt[4][2];
#pragma unroll
          for (int mc = 0; mc < 4; ++mc)
#pragma unroll
              for (int nt = 0; nt < 2; ++nt) { const s16x4 rr = __builtin_amdgcn_ds_read_tr16_b64_v4i16((LAS s16x4*)(wl + CP_XR + (16 * mc + 4 * fq + (fr >> 2)) * 64 + (fr & 3) * 8 + nt * 32));
                  f32x4 cin; cin[0] = __uint_as_float((unsigned)(unsigned short)rr[0] << 16); cin[1] = __uint_as_float((unsigned)(unsigned short)rr[1] << 16); cin[2] = __uint_as_float((unsigned)(unsigned short)rr[2] << 16); cin[3] = __uint_as_float((unsigned)(unsigned short)rr[3] << 16);
                  rt[mc][nt] = MFMA16(AhF[mc], QrbF[nt], cin); }
          bf16x8* RTF = (bf16x8*)(ws + OFF_RTF) + (size_t)pr * 256;
#pragma unroll
          for (int nt = 0; nt < 2; ++nt)
#pragma unroll
              for (int s2 = 0; s2 < 2; ++s2) RTF[(nt * 2 + s2) * 64 + lane] = pack_frag(rt[2 * s2][nt], rt[2 * s2 + 1][nt]); }
        { u32x2* YLF = (u32x2*)(ws + OFF_YLF) + (size_t)pr * 512;
#pragma unroll
          for (int nv = 0; nv < 4; ++nv)
#pragma unroll
              for (int mt = 0; mt < 2; ++mt) { f32x4 y = MFMA16(QrbF[mt], UF[nv], z4); y = MFMA16(QrkF[mt], Vf[nv], y);
                  u32x2 w; w.x = cvt_pk_bf16(y[0], y[1]); w.y = cvt_pk_bf16(y[2], y[3]); YLF[(nv * 2 + mt) * 64 + lane] = w; } }
        { bf16x8* GTF = (bf16x8*)(ws + OFF_GTF) + (size_t)pr * 512; u32x2* HHF = (u32x2*)(ws + OFF_HHF) + (size_t)pr * 1024;
#pragma unroll
          for (int nc = 0; nc < 4; ++nc) { LAS unsigned char* pp = wl + CP_XB + (16 * nc + fr) * 64 + 8 * fq; const bf16x8 bf_ = rd2(pp, pp + 32);
              LAS unsigned char* pk = wl + CP_XK + (16 * nc + fr) * 64 + 8 * fq; const bf16x8 kf_ = rd2(pk, pk + 32);
              const float gcol = __int_as_float(__builtin_amdgcn_ds_bpermute((16 * nc + fr) << 2, __float_as_int(gamC)));
              f32x4 gt[4];
#pragma unroll
              for (int mc = 0; mc < 4; ++mc) { f32x4 a = MFMA16(AhF[mc], bf_, z4);
#pragma unroll
                  for (int j = 0; j < 4; ++j) { if (mc == nc && 4 * fq + j == fr) a[j] += 1.0f; a[j] *= gcol; }
                  gt[mc] = a; }
              GTF[(nc * 2 + 0) * 64 + lane] = pack_frag(gt[0], gt[1]); GTF[(nc * 2 + 1) * 64 + lane] = pack_frag(gt[2], gt[3]);
              f32x4 grow;
#pragma unroll
              for (int j = 0; j < 4; ++j) grow[j] = __int_as_float(__builtin_amdgcn_ds_bpermute((16 * nc + 4 * fq + j) << 2, __float_as_int(gamC)));
#pragma unroll
              for (int nv = 0; nv < 4; ++nv) { f32x4 hh = MFMA16(bf_, UF[nv], z4); hh = MFMA16(kf_, Vf[nv], hh); hh = hh * grow;
                  u32x2 w; w.x = cvt_pk_bf16(hh[0], hh[1]); w.y = cvt_pk_bf16(hh[2], hh[3]); HHF[(nv * 4 + nc) * 64 + lane] = w; } } }
        asm volatile("s_waitcnt lgkmcnt(0)" ::: "memory");
    }
    __syncthreads();
    if (tid == 0) *(LAS u32x4*)(lds + LDS_X) = *(const u32x4*)(ws + OFF_CTL + CTL_KEEP + blockIdx.x * 16);
}
__device__ __forceinline__ void phase_scan_seq(const int wv, LAS unsigned char* lds) {
    KParams& p = *kparams();
    const int tid = opaque_tid(wv), wid = __builtin_amdgcn_readfirstlane(tid >> 6), lane = tid & 63, fr = lane & 15, fq = lane >> 4; unsigned char* ws = p.ws;
    if (blockIdx.x >= 64) return;
    const int bh = blockIdx.x, b = bh >> 3, h = bh & 7;
    const char* gG = (const char*)(ws + OFF_GTF) + (size_t)bh * 64 * 8192; const char* gR = (const char*)(ws + OFF_RTF) + (size_t)bh * 64 * 4096;
    const char* gH = (const char*)(ws + OFF_HHF) + (size_t)bh * 64 * 8192; const char* gY = (const char*)(ws + OFF_YLF) + (size_t)bh * 64 * 4096;
    constexpr int SLOT = 24576;
    if (wid >= 4) {
        const int w = wid - 4;
        auto issue = [&](int c) { LAS unsigned char* slot = lds + (c % 5) * SLOT;
#pragma unroll
            for (int i = 0; i < 6; ++i) { const int pc = w + 4 * i;
                const char* src = pc < 8 ? gG + (size_t)c * 8192 + pc * 1024 : pc < 12 ? gR + (size_t)c * 4096 + (pc - 8) * 1024 : pc < 20 ? gH + (size_t)c * 8192 + (pc - 12) * 1024 : gY + (size_t)c * 4096 + (pc - 20) * 1024;
                __builtin_amdgcn_global_load_lds((const unsigned*)(src + lane * 16), (LAS unsigned*)(slot + pc * 1024), 16, 0, 0); } };
        issue(0); issue(1); issue(2); issue(3);
        for (int c = 0; c < 64; ++c) {
            if (c < 60) asm volatile("s_waitcnt vmcnt(18)" ::: "memory"); else asm volatile("s_waitcnt vmcnt(0)" ::: "memory");
            __builtin_amdgcn_s_barrier();
            if (c + 4 < 64) issue(c + 4);
        }
        return; }
    const int nv = wid;
    float* Yraw = (float*)(ws + OFF_YRAW) + (size_t)b * SEQ * 512 + h * 64 + 16 * nv + fr;
    f32x4 T[4]; const f32x4 z4s = zero4f();
#pragma unroll
    for (int m = 0; m < 4; ++m) T[m] = z4s;
    for (int c = 0; c < 64; ++c) {
        __builtin_amdgcn_s_barrier();
        const LAS unsigned char* slot = lds + (c % 5) * SLOT + lane * 16;
        bf16x8 G[8], R[4]; u32x2 H[4], Y[2];
#pragma unroll
        for (int i = 0; i < 8; ++i) G[i] = *(const LAS bf16x8*)(slot + i * 1024);
#pragma unroll
        for (int i = 0; i < 4; ++i) R[i] = *(const LAS bf16x8*)(slot + 8192 + i * 1024);
#pragma unroll
        for (int i = 0; i < 4; ++i) H[i] = *(const LAS u32x2*)(lds + (c % 5) * SLOT + 12288 + (nv * 4 + i) * 512 + lane * 8);
#pragma unroll
        for (int i = 0; i < 2; ++i) Y[i] = *(const LAS u32x2*)(lds + (c % 5) * SLOT + 20480 + (nv * 2 + i) * 512 + lane * 8);
        const bf16x8 tf0 = pack_frag(T[0], T[1]), tf1 = pack_frag(T[2], T[3]);
#pragma unroll
        for (int nt = 0; nt < 2; ++nt) { f32x4 y; y[0] = bf_lo(Y[nt].x); y[1] = bf_hi(Y[nt].x); y[2] = bf_lo(Y[nt].y); y[3] = bf_hi(Y[nt].y);
            y = MFMA16(R[nt * 2], tf0, y); y = MFMA16(R[nt * 2 + 1], tf1, y);
#pragma unroll
            for (int j = 0; j < 4; ++j) Yraw[(size_t)(c * 32 + 16 * nt + 4 * fq + j) * 512] = y[j]; }
#pragma unroll
        for (int m = 0; m < 4; ++m) { f32x4 t; t[0] = bf_lo(H[m].x); t[1] = bf_hi(H[m].x); t[2] = bf_lo(H[m].y); t[3] = bf_hi(H[m].y);
            t = MFMA16(G[m * 2], tf0, t); t = MFMA16(G[m * 2 + 1], tf1, t); T[m] = t; }
        asm volatile("s_waitcnt lgkmcnt(0)" ::: "memory");
    }
}

__device__ __forceinline__ bf16x8 tr_pair(LAS unsigned char* pa, LAS unsigned char* pb, bool useB) {
    const s16x4 a = __builtin_amdgcn_ds_read_tr16_b64_v4i16((LAS s16x4*)pa);
    s16x4 b2 = (s16x4){0, 0, 0, 0};
    if (useB) b2 = __builtin_amdgcn_ds_read_tr16_b64_v4i16((LAS s16x4*)pb);
    return __builtin_shufflevector(a, b2, 0, 1, 2, 3, 4, 5, 6, 7);
}
__device__ __forceinline__ void phase_dil_attn(const int wv, LAS unsigned char* lds) {
    KParams& p = *kparams();
    const int tid = opaque_tid(wv), wid = tid >> 6, lane = tid & 63, fr = lane & 15, fq = lane >> 4; unsigned char* ws = p.ws;
    const bf16_t* Z = (const bf16_t*)(ws + OFF_Z); float* DILO = (float*)(ws + OFF_DILO); float* LSE = (float*)(ws + OFF_LSE);
    LAS unsigned char* kb = lds; LAS unsigned char* vb = lds + 32768; const float* qn = p.in[15]; const float* kn = p.in[16];
    float qkw[2][8];
#pragma unroll
    for (int ks = 0; ks < 2; ++ks)
#pragma unroll
        for (int j = 0; j < 8; ++j) qkw[ks][j] = qn[ks * 32 + 8 * fq + j] * kn[ks * 32 + 8 * fq + j];
    const bool seqwg = blockIdx.x < 64;
    const int ynd = ((int)blockIdx.x - 64) >> 3, ndil = ynd < 8 ? 5 : (ynd < 16 ? 8 : 7);
    const int u0 = seqwg ? 4 * (int)blockIdx.x : 256 + (int)blockIdx.x - 64, uend = seqwg ? 4 * (int)blockIdx.x + 4 : u0 + 192 * ndil, ustep = seqwg ? 1 : 192;
    auto umap = [&](int v) -> int { if (seqwg) return v; const int c2 = (int)blockIdx.x - 64, x = c2 & 7, y = c2 >> 3, i = (v - u0) / 192, k = i < 5 ? 24 * i + y : (y < 16 ? 120 + (y - 8) * 3 + (i - 5) : 144 + (y - 16) * 2 + (i - 5)); return 256 + (k >> 3) * 64 + 8 * x + (k & 7); };
    const int ki = tid >> 1, half = tid & 1;
    u32x4 kvA[4], vvA[4], qvA[2], kvB[4], vvB[4], qvB[2]; bool kvalidA = false, kvalidB = false;
    auto unit_load = [&](int uv, u32x4 (&kv)[4], u32x4 (&vv)[4], u32x4 (&qv)[2], bool& kvalid) { const int u = umap(uv);
        const int b = u / 192, rem = u % 192, hh = rem >> 4, qb = rem & 15, g = hh >> 2;
        const int dil = g == 0 ? 1 : (g == 1 ? 4 : 16), nbc = 16 / dil, r = qb / nbc, j0 = (qb % nbc) * 128;
        const bf16_t* Zb = Z + (size_t)b * SEQ * INC; const int kj = j0 - 128 + ki; kvalid = kj >= 0;
        { const bf16_t* rowp = Zb + (size_t)((kvalid ? kj : 0) * dil + r) * INC + hh * 64 + half * 32;
#pragma unroll
            for (int i = 0; i < 4; ++i) { kv[i] = *(const u32x4*)(rowp + C_DK + 8 * i); vv[i] = *(const u32x4*)(rowp + C_DV + 8 * i); } }
        const int tq = (j0 + 16 * wid + fr) * dil + r;
#pragma unroll
        for (int ks = 0; ks < 2; ++ks) qv[ks] = *(const u32x4*)(Zb + (size_t)tq * INC + C_DQ + hh * 64 + ks * 32 + 8 * fq); };
    auto do_unit = [&](const int uvv, u32x4 (&kv)[4], u32x4 (&vv)[4], u32x4 (&qv)[2], bool& kvalid) { const int u = umap(uvv); const int uv_ = uvv;
        const int b = u / 192, rem = u % 192, hh = rem >> 4, qb = rem & 15, g = hh >> 2, hg = hh & 3;
        const int dil = g == 0 ? 1 : (g == 1 ? 4 : 16), nbc = 16 / dil, r = qb / nbc, j0 = (qb % nbc) * 128;
        { if (kvalid) {
              float ss = sumsq8(kv[0]) + sumsq8(kv[1]) + sumsq8(kv[2]) + sumsq8(kv[3]); ss += dpp_f<0xB1>(ss);
              const float rs = rsqrtf(ss * (1.0f / 64.0f) + 1e-5f);
#pragma unroll
              for (int i = 0; i < 4; ++i) kv[i] = scale8s(kv[i], rs); }
          else { const u32x4 zu = zero4u();
#pragma unroll
              for (int i = 0; i < 4; ++i) { kv[i] = zu; vv[i] = zu; } }
#pragma unroll
          for (int i = 0; i < 4; ++i) { const int sw = (half * 4 + i) ^ (ki & 7); *(LAS u32x4*)(kb + ki * 128 + sw * 16) = kv[i]; *(LAS u32x4*)(vb + ki * 128 + sw * 16) = vv[i]; } }
        const int qi = 16 * wid + fr, tq = (j0 + qi) * dil + r;
        bf16x8 qf[2];
        { float ss = sumsq8(qv[0]) + sumsq8(qv[1]); ss += sxor(ss, 16); ss += sxor(ss, 32);
          const float rs = rsqrtf(ss * (1.0f / 64.0f) + 1e-5f) * 0.125f;
#pragma unroll
          for (int ks = 0; ks < 2; ++ks) { const u32x4 w = scale8r(qv[ks], rs, qkw[ks]); __builtin_memcpy(&qf[ks], &w, 16); } }
        __syncthreads();
        if (uv_ + 2 * ustep < uend) unit_load(uv_ + 2 * ustep, kv, vv, qv, kvalid);
        f32x4 st[9]; float mx = -1e30f; const f32x4 zq = zero4f();
        LAS unsigned char* kp0 = kb + (16 * wid + fr) * 128 + ((fq ^ (fr & 7)) << 4); LAS unsigned char* kp1 = kb + (16 * wid + fr) * 128 + (((4 + fq) ^ (fr & 7)) << 4);
#pragma unroll
        for (int ti = 0; ti < 9; ++ti) {
            const bf16x8 k0 = *(const LAS bf16x8*)(kp0 + ti * 2048), k1 = *(const LAS bf16x8*)(kp1 + ti * 2048);
            f32x4 s = __builtin_amdgcn_mfma_f32_16x16x32_bf16(k0, qf[0], zq, 0, 0, 0);
            s = __builtin_amdgcn_mfma_f32_16x16x32_bf16(k1, qf[1], s, 0, 0, 0);
#pragma unroll
            for (int j = 0; j < 4; ++j) { const int ki = 16 * (wid + ti) + 4 * fq + j, off = qi + 128 - ki; const bool ok = (off >= 0) && (off <= 128) && (j0 - 128 + ki >= 0);
                s[j] = ok ? s[j] : -1e30f; mx = fmaxf(mx, s[j]); }
            st[ti] = s; }
        mx = fmaxf(mx, sxor(mx, 16)); mx = fmaxf(mx, sxor(mx, 32));
        float den = 0.f;
#pragma unroll
        for (int ti = 0; ti < 9; ++ti)
#pragma unroll
            for (int j = 0; j < 4; ++j) { const float e = __builtin_amdgcn_exp2f((st[ti][j] - mx) * 1.44269504f); st[ti][j] = e; den += e; }
        den += sxor(den, 16); den += sxor(den, 32);
        f32x4 o[4];
#pragma unroll
        for (int dt = 0; dt < 4; ++dt) o[dt] = zq;
        const int q4 = fr >> 2, p4 = fr & 3; const int kl = 4 * fq + q4;
        LAS unsigned char* vp[4];
#pragma unroll
        for (int dt = 0; dt < 4; ++dt) vp[dt] = vb + (16 * wid + kl) * 128 + (((2 * dt + (p4 >> 1)) ^ (kl & 7)) << 4) + (p4 & 1) * 8;
#pragma unroll
        for (int pp = 0; pp < 5; ++pp) { const bool two = pp < 4; const int tA = 2 * pp, tB = two ? 2 * pp + 1 : 2 * pp;
            u32x4 pw; pw.x = cvt_pk_bf16(st[tA][0], st[tA][1]); pw.y = cvt_pk_bf16(st[tA][2], st[tA][3]);
            if (two) { pw.z = cvt_pk_bf16(st[tB][0], st[tB][1]); pw.w = cvt_pk_bf16(st[tB][2], st[tB][3]); } else { pw.z = 0u; pw.w = 0u; }
            bf16x8 pf; __builtin_memcpy(&pf, &pw, 16);
#pragma unroll
            for (int dt = 0; dt < 4; ++dt) { const bf16x8 vf = tr_pair(vp[dt] + tA * 2048, vp[dt] + tB * 2048, two);
                o[dt] = __builtin_amdgcn_mfma_f32_16x16x32_bf16(vf, pf, o[dt], 0, 0, 0); } }
        const float inv = __builtin_amdgcn_rcpf(den); const size_t ob = ((size_t)(g * NTOK + b * SEQ + tq) * 4 + hg);
#pragma unroll
        for (int dt = 0; dt < 4; ++dt) *(f32x4*)(DILO + ob * 64 + 16 * dt + 4 * fq) = o[dt] * inv;
        if (fq == 0) LSE[ob] = mx + __logf(den);
        __syncthreads();
    };
    if (u0 < uend) unit_load(u0, kvA, vvA, qvA, kvalidA);
    if (u0 + ustep < uend) unit_load(u0 + ustep, kvB, vvB, qvB, kvalidB);
    for (int u = u0; u < uend; u += 2 * ustep) {
        do_unit(u, kvA, vvA, qvA, kvalidA);
        if (u + ustep < uend) do_unit(u + ustep, kvB, vvB, qvB, kvalidB);
    }
}

__device__ __forceinline__ void phase_mem_attn(const int wv, LAS unsigned char* lds) {
    KParams& p = *kparams();
    const int tid = opaque_tid(wv), wid = tid >> 6, lane = tid & 63, fr = lane & 15, fq = lane >> 4; unsigned char* ws = p.ws;
    const bf16_t* Z = (const bf16_t*)(ws + OFF_Z); const bf16_t* KV = (const bf16_t*)(ws + OFF_KV); bf16_t* YM = (bf16_t*)(ws + OFF_YCAT) + 768;
    LAS unsigned char* kb = lds; LAS unsigned char* vb = lds + 65536; const float* mqn = p.in[19]; const float* mkn = p.in[20];
    if (blockIdx.x < 64) return;
    float mqk[4][8];
#pragma unroll
    for (int ks = 0; ks < 4; ++ks)
#pragma unroll
        for (int j = 0; j < 8; ++j) mqk[ks][j] = mqn[ks * 32 + 8 * fq + j] * mkn[ks * 32 + 8 * fq + j];
    for (int bhq = (int)blockIdx.x - 64; bhq < 256; bhq += (int)gridDim.x - 64) {
        const int bhm = bhq >> 3, b = bhm >> 2, hm = bhm & 3;
        { const int ki = tid >> 1, half = tid & 1; const bf16_t* rowp = KV + (size_t)(b * 256 + ki) * 1024 + hm * 128 + half * 64;
          u32x4 kv[8], vv[8];
#pragma unroll
          for (int i = 0; i < 8; ++i) { kv[i] = *(const u32x4*)(rowp + 8 * i); vv[i] = *(const u32x4*)(rowp + 512 + 8 * i); }
          { float ss = 0.f;
#pragma unroll
            for (int i = 0; i < 8; ++i) ss += sumsq8(kv[i]);
            ss += dpp_f<0xB1>(ss); const float rs = rsqrtf(ss * (1.0f / 128.0f) + 1e-5f);
#pragma unroll
            for (int i = 0; i < 8; ++i) kv[i] = scale8s(kv[i], rs); }
#pragma unroll
          for (int i = 0; i < 8; ++i) { const int sw = (half * 8 + i) ^ (ki & 15); *(LAS u32x4*)(kb + ki * 256 + sw * 16) = kv[i]; *(LAS u32x4*)(vb + ki * 256 + sw * 16) = vv[i]; } }
        __syncthreads();
        const int q4 = fr >> 2, p4 = fr & 3; const int kl = 4 * fq + q4;
        LAS unsigned char* kp[4]; LAS unsigned char* vp[8];
#pragma unroll
        for (int ks = 0; ks < 4; ++ks) kp[ks] = kb + fr * 256 + (((4 * ks + fq) ^ fr) << 4);
#pragma unroll
        for (int dt = 0; dt < 8; ++dt) vp[dt] = vb + kl * 256 + (((2 * dt + (p4 >> 1)) ^ kl) << 4) + (p4 & 1) * 8;
        for (int qq = 0; qq < 2; ++qq) { const int qblk = (bhq & 7) * 2 + qq; const int tq = b * SEQ + qblk * 128 + 16 * wid + fr;
            bf16x8 qf[4];
#pragma unroll
            for (int ks = 0; ks < 4; ++ks) qf[ks] = *(const bf16x8*)(Z + (size_t)tq * INC + C_MQ + hm * 128 + ks * 32 + 8 * fq);
            { u32x4 qv[4]; float ss = 0.f;
#pragma unroll
              for (int ks = 0; ks < 4; ++ks) { __builtin_memcpy(&qv[ks], &qf[ks], 16); ss += sumsq8(qv[ks]); }
              ss += sxor(ss, 16); ss += sxor(ss, 32); const float rs = rsqrtf(ss * (1.0f / 128.0f) + 1e-5f);
#pragma unroll
              for (int ks = 0; ks < 4; ++ks) { const u32x4 w = scale8r(qv[ks], rs, mqk[ks]); __builtin_memcpy(&qf[ks], &w, 16); } }
            f32x4 st[16]; float mx = -1e30f; const f32x4 zq = zero4f();
#pragma unroll
            for (int ti = 0; ti < 16; ++ti) { f32x4 s = zq;
#pragma unroll
                for (int ks = 0; ks < 4; ++ks) { const bf16x8 kf = *(const LAS bf16x8*)(kp[ks] + ti * 4096); s = __builtin_amdgcn_mfma_f32_16x16x32_bf16(kf, qf[ks], s, 0, 0, 0); }
#pragma unroll
                for (int j = 0; j < 4; ++j) mx = fmaxf(mx, s[j]);
                st[ti] = s; if (ti & 1) asm volatile("" ::: "memory"); }
            mx = fmaxf(mx, sxor(mx, 16)); mx = fmaxf(mx, sxor(mx, 32));
            const float sc = 0.08838834764831845f * 1.44269504f; float den = 0.f;
#pragma unroll
            for (int ti = 0; ti < 16; ++ti)
#pragma unroll
                for (int j = 0; j < 4; ++j) { const float e = __builtin_amdgcn_exp2f((st[ti][j] - mx) * sc); st[ti][j] = e; den += e; }
            den += sxor(den, 16); den += sxor(den, 32);
            f32x4 o[8];
#pragma unroll
            for (int dt = 0; dt < 8; ++dt) o[dt] = zq;
#pragma unroll
            for (int pp = 0; pp < 8; ++pp) { const int tA = 2 * pp, tB = 2 * pp + 1;
                u32x4 pw; pw.x = cvt_pk_bf16(st[tA][0], st[tA][1]); pw.y = cvt_pk_bf16(st[tA][2], st[tA][3]); pw.z = cvt_pk_bf16(st[tB][0], st[tB][1]); pw.w = cvt_pk_bf16(st[tB][2], st[tB][3]);
                bf16x8 pf; __builtin_memcpy(&pf, &pw, 16);
#pragma unroll
                for (int dt = 0; dt < 8; ++dt) { const bf16x8 vf = tr_pair(vp[dt] + tA * 4096, vp[dt] + tB * 4096, true);
                    o[dt] = __builtin_amdgcn_mfma_f32_16x16x32_bf16(vf, pf, o[dt], 0, 0, 0); } }
            const float inv = __builtin_amdgcn_rcpf(den);
#pragma unroll
            for (int dt = 0; dt < 8; ++dt) { u32x2 w; w.x = cvt_pk_bf16(o[dt][0] * inv, o[dt][1] * inv); w.y = cvt_pk_bf16(o[dt][2] * inv, o[dt][3] * inv);
                *(u32x2*)(YM + (size_t)tq * 1280 + hm * 128 + 16 * dt + 4 * fq) = w; } }
        __syncthreads();
    }
}

__device__ __forceinline__ void phase_post(const int wv) {
    KParams& p = *kparams();
    const int gt = blockIdx.x * 512 + opaque_tid(wv), nthr = gridDim.x * 512; unsigned char* ws = p.ws;
    const float* Yraw = (const float*)(ws + OFF_YRAW); const bf16_t* C1 = (const bf16_t*)(ws + OFF_C1); const bf16_t* C2 = (const bf16_t*)(ws + OFF_C2); bf16_t* YR = (bf16_t*)(ws + OFF_YCAT);
    for (int idx = gt; idx < NTOK * 128; idx += nthr) { const int t = idx >> 7, c = ((idx >> 4) & 7) * 64 + 4 * (idx & 15);
        const f32x4 y = *(const f32x4*)(Yraw + (size_t)t * 512 + c);
        const float mean = red16(y[0] + y[1] + y[2] + y[3]) * (1.0f / 64.0f);
        const f32x4 d = y - mean; const float var = red16(d[0] * d[0] + d[1] * d[1] + d[2] * d[2] + d[3] * d[3]) * (1.0f / 64.0f);
        const float rs = rsqrtf(var + 64.0f * 1e-5f);
        float c1[4], c2[4]; unpack4(*(const u32x2*)(C1 + (size_t)t * 512 + c), c1); unpack4(*(const u32x2*)(C2 + (size_t)t * 512 + c), c2);
        u32x2 w; w.x = cvt_pk_bf16(d[0] * rs * c1[0] + c2[0], d[1] * rs * c1[1] + c2[1]); w.y = cvt_pk_bf16(d[2] * rs * c1[2] + c2[2], d[3] * rs * c1[3] + c2[3]);
        *(u32x2*)(YR + (size_t)t * 1280 + c) = w; }
    const float* DILO = (const float*)(ws + OFF_DILO); const float* LSE = (const float*)(ws + OFF_LSE); bf16_t* YD = (bf16_t*)(ws + OFF_YCAT) + 512;
    for (int idx = gt; idx < NTOK * 64; idx += nthr) { const int t = idx >> 6, hg = (idx >> 4) & 3, q = idx & 15;
        const float l0 = LSE[(size_t)t * 4 + hg], l1 = LSE[((size_t)NTOK + t) * 4 + hg], l2 = LSE[((size_t)2 * NTOK + t) * 4 + hg];
        const float m = fmaxf(l0, fmaxf(l1, l2)); const float e0 = __expf(l0 - m), e1 = __expf(l1 - m), e2 = __expf(l2 - m); const float inv = __builtin_amdgcn_rcpf(e0 + e1 + e2);
        const f32x4 o0 = *(const f32x4*)(DILO + ((size_t)t * 4 + hg) * 64 + 4 * q), o1 = *(const f32x4*)(DILO + (((size_t)NTOK + t) * 4 + hg) * 64 + 4 * q), o2 = *(const f32x4*)(DILO + (((size_t)2 * NTOK + t) * 4 + hg) * 64 + 4 * q);
        const f32x4 o = (o0 * e0 + o1 * e1 + o2 * e2) * inv;
        u32x2 w; w.x = cvt_pk_bf16(o[0], o[1]); w.y = cvt_pk_bf16(o[2], o[3]); *(u32x2*)(YD + (size_t)t * 1280 + hg * 64 + 4 * q) = w; }
}

__device__ __forceinline__ void phase_router(const int wv, LAS unsigned char* lds, const bool real = true) {
    KParams& p = *kparams();
    const int tid = opaque_tid(wv), wid = tid >> 6, lane = tid & 63, fr = lane & 15, fq = lane >> 4; unsigned char* ws = p.ws;
    const bf16_t* X1 = (const bf16_t*)(ws + OFF_X1B); const float* ln2 = p.in[25]; const float* br = p.in[27]; const bf16_t* WRT = (const bf16_t*)(ws + OFF_WRT);
    unsigned char* XN2 = ws + OFF_XN2; int* TOPE = (int*)(ws + OFF_TOPE); float* TOPG = (float*)(ws + OFF_TOPG);
    LAS int* hist = (LAS int*)(lds + LX_HIST);
    LAS float* red = (LAS float*)lds;
    LAS float* part = (LAS float*)(lds + 1024);
    if (tid < 32) hist[tid] = 0;
    const int grp = wid >> 2, kq = wid & 3;
    int tek[2][4] = {{0, 0, 0, 0}, {0, 0, 0, 0}}, lrk[2][4] = {{0, 0, 0, 0}, {0, 0, 0, 0}};
    u32x4 xq[2][8];
#pragma unroll
    for (int rd = 0; rd < 2; ++rd) { const bf16_t* xp = X1 + (size_t)((blockIdx.x * 4 + rd * 2 + grp) * 16 + fr) * 1024 + kq * 256 + 8 * fq;
#pragma unroll
        for (int s2 = 0; s2 < 8; ++s2) xq[rd][s2] = __builtin_nontemporal_load((const u32x4*)(xp + 32 * s2)); }
#pragma unroll
    for (int rd = 0; rd < 2; ++rd) { const int t0 = (blockIdx.x * 4 + rd * 2 + grp) * 16;
        f32x4 xa[8], xb[8]; float ss = 0.f;
#pragma unroll
        for (int s2 = 0; s2 < 8; ++s2) { float f[8]; unpack8(xq[rd][s2], f); xa[s2] = (f32x4){f[0], f[1], f[2], f[3]}; xb[s2] = (f32x4){f[4], f[5], f[6], f[7]}; }
#pragma unroll
        for (int s2 = 0; s2 < 8; ++s2) ss += xa[s2][0] * xa[s2][0] + xa[s2][1] * xa[s2][1] + xa[s2][2] * xa[s2][2] + xa[s2][3] * xa[s2][3] + xb[s2][0] * xb[s2][0] + xb[s2][1] * xb[s2][1] + xb[s2][2] * xb[s2][2] + xb[s2][3] * xb[s2][3];
        ss += sxor(ss, 16); ss += sxor(ss, 32);
        __syncthreads();
        if (fq == 0) red[(grp * 4 + kq) * 16 + fr] = ss;
        __syncthreads();
        const float tot = red[(grp * 4 + 0) * 16 + fr] + red[(grp * 4 + 1) * 16 + fr] + red[(grp * 4 + 2) * 16 + fr] + red[(grp * 4 + 3) * 16 + fr];
        const float rs = rsqrtf(tot * (1.0f / 1024.0f) + 1e-5f);
        f32x4 acc[2]; acc[0] = zero4f(); acc[1] = acc[0];
#pragma unroll
        for (int s2 = 0; s2 < 8; ++s2) { const int k = kq * 256 + 32 * s2 + 8 * fq;
            const f32x4 g0 = *(const f32x4*)(ln2 + k), g1 = *(const f32x4*)(ln2 + k + 4);
            float xn[8]; xn[0] = xa[s2][0] * rs * g0[0]; xn[1] = xa[s2][1] * rs * g0[1]; xn[2] = xa[s2][2] * rs * g0[2]; xn[3] = xa[s2][3] * rs * g0[3];
            xn[4] = xb[s2][0] * rs * g1[0]; xn[5] = xb[s2][1] * rs * g1[1]; xn[6] = xb[s2][2] * rs * g1[2]; xn[7] = xb[s2][3] * rs * g1[3];
            const u32x4 hi = pack8(xn); float hf[8]; unpack8(hi, hf);
#pragma unroll
            for (int j = 0; j < 8; ++j) hf[j] = xn[j] - hf[j];
            const u32x4 lo = pack8(hf);
            { u32x2 q8; q8.x = pack4_fp8(xn[0] * 8.0f, xn[1] * 8.0f, xn[2] * 8.0f, xn[3] * 8.0f); q8.y = pack4_fp8(xn[4] * 8.0f, xn[5] * 8.0f, xn[6] * 8.0f, xn[7] * 8.0f); if (real) *(u32x2*)(XN2 + (size_t)(t0 + fr) * 1024 + k) = q8; }
            bf16x8 xh, xl; __builtin_memcpy(&xh, &hi, 16); __builtin_memcpy(&xl, &lo, 16);
#pragma unroll
            for (int m = 0; m < 2; ++m) { const bf16x8 wh = *(const bf16x8*)(WRT + (size_t)(16 * m + fr) * 1024 + k), wl = *(const bf16x8*)(WRT + 32768 + (size_t)(16 * m + fr) * 1024 + k);
                acc[m] = MFMA16(wh, xh, acc[m]); acc[m] = MFMA16(wh, xl, acc[m]); acc[m] = MFMA16(wl, xh, acc[m]); } }
#pragma unroll
        for (int m = 0; m < 2; ++m)
#pragma unroll
            for (int j = 0; j < 4; ++j) part[((grp * 4 + kq) * 32 + 16 * m + 4 * fq + j) * 16 + fr] = acc[m][j];
        __syncthreads();
        if (kq == 0) { float lg[8]; int le[8];
#pragma unroll
            for (int m = 0; m < 2; ++m)
#pragma unroll
                for (int j = 0; j < 4; ++j) { const int e = 16 * m + 4 * fq + j; le[m * 4 + j] = e;
                    lg[m * 4 + j] = part[((grp * 4 + 0) * 32 + e) * 16 + fr] + part[((grp * 4 + 1) * 32 + e) * 16 + fr] + part[((grp * 4 + 2) * 32 + e) * 16 + fr] + part[((grp * 4 + 3) * 32 + e) * 16 + fr] + br[e]; }
            float tv[4]; int te[4];
#pragma unroll
            for (int r = 0; r < 4; ++r) { float bv = lg[0]; int bi = le[0];
#pragma unroll
                for (int q = 1; q < 8; ++q) if (lg[q] > bv) { bv = lg[q]; bi = le[q]; }
#pragma unroll
                for (int sft = 16; sft < 64; sft <<= 1) { const float ov = sxor(bv, sft); const int oi = sxor(bi, sft); if (ov > bv || (ov == bv && oi < bi)) { bv = ov; bi = oi; } }
                tv[r] = bv; te[r] = bi;
#pragma unroll
                for (int q = 0; q < 8; ++q) if (le[q] == bi) lg[q] = -3.0e38f; }
            const float e1 = __expf(tv[1] - tv[0]), e2 = __expf(tv[2] - tv[0]), e3 = __expf(tv[3] - tv[0]); const float inv = 1.0f / (1.0f + e1 + e2 + e3);
            if (fq == 0 && real) { const int t = t0 + fr; *(int4*)(TOPE + (size_t)t * 4) = make_int4(te[0], te[1], te[2], te[3]); *(f32x4*)(TOPG + (size_t)t * 4) = (f32x4){inv, e1 * inv, e2 * inv, e3 * inv};
#pragma unroll
                for (int k = 0; k < 4; ++k) { tek[rd][k] = te[k]; lrk[rd][k] = atomicAdd((int*)&hist[te[k]], 1); } } }
    }
    LAS int* bbase = (LAS int*)(lds + LX_BBASE);
    __syncthreads();
    if (tid < 32) { const int hcount = hist[tid]; bbase[tid] = (hcount && real) ? atomicAdd((int*)(ws + OFF_CTL + CTL_CUR) + tid, hcount) : 0; }
    __syncthreads();
    if (kq == 0 && fq == 0 && real) { int* POS = (int*)(ws + OFF_POS); int* STOKE = (int*)(ws + OFF_STOKE);
#pragma unroll
        for (int rd = 0; rd < 2; ++rd) { const int t = (blockIdx.x * 4 + rd * 2 + grp) * 16 + fr; int ps[4];
#pragma unroll
            for (int k = 0; k < 4; ++k) { ps[k] = bbase[tek[rd][k]] + lrk[rd][k]; STOKE[(size_t)tek[rd][k] * NTOK + ps[k]] = t; }
            *(int4*)(POS + (size_t)t * 4) = make_int4(ps[0], ps[1], ps[2], ps[3]); } }
}

__device__ __forceinline__ void build_tables(const int wv, LAS unsigned char* lds) {
    KParams& p = *kparams();
    LAS int* ts = (LAS int*)(lds + LX_TSTART); LAS int* sb = (LAS int*)(lds + LX_SBASE); LAS int* cn = (LAS int*)(lds + LX_CNT);
    if (wv == 0) { const int l = lane_id(); int* gc = (int*)(p.ws + OFF_CTL + CTL_CUR);
        const int c = (l < 32) ? (int)__hip_atomic_load(gc + l, __ATOMIC_RELAXED, __HIP_MEMORY_SCOPE_AGENT) : 0; const int tl = (c + 255) >> 8; int v = tl;
#pragma unroll
        for (int d = 1; d < 32; d <<= 1) { const int o = __builtin_amdgcn_ds_bpermute((l - d) << 2, v); if (l >= d) v += o; }
        if (l < 32) { cn[l] = c; sb[l] = (v - tl) * 256; ts[l + 1] = v; if (l == 0) ts[0] = 0; } }
    __syncthreads();
    { const int tid = (wv << 6) | lane_id(); LAS unsigned char* te = (LAS unsigned char*)(lds + LX_TEXP); const int nt = ts[32];
      if (tid < nt) { int e = 0; while (e < 31 && tid >= ts[e + 1]) ++e; te[tid] = (unsigned char)e; } }
    __syncthreads();
}

__device__ __forceinline__ void phase_combine(const int wv, const bool real = true) {
    KParams& p = *kparams();
    const int tid = opaque_tid(wv), wid = tid >> 6, lane = tid & 63; unsigned char* ws = p.ws;
    const int* SLOT = (const int*)(ws + OFF_SLOT); const float* TOPG = (const float*)(ws + OFF_TOPG); const bf16_t* YS = (const bf16_t*)(ws + OFF_YS); const bf16_t* X1 = (const bf16_t*)(ws + OFF_X1B); float* out = p.out;
    for (int t0 = (blockIdx.x * 8 + wid) * 8; t0 < NTOK; t0 += gridDim.x * 64) {
        int4 sl[8]; f32x4 gg[8];
#pragma unroll
        for (int i = 0; i < 8; ++i) { sl[i] = *(const int4*)(SLOT + (size_t)(t0 + i) * 4); gg[i] = *(const f32x4*)(TOPG + (size_t)(t0 + i) * 4); }
#pragma unroll
        for (int i = 0; i < 8; ++i) { const int t = t0 + i; const int s4[4] = {sl[i].x, sl[i].y, sl[i].z, sl[i].w};
#pragma unroll
            for (int hf = 0; hf < 2; ++hf) { const int c = hf * 512 + 8 * lane; float acc[8];
                const u32x4 xv = __builtin_nontemporal_load((const u32x4*)(X1 + (size_t)t * 1024 + c));
                u32x4 yv[4];
#pragma unroll
                for (int k = 0; k < 4; ++k) yv[k] = __builtin_nontemporal_load((const u32x4*)(YS + (size_t)s4[k] * 1024 + c));
                unpack8(xv, acc);
#pragma unroll
                for (int k = 0; k < 4; ++k) { float f[8]; unpack8(yv[k], f);
#pragma unroll
                    for (int j = 0; j < 8; ++j) acc[j] = fmaf(gg[i][k], f[j], acc[j]); }
                float* dst = real ? out : (float*)(ws + OFF_ACT);
                *(f32x4*)(dst + (size_t)t * 1024 + c) = (f32x4){acc[0], acc[1], acc[2], acc[3]}; *(f32x4*)(dst + (size_t)t * 1024 + c + 4) = (f32x4){acc[4], acc[5], acc[6], acc[7]}; }
            if (i & 1) asm volatile("" ::: "memory"); }
    }
}

__global__ void __launch_bounds__(512, 2) mk_fwd(Params p) {
    extern __shared__ __attribute__((aligned(16))) unsigned char lds_raw[];
    LAS unsigned char* lds = (LAS unsigned char*)lds_raw;
    unsigned char* ws = p.ws;
    const int wv = __builtin_amdgcn_readfirstlane((int)threadIdx.x >> 6);
    const bool multi = (p.ph_hi - p.ph_lo) > 1;
    XcdBarrier xb; xb.bar = (unsigned*)(ws + OFF_CTL); xb.x = 0; xb.st = (volatile LAS unsigned*)(lds + LDS_X);
    if (multi) {
        if (wv == 0 && lane_id() == 0) { *(LAS u32x4*)(lds + LDS_X) = zero4u(); }
        __syncthreads();
        xb = xcd_barrier_post((unsigned*)(ws + OFF_CTL), (volatile LAS unsigned*)(lds + LDS_X), wv);
    }
#if MFMA_BENCH
    { const int l = lane_id(); unsigned h = (unsigned)l * 2654435761u ^ (unsigned)blockIdx.x * 40503u ^ (unsigned)wv * 977u;
      i32x8 a, b;
#pragma unroll
      for (int j = 0; j < 8; ++j) { h = h * 1664525u + 1013904223u; a[j] = (int)(MFMA_BENCH == 1 ? ((h & 0x00ff00ffu) | 0x3f003f00u) : ((h & 0x0f0f0f0fu) | 0x30303030u));
                                    h = h * 1664525u + 1013904223u; b[j] = (int)(MFMA_BENCH == 1 ? ((h & 0x00ff00ffu) | 0x3f003f00u) : ((h & 0x0f0f0f0fu) | 0x30303030u)); }
      f32x4 c[8]; const f32x4 z0 = zero4f();
#pragma unroll
      for (int j = 0; j < 8; ++j) c[j] = z0;
      const int one_scale = 0x7f7f7f7f;
#pragma clang loop unroll(disable)
      for (int it = 0; it < (MFMA_BENCH == 1 ? 1875 : 938); ++it) {
#pragma unroll
          for (int j = 0; j < 8; ++j) {
              if (MFMA_BENCH == 1) c[j] = (j & 1) ? __builtin_amdgcn_mfma_f32_16x16x32_bf16(pg8::half8<1>(a), pg8::half8<1>(b), c[j], 0, 0, 0) : __builtin_amdgcn_mfma_f32_16x16x32_bf16(pg8::half8<0>(a), pg8::half8<0>(b), c[j], 0, 0, 0);
              else asm volatile("v_mfma_scale_f32_16x16x128_f8f6f4 %0, %1, %2, %0, %3, %3 op_sel_hi:[0,0,0]" : "+v"(c[j]) : "v"(a), "v"(b), "v"(one_scale)); } }
      asm volatile("s_nop 15\n\ts_nop 15" ::: "memory");
      float sm = 0.f;
#pragma unroll
      for (int j = 0; j < 8; ++j) sm += c[j][0] + c[j][1] + c[j][2] + c[j][3];
      if (sm == 1.2345f) *(float*)(ws + OFF_CTL + 8192) = sm; }
#endif
    for (int ph = p.ph_lo; ph < p.ph_hi; ++ph) {
      if (ph == 2 || ph == 3 || ph == 10) continue;
      for (int rep = 0; rep < (((DBL_MASK >> ph) & 1) ? 2 : 1); ++rep) {
        KParams& q = *kparams(); unsigned char* ws = q.ws;
        switch (ph) {
        case 0: phase_prep(wv, lds); break;
        case 1: { { SchedZ S; S.H = (const char*)(ws + OFF_H); S.WinT = (const char*)(ws + OFF_WINT); S.HM = (const char*)(ws + OFF_HM); S.WmkvT = (const char*)(ws + OFF_WMKVT); S.G = gridDim.x; S.c = blockIdx.x;
                    EpiZ E; E.Z = (bf16_t*)(ws + OFF_Z); E.KV = (bf16_t*)(ws + OFF_KV); E.GFp = (bf16_t*)(ws + OFF_GF); E.pn0 = 0; E.scale = 1.0f; pg8::gemm_phase(wv, lds, 1024, S, E); }
                  { SchedZ8 S; S.H8 = (const char*)(ws + OFF_H8); S.WIN8 = (const char*)(ws + OFF_WIN8); S.G = gridDim.x; S.c = blockIdx.x;
                    EpiZ E; E.Z = (bf16_t*)(ws + OFF_Z); E.KV = (bf16_t*)(ws + OFF_KV); E.GFp = (bf16_t*)(ws + OFF_GF); E.pn0 = 7; E.scale = 1.0f / 256.0f; pg8::gemm_phase<EpiZ, SchedZ8, 1>(wv, lds, 1024, S, E); }
                  { const int c = blockIdx.x; if (c >= 192) { const int r0 = c < 224 ? (c - 192) * TAIL1_A : 32 * TAIL1_A + (c - 224) * TAIL1_B;
                        prep_tiles(wv, lds, c < 224 ? TAIL1_A : TAIL1_B, [&](int n) { return NTILE - NRES + r0 + n; }); } } } break;
        case 2: phase_elem_c(wv); break;
        case 3: { pg8::DenseOrder S; S.init(ws + OFF_ALORA, ws + OFF_LORAT, NTOK, 1536, 256); EpiLora E; E.L = (float*)(ws + OFF_L); E.w0 = q.in[5]; E.a0 = q.in[7]; pg8::gemm_phase(wv, lds, 256, S, E); } break;
        case 4: phase_chunk_pre(wv, lds); break;
        case 5: for (int r2 = 0; r2 < (((DBL_MASK >> 16) & 1) ? 2 : 1); ++r2) phase_scan_seq(wv, lds);
                for (int r2 = 0; r2 < (((DBL_MASK >> 17) & 1) ? 2 : 1); ++r2) phase_dil_attn(wv, lds);
                for (int r2 = 0; r2 < (((DBL_MASK >> 18) & 1) ? 2 : 1); ++r2) phase_mem_attn(wv, lds); break;
        case 6: phase_post(wv); break;
        case 7: { pg8::DenseOrder S; S.init(ws + OFF_YCAT, ws + OFF_PCAT, NTOK, 1024, 1280); EpiMixCat E; E.mixbf = (bf16_t*)(ws + OFF_MIXBF); E.GF = (const bf16_t*)(ws + OFF_GF); E.tid = (wv << 6) | lane_id(); pg8::gemm_phase(wv, lds, 1280, S, E); } break;
        case 8: { pg8::DenseOrder S; S.init(ws + OFF_MIXBF, ws + OFF_WOT, NTOK, 1024, 1024); EpiX1 E; E.x = q.in[0]; E.x1 = (bf16_t*)(ws + OFF_X1B); pg8::gemm_phase(wv, lds, 1024, S, E); } break;
        case 9: phase_router(wv, lds, rep + 1 == (((DBL_MASK >> ph) & 1) ? 2 : 1)); break;
        case 11: { build_tables(wv, lds);
                   { const int* TOPE = (const int*)(ws + OFF_TOPE); const int* POS = (const int*)(ws + OFF_POS); int* SLOT = (int*)(ws + OFF_SLOT); const LAS int* sb = (const LAS int*)(lds + LX_SBASE);
                     for (int i = blockIdx.x * 512 + ((wv << 6) | lane_id()); i < NTOK * 4; i += gridDim.x * 512) SLOT[i] = sb[TOPE[i]] + POS[i]; }
                   SchedMoe<true> S; S.A = (const char*)(ws + OFF_XN2); S.Bt = (const char*)(ws + OFF_W1T); S.tstart = (const LAS int*)(lds + LX_TSTART); S.stok = (const int*)(ws + OFF_STOKE); S.lgN = 3; S.total = S.tstart[32] * 8; S.estride = (size_t)2048 * 1024; S.tbytes = (size_t)256 * 1024;
                   EpiSwiglu E; E.act = ws + OFF_ACT; E.b1 = q.in[29]; E.lds = lds; pg8::gemm_phase<EpiSwiglu, SchedMoe<true>, 1>(wv, lds, 1024, S, E);
                   { const int c = blockIdx.x, rem = S.total & 255, nearly = rem ? 256 - rem : 0, j = ((c & 7) * 32 + (c >> 3)) - rem;
                     if (rem && j >= 0 && j < 128) prep_tiles(wv, lds, TAIL6, [&](int n) { return NTILE - NRES + NRES1 + n * 128 + j; });
                     const int m = 128 - (nearly < 128 ? nearly : 128);
                     if (m > 0) { const int nf = m * TAIL6, top = nf - 1 - c; prep_tiles(wv, lds, top >= 0 ? top / (int)gridDim.x + 1 : 0, [&](int n) { const int f = top - n * (int)gridDim.x; return NTILE - NRES + NRES1 + (f / m) * 128 + nearly + (f % m); }); } } } break;
        case 12: { build_tables(wv, lds); SchedMoe<false> S; S.A = (const char*)(ws + OFF_ACT); S.Bt = (const char*)(ws + OFF_W2T); S.tstart = (const LAS int*)(lds + LX_TSTART); S.stok = nullptr; S.lgN = 2; S.total = S.tstart[32] * 4; S.estride = (size_t)1024 * 1024; S.tbytes = (size_t)256 * 1024;
                   EpiYs E; E.ys = (bf16_t*)(ws + OFF_YS); E.b2 = q.in[31]; E.lds = lds; pg8::gemm_phase<EpiYs, SchedMoe<false>, 1>(wv, lds, 1024, S, E); } break;
        case 13: phase_combine(wv, rep + 1 == (((DBL_MASK >> ph) & 1) ? 2 : 1)); break;
        default: break;
        }
      }
        if (ph + 1 < p.ph_hi) xcd_barrier(xb, wv);
        if (((DBL_MASK >> 20) & 1) && ph == 3 && multi) for (int e = 0; e < 10; ++e) xcd_barrier(xb, wv);
    }
}

extern "C" void kernel_launch(void* const* d_in, const int* in_sizes, int n_in, void* d_out, int out_size, void* d_ws, size_t ws_size, hipStream_t stream) {
    static int ready = 0;
    if (ready == 0) {
        if (n_in != 32 || out_size != NTOK * 1024 || ws_size < WS_NEED) { fprintf(stderr, "kernel_launch: unexpected shapes (n_in %d, out %d, ws %zu < %zu)\n", n_in, out_size, ws_size, (size_t)WS_NEED); ready = -1; return; }
        if (hipFuncSetAttribute((const void*)mk_fwd, hipFuncAttributeMaxDynamicSharedMemorySize, LDS_BYTES) != hipSuccess) { fprintf(stderr, "kernel_launch: hipFuncSetAttribute failed\n"); ready = -1; return; }
        int per_cu = 0, dev = 0, cus = 0; hipGetDevice(&dev); hipDeviceGetAttribute(&cus, hipDeviceAttributeMultiprocessorCount, dev);
        hipOccupancyMaxActiveBlocksPerMultiprocessor(&per_cu, (const void*)mk_fwd, 512, LDS_BYTES);
        if (per_cu < 1 || cus < 256) { fprintf(stderr, "kernel_launch: occupancy %d blocks/CU on %d CUs; need >= 1 on 256\n", per_cu, cus); ready = -1; (void)hipGetLastError(); return; }
        ready = 1;
    }
    if (ready < 0) return;
    hipMemsetAsync((char*)d_ws + OFF_CTL, 0, CTL_BYTES, stream);
    Params p{};
    for (int i = 0; i < 32; ++i) p.in[i] = (const float*)d_in[i];
    p.out = (float*)d_out; p.ws = (unsigned char*)d_ws;
#if MK_N_LAUNCH_PER_PHASE
    for (int ph = 0; ph < NPHASE; ++ph) { p.ph_lo = ph; p.ph_hi = ph + 1; hipLaunchKernelGGL(mk_fwd, dim3(256), dim3(512), LDS_BYTES, stream, p); }
#else
    p.ph_lo = 0; p.ph_hi = NPHASE;
    void* args[] = {&p};
    hipError_t e = hipLaunchCooperativeKernel((const void*)mk_fwd, dim3(256), dim3(512), args, LDS_BYTES, stream);
    if (e != hipSuccess) fprintf(stderr, "cooperative launch failed: %s\n", hipGetErrorString(e));
#endif
}
```

```cpp
#include <hip/hip_runtime.h>
#include <cstdio>
#include <cstdint>

#define LAS __attribute__((address_space(3)))
typedef unsigned short bf16_t;
typedef short bf16x8 __attribute__((ext_vector_type(8)));
typedef short s16x4 __attribute__((ext_vector_type(4)));
typedef float f32x4 __attribute__((ext_vector_type(4)));
typedef float f32x2 __attribute__((ext_vector_type(2)));
typedef unsigned u32x4 __attribute__((ext_vector_type(4)));
typedef unsigned u32x2 __attribute__((ext_vector_type(2)));
typedef int i32x8 __attribute__((ext_vector_type(8)));
typedef int i32x4 __attribute__((ext_vector_type(4)));

#ifndef DBL_MASK
#define DBL_MASK 0
#endif
#ifndef MK_N_LAUNCH_PER_PHASE
#define MK_N_LAUNCH_PER_PHASE 0
#endif

constexpr int NTOK = 16384, SEQ = 2048, INC = 7680;
constexpr int C_K = 512, C_V = 1024, C_ZW = 1536, C_DQ = 1792, C_DK = 2560, C_DV = 3328, C_MQ = 4096, C_GATE = 4608;
constexpr int NPHASE = 14;
constexpr int NSLOT_MAX = 65536 + 32 * 256;

constexpr size_t MiB = 1ull << 20;
constexpr size_t OFF_CTL = 0;
constexpr size_t CTL_BYTES = 32768;
constexpr size_t CTL_CNT = 16384;
constexpr size_t CTL_CUR = 16384 + 256;
constexpr size_t CTL_KEEP = 20480;
constexpr size_t OFF_TOPE = 1 * MiB;
constexpr size_t OFF_TOPG = 1 * MiB + 262144;
constexpr size_t OFF_SLOT = 1 * MiB + 524288;
constexpr size_t OFF_STOK = 2 * MiB;
constexpr size_t OFF_WRT = 3 * MiB;
constexpr size_t OFF_WINT = 4 * MiB, OFF_WMKVT = 19 * MiB, OFF_LORAT = 21 * MiB, OFF_PRT = 22 * MiB, OFF_PDT = 23 * MiB, OFF_PMT = 24 * MiB, OFF_WOT = 25 * MiB;
constexpr size_t OFF_WIN8 = 8 * MiB;
constexpr size_t OFF_H8 = 539 * MiB;
constexpr size_t OFF_YCAT = 223 * MiB;
constexpr size_t OFF_PCAT = 22 * MiB;
constexpr size_t OFF_W1T = 27 * MiB, OFF_W2T = 155 * MiB, OFF_KV = 219 * MiB, OFF_YM = 223 * MiB, OFF_YR = 239 * MiB, OFF_YD = 255 * MiB, OFF_Z = 263 * MiB;
constexpr size_t OFF_H = 503 * MiB, OFF_HM = 535 * MiB, OFF_ALORA = 503 * MiB, OFF_L = 511 * MiB, OFF_REC = 607 * MiB;
constexpr size_t OFF_GF = OFF_REC;
constexpr size_t OFF_LW = OFF_REC + 64 * MiB;
constexpr size_t OFF_VB = OFF_REC + 96 * MiB;
constexpr size_t OFF_GTF = OFF_REC + 112 * MiB;
constexpr size_t OFF_RTF = OFF_REC + 144 * MiB;
constexpr size_t OFF_HHF = OFF_REC + 160 * MiB;
constexpr size_t OFF_YLF = OFF_REC + 192 * MiB;
constexpr size_t OFF_C1 = 816 * MiB, OFF_C2 = 832 * MiB, OFF_YRAW = 848 * MiB, OFF_DILO = 880 * MiB, OFF_LSE = 928 * MiB;
constexpr size_t OFF_MIX32 = 503 * MiB, OFF_MIXBF = 567 * MiB, OFF_XN2 = 503 * MiB, OFF_XS = 263 * MiB, OFF_ACT = 607 * MiB, OFF_YS = 407 * MiB;
constexpr size_t OFF_X1B = 263 * MiB;
constexpr size_t OFF_STOKE = 296 * MiB;
constexpr size_t OFF_POS = 2 * MiB;
constexpr size_t WS_NEED = 929 * MiB;

constexpr int LDS_BYTES = 160 * 1024;
constexpr int LDS_X = LDS_BYTES - 4096;
constexpr int LX_TSTART = LDS_X + 64;
constexpr int LX_SBASE = LDS_X + 256;
constexpr int LX_CNT = LDS_X + 512;
constexpr int LX_HIST = LDS_X + 768;
constexpr int LX_BBASE = LDS_X + 1024;
constexpr int LX_SLOTL = LDS_X + 2048;
constexpr int LX_TEXP = LDS_X + 3072;

struct Params { const float* in[32]; float* out; unsigned char* ws; int ph_lo, ph_hi; };
typedef const Params __attribute__((address_space(4))) KParams;
__device__ __forceinline__ KParams* kparams() { KParams* kp = (KParams*)__builtin_amdgcn_kernarg_segment_ptr(); asm volatile("" : "+s"(kp)); return kp; }

typedef __bf16 bf16x2_t __attribute__((ext_vector_type(2)));
__device__ __forceinline__ unsigned cvt_pk_bf16(float lo, float hi) { f32x2 v = {lo, hi}; bf16x2_t b = __builtin_convertvector(v, bf16x2_t); unsigned r; __builtin_memcpy(&r, &b, 4); return r; }
__device__ __forceinline__ unsigned pack4_fp8(float a, float b, float c, float d) { int r = __builtin_amdgcn_cvt_pk_fp8_f32(a, b, 0, false); r = __builtin_amdgcn_cvt_pk_fp8_f32(c, d, r, true); return (unsigned)r; }
__device__ __forceinline__ float bf_lo(unsigned u) { return __uint_as_float(u << 16); }
__device__ __forceinline__ float bf_hi(unsigned u) { return __uint_as_float(u & 0xffff0000u); }
__device__ __forceinline__ int lane_id() { int l; asm volatile("v_mbcnt_lo_u32_b32 %0, -1, 0\n\tv_mbcnt_hi_u32_b32 %0, -1, %0" : "=v"(l)); return l; }
__device__ __forceinline__ int sxor(int x, int m) { return __builtin_amdgcn_ds_bpermute((lane_id() ^ m) << 2, x); }
__device__ __forceinline__ float sxor(float x, int m) { return __int_as_float(__builtin_amdgcn_ds_bpermute((lane_id() ^ m) << 2, __float_as_int(x))); }
template <int CTRL> __device__ __forceinline__ float dpp_f(float x) { return __int_as_float(__builtin_amdgcn_update_dpp(0, __float_as_int(x), CTRL, 0xF, 0xF, true)); }
__device__ __forceinline__ float red4(float x) { x += dpp_f<0xB1>(x); x += dpp_f<0x4E>(x); return x; }
__device__ __forceinline__ float red8(float x) { x = red4(x); x += dpp_f<0x141>(x); return x; }
__device__ __forceinline__ float red16(float x) { x = red8(x); x += dpp_f<0x140>(x); return x; }
__device__ __forceinline__ float red64(float x) { x = red16(x); x += sxor(x, 16); x += sxor(x, 32); return x; }
__device__ __forceinline__ int opaque_tid(const int wv) { int t = (wv << 6) | lane_id(); asm volatile("" : "+v"(t)); return t; }
__device__ __forceinline__ f32x4 zero4f() { float z = 0.f; asm volatile("" : "+v"(z)); return (f32x4){z, z, z, z}; }
__device__ __forceinline__ u32x4 zero4u() { unsigned z = 0u; asm volatile("" : "+v"(z)); return (u32x4){z, z, z, z}; }
__device__ __forceinline__ float sigmoidf_(float x) { return __builtin_amdgcn_rcpf(1.0f + __builtin_amdgcn_exp2f(-1.44269504f * x)); }
__device__ __forceinline__ void unpack8(const u32x4 v, float (&f)[8]) { f[0] = bf_lo(v.x); f[1] = bf_hi(v.x); f[2] = bf_lo(v.y); f[3] = bf_hi(v.y); f[4] = bf_lo(v.z); f[5] = bf_hi(v.z); f[6] = bf_lo(v.w); f[7] = bf_hi(v.w); }
__device__ __forceinline__ u32x4 pack8(const float (&f)[8]) { u32x4 w; w.x = cvt_pk_bf16(f[0], f[1]); w.y = cvt_pk_bf16(f[2], f[3]); w.z = cvt_pk_bf16(f[4], f[5]); w.w = cvt_pk_bf16(f[6], f[7]); return w; }
__device__ __forceinline__ float sumsq8(const u32x4 v) { float f[8]; unpack8(v, f); float s = 0.f;
#pragma unroll
    for (int j = 0; j < 8; ++j) s += f[j] * f[j];
    return s; }
__device__ __forceinline__ u32x4 scale8(const u32x4 v, const float rs, const float* w) { float f[8]; unpack8(v, f); const f32x4 w0 = *(const f32x4*)w, w1 = *(const f32x4*)(w + 4);
    f[0] *= rs * w0[0]; f[1] *= rs * w0[1]; f[2] *= rs * w0[2]; f[3] *= rs * w0[3]; f[4] *= rs * w1[0]; f[5] *= rs * w1[1]; f[6] *= rs * w1[2]; f[7] *= rs * w1[3]; return pack8(f); }
__device__ __forceinline__ u32x4 scale8r(const u32x4 v, const float rs, const float (&w)[8]) { float f[8]; unpack8(v, f);
#pragma unroll
    for (int j = 0; j < 8; ++j) f[j] *= rs * w[j];
    return pack8(f); }
__device__ __forceinline__ u32x4 scale8s(const u32x4 v, const float rs) { float f[8]; unpack8(v, f);
#pragma unroll
    for (int j = 0; j < 8; ++j) f[j] *= rs;
    return pack8(f); }
__device__ __forceinline__ void unpack4(const u32x2 v, float (&f)[4]) { f[0] = bf_lo(v.x); f[1] = bf_hi(v.x); f[2] = bf_lo(v.y); f[3] = bf_hi(v.y); }

#define XB_TMO      128
#define XB_XCNT(j)  (256  + 64 * (j))
#define XB_XSUB(j)  (1280 + 64 * (j))
#define XB_XGEN(j)  (2304 + 64 * (j))
#define XB_TOP      3328
#define XB_TOPGEN   3392
#define XCD_BAR_WORDS 3456
#define XB_SPIN_CAP (1u << 22)
__device__ __forceinline__ unsigned xb_ld(unsigned* p)              { return __hip_atomic_load(p, __ATOMIC_RELAXED, __HIP_MEMORY_SCOPE_AGENT); }
__device__ __forceinline__ unsigned xb_add(unsigned* p, unsigned v) { return __hip_atomic_fetch_add(p, v, __ATOMIC_RELAXED, __HIP_MEMORY_SCOPE_AGENT); }
__device__ __forceinline__ unsigned xb_xcc_id() { return (unsigned)__builtin_amdgcn_s_getreg((3 << 11) | 20) & 0xFu; }
#define XB_SPIN(cond, bar) do { unsigned _sp = 0; while (cond) { __builtin_amdgcn_s_sleep(1); \
    if ((++_sp & 255u) == 0u) { if (xb_ld(&(bar)[XB_TMO])) break; if (_sp > XB_SPIN_CAP) { atomicAdd(&(bar)[XB_TMO], 1u); break; } } } } while (0)
struct XcdBarrier { unsigned* bar; unsigned x; volatile LAS unsigned* st; };
__device__ __forceinline__ XcdBarrier xcd_barrier_post(unsigned* bar, volatile LAS unsigned* st, const int wv) {
    XcdBarrier b; b.bar = bar; b.x = xb_xcc_id(); b.st = st;
    if (wv == 0 && lane_id() == 0) (void)xb_add(&bar[XB_XCNT(b.x)], 1u);
    return b;
}
__device__ __forceinline__ void xcd_barrier_complete(unsigned* bar, unsigned x, unsigned& nloc, unsigned& nx) {
    const unsigned G = gridDim.x * gridDim.y * gridDim.z;
    unsigned sum, cnt, mine, sp = 0u;
    for (;;) {
        sum = 0u; cnt = 0u; mine = 0u;
#pragma unroll
        for (unsigned j = 0; j < 16; ++j) { const unsigned c = xb_ld(&bar[XB_XCNT(j)]); sum += c; cnt += (c > 0u) ? 1u : 0u; mine = (j == x) ? c : mine; }
        if (sum == G) break;
        __builtin_amdgcn_s_sleep(1);
        if ((++sp & 255u) == 0u) { if (xb_ld(&bar[XB_TMO])) break; if (sp > XB_SPIN_CAP) { atomicAdd(&bar[XB_TMO], 1u); break; } }
    }
    nloc = mine > 0u ? mine : 1u; nx = cnt > 0u ? cnt : 1u;
}
__device__ __forceinline__ void xcd_barrier(const XcdBarrier& b, const int wv) {
    asm volatile("s_waitcnt vmcnt(0)" ::: "memory");
    __syncthreads();
    if (wv == 0 && lane_id() == 0) {
        unsigned* bar = b.bar;
        __builtin_amdgcn_s_waitcnt(0);
        unsigned nloc = b.st[0], nx = b.st[1];
        if (nloc == 0u) { xcd_barrier_complete(bar, b.x, nloc, nx); b.st[0] = nloc; b.st[1] = nx; }
        const unsigned old = xb_add(&bar[XB_XSUB(b.x)], 1u);
        const unsigned gen = old / nloc;
        if (old + 1u == (gen + 1u) * nloc) {
            __builtin_amdgcn_fence(__ATOMIC_RELEASE, "agent");
            asm volatile("s_waitcnt vmcnt(0)" ::: "memory");
            const unsigned og = xb_add(&bar[XB_TOP], 1u);
            const unsigned tg = og / nx;
            if (og + 1u == (tg + 1u) * nx) xb_add(&bar[XB_TOPGEN], 1u);
            else XB_SPIN(xb_ld(&bar[XB_TOPGEN]) == tg, bar);
            __builtin_amdgcn_fence(__ATOMIC_ACQUIRE, "agent");
            xb_add(&bar[XB_XGEN(b.x)], 1u);
            asm volatile("s_waitcnt vmcnt(0)" ::: "memory");
        } else {
            XB_SPIN(xb_ld(&bar[XB_XGEN(b.x)]) == gen, bar);
            __builtin_amdgcn_fence(__ATOMIC_ACQUIRE, "agent");
            asm volatile("s_waitcnt vmcnt(0)" ::: "memory");
        }
    }
    __syncthreads();
}

#ifndef MFMA_BENCH
#define MFMA_BENCH 0
#endif
#ifndef EDBL
#define EDBL 0
#endif
#ifndef KMODE
#define KMODE 0
#endif
#ifndef KDBL
#define KDBL 0
#endif
struct EpiSwiglu; struct EpiYs; struct EpiZ; struct EpiMixCat; struct EpiX1;
namespace pg8 {
constexpr int BM = 256, BK = 64, HALF = 128, HTB = HALF * BK * 2, STAGE_BYTES = 8 * HTB, NXCD = 8, WGM = 8;
__host__ __device__ __forceinline__ int lds_byte(int r, int c) { const int st = (r >> 4) * 2 + (c >> 5), rr = r & 15, cc = c & 31, ob = rr * 64 + cc * 2; return st * 1024 + (ob ^ (((ob >> 9) & 1) << 5)); }
__host__ __device__ __forceinline__ void stage_rc(int b, int& R, int& C) { const int st = b / 1024, sb = b % 1024, swz = sb ^ (((sb >> 9) & 1) << 5); R = (st >> 1) * 16 + swz / 64; C = (st & 1) * 32 + (swz % 64) / 2; }
__host__ __device__ __forceinline__ int perm32(int rho) { const int n = rho >> 4, i = rho & 15; return 8 * (i >> 2) + 4 * n + (i & 3); }
struct Unit { int pm, pn, tag, aux; const char* pa; const char* pb; };
template <class E, class = void> struct HasPre { static constexpr bool value = false; };
template <class E> struct HasPre<E, decltype((void)E::PRE)> { static constexpr bool value = true; };

__device__ __forceinline__ void static_map(long L, int nM, int nN, int& pm, int& pn) {
    const int nwg = nM * nN; int wgid = (int)L;
    { const int q = nwg / NXCD, r = nwg % NXCD, xcd = wgid % NXCD, off = wgid / NXCD; wgid = (xcd < r ? xcd * (q + 1) : r * (q + 1) + (xcd - r) * q) + off; }
    const int nig = WGM * nN, gid = wgid / nig, fm = gid * WGM, gsz = (nM - fm) < WGM ? (nM - fm) : WGM;
    pm = fm + ((wgid % nig) % gsz); pn = (wgid % nig) / gsz;
}
struct DenseOrder {
    static constexpr bool GATHER = false; __device__ __forceinline__ unsigned a_off(const Unit&, int, int, int, int) const { return 0u; }
    const char* A; const char* Bt; int nM, nN, G, c; size_t tstep;
    __device__ __forceinline__ void init(const void* A_, const void* Bt_, int M, int N, int K) { A = (const char*)A_; Bt = (const char*)Bt_; nM = M / BM; nN = N / BM; G = gridDim.x; c = blockIdx.x; tstep = (size_t)BM * K * 2; }
    __device__ __forceinline__ bool next(int i, Unit& u) const {
        const long L = (long)i * G + c; if (L >= (long)nM * nN) return false;
        static_map(L, nM, nN, u.pm, u.pn); u.tag = 0; u.pa = A + (size_t)u.pm * tstep; u.pb = Bt + (size_t)u.pn * tstep; return true;
    }
};

template <int H> __device__ __forceinline__ bf16x8 half8(const i32x8 v) { const i32x4 x = H ? __builtin_shufflevector(v, v, 4, 5, 6, 7) : __builtin_shufflevector(v, v, 0, 1, 2, 3); bf16x8 r; __builtin_memcpy(&r, &x, 16); return r; }
template <class Epi, class Sched, int ES = 2>
__device__ __forceinline__ void gemm_phase(const int wv, LAS unsigned char* lds, const int K, const Sched& S, const Epi& E) {
    int tid_ = (wv << 6) | lane_id(); asm volatile("" : "+v"(tid_));
    const int tid = tid_, wid = __builtin_amdgcn_readfirstlane(tid >> 6), lane = tid & 63, wr = wid >> 2, wc = wid & 3, fr = lane & 15, fq = lane >> 4;
    const int nt = K * ES / (BK * 2);
    unsigned voffA[2], voffB[2]; int RA[2], CA[2];
#pragma unroll
    for (int i = 0; i < 2; ++i) { int R, C; stage_rc(tid * 16 + i * 8192, R, C); const int Rb = Epi::PERM ? ((R & ~31) + perm32(R & 31)) : R; RA[i] = R; CA[i] = C;
        voffA[i] = (unsigned)(R * K * ES + C * 2); voffB[i] = (unsigned)(Rb * K * ES + C * 2); }
    unsigned vA[2][2][2];
    const size_t kstep = (size_t)(BK * 2);
    const size_t hstep = (size_t)HALF * K * ES;
    const unsigned ldsw = (unsigned)wid * 1024u;
    const int aoff = lds_byte(wr * 64 + fr, fq * 8), boff = lds_byte(wc * 32 + fr, fq * 8);
#define PG8_SA(b, h) (((b) * 2 + (h)) * HTB)
#define PG8_SB(b, h) ((4 + (b) * 2 + (h)) * HTB)
#define PG8_STAGE(bufoff, gbase, voff) do { _Pragma("unroll") for (int _i = 0; _i < 2; ++_i) \
        __builtin_amdgcn_global_load_lds((const unsigned*)((const char*)(gbase) + (voff)[_i]), (LAS unsigned*)(lds + (bufoff) + ldsw + _i * 8192), 16, 0, 0); } while (0)
#define PG8_LDA(dst, b, h) do { _Pragma("unroll") for (int m = 0; m < 4; ++m) { const i32x4 _lo = *(const LAS i32x4*)(lds + PG8_SA(b, h) + aoff + m * 2048), _hi = *(const LAS i32x4*)(lds + PG8_SA(b, h) + aoff + m * 2048 + 1024); dst[m] = __builtin_shufflevector(_lo, _hi, 0, 1, 2, 3, 4, 5, 6, 7); } } while (0)
#define PG8_LDB(dst, b, h) do { _Pragma("unroll") for (int n = 0; n < 2; ++n) { const i32x4 _lo = *(const LAS i32x4*)(lds + PG8_SB(b, h) + boff + n * 2048), _hi = *(const LAS i32x4*)(lds + PG8_SB(b, h) + boff + n * 2048 + 1024); dst[n] = __builtin_shufflevector(_lo, _hi, 0, 1, 2, 3, 4, 5, 6, 7); } } while (0)
#define PG8_MMA(ai, bj, At, Bt) do { __builtin_amdgcn_s_setprio(1); _Pragma("unroll") for (int m = 0; m < 4; ++m) _Pragma("unroll") for (int n = 0; n < 2; ++n) { \
        if (ES == 2) { acc[ai][bj][m][n] = __builtin_amdgcn_mfma_f32_16x16x32_bf16(half8<0>(Bt[n]), half8<0>(At[m]), acc[ai][bj][m][n], 0, 0, 0); \
                       acc[ai][bj][m][n] = __builtin_amdgcn_mfma_f32_16x16x32_bf16(half8<1>(Bt[n]), half8<1>(At[m]), acc[ai][bj][m][n], 0, 0, 0); } \
        else asm volatile("v_mfma_scale_f32_16x16x128_f8f6f4 %0, %1, %2, %0, %3, %3 op_sel_hi:[0,0,0]" : "+v"(acc[ai][bj][m][n]) : "v"(Bt[n]), "v"(At[m]), "v"(one_scale)); } \
        __builtin_amdgcn_s_setprio(0); } while (0)
#define PG8_WAIT_V(n) asm volatile("s_waitcnt vmcnt(" #n ")" ::: "memory")
#define PG8_WAIT_L(n) asm volatile("s_waitcnt lgkmcnt(" #n ")" ::: "memory")
#define PG8_BAR __builtin_amdgcn_s_barrier()
#define PG8_SCHED __builtin_amdgcn_sched_barrier(0)
    constexpr int kd = (KDBL == 1 && (__is_same(Epi, EpiSwiglu) || __is_same(Epi, EpiYs))) || (KDBL == 2 && __is_same(Epi, EpiZ)) || (KDBL == 3 && (__is_same(Epi, EpiMixCat) || __is_same(Epi, EpiX1))) ? 1 : 0;
    Unit cur, nxt; int ui = 0;
    if (!S.next(0, cur)) return;
    cur.aux = 0; if constexpr (HasPre<Epi>::value) E.pre(cur, wid, wc, lane);
    f32x4 acc[2][2][4][2]; const f32x4 zz0 = zero4f();
#pragma unroll
    for (int a = 0; a < 2; ++a)
#pragma unroll
        for (int b = 0; b < 2; ++b)
#pragma unroll
            for (int m = 0; m < 4; ++m)
#pragma unroll
                for (int n = 0; n < 2; ++n) acc[a][b][m][n] = zz0;
    i32x8 At[4], B0[2], B1[2];
    const int one_scale = 0x7f7f7f7f;
    const char* cA = cur.pa; const char* cB = cur.pb;
#pragma unroll
    for (int h = 0; h < 2; ++h)
#pragma unroll
        for (int i = 0; i < 2; ++i) vA[0][h][i] = Sched::GATHER ? S.a_off(cur, h, RA[i], CA[i], K * ES) : voffA[i] + (unsigned)(h * hstep);
    if constexpr (kd && KMODE == 1) { cA = S.A; cB = S.Bt;
#pragma unroll
        for (int h = 0; h < 2; ++h)
#pragma unroll
            for (int i = 0; i < 2; ++i) vA[0][h][i] = voffA[i] + (unsigned)(h * hstep); }
    PG8_STAGE(PG8_SB(0, 0), cB, voffB); PG8_STAGE(PG8_SA(0, 0), cA, vA[0][0]); PG8_STAGE(PG8_SB(0, 1), cB + hstep, voffB); PG8_STAGE(PG8_SA(0, 1), cA, vA[0][1]);
    if (wr == 1) PG8_BAR;
    PG8_WAIT_V(4); PG8_BAR;
    PG8_STAGE(PG8_SB(1, 0), cB + kstep, voffB); PG8_STAGE(PG8_SA(1, 0), cA + kstep, vA[0][0]); PG8_STAGE(PG8_SB(1, 1), cB + hstep + kstep, voffB);
    PG8_WAIT_V(6); PG8_BAR;
    for (;;) {
        const bool has_next = S.next((ui + 1) >> kd, nxt);
        const char* nA = has_next ? nxt.pa : cA; const char* nB = has_next ? nxt.pb : cB;
#pragma unroll
        for (int h = 0; h < 2; ++h)
#pragma unroll
            for (int i = 0; i < 2; ++i) vA[1][h][i] = has_next ? (Sched::GATHER ? S.a_off(nxt, h, RA[i], CA[i], K * ES) : voffA[i] + (unsigned)(h * hstep)) : vA[0][h][i];
        if constexpr (kd && KMODE == 1) { if (has_next && (ui & 1)) { nA = S.A; nB = S.Bt;
#pragma unroll
            for (int h = 0; h < 2; ++h)
#pragma unroll
                for (int i = 0; i < 2; ++i) vA[1][h][i] = voffA[i] + (unsigned)(h * hstep); } }
        const bool ld = !(kd && KMODE == 2 && !(ui & 1));
#pragma clang loop unroll(disable)
        for (int t = 0; t < nt; t += 2) {
            if constexpr (Epi::MID) { if (t == 8 || t == 12) E.mid(acc, cur, t, wr, wc, fr, fq); }
            const bool last = (t == nt - 2);
            const char* a1 = cA + (size_t)(t + 1) * kstep;
            const char* a2 = last ? nA : cA + (size_t)(t + 2) * kstep; const char* b2 = last ? nB : cB + (size_t)(t + 2) * kstep;
            const char* a3 = a2 + kstep; const char* b3 = b2 + kstep;
            unsigned w0[2], w1[2];
#pragma unroll
            for (int i = 0; i < 2; ++i) { w0[i] = vA[0][0][i]; w1[i] = vA[0][1][i]; }
            if (last) { asm volatile("" ::: "memory");
#pragma unroll
                for (int i = 0; i < 2; ++i) { w0[i] = vA[1][0][i]; w1[i] = vA[1][1][i]; } }
            PG8_LDB(B0, 0, 0); PG8_SCHED; PG8_LDA(At, 0, 0); if (ld) PG8_STAGE(PG8_SA(1, 1), a1, vA[0][1]);
            PG8_WAIT_L(8); PG8_BAR; PG8_WAIT_L(0); PG8_MMA(0, 0, At, B0); PG8_BAR; PG8_SCHED;
            PG8_LDB(B1, 0, 1); if (ld || last) PG8_STAGE(PG8_SB(0, 0), b2, voffB);
            PG8_BAR; PG8_WAIT_L(0); PG8_MMA(0, 1, At, B1); PG8_BAR;
            PG8_LDA(At, 0, 1); if (ld || last) PG8_STAGE(PG8_SA(0, 0), a2, w0);
            PG8_BAR; PG8_WAIT_L(0); PG8_MMA(1, 0, At, B0); PG8_BAR; PG8_SCHED;
            if (ld || last) PG8_STAGE(PG8_SB(0, 1), b2 + hstep, voffB);
            PG8_WAIT_V(6); PG8_BAR; PG8_MMA(1, 1, At, B1); PG8_BAR;
            PG8_LDB(B0, 1, 0); PG8_SCHED; PG8_LDA(At, 1, 0); if (ld || last) PG8_STAGE(PG8_SA(0, 1), a2, w1);
            PG8_WAIT_L(8); PG8_BAR; PG8_WAIT_L(0); PG8_MMA(0, 0, At, B0); PG8_BAR; PG8_SCHED;
            PG8_LDB(B1, 1, 1); if (ld || last) PG8_STAGE(PG8_SB(1, 0), b3, voffB);
            PG8_BAR; PG8_WAIT_L(0); PG8_MMA(0, 1, At, B1); PG8_BAR;
            PG8_LDA(At, 1, 1); if (ld || last) PG8_STAGE(PG8_SA(1, 0), a3, w0);
            PG8_BAR; PG8_WAIT_L(0); PG8_MMA(1, 0, At, B0); PG8_BAR; PG8_SCHED;
            if (ld || last) PG8_STAGE(PG8_SB(1, 1), b3 + hstep, voffB);
            PG8_WAIT_V(6); PG8_BAR; PG8_MMA(1, 1, At, B1); PG8_BAR;
        }
        if (ES == 1) asm volatile("s_nop 15\n\ts_nop 15" ::: "memory");
        if (!kd || (ui & 1)) E(acc, cur, wr, wc, fr, fq);
        if constexpr (EDBL == 1 && (__is_same(Epi, EpiSwiglu) || __is_same(Epi, EpiYs))) { asm volatile("" ::: "memory"); E(acc, cur, wr, wc, fr, fq); }
        if (!has_next) break;
        const f32x4 zz1 = zero4f();
#pragma unroll
        for (int a = 0; a < 2; ++a)
#pragma unroll
            for (int b = 0; b < 2; ++b)
#pragma unroll
                for (int m = 0; m < 4; ++m)
#pragma unroll
                    for (int n = 0; n < 2; ++n) acc[a][b][m][n] = zz1;
        cur = nxt; cA = nA; cB = nB; ++ui;
        cur.aux = ui & 1; if constexpr (HasPre<Epi>::value) E.pre(cur, wid, wc, lane);
#pragma unroll
        for (int h = 0; h < 2; ++h)
#pragma unroll
            for (int i = 0; i < 2; ++i) vA[0][h][i] = vA[1][h][i];
    }
    PG8_WAIT_V(0);
    if (wr == 0) PG8_BAR;
    PG8_BAR;
#undef PG8_SA
#undef PG8_SB
#undef PG8_STAGE
#undef PG8_LDA
#undef PG8_LDB
#undef PG8_MMA
#undef PG8_WAIT_V
#undef PG8_WAIT_L
#undef PG8_BAR
#undef PG8_SCHED
}
}
using pg8::Unit;

struct EpiZ {
    static constexpr bool PERM = true, MID = false;
    bf16_t* Z; bf16_t* KV; bf16_t* GFp; int pn0; float scale;
    __device__ __forceinline__ void operator()(const f32x4 (&acc)[2][2][4][2], const Unit& u, int wr, int wc, int fr, int fq) const {
        const bool kvu = u.pn >= 32; const int pn = (u.pn & 31) + (kvu ? 0 : pn0);
        bf16_t* base = kvu ? KV : Z; const int ldc = kvu ? 1024 : INC; const bool sg = (!kvu) && (pn >= C_GATE / 256);
        if (sg) {
            bf16_t* gf = GFp + ((size_t)(u.pm * 12 + (pn - C_GATE / 256)) * 16) * 4096 + (size_t)((wr * 4 + wc) * 64 + fq * 16 + fr) * 8;
#pragma unroll
            for (int ai = 0; ai < 2; ++ai)
#pragma unroll
                for (int m = 0; m < 4; ++m)
#pragma unroll
                    for (int bj = 0; bj < 2; ++bj) { f32x4 v0 = acc[ai][bj][m][0] * scale, v1 = acc[ai][bj][m][1] * scale;
#pragma unroll
                        for (int j = 0; j < 4; ++j) { v0[j] = sigmoidf_(v0[j]); v1[j] = sigmoidf_(v1[j]); }
                        u32x4 w; w.x = cvt_pk_bf16(v0[0], v0[1]); w.y = cvt_pk_bf16(v0[2], v0[3]); w.z = cvt_pk_bf16(v1[0], v1[1]); w.w = cvt_pk_bf16(v1[2], v1[3]);
                        *(u32x4*)(gf + (size_t)((ai * 4 + m) * 2 + bj) * 4096) = w; }
            return; }
        const int row0 = u.pm * 256 + wr * 64 + fr, col0 = pn * 256 + wc * 32 + 8 * fq;
#pragma unroll
        for (int ai = 0; ai < 2; ++ai)
#pragma unroll
            for (int m = 0; m < 4; ++m) { bf16_t* rowp = base + (size_t)(row0 + ai * 128 + m * 16) * ldc + col0;
#pragma unroll
                for (int bj = 0; bj < 2; ++bj) { f32x4 v0 = acc[ai][bj][m][0] * scale, v1 = acc[ai][bj][m][1] * scale;
                    if (sg) {
#pragma unroll
                        for (int j = 0; j < 4; ++j) { v0[j] = sigmoidf_(v0[j]); v1[j] = sigmoidf_(v1[j]); } }
                    u32x4 w; w.x = cvt_pk_bf16(v0[0], v0[1]); w.y = cvt_pk_bf16(v0[2], v0[3]); w.z = cvt_pk_bf16(v1[0], v1[1]); w.w = cvt_pk_bf16(v1[2], v1[3]);
                    *(u32x4*)(rowp + bj * 128) = w; } }
    }
};
struct SchedZ8 {
    static constexpr bool GATHER = false; __device__ __forceinline__ unsigned a_off(const Unit&, int, int, int, int) const { return 0u; }
    const char* H8; const char* WIN8; int G, c;
    __device__ __forceinline__ bool next(int i, Unit& u) const {
        const long L = (long)i * G + c; if (L >= 64 * 23) return false;
        pg8::static_map(L, 64, 23, u.pm, u.pn); u.tag = 0; u.pa = H8 + (size_t)u.pm * (256 * 1024); u.pb = WIN8 + (size_t)u.pn * (256 * 1024); return true;
    }
};
struct SchedZ {
    static constexpr bool GATHER = false; __device__ __forceinline__ unsigned a_off(const Unit&, int, int, int, int) const { return 0u; }
    const char* H; const char* WinT; const char* HM; const char* WmkvT; int G, c;
    __device__ __forceinline__ bool next(int i, Unit& u) const {
        const long L = (long)i * G + c; if (L >= 480) return false;
        const size_t tstep = (size_t)256 * 1024 * 2;
        if (L < 448) { pg8::static_map(L, 64, 7, u.pm, u.pn); u.tag = 0; u.pa = H + (size_t)u.pm * tstep; u.pb = WinT + (size_t)u.pn * tstep; }
        else { const int q = (int)(L - 448); u.pm = q >> 2; u.pn = 32 + (q & 3); u.tag = 0; u.pa = HM + (size_t)u.pm * tstep; u.pb = WmkvT + (size_t)(q & 3) * tstep; }
        return true;
    }
};
struct EpiLora {
    static constexpr bool PERM = false, MID = false;
    float* L; const float* w0; const float* a0;
    __device__ __forceinline__ void operator()(const f32x4 (&acc)[2][2][4][2], const Unit& u, int wr, int wc, int fr, int fq) const {
        const int row0 = u.pm * 256 + wr * 64 + fr, col0 = u.pn * 256 + wc * 32 + 4 * fq; const int kind = u.pn >> 1; const f32x4 zb = zero4f();
#pragma unroll
        for (int bj = 0; bj < 2; ++bj)
#pragma unroll
            for (int n = 0; n < 2; ++n) { const int c = col0 + bj * 128 + n * 16;
                f32x4 bv = zb;
                if (kind == 0) bv = *(const f32x4*)(w0 + c); else if (kind == 1) bv = *(const f32x4*)(a0 + (c - 512));
#pragma unroll
                for (int ai = 0; ai < 2; ++ai)
#pragma unroll
                    for (int m = 0; m < 4; ++m) { f32x4 v = acc[ai][bj][m][n] + bv;
                        if (kind == 0) {
#pragma unroll
                            for (int j = 0; j < 4; ++j) v[j] = -0.60653066f * sigmoidf_(v[j]); }
                        else if (kind == 1) {
#pragma unroll
                            for (int j = 0; j < 4; ++j) v[j] = sigmoidf_(v[j]); }
                        const size_t row = (size_t)(row0 + ai * 128 + m * 16);
                        if (kind == 0) *(f32x4*)(L + row * 512 + c) = v;
                        else { u32x2 w; w.x = cvt_pk_bf16(v[0], v[1]); w.y = cvt_pk_bf16(v[2], v[3]); *(u32x2*)((bf16_t*)(L + (size_t)NTOK * 512) + row * 1024 + (c - 512)) = w; } } }
    }
};
template <int mode> struct EpiMix {
    static constexpr bool PERM = false, MID = false;
    float* mix32; bf16_t* mixbf; const bf16_t* Z;
    __device__ __forceinline__ void operator()(const f32x4 (&acc)[2][2][4][2], const Unit& u, int wr, int wc, int fr, int fq) const {
        const int row0 = u.pm * 256 + wr * 64 + fr, col0 = u.pn * 256 + wc * 32 + 4 * fq;
#pragma unroll
        for (int ai = 0; ai < 2; ++ai)
#pragma unroll
            for (int m = 0; m < 4; ++m) { const size_t row = (size_t)(row0 + ai * 128 + m * 16);
#pragma unroll
                for (int bj = 0; bj < 2; ++bj)
#pragma unroll
                    for (int n = 0; n < 2; ++n) { const int c = col0 + bj * 128 + n * 16;
                        const u32x2 gz = *(const u32x2*)(Z + row * INC + C_GATE + mode * 1024 + c); float g[4]; unpack4(gz, g);
                        f32x4 v = acc[ai][bj][m][n]; v[0] *= g[0]; v[1] *= g[1]; v[2] *= g[2]; v[3] *= g[3];
                        if (mode > 0) v += *(const f32x4*)(mix32 + row * 1024 + c);
                        if (mode < 2) *(f32x4*)(mix32 + row * 1024 + c) = v;
                        else { u32x2 w; w.x = cvt_pk_bf16(v[0], v[1]); w.y = cvt_pk_bf16(v[2], v[3]); *(u32x2*)(mixbf + row * 1024 + c) = w; } }
                asm volatile("" ::: "memory"); }
    }
};
struct EpiMixCat {
    static constexpr bool PERM = true, MID = true;
    bf16_t* mixbf; const bf16_t* GF; int tid;
    __device__ __forceinline__ const bf16_t* gtile(const Unit& u, int b) const { return GF + ((size_t)(u.pm * 12 + 4 * b + u.pn) * 16) * 4096 + (size_t)tid * 8; }
    __device__ __forceinline__ void mid(f32x4 (&acc)[2][2][4][2], const Unit& u, int t, int wr, int wc, int fr, int fq) const {
        const int ga = (t == 8) ? 0 : 1; int off = 0; asm volatile("" : "+v"(off));
        const bf16_t* pa = gtile(u, ga) + off; const bf16_t* pb = gtile(u, ga + 1) + off;
#pragma unroll
        for (int ai = 0; ai < 2; ++ai) {
#pragma unroll
            for (int m = 0; m < 4; ++m)
#pragma unroll
                for (int bj = 0; bj < 2; ++bj) { float a[8], b[8]; unpack8(*(const u32x4*)(pa + (size_t)((ai * 4 + m) * 2 + bj) * 4096), a); unpack8(*(const u32x4*)(pb + (size_t)((ai * 4 + m) * 2 + bj) * 4096), b);
#pragma unroll
                    for (int j = 0; j < 4; ++j) { acc[ai][bj][m][0][j] *= a[j] * __builtin_amdgcn_rcpf(b[j]); acc[ai][bj][m][1][j] *= a[4 + j] * __builtin_amdgcn_rcpf(b[4 + j]); } }
            asm volatile("" ::: "memory"); }
    }
    __device__ __forceinline__ void operator()(const f32x4 (&acc)[2][2][4][2], const Unit& u, int wr, int wc, int fr, int fq) const {
        const int row0 = u.pm * 256 + wr * 64 + fr, col0 = u.pn * 256 + wc * 32 + 8 * fq; const bf16_t* pg = gtile(u, 2);
#pragma unroll
        for (int ai = 0; ai < 2; ++ai)
#pragma unroll
            for (int m = 0; m < 4; ++m) { bf16_t* rowp = mixbf + (size_t)(row0 + ai * 128 + m * 16) * 1024 + col0;
#pragma unroll
                for (int bj = 0; bj < 2; ++bj) { float g[8]; unpack8(*(const u32x4*)(pg + (size_t)((ai * 4 + m) * 2 + bj) * 4096), g);
                    const f32x4 v0 = acc[ai][bj][m][0], v1 = acc[ai][bj][m][1];
                    u32x4 w; w.x = cvt_pk_bf16(v0[0] * g[0], v0[1] * g[1]); w.y = cvt_pk_bf16(v0[2] * g[2], v0[3] * g[3]); w.z = cvt_pk_bf16(v1[0] * g[4], v1[1] * g[5]); w.w = cvt_pk_bf16(v1[2] * g[6], v1[3] * g[7]);
                    *(u32x4*)(rowp + bj * 128) = w; } }
    }
};
struct EpiX1 {
    static constexpr bool PERM = true, MID = false;
    const float* x; bf16_t* x1;
    __device__ __forceinline__ void operator()(const f32x4 (&acc)[2][2][4][2], const Unit& u, int wr, int wc, int fr, int fq) const {
        const int row0 = u.pm * 256 + wr * 64 + fr, col0 = u.pn * 256 + wc * 32 + 8 * fq;
#pragma unroll
        for (int ai = 0; ai < 2; ++ai)
#pragma unroll
            for (int m = 0; m < 4; ++m) { const size_t off = (size_t)(row0 + ai * 128 + m * 16) * 1024 + col0;
#pragma unroll
                for (int bj = 0; bj < 2; ++bj) { const f32x4 a = __builtin_nontemporal_load((const f32x4*)(x + off + bj * 128)) + acc[ai][bj][m][0], b = __builtin_nontemporal_load((const f32x4*)(x + off + bj * 128 + 4)) + acc[ai][bj][m][1];
                    u32x4 w; w.x = cvt_pk_bf16(a[0], a[1]); w.y = cvt_pk_bf16(a[2], a[3]); w.z = cvt_pk_bf16(b[0], b[1]); w.w = cvt_pk_bf16(b[2], b[3]);
                    *(u32x4*)(x1 + off + bj * 128) = w; }
                if (m & 1) asm volatile("" ::: "memory"); }
    }
};
struct EpiSwiglu {
    static constexpr bool PERM = true, MID = false;
    static constexpr bool PRE = true;
    unsigned char* act; const float* b1; LAS unsigned char* lds;
    __device__ __forceinline__ void pre(const Unit& u, int wid, int wc, int lane) const {
        __builtin_amdgcn_global_load_lds((const unsigned*)(b1 + (size_t)u.tag * 2048 + 256 * u.pn + 64 * wc + lane), (LAS unsigned*)(lds + 131072 + u.aux * 2048 + wid * 256), 4, 0, 0); }
    __device__ __forceinline__ void operator()(const f32x4 (&acc)[2][2][4][2], const Unit& u, int wr, int wc, int fr, int fq) const {
        const int row0 = u.pm * 256 + wr * 64 + fr; const LAS float* be = (const LAS float*)(lds + 131072 + u.aux * 2048 + (wr * 4 + wc) * 256) + 16 * fq; const int j = 128 * u.pn + 32 * wc + 8 * fq;
        constexpr float CS = -1.702f * 1.44269504f, ICS = 1.0f / CS;
        float bg[8], bl[8];
#pragma unroll
        for (int q = 0; q < 4; ++q) { const f32x4 t = *(const LAS f32x4*)(be + 4 * q); bg[2 * q] = t[0] * CS; bl[2 * q] = (4.0f * t[1] + 4.0f) * ICS; bg[2 * q + 1] = t[2] * CS; bl[2 * q + 1] = (4.0f * t[3] + 4.0f) * ICS; }
#pragma unroll
        for (int ai = 0; ai < 2; ++ai)
#pragma unroll
            for (int m = 0; m < 4; ++m) { float o[8];
#pragma unroll
                for (int n = 0; n < 2; ++n)
#pragma unroll
                    for (int i = 0; i < 4; ++i) { const float sg = fmaxf(fmaf(acc[ai][0][m][n][i], CS / 256.0f, bg[4 * n + i]), 7.0f * CS);
                        const float ql = __builtin_amdgcn_fmed3f(fmaf(acc[ai][1][m][n][i], 4.0f * ICS / 256.0f, bl[4 * n + i]), -24.0f * ICS, 32.0f * ICS);
                        o[4 * n + i] = sg * __builtin_amdgcn_rcpf(1.0f + __builtin_amdgcn_exp2f(sg)) * ql; }
                u32x2 w; w.x = pack4_fp8(o[0], o[1], o[2], o[3]); w.y = pack4_fp8(o[4], o[5], o[6], o[7]);
                *(u32x2*)(act + (size_t)(row0 + ai * 128 + m * 16) * 1024 + j) = w; }
    }
};
struct EpiYs {
    static constexpr bool PERM = true, MID = false;
    static constexpr bool PRE = true;
    bf16_t* ys; const float* b2; LAS unsigned char* lds;
    __device__ __forceinline__ void pre(const Unit& u, int wid, int wc, int lane) const {
        __builtin_amdgcn_global_load_lds((const unsigned*)(b2 + (size_t)u.tag * 1024 + 256 * u.pn + (lane >> 5) * 128 + 32 * wc + (lane & 31)), (LAS unsigned*)(lds + 131072 + u.aux * 2048 + wid * 256), 4, 0, 0); }
    __device__ __forceinline__ void operator()(const f32x4 (&acc)[2][2][4][2], const Unit& u, int wr, int wc, int fr, int fq) const {
        const int row0 = u.pm * 256 + wr * 64 + fr, col0 = u.pn * 256 + wc * 32 + 8 * fq; const LAS float* be = (const LAS float*)(lds + 131072 + u.aux * 2048 + (wr * 4 + wc) * 256) + 8 * fq;
#pragma unroll
        for (int bj = 0; bj < 2; ++bj) { const f32x4 c0 = *(const LAS f32x4*)(be + bj * 32), c1 = *(const LAS f32x4*)(be + bj * 32 + 4);
#pragma unroll
            for (int ai = 0; ai < 2; ++ai)
#pragma unroll
                for (int m = 0; m < 4; ++m) { const f32x4 v0 = acc[ai][bj][m][0] * (1.0f / 128.0f) + c0, v1 = acc[ai][bj][m][1] * (1.0f / 128.0f) + c1;
                    u32x4 w; w.x = cvt_pk_bf16(v0[0], v0[1]); w.y = cvt_pk_bf16(v0[2], v0[3]); w.z = cvt_pk_bf16(v1[0], v1[1]); w.w = cvt_pk_bf16(v1[2], v1[3]);
                    *(u32x4*)(ys + (size_t)(row0 + ai * 128 + m * 16) * 1024 + col0 + bj * 128) = w; } }
    }
};
template <bool GATHER_> struct SchedMoe {
    static constexpr bool GATHER = GATHER_;
    const char* A; const char* Bt; const LAS int* tstart; const int* stok; int lgN, total; size_t estride, tbytes;
    __device__ __forceinline__ bool next(int i, Unit& u) const {
        const int c = blockIdx.x; const int un = i * 256 + (c & 7) * 32 + (c >> 3); if (un >= total) return false;
        const int mt = un >> lgN, pn = un & ((1 << lgN) - 1); const int e = ((const LAS unsigned char*)tstart)[(LX_TEXP - LX_TSTART) + mt];
        u.pm = mt; u.pn = pn; u.tag = e; u.pa = GATHER ? A : A + (size_t)mt * tbytes; u.pb = Bt + (size_t)e * estride + (size_t)pn * tbytes; return true;
    }
    __device__ __forceinline__ unsigned a_off(const Unit& u, int h, int R, int C, int rowbytes) const { const int e = u.tag, ps = u.pm * 256 + h * 128 + R - tstart[(LX_SBASE - LX_TSTART) / 4 + e];
        const int tok = ps < tstart[(LX_CNT - LX_TSTART) / 4 + e] ? stok[(size_t)e * NTOK + ps] : 0; return (unsigned)(tok * rowbytes + C * 2); }
};

__device__ __forceinline__ int w1perm(int c) { const int j = c >> 1, s = c & 1; return ((j >> 7) << 8) | (s << 7) | (j & 127); }
constexpr int NTILE = 13664, TAIL1_A = 6, TAIL1_B = 20, TAIL6 = 8, NRES1 = 32 * TAIL1_A + 32 * TAIL1_B, NRES = NRES1 + 128 * TAIL6;
template <class F> __device__ __forceinline__ void prep_tiles(const int wv, LAS unsigned char* lds, const int cnt, F tile_of) {
    KParams& p = *kparams();
    const int tid = opaque_tid(wv); unsigned char* ws = p.ws;
    LAS float* tile = (LAS float*)lds;
    if (cnt <= 0) return;
    struct TileJob { const float* src; bf16_t* dst; unsigned char* dst8; int K, N, perm, f8, ldd, k0, n0; };
    auto decode = [&](int t) -> TileJob { TileJob j; j.dst = nullptr; j.dst8 = nullptr; j.f8 = 0; j.perm = 0; j.ldd = 0; int lt;
        if (t < 960) { j.src = p.in[3]; j.dst = (bf16_t*)(ws + OFF_WINT); j.K = 1024; j.N = 7680; lt = t; if ((lt % 120) >= 28) { j.f8 = 1; j.dst8 = ws + OFF_WIN8 - (size_t)1792 * 1024; } }
        else if (t < 1088) { j.src = p.in[18]; j.dst = (bf16_t*)(ws + OFF_WMKVT); j.K = 1024; j.N = 1024; lt = t - 960; }
        else if (t < 1152) { j.src = p.in[21]; j.dst = (bf16_t*)(ws + OFF_PCAT); j.K = 512; j.N = 1024; lt = t - 1088; j.ldd = 1280; }
        else if (t < 1184) { j.src = p.in[22]; j.dst = (bf16_t*)(ws + OFF_PCAT) + 512; j.K = 256; j.N = 1024; lt = t - 1152; j.ldd = 1280; }
        else if (t < 1248) { j.src = p.in[23]; j.dst = (bf16_t*)(ws + OFF_PCAT) + 768; j.K = 512; j.N = 1024; lt = t - 1184; j.ldd = 1280; }
        else if (t < 1376) { j.src = p.in[24]; j.dst = (bf16_t*)(ws + OFF_WOT); j.K = 1024; j.N = 1024; lt = t - 1248; }
        else if (t < 9568) { const int q = t - 1376, e = q >> 8; j.src = p.in[28] + (size_t)e * 1024 * 2048; j.dst8 = ws + OFF_W1T + (size_t)e * 2048 * 1024; j.K = 1024; j.N = 2048; j.perm = 1; lt = q & 255; j.f8 = 1; }
        else { const int q = t - 9568, e = q >> 7; j.src = p.in[30] + (size_t)e * 1024 * 1024; j.dst8 = ws + OFF_W2T + (size_t)e * 1024 * 1024; j.K = 1024; j.N = 1024; lt = q & 127; j.f8 = 1; }
        const int tn = j.N >> 6; j.k0 = (lt / tn) * 128; j.n0 = (lt % tn) * 64; return j; };
    { auto ldtile = [&](const TileJob& j, f32x4 (&v)[4]) {
#pragma unroll
          for (int i = 0; i < 4; ++i) { const int idx = tid + 512 * i, row = idx >> 4, c4 = idx & 15; v[i] = __builtin_nontemporal_load((const f32x4*)(j.src + (size_t)(j.k0 + row) * j.N + j.n0 + 4 * c4)); } };
      TileJob j0 = decode(tile_of(0)), j1 = decode(tile_of(cnt > 1 ? 1 : 0)); f32x4 v0[4], v1[4];
      ldtile(j0, v0);
      if (cnt > 1) ldtile(j1, v1);
      for (int n = 0; n < cnt; ++n) {
#pragma unroll
          for (int i = 0; i < 4; ++i) { const int idx = tid + 512 * i, row = idx >> 4, c4 = idx & 15; LAS float* tp = tile + row * 65 + 4 * c4; tp[0] = v0[i][0]; tp[1] = v0[i][1]; tp[2] = v0[i][2]; tp[3] = v0[i][3]; }
          __syncthreads();
          const TileJob cur = j0; j0 = j1;
#pragma unroll
          for (int i = 0; i < 4; ++i) v0[i] = v1[i];
          if (n + 2 < cnt) { j1 = decode(tile_of(n + 2)); ldtile(j1, v1); }
          if (!cur.f8) {
#pragma unroll
              for (int i = 0; i < 2; ++i) { const int kc = (tid & 3) | (((tid >> 8) & 1) << 2) | (i << 3), n = (tid >> 2) & 63; float f[8];
#pragma unroll
                  for (int j = 0; j < 8; ++j) f[j] = tile[(kc * 8 + j) * 65 + n];
                  const int drow = cur.n0 + n;
                  *(u32x4*)(cur.dst + (size_t)drow * (cur.ldd ? cur.ldd : cur.K) + cur.k0 + kc * 8) = pack8(f); }
          } else {
              const int kc = (tid & 3) | (((tid >> 8) & 1) << 2), n = (tid >> 2) & 63; float f[16];
#pragma unroll
              for (int j = 0; j < 16; ++j) f[j] = tile[(kc * 16 + j) * 65 + n] * 32.0f;
              const int drow = cur.perm ? w1perm(cur.n0 + n) : (cur.n0 + n);
              u32x4 w; w.x = pack4_fp8(f[0], f[1], f[2], f[3]); w.y = pack4_fp8(f[4], f[5], f[6], f[7]); w.z = pack4_fp8(f[8], f[9], f[10], f[11]); w.w = pack4_fp8(f[12], f[13], f[14], f[15]);
              *(u32x4*)(cur.dst8 + (size_t)drow * cur.K + cur.k0 + kc * 16) = w; }
          __syncthreads(); } }
}
__device__ __forceinline__ void phase_prep(const int wv, LAS unsigned char* lds) {
    KParams& p = *kparams();
    const int tid = opaque_tid(wv); unsigned char* ws = p.ws;
    { const int G = (int)gridDim.x, top = NTILE - NRES - 1 - (int)blockIdx.x; prep_tiles(wv, lds, top >= 0 ? top / G + 1 : 0, [&](int n) { return top - n * G; }); }
    { const float* w2 = p.in[6]; const float* a2 = p.in[8]; const float* g2 = p.in[9]; bf16_t* lt = (bf16_t*)(ws + OFF_LORAT);
      for (int idx = blockIdx.x * 512 + tid; idx < 1536 * 32; idx += gridDim.x * 512) { const int n = idx >> 5, kc = idx & 31; float f[8];
#pragma unroll
          for (int j = 0; j < 8; ++j) { const int k = kc * 8 + j; float val = 0.f;
              if (n < 512) { if (k < 64) val = w2[k * 512 + n]; }
              else if (n < 1024) { if (k >= 64 && k < 128) val = a2[(k - 64) * 512 + (n - 512)]; }
              else { if (k >= 128) val = g2[(k - 128) * 512 + (n - 1024)]; }
              f[j] = val; }
          *(u32x4*)(lt + (size_t)n * 256 + kc * 8) = pack8(f); } }
    { const float* wr = p.in[26]; bf16_t* wt = (bf16_t*)(ws + OFF_WRT);
      for (int idx = blockIdx.x * 512 + tid; idx < 32 * 1024; idx += gridDim.x * 512) { const int e = idx >> 10, k = idx & 1023; const float v = wr[k * 32 + e];
          const unsigned hi = cvt_pk_bf16(v, 0.f) & 0xffffu; const float vh = __uint_as_float(hi << 16); const unsigned lo = cvt_pk_bf16(v - vh, 0.f) & 0xffffu;
          wt[idx] = (bf16_t)hi; wt[32768 + idx] = (bf16_t)lo; } }
    { const int wid = tid >> 6, lane = tid & 63; const int gw = blockIdx.x * 8 + wid, nw = gridDim.x * 8;
      for (int row0 = gw; row0 < NTOK + 2048; row0 += 3 * nw) {
          f32x4 v[3][4];
#pragma unroll
          for (int r3 = 0; r3 < 3; ++r3) { const int row = row0 + r3 * nw; if (row < NTOK + 2048) { const float* src = row >= NTOK ? p.in[1] + (size_t)(row - NTOK) * 1024 : p.in[0] + (size_t)row * 1024;
#pragma unroll
              for (int i = 0; i < 4; ++i) v[r3][i] = __builtin_nontemporal_load((const f32x4*)(src + 4 * lane + 256 * i)); } }
#pragma unroll
          for (int r3 = 0; r3 < 3; ++r3) { const int row = row0 + r3 * nw; if (row >= NTOK + 2048) break;
              const bool ism = row >= NTOK; const float* gain = ism ? p.in[17] : p.in[2]; bf16_t* dst = ism ? (bf16_t*)(ws + OFF_HM) + (size_t)(row - NTOK) * 1024 : (bf16_t*)(ws + OFF_H) + (size_t)row * 1024;
              float ss = 0.f;
#pragma unroll
              for (int i = 0; i < 4; ++i) ss += v[r3][i][0] * v[r3][i][0] + v[r3][i][1] * v[r3][i][1] + v[r3][i][2] * v[r3][i][2] + v[r3][i][3] * v[r3][i][3];
              ss = red64(ss); const float rs = rsqrtf(ss * (1.0f / 1024.0f) + 1e-5f);
#pragma unroll
              for (int i = 0; i < 4; ++i) { const f32x4 g = *(const f32x4*)(gain + 4 * lane + 256 * i); const f32x4 y = v[r3][i] * rs * g;
                  u32x2 w; w.x = cvt_pk_bf16(y[0], y[1]); w.y = cvt_pk_bf16(y[2], y[3]);
                  *(u32x2*)(dst + 4 * lane + 256 * i) = w;
                  if (!ism) *(unsigned*)(ws + OFF_H8 + (size_t)row * 1024 + 4 * lane + 256 * i) = pack4_fp8(y[0] * 8.0f, y[1] * 8.0f, y[2] * 8.0f, y[3] * 8.0f); } } }
    }
}

__device__ __forceinline__ void phase_elem_c(const int wv) {
    KParams& p = *kparams();
    const int gt = blockIdx.x * 512 + opaque_tid(wv), nthr = gridDim.x * 512; unsigned char* ws = p.ws;
    bf16_t* Z = (bf16_t*)(ws + OFF_Z); bf16_t* AL = (bf16_t*)(ws + OFF_ALORA); bf16_t* KV = (bf16_t*)(ws + OFF_KV);
    const float* mu = p.in[4];
    u32x4 za[4], zb[4]; const u32x4 zq0 = zero4u();
#pragma unroll
    for (int k = 0; k < 4; ++k) { const int idx = gt + k * nthr, t = idx >> 5, ch = idx & 31, col = C_ZW + 8 * ch;
        za[k] = *(const u32x4*)(Z + (size_t)t * INC + col);
        zb[k] = zq0; if ((t & (SEQ - 1)) != 0) zb[k] = *(const u32x4*)(Z + (size_t)(t - 1) * INC + col); }
#pragma unroll
    for (int k = 0; k < 4; ++k) { const int idx = gt + k * nthr, t = idx >> 5, ch = idx & 31, col = C_ZW + 8 * ch;
        float a[8], b[8]; unpack8(za[k], a); unpack8(zb[k], b);
        const f32x4 m0 = *(const f32x4*)(mu + col), m1 = *(const f32x4*)(mu + col + 4); const float mm[8] = {m0[0], m0[1], m0[2], m0[3], m1[0], m1[1], m1[2], m1[3]};
#pragma unroll
        for (int j = 0; j < 8; ++j) { float v = a[j] + (b[j] - a[j]) * mm[j]; if (ch < 8) v = tanhf(v); else if (ch >= 16) v = sigmoidf_(v); a[j] = v; }
        *(u32x4*)(AL + (size_t)t * 256 + 8 * ch) = pack8(a); }
}

__device__ __forceinline__ bf16x8 pack_frag(const f32x4 lo, const f32x4 hi) { u32x4 w; w.x = cvt_pk_bf16(lo[0], lo[1]); w.y = cvt_pk_bf16(lo[2], lo[3]); w.z = cvt_pk_bf16(hi[0], hi[1]); w.w = cvt_pk_bf16(hi[2], hi[3]); bf16x8 r; __builtin_memcpy(&r, &w, 16); return r; }
__device__ __forceinline__ bf16x8 tr2(LAS unsigned char* pa, LAS unsigned char* pb) { const s16x4 a = __builtin_amdgcn_ds_read_tr16_b64_v4i16((LAS s16x4*)pa), b = __builtin_amdgcn_ds_read_tr16_b64_v4i16((LAS s16x4*)pb); return __builtin_shufflevector(a, b, 0, 1, 2, 3, 4, 5, 6, 7); }
__device__ __forceinline__ bf16x8 rd2(LAS unsigned char* pa, LAS unsigned char* pb) { const s16x4 a = *(const LAS s16x4*)pa, b = *(const LAS s16x4*)pb; return __builtin_shufflevector(a, b, 0, 1, 2, 3, 4, 5, 6, 7); }
#define MFMA16(a, b, c) __builtin_amdgcn_mfma_f32_16x16x32_bf16((a), (b), (c), 0, 0, 0)
constexpr int CP_XA = 0, CP_XR = 4096, CP_XB = 8192, CP_XK = 12288, CP_VL = 16384, CP_NL = 16384, CP_WAVE = 20480;
__device__ __forceinline__ void phase_chunk_pre(const int wv, LAS unsigned char* lds) {
    KParams& p = *kparams();
    const int tid = opaque_tid(wv), wid = tid >> 6, lane = tid & 63, fr = lane & 15, fq = lane >> 4; unsigned char* ws = p.ws;
    if (tid == 0) { *(u32x4*)(ws + OFF_CTL + CTL_KEEP + blockIdx.x * 16) = *(const LAS u32x4*)(lds + LDS_X); asm volatile("s_waitcnt vmcnt(0)" ::: "memory"); }
    __syncthreads();
    LAS unsigned char* wl = lds + wid * CP_WAVE;
    const bf16_t* Z = (const bf16_t*)(ws + OFF_Z); bf16_t* C1 = (bf16_t*)(ws + OFF_C1); bf16_t* C2 = (bf16_t*)(ws + OFF_C2);
    const float* mu = p.in[4]; const float* k_k = p.in[10]; const float* k_a = p.in[11]; const float* r_k = p.in[12]; const float* ln_w = p.in[13]; const float* ln_b = p.in[14];
    const f32x4 z4 = zero4f();
    const bf16_t* LT = (const bf16_t*)(ws + OFF_LORAT); const float* w0v = p.in[5]; const float* a0v = p.in[7];
    bf16_t* AL = (bf16_t*)(ws + OFF_ALORA);
    { int tida = tid; asm volatile("" : "+v"(tida));
      for (int un = blockIdx.x; un < 512; un += gridDim.x) { const int tok0 = (un >> 6) * SEQ + (un & 63) * 32; const int t = tok0 + (tida >> 4); u32x4 za[2], zb[2]; const u32x4 zq0 = zero4u();
#pragma unroll
          for (int g2 = 0; g2 < 2; ++g2) { const int col = C_ZW + 8 * ((tida & 15) * 2 + g2); za[g2] = *(const u32x4*)(Z + (size_t)t * INC + col);
              zb[g2] = zq0; if ((t & (SEQ - 1)) != 0) zb[g2] = *(const u32x4*)(Z + (size_t)(t - 1) * INC + col); }
#pragma unroll
          for (int g2 = 0; g2 < 2; ++g2) { const int ch = (tida & 15) * 2 + g2, col = C_ZW + 8 * ch; float a[8], b[8]; unpack8(za[g2], a); unpack8(zb[g2], b);
              const f32x4 m0 = *(const f32x4*)(mu + col), m1 = *(const f32x4*)(mu + col + 4); const float mm[8] = {m0[0], m0[1], m0[2], m0[3], m1[0], m1[1], m1[2], m1[3]};
#pragma unroll
              for (int j = 0; j < 8; ++j) { float v = a[j] + (b[j] - a[j]) * mm[j]; if (ch < 8) v = 1.0f - 2.0f * __builtin_amdgcn_rcpf(1.0f + __builtin_amdgcn_exp2f(2.88539008f * v)); else if (ch >= 16) v = sigmoidf_(v); a[j] = v; }
              *(u32x4*)(AL + (size_t)t * 256 + 8 * ch) = pack8(a); } }
      asm volatile("s_waitcnt vmcnt(0)" ::: "memory");
      __syncthreads(); }
    for (int un = blockIdx.x; un < 512; un += gridDim.x) {
        const int b_ = un >> 6, cc = un & 63, h_ = wid; const int pr = ((b_ * 8 + h_) << 6) | cc; const int tok0 = b_ * SEQ + cc * 32;
        float gamC;
        int tidl = tid; asm volatile("" : "+v"(tidl));
        { const int fr = tidl & 15, fq = (tidl >> 4) & 3;
          bf16x8 wfa[16], tfa[8];
          float bw[4], ba[4];
#pragma unroll
          for (int mt = 0; mt < 4; ++mt) { bw[mt] = w0v[h_ * 64 + 16 * mt + fr]; ba[mt] = a0v[h_ * 64 + 16 * mt + fr]; }
#pragma unroll
          for (int kind = 0; kind < 2; ++kind)
#pragma unroll
              for (int ks = 0; ks < 2; ++ks) {
#pragma unroll
                  for (int nt = 0; nt < 2; ++nt) tfa[(kind * 2 + ks) * 2 + nt] = *(const bf16x8*)(AL + (size_t)(tok0 + 16 * nt + fr) * 256 + kind * 64 + 32 * ks + 8 * fq);
#pragma unroll
                  for (int mt = 0; mt < 4; ++mt) wfa[(kind * 2 + ks) * 4 + mt] = *(const bf16x8*)(LT + (size_t)(kind * 512 + h_ * 64 + 16 * mt + fr) * 256 + kind * 64 + 32 * ks + 8 * fq); }
          bf16x8 wfg[16], tfg[8];
#pragma unroll
          for (int kind = 0; kind < 3; ++kind) { const int nks = kind == 2 ? 4 : 2;
              if (kind == 1) { asm volatile("" ::: "memory");
#pragma unroll
                  for (int ks = 0; ks < 4; ++ks) {
#pragma unroll
                      for (int nt = 0; nt < 2; ++nt) tfg[ks * 2 + nt] = *(const bf16x8*)(AL + (size_t)(tok0 + 16 * nt + fr) * 256 + 128 + 32 * ks + 8 * fq);
#pragma unroll
                      for (int mt = 0; mt < 4; ++mt) wfg[ks * 4 + mt] = *(const bf16x8*)(LT + (size_t)(1024 + h_ * 64 + 16 * mt + fr) * 256 + 128 + 32 * ks + 8 * fq); }
                  asm volatile("" ::: "memory"); }
              f32x4 acc[4][2];
#pragma unroll
              for (int mt = 0; mt < 4; ++mt) { acc[mt][0] = z4; acc[mt][1] = z4; }
#pragma unroll
              for (int ks = 0; ks < nks; ++ks) { const bf16x8 tf0 = kind == 2 ? tfg[ks * 2] : tfa[(kind * 2 + ks) * 2], tf1 = kind == 2 ? tfg[ks * 2 + 1] : tfa[(kind * 2 + ks) * 2 + 1];
#pragma unroll
                  for (int mt = 0; mt < 4; ++mt) { const bf16x8 wf = kind == 2 ? wfg[ks * 4 + mt] : wfa[(kind * 2 + ks) * 4 + mt];
                      acc[mt][0] = MFMA16(tf0, wf, acc[mt][0]); acc[mt][1] = MFMA16(tf1, wf, acc[mt][1]); } }
#pragma unroll
              for (int mt = 0; mt < 4; ++mt) { const int ch = 16 * mt + fr; const float bv = kind == 0 ? bw[mt] : (kind == 1 ? ba[mt] : 0.f);
#pragma unroll
                  for (int nt = 0; nt < 2; ++nt) { f32x4 v = acc[mt][nt] + bv; LAS unsigned char* dst = wl + ch * 64 + (16 * nt + 4 * fq) * 2;
                      if (kind == 0) { float hf[4];
#pragma unroll
                          for (int j = 0; j < 4; ++j) v[j] = -0.60653066f * sigmoidf_(v[j]);
                          u32x2 hi; hi.x = cvt_pk_bf16(v[0], v[1]); hi.y = cvt_pk_bf16(v[2], v[3]);
                          hf[0] = v[0] - __uint_as_float(hi.x << 16); hf[1] = v[1] - __uint_as_float(hi.x & 0xffff0000u); hf[2] = v[2] - __uint_as_float(hi.y << 16); hf[3] = v[3] - __uint_as_float(hi.y & 0xffff0000u);
                          u32x2 lo; lo.x = cvt_pk_bf16(hf[0], hf[1]); lo.y = cvt_pk_bf16(hf[2], hf[3]);
                          *(LAS u32x2*)(dst + CP_XR) = hi; *(LAS u32x2*)(dst + CP_XB) = lo; }
                      else { if (kind == 1) {
#pragma unroll
                              for (int j = 0; j < 4; ++j) v[j] = sigmoidf_(v[j]); }
                          u32x2 w; w.x = cvt_pk_bf16(v[0], v[1]); w.y = cvt_pk_bf16(v[2], v[3]); *(LAS u32x2*)(dst + (kind == 1 ? CP_XK : CP_XA)) = w; } } } }
          asm volatile("s_waitcnt lgkmcnt(0)" ::: "memory"); }
        { const int c = h_ * 64 + (tidl & 63);
          const bf16_t* zp = Z + (size_t)tok0 * INC + c;
          const float mur = mu[c], muk = mu[C_K + c], muv = mu[C_V + c], kk_ = k_k[c], ka_ = k_a[c], rk_ = r_k[c], lnw = ln_w[c], lnb = ln_b[c];
          float pzr = 0.f, pzk = 0.f, pzv = 0.f;
          if (cc != 0) { pzr = __uint_as_float((unsigned)zp[-INC] << 16); pzk = __uint_as_float((unsigned)zp[-INC + C_K] << 16); pzv = __uint_as_float((unsigned)zp[-INC + C_V] << 16); }
          unsigned short zq[2][4][3]; u32x2 sq[2][4];
#pragma unroll
          for (int e = 0; e < 4; ++e) {
#pragma unroll
              for (int q = 0; q < 3; ++q) zq[0][e][q] = zp[(size_t)e * INC + q * 512]; }
#pragma unroll
          for (int r = 0; r < 4; ++r) sq[0][r] = *(const LAS u32x2*)(wl + r * 4096 + lane * 64);
          __builtin_amdgcn_sched_barrier(0);
          float cs = 0.f, g = 1.0f;
#pragma unroll
          for (int t4 = 0; t4 < 8; ++t4) { unsigned pa[2], pr_[2], pb[2], pk[2];
              if (t4 < 7) {
#pragma unroll
                  for (int e = 0; e < 4; ++e) {
#pragma unroll
                      for (int q = 0; q < 3; ++q) zq[(t4 + 1) & 1][e][q] = zp[(size_t)((t4 + 1) * 4 + e) * INC + q * 512]; }
#pragma unroll
                  for (int r = 0; r < 4; ++r) sq[(t4 + 1) & 1][r] = *(const LAS u32x2*)(wl + r * 4096 + lane * 64 + (t4 + 1) * 8); }
              __builtin_amdgcn_sched_barrier(0);
#pragma unroll
              for (int tp = 0; tp < 2; ++tp) { float va[2], vr[2], vb[2], vk[2];
#pragma unroll
                  for (int e = 0; e < 2; ++e) { const int te = tp * 2 + e, t = t4 * 4 + te;
                      const float zr = __uint_as_float((unsigned)zq[t4 & 1][te][0] << 16), zk = __uint_as_float((unsigned)zq[t4 & 1][te][1] << 16), zv = __uint_as_float((unsigned)zq[t4 & 1][te][2] << 16);
                      const float r = zr + (pzr - zr) * mur, k = zk + (pzk - zk) * muk, v = zv + (pzv - zv) * muv; pzr = zr; pzk = zk; pzv = zv;
                      const unsigned wg = sq[t4 & 1][0][te >> 1], wh = sq[t4 & 1][1][te >> 1], wlo = sq[t4 & 1][2][te >> 1], wa = sq[t4 & 1][3][te >> 1];
                      const float lw = __uint_as_float((te & 1) ? (wh & 0xffff0000u) : (wh << 16)) + __uint_as_float((te & 1) ? (wlo & 0xffff0000u) : (wlo << 16));
                      const float al = __uint_as_float((te & 1) ? (wa & 0xffff0000u) : (wa << 16)), gg = __uint_as_float((te & 1) ? (wg & 0xffff0000u) : (wg << 16));
                      const float kk = k * kk_, kp = k * (1.0f + (al - 1.0f) * ka_);
                      const float n2 = red64(kk * kk), bon = red64(r * kp * rk_);
                      const float kn = kk * __builtin_amdgcn_rsqf(fmaxf(n2, 1e-24f));
                      const float gm1 = g; cs += lw; g = __builtin_amdgcn_exp2f(cs * 1.44269504f); const float gi = __builtin_amdgcn_rcpf(g);
                      va[e] = -kn * gm1; vb[e] = kn * al * gi; vk[e] = kp * gi; vr[e] = r * g;
                      *(LAS bf16_t*)(wl + CP_VL + t * 128 + lane * 2) = (bf16_t)(cvt_pk_bf16(v, 0.f) & 0xffffu);
                      const size_t to = (size_t)(tok0 + t) * 512 + c;
                      C1[to] = (bf16_t)(cvt_pk_bf16(lnw * gg, 0.f) & 0xffffu); C2[to] = (bf16_t)(cvt_pk_bf16((lnb + bon * v) * gg, 0.f) & 0xffffu); }
                  pa[tp] = cvt_pk_bf16(va[0], va[1]); pr_[tp] = cvt_pk_bf16(vr[0], vr[1]); pb[tp] = cvt_pk_bf16(vb[0], vb[1]); pk[tp] = cvt_pk_bf16(vk[0], vk[1]); }
              *(LAS u32x2*)(wl + CP_XA + lane * 64 + t4 * 8) = (u32x2){pa[0], pa[1]}; *(LAS u32x2*)(wl + CP_XR + lane * 64 + t4 * 8) = (u32x2){pr_[0], pr_[1]};
              *(LAS u32x2*)(wl + CP_XB + lane * 64 + t4 * 8) = (u32x2){pb[0], pb[1]}; *(LAS u32x2*)(wl + CP_XK + lane * 64 + t4 * 8) = (u32x2){pk[0], pk[1]};
              __builtin_amdgcn_sched_barrier(0); }
          gamC = g; }
        asm volatile("s_waitcnt lgkmcnt(0)" ::: "memory");
        bf16x8 Vf[4];
        { const int vtb = (4 * fq + (fr >> 2)) * 128 + (fr & 3) * 8;
#pragma unroll
          for (int nv = 0; nv < 4; ++nv) { LAS unsigned char* pp = wl + CP_VL + vtb + nv * 32; Vf[nv] = tr2(pp, pp + 2048); } }
        asm volatile("s_waitcnt lgkmcnt(0)" ::: "memory");
        const int trb = (8 * fq + (fr >> 2)) * 64 + (fr & 3) * 8;
        bf16x8 LakF[2], QrbF[2], QrkF[2];
#pragma unroll
        for (int yi = 0; yi < 2; ++yi) {
            bf16x8 fy[2][2];
#pragma unroll
            for (int nt = 0; nt < 2; ++nt)
#pragma unroll
                for (int s2 = 0; s2 < 2; ++s2) { LAS unsigned char* pp = wl + (yi ? CP_XR : CP_XA) + trb + s2 * 2048 + nt * 32; fy[nt][s2] = tr2(pp, pp + 256); }
#pragma unroll
            for (int xi = 0; xi < 2; ++xi) {
                f32x4 d[2][2];
#pragma unroll
                for (int mi = 0; mi < 2; ++mi) { bf16x8 fx[2];
#pragma unroll
                    for (int s2 = 0; s2 < 2; ++s2) { LAS unsigned char* pp = wl + (xi ? CP_XK : CP_XB) + trb + s2 * 2048 + mi * 32; fx[s2] = tr2(pp, pp + 256); }
#pragma unroll
                    for (int nt = 0; nt < 2; ++nt) {
                        if (mi == 1 && nt == 0) { d[mi][nt] = z4; continue; }
                        f32x4 acc = MFMA16(fx[0], fy[nt][0], z4); acc = MFMA16(fx[1], fy[nt][1], acc);
#pragma unroll
                        for (int j = 0; j < 4; ++j) { const int i = 16 * mi + 4 * fq + j, t = 16 * nt + fr; const bool ok = yi ? (i <= t) : (i < t); acc[j] = ok ? acc[j] : 0.f; }
                        d[mi][nt] = acc; } }
                if (yi == 0 && xi == 0) {
#pragma unroll
                    for (int mi = 0; mi < 2; ++mi)
#pragma unroll
                        for (int nt = 0; nt < 2; ++nt)
#pragma unroll
                            for (int j = 0; j < 4; ++j) *(LAS float*)(wl + CP_NL + ((16 * nt + fr) * 32 + 16 * mi + 4 * fq + j) * 4) = d[mi][nt][j];
                } else {
#pragma unroll
                    for (int nt = 0; nt < 2; ++nt) { const bf16x8 f = pack_frag(d[0][nt], d[1][nt]); if (yi == 0) LakF[nt] = f; else if (xi == 0) QrbF[nt] = f; else QrkF[nt] = f; } } } }
        asm volatile("s_waitcnt lgkmcnt(0)" ::: "memory");
        bf16x8 InvF[2];
        { const int c = lane & 31; float X[32];
#pragma unroll
          for (int t = 0; t < 32; ++t) { float a0 = (t == c) ? 1.0f : 0.f, a1 = 0.f;
#pragma unroll
              for (int i4 = 0; i4 < (t + 3) / 4; ++i4) { const f32x4 nv = *(const LAS f32x4*)(wl + CP_NL + (t * 32 + 4 * i4) * 4);
#pragma unroll
                  for (int e = 0; e < 4; ++e) if (4 * i4 + e < t) { if (e & 1) a1 = fmaf(nv[e], X[4 * i4 + e], a1); else a0 = fmaf(nv[e], X[4 * i4 + e], a0); } }
              X[t] = a0 + a1; }
          asm volatile("s_waitcnt lgkmcnt(0)" ::: "memory");
#pragma unroll
          for (int t = 0; t < 32; ++t) *(LAS float*)(wl + CP_NL + (t * 32 + c) * 4) = X[t];
          asm volatile("s_waitcnt lgkmcnt(0)" ::: "memory");
#pragma unroll
          for (int n = 0; n < 2; ++n) { const f32x4 lo = *(const LAS f32x4*)(wl + CP_NL + ((16 * n + fr) * 32 + 4 * fq) * 4), hi = *(const LAS f32x4*)(wl + CP_NL + ((16 * n + fr) * 32 + 16 + 4 * fq) * 4); InvF[n] = pack_frag(lo, hi); } }
        bf16x8 UF[4], AhF[4];
#pragma unroll
        for (int nv = 0; nv < 4; ++nv) { const f32x4 w0 = MFMA16(LakF[0], Vf[nv], z4), w1 = MFMA16(LakF[1], Vf[nv], z4); const bf16x8 wf = pack_frag(w0, w1);
            const f32x4 u0 = MFMA16(InvF[0], wf, z4), u1 = MFMA16(InvF[1], wf, z4); UF[nv] = pack_frag(u0, u1); }
#pragma unroll
        for (int nc = 0; nc < 4; ++nc) { LAS unsigned char* pp = wl + CP_XA + (16 * nc + fr) * 64 + 8 * fq; const bf16x8 af = rd2(pp, pp + 32);
            const f32x4 h0 = MFMA16(InvF[0], af, z4), h1 = MFMA16(InvF[1], af, z4); AhF[nc] = pack_frag(h0, h1); }
        { f32x4 rt[4][2];
#pragma unroll
          for (int mc = 0; mc < 4; ++mc)
#pragma unroll
              for (int nt = 0; nt < 2; ++nt) { const s16x4 rr = __builtin_amdgcn_ds_read_tr16_b64_v4i16((LAS s16x4*)(wl + CP_XR + (16 * mc + 4 * fq + (fr >> 2)) * 64 + (fr & 3) * 8 + nt * 32));
                  f32x4 cin; cin[0] = __uint_as_float((unsigned)(unsigned short)rr[0] << 16); cin[1] = __uint_as_float((unsigned)(unsigned short)rr[1] << 16); cin[2] = __uint_as_float((unsigned)(unsigned short)rr[2] << 16); cin[3] = __uint_as_float((unsigned)(unsigned short)rr[3] << 16);
                  rt[mc][nt] = MFMA16(AhF[mc], QrbF[nt], cin); }
          bf16x8* RTF = (bf16x8*)(ws + OFF_RTF) + (size_t)pr * 256;
#pragma unroll
          for (int nt = 0; nt < 2; ++nt)
#pragma unroll
              for (int s2 = 0; s2 < 2; ++s2) RTF[(nt * 2 + s2) * 64 + lane] = pack_frag(rt[2 * s2][nt], rt[2 * s2 + 1][nt]); }
        { u32x2* YLF = (u32x2*)(ws + OFF_YLF) + (size_t)pr * 512;
#pragma unroll
          for (int nv = 0; nv < 4; ++nv)
#pragma unroll
              for (int mt = 0; mt < 2; ++mt) { f32x4 y = MFMA16(QrbF[mt], UF[nv], z4); y = MFMA16(QrkF[mt], Vf[nv], y);
                  u32x2 w; w.x = cvt_pk_bf16(y[0], y[1]); w.y = cvt_pk_bf16(y[2], y[3]); YLF[(nv * 2 + mt) * 64 + lane] = w; } }
        { bf16x8* GTF = (bf16x8*)(ws + OFF_GTF) + (size_t)pr * 512; u32x2* HHF = (u32x2*)(ws + OFF_HHF) + (size_t)pr * 1024;
#pragma unroll
          for (int nc = 0; nc < 4; ++nc) { LAS unsigned char* pp = wl + CP_XB + (16 * nc + fr) * 64 + 8 * fq; const bf16x8 bf_ = rd2(pp, pp + 32);
              LAS unsigned char* pk = wl + CP_XK + (16 * nc + fr) * 64 + 8 * fq; const bf16x8 kf_ = rd2(pk, pk + 32);
              const float gcol = __int_as_float(__builtin_amdgcn_ds_bpermute((16 * nc + fr) << 2, __float_as_int(gamC)));
              f32x4 gt[4];
#pragma unroll
              for (int mc = 0; mc < 4; ++mc) { f32x4 a = MFMA16(AhF[mc], bf_, z4);
#pragma unroll
                  for (int j = 0; j < 4; ++j) { if (mc == nc && 4 * fq + j == fr) a[j] += 1.0f; a[j] *= gcol; }
                  gt[mc] = a; }
              GTF[(nc * 2 + 0) * 64 + lane] = pack_frag(gt[0], gt[1]); GTF[(nc * 2 + 1) * 64 + lane] = pack_frag(gt[2], gt[3]);
              f32x4 grow;
#pragma unroll
              for (int j = 0; j < 4; ++j) grow[j] = __int_as_float(__builtin_amdgcn_ds_bpermute((16 * nc + 4 * fq + j) << 2, __float_as_int(gamC)));
#pragma unroll
              for (int nv = 0; nv < 4; ++nv) { f32x4 hh = MFMA16(bf_, UF[nv], z4); hh = MFMA16(kf_, Vf[nv], hh); hh = hh * grow;
                  u32x2 w; w.x = cvt_pk_bf16(hh[0], hh[1]); w.y = cvt_pk_bf16(hh[2], hh[3]); HHF[(nv * 4 + nc) * 64 + lane] = w; } } }
        asm volatile("s_waitcnt lgkmcnt(0)" ::: "memory");
    }
    __syncthreads();
    if (tid == 0) *(LAS u32x4*)(lds + LDS_X) = *(const u32x4*)(ws + OFF_CTL + CTL_KEEP + blockIdx.x * 16);
}
__device__ __forceinline__ void phase_scan_seq(const int wv, LAS unsigned char* lds) {
    KParams& p = *kparams();
    const int tid = opaque_tid(wv), wid = __builtin_amdgcn_readfirstlane(tid >> 6), lane = tid & 63, fr = lane & 15, fq = lane >> 4; unsigned char* ws = p.ws;
    if (blockIdx.x >= 64) return;
    const int bh = blockIdx.x, b = bh >> 3, h = bh & 7;
    const char* gG = (const char*)(ws + OFF_GTF) + (size_t)bh * 64 * 8192; const char* gR = (const char*)(ws + OFF_RTF) + (size_t)bh * 64 * 4096;
    const char* gH = (const char*)(ws + OFF_HHF) + (size_t)bh * 64 * 8192; const char* gY = (const char*)(ws + OFF_YLF) + (size_t)bh * 64 * 4096;
    constexpr int SLOT = 24576;
    if (wid >= 4) {
        const int w = wid - 4;
        auto issue = [&](int c) { LAS unsigned char* slot = lds + (c % 5) * SLOT;
#pragma unroll
            for (int i = 0; i < 6; ++i) { const int pc = w + 4 * i;
                const char* src = pc < 8 ? gG + (size_t)c * 8192 + pc * 1024 : pc < 12 ? gR + (size_t)c * 4096 + (pc - 8) * 1024 : pc < 20 ? gH + (size_t)c * 8192 + (pc - 12) * 1024 : gY + (size_t)c * 4096 + (pc - 20) * 1024;
                __builtin_amdgcn_global_load_lds((const unsigned*)(src + lane * 16), (LAS unsigned*)(slot + pc * 1024), 16, 0, 0); } };
        issue(0); issue(1); issue(2); issue(3);
        for (int c = 0; c < 64; ++c) {
            if (c < 60) asm volatile("s_waitcnt vmcnt(18)" ::: "memory"); else asm volatile("s_waitcnt vmcnt(0)" ::: "memory");
            __builtin_amdgcn_s_barrier();
            if (c + 4 < 64) issue(c + 4);
        }
        return; }
    const int nv = wid;
    float* Yraw = (float*)(ws + OFF_YRAW) + (size_t)b * SEQ * 512 + h * 64 + 16 * nv + fr;
    f32x4 T[4]; const f32x4 z4s = zero4f();
#pragma unroll
    for (int m = 0; m < 4; ++m) T[m] = z4s;
    for (int c = 0; c < 64; ++c) {
        __builtin_amdgcn_s_barrier();
        const LAS unsigned char* slot = lds + (c % 5) * SLOT + lane * 16;
        bf16x8 G[8], R[4]; u32x2 H[4], Y[2];
#pragma unroll
        for (int i = 0; i < 8; ++i) G[i] = *(const LAS bf16x8*)(slot + i * 1024);
#pragma unroll
        for (int i = 0; i < 4; ++i) R[i] = *(const LAS bf16x8*)(slot + 8192 + i * 1024);
#pragma unroll
        for (int i = 0; i < 4; ++i) H[i] = *(const LAS u32x2*)(lds + (c % 5) * SLOT + 12288 + (nv * 4 + i) * 512 + lane * 8);
#pragma unroll
        for (int i = 0; i < 2; ++i) Y[i] = *(const LAS u32x2*)(lds + (c % 5) * SLOT + 20480 + (nv * 2 + i) * 512 + lane * 8);
        const bf16x8 tf0 = pack_frag(T[0], T[1]), tf1 = pack_frag(T[2], T[3]);
#pragma unroll
        for (int nt = 0; nt < 2; ++nt) { f32x4 y; y[0] = bf_lo(Y[nt].x); y[1] = bf_hi(Y[nt].x); y[2] = bf_lo(Y[nt].y); y[3] = bf_hi(Y[nt].y);
            y = MFMA16(R[nt * 2], tf0, y); y = MFMA16(R[nt * 2 + 1], tf1, y);
#pragma unroll
            for (int j = 0; j < 4; ++j) Yraw[(size_t)(c * 32 + 16 * nt + 4 * fq + j) * 512] = y[j]; }
#pragma unroll
        for (int m = 0; m < 4; ++m) { f32x4 t; t[0] = bf_lo(H[m].x); t[1] = bf_hi(H[m].x); t[2] = bf_lo(H[m].y); t[3] = bf_hi(H[m].y);
            t = MFMA16(G[m * 2], tf0, t); t = MFMA16(G[m * 2 + 1], tf1, t); T[m] = t; }
        asm volatile("s_waitcnt lgkmcnt(0)" ::: "memory");
    }
}

__device__ __forceinline__ bf16x8 tr_pair(LAS unsigned char* pa, LAS unsigned char* pb, bool useB) {
    const s16x4 a = __builtin_amdgcn_ds_read_tr16_b64_v4i16((LAS s16x4*)pa);
    s16x4 b2 = (s16x4){0, 0, 0, 0};
    if (useB) b2 = __builtin_amdgcn_ds_read_tr16_b64_v4i16((LAS s16x4*)pb);
    return __builtin_shufflevector(a, b2, 0, 1, 2, 3, 4, 5, 6, 7);
}
__device__ __forceinline__ void phase_dil_attn(const int wv, LAS unsigned char* lds) {
    KParams& p = *kparams();
    const int tid = opaque_tid(wv), wid = tid >> 6, lane = tid & 63, fr = lane & 15, fq = lane >> 4; unsigned char* ws = p.ws;
    const bf16_t* Z = (const bf16_t*)(ws + OFF_Z); float* DILO = (float*)(ws + OFF_DILO); float* LSE = (float*)(ws + OFF_LSE);
    LAS unsigned char* kb = lds; LAS unsigned char* vb = lds + 32768; const float* qn = p.in[15]; const float* kn = p.in[16];
    float qkw[2][8];
#pragma unroll
    for (int ks = 0; ks < 2; ++ks)
#pragma unroll
        for (int j = 0; j < 8; ++j) qkw[ks][j] = qn[ks * 32 + 8 * fq + j] * kn[ks * 32 + 8 * fq + j];
    const bool seqwg = blockIdx.x < 64;
    const int ynd = ((int)blockIdx.x - 64) >> 3, ndil = ynd < 8 ? 5 : (ynd < 16 ? 8 : 7);
    const int u0 = seqwg ? 4 * (int)blockIdx.x : 256 + (int)blockIdx.x - 64, uend = seqwg ? 4 * (int)blockIdx.x + 4 : u0 + 192 * ndil, ustep = seqwg ? 1 : 192;
    auto umap = [&](int v) -> int { if (seqwg) return v; const int c2 = (int)blockIdx.x - 64, x = c2 & 7, y = c2 >> 3, i = (v - u0) / 192, k = i < 5 ? 24 * i + y : (y < 16 ? 120 + (y - 8) * 3 + (i - 5) : 144 + (y - 16) * 2 + (i - 5)); return 256 + (k >> 3) * 64 + 8 * x + (k & 7); };
    const int ki = tid >> 1, half = tid & 1;
    u32x4 kvA[4], vvA[4], qvA[2], kvB[4], vvB[4], qvB[2]; bool kvalidA = false, kvalidB = false;
    auto unit_load = [&](int uv, u32x4 (&kv)[4], u32x4 (&vv)[4], u32x4 (&qv)[2], bool& kvalid) { const int u = umap(uv);
        const int b = u / 192, rem = u % 192, hh = rem >> 4, qb = rem & 15, g = hh >> 2;
        const int dil = g == 0 ? 1 : (g == 1 ? 4 : 16), nbc = 16 / dil, r = qb / nbc, j0 = (qb % nbc) * 128;
        const bf16_t* Zb = Z + (size_t)b * SEQ * INC; const int kj = j0 - 128 + ki; kvalid = kj >= 0;
        { const bf16_t* rowp = Zb + (size_t)((kvalid ? kj : 0) * dil + r) * INC + hh * 64 + half * 32;
#pragma unroll
            for (int i = 0; i < 4; ++i) { kv[i] = *(const u32x4*)(rowp + C_DK + 8 * i); vv[i] = *(const u32x4*)(rowp + C_DV + 8 * i); } }
        const int tq = (j0 + 16 * wid + fr) * dil + r;
#pragma unroll
        for (int ks = 0; ks < 2; ++ks) qv[ks] = *(const u32x4*)(Zb + (size_t)tq * INC + C_DQ + hh * 64 + ks * 32 + 8 * fq); };
    auto do_unit = [&](const int uvv, u32x4 (&kv)[4], u32x4 (&vv)[4], u32x4 (&qv)[2], bool& kvalid) { const int u = umap(uvv); const int uv_ = uvv;
        const int b = u / 192, rem = u % 192, hh = rem >> 4, qb = rem & 15, g = hh >> 2, hg = hh & 3;
        const int dil = g == 0 ? 1 : (g == 1 ? 4 : 16), nbc = 16 / dil, r = qb / nbc, j0 = (qb % nbc) * 128;
        { if (kvalid) {
              float ss = sumsq8(kv[0]) + sumsq8(kv[1]) + sumsq8(kv[2]) + sumsq8(kv[3]); ss += dpp_f<0xB1>(ss);
              const float rs = rsqrtf(ss * (1.0f / 64.0f) + 1e-5f);
#pragma unroll
              for (int i = 0; i < 4; ++i) kv[i] = scale8s(kv[i], rs); }
          else { const u32x4 zu = zero4u();
#pragma unroll
              for (int i = 0; i < 4; ++i) { kv[i] = zu; vv[i] = zu; } }
#pragma unroll
          for (int i = 0; i < 4; ++i) { const int sw = (half * 4 + i) ^ (ki & 7); *(LAS u32x4*)(kb + ki * 128 + sw * 16) = kv[i]; *(LAS u32x4*)(vb + ki * 128 + sw * 16) = vv[i]; } }
        const int qi = 16 * wid + fr, tq = (j0 + qi) * dil + r;
        bf16x8 qf[2];
        { float ss = sumsq8(qv[0]) + sumsq8(qv[1]); ss += sxor(ss, 16); ss += sxor(ss, 32);
          const float rs = rsqrtf(ss * (1.0f / 64.0f) + 1e-5f) * 0.125f;
#pragma unroll
          for (int ks = 0; ks < 2; ++ks) { const u32x4 w = scale8r(qv[ks], rs, qkw[ks]); __builtin_memcpy(&qf[ks], &w, 16); } }
        __syncthreads();
        if (uv_ + 2 * ustep < uend) unit_load(uv_ + 2 * ustep, kv, vv, qv, kvalid);
        f32x4 st[9]; float mx = -1e30f; const f32x4 zq = zero4f();
        LAS unsigned char* kp0 = kb + (16 * wid + fr) * 128 + ((fq ^ (fr & 7)) << 4); LAS unsigned char* kp1 = kb + (16 * wid + fr) * 128 + (((4 + fq) ^ (fr & 7)) << 4);
#pragma unroll
        for (int ti = 0; ti < 9; ++ti) {
            const bf16x8 k0 = *(const LAS bf16x8*)(kp0 + ti * 2048), k1 = *(const LAS bf16x8*)(kp1 + ti * 2048);
            f32x4 s = __builtin_amdgcn_mfma_f32_16x16x32_bf16(k0, qf[0], zq, 0, 0, 0);
            s = __builtin_amdgcn_mfma_f32_16x16x32_bf16(k1, qf[1], s, 0, 0, 0);
#pragma unroll
            for (int j = 0; j < 4; ++j) { const int ki = 16 * (wid + ti) + 4 * fq + j, off = qi + 128 - ki; const bool ok = (off >= 0) && (off <= 128) && (j0 - 128 + ki >= 0);
                s[j] = ok ? s[j] : -1e30f; mx = fmaxf(mx, s[j]); }
            st[ti] = s; }
        mx = fmaxf(mx, sxor(mx, 16)); mx = fmaxf(mx, sxor(mx, 32));
        float den = 0.f;
#pragma unroll
        for (int ti = 0; ti < 9; ++ti)
#pragma unroll
            for (int j = 0; j < 4; ++j) { const float e = __builtin_amdgcn_exp2f((st[ti][j] - mx) * 1.44269504f); st[ti][j] = e; den += e; }
        den += sxor(den, 16); den += sxor(den, 32);
        f32x4 o[4];
#pragma unroll
        for (int dt = 0; dt < 4; ++dt) o[dt] = zq;
        const int q4 = fr >> 2, p4 = fr & 3; const int kl = 4 * fq + q4;
        LAS unsigned char* vp[4];
#pragma unroll
        for (int dt = 0; dt < 4; ++dt) vp[dt] = vb + (16 * wid + kl) * 128 + (((2 * dt + (p4 >> 1)) ^ (kl & 7)) << 4) + (p4 & 1) * 8;
#pragma unroll
        for (int pp = 0; pp < 5; ++pp) { const bool two = pp < 4; const int tA = 2 * pp, tB = two ? 2 * pp + 1 : 2 * pp;
            u32x4 pw; pw.x = cvt_pk_bf16(st[tA][0], st[tA][1]); pw.y = cvt_pk_bf16(st[tA][2], st[tA][3]);
            if (two) { pw.z = cvt_pk_bf16(st[tB][0], st[tB][1]); pw.w = cvt_pk_bf16(st[tB][2], st[tB][3]); } else { pw.z = 0u; pw.w = 0u; }
            bf16x8 pf; __builtin_memcpy(&pf, &pw, 16);
#pragma unroll
            for (int dt = 0; dt < 4; ++dt) { const bf16x8 vf = tr_pair(vp[dt] + tA * 2048, vp[dt] + tB * 2048, two);
                o[dt] = __builtin_amdgcn_mfma_f32_16x16x32_bf16(vf, pf, o[dt], 0, 0, 0); } }
        const float inv = __builtin_amdgcn_rcpf(den); const size_t ob = ((size_t)(g * NTOK + b * SEQ + tq) * 4 + hg);
#pragma unroll
        for (int dt = 0; dt < 4; ++dt) *(f32x4*)(DILO + ob * 64 + 16 * dt + 4 * fq) = o[dt] * inv;
        if (fq == 0) LSE[ob] = mx + __logf(den);
        __syncthreads();
    };
    if (u0 < uend) unit_load(u0, kvA, vvA, qvA, kvalidA);
    if (u0 + ustep < uend) unit_load(u0 + ustep, kvB, vvB, qvB, kvalidB);
    for (int u = u0; u < uend; u += 2 * ustep) {
        do_unit(u, kvA, vvA, qvA, kvalidA);
        if (u + ustep < uend) do_unit(u + ustep, kvB, vvB, qvB, kvalidB);
    }
}

__device__ __forceinline__ void phase_mem_attn(const int wv, LAS unsigned char* lds) {
    KParams& p = *kparams();
    const int tid = opaque_tid(wv), wid = tid >> 6, lane = tid & 63, fr = lane & 15, fq = lane >> 4; unsigned char* ws = p.ws;
    const bf16_t* Z = (const bf16_t*)(ws + OFF_Z); const bf16_t* KV = (const bf16_t*)(ws + OFF_KV); bf16_t* YM = (bf16_t*)(ws + OFF_YCAT) + 768;
    LAS unsigned char* kb = lds; LAS unsigned char* vb = lds + 65536; const float* mqn = p.in[19]; const float* mkn = p.in[20];
    if (blockIdx.x < 64) return;
    float mqk[4][8];
#pragma unroll
    for (int ks = 0; ks < 4; ++ks)
#pragma unroll
        for (int j = 0; j < 8; ++j) mqk[ks][j] = mqn[ks * 32 + 8 * fq + j] * mkn[ks * 32 + 8 * fq + j];
    for (int bhq = (int)blockIdx.x - 64; bhq < 256; bhq += (int)gridDim.x - 64) {
        const int bhm = bhq >> 3, b = bhm >> 2, hm = bhm & 3;
        { const int ki = tid >> 1, half = tid & 1; const bf16_t* rowp = KV + (size_t)(b * 256 + ki) * 1024 + hm * 128 + half * 64;
          u32x4 kv[8], vv[8];
#pragma unroll
          for (int i = 0; i < 8; ++i) { kv[i] = *(const u32x4*)(rowp + 8 * i); vv[i] = *(const u32x4*)(rowp + 512 + 8 * i); }
          { float ss = 0.f;
#pragma unroll
            for (int i = 0; i < 8; ++i) ss += sumsq8(kv[i]);
            ss += dpp_f<0xB1>(ss); const float rs = rsqrtf(ss * (1.0f / 128.0f) + 1e-5f);
#pragma unroll
            for (int i = 0; i < 8; ++i) kv[i] = scale8s(kv[i], rs); }
#pragma unroll
          for (int i = 0; i < 8; ++i) { const int sw = (half * 8 + i) ^ (ki & 15); *(LAS u32x4*)(kb + ki * 256 + sw * 16) = kv[i]; *(LAS u32x4*)(vb + ki * 256 + sw * 16) = vv[i]; } }
        __syncthreads();
        const int q4 = fr >> 2, p4 = fr & 3; const int kl = 4 * fq + q4;
        LAS unsigned char* kp[4]; LAS unsigned char* vp[8];
#pragma unroll
        for (int ks = 0; ks < 4; ++ks) kp[ks] = kb + fr * 256 + (((4 * ks + fq) ^ fr) << 4);
#pragma unroll
        for (int dt = 0; dt < 8; ++dt) vp[dt] = vb + kl * 256 + (((2 * dt + (p4 >> 1)) ^ kl) << 4) + (p4 & 1) * 8;
        for (int qq = 0; qq < 2; ++qq) { const int qblk = (bhq & 7) * 2 + qq; const int tq = b * SEQ + qblk * 128 + 16 * wid + fr;
            bf16x8 qf[4];
#pragma unroll
            for (int ks = 0; ks < 4; ++ks) qf[ks] = *(const bf16x8*)(Z + (size_t)tq * INC + C_MQ + hm * 128 + ks * 32 + 8 * fq);
            { u32x4 qv[4]; float ss = 0.f;
#pragma unroll
              for (int ks = 0; ks < 4; ++ks) { __builtin_memcpy(&qv[ks], &qf[ks], 16); ss += sumsq8(qv[ks]); }
              ss += sxor(ss, 16); ss += sxor(ss, 32); const float rs = rsqrtf(ss * (1.0f / 128.0f) + 1e-5f);
#pragma unroll
              for (int ks = 0; ks < 4; ++ks) { const u32x4 w = scale8r(qv[ks], rs, mqk[ks]); __builtin_memcpy(&qf[ks], &w, 16); } }
            f32x4 st[16]; float mx = -1e30f; const f32x4 zq = zero4f();
#pragma unroll
            for (int ti = 0; ti < 16; ++ti) { f32x4 s = zq;
#pragma unroll
                for (int ks = 0; ks < 4; ++ks) { const bf16x8 kf = *(const LAS bf16x8*)(kp[ks] + ti * 4096); s = __builtin_amdgcn_mfma_f32_16x16x32_bf16(kf, qf[ks], s, 0, 0, 0); }
#pragma unroll
                for (int j = 0; j < 4; ++j) mx = fmaxf(mx, s[j]);
                st[ti] = s; if (ti & 1) asm volatile("" ::: "memory"); }
            mx = fmaxf(mx, sxor(mx, 16)); mx = fmaxf(mx, sxor(mx, 32));
            const float sc = 0.08838834764831845f * 1.44269504f; float den = 0.f;
#pragma unroll
            for (int ti = 0; ti < 16; ++ti)
#pragma unroll
                for (int j = 0; j < 4; ++j) { const float e = __builtin_amdgcn_exp2f((st[ti][j] - mx) * sc); st[ti][j] = e; den += e; }
            den += sxor(den, 16); den += sxor(den, 32);
            f32x4 o[8];
#pragma unroll
            for (int dt = 0; dt < 8; ++dt) o[dt] = zq;
#pragma unroll
            for (int pp = 0; pp < 8; ++pp) { const int tA = 2 * pp, tB = 2 * pp + 1;
                u32x4 pw; pw.x = cvt_pk_bf16(st[tA][0], st[tA][1]); pw.y = cvt_pk_bf16(st[tA][2], st[tA][3]); pw.z = cvt_pk_bf16(st[tB][0], st[tB][1]); pw.w = cvt_pk_bf16(st[tB][2], st[tB][3]);
                bf16x8 pf; __builtin_memcpy(&pf, &pw, 16);
#pragma unroll
                for (int dt = 0; dt < 8; ++dt) { const bf16x8 vf = tr_pair(vp[dt] + tA * 4096, vp[dt] + tB * 4096, true);
                    o[dt] = __builtin_amdgcn_mfma_f32_16x16x32_bf16(vf, pf, o[dt], 0, 0, 0); } }
            const float inv = __builtin_amdgcn_rcpf(den);
#pragma unroll
            for (int dt = 0; dt < 8; ++dt) { u32x2 w; w.x = cvt_pk_bf16(o[dt][0] * inv, o[dt][1] * inv); w.y = cvt_pk_bf16(o[dt][2] * inv, o[dt][3] * inv);
                *(u32x2*)(YM + (size_t)tq * 1280 + hm * 128 + 16 * dt + 4 * fq) = w; } }
        __syncthreads();
    }
}

__device__ __forceinline__ void phase_post(const int wv) {
    KParams& p = *kparams();
    const int gt = blockIdx.x * 512 + opaque_tid(wv), nthr = gridDim.x * 512; unsigned char* ws = p.ws;
    const float* Yraw = (const float*)(ws + OFF_YRAW); const bf16_t* C1 = (const bf16_t*)(ws + OFF_C1); const bf16_t* C2 = (const bf16_t*)(ws + OFF_C2); bf16_t* YR = (bf16_t*)(ws + OFF_YCAT);
    for (int idx = gt; idx < NTOK * 128; idx += nthr) { const int t = idx >> 7, c = ((idx >> 4) & 7) * 64 + 4 * (idx & 15);
        const f32x4 y = *(const f32x4*)(Yraw + (size_t)t * 512 + c);
        const float mean = red16(y[0] + y[1] + y[2] + y[3]) * (1.0f / 64.0f);
        const f32x4 d = y - mean; const float var = red16(d[0] * d[0] + d[1] * d[1] + d[2] * d[2] + d[3] * d[3]) * (1.0f / 64.0f);
        const float rs = rsqrtf(var + 64.0f * 1e-5f);
        float c1[4], c2[4]; unpack4(*(const u32x2*)(C1 + (size_t)t * 512 + c), c1); unpack4(*(const u32x2*)(C2 + (size_t)t * 512 + c), c2);
        u32x2 w; w.x = cvt_pk_bf16(d[0] * rs * c1[0] + c2[0], d[1] * rs * c1[1] + c2[1]); w.y = cvt_pk_bf16(d[2] * rs * c1[2] + c2[2], d[3] * rs * c1[3] + c2[3]);
        *(u32x2*)(YR + (size_t)t * 1280 + c) = w; }
    const float* DILO = (const float*)(ws + OFF_DILO); const float* LSE = (const float*)(ws + OFF_LSE); bf16_t* YD = (bf16_t*)(ws + OFF_YCAT) + 512;
    for (int idx = gt; idx < NTOK * 64; idx += nthr) { const int t = idx >> 6, hg = (idx >> 4) & 3, q = idx & 15;
        const float l0 = LSE[(size_t)t * 4 + hg], l1 = LSE[((size_t)NTOK + t) * 4 + hg], l2 = LSE[((size_t)2 * NTOK + t) * 4 + hg];
        const float m = fmaxf(l0, fmaxf(l1, l2)); const float e0 = __expf(l0 - m), e1 = __expf(l1 - m), e2 = __expf(l2 - m); const float inv = __builtin_amdgcn_rcpf(e0 + e1 + e2);
        const f32x4 o0 = *(const f32x4*)(DILO + ((size_t)t * 4 + hg) * 64 + 4 * q), o1 = *(const f32x4*)(DILO + (((size_t)NTOK + t) * 4 + hg) * 64 + 4 * q), o2 = *(const f32x4*)(DILO + (((size_t)2 * NTOK + t) * 4 + hg) * 64 + 4 * q);
        const f32x4 o = (o0 * e0 + o1 * e1 + o2 * e2) * inv;
        u32x2 w; w.x = cvt_pk_bf16(o[0], o[1]); w.y = cvt_pk_bf16(o[2], o[3]); *(u32x2*)(YD + (size_t)t * 1280 + hg * 64 + 4 * q) = w; }
}

__device__ __forceinline__ void phase_router(const int wv, LAS unsigned char* lds, const bool real = true) {
    KParams& p = *kparams();
    const int tid = opaque_tid(wv), wid = tid >> 6, lane = tid & 63, fr = lane & 15, fq = lane >> 4; unsigned char* ws = p.ws;
    const bf16_t* X1 = (const bf16_t*)(ws + OFF_X1B); const float* ln2 = p.in[25]; const float* br = p.in[27]; const bf16_t* WRT = (const bf16_t*)(ws + OFF_WRT);
    unsigned char* XN2 = ws + OFF_XN2; int* TOPE = (int*)(ws + OFF_TOPE); float* TOPG = (float*)(ws + OFF_TOPG);
    LAS int* hist = (LAS int*)(lds + LX_HIST); LAS int* bbase = (LAS int*)(lds + LX_BBASE);
    LAS float* part = (LAS float*)lds;
    if (tid < 32) hist[tid] = 0;
    const int tg = wid & 3, kh = wid >> 2; const int t = blockIdx.x * 64 + tg * 16 + fr;
    int tek[4] = {0, 0, 0, 0}, lrk[4] = {0, 0, 0, 0};
    f32x4 acc[2]; float ss;
    {
        u32x4 xr[4][4];
#pragma unroll
        for (int g4 = 0; g4 < 4; ++g4) { const bf16_t* xp = X1 + (size_t)(blockIdx.x * 64 + g4 * 16 + fr) * 1024 + wid * 128 + 8 * fq;
#pragma unroll
            for (int s2 = 0; s2 < 4; ++s2) xr[g4][s2] = *(const u32x4*)(xp + 32 * s2); }
        f32x4 pa[4][2]; float ps4[4]; const f32x4 zz = zero4f();
#pragma unroll
        for (int g4 = 0; g4 < 4; ++g4) { pa[g4][0] = zz; pa[g4][1] = zz; ps4[g4] = 0.f; }
#pragma unroll
        for (int s2 = 0; s2 < 4; ++s2) { const int k = wid * 128 + 32 * s2 + 8 * fq;
            const f32x4 g0 = *(const f32x4*)(ln2 + k), g1 = *(const f32x4*)(ln2 + k + 4);
            bf16x8 wh[2], wl[2];
#pragma unroll
            for (int m = 0; m < 2; ++m) { wh[m] = *(const bf16x8*)(WRT + (size_t)(16 * m + fr) * 1024 + k); wl[m] = *(const bf16x8*)(WRT + 32768 + (size_t)(16 * m + fr) * 1024 + k); }
#pragma unroll
            for (int g4 = 0; g4 < 4; ++g4) { float x[8]; unpack8(xr[g4][s2], x);
                ps4[g4] += x[0] * x[0] + x[1] * x[1] + x[2] * x[2] + x[3] * x[3] + x[4] * x[4] + x[5] * x[5] + x[6] * x[6] + x[7] * x[7];
                float xg[8]; xg[0] = x[0] * g0[0]; xg[1] = x[1] * g0[1]; xg[2] = x[2] * g0[2]; xg[3] = x[3] * g0[3]; xg[4] = x[4] * g1[0]; xg[5] = x[5] * g1[1]; xg[6] = x[6] * g1[2]; xg[7] = x[7] * g1[3];
                const u32x4 hi = pack8(xg); float hf[8]; unpack8(hi, hf);
#pragma unroll
                for (int j = 0; j < 8; ++j) hf[j] = xg[j] - hf[j];
                const u32x4 lo = pack8(hf);
                bf16x8 xh, xl; __builtin_memcpy(&xh, &hi, 16); __builtin_memcpy(&xl, &lo, 16);
#pragma unroll
                for (int m = 0; m < 2; ++m) { pa[g4][m] = MFMA16(wh[m], xh, pa[g4][m]); pa[g4][m] = MFMA16(wh[m], xl, pa[g4][m]); pa[g4][m] = MFMA16(wl[m], xh, pa[g4][m]); } } }
#pragma unroll
        for (int g4 = 0; g4 < 4; ++g4) { float sq = ps4[g4]; sq += sxor(sq, 16); sq += sxor(sq, 32);
#pragma unroll
            for (int m = 0; m < 2; ++m)
#pragma unroll
                for (int j = 0; j < 4; ++j) part[((wid * 4 + g4) * 9 + m * 4 + j) * 64 + lane] = pa[g4][m][j];
            part[((wid * 4 + g4) * 9 + 8) * 64 + lane] = sq; }
        __syncthreads();
        acc[0] = zz; acc[1] = zz; ss = 0.f;
#pragma unroll
        for (int sw = 0; sw < 8; ++sw) {
#pragma unroll
            for (int m = 0; m < 2; ++m)
#pragma unroll
                for (int j = 0; j < 4; ++j) acc[m][j] += part[((sw * 4 + tg) * 9 + m * 4 + j) * 64 + lane];
            ss += part[((sw * 4 + tg) * 9 + 8) * 64 + lane]; } }
    const float rs = rsqrtf(ss * (1.0f / 1024.0f) + 1e-5f);
    if (real) {
        float r8 = rs * 8.0f; asm volatile("" : "+v"(r8));
#pragma unroll
        for (int s2 = 0; s2 < 16; ++s2) { const int k = kh * 512 + 32 * s2 + 8 * fq; float x[8]; unpack8(*(const u32x4*)(X1 + (size_t)t * 1024 + k), x);
            const f32x4 g0 = *(const f32x4*)(ln2 + k) * r8, g1 = *(const f32x4*)(ln2 + k + 4) * r8;
            u32x2 q8; q8.x = pack4_fp8(x[0] * g0[0], x[1] * g0[1], x[2] * g0[2], x[3] * g0[3]); q8.y = pack4_fp8(x[4] * g1[0], x[5] * g1[1], x[6] * g1[2], x[7] * g1[3]);
            *(u32x2*)(XN2 + (size_t)t * 1024 + k) = q8;
            if ((s2 & 3) == 3) asm volatile("" ::: "memory"); } }
    if (kh == 0) { float lg[8]; int le[8];
#pragma unroll
        for (int m = 0; m < 2; ++m)
#pragma unroll
            for (int j = 0; j < 4; ++j) { const int e = 16 * m + 4 * fq + j; le[m * 4 + j] = e; lg[m * 4 + j] = acc[m][j] * rs + br[e]; }
        float tv[4]; int te[4];
#pragma unroll
        for (int r = 0; r < 4; ++r) { float bv = lg[0]; int bi = le[0];
#pragma unroll
            for (int q = 1; q < 8; ++q) if (lg[q] > bv) { bv = lg[q]; bi = le[q]; }
#pragma unroll
            for (int sft = 16; sft < 64; sft <<= 1) { const float ov = sxor(bv, sft); const int oi = sxor(bi, sft); if (ov > bv || (ov == bv && oi < bi)) { bv = ov; bi = oi; } }
            tv[r] = bv; te[r] = bi;
#pragma unroll
            for (int q = 0; q < 8; ++q) if (le[q] == bi) lg[q] = -3.0e38f; }
        const float e1 = __expf(tv[1] - tv[0]), e2 = __expf(tv[2] - tv[0]), e3 = __expf(tv[3] - tv[0]); const float inv = 1.0f / (1.0f + e1 + e2 + e3);
        if (fq == 0 && real) { *(int4*)(TOPE + (size_t)t * 4) = make_int4(te[0], te[1], te[2], te[3]); *(f32x4*)(TOPG + (size_t)t * 4) = (f32x4){inv, e1 * inv, e2 * inv, e3 * inv};
#pragma unroll
            for (int k = 0; k < 4; ++k) { tek[k] = te[k]; lrk[k] = atomicAdd((int*)&hist[te[k]], 1); } } }
    __syncthreads();
    if (tid < 32) { const int hcount = hist[tid]; bbase[tid] = (hcount && real) ? atomicAdd((int*)(ws + OFF_CTL + CTL_CUR) + tid, hcount) : 0; }
    __syncthreads();
    if (kh == 0 && fq == 0 && real) { int* POS = (int*)(ws + OFF_POS); int* STOKE = (int*)(ws + OFF_STOKE); int ps[4];
#pragma unroll
        for (int k = 0; k < 4; ++k) { ps[k] = bbase[tek[k]] + lrk[k]; STOKE[(size_t)tek[k] * NTOK + ps[k]] = t; }
        *(int4*)(POS + (size_t)t * 4) = make_int4(ps[0], ps[1], ps[2], ps[3]); }
}

__device__ __forceinline__ void build_tables(const int wv, LAS unsigned char* lds) {
    KParams& p = *kparams();
    LAS int* ts = (LAS int*)(lds + LX_TSTART); LAS int* sb = (LAS int*)(lds + LX_SBASE); LAS int* cn = (LAS int*)(lds + LX_CNT);
    if (wv == 0) { const int l = lane_id(); int* gc = (int*)(p.ws + OFF_CTL + CTL_CUR);
        const int c = (l < 32) ? (int)__hip_atomic_load(gc + l, __ATOMIC_RELAXED, __HIP_MEMORY_SCOPE_AGENT) : 0; const int tl = (c + 255) >> 8; int v = tl;
#pragma unroll
        for (int d = 1; d < 32; d <<= 1) { const int o = __builtin_amdgcn_ds_bpermute((l - d) << 2, v); if (l >= d) v += o; }
        if (l < 32) { cn[l] = c; sb[l] = (v - tl) * 256; ts[l + 1] = v; if (l == 0) ts[0] = 0; } }
    __syncthreads();
    { const int tid = (wv << 6) | lane_id(); LAS unsigned char* te = (LAS unsigned char*)(lds + LX_TEXP); const int nt = ts[32];
      if (tid < nt) { int e = 0; while (e < 31 && tid >= ts[e + 1]) ++e; te[tid] = (unsigned char)e; } }
    __syncthreads();
}

__device__ __forceinline__ void phase_combine(const int wv, const bool real = true) {
    KParams& p = *kparams();
    const int tid = opaque_tid(wv), wid = tid >> 6, lane = tid & 63; unsigned char* ws = p.ws;
    const int* SLOT = (const int*)(ws + OFF_SLOT); const float* TOPG = (const float*)(ws + OFF_TOPG); const bf16_t* YS = (const bf16_t*)(ws + OFF_YS); const bf16_t* X1 = (const bf16_t*)(ws + OFF_X1B); float* out = p.out;
    for (int t0 = (blockIdx.x * 8 + wid) * 8; t0 < NTOK; t0 += gridDim.x * 64) {
        int4 sl[8]; f32x4 gg[8];
#pragma unroll
        for (int i = 0; i < 8; ++i) { sl[i] = *(const int4*)(SLOT + (size_t)(t0 + i) * 4); gg[i] = *(const f32x4*)(TOPG + (size_t)(t0 + i) * 4); }
#pragma unroll
        for (int i = 0; i < 8; ++i) { const int t = t0 + i; const int s4[4] = {sl[i].x, sl[i].y, sl[i].z, sl[i].w};
#pragma unroll
            for (int hf = 0; hf < 2; ++hf) { const int c = hf * 512 + 8 * lane; float acc[8];
                const u32x4 xv = __builtin_nontemporal_load((const u32x4*)(X1 + (size_t)t * 1024 + c));
                u32x4 yv[4];
#pragma unroll
                for (int k = 0; k < 4; ++k) yv[k] = __builtin_nontemporal_load((const u32x4*)(YS + (size_t)s4[k] * 1024 + c));
                unpack8(xv, acc);
#pragma unroll
                for (int k = 0; k < 4; ++k) { float f[8]; unpack8(yv[k], f);
#pragma unroll
                    for (int j = 0; j < 8; ++j) acc[j] = fmaf(gg[i][k], f[j], acc[j]); }
                float* dst = real ? out : (float*)(ws + OFF_ACT);
                *(f32x4*)(dst + (size_t)t * 1024 + c) = (f32x4){acc[0], acc[1], acc[2], acc[3]}; *(f32x4*)(dst + (size_t)t * 1024 + c + 4) = (f32x4){acc[4], acc[5], acc[6], acc[7]}; }
            if (i & 1) asm volatile("" ::: "memory"); }
    }
}

__global__ void __launch_bounds__(512, 2) mk_fwd(Params p) {
    extern __shared__ __attribute__((aligned(16))) unsigned char lds_raw[];
    LAS unsigned char* lds = (LAS unsigned char*)lds_raw;
    unsigned char* ws = p.ws;
    const int wv = __builtin_amdgcn_readfirstlane((int)threadIdx.x >> 6);
    const bool multi = (p.ph_hi - p.ph_lo) > 1;
    XcdBarrier xb; xb.bar = (unsigned*)(ws + OFF_CTL); xb.x = 0; xb.st = (volatile LAS unsigned*)(lds + LDS_X);
    if (multi) {
        if (wv == 0 && lane_id() == 0) { *(LAS u32x4*)(lds + LDS_X) = zero4u(); }
        __syncthreads();
        xb = xcd_barrier_post((unsigned*)(ws + OFF_CTL), (volatile LAS unsigned*)(lds + LDS_X), wv);
    }
#if MFMA_BENCH
    { const int l = lane_id(); unsigned h = (unsigned)l * 2654435761u ^ (unsigned)blockIdx.x * 40503u ^ (unsigned)wv * 977u;
      i32x8 a, b;
#pragma unroll
      for (int j = 0; j < 8; ++j) { h = h * 1664525u + 1013904223u; a[j] = (int)(MFMA_BENCH == 1 ? ((h & 0x00ff00ffu) | 0x3f003f00u) : ((h & 0x0f0f0f0fu) | 0x30303030u));
                                    h = h * 1664525u + 1013904223u; b[j] = (int)(MFMA_BENCH == 1 ? ((h & 0x00ff00ffu) | 0x3f003f00u) : ((h & 0x0f0f0f0fu) | 0x30303030u)); }
      f32x4 c[8]; const f32x4 z0 = zero4f();
#pragma unroll
      for (int j = 0; j < 8; ++j) c[j] = z0;
      const int one_scale = 0x7f7f7f7f;
#pragma clang loop unroll(disable)
      for (int it = 0; it < (MFMA_BENCH == 1 ? 1875 : 938); ++it) {
#pragma unroll
          for (int j = 0; j < 8; ++j) {
              if (MFMA_BENCH == 1) c[j] = (j & 1) ? __builtin_amdgcn_mfma_f32_16x16x32_bf16(pg8::half8<1>(a), pg8::half8<1>(b), c[j], 0, 0, 0) : __builtin_amdgcn_mfma_f32_16x16x32_bf16(pg8::half8<0>(a), pg8::half8<0>(b), c[j], 0, 0, 0);
              else asm volatile("v_mfma_scale_f32_16x16x128_f8f6f4 %0, %1, %2, %0, %3, %3 op_sel_hi:[0,0,0]" : "+v"(c[j]) : "v"(a), "v"(b), "v"(one_scale)); } }
      asm volatile("s_nop 15\n\ts_nop 15" ::: "memory");
      float sm = 0.f;
#pragma unroll
      for (int j = 0; j < 8; ++j) sm += c[j][0] + c[j][1] + c[j][2] + c[j][3];
      if (sm == 1.2345f) *(float*)(ws + OFF_CTL + 8192) = sm; }
#endif
    for (int ph = p.ph_lo; ph < p.ph_hi; ++ph) {
      if (ph == 2 || ph == 3 || ph == 10) continue;
      for (int rep = 0; rep < (((DBL_MASK >> ph) & 1) ? 2 : 1); ++rep) {
        KParams& q = *kparams(); unsigned char* ws = q.ws;
        switch (ph) {
        case 0: phase_prep(wv, lds); break;
        case 1: { { SchedZ S; S.H = (const char*)(ws + OFF_H); S.WinT = (const char*)(ws + OFF_WINT); S.HM = (const char*)(ws + OFF_HM); S.WmkvT = (const char*)(ws + OFF_WMKVT); S.G = gridDim.x; S.c = blockIdx.x;
                    EpiZ E; E.Z = (bf16_t*)(ws + OFF_Z); E.KV = (bf16_t*)(ws + OFF_KV); E.GFp = (bf16_t*)(ws + OFF_GF); E.pn0 = 0; E.scale = 1.0f; pg8::gemm_phase(wv, lds, 1024, S, E); }
                  { SchedZ8 S; S.H8 = (const char*)(ws + OFF_H8); S.WIN8 = (const char*)(ws + OFF_WIN8); S.G = gridDim.x; S.c = blockIdx.x;
                    EpiZ E; E.Z = (bf16_t*)(ws + OFF_Z); E.KV = (bf16_t*)(ws + OFF_KV); E.GFp = (bf16_t*)(ws + OFF_GF); E.pn0 = 7; E.scale = 1.0f / 256.0f; pg8::gemm_phase<EpiZ, SchedZ8, 1>(wv, lds, 1024, S, E); }
                  { const int c = blockIdx.x; if (c >= 192) { const int r0 = c < 224 ? (c - 192) * TAIL1_A : 32 * TAIL1_A + (c - 224) * TAIL1_B;
                        prep_tiles(wv, lds, c < 224 ? TAIL1_A : TAIL1_B, [&](int n) { return NTILE - NRES + r0 + n; }); } } } break;
        case 2: phase_elem_c(wv); break;
        case 3: { pg8::DenseOrder S; S.init(ws + OFF_ALORA, ws + OFF_LORAT, NTOK, 1536, 256); EpiLora E; E.L = (float*)(ws + OFF_L); E.w0 = q.in[5]; E.a0 = q.in[7]; pg8::gemm_phase(wv, lds, 256, S, E); } break;
        case 4: phase_chunk_pre(wv, lds); break;
        case 5: for (int r2 = 0; r2 < (((DBL_MASK >> 16) & 1) ? 2 : 1); ++r2) phase_scan_seq(wv, lds);
                for (int r2 = 0; r2 < (((DBL_MASK >> 17) & 1) ? 2 : 1); ++r2) phase_dil_attn(wv, lds);
                for (int r2 = 0; r2 < (((DBL_MASK >> 18) & 1) ? 2 : 1); ++r2) phase_mem_attn(wv, lds); break;
        case 6: phase_post(wv); break;
        case 7: { pg8::DenseOrder S; S.init(ws + OFF_YCAT, ws + OFF_PCAT, NTOK, 1024, 1280); EpiMixCat E; E.mixbf = (bf16_t*)(ws + OFF_MIXBF); E.GF = (const bf16_t*)(ws + OFF_GF); E.tid = (wv << 6) | lane_id(); pg8::gemm_phase(wv, lds, 1280, S, E); } break;
        case 8: { pg8::DenseOrder S; S.init(ws + OFF_MIXBF, ws + OFF_WOT, NTOK, 1024, 1024); EpiX1 E; E.x = q.in[0]; E.x1 = (bf16_t*)(ws + OFF_X1B); pg8::gemm_phase(wv, lds, 1024, S, E); } break;
        case 9: phase_router(wv, lds, rep + 1 == (((DBL_MASK >> ph) & 1) ? 2 : 1)); break;
        case 11: { build_tables(wv, lds);
                   { const int* TOPE = (const int*)(ws + OFF_TOPE); const int* POS = (const int*)(ws + OFF_POS); int* SLOT = (int*)(ws + OFF_SLOT); const LAS int* sb = (const LAS int*)(lds + LX_SBASE);
                     for (int i = blockIdx.x * 512 + ((wv << 6) | lane_id()); i < NTOK * 4; i += gridDim.x * 512) SLOT[i] = sb[TOPE[i]] + POS[i]; }
                   SchedMoe<true> S; S.A = (const char*)(ws + OFF_XN2); S.Bt = (const char*)(ws + OFF_W1T); S.tstart = (const LAS int*)(lds + LX_TSTART); S.stok = (const int*)(ws + OFF_STOKE); S.lgN = 3; S.total = S.tstart[32] * 8; S.estride = (size_t)2048 * 1024; S.tbytes = (size_t)256 * 1024;
                   EpiSwiglu E; E.act = ws + OFF_ACT; E.b1 = q.in[29]; E.lds = lds; pg8::gemm_phase<EpiSwiglu, SchedMoe<true>, 1>(wv, lds, 1024, S, E);
                   { const int c = blockIdx.x, rem = S.total & 255, nearly = rem ? 256 - rem : 0, j = ((c & 7) * 32 + (c >> 3)) - rem;
                     if (rem && j >= 0 && j < 128) prep_tiles(wv, lds, TAIL6, [&](int n) { return NTILE - NRES + NRES1 + n * 128 + j; });
                     const int m = 128 - (nearly < 128 ? nearly : 128);
                     if (m > 0) { const int nf = m * TAIL6, top = nf - 1 - c; prep_tiles(wv, lds, top >= 0 ? top / (int)gridDim.x + 1 : 0, [&](int n) { const int f = top - n * (int)gridDim.x; return NTILE - NRES + NRES1 + (f / m) * 128 + nearly + (f % m); }); } } } break;
        case 12: { build_tables(wv, lds); SchedMoe<false> S; S.A = (const char*)(ws + OFF_ACT); S.Bt = (const char*)(ws + OFF_W2T); S.tstart = (const LAS int*)(lds + LX_TSTART); S.stok = nullptr; S.lgN = 2; S.total = S.tstart[32] * 4; S.estride = (size_t)1024 * 1024; S.tbytes = (size_t)256 * 1024;
                   EpiYs E; E.ys = (bf16_t*)(ws + OFF_YS); E.b2 = q.in[31]; E.lds = lds; pg8::gemm_phase<EpiYs, SchedMoe<false>, 1>(wv, lds, 1024, S, E); } break;
        case 13: phase_combine(wv, rep + 1 == (((DBL_MASK >> ph) & 1) ? 2 : 1)); break;
        default: break;
        }
      }
        if (ph + 1 < p.ph_hi) xcd_barrier(xb, wv);
        if (((DBL_MASK >> 20) & 1) && ph == 3 && multi) for (int e = 0; e < 10; ++e) xcd_barrier(xb, wv);
    }
}

extern "C" void kernel_launch(void* const* d_in, const int* in_sizes, int n_in, void* d_out, int out_size, void* d_ws, size_t ws_size, hipStream_t stream) {
    static int ready = 0;
    if (ready == 0) {
        if (n_in != 32 || out_size != NTOK * 1024 || ws_size < WS_NEED) { fprintf(stderr, "kernel_launch: unexpected shapes (n_in %d, out %d, ws %zu < %zu)\n", n_in, out_size, ws_size, (size_t)WS_NEED); ready = -1; return; }
        if (hipFuncSetAttribute((const void*)mk_fwd, hipFuncAttributeMaxDynamicSharedMemorySize, LDS_BYTES) != hipSuccess) { fprintf(stderr, "kernel_launch: hipFuncSetAttribute failed\n"); ready = -1; return; }
        int per_cu = 0, dev = 0, cus = 0; hipGetDevice(&dev); hipDeviceGetAttribute(&cus, hipDeviceAttributeMultiprocessorCount, dev);
        hipOccupancyMaxActiveBlocksPerMultiprocessor(&per_cu, (const void*)mk_fwd, 512, LDS_BYTES);
        if (per_cu < 1 || cus < 256) { fprintf(stderr, "kernel_launch: occupancy %d blocks/CU on %d CUs; need >= 1 on 256\n", per_cu, cus); ready = -1; (void)hipGetLastError(); return; }
        ready = 1;
    }
    if (ready < 0) return;
    hipMemsetAsync((char*)d_ws + OFF_CTL, 0, CTL_BYTES, stream);
    Params p{};
    for (int i = 0; i < 32; ++i) p.in[i] = (const float*)d_in[i];
    p.out = (float*)d_out; p.ws = (unsigned char*)d_ws;
#if MK_N_LAUNCH_PER_PHASE
    for (int ph = 0; ph < NPHASE; ++ph) { p.ph_lo = ph; p.ph_hi = ph + 1; hipLaunchKernelGGL(mk_fwd, dim3(256), dim3(512), LDS_BYTES, stream, p); }
#else
    p.ph_lo = 0; p.ph_hi = NPHASE;
    void* args[] = {&p};
    hipError_t e = hipLaunchCooperativeKernel((const void*)mk_fwd, dim3(256), dim3(512), args, LDS_BYTES, stream);
    if (e != hipSuccess) fprintf(stderr, "cooperative launch failed: %s\n", hipGetErrorString(e));
#endif
}
```

```cpp
#include <hip/hip_runtime.h>
#include <cstdio>
#include <cstdint>

#define LAS __attribute__((address_space(3)))
typedef unsigned short bf16_t;
typedef short bf16x8 __attribute__((ext_vector_type(8)));
typedef short s16x4 __attribute__((ext_vector_type(4)));
typedef float f32x4 __attribute__((ext_vector_type(4)));
typedef float f32x2 __attribute__((ext_vector_type(2)));
typedef unsigned u32x4 __attribute__((ext_vector_type(4)));
typedef unsigned u32x2 __attribute__((ext_vector_type(2)));
typedef int i32x8 __attribute__((ext_vector_type(8)));
typedef int i32x4 __attribute__((ext_vector_type(4)));

#ifndef DBL_MASK
#define DBL_MASK 0
#endif
#ifndef MK_N_LAUNCH_PER_PHASE
#define MK_N_LAUNCH_PER_PHASE 0
#endif

constexpr int NTOK = 16384, SEQ = 2048, INC = 7680;
constexpr int C_K = 512, C_V = 1024, C_ZW = 1536, C_DQ = 1792, C_DK = 2560, C_DV = 3328, C_MQ = 4096, C_GATE = 4608;
constexpr int NPHASE = 14;
constexpr int NSLOT_MAX = 65536 + 32 * 256;

constexpr size_t MiB = 1ull << 20;
constexpr size_t OFF_CTL = 0;
constexpr size_t CTL_BYTES = 32768;
constexpr size_t CTL_CNT = 16384;
constexpr size_t CTL_CUR = 16384 + 256;
constexpr size_t CTL_KEEP = 20480;
constexpr size_t OFF_TOPE = 1 * MiB;
constexpr size_t OFF_TOPG = 1 * MiB + 262144;
constexpr size_t OFF_SLOT = 1 * MiB + 524288;
constexpr size_t OFF_STOK = 2 * MiB;
constexpr size_t OFF_WRT = 3 * MiB;
constexpr size_t OFF_WINT = 4 * MiB, OFF_WMKVT = 19 * MiB, OFF_LORAT = 21 * MiB, OFF_PRT = 22 * MiB, OFF_PDT = 23 * MiB, OFF_PMT = 24 * MiB, OFF_WOT = 25 * MiB;
constexpr size_t OFF_WIN8 = 8 * MiB;
constexpr size_t OFF_H8 = 539 * MiB;
constexpr size_t OFF_YCAT = 223 * MiB;
constexpr size_t OFF_PCAT = 22 * MiB;
constexpr size_t OFF_W1T = 27 * MiB, OFF_W2T = 155 * MiB, OFF_KV = 219 * MiB, OFF_YM = 223 * MiB, OFF_YR = 239 * MiB, OFF_YD = 255 * MiB, OFF_Z = 263 * MiB;
constexpr size_t OFF_H = 503 * MiB, OFF_HM = 535 * MiB, OFF_ALORA = 503 * MiB, OFF_L = 511 * MiB, OFF_REC = 607 * MiB;
constexpr size_t OFF_GF = OFF_REC;
constexpr size_t OFF_LW = OFF_REC + 64 * MiB;
constexpr size_t OFF_VB = OFF_REC + 96 * MiB;
constexpr size_t OFF_GTF = OFF_REC + 112 * MiB;
constexpr size_t OFF_RTF = OFF_REC + 144 * MiB;
constexpr size_t OFF_HHF = OFF_REC + 160 * MiB;
constexpr size_t OFF_YLF = OFF_REC + 192 * MiB;
constexpr size_t OFF_C1 = 816 * MiB, OFF_C2 = 832 * MiB, OFF_YRAW = 848 * MiB, OFF_DILO = 880 * MiB, OFF_LSE = 928 * MiB;
constexpr size_t OFF_MIX32 = 503 * MiB, OFF_MIXBF = 567 * MiB, OFF_XN2 = 503 * MiB, OFF_XS = 263 * MiB, OFF_ACT = 607 * MiB, OFF_YS = 407 * MiB;
constexpr size_t OFF_X1B = 263 * MiB;
constexpr size_t OFF_STOKE = 296 * MiB;
constexpr size_t OFF_POS = 2 * MiB;
constexpr size_t WS_NEED = 929 * MiB;

constexpr int LDS_BYTES = 160 * 1024;
constexpr int LDS_X = LDS_BYTES - 4096;
constexpr int LX_TSTART = LDS_X + 64;
constexpr int LX_SBASE = LDS_X + 256;
constexpr int LX_CNT = LDS_X + 512;
constexpr int LX_HIST = LDS_X + 768;
constexpr int LX_BBASE = LDS_X + 1024;
constexpr int LX_SLOTL = LDS_X + 2048;
constexpr int LX_TEXP = LDS_X + 3072;

struct Params { const float* in[32]; float* out; unsigned char* ws; int ph_lo, ph_hi; };
typedef const Params __attribute__((address_space(4))) KParams;
__device__ __forceinline__ KParams* kparams() { KParams* kp = (KParams*)__builtin_amdgcn_kernarg_segment_ptr(); asm volatile("" : "+s"(kp)); return kp; }

typedef __bf16 bf16x2_t __attribute__((ext_vector_type(2)));
__device__ __forceinline__ unsigned cvt_pk_bf16(float lo, float hi) { f32x2 v = {lo, hi}; bf16x2_t b = __builtin_convertvector(v, bf16x2_t); unsigned r; __builtin_memcpy(&r, &b, 4); return r; }
__device__ __forceinline__ unsigned pack4_fp8(float a, float b, float c, float d) { int r = __builtin_amdgcn_cvt_pk_fp8_f32(a, b, 0, false); r = __builtin_amdgcn_cvt_pk_fp8_f32(c, d, r, true); return (unsigned)r; }
__device__ __forceinline__ float bf_lo(unsigned u) { return __uint_as_float(u << 16); }
__device__ __forceinline__ float bf_hi(unsigned u) { return __uint_as_float(u & 0xffff0000u); }
__device__ __forceinline__ int lane_id() { int l; asm volatile("v_mbcnt_lo_u32_b32 %0, -1, 0\n\tv_mbcnt_hi_u32_b32 %0, -1, %0" : "=v"(l)); return l; }
__device__ __forceinline__ int sxor(int x, int m) { return __builtin_amdgcn_ds_bpermute((lane_id() ^ m) << 2, x); }
__device__ __forceinline__ float sxor(float x, int m) { return __int_as_float(__builtin_amdgcn_ds_bpermute((lane_id() ^ m) << 2, __float_as_int(x))); }
template <int CTRL> __device__ __forceinline__ float dpp_f(float x) { return __int_as_float(__builtin_amdgcn_update_dpp(0, __float_as_int(x), CTRL, 0xF, 0xF, true)); }
__device__ __forceinline__ float red4(float x) { x += dpp_f<0xB1>(x); x += dpp_f<0x4E>(x); return x; }
__device__ __forceinline__ float red8(float x) { x = red4(x); x += dpp_f<0x141>(x); return x; }
__device__ __forceinline__ float red16(float x) { x = red8(x); x += dpp_f<0x140>(x); return x; }
__device__ __forceinline__ float red64(float x) { x = red16(x);
    x += __int_as_float(__builtin_amdgcn_update_dpp(0, __float_as_int(x), 0x142, 0xA, 0xF, false));
    x += __int_as_float(__builtin_amdgcn_update_dpp(0, __float_as_int(x), 0x143, 0xC, 0xF, false));
    return __int_as_float(__builtin_amdgcn_readlane(__float_as_int(x), 63)); }
__device__ __forceinline__ u32x4 widen8(const u32x2 a, const u32x2 b) { const auto rx = __builtin_amdgcn_permlane16_swap(a.x, b.x, false, false), ry = __builtin_amdgcn_permlane16_swap(a.y, b.y, false, false);
    return (u32x4){(unsigned)rx[0], (unsigned)ry[0], (unsigned)rx[1], (unsigned)ry[1]}; }
__device__ __forceinline__ int opaque_tid(const int wv) { int t = (wv << 6) | lane_id(); asm volatile("" : "+v"(t)); return t; }
__device__ __forceinline__ f32x4 zero4f() { float z = 0.f; asm volatile("" : "+v"(z)); return (f32x4){z, z, z, z}; }
__device__ __forceinline__ u32x4 zero4u() { unsigned z = 0u; asm volatile("" : "+v"(z)); return (u32x4){z, z, z, z}; }
__device__ __forceinline__ float sigmoidf_(float x) { return __builtin_amdgcn_rcpf(1.0f + __builtin_amdgcn_exp2f(-1.44269504f * x)); }
__device__ __forceinline__ void unpack8(const u32x4 v, float (&f)[8]) { f[0] = bf_lo(v.x); f[1] = bf_hi(v.x); f[2] = bf_lo(v.y); f[3] = bf_hi(v.y); f[4] = bf_lo(v.z); f[5] = bf_hi(v.z); f[6] = bf_lo(v.w); f[7] = bf_hi(v.w); }
__device__ __forceinline__ u32x4 pack8(const float (&f)[8]) { u32x4 w; w.x = cvt_pk_bf16(f[0], f[1]); w.y = cvt_pk_bf16(f[2], f[3]); w.z = cvt_pk_bf16(f[4], f[5]); w.w = cvt_pk_bf16(f[6], f[7]); return w; }
__device__ __forceinline__ float sumsq8(const u32x4 v) { float f[8]; unpack8(v, f); float s = 0.f;
#pragma unroll
    for (int j = 0; j < 8; ++j) s += f[j] * f[j];
    return s; }
__device__ __forceinline__ u32x4 scale8(const u32x4 v, const float rs, const float* w) { float f[8]; unpack8(v, f); const f32x4 w0 = *(const f32x4*)w, w1 = *(const f32x4*)(w + 4);
    f[0] *= rs * w0[0]; f[1] *= rs * w0[1]; f[2] *= rs * w0[2]; f[3] *= rs * w0[3]; f[4] *= rs * w1[0]; f[5] *= rs * w1[1]; f[6] *= rs * w1[2]; f[7] *= rs * w1[3]; return pack8(f); }
__device__ __forceinline__ u32x4 scale8r(const u32x4 v, const float rs, const float (&w)[8]) { float f[8]; unpack8(v, f);
#pragma unroll
    for (int j = 0; j < 8; ++j) f[j] *= rs * w[j];
    return pack8(f); }
__device__ __forceinline__ u32x4 scale8s(const u32x4 v, const float rs) { float f[8]; unpack8(v, f);
#pragma unroll
    for (int j = 0; j < 8; ++j) f[j] *= rs;
    return pack8(f); }
__device__ __forceinline__ void unpack4(const u32x2 v, float (&f)[4]) { f[0] = bf_lo(v.x); f[1] = bf_hi(v.x); f[2] = bf_lo(v.y); f[3] = bf_hi(v.y); }

#define XB_TMO      128
#define XB_XCNT(j)  (256  + 64 * (j))
#define XB_XSUB(j)  (1280 + 64 * (j))
#define XB_XGEN(j)  (2304 + 64 * (j))
#define XB_TOP      3328
#define XB_TOPGEN   3392
#define XCD_BAR_WORDS 3456
#define XB_SPIN_CAP (1u << 22)
__device__ __forceinline__ unsigned xb_ld(unsigned* p)              { return __hip_atomic_load(p, __ATOMIC_RELAXED, __HIP_MEMORY_SCOPE_AGENT); }
__device__ __forceinline__ unsigned xb_add(unsigned* p, unsigned v) { return __hip_atomic_fetch_add(p, v, __ATOMIC_RELAXED, __HIP_MEMORY_SCOPE_AGENT); }
__device__ __forceinline__ unsigned xb_xcc_id() { return (unsigned)__builtin_amdgcn_s_getreg((3 << 11) | 20) & 0xFu; }
#define XB_SPIN(cond, bar) do { unsigned _sp = 0; while (cond) { __builtin_amdgcn_s_sleep(1); \
    if ((++_sp & 255u) == 0u) { if (xb_ld(&(bar)[XB_TMO])) break; if (_sp > XB_SPIN_CAP) { atomicAdd(&(bar)[XB_TMO], 1u); break; } } } } while (0)
struct XcdBarrier { unsigned* bar; unsigned x; volatile LAS unsigned* st; };
__device__ __forceinline__ XcdBarrier xcd_barrier_post(unsigned* bar, volatile LAS unsigned* st, const int wv) {
    XcdBarrier b; b.bar = bar; b.x = xb_xcc_id(); b.st = st;
    if (wv == 0 && lane_id() == 0) (void)xb_add(&bar[XB_XCNT(b.x)], 1u);
    return b;
}
__device__ __forceinline__ void xcd_barrier_complete(unsigned* bar, unsigned x, unsigned& nloc, unsigned& nx) {
    const unsigned G = gridDim.x * gridDim.y * gridDim.z;
    unsigned sum, cnt, mine, sp = 0u;
    for (;;) {
        sum = 0u; cnt = 0u; mine = 0u;
#pragma unroll
        for (unsigned j = 0; j < 16; ++j) { const unsigned c = xb_ld(&bar[XB_XCNT(j)]); sum += c; cnt += (c > 0u) ? 1u : 0u; mine = (j == x) ? c : mine; }
        if (sum == G) break;
        __builtin_amdgcn_s_sleep(1);
        if ((++sp & 255u) == 0u) { if (xb_ld(&bar[XB_TMO])) break; if (sp > XB_SPIN_CAP) { atomicAdd(&bar[XB_TMO], 1u); break; } }
    }
    nloc = mine > 0u ? mine : 1u; nx = cnt > 0u ? cnt : 1u;
}
__device__ __forceinline__ void xcd_barrier(const XcdBarrier& b, const int wv) {
    asm volatile("s_waitcnt vmcnt(0)" ::: "memory");
    __syncthreads();
    if (wv == 0 && lane_id() == 0) {
        unsigned* bar = b.bar;
        __builtin_amdgcn_s_waitcnt(0);
        unsigned nloc = b.st[0], nx = b.st[1];
        if (nloc == 0u) { xcd_barrier_complete(bar, b.x, nloc, nx); b.st[0] = nloc; b.st[1] = nx; }
        const unsigned old = xb_add(&bar[XB_XSUB(b.x)], 1u);
        const unsigned gen = old / nloc;
        if (old + 1u == (gen + 1u) * nloc) {
            __builtin_amdgcn_fence(__ATOMIC_RELEASE, "agent");
            asm volatile("s_waitcnt vmcnt(0)" ::: "memory");
            const unsigned og = xb_add(&bar[XB_TOP], 1u);
            const unsigned tg = og / nx;
            if (og + 1u == (tg + 1u) * nx) xb_add(&bar[XB_TOPGEN], 1u);
            else XB_SPIN(xb_ld(&bar[XB_TOPGEN]) == tg, bar);
            __builtin_amdgcn_fence(__ATOMIC_ACQUIRE, "agent");
            xb_add(&bar[XB_XGEN(b.x)], 1u);
            asm volatile("s_waitcnt vmcnt(0)" ::: "memory");
        } else {
            XB_SPIN(xb_ld(&bar[XB_XGEN(b.x)]) == gen, bar);
            __builtin_amdgcn_fence(__ATOMIC_ACQUIRE, "agent");
            asm volatile("s_waitcnt vmcnt(0)" ::: "memory");
        }
    }
    __syncthreads();
}

#ifndef MFMA_BENCH
#define MFMA_BENCH 0
#endif
#ifndef EDBL
#define EDBL 0
#endif
#ifndef KMODE
#define KMODE 0
#endif
#ifndef KDBL
#define KDBL 0
#endif
struct EpiSwiglu; struct EpiYs; struct EpiZ; struct EpiMixCat; struct EpiX1;
namespace pg8 {
constexpr int BM = 256, BK = 64, HALF = 128, HTB = HALF * BK * 2, STAGE_BYTES = 8 * HTB, NXCD = 8, WGM = 8;
__host__ __device__ __forceinline__ int lds_byte(int r, int c) { const int st = (r >> 4) * 2 + (c >> 5), rr = r & 15, cc = c & 31, ob = rr * 64 + cc * 2; return st * 1024 + (ob ^ (((ob >> 9) & 1) << 5)); }
__host__ __device__ __forceinline__ void stage_rc(int b, int& R, int& C) { const int st = b / 1024, sb = b % 1024, swz = sb ^ (((sb >> 9) & 1) << 5); R = (st >> 1) * 16 + swz / 64; C = (st & 1) * 32 + (swz % 64) / 2; }
__host__ __device__ __forceinline__ int perm32(int rho) { const int n = rho >> 4, i = rho & 15; return 8 * (i >> 2) + 4 * n + (i & 3); }
struct Unit { int pm, pn, tag, aux; const char* pa; const char* pb; };
template <class E, class = void> struct HasPre { static constexpr bool value = false; };
template <class E> struct HasPre<E, decltype((void)E::PRE)> { static constexpr bool value = true; };

__device__ __forceinline__ void static_map(long L, int nM, int nN, int& pm, int& pn) {
    const int nwg = nM * nN; int wgid = (int)L;
    { const int q = nwg / NXCD, r = nwg % NXCD, xcd = wgid % NXCD, off = wgid / NXCD; wgid = (xcd < r ? xcd * (q + 1) : r * (q + 1) + (xcd - r) * q) + off; }
    const int nig = WGM * nN, gid = wgid / nig, fm = gid * WGM, gsz = (nM - fm) < WGM ? (nM - fm) : WGM;
    pm = fm + ((wgid % nig) % gsz); pn = (wgid % nig) / gsz;
}
struct DenseOrder {
    static constexpr bool GATHER = false; __device__ __forceinline__ unsigned a_off(const Unit&, int, int, int, int) const { return 0u; }
    const char* A; const char* Bt; int nM, nN, G, c; size_t tstep;
    __device__ __forceinline__ void init(const void* A_, const void* Bt_, int M, int N, int K) { A = (const char*)A_; Bt = (const char*)Bt_; nM = M / BM; nN = N / BM; G = gridDim.x; c = blockIdx.x; tstep = (size_t)BM * K * 2; }
    __device__ __forceinline__ bool next(int i, Unit& u) const {
        const long L = (long)i * G + c; if (L >= (long)nM * nN) return false;
        static_map(L, nM, nN, u.pm, u.pn); u.tag = 0; u.pa = A + (size_t)u.pm * tstep; u.pb = Bt + (size_t)u.pn * tstep; return true;
    }
};

template <int H> __device__ __forceinline__ bf16x8 half8(const i32x8 v) { const i32x4 x = H ? __builtin_shufflevector(v, v, 4, 5, 6, 7) : __builtin_shufflevector(v, v, 0, 1, 2, 3); bf16x8 r; __builtin_memcpy(&r, &x, 16); return r; }
template <class Epi, class Sched, int ES = 2>
__device__ __forceinline__ void gemm_phase(const int wv, LAS unsigned char* lds, const int K, const Sched& S, const Epi& E) {
    int tid_ = (wv << 6) | lane_id(); asm volatile("" : "+v"(tid_));
    const int tid = tid_, wid = __builtin_amdgcn_readfirstlane(tid >> 6), lane = tid & 63, wr = wid >> 2, wc = wid & 3, fr = lane & 15, fq = lane >> 4;
    const int nt = K * ES / (BK * 2);
    unsigned voffA[2], voffB[2]; int RA[2], CA[2];
#pragma unroll
    for (int i = 0; i < 2; ++i) { int R, C; stage_rc(tid * 16 + i * 8192, R, C); const int Rb = Epi::PERM ? ((R & ~31) + perm32(R & 31)) : R; RA[i] = R; CA[i] = C;
        voffA[i] = (unsigned)(R * K * ES + C * 2); voffB[i] = (unsigned)(Rb * K * ES + C * 2); }
    unsigned vA[2][2][2];
    const size_t kstep = (size_t)(BK * 2);
    const size_t hstep = (size_t)HALF * K * ES;
    const unsigned ldsw = (unsigned)wid * 1024u;
    const int aoff = lds_byte(wr * 64 + fr, fq * 8), boff = lds_byte(wc * 32 + fr, fq * 8);
#define PG8_SA(b, h) (((b) * 2 + (h)) * HTB)
#define PG8_SB(b, h) ((4 + (b) * 2 + (h)) * HTB)
#define PG8_STAGE(bufoff, gbase, voff) do { _Pragma("unroll") for (int _i = 0; _i < 2; ++_i) \
        __builtin_amdgcn_global_load_lds((const unsigned*)((const char*)(gbase) + (voff)[_i]), (LAS unsigned*)(lds + (bufoff) + ldsw + _i * 8192), 16, 0, 0); } while (0)
#define PG8_LDA(dst, b, h) do { _Pragma("unroll") for (int m = 0; m < 4; ++m) { const i32x4 _lo = *(const LAS i32x4*)(lds + PG8_SA(b, h) + aoff + m * 2048), _hi = *(const LAS i32x4*)(lds + PG8_SA(b, h) + aoff + m * 2048 + 1024); dst[m] = __builtin_shufflevector(_lo, _hi, 0, 1, 2, 3, 4, 5, 6, 7); } } while (0)
#define PG8_LDB(dst, b, h) do { _Pragma("unroll") for (int n = 0; n < 2; ++n) { const i32x4 _lo = *(const LAS i32x4*)(lds + PG8_SB(b, h) + boff + n * 2048), _hi = *(const LAS i32x4*)(lds + PG8_SB(b, h) + boff + n * 2048 + 1024); dst[n] = __builtin_shufflevector(_lo, _hi, 0, 1, 2, 3, 4, 5, 6, 7); } } while (0)
#define PG8_MMA(ai, bj, At, Bt) do { __builtin_amdgcn_s_setprio(1); _Pragma("unroll") for (int m = 0; m < 4; ++m) _Pragma("unroll") for (int n = 0; n < 2; ++n) { \
        if (ES == 2) { acc[ai][bj][m][n] = __builtin_amdgcn_mfma_f32_16x16x32_bf16(half8<0>(Bt[n]), half8<0>(At[m]), acc[ai][bj][m][n], 0, 0, 0); \
                       acc[ai][bj][m][n] = __builtin_amdgcn_mfma_f32_16x16x32_bf16(half8<1>(Bt[n]), half8<1>(At[m]), acc[ai][bj][m][n], 0, 0, 0); } \
        else asm volatile("v_mfma_scale_f32_16x16x128_f8f6f4 %0, %1, %2, %0, %3, %3 op_sel_hi:[0,0,0]" : "+v"(acc[ai][bj][m][n]) : "v"(Bt[n]), "v"(At[m]), "v"(one_scale)); } \
        __builtin_amdgcn_s_setprio(0); } while (0)
#define PG8_WAIT_V(n) asm volatile("s_waitcnt vmcnt(" #n ")" ::: "memory")
#define PG8_WAIT_L(n) asm volatile("s_waitcnt lgkmcnt(" #n ")" ::: "memory")
#define PG8_BAR __builtin_amdgcn_s_barrier()
#define PG8_SCHED __builtin_amdgcn_sched_barrier(0)
    constexpr int kd = (KDBL == 1 && (__is_same(Epi, EpiSwiglu) || __is_same(Epi, EpiYs))) || (KDBL == 2 && __is_same(Epi, EpiZ)) || (KDBL == 3 && (__is_same(Epi, EpiMixCat) || __is_same(Epi, EpiX1))) ? 1 : 0;
    Unit cur, nxt; int ui = 0;
    if (!S.next(0, cur)) return;
    cur.aux = 0; if constexpr (HasPre<Epi>::value) E.pre(cur, wid, wc, lane);
    f32x4 acc[2][2][4][2]; const f32x4 zz0 = zero4f();
#pragma unroll
    for (int a = 0; a < 2; ++a)
#pragma unroll
        for (int b = 0; b < 2; ++b)
#pragma unroll
            for (int m = 0; m < 4; ++m)
#pragma unroll
                for (int n = 0; n < 2; ++n) acc[a][b][m][n] = zz0;
    i32x8 At[4], B0[2], B1[2];
    const int one_scale = 0x7f7f7f7f;
    const char* cA = cur.pa; const char* cB = cur.pb;
#pragma unroll
    for (int h = 0; h < 2; ++h)
#pragma unroll
        for (int i = 0; i < 2; ++i) vA[0][h][i] = Sched::GATHER ? S.a_off(cur, h, RA[i], CA[i], K * ES) : voffA[i] + (unsigned)(h * hstep);
    if constexpr (kd && KMODE == 1) { cA = S.A; cB = S.Bt;
#pragma unroll
        for (int h = 0; h < 2; ++h)
#pragma unroll
            for (int i = 0; i < 2; ++i) vA[0][h][i] = voffA[i] + (unsigned)(h * hstep); }
    PG8_STAGE(PG8_SB(0, 0), cB, voffB); PG8_STAGE(PG8_SA(0, 0), cA, vA[0][0]); PG8_STAGE(PG8_SB(0, 1), cB + hstep, voffB); PG8_STAGE(PG8_SA(0, 1), cA, vA[0][1]);
    if (wr == 1) PG8_BAR;
    PG8_WAIT_V(4); PG8_BAR;
    PG8_STAGE(PG8_SB(1, 0), cB + kstep, voffB); PG8_STAGE(PG8_SA(1, 0), cA + kstep, vA[0][0]); PG8_STAGE(PG8_SB(1, 1), cB + hstep + kstep, voffB);
    PG8_WAIT_V(6); PG8_BAR;
    for (;;) {
        const bool has_next = S.next((ui + 1) >> kd, nxt);
        const char* nA = has_next ? nxt.pa : cA; const char* nB = has_next ? nxt.pb : cB;
#pragma unroll
        for (int h = 0; h < 2; ++h)
#pragma unroll
            for (int i = 0; i < 2; ++i) vA[1][h][i] = has_next ? (Sched::GATHER ? S.a_off(nxt, h, RA[i], CA[i], K * ES) : voffA[i] + (unsigned)(h * hstep)) : vA[0][h][i];
        if constexpr (kd && KMODE == 1) { if (has_next && (ui & 1)) { nA = S.A; nB = S.Bt;
#pragma unroll
            for (int h = 0; h < 2; ++h)
#pragma unroll
                for (int i = 0; i < 2; ++i) vA[1][h][i] = voffA[i] + (unsigned)(h * hstep); } }
        const bool ld = !(kd && KMODE == 2 && !(ui & 1));
#pragma clang loop unroll(disable)
        for (int t = 0; t < nt; t += 2) {
            if constexpr (Epi::MID) { if (t == 8 || t == 12) E.mid(acc, cur, t, wr, wc, fr, fq); }
            const bool last = (t == nt - 2);
            const char* a1 = cA + (size_t)(t + 1) * kstep;
            const char* a2 = last ? nA : cA + (size_t)(t + 2) * kstep; const char* b2 = last ? nB : cB + (size_t)(t + 2) * kstep;
            const char* a3 = a2 + kstep; const char* b3 = b2 + kstep;
            unsigned w0[2], w1[2];
#pragma unroll
            for (int i = 0; i < 2; ++i) { w0[i] = vA[0][0][i]; w1[i] = vA[0][1][i]; }
            if (last) { asm volatile("" ::: "memory");
#pragma unroll
                for (int i = 0; i < 2; ++i) { w0[i] = vA[1][0][i]; w1[i] = vA[1][1][i]; } }
            PG8_LDB(B0, 0, 0); PG8_SCHED; PG8_LDA(At, 0, 0); if (ld) PG8_STAGE(PG8_SA(1, 1), a1, vA[0][1]);
            PG8_WAIT_L(8); PG8_BAR; PG8_WAIT_L(0); PG8_MMA(0, 0, At, B0); PG8_BAR; PG8_SCHED;
            PG8_LDB(B1, 0, 1); if (ld || last) PG8_STAGE(PG8_SB(0, 0), b2, voffB);
            PG8_BAR; PG8_WAIT_L(0); PG8_MMA(0, 1, At, B1); PG8_BAR;
            PG8_LDA(At, 0, 1); if (ld || last) PG8_STAGE(PG8_SA(0, 0), a2, w0);
            PG8_BAR; PG8_WAIT_L(0); PG8_MMA(1, 0, At, B0); PG8_BAR; PG8_SCHED;
            if (ld || last) PG8_STAGE(PG8_SB(0, 1), b2 + hstep, voffB);
            PG8_WAIT_V(6); PG8_BAR; PG8_MMA(1, 1, At, B1); PG8_BAR;
            PG8_LDB(B0, 1, 0); PG8_SCHED; PG8_LDA(At, 1, 0); if (ld || last) PG8_STAGE(PG8_SA(0, 1), a2, w1);
            PG8_WAIT_L(8); PG8_BAR; PG8_WAIT_L(0); PG8_MMA(0, 0, At, B0); PG8_BAR; PG8_SCHED;
            PG8_LDB(B1, 1, 1); if (ld || last) PG8_STAGE(PG8_SB(1, 0), b3, voffB);
            PG8_BAR; PG8_WAIT_L(0); PG8_MMA(0, 1, At, B1); PG8_BAR;
            PG8_LDA(At, 1, 1); if (ld || last) PG8_STAGE(PG8_SA(1, 0), a3, w0);
            PG8_BAR; PG8_WAIT_L(0); PG8_MMA(1, 0, At, B0); PG8_BAR; PG8_SCHED;
            if (ld || last) PG8_STAGE(PG8_SB(1, 1), b3 + hstep, voffB);
            PG8_WAIT_V(6); PG8_BAR; PG8_MMA(1, 1, At, B1); PG8_BAR;
        }
        if (ES == 1) asm volatile("s_nop 15\n\ts_nop 15" ::: "memory");
        if (!kd || (ui & 1)) E(acc, cur, wr, wc, fr, fq);
        if constexpr (EDBL == 1 && (__is_same(Epi, EpiSwiglu) || __is_same(Epi, EpiYs))) { asm volatile("" ::: "memory"); E(acc, cur, wr, wc, fr, fq); }
        if (!has_next) break;
        const f32x4 zz1 = zero4f();
#pragma unroll
        for (int a = 0; a < 2; ++a)
#pragma unroll
            for (int b = 0; b < 2; ++b)
#pragma unroll
                for (int m = 0; m < 4; ++m)
#pragma unroll
                    for (int n = 0; n < 2; ++n) acc[a][b][m][n] = zz1;
        cur = nxt; cA = nA; cB = nB; ++ui;
        cur.aux = ui & 1; if constexpr (HasPre<Epi>::value) E.pre(cur, wid, wc, lane);
#pragma unroll
        for (int h = 0; h < 2; ++h)
#pragma unroll
            for (int i = 0; i < 2; ++i) vA[0][h][i] = vA[1][h][i];
    }
    PG8_WAIT_V(0);
    if (wr == 0) PG8_BAR;
    PG8_BAR;
#undef PG8_SA
#undef PG8_SB
#undef PG8_STAGE
#undef PG8_LDA
#undef PG8_LDB
#undef PG8_MMA
#undef PG8_WAIT_V
#undef PG8_WAIT_L
#undef PG8_BAR
#undef PG8_SCHED
}
}
using pg8::Unit;

struct EpiZ {
    static constexpr bool PERM = true, MID = false;
    bf16_t* Z; bf16_t* KV; bf16_t* GFp; int pn0; float scale;
    __device__ __forceinline__ void operator()(const f32x4 (&acc)[2][2][4][2], const Unit& u, int wr, int wc, int fr, int fq) const {
        const bool kvu = u.pn >= 32; const int pn = (u.pn & 31) + (kvu ? 0 : pn0);
        bf16_t* base = kvu ? KV : Z; const int ldc = kvu ? 1024 : INC; const bool sg = (!kvu) && (pn >= C_GATE / 256);
        if (sg) {
            bf16_t* gf = GFp + ((size_t)(u.pm * 12 + (pn - C_GATE / 256)) * 16) * 4096 + (size_t)((wr * 4 + wc) * 64 + fq * 16 + fr) * 8;
            float nsc1 = -1.44269504f * scale, one1 = 1.0f; asm volatile("" : "+v"(nsc1), "+v"(one1)); const f32x4 nsc = {nsc1, nsc1, nsc1, nsc1}, one4 = {one1, one1, one1, one1};
#pragma unroll
            for (int ai = 0; ai < 2; ++ai)
#pragma unroll
                for (int m = 0; m < 4; ++m)
#pragma unroll
                    for (int bj = 0; bj < 2; ++bj) { f32x4 v0 = acc[ai][bj][m][0] * nsc, v1 = acc[ai][bj][m][1] * nsc;
#pragma unroll
                        for (int j = 0; j < 4; ++j) { v0[j] = __builtin_amdgcn_exp2f(v0[j]); v1[j] = __builtin_amdgcn_exp2f(v1[j]); }
                        v0 = v0 + one4; v1 = v1 + one4;
#pragma unroll
                        for (int j = 0; j < 4; ++j) { v0[j] = __builtin_amdgcn_rcpf(v0[j]); v1[j] = __builtin_amdgcn_rcpf(v1[j]); }
                        u32x4 w; w.x = cvt_pk_bf16(v0[0], v0[1]); w.y = cvt_pk_bf16(v0[2], v0[3]); w.z = cvt_pk_bf16(v1[0], v1[1]); w.w = cvt_pk_bf16(v1[2], v1[3]);
                        *(u32x4*)(gf + (size_t)((ai * 4 + m) * 2 + bj) * 4096) = w; }
            return; }
        const int row0 = u.pm * 256 + wr * 64 + fr, col0 = pn * 256 + wc * 32 + 8 * fq;
#pragma unroll
        for (int ai = 0; ai < 2; ++ai)
#pragma unroll
            for (int m = 0; m < 4; ++m) { bf16_t* rowp = base + (size_t)(row0 + ai * 128 + m * 16) * ldc + col0;
#pragma unroll
                for (int bj = 0; bj < 2; ++bj) { f32x4 v0 = acc[ai][bj][m][0] * scale, v1 = acc[ai][bj][m][1] * scale;
                    if (sg) {
#pragma unroll
                        for (int j = 0; j < 4; ++j) { v0[j] = sigmoidf_(v0[j]); v1[j] = sigmoidf_(v1[j]); } }
                    u32x4 w; w.x = cvt_pk_bf16(v0[0], v0[1]); w.y = cvt_pk_bf16(v0[2], v0[3]); w.z = cvt_pk_bf16(v1[0], v1[1]); w.w = cvt_pk_bf16(v1[2], v1[3]);
                    *(u32x4*)(rowp + bj * 128) = w; } }
    }
};
struct SchedZ8 {
    static constexpr bool GATHER = false; __device__ __forceinline__ unsigned a_off(const Unit&, int, int, int, int) const { return 0u; }
    const char* H8; const char* WIN8; int G, c;
    __device__ __forceinline__ bool next(int i, Unit& u) const {
        const long L = (long)i * G + c; if (L >= 64 * 23) return false;
        pg8::static_map(L, 64, 23, u.pm, u.pn); u.tag = 0; u.pa = H8 + (size_t)u.pm * (256 * 1024); u.pb = WIN8 + (size_t)u.pn * (256 * 1024); return true;
    }
};
struct SchedZ {
    static constexpr bool GATHER = false; __device__ __forceinline__ unsigned a_off(const Unit&, int, int, int, int) const { return 0u; }
    const char* H; const char* WinT; const char* HM; const char* WmkvT; int G, c;
    __device__ __forceinline__ bool next(int i, Unit& u) const {
        const long L = (long)i * G + c; if (L >= 480) return false;
        const size_t tstep = (size_t)256 * 1024 * 2;
        if (L < 448) { pg8::static_map(L, 64, 7, u.pm, u.pn); u.tag = 0; u.pa = H + (size_t)u.pm * tstep; u.pb = WinT + (size_t)u.pn * tstep; }
        else { const int q = (int)(L - 448); u.pm = q >> 2; u.pn = 32 + (q & 3); u.tag = 0; u.pa = HM + (size_t)u.pm * tstep; u.pb = WmkvT + (size_t)(q & 3) * tstep; }
        return true;
    }
};
struct EpiLora {
    static constexpr bool PERM = false, MID = false;
    float* L; const float* w0; const float* a0;
    __device__ __forceinline__ void operator()(const f32x4 (&acc)[2][2][4][2], const Unit& u, int wr, int wc, int fr, int fq) const {
        const int row0 = u.pm * 256 + wr * 64 + fr, col0 = u.pn * 256 + wc * 32 + 4 * fq; const int kind = u.pn >> 1; const f32x4 zb = zero4f();
#pragma unroll
        for (int bj = 0; bj < 2; ++bj)
#pragma unroll
            for (int n = 0; n < 2; ++n) { const int c = col0 + bj * 128 + n * 16;
                f32x4 bv = zb;
                if (kind == 0) bv = *(const f32x4*)(w0 + c); else if (kind == 1) bv = *(const f32x4*)(a0 + (c - 512));
#pragma unroll
                for (int ai = 0; ai < 2; ++ai)
#pragma unroll
                    for (int m = 0; m < 4; ++m) { f32x4 v = acc[ai][bj][m][n] + bv;
                        if (kind == 0) {
#pragma unroll
                            for (int j = 0; j < 4; ++j) v[j] = -0.60653066f * sigmoidf_(v[j]); }
                        else if (kind == 1) {
#pragma unroll
                            for (int j = 0; j < 4; ++j) v[j] = sigmoidf_(v[j]); }
                        const size_t row = (size_t)(row0 + ai * 128 + m * 16);
                        if (kind == 0) *(f32x4*)(L + row * 512 + c) = v;
                        else { u32x2 w; w.x = cvt_pk_bf16(v[0], v[1]); w.y = cvt_pk_bf16(v[2], v[3]); *(u32x2*)((bf16_t*)(L + (size_t)NTOK * 512) + row * 1024 + (c - 512)) = w; } } }
    }
};
template <int mode> struct EpiMix {
    static constexpr bool PERM = false, MID = false;
    float* mix32; bf16_t* mixbf; const bf16_t* Z;
    __device__ __forceinline__ void operator()(const f32x4 (&acc)[2][2][4][2], const Unit& u, int wr, int wc, int fr, int fq) const {
        const int row0 = u.pm * 256 + wr * 64 + fr, col0 = u.pn * 256 + wc * 32 + 4 * fq;
#pragma unroll
        for (int ai = 0; ai < 2; ++ai)
#pragma unroll
            for (int m = 0; m < 4; ++m) { const size_t row = (size_t)(row0 + ai * 128 + m * 16);
#pragma unroll
                for (int bj = 0; bj < 2; ++bj)
#pragma unroll
                    for (int n = 0; n < 2; ++n) { const int c = col0 + bj * 128 + n * 16;
                        const u32x2 gz = *(const u32x2*)(Z + row * INC + C_GATE + mode * 1024 + c); float g[4]; unpack4(gz, g);
                        f32x4 v = acc[ai][bj][m][n]; v[0] *= g[0]; v[1] *= g[1]; v[2] *= g[2]; v[3] *= g[3];
                        if (mode > 0) v += *(const f32x4*)(mix32 + row * 1024 + c);
                        if (mode < 2) *(f32x4*)(mix32 + row * 1024 + c) = v;
                        else { u32x2 w; w.x = cvt_pk_bf16(v[0], v[1]); w.y = cvt_pk_bf16(v[2], v[3]); *(u32x2*)(mixbf + row * 1024 + c) = w; } }
                asm volatile("" ::: "memory"); }
    }
};
struct EpiMixCat {
    static constexpr bool PERM = true, MID = true;
    bf16_t* mixbf; const bf16_t* GF; int tid;
    __device__ __forceinline__ const bf16_t* gtile(const Unit& u, int b) const { return GF + ((size_t)(u.pm * 12 + 4 * b + u.pn) * 16) * 4096 + (size_t)tid * 8; }
    __device__ __forceinline__ void mid(f32x4 (&acc)[2][2][4][2], const Unit& u, int t, int wr, int wc, int fr, int fq) const {
        const int ga = (t == 8) ? 0 : 1; int off = 0; asm volatile("" : "+v"(off));
        const bf16_t* pa = gtile(u, ga) + off; const bf16_t* pb = gtile(u, ga + 1) + off;
        u32x4 va[2][4], vb[2][4];
        auto ldq = [&](int q, int sl) {
#pragma unroll
            for (int i = 0; i < 4; ++i) { const size_t o = (size_t)(q * 4 + i) * 4096; va[sl][i] = *(const u32x4*)(pa + o); vb[sl][i] = *(const u32x4*)(pb + o); } };
        ldq(0, 0); ldq(1, 1);
#pragma unroll
        for (int q = 0; q < 4; ++q) { const int sl = q & 1;
            asm volatile("" ::: "memory");
#pragma unroll
            for (int i = 0; i < 4; ++i) { const int f = q * 4 + i, ai = f >> 3, m = (f >> 1) & 3, bj = f & 1; float a[8], b[8]; unpack8(va[sl][i], a); unpack8(vb[sl][i], b);
#pragma unroll
                for (int j = 0; j < 8; ++j) b[j] = __builtin_amdgcn_rcpf(b[j]);
                acc[ai][bj][m][0] *= (f32x4){a[0], a[1], a[2], a[3]} * (f32x4){b[0], b[1], b[2], b[3]}; acc[ai][bj][m][1] *= (f32x4){a[4], a[5], a[6], a[7]} * (f32x4){b[4], b[5], b[6], b[7]}; }
            asm volatile("" ::: "memory");
            if (q + 2 < 4) ldq(q + 2, sl); }
    }
    __device__ __forceinline__ void operator()(const f32x4 (&acc)[2][2][4][2], const Unit& u, int wr, int wc, int fr, int fq) const {
        const int row0 = u.pm * 256 + wr * 64 + fr, col0 = u.pn * 256 + wc * 32 + 8 * fq; const bf16_t* pg = gtile(u, 2);
        u32x4 gv[16];
#pragma unroll
        for (int f = 0; f < 16; ++f) gv[f] = __builtin_nontemporal_load((const u32x4*)(pg + (size_t)f * 4096));
        asm volatile("" ::: "memory");
#pragma unroll
        for (int ai = 0; ai < 2; ++ai)
#pragma unroll
            for (int m = 0; m < 4; ++m) { bf16_t* rowp = mixbf + (size_t)(row0 + ai * 128 + m * 16) * 1024 + col0;
#pragma unroll
                for (int bj = 0; bj < 2; ++bj) { float g[8]; unpack8(gv[(ai * 4 + m) * 2 + bj], g);
                    const f32x4 v0 = acc[ai][bj][m][0], v1 = acc[ai][bj][m][1];
                    u32x4 w; w.x = cvt_pk_bf16(v0[0] * g[0], v0[1] * g[1]); w.y = cvt_pk_bf16(v0[2] * g[2], v0[3] * g[3]); w.z = cvt_pk_bf16(v1[0] * g[4], v1[1] * g[5]); w.w = cvt_pk_bf16(v1[2] * g[6], v1[3] * g[7]);
                    *(u32x4*)(rowp + bj * 128) = w; } }
    }
};
struct EpiX1 {
    static constexpr bool PERM = true, MID = false;
    const float* x; bf16_t* x1;
    __device__ __forceinline__ void operator()(const f32x4 (&acc)[2][2][4][2], const Unit& u, int wr, int wc, int fr, int fq) const {
        const int row0 = u.pm * 256 + wr * 64 + fr, col0 = u.pn * 256 + wc * 32 + 8 * fq;
        f32x4 xv[3][4];
        auto ldb = [&](int g, int sl) { const size_t off = (size_t)(row0 + (g >> 2) * 128 + (g & 3) * 16) * 1024 + col0;
#pragma unroll
            for (int bj = 0; bj < 2; ++bj) { xv[sl][bj * 2] = __builtin_nontemporal_load((const f32x4*)(x + off + bj * 128)); xv[sl][bj * 2 + 1] = __builtin_nontemporal_load((const f32x4*)(x + off + bj * 128 + 4)); } };
        ldb(0, 0); ldb(1, 1); ldb(2, 2);
#pragma unroll
        for (int g = 0; g < 8; ++g) { const int sl = g % 3, ai = g >> 2, m = g & 3; const size_t off = (size_t)(row0 + ai * 128 + m * 16) * 1024 + col0;
            asm volatile("" ::: "memory");
#pragma unroll
            for (int bj = 0; bj < 2; ++bj) { const f32x4 a = xv[sl][bj * 2] + acc[ai][bj][m][0], b = xv[sl][bj * 2 + 1] + acc[ai][bj][m][1];
                u32x4 w; w.x = cvt_pk_bf16(a[0], a[1]); w.y = cvt_pk_bf16(a[2], a[3]); w.z = cvt_pk_bf16(b[0], b[1]); w.w = cvt_pk_bf16(b[2], b[3]);
                *(u32x4*)(x1 + off + bj * 128) = w; }
            asm volatile("" ::: "memory");
            if (g + 3 < 8) ldb(g + 3, sl); }
    }
};
struct EpiSwiglu {
    static constexpr bool PERM = true, MID = false;
    static constexpr bool PRE = true;
    unsigned char* act; const float* b1; LAS unsigned char* lds;
    __device__ __forceinline__ void pre(const Unit& u, int wid, int wc, int lane) const {
        __builtin_amdgcn_global_load_lds((const unsigned*)(b1 + (size_t)u.tag * 2048 + 256 * u.pn + 64 * wc + lane), (LAS unsigned*)(lds + 131072 + u.aux * 2048 + wid * 256), 4, 0, 0); }
    __device__ __forceinline__ void operator()(const f32x4 (&acc)[2][2][4][2], const Unit& u, int wr, int wc, int fr, int fq) const {
        const int row0 = u.pm * 256 + wr * 64 + fr; const LAS float* be = (const LAS float*)(lds + 131072 + u.aux * 2048 + (wr * 4 + wc) * 256) + 16 * fq; const int j = 128 * u.pn + 32 * wc + 8 * fq;
        constexpr float CS = -1.702f * 1.44269504f, ICS = 1.0f / CS;
        f32x2 bgq[4], blq[4]; u32x2 wprev = {0u, 0u};
        float k1 = CS / 256.0f, k2 = 4.0f * ICS / 256.0f, k3 = 1.0f; asm volatile("" : "+v"(k1), "+v"(k2), "+v"(k3));
        const f32x2 kcs = {k1, k1}, kics = {k2, k2}, kone = {k3, k3};
#pragma unroll
        for (int q = 0; q < 4; ++q) { const f32x4 t = *(const LAS f32x4*)(be + 4 * q); bgq[q] = (f32x2){t[0] * CS, t[2] * CS}; blq[q] = (f32x2){(4.0f * t[1] + 4.0f) * ICS, (4.0f * t[3] + 4.0f) * ICS}; }
#pragma unroll
        for (int ai = 0; ai < 2; ++ai)
#pragma unroll
            for (int m = 0; m < 4; ++m) { float o[8];
#pragma unroll
                for (int n = 0; n < 2; ++n)
#pragma unroll
                    for (int ip = 0; ip < 2; ++ip) {
                        const f32x2 a0 = {acc[ai][0][m][n][2 * ip], acc[ai][0][m][n][2 * ip + 1]}, a1 = {acc[ai][1][m][n][2 * ip], acc[ai][1][m][n][2 * ip + 1]};
                        const f32x2 bgp = bgq[2 * n + ip], blp = blq[2 * n + ip];
                        f32x2 sg = a0 * kcs + bgp; sg[0] = fmaxf(sg[0], 7.0f * CS); sg[1] = fmaxf(sg[1], 7.0f * CS);
                        f32x2 ql = a1 * kics + blp; ql[0] = __builtin_amdgcn_fmed3f(ql[0], -24.0f * ICS, 32.0f * ICS); ql[1] = __builtin_amdgcn_fmed3f(ql[1], -24.0f * ICS, 32.0f * ICS);
                        f32x2 d = {__builtin_amdgcn_exp2f(sg[0]), __builtin_amdgcn_exp2f(sg[1])}; d = d + kone;
                        const f32x2 r = {__builtin_amdgcn_rcpf(d[0]), __builtin_amdgcn_rcpf(d[1])};
                        const f32x2 ov = sg * r * ql; o[4 * n + 2 * ip] = ov[0]; o[4 * n + 2 * ip + 1] = ov[1]; }
                u32x2 w; w.x = pack4_fp8(o[0], o[1], o[2], o[3]); w.y = pack4_fp8(o[4], o[5], o[6], o[7]);
                if (m & 1) { const u32x4 v16 = widen8(wprev, w);
                    *(u32x4*)(act + (size_t)(row0 + ai * 128 + (m - 1 + (fq & 1)) * 16) * 1024 + 128 * u.pn + 32 * wc + 16 * (fq >> 1)) = v16; }
                wprev = w; }
    }
};
struct EpiYs {
    static constexpr bool PERM = true, MID = false;
    static constexpr bool PRE = true;
    unsigned char* ys; const float* b2; LAS unsigned char* lds;
    __device__ __forceinline__ void pre(const Unit& u, int wid, int wc, int lane) const {
        __builtin_amdgcn_global_load_lds((const unsigned*)(b2 + (size_t)u.tag * 1024 + 256 * u.pn + (lane >> 5) * 128 + 32 * wc + (lane & 31)), (LAS unsigned*)(lds + 131072 + u.aux * 2048 + wid * 256), 4, 0, 0); }
    __device__ __forceinline__ void operator()(const f32x4 (&acc)[2][2][4][2], const Unit& u, int wr, int wc, int fr, int fq) const {
        const int row0 = u.pm * 256 + wr * 64 + fr; const LAS float* be = (const LAS float*)(lds + 131072 + u.aux * 2048 + (wr * 4 + wc) * 256) + 8 * fq; u32x2 wprev = {0u, 0u};
#pragma unroll
        for (int bj = 0; bj < 2; ++bj) { const f32x4 c0 = *(const LAS f32x4*)(be + bj * 32) * 32.0f, c1 = *(const LAS f32x4*)(be + bj * 32 + 4) * 32.0f;
#pragma unroll
            for (int ai = 0; ai < 2; ++ai)
#pragma unroll
                for (int m = 0; m < 4; ++m) { const f32x4 v0 = acc[ai][bj][m][0] * 0.25f + c0, v1 = acc[ai][bj][m][1] * 0.25f + c1;
                    u32x2 w; w.x = pack4_fp8(v0[0], v0[1], v0[2], v0[3]); w.y = pack4_fp8(v1[0], v1[1], v1[2], v1[3]);
                    if (m & 1) { const u32x4 v16 = widen8(wprev, w);
                        *(u32x4*)(ys + (size_t)(row0 + ai * 128 + (m - 1 + (fq & 1)) * 16) * 1024 + u.pn * 256 + wc * 32 + 16 * (fq >> 1) + bj * 128) = v16; }
                    wprev = w; } }
    }
};
template <bool GATHER_> struct SchedMoe {
    static constexpr bool GATHER = GATHER_;
    const char* A; const char* Bt; const LAS int* tstart; const int* stok; int lgN, total; size_t estride, tbytes;
    __device__ __forceinline__ bool next(int i, Unit& u) const {
        const int c = blockIdx.x; const int un = i * 256 + (c & 7) * 32 + (c >> 3); if (un >= total) return false;
        const int mt = un >> lgN, pn = un & ((1 << lgN) - 1); const int e = ((const LAS unsigned char*)tstart)[(LX_TEXP - LX_TSTART) + mt];
        u.pm = mt; u.pn = pn; u.tag = e; u.pa = GATHER ? A : A + (size_t)mt * tbytes; u.pb = Bt + (size_t)e * estride + (size_t)pn * tbytes; return true;
    }
    __device__ __forceinline__ unsigned a_off(const Unit& u, int h, int R, int C, int rowbytes) const { const int e = u.tag, ps = u.pm * 256 + h * 128 + R - tstart[(LX_SBASE - LX_TSTART) / 4 + e];
        const int tok = ps < tstart[(LX_CNT - LX_TSTART) / 4 + e] ? stok[(size_t)e * NTOK + ps] : 0; return (unsigned)(tok * rowbytes + C * 2); }
};

__device__ __forceinline__ int w1perm(int c) { const int j = c >> 1, s = c & 1; return ((j >> 7) << 8) | (s << 7) | (j & 127); }
constexpr int NTILE = 13664, NSMALL = 1376, TAIL1_A = 6, TAIL1_B = 20, TAIL6 = 8, NRES1 = 32 * TAIL1_A + 32 * TAIL1_B, NRES = NRES1 + 128 * TAIL6;
template <int D, class F> __device__ __forceinline__ void prep_tiles_d(const int wv, LAS unsigned char* lds, const int cnt, F tile_of) {
    KParams& p = *kparams();
    const int tid = opaque_tid(wv); unsigned char* ws = p.ws;
    LAS float* tile0 = (LAS float*)lds;
    if (cnt <= 0) return;
    static_assert((D & 1) == 0, "slot parity selects the staging buffer");
    LAS float* tile = tile0;
    asm volatile("s_waitcnt lgkmcnt(0)" ::: "memory"); __builtin_amdgcn_s_barrier();
    struct TileJob { const float* src; bf16_t* dst; unsigned char* dst8; int K, N, perm, f8, ldd, k0, n0; };
    auto decode = [&](int t) -> TileJob { TileJob j; j.dst = nullptr; j.dst8 = nullptr; j.f8 = 0; j.perm = 0; j.ldd = 0; int lt;
        if (t < 960) { j.src = p.in[3]; j.dst = (bf16_t*)(ws + OFF_WINT); j.K = 1024; j.N = 7680; lt = t; if ((lt % 120) >= 28) { j.f8 = 1; j.dst8 = ws + OFF_WIN8 - (size_t)1792 * 1024; } }
        else if (t < 1088) { j.src = p.in[18]; j.dst = (bf16_t*)(ws + OFF_WMKVT); j.K = 1024; j.N = 1024; lt = t - 960; }
        else if (t < 1152) { j.src = p.in[21]; j.dst = (bf16_t*)(ws + OFF_PCAT); j.K = 512; j.N = 1024; lt = t - 1088; j.ldd = 1280; }
        else if (t < 1184) { j.src = p.in[22]; j.dst = (bf16_t*)(ws + OFF_PCAT) + 512; j.K = 256; j.N = 1024; lt = t - 1152; j.ldd = 1280; }
        else if (t < 1248) { j.src = p.in[23]; j.dst = (bf16_t*)(ws + OFF_PCAT) + 768; j.K = 512; j.N = 1024; lt = t - 1184; j.ldd = 1280; }
        else if (t < 1376) { j.src = p.in[24]; j.dst = (bf16_t*)(ws + OFF_WOT); j.K = 1024; j.N = 1024; lt = t - 1248; }
        else if (t < 9568) { const int q = t - 1376, e = q >> 8; j.src = p.in[28] + (size_t)e * 1024 * 2048; j.dst8 = ws + OFF_W1T + (size_t)e * 2048 * 1024; j.K = 1024; j.N = 2048; j.perm = 1; lt = q & 255; j.f8 = 1; }
        else { const int q = t - 9568, e = q >> 7; j.src = p.in[30] + (size_t)e * 1024 * 1024; j.dst8 = ws + OFF_W2T + (size_t)e * 1024 * 1024; j.K = 1024; j.N = 1024; lt = q & 127; j.f8 = 1; }
        const int tn = j.N >> 6; j.k0 = (lt / tn) * 128; j.n0 = (lt % tn) * 64; return j; };
    { auto ldtile = [&](const TileJob& j, f32x4 (&v)[4]) {
#pragma unroll
          for (int i = 0; i < 4; ++i) { const int idx = tid + 512 * i, row = idx >> 4, c4 = idx & 15; v[i] = __builtin_nontemporal_load((const f32x4*)(j.src + (size_t)(j.k0 + row) * j.N + j.n0 + 4 * c4)); } };
      TileJob jb[D]; f32x4 vb[D][4];
#pragma unroll
      for (int d = 0; d < D; ++d) { jb[d] = decode(tile_of(d < cnt ? d : 0)); if (d < cnt) ldtile(jb[d], vb[d]); }
      auto one = [&](const int d, const int n, const bool always) {
#pragma unroll
          for (int i = 0; i < 4; ++i) { const int idx = tid + 512 * i, row = idx >> 4, c4 = idx & 15; LAS float* tp = tile + (d & 1) * (128 * 65) + row * 65 + 4 * c4; tp[0] = vb[d][i][0]; tp[1] = vb[d][i][1]; tp[2] = vb[d][i][2]; tp[3] = vb[d][i][3]; }
          asm volatile("s_waitcnt lgkmcnt(0)" ::: "memory"); __builtin_amdgcn_s_barrier();
          const LAS float* tile = tile0 + (d & 1) * (128 * 65);
          const TileJob cur = jb[d];
          if (always || n + D < cnt) { jb[d] = decode(tile_of(n + D)); ldtile(jb[d], vb[d]); }
          if (!cur.f8) {
#pragma unroll
              for (int i = 0; i < 2; ++i) { const int kc = (tid & 3) | (((tid >> 8) & 1) << 2) | (i << 3), n = (tid >> 2) & 63; float f[8];
#pragma unroll
                  for (int j = 0; j < 8; ++j) f[j] = tile[(kc * 8 + j) * 65 + n];
                  const int drow = cur.n0 + n;
                  *(u32x4*)(cur.dst + (size_t)drow * (cur.ldd ? cur.ldd : cur.K) + cur.k0 + kc * 8) = pack8(f); }
          } else {
              const int kc = (tid & 3) | (((tid >> 8) & 1) << 2), n = (tid >> 2) & 63; float f[16];
#pragma unroll
              for (int j = 0; j < 16; ++j) f[j] = tile[(kc * 16 + j) * 65 + n] * 32.0f;
              const int drow = cur.perm ? w1perm(cur.n0 + n) : (cur.n0 + n);
              u32x4 w; w.x = pack4_fp8(f[0], f[1], f[2], f[3]); w.y = pack4_fp8(f[4], f[5], f[6], f[7]); w.z = pack4_fp8(f[8], f[9], f[10], f[11]); w.w = pack4_fp8(f[12], f[13], f[14], f[15]);
              *(u32x4*)(cur.dst8 + (size_t)drow * cur.K + cur.k0 + kc * 16) = w; } };
      int n0 = 0;
      for (; n0 + 2 * D <= cnt; n0 += D) {
#pragma unroll
          for (int d = 0; d < D; ++d) one(d, n0 + d, true); }
      for (; n0 < cnt; n0 += D) {
#pragma unroll
          for (int d = 0; d < D; ++d) { if (n0 + d < cnt) one(d, n0 + d, false); } }
      asm volatile("s_waitcnt lgkmcnt(0)" ::: "memory"); __builtin_amdgcn_s_barrier(); }
}
template <class F> __device__ __forceinline__ void prep_tiles(const int wv, LAS unsigned char* lds, const int cnt, F tile_of) { prep_tiles_d<4>(wv, lds, cnt, tile_of); }
__device__ __forceinline__ void phase_prep(const int wv, LAS unsigned char* lds) {
    KParams& p = *kparams();
    const int tid = opaque_tid(wv); unsigned char* ws = p.ws;
    { const int wid = tid >> 6, lane = tid & 63; const int gw = blockIdx.x * 8 + wid, nw = gridDim.x * 8;
      const float* const px = p.in[0]; const float* const pmem = p.in[1]; const float* const pln1 = p.in[2]; const float* const plnm = p.in[17];
      f32x4 gx[4], gm[4];
#pragma unroll
      for (int i = 0; i < 4; ++i) { gx[i] = *(const f32x4*)(pln1 + 4 * lane + 256 * i); gm[i] = *(const f32x4*)(plnm + 4 * lane + 256 * i); }
      f32x4 va[3][4], vb[3][4];
      auto ldrows = [&](int row0, f32x4 (&v)[3][4]) {
#pragma unroll
          for (int r3 = 0; r3 < 3; ++r3) { const int row = row0 + r3 * nw; if (row < NTOK + 2048) { const float* src = row >= NTOK ? pmem + (size_t)(row - NTOK) * 1024 : px + (size_t)row * 1024;
#pragma unroll
              for (int i = 0; i < 4; ++i) v[r3][i] = __builtin_nontemporal_load((const f32x4*)(src + 4 * lane + 256 * i)); } } };
      auto dorows = [&](int row0, f32x4 (&v)[3][4]) {
#pragma unroll
          for (int r3 = 0; r3 < 3; ++r3) { const int row = row0 + r3 * nw; if (row >= NTOK + 2048) break;
              const bool ism = row >= NTOK; bf16_t* dst = ism ? (bf16_t*)(ws + OFF_HM) + (size_t)(row - NTOK) * 1024 : (bf16_t*)(ws + OFF_H) + (size_t)row * 1024;
              float ss = 0.f;
#pragma unroll
              for (int i = 0; i < 4; ++i) ss += v[r3][i][0] * v[r3][i][0] + v[r3][i][1] * v[r3][i][1] + v[r3][i][2] * v[r3][i][2] + v[r3][i][3] * v[r3][i][3];
              ss = red64(ss); const float rs = rsqrtf(ss * (1.0f / 1024.0f) + 1e-5f);
#pragma unroll
              for (int i = 0; i < 4; ++i) { const f32x4 g = ism ? gm[i] : gx[i]; const f32x4 y = v[r3][i] * rs * g;
                  u32x2 w; w.x = cvt_pk_bf16(y[0], y[1]); w.y = cvt_pk_bf16(y[2], y[3]);
                  *(u32x2*)(dst + 4 * lane + 256 * i) = w;
                  if (!ism) *(unsigned*)(ws + OFF_H8 + (size_t)row * 1024 + 4 * lane + 256 * i) = pack4_fp8(y[0] * 8.0f, y[1] * 8.0f, y[2] * 8.0f, y[3] * 8.0f); } } };
      if (gw < NTOK + 2048) ldrows(gw, va);
    { const int G = (int)gridDim.x, top = NSMALL - 1 - (int)blockIdx.x; prep_tiles(wv, lds, top >= 0 ? top / G + 1 : 0, [&](int n) { return top - n * G; }); }
      for (int row0 = gw; row0 < NTOK + 2048; row0 += 6 * nw) {
          if (row0 + 3 * nw < NTOK + 2048) ldrows(row0 + 3 * nw, vb);
          asm volatile("" ::: "memory");
          dorows(row0, va);
          if (row0 + 3 * nw < NTOK + 2048) { if (row0 + 6 * nw < NTOK + 2048) ldrows(row0 + 6 * nw, va);
              asm volatile("" ::: "memory");
              dorows(row0 + 3 * nw, vb); } }
    }
    { const float* w2 = p.in[6]; const float* a2 = p.in[8]; const float* g2 = p.in[9]; bf16_t* lt = (bf16_t*)(ws + OFF_LORAT);
      for (int idx = blockIdx.x * 512 + tid; idx < 1536 * 32; idx += gridDim.x * 512) { const int n = idx >> 5, kc = idx & 31; float f[8];
#pragma unroll
          for (int j = 0; j < 8; ++j) { const int k = kc * 8 + j; float val = 0.f;
              if (n < 512) { if (k < 64) val = w2[k * 512 + n]; }
              else if (n < 1024) { if (k >= 64 && k < 128) val = a2[(k - 64) * 512 + (n - 512)]; }
              else { if (k >= 128) val = g2[(k - 128) * 512 + (n - 1024)]; }
              f[j] = val; }
          *(u32x4*)(lt + (size_t)n * 256 + kc * 8) = pack8(f); } }
    { const float* wr = p.in[26]; bf16_t* wt = (bf16_t*)(ws + OFF_WRT);
      for (int idx = blockIdx.x * 512 + tid; idx < 32 * 1024; idx += gridDim.x * 512) { const int e = idx >> 10, k = idx & 1023; const float v = wr[k * 32 + e];
          const unsigned hi = cvt_pk_bf16(v, 0.f) & 0xffffu; const float vh = __uint_as_float(hi << 16); const unsigned lo = cvt_pk_bf16(v - vh, 0.f) & 0xffffu;
          wt[idx] = (bf16_t)hi; wt[32768 + idx] = (bf16_t)lo; } }
}

__device__ __forceinline__ void phase_elem_c(const int wv) {
    KParams& p = *kparams();
    const int gt = blockIdx.x * 512 + opaque_tid(wv), nthr = gridDim.x * 512; unsigned char* ws = p.ws;
    bf16_t* Z = (bf16_t*)(ws + OFF_Z); bf16_t* AL = (bf16_t*)(ws + OFF_ALORA); bf16_t* KV = (bf16_t*)(ws + OFF_KV);
    const float* mu = p.in[4];
    u32x4 za[4], zb[4]; const u32x4 zq0 = zero4u();
#pragma unroll
    for (int k = 0; k < 4; ++k) { const int idx = gt + k * nthr, t = idx >> 5, ch = idx & 31, col = C_ZW + 8 * ch;
        za[k] = *(const u32x4*)(Z + (size_t)t * INC + col);
        zb[k] = zq0; if ((t & (SEQ - 1)) != 0) zb[k] = *(const u32x4*)(Z + (size_t)(t - 1) * INC + col); }
#pragma unroll
    for (int k = 0; k < 4; ++k) { const int idx = gt + k * nthr, t = idx >> 5, ch = idx & 31, col = C_ZW + 8 * ch;
        float a[8], b[8]; unpack8(za[k], a); unpack8(zb[k], b);
        const f32x4 m0 = *(const f32x4*)(mu + col), m1 = *(const f32x4*)(mu + col + 4); const float mm[8] = {m0[0], m0[1], m0[2], m0[3], m1[0], m1[1], m1[2], m1[3]};
#pragma unroll
        for (int j = 0; j < 8; ++j) { float v = a[j] + (b[j] - a[j]) * mm[j]; if (ch < 8) v = tanhf(v); else if (ch >= 16) v = sigmoidf_(v); a[j] = v; }
        *(u32x4*)(AL + (size_t)t * 256 + 8 * ch) = pack8(a); }
}

__device__ __forceinline__ bf16x8 pack_frag(const f32x4 lo, const f32x4 hi) { u32x4 w; w.x = cvt_pk_bf16(lo[0], lo[1]); w.y = cvt_pk_bf16(lo[2], lo[3]); w.z = cvt_pk_bf16(hi[0], hi[1]); w.w = cvt_pk_bf16(hi[2], hi[3]); bf16x8 r; __builtin_memcpy(&r, &w, 16); return r; }
__device__ __forceinline__ bf16x8 tr2(LAS unsigned char* pa, LAS unsigned char* pb) { const s16x4 a = __builtin_amdgcn_ds_read_tr16_b64_v4i16((LAS s16x4*)pa), b = __builtin_amdgcn_ds_read_tr16_b64_v4i16((LAS s16x4*)pb); return __builtin_shufflevector(a, b, 0, 1, 2, 3, 4, 5, 6, 7); }
__device__ __forceinline__ bf16x8 rd2(LAS unsigned char* pa, LAS unsigned char* pb) { const s16x4 a = *(const LAS s16x4*)pa, b = *(const LAS s16x4*)pb; return __builtin_shufflevector(a, b, 0, 1, 2, 3, 4, 5, 6, 7); }
#define MFMA16(a, b, c) __builtin_amdgcn_mfma_f32_16x16x32_bf16((a), (b), (c), 0, 0, 0)
__device__ __forceinline__ int xoff(int row, int g) { return row * 64 + ((g ^ ((row ^ (row >> 3)) & 7)) << 3); }
constexpr int CP_XA = 0, CP_XR = 4096, CP_XB = 8192, CP_XK = 12288, CP_VL = 16384, CP_NL = 16384, CP_WAVE = 20480;
__device__ __forceinline__ void phase_chunk_pre(const int wv, LAS unsigned char* lds) {
    KParams& p = *kparams();
    const int tid = opaque_tid(wv), wid = tid >> 6, lane = tid & 63, fr = lane & 15, fq = lane >> 4; unsigned char* ws = p.ws;
    if (tid == 0) { *(u32x4*)(ws + OFF_CTL + CTL_KEEP + blockIdx.x * 16) = *(const LAS u32x4*)(lds + LDS_X); asm volatile("s_waitcnt vmcnt(0)" ::: "memory"); }
    __syncthreads();
    LAS unsigned char* wl = lds + wid * CP_WAVE;
    const bf16_t* Z = (const bf16_t*)(ws + OFF_Z); bf16_t* C1 = (bf16_t*)(ws + OFF_C1); bf16_t* C2 = (bf16_t*)(ws + OFF_C2);
    const float* mu = p.in[4]; const float* k_k = p.in[10]; const float* k_a = p.in[11]; const float* r_k = p.in[12]; const float* ln_w = p.in[13]; const float* ln_b = p.in[14];
    const f32x4 z4 = zero4f();
    const bf16_t* LT = (const bf16_t*)(ws + OFF_LORAT); const float* w0v = p.in[5]; const float* a0v = p.in[7];
    bf16_t* AL = (bf16_t*)(ws + OFF_ALORA);
    { int tida = tid; asm volatile("" : "+v"(tida));
      u32x4 za[2][2], zb[2][2]; const u32x4 zq0 = zero4u();
#pragma unroll
      for (int iu = 0; iu < 2; ++iu) { const int un = blockIdx.x + iu * (int)gridDim.x; const int tok0 = (un >> 6) * SEQ + (un & 63) * 32; const int t = tok0 + (tida >> 4);
#pragma unroll
          for (int g2 = 0; g2 < 2; ++g2) { const int col = C_ZW + 8 * ((tida & 15) * 2 + g2); za[iu][g2] = zq0; zb[iu][g2] = zq0;
              if (un < 512) { za[iu][g2] = *(const u32x4*)(Z + (size_t)t * INC + col); if ((t & (SEQ - 1)) != 0) zb[iu][g2] = *(const u32x4*)(Z + (size_t)(t - 1) * INC + col); } } }
      asm volatile("" ::: "memory");
#pragma unroll
      for (int iu = 0; iu < 2; ++iu) { const int un = blockIdx.x + iu * (int)gridDim.x; const int tok0 = (un >> 6) * SEQ + (un & 63) * 32; const int t = tok0 + (tida >> 4);
        if (un < 512) {
#pragma unroll
          for (int g2 = 0; g2 < 2; ++g2) { const int ch = (tida & 15) * 2 + g2, col = C_ZW + 8 * ch; float a[8], b[8]; unpack8(za[iu][g2], a); unpack8(zb[iu][g2], b);
              const f32x4 m0 = *(const f32x4*)(mu + col), m1 = *(const f32x4*)(mu + col + 4); const float mm[8] = {m0[0], m0[1], m0[2], m0[3], m1[0], m1[1], m1[2], m1[3]};
#pragma unroll
              for (int j = 0; j < 8; ++j) { float v = a[j] + (b[j] - a[j]) * mm[j]; if (ch < 8) v = 1.0f - 2.0f * __builtin_amdgcn_rcpf(1.0f + __builtin_amdgcn_exp2f(2.88539008f * v)); else if (ch >= 16) v = sigmoidf_(v); a[j] = v; }
              *(u32x4*)(AL + (size_t)t * 256 + 8 * ch) = pack8(a); } } }
      asm volatile("s_waitcnt vmcnt(0)" ::: "memory");
      __syncthreads(); }
    for (int un = blockIdx.x; un < 512; un += gridDim.x) {
        const int b_ = un >> 6, cc = un & 63, h_ = wid; const int pr = ((b_ * 8 + h_) << 6) | cc; const int tok0 = b_ * SEQ + cc * 32;
        float gamC;
        int tidl = tid; asm volatile("" : "+v"(tidl));
        const int lnl = tidl & 63, frl = tidl & 15, fql = (tidl >> 4) & 3;
        { const int fr = tidl & 15, fq = (tidl >> 4) & 3;
          bf16x8 wfa[16], tfa[8];
          float bw[4], ba[4];
#pragma unroll
          for (int mt = 0; mt < 4; ++mt) { bw[mt] = w0v[h_ * 64 + 16 * mt + fr]; ba[mt] = a0v[h_ * 64 + 16 * mt + fr]; }
#pragma unroll
          for (int kind = 0; kind < 2; ++kind)
#pragma unroll
              for (int ks = 0; ks < 2; ++ks) {
#pragma unroll
                  for (int nt = 0; nt < 2; ++nt) tfa[(kind * 2 + ks) * 2 + nt] = *(const bf16x8*)(AL + (size_t)(tok0 + 16 * nt + fr) * 256 + kind * 64 + 32 * ks + 8 * fq);
#pragma unroll
                  for (int mt = 0; mt < 4; ++mt) wfa[(kind * 2 + ks) * 4 + mt] = *(const bf16x8*)(LT + (size_t)(kind * 512 + h_ * 64 + 16 * mt + fr) * 256 + kind * 64 + 32 * ks + 8 * fq); }
          bf16x8 wfg[16], tfg[8];
#pragma unroll
          for (int kind = 0; kind < 3; ++kind) { const int nks = kind == 2 ? 4 : 2;
              if (kind == 1) { asm volatile("" ::: "memory");
#pragma unroll
                  for (int ks = 0; ks < 4; ++ks) {
#pragma unroll
                      for (int nt = 0; nt < 2; ++nt) tfg[ks * 2 + nt] = *(const bf16x8*)(AL + (size_t)(tok0 + 16 * nt + fr) * 256 + 128 + 32 * ks + 8 * fq);
#pragma unroll
                      for (int mt = 0; mt < 4; ++mt) wfg[ks * 4 + mt] = *(const bf16x8*)(LT + (size_t)(1024 + h_ * 64 + 16 * mt + fr) * 256 + 128 + 32 * ks + 8 * fq); }
                  asm volatile("" ::: "memory"); }
              f32x4 acc[4][2];
#pragma unroll
              for (int mt = 0; mt < 4; ++mt) { acc[mt][0] = z4; acc[mt][1] = z4; }
#pragma unroll
              for (int ks = 0; ks < nks; ++ks) { const bf16x8 tf0 = kind == 2 ? tfg[ks * 2] : tfa[(kind * 2 + ks) * 2], tf1 = kind == 2 ? tfg[ks * 2 + 1] : tfa[(kind * 2 + ks) * 2 + 1];
#pragma unroll
                  for (int mt = 0; mt < 4; ++mt) { const bf16x8 wf = kind == 2 ? wfg[ks * 4 + mt] : wfa[(kind * 2 + ks) * 4 + mt];
                      acc[mt][0] = MFMA16(tf0, wf, acc[mt][0]); acc[mt][1] = MFMA16(tf1, wf, acc[mt][1]); } }
#pragma unroll
              for (int mt = 0; mt < 4; ++mt) { const int ch = 16 * mt + fr; const float bv = kind == 0 ? bw[mt] : (kind == 1 ? ba[mt] : 0.f);
#pragma unroll
                  for (int nt = 0; nt < 2; ++nt) { f32x4 v = acc[mt][nt] + bv; LAS unsigned char* dst = wl + xoff(ch, 4 * nt + fql);
                      if (kind == 0) { float hf[4];
#pragma unroll
                          for (int j = 0; j < 4; ++j) v[j] = -0.60653066f * sigmoidf_(v[j]);
                          u32x2 hi; hi.x = cvt_pk_bf16(v[0], v[1]); hi.y = cvt_pk_bf16(v[2], v[3]);
                          hf[0] = v[0] - __uint_as_float(hi.x << 16); hf[1] = v[1] - __uint_as_float(hi.x & 0xffff0000u); hf[2] = v[2] - __uint_as_float(hi.y << 16); hf[3] = v[3] - __uint_as_float(hi.y & 0xffff0000u);
                          u32x2 lo; lo.x = cvt_pk_bf16(hf[0], hf[1]); lo.y = cvt_pk_bf16(hf[2], hf[3]);
                          *(LAS u32x2*)(dst + CP_XR) = hi; *(LAS u32x2*)(dst + CP_XB) = lo; }
                      else { if (kind == 1) {
#pragma unroll
                              for (int j = 0; j < 4; ++j) v[j] = sigmoidf_(v[j]); }
                          u32x2 w; w.x = cvt_pk_bf16(v[0], v[1]); w.y = cvt_pk_bf16(v[2], v[3]); *(LAS u32x2*)(dst + (kind == 1 ? CP_XK : CP_XA)) = w; } } } }
          asm volatile("s_waitcnt lgkmcnt(0)" ::: "memory"); }
        { const int c = h_ * 64 + (tidl & 63);
          const bf16_t* zp = Z + (size_t)tok0 * INC + c;
          const float mur = mu[c], muk = mu[C_K + c], muv = mu[C_V + c], kk_ = k_k[c], ka_ = k_a[c], rk_ = r_k[c], lnw = ln_w[c], lnb = ln_b[c];
          float pzr = 0.f, pzk = 0.f, pzv = 0.f;
          if (cc != 0) { pzr = __uint_as_float((unsigned)zp[-INC] << 16); pzk = __uint_as_float((unsigned)zp[-INC + C_K] << 16); pzv = __uint_as_float((unsigned)zp[-INC + C_V] << 16); }
          unsigned short zq[2][4][3]; u32x2 sq[2][4];
#pragma unroll
          for (int e = 0; e < 4; ++e) {
#pragma unroll
              for (int q = 0; q < 3; ++q) zq[0][e][q] = zp[(size_t)e * INC + q * 512]; }
#pragma unroll
          for (int r = 0; r < 4; ++r) sq[0][r] = *(const LAS u32x2*)(wl + r * 4096 + xoff(lnl, 0));
          __builtin_amdgcn_sched_barrier(0);
          float cs = 0.f, g = 1.0f;
#pragma unroll
          for (int t4 = 0; t4 < 8; ++t4) { unsigned pa[2], pr_[2], pb[2], pk[2];
              if (t4 < 7) {
#pragma unroll
                  for (int e = 0; e < 4; ++e) {
#pragma unroll
                      for (int q = 0; q < 3; ++q) zq[(t4 + 1) & 1][e][q] = zp[(size_t)((t4 + 1) * 4 + e) * INC + q * 512]; }
#pragma unroll
                  for (int r = 0; r < 4; ++r) sq[(t4 + 1) & 1][r] = *(const LAS u32x2*)(wl + r * 4096 + xoff(lnl, t4 + 1)); }
              __builtin_amdgcn_sched_barrier(0);
#pragma unroll
              for (int tp = 0; tp < 2; ++tp) { float va[2], vr[2], vb[2], vk[2];
#pragma unroll
                  for (int e = 0; e < 2; ++e) { const int te = tp * 2 + e, t = t4 * 4 + te;
                      const float zr = __uint_as_float((unsigned)zq[t4 & 1][te][0] << 16), zk = __uint_as_float((unsigned)zq[t4 & 1][te][1] << 16), zv = __uint_as_float((unsigned)zq[t4 & 1][te][2] << 16);
                      const float r = zr + (pzr - zr) * mur, k = zk + (pzk - zk) * muk, v = zv + (pzv - zv) * muv; pzr = zr; pzk = zk; pzv = zv;
                      const unsigned wg = sq[t4 & 1][0][te >> 1], wh = sq[t4 & 1][1][te >> 1], wlo = sq[t4 & 1][2][te >> 1], wa = sq[t4 & 1][3][te >> 1];
                      const float lw = __uint_as_float((te & 1) ? (wh & 0xffff0000u) : (wh << 16)) + __uint_as_float((te & 1) ? (wlo & 0xffff0000u) : (wlo << 16));
                      const float al = __uint_as_float((te & 1) ? (wa & 0xffff0000u) : (wa << 16)), gg = __uint_as_float((te & 1) ? (wg & 0xffff0000u) : (wg << 16));
                      const float kk = k * kk_, kp = k * (1.0f + (al - 1.0f) * ka_);
                      const float n2 = red64(kk * kk), bon = red64(r * kp * rk_);
                      const float kn = kk * __builtin_amdgcn_rsqf(fmaxf(n2, 1e-24f));
                      const float gm1 = g; cs += lw; g = __builtin_amdgcn_exp2f(cs * 1.44269504f); const float gi = __builtin_amdgcn_rcpf(g);
                      va[e] = -kn * gm1; vb[e] = kn * al * gi; vk[e] = kp * gi; vr[e] = r * g;
                      *(LAS bf16_t*)(wl + CP_VL + t * 128 + lane * 2) = (bf16_t)(cvt_pk_bf16(v, 0.f) & 0xffffu);
                      const size_t to = (size_t)(tok0 + t) * 512 + c;
                      C1[to] = (bf16_t)(cvt_pk_bf16(lnw * gg, 0.f) & 0xffffu); C2[to] = (bf16_t)(cvt_pk_bf16((lnb + bon * v) * gg, 0.f) & 0xffffu); }
                  pa[tp] = cvt_pk_bf16(va[0], va[1]); pr_[tp] = cvt_pk_bf16(vr[0], vr[1]); pb[tp] = cvt_pk_bf16(vb[0], vb[1]); pk[tp] = cvt_pk_bf16(vk[0], vk[1]); }
              { const int xo = xoff(lnl, t4);
              *(LAS u32x2*)(wl + CP_XA + xo) = (u32x2){pa[0], pa[1]}; *(LAS u32x2*)(wl + CP_XR + xo) = (u32x2){pr_[0], pr_[1]};
              *(LAS u32x2*)(wl + CP_XB + xo) = (u32x2){pb[0], pb[1]}; *(LAS u32x2*)(wl + CP_XK + xo) = (u32x2){pk[0], pk[1]}; }
              __builtin_amdgcn_sched_barrier(0); }
          gamC = g; }
        asm volatile("s_waitcnt lgkmcnt(0)" ::: "memory");
        bf16x8 Vf[4];
        { const int vtb = (4 * fq + (fr >> 2)) * 128 + (fr & 3) * 8;
#pragma unroll
          for (int nv = 0; nv < 4; ++nv) { LAS unsigned char* pp = wl + CP_VL + vtb + nv * 32; Vf[nv] = tr2(pp, pp + 2048); } }
        asm volatile("s_waitcnt lgkmcnt(0)" ::: "memory");
        const int trr = 8 * fql + (frl >> 2), trg = frl & 3;
        bf16x8 LakF[2], QrbF[2], QrkF[2];
#pragma unroll
        for (int yi = 0; yi < 2; ++yi) {
            bf16x8 fy[2][2];
#pragma unroll
            for (int nt = 0; nt < 2; ++nt)
#pragma unroll
                for (int s2 = 0; s2 < 2; ++s2) { LAS unsigned char* pb_ = wl + (yi ? CP_XR : CP_XA); fy[nt][s2] = tr2(pb_ + xoff(trr + 32 * s2, trg + 4 * nt), pb_ + xoff(trr + 32 * s2 + 4, trg + 4 * nt)); }
#pragma unroll
            for (int xi = 0; xi < 2; ++xi) {
                f32x4 d[2][2];
#pragma unroll
                for (int mi = 0; mi < 2; ++mi) { bf16x8 fx[2];
#pragma unroll
                    for (int s2 = 0; s2 < 2; ++s2) { LAS unsigned char* pb_ = wl + (xi ? CP_XK : CP_XB); fx[s2] = tr2(pb_ + xoff(trr + 32 * s2, trg + 4 * mi), pb_ + xoff(trr + 32 * s2 + 4, trg + 4 * mi)); }
#pragma unroll
                    for (int nt = 0; nt < 2; ++nt) {
                        if (mi == 1 && nt == 0) { d[mi][nt] = z4; continue; }
                        f32x4 acc = MFMA16(fx[0], fy[nt][0], z4); acc = MFMA16(fx[1], fy[nt][1], acc);
#pragma unroll
                        for (int j = 0; j < 4; ++j) { const int i = 16 * mi + 4 * fq + j, t = 16 * nt + fr; const bool ok = yi ? (i <= t) : (i < t); acc[j] = ok ? acc[j] : 0.f; }
                        d[mi][nt] = acc; } }
                if (yi == 0 && xi == 0) {
#pragma unroll
                    for (int mi = 0; mi < 2; ++mi)
#pragma unroll
                        for (int nt = 0; nt < 2; ++nt)
#pragma unroll
                            for (int j = 0; j < 4; ++j) *(LAS float*)(wl + CP_NL + ((16 * nt + fr) * 32 + 16 * mi + 4 * fq + j) * 4) = d[mi][nt][j];
                } else {
#pragma unroll
                    for (int nt = 0; nt < 2; ++nt) { const bf16x8 f = pack_frag(d[0][nt], d[1][nt]); if (yi == 0) LakF[nt] = f; else if (xi == 0) QrbF[nt] = f; else QrkF[nt] = f; } } } }
        asm volatile("s_waitcnt lgkmcnt(0)" ::: "memory");
        bf16x8 InvF[2];
        { const int c = lane & 31; float X[32];
#pragma unroll
          for (int t = 0; t < 32; ++t) { float a0 = (t == c) ? 1.0f : 0.f, a1 = 0.f;
#pragma unroll
              for (int i4 = 0; i4 < (t + 3) / 4; ++i4) { const f32x4 nv = *(const LAS f32x4*)(wl + CP_NL + (t * 32 + 4 * i4) * 4);
#pragma unroll
                  for (int e = 0; e < 4; ++e) if (4 * i4 + e < t) { if (e & 1) a1 = fmaf(nv[e], X[4 * i4 + e], a1); else a0 = fmaf(nv[e], X[4 * i4 + e], a0); } }
              X[t] = a0 + a1; }
          asm volatile("s_waitcnt lgkmcnt(0)" ::: "memory");
#pragma unroll
          for (int t = 0; t < 32; ++t) *(LAS float*)(wl + CP_NL + (t * 32 + c) * 4) = X[t];
          asm volatile("s_waitcnt lgkmcnt(0)" ::: "memory");
#pragma unroll
          for (int n = 0; n < 2; ++n) { const f32x4 lo = *(const LAS f32x4*)(wl + CP_NL + ((16 * n + fr) * 32 + 4 * fq) * 4), hi = *(const LAS f32x4*)(wl + CP_NL + ((16 * n + fr) * 32 + 16 + 4 * fq) * 4); InvF[n] = pack_frag(lo, hi); } }
        bf16x8 UF[4], AhF[4];
#pragma unroll
        for (int nv = 0; nv < 4; ++nv) { const f32x4 w0 = MFMA16(LakF[0], Vf[nv], z4), w1 = MFMA16(LakF[1], Vf[nv], z4); const bf16x8 wf = pack_frag(w0, w1);
            const f32x4 u0 = MFMA16(InvF[0], wf, z4), u1 = MFMA16(InvF[1], wf, z4); UF[nv] = pack_frag(u0, u1); }
#pragma unroll
        for (int nc = 0; nc < 4; ++nc) { const bf16x8 af = rd2(wl + CP_XA + xoff(16 * nc + frl, fql), wl + CP_XA + xoff(16 * nc + frl, fql + 4));
            const f32x4 h0 = MFMA16(InvF[0], af, z4), h1 = MFMA16(InvF[1], af, z4); AhF[nc] = pack_frag(h0, h1); }
        { f32x4 rt[4][2];
#pragma unroll
          for (int mc = 0; mc < 4; ++mc)
#pragma unroll
              for (int nt = 0; nt < 2; ++nt) { const s16x4 rr = __builtin_amdgcn_ds_read_tr16_b64_v4i16((LAS s16x4*)(wl + CP_XR + xoff(16 * mc + 4 * fql + (frl >> 2), (frl & 3) + 4 * nt)));
                  f32x4 cin; cin[0] = __uint_as_float((unsigned)(unsigned short)rr[0] << 16); cin[1] = __uint_as_float((unsigned)(unsigned short)rr[1] << 16); cin[2] = __uint_as_float((unsigned)(unsigned short)rr[2] << 16); cin[3] = __uint_as_float((unsigned)(unsigned short)rr[3] << 16);
                  rt[mc][nt] = MFMA16(AhF[mc], QrbF[nt], cin); }
          bf16x8* RTF = (bf16x8*)(ws + OFF_RTF) + (size_t)pr * 256;
#pragma unroll
          for (int nt = 0; nt < 2; ++nt)
#pragma unroll
              for (int s2 = 0; s2 < 2; ++s2) RTF[(nt * 2 + s2) * 64 + lane] = pack_frag(rt[2 * s2][nt], rt[2 * s2 + 1][nt]); }
        { u32x2* YLF = (u32x2*)(ws + OFF_YLF) + (size_t)pr * 512;
#pragma unroll
          for (int nv = 0; nv < 4; ++nv)
#pragma unroll
              for (int mt = 0; mt < 2; ++mt) { f32x4 y = MFMA16(QrbF[mt], UF[nv], z4); y = MFMA16(QrkF[mt], Vf[nv], y);
                  u32x2 w; w.x = cvt_pk_bf16(y[0], y[1]); w.y = cvt_pk_bf16(y[2], y[3]); YLF[(nv * 2 + mt) * 64 + lane] = w; } }
        { bf16x8* GTF = (bf16x8*)(ws + OFF_GTF) + (size_t)pr * 512; u32x2* HHF = (u32x2*)(ws + OFF_HHF) + (size_t)pr * 1024;
#pragma unroll
          for (int nc = 0; nc < 4; ++nc) { const bf16x8 bf_ = rd2(wl + CP_XB + xoff(16 * nc + frl, fql), wl + CP_XB + xoff(16 * nc + frl, fql + 4));
              const bf16x8 kf_ = rd2(wl + CP_XK + xoff(16 * nc + frl, fql), wl + CP_XK + xoff(16 * nc + frl, fql + 4));
              const float gcol = __int_as_float(__builtin_amdgcn_ds_bpermute((16 * nc + fr) << 2, __float_as_int(gamC)));
              f32x4 gt[4];
#pragma unroll
              for (int mc = 0; mc < 4; ++mc) { f32x4 a = MFMA16(AhF[mc], bf_, z4);
#pragma unroll
                  for (int j = 0; j < 4; ++j) { if (mc == nc && 4 * fq + j == fr) a[j] += 1.0f; a[j] *= gcol; }
                  gt[mc] = a; }
              GTF[(nc * 2 + 0) * 64 + lane] = pack_frag(gt[0], gt[1]); GTF[(nc * 2 + 1) * 64 + lane] = pack_frag(gt[2], gt[3]);
              f32x4 grow;
#pragma unroll
              for (int j = 0; j < 4; ++j) grow[j] = __int_as_float(__builtin_amdgcn_ds_bpermute((16 * nc + 4 * fq + j) << 2, __float_as_int(gamC)));
#pragma unroll
              for (int nv = 0; nv < 4; ++nv) { f32x4 hh = MFMA16(bf_, UF[nv], z4); hh = MFMA16(kf_, Vf[nv], hh); hh = hh * grow;
                  u32x2 w; w.x = cvt_pk_bf16(hh[0], hh[1]); w.y = cvt_pk_bf16(hh[2], hh[3]); HHF[(nv * 4 + nc) * 64 + lane] = w; } } }
        asm volatile("s_waitcnt lgkmcnt(0)" ::: "memory");
    }
    __syncthreads();
    if (tid == 0) *(LAS u32x4*)(lds + LDS_X) = *(const u32x4*)(ws + OFF_CTL + CTL_KEEP + blockIdx.x * 16);
}
__device__ __forceinline__ void phase_scan_seq(const int wv, LAS unsigned char* lds) {
    KParams& p = *kparams();
    const int tid = opaque_tid(wv), wid = __builtin_amdgcn_readfirstlane(tid >> 6), lane = tid & 63, fr = lane & 15, fq = lane >> 4; unsigned char* ws = p.ws;
    if (blockIdx.x >= 64) return;
    const int bh = blockIdx.x, b = bh >> 3, h = bh & 7;
    const char* gG = (const char*)(ws + OFF_GTF) + (size_t)bh * 64 * 8192; const char* gR = (const char*)(ws + OFF_RTF) + (size_t)bh * 64 * 4096;
    const char* gH = (const char*)(ws + OFF_HHF) + (size_t)bh * 64 * 8192; const char* gY = (const char*)(ws + OFF_YLF) + (size_t)bh * 64 * 4096;
    constexpr int SLOT = 24576;
    if (wid >= 4) {
        const int w = wid - 4;
        auto issue = [&](int c) { LAS unsigned char* slot = lds + (c % 5) * SLOT;
#pragma unroll
            for (int i = 0; i < 6; ++i) { const int pc = w + 4 * i;
                const char* src = pc < 8 ? gG + (size_t)c * 8192 + pc * 1024 : pc < 12 ? gR + (size_t)c * 4096 + (pc - 8) * 1024 : pc < 20 ? gH + (size_t)c * 8192 + (pc - 12) * 1024 : gY + (size_t)c * 4096 + (pc - 20) * 1024;
                __builtin_amdgcn_global_load_lds((const unsigned*)(src + lane * 16), (LAS unsigned*)(slot + pc * 1024), 16, 0, 0); } };
        issue(0); issue(1); issue(2); issue(3);
        asm volatile("s_waitcnt vmcnt(18)" ::: "memory");
        __builtin_amdgcn_s_barrier();
        for (int c = 0; c < 64; ++c) {
            if (c < 61) asm volatile("s_waitcnt vmcnt(12)" ::: "memory"); else asm volatile("s_waitcnt vmcnt(0)" ::: "memory");
            __builtin_amdgcn_s_barrier();
            if (c + 4 < 64) issue(c + 4);
        }
        return; }
    const int nv = wid;
    float* Yraw = (float*)(ws + OFF_YRAW) + (size_t)b * SEQ * 512 + h * 64 + 16 * nv + fr;
    f32x4 T[4]; const f32x4 z4s = zero4f();
#pragma unroll
    for (int m = 0; m < 4; ++m) T[m] = z4s;
    auto rd = [&](int c, bf16x8 (&G)[8], bf16x8 (&R)[4], u32x2 (&H)[4], u32x2 (&Y)[2]) { const LAS unsigned char* slot = lds + (c % 5) * SLOT + lane * 16;
#pragma unroll
        for (int i = 0; i < 8; ++i) G[i] = *(const LAS bf16x8*)(slot + i * 1024);
#pragma unroll
        for (int i = 0; i < 4; ++i) R[i] = *(const LAS bf16x8*)(slot + 8192 + i * 1024);
#pragma unroll
        for (int i = 0; i < 4; ++i) H[i] = *(const LAS u32x2*)(lds + (c % 5) * SLOT + 12288 + (nv * 4 + i) * 512 + lane * 8);
#pragma unroll
        for (int i = 0; i < 2; ++i) Y[i] = *(const LAS u32x2*)(lds + (c % 5) * SLOT + 20480 + (nv * 2 + i) * 512 + lane * 8); };
    auto step = [&](int c, const bf16x8 (&G)[8], const bf16x8 (&R)[4], const u32x2 (&H)[4], const u32x2 (&Y)[2]) {
        const bf16x8 tf0 = pack_frag(T[0], T[1]), tf1 = pack_frag(T[2], T[3]);
#pragma unroll
        for (int nt = 0; nt < 2; ++nt) { f32x4 y; y[0] = bf_lo(Y[nt].x); y[1] = bf_hi(Y[nt].x); y[2] = bf_lo(Y[nt].y); y[3] = bf_hi(Y[nt].y);
            y = MFMA16(R[nt * 2], tf0, y); y = MFMA16(R[nt * 2 + 1], tf1, y);
#pragma unroll
            for (int j = 0; j < 4; ++j) Yraw[(size_t)(c * 32 + 16 * nt + 4 * fq + j) * 512] = y[j]; }
#pragma unroll
        for (int m = 0; m < 4; ++m) { f32x4 t; t[0] = bf_lo(H[m].x); t[1] = bf_hi(H[m].x); t[2] = bf_lo(H[m].y); t[3] = bf_hi(H[m].y);
            t = MFMA16(G[m * 2], tf0, t); t = MFMA16(G[m * 2 + 1], tf1, t); T[m] = t; } };
    bf16x8 GA[8], RA[4], GB[8], RB[4]; u32x2 HA[4], YA[2], HB[4], YB[2];
    __builtin_amdgcn_s_barrier();
    rd(0, GA, RA, HA, YA);
    for (int c = 0; c < 64; c += 2) {
        __builtin_amdgcn_s_barrier();
        rd(c + 1, GB, RB, HB, YB);
        step(c, GA, RA, HA, YA);
        asm volatile("s_waitcnt lgkmcnt(0)" ::: "memory");
        __builtin_amdgcn_s_barrier();
        if (c + 2 < 64) rd(c + 2, GA, RA, HA, YA);
        step(c + 1, GB, RB, HB, YB);
        asm volatile("s_waitcnt lgkmcnt(0)" ::: "memory");
    }
}

__device__ __forceinline__ bf16x8 tr_pair(LAS unsigned char* pa, LAS unsigned char* pb, bool useB) {
    const s16x4 a = __builtin_amdgcn_ds_read_tr16_b64_v4i16((LAS s16x4*)pa);
    s16x4 b2 = (s16x4){0, 0, 0, 0};
    if (useB) b2 = __builtin_amdgcn_ds_read_tr16_b64_v4i16((LAS s16x4*)pb);
    return __builtin_shufflevector(a, b2, 0, 1, 2, 3, 4, 5, 6, 7);
}
__device__ __forceinline__ void phase_dil_attn(const int wv, LAS unsigned char* lds) {
    KParams& p = *kparams();
    const int tid = opaque_tid(wv), wid = tid >> 6, lane = tid & 63, fr = lane & 15, fq = lane >> 4; unsigned char* ws = p.ws;
    const bf16_t* Z = (const bf16_t*)(ws + OFF_Z); float* DILO = (float*)(ws + OFF_DILO); float* LSE = (float*)(ws + OFF_LSE);
    LAS unsigned char* kb = lds; LAS unsigned char* vb = lds + 32768; const float* qn = p.in[15]; const float* kn = p.in[16];
    float qkw[2][8];
#pragma unroll
    for (int ks = 0; ks < 2; ++ks)
#pragma unroll
        for (int j = 0; j < 8; ++j) qkw[ks][j] = qn[ks * 32 + 8 * fq + j] * kn[ks * 32 + 8 * fq + j];
    const bool seqwg = blockIdx.x < 64;
    const int ynd = ((int)blockIdx.x - 64) >> 3, ndil = ynd < 8 ? 5 : 8;
    const int u0 = seqwg ? 3 * (int)blockIdx.x : 192 + (int)blockIdx.x - 64, uend = seqwg ? 3 * (int)blockIdx.x + 3 : u0 + 192 * ndil, ustep = seqwg ? 1 : 192;
    auto umap = [&](int v) -> int { if (seqwg) return v; const int c2 = (int)blockIdx.x - 64, x = c2 & 7, y = c2 >> 3, i = (v - u0) / 192, k = i < 5 ? 24 * i + y : 120 + (y - 8) * 3 + (i - 5); return 192 + (k >> 3) * 64 + 8 * x + (k & 7); };
    const int kr = tid >> 3, kpc = tid & 7;
    u32x4 kvA[4], vvA[4], qvA[2], kvB[4], vvB[4], qvB[2]; bool kvalidA = false, kvalidB = false;
    auto unit_load = [&](int uv, u32x4 (&kv)[4], u32x4 (&vv)[4], u32x4 (&qv)[2], bool& kvalid) { const int u = umap(uv);
        const int b = u / 192, rem = u % 192, hh = rem >> 4, qb = rem & 15, g = hh >> 2;
        const int dil = g == 0 ? 1 : (g == 1 ? 4 : 16), nbc = 16 / dil, r = qb / nbc, j0 = (qb % nbc) * 128;
        const bf16_t* Zb = Z + (size_t)b * SEQ * INC; kvalid = j0 != 0;
#pragma unroll
        for (int i = 0; i < 4; ++i) { const int kj = j0 - 128 + kr + 64 * i; const bf16_t* rowp = Zb + (size_t)((kj >= 0 ? kj : 0) * dil + r) * INC + hh * 64 + kpc * 8;
            kv[i] = *(const u32x4*)(rowp + C_DK); vv[i] = *(const u32x4*)(rowp + C_DV); }
        const int tq = (j0 + 16 * wid + fr) * dil + r;
#pragma unroll
        for (int ks = 0; ks < 2; ++ks) qv[ks] = *(const u32x4*)(Zb + (size_t)tq * INC + C_DQ + hh * 64 + ks * 32 + 8 * fq); };
    auto do_unit = [&](const int uvv, u32x4 (&kv)[4], u32x4 (&vv)[4], u32x4 (&qv)[2], bool& kvalid) { const int u = umap(uvv); const int uv_ = uvv;
        const int b = u / 192, rem = u % 192, hh = rem >> 4, qb = rem & 15, g = hh >> 2, hg = hh & 3;
        const int dil = g == 0 ? 1 : (g == 1 ? 4 : 16), nbc = 16 / dil, r = qb / nbc, j0 = (qb % nbc) * 128;
        {
#pragma unroll
          for (int i = 0; i < 4; ++i) { const int row = kr + 64 * i;
              if (kvalid || i >= 2) { const float ss = red8(sumsq8(kv[i]));
                  const float rs = rsqrtf(ss * (1.0f / 64.0f) + 1e-5f); kv[i] = scale8s(kv[i], rs); }
              else { const u32x4 zu = zero4u(); kv[i] = zu; vv[i] = zu; }
              const int sw = kpc ^ (row & 7); *(LAS u32x4*)(kb + row * 128 + sw * 16) = kv[i]; *(LAS u32x4*)(vb + row * 128 + sw * 16) = vv[i]; } }
        const int qi = 16 * wid + fr, tq = (j0 + qi) * dil + r;
        bf16x8 qf[2];
        { float ss = sumsq8(qv[0]) + sumsq8(qv[1]); ss += sxor(ss, 16); ss += sxor(ss, 32);
          const float rs = rsqrtf(ss * (1.0f / 64.0f) + 1e-5f) * 0.125f;
#pragma unroll
          for (int ks = 0; ks < 2; ++ks) { const u32x4 w = scale8r(qv[ks], rs, qkw[ks]); __builtin_memcpy(&qf[ks], &w, 16); } }
        asm volatile("s_waitcnt lgkmcnt(0)" ::: "memory"); __builtin_amdgcn_s_barrier();
        if (uv_ + 2 * ustep < uend) unit_load(uv_ + 2 * ustep, kv, vv, qv, kvalid);
        f32x4 st[9]; float mx = -1e30f; const f32x4 zq = zero4f(); const int dq = fr - 4 * fq;
        LAS unsigned char* kp0 = kb + (16 * wid + fr) * 128 + ((fq ^ (fr & 7)) << 4); LAS unsigned char* kp1 = kb + (16 * wid + fr) * 128 + (((4 + fq) ^ (fr & 7)) << 4);
#pragma unroll
        for (int ti = 0; ti < 9; ++ti) {
            const bf16x8 k0 = *(const LAS bf16x8*)(kp0 + ti * 2048), k1 = *(const LAS bf16x8*)(kp1 + ti * 2048);
            f32x4 s = __builtin_amdgcn_mfma_f32_16x16x32_bf16(k0, qf[0], zq, 0, 0, 0);
            s = __builtin_amdgcn_mfma_f32_16x16x32_bf16(k1, qf[1], s, 0, 0, 0);
#pragma unroll
            for (int j = 0; j < 4; ++j) {
                const bool tv = (j0 != 0) || (wid + ti >= 8); const bool ok = ti == 0 ? (tv && dq <= j) : (ti == 8 ? (tv && dq >= j) : tv);
                s[j] = ok ? s[j] : -1e30f; mx = fmaxf(mx, s[j]); }
            st[ti] = s; }
        mx = fmaxf(mx, sxor(mx, 16)); mx = fmaxf(mx, sxor(mx, 32));
        float den = 0.f;
#pragma unroll
        for (int ti = 0; ti < 9; ++ti)
#pragma unroll
            for (int j = 0; j < 4; ++j) { const float e = __builtin_amdgcn_exp2f((st[ti][j] - mx) * 1.44269504f); st[ti][j] = e; den += e; }
        den += sxor(den, 16); den += sxor(den, 32);
        f32x4 o[4];
#pragma unroll
        for (int dt = 0; dt < 4; ++dt) o[dt] = zq;
        const int q4 = fr >> 2, p4 = fr & 3; const int kl = 4 * fq + q4;
        LAS unsigned char* vp[4];
#pragma unroll
        for (int dt = 0; dt < 4; ++dt) vp[dt] = vb + (16 * wid + kl) * 128 + (((2 * dt + (p4 >> 1)) ^ (kl & 7)) << 4) + (p4 & 1) * 8;
#pragma unroll
        for (int pp = 0; pp < 5; ++pp) { const bool two = pp < 4; const int tA = 2 * pp, tB = two ? 2 * pp + 1 : 2 * pp;
            u32x4 pw; pw.x = cvt_pk_bf16(st[tA][0], st[tA][1]); pw.y = cvt_pk_bf16(st[tA][2], st[tA][3]);
            if (two) { pw.z = cvt_pk_bf16(st[tB][0], st[tB][1]); pw.w = cvt_pk_bf16(st[tB][2], st[tB][3]); } else { pw.z = 0u; pw.w = 0u; }
            bf16x8 pf; __builtin_memcpy(&pf, &pw, 16);
#pragma unroll
            for (int dt = 0; dt < 4; ++dt) { const bf16x8 vf = tr_pair(vp[dt] + tA * 2048, vp[dt] + tB * 2048, two);
                o[dt] = __builtin_amdgcn_mfma_f32_16x16x32_bf16(vf, pf, o[dt], 0, 0, 0); } }
        const float inv = __builtin_amdgcn_rcpf(den); const size_t ob = ((size_t)(g * NTOK + b * SEQ + tq) * 4 + hg);
#pragma unroll
        for (int dt = 0; dt < 4; ++dt) *(f32x4*)(DILO + ob * 64 + 16 * dt + 4 * fq) = o[dt] * inv;
        if (fq == 0) LSE[ob] = mx + __logf(den);
        asm volatile("s_waitcnt lgkmcnt(0)" ::: "memory"); __builtin_amdgcn_s_barrier();
    };
    if (u0 < uend) unit_load(u0, kvA, vvA, qvA, kvalidA);
    if (u0 + ustep < uend) unit_load(u0 + ustep, kvB, vvB, qvB, kvalidB);
    for (int u = u0; u < uend; u += 2 * ustep) {
        do_unit(u, kvA, vvA, qvA, kvalidA);
        if (u + ustep < uend) do_unit(u + ustep, kvB, vvB, qvB, kvalidB);
    }
}

__device__ __forceinline__ void phase_mem_attn(const int wv, LAS unsigned char* lds) {
    KParams& p = *kparams();
    const int tid = opaque_tid(wv), wid = tid >> 6, lane = tid & 63, fr = lane & 15, fq = lane >> 4; unsigned char* ws = p.ws;
    const bf16_t* Z = (const bf16_t*)(ws + OFF_Z); const bf16_t* KV = (const bf16_t*)(ws + OFF_KV); bf16_t* YM = (bf16_t*)(ws + OFF_YCAT) + 768;
    LAS unsigned char* kb = lds; LAS unsigned char* vb = lds + 65536; const float* mqn = p.in[19]; const float* mkn = p.in[20];
    if (blockIdx.x < 64) return;
    float mqk[4][8];
#pragma unroll
    for (int ks = 0; ks < 4; ++ks)
#pragma unroll
        for (int j = 0; j < 8; ++j) mqk[ks][j] = mqn[ks * 32 + 8 * fq + j] * mkn[ks * 32 + 8 * fq + j];
    for (int bhq = (int)blockIdx.x - 64; bhq < 256; bhq += (int)gridDim.x - 64) {
        const int bhm = bhq >> 3, b = bhm >> 2, hm = bhm & 3;
        { const int kr = tid >> 4, kpc = tid & 15;
          u32x4 kv[8], vv[8];
#pragma unroll
          for (int i = 0; i < 8; ++i) { const bf16_t* rowp = KV + (size_t)(b * 256 + kr + 32 * i) * 1024 + hm * 128 + kpc * 8; kv[i] = *(const u32x4*)rowp; vv[i] = *(const u32x4*)(rowp + 512); }
#pragma unroll
          for (int i = 0; i < 8; ++i) { const int row = kr + 32 * i; const float ss = red16(sumsq8(kv[i])); const float rs = rsqrtf(ss * (1.0f / 128.0f) + 1e-5f);
              kv[i] = scale8s(kv[i], rs);
              const int sw = kpc ^ (row & 15); *(LAS u32x4*)(kb + row * 256 + sw * 16) = kv[i]; *(LAS u32x4*)(vb + row * 256 + sw * 16) = vv[i]; } }
        asm volatile("s_waitcnt lgkmcnt(0)" ::: "memory"); __builtin_amdgcn_s_barrier();
        const int q4 = fr >> 2, p4 = fr & 3; const int kl = 4 * fq + q4;
        LAS unsigned char* kp[4]; LAS unsigned char* vp[8];
#pragma unroll
        for (int ks = 0; ks < 4; ++ks) kp[ks] = kb + fr * 256 + (((4 * ks + fq) ^ fr) << 4);
#pragma unroll
        for (int dt = 0; dt < 8; ++dt) vp[dt] = vb + kl * 256 + (((2 * dt + (p4 >> 1)) ^ kl) << 4) + (p4 & 1) * 8;
        for (int qq = 0; qq < 2; ++qq) { const int qblk = (bhq & 7) * 2 + qq; const int tq = b * SEQ + qblk * 128 + 16 * wid + fr;
            bf16x8 qf[4];
#pragma unroll
            for (int ks = 0; ks < 4; ++ks) qf[ks] = *(const bf16x8*)(Z + (size_t)tq * INC + C_MQ + hm * 128 + ks * 32 + 8 * fq);
            { u32x4 qv[4]; float ss = 0.f;
#pragma unroll
              for (int ks = 0; ks < 4; ++ks) { __builtin_memcpy(&qv[ks], &qf[ks], 16); ss += sumsq8(qv[ks]); }
              ss += sxor(ss, 16); ss += sxor(ss, 32); const float rs = rsqrtf(ss * (1.0f / 128.0f) + 1e-5f);
#pragma unroll
              for (int ks = 0; ks < 4; ++ks) { const u32x4 w = scale8r(qv[ks], rs, mqk[ks]); __builtin_memcpy(&qf[ks], &w, 16); } }
            f32x4 st[16]; float mx = -1e30f; const f32x4 zq = zero4f();
#pragma unroll
            for (int ti = 0; ti < 16; ++ti) { f32x4 s = zq;
#pragma unroll
                for (int ks = 0; ks < 4; ++ks) { const bf16x8 kf = *(const LAS bf16x8*)(kp[ks] + ti * 4096); s = __builtin_amdgcn_mfma_f32_16x16x32_bf16(kf, qf[ks], s, 0, 0, 0); }
#pragma unroll
                for (int j = 0; j < 4; ++j) mx = fmaxf(mx, s[j]);
                st[ti] = s; if (ti & 1) asm volatile("" ::: "memory"); }
            mx = fmaxf(mx, sxor(mx, 16)); mx = fmaxf(mx, sxor(mx, 32));
            const float sc = 0.08838834764831845f * 1.44269504f; float den = 0.f;
#pragma unroll
            for (int ti = 0; ti < 16; ++ti)
#pragma unroll
                for (int j = 0; j < 4; ++j) { const float e = __builtin_amdgcn_exp2f((st[ti][j] - mx) * sc); st[ti][j] = e; den += e; }
            den += sxor(den, 16); den += sxor(den, 32);
            f32x4 o[8];
#pragma unroll
            for (int dt = 0; dt < 8; ++dt) o[dt] = zq;
#pragma unroll
            for (int pp = 0; pp < 8; ++pp) { const int tA = 2 * pp, tB = 2 * pp + 1;
                u32x4 pw; pw.x = cvt_pk_bf16(st[tA][0], st[tA][1]); pw.y = cvt_pk_bf16(st[tA][2], st[tA][3]); pw.z = cvt_pk_bf16(st[tB][0], st[tB][1]); pw.w = cvt_pk_bf16(st[tB][2], st[tB][3]);
                bf16x8 pf; __builtin_memcpy(&pf, &pw, 16);
#pragma unroll
                for (int dt = 0; dt < 8; ++dt) { const bf16x8 vf = tr_pair(vp[dt] + tA * 4096, vp[dt] + tB * 4096, true);
                    o[dt] = __builtin_amdgcn_mfma_f32_16x16x32_bf16(vf, pf, o[dt], 0, 0, 0); } }
            const float inv = __builtin_amdgcn_rcpf(den);
#pragma unroll
            for (int dt = 0; dt < 8; dt += 2) { u32x2 wa, wb; wa.x = cvt_pk_bf16(o[dt][0] * inv, o[dt][1] * inv); wa.y = cvt_pk_bf16(o[dt][2] * inv, o[dt][3] * inv);
                wb.x = cvt_pk_bf16(o[dt + 1][0] * inv, o[dt + 1][1] * inv); wb.y = cvt_pk_bf16(o[dt + 1][2] * inv, o[dt + 1][3] * inv);
                *(u32x4*)(YM + (size_t)tq * 1280 + hm * 128 + 16 * (dt + (fq & 1)) + 4 * (fq & 2)) = widen8(wa, wb); } }
        asm volatile("s_waitcnt lgkmcnt(0)" ::: "memory"); __builtin_amdgcn_s_barrier();
    }
}

__device__ __forceinline__ void phase_post(const int wv) {
    KParams& p = *kparams();
    const int gt = blockIdx.x * 512 + opaque_tid(wv), nthr = gridDim.x * 512; unsigned char* ws = p.ws;
    const float* Yraw = (const float*)(ws + OFF_YRAW); const bf16_t* C1 = (const bf16_t*)(ws + OFF_C1); const bf16_t* C2 = (const bf16_t*)(ws + OFF_C2); bf16_t* YR = (bf16_t*)(ws + OFF_YCAT);
    for (int idx0 = gt; idx0 < NTOK * 128; idx0 += 8 * nthr) { f32x4 yv[8]; u32x2 c1v[8], c2v[8];
#pragma unroll
        for (int q = 0; q < 8; ++q) { const int idx = idx0 + q * nthr, t = idx >> 7, c = ((idx >> 4) & 7) * 64 + 4 * (idx & 15);
            yv[q] = __builtin_nontemporal_load((const f32x4*)(Yraw + (size_t)t * 512 + c)); c1v[q] = __builtin_nontemporal_load((const u32x2*)(C1 + (size_t)t * 512 + c)); c2v[q] = __builtin_nontemporal_load((const u32x2*)(C2 + (size_t)t * 512 + c)); }
        asm volatile("" ::: "memory");
#pragma unroll
        for (int q = 0; q < 8; ++q) { const int idx = idx0 + q * nthr, t = idx >> 7, c = ((idx >> 4) & 7) * 64 + 4 * (idx & 15); const f32x4 y = yv[q];
            const float mean = red16(y[0] + y[1] + y[2] + y[3]) * (1.0f / 64.0f);
            const f32x4 d = y - mean; const float var = red16(d[0] * d[0] + d[1] * d[1] + d[2] * d[2] + d[3] * d[3]) * (1.0f / 64.0f);
            const float rs = rsqrtf(var + 64.0f * 1e-5f);
            float c1[4], c2[4]; unpack4(c1v[q], c1); unpack4(c2v[q], c2);
            u32x2 w; w.x = cvt_pk_bf16(d[0] * rs * c1[0] + c2[0], d[1] * rs * c1[1] + c2[1]); w.y = cvt_pk_bf16(d[2] * rs * c1[2] + c2[2], d[3] * rs * c1[3] + c2[3]);
            *(u32x2*)(YR + (size_t)t * 1280 + c) = w; }
        asm volatile("" ::: "memory"); }
    const float* DILO = (const float*)(ws + OFF_DILO); const float* LSE = (const float*)(ws + OFF_LSE); bf16_t* YD = (bf16_t*)(ws + OFF_YCAT) + 512;
    for (int idx0 = gt; idx0 < NTOK * 64; idx0 += 8 * nthr) { f32x4 ov[8][3]; float lv[8][3];
#pragma unroll
        for (int q = 0; q < 8; ++q) { const int idx = idx0 + q * nthr, t = idx >> 6, hg = (idx >> 4) & 3, qq = idx & 15;
#pragma unroll
            for (int g = 0; g < 3; ++g) { lv[q][g] = LSE[((size_t)g * NTOK + t) * 4 + hg]; ov[q][g] = __builtin_nontemporal_load((const f32x4*)(DILO + (((size_t)g * NTOK + t) * 4 + hg) * 64 + 4 * qq)); } }
        asm volatile("" ::: "memory");
#pragma unroll
        for (int q = 0; q < 8; ++q) { const int idx = idx0 + q * nthr, t = idx >> 6, hg = (idx >> 4) & 3, qq = idx & 15;
            const float l0 = lv[q][0], l1 = lv[q][1], l2 = lv[q][2];
            const float m = fmaxf(l0, fmaxf(l1, l2)); const float e0 = __expf(l0 - m), e1 = __expf(l1 - m), e2 = __expf(l2 - m); const float inv = __builtin_amdgcn_rcpf(e0 + e1 + e2);
            const f32x4 o = (ov[q][0] * e0 + ov[q][1] * e1 + ov[q][2] * e2) * inv;
            u32x2 w; w.x = cvt_pk_bf16(o[0], o[1]); w.y = cvt_pk_bf16(o[2], o[3]); *(u32x2*)(YD + (size_t)t * 1280 + hg * 64 + 4 * qq) = w; }
        asm volatile("" ::: "memory"); }
}

__device__ __forceinline__ void phase_router(const int wv, LAS unsigned char* lds, const bool real = true) {
    KParams& p = *kparams();
    const int tid = opaque_tid(wv), wid = tid >> 6, lane = tid & 63, fr = lane & 15, fq = lane >> 4; unsigned char* ws = p.ws;
    const bf16_t* X1 = (const bf16_t*)(ws + OFF_X1B); const float* ln2 = p.in[25]; const float* br = p.in[27]; const bf16_t* WRT = (const bf16_t*)(ws + OFF_WRT);
    unsigned char* XN2 = ws + OFF_XN2; int* TOPE = (int*)(ws + OFF_TOPE); float* TOPG = (float*)(ws + OFF_TOPG);
    LAS int* hist = (LAS int*)(lds + LX_HIST); LAS int* bbase = (LAS int*)(lds + LX_BBASE);
    LAS float* part = (LAS float*)lds;
    if (tid < 32) hist[tid] = 0;
    const int tg = wid & 3, kh = wid >> 2; const int t = blockIdx.x * 64 + tg * 16 + fr;
    int tek[4] = {0, 0, 0, 0}, lrk[4] = {0, 0, 0, 0};
    f32x4 acc[2]; float ss;
    {
        u32x4 xr[4][4];
#pragma unroll
        for (int g4 = 0; g4 < 4; ++g4) { const bf16_t* xp = X1 + (size_t)(blockIdx.x * 64 + g4 * 16 + fr) * 1024 + wid * 128 + 8 * fq;
#pragma unroll
            for (int s2 = 0; s2 < 4; ++s2) xr[g4][s2] = *(const u32x4*)(xp + 32 * s2); }
        f32x4 pa[4][2]; float ps4[4]; const f32x4 zz = zero4f();
#pragma unroll
        for (int g4 = 0; g4 < 4; ++g4) { pa[g4][0] = zz; pa[g4][1] = zz; ps4[g4] = 0.f; }
#pragma unroll
        for (int s2 = 0; s2 < 4; ++s2) { const int k = wid * 128 + 32 * s2 + 8 * fq;
            const f32x4 g0 = *(const f32x4*)(ln2 + k), g1 = *(const f32x4*)(ln2 + k + 4);
            bf16x8 wh[2], wl[2];
#pragma unroll
            for (int m = 0; m < 2; ++m) { wh[m] = *(const bf16x8*)(WRT + (size_t)(16 * m + fr) * 1024 + k); wl[m] = *(const bf16x8*)(WRT + 32768 + (size_t)(16 * m + fr) * 1024 + k); }
#pragma unroll
            for (int g4 = 0; g4 < 4; ++g4) { float x[8]; unpack8(xr[g4][s2], x);
                ps4[g4] += x[0] * x[0] + x[1] * x[1] + x[2] * x[2] + x[3] * x[3] + x[4] * x[4] + x[5] * x[5] + x[6] * x[6] + x[7] * x[7];
                float xg[8]; xg[0] = x[0] * g0[0]; xg[1] = x[1] * g0[1]; xg[2] = x[2] * g0[2]; xg[3] = x[3] * g0[3]; xg[4] = x[4] * g1[0]; xg[5] = x[5] * g1[1]; xg[6] = x[6] * g1[2]; xg[7] = x[7] * g1[3];
                const u32x4 hi = pack8(xg); float hf[8]; unpack8(hi, hf);
#pragma unroll
                for (int j = 0; j < 8; ++j) hf[j] = xg[j] - hf[j];
                const u32x4 lo = pack8(hf);
                bf16x8 xh, xl; __builtin_memcpy(&xh, &hi, 16); __builtin_memcpy(&xl, &lo, 16);
#pragma unroll
                for (int m = 0; m < 2; ++m) { pa[g4][m] = MFMA16(wh[m], xh, pa[g4][m]); pa[g4][m] = MFMA16(wh[m], xl, pa[g4][m]); pa[g4][m] = MFMA16(wl[m], xh, pa[g4][m]); } } }
#pragma unroll
        for (int g4 = 0; g4 < 4; ++g4) { float sq = ps4[g4]; sq += sxor(sq, 16); sq += sxor(sq, 32);
#pragma unroll
            for (int m = 0; m < 2; ++m)
#pragma unroll
                for (int j = 0; j < 4; ++j) part[((wid * 4 + g4) * 9 + m * 4 + j) * 64 + lane] = pa[g4][m][j];
            part[((wid * 4 + g4) * 9 + 8) * 64 + lane] = sq; }
        __syncthreads();
        acc[0] = zz; acc[1] = zz; ss = 0.f;
#pragma unroll
        for (int sw = 0; sw < 8; ++sw) {
#pragma unroll
            for (int m = 0; m < 2; ++m)
#pragma unroll
                for (int j = 0; j < 4; ++j) acc[m][j] += part[((sw * 4 + tg) * 9 + m * 4 + j) * 64 + lane];
            ss += part[((sw * 4 + tg) * 9 + 8) * 64 + lane]; } }
    const float rs = rsqrtf(ss * (1.0f / 1024.0f) + 1e-5f);
    if (real) {
        float r8 = rs * 8.0f; asm volatile("" : "+v"(r8));
        u32x4 xv[16];
#pragma unroll
        for (int s2 = 0; s2 < 16; ++s2) xv[s2] = *(const u32x4*)(X1 + (size_t)t * 1024 + kh * 512 + 32 * s2 + 8 * fq);
        asm volatile("" ::: "memory");
#pragma unroll
        for (int h8 = 0; h8 < 2; ++h8) { f32x4 gq[8][2];
#pragma unroll
            for (int q = 0; q < 8; ++q) { const int k = kh * 512 + 32 * (8 * h8 + q) + 8 * fq; gq[q][0] = *(const f32x4*)(ln2 + k); gq[q][1] = *(const f32x4*)(ln2 + k + 4); }
            asm volatile("" ::: "memory");
#pragma unroll
            for (int q = 0; q < 8; ++q) { const int s2 = 8 * h8 + q; float x[8]; unpack8(xv[s2], x); const f32x4 g0 = gq[q][0] * r8, g1 = gq[q][1] * r8;
                xv[s2].x = pack4_fp8(x[0] * g0[0], x[1] * g0[1], x[2] * g0[2], x[3] * g0[3]); xv[s2].y = pack4_fp8(x[4] * g1[0], x[5] * g1[1], x[6] * g1[2], x[7] * g1[3]); } }
#pragma unroll
        for (int s2 = 0; s2 < 16; s2 += 2) { const u32x4 v16 = widen8((u32x2){xv[s2].x, xv[s2].y}, (u32x2){xv[s2 + 1].x, xv[s2 + 1].y});
            *(u32x4*)(XN2 + (size_t)t * 1024 + kh * 512 + 32 * (s2 + (fq & 1)) + 8 * (fq & 2)) = v16; } }
    if (kh == 0) { float lg[8]; int le[8];
#pragma unroll
        for (int m = 0; m < 2; ++m)
#pragma unroll
            for (int j = 0; j < 4; ++j) { const int e = 16 * m + 4 * fq + j; le[m * 4 + j] = e; lg[m * 4 + j] = acc[m][j] * rs + br[e]; }
        float tv[4]; int te[4];
#pragma unroll
        for (int r = 0; r < 4; ++r) { float bv = lg[0]; int bi = le[0];
#pragma unroll
            for (int q = 1; q < 8; ++q) if (lg[q] > bv) { bv = lg[q]; bi = le[q]; }
#pragma unroll
            for (int sft = 16; sft < 64; sft <<= 1) { const float ov = sxor(bv, sft); const int oi = sxor(bi, sft); if (ov > bv || (ov == bv && oi < bi)) { bv = ov; bi = oi; } }
            tv[r] = bv; te[r] = bi;
#pragma unroll
            for (int q = 0; q < 8; ++q) if (le[q] == bi) lg[q] = -3.0e38f; }
        const float e1 = __expf(tv[1] - tv[0]), e2 = __expf(tv[2] - tv[0]), e3 = __expf(tv[3] - tv[0]); const float inv = 1.0f / (1.0f + e1 + e2 + e3);
        if (fq == 0 && real) { *(int4*)(TOPE + (size_t)t * 4) = make_int4(te[0], te[1], te[2], te[3]); *(f32x4*)(TOPG + (size_t)t * 4) = (f32x4){inv, e1 * inv, e2 * inv, e3 * inv};
#pragma unroll
            for (int k = 0; k < 4; ++k) { tek[k] = te[k]; lrk[k] = atomicAdd((int*)&hist[te[k]], 1); } } }
    __syncthreads();
    if (tid < 32) { const int hcount = hist[tid]; bbase[tid] = (hcount && real) ? atomicAdd((int*)(ws + OFF_CTL + CTL_CUR) + tid, hcount) : 0; }
    __syncthreads();
    if (kh == 0 && fq == 0 && real) { int* POS = (int*)(ws + OFF_POS); int* STOKE = (int*)(ws + OFF_STOKE); int ps[4];
#pragma unroll
        for (int k = 0; k < 4; ++k) { ps[k] = bbase[tek[k]] + lrk[k]; STOKE[(size_t)tek[k] * NTOK + ps[k]] = t; }
        *(int4*)(POS + (size_t)t * 4) = make_int4(ps[0], ps[1], ps[2], ps[3]); }
}

__device__ __forceinline__ void build_tables(const int wv, LAS unsigned char* lds) {
    KParams& p = *kparams();
    LAS int* ts = (LAS int*)(lds + LX_TSTART); LAS int* sb = (LAS int*)(lds + LX_SBASE); LAS int* cn = (LAS int*)(lds + LX_CNT);
    if (wv == 0) { const int l = lane_id(); int* gc = (int*)(p.ws + OFF_CTL + CTL_CUR);
        const int c = (l < 32) ? (int)__hip_atomic_load(gc + l, __ATOMIC_RELAXED, __HIP_MEMORY_SCOPE_AGENT) : 0; const int tl = (c + 255) >> 8; int v = tl;
#pragma unroll
        for (int d = 1; d < 32; d <<= 1) { const int o = __builtin_amdgcn_ds_bpermute((l - d) << 2, v); if (l >= d) v += o; }
        if (l < 32) { cn[l] = c; sb[l] = (v - tl) * 256; ts[l + 1] = v; if (l == 0) ts[0] = 0; } }
    __syncthreads();
    { const int tid = (wv << 6) | lane_id(); LAS unsigned char* te = (LAS unsigned char*)(lds + LX_TEXP); const int nt = ts[32];
      if (tid < nt) { int e = 0; while (e < 31 && tid >= ts[e + 1]) ++e; te[tid] = (unsigned char)e; } }
    __syncthreads();
}

__device__ __forceinline__ void phase_combine(const int wv, const bool real = true) {
    KParams& p = *kparams();
    const int tid = opaque_tid(wv), wid = tid >> 6, lane = tid & 63; unsigned char* ws = p.ws;
    const int* SLOT = (const int*)(ws + OFF_SLOT); const float* TOPG = (const float*)(ws + OFF_TOPG); const unsigned char* YS = ws + OFF_YS; const bf16_t* X1 = (const bf16_t*)(ws + OFF_X1B); float* out = p.out;
    for (int t0 = (blockIdx.x * 8 + wid) * 8; t0 < NTOK; t0 += gridDim.x * 64) {
        int4 sl[8]; f32x4 gg[8];
#pragma unroll
        for (int i = 0; i < 8; ++i) { sl[i] = *(const int4*)(SLOT + (size_t)(t0 + i) * 4); gg[i] = *(const f32x4*)(TOPG + (size_t)(t0 + i) * 4) * (1.0f / 32.0f); }
#pragma unroll
        for (int i = 0; i < 8; ++i) { const int t = t0 + i; const int s4[4] = {sl[i].x, sl[i].y, sl[i].z, sl[i].w}; const int c = 16 * lane; float acc[16];
            const u32x4 xa = __builtin_nontemporal_load((const u32x4*)(X1 + (size_t)t * 1024 + c)), xb = __builtin_nontemporal_load((const u32x4*)(X1 + (size_t)t * 1024 + c + 8));
            u32x4 yv[4];
#pragma unroll
            for (int k = 0; k < 4; ++k) yv[k] = __builtin_nontemporal_load((const u32x4*)(YS + (size_t)s4[k] * 1024 + c));
            { float f[8]; unpack8(xa, f);
#pragma unroll
              for (int j = 0; j < 8; ++j) acc[j] = f[j];
              unpack8(xb, f);
#pragma unroll
              for (int j = 0; j < 8; ++j) acc[8 + j] = f[j]; }
#pragma unroll
            for (int k = 0; k < 4; ++k) {
#pragma unroll
                for (int w4 = 0; w4 < 4; ++w4) { const int word = (int)yv[k][w4]; const f32x2 lo = __builtin_amdgcn_cvt_pk_f32_fp8(word, false), hi = __builtin_amdgcn_cvt_pk_f32_fp8(word, true); const f32x2 g2 = {gg[i][k], gg[i][k]};
                    f32x2 a01 = {acc[4 * w4], acc[4 * w4 + 1]}, a23 = {acc[4 * w4 + 2], acc[4 * w4 + 3]}; a01 = g2 * lo + a01; a23 = g2 * hi + a23;
                    acc[4 * w4] = a01[0]; acc[4 * w4 + 1] = a01[1]; acc[4 * w4 + 2] = a23[0]; acc[4 * w4 + 3] = a23[1]; } }
            float* dst = real ? out : (float*)(ws + OFF_ACT);
#pragma unroll
            for (int w4 = 0; w4 < 4; ++w4) *(f32x4*)(dst + (size_t)t * 1024 + c + 4 * w4) = (f32x4){acc[4 * w4], acc[4 * w4 + 1], acc[4 * w4 + 2], acc[4 * w4 + 3]};
            if ((i & 3) == 3) asm volatile("" ::: "memory"); }
    }
}

__global__ void __launch_bounds__(512, 2) mk_fwd(Params p) {
    extern __shared__ __attribute__((aligned(16))) unsigned char lds_raw[];
    LAS unsigned char* lds = (LAS unsigned char*)lds_raw;
    unsigned char* ws = p.ws;
    const int wv = __builtin_amdgcn_readfirstlane((int)threadIdx.x >> 6);
    const bool multi = (p.ph_hi - p.ph_lo) > 1;
    XcdBarrier xb; xb.bar = (unsigned*)(ws + OFF_CTL); xb.x = 0; xb.st = (volatile LAS unsigned*)(lds + LDS_X);
    if (multi) {
        if (wv == 0 && lane_id() == 0) { *(LAS u32x4*)(lds + LDS_X) = zero4u(); }
        __syncthreads();
        xb = xcd_barrier_post((unsigned*)(ws + OFF_CTL), (volatile LAS unsigned*)(lds + LDS_X), wv);
    }
#if MFMA_BENCH
    { const int l = lane_id(); unsigned h = (unsigned)l * 2654435761u ^ (unsigned)blockIdx.x * 40503u ^ (unsigned)wv * 977u;
      i32x8 a, b;
#pragma unroll
      for (int j = 0; j < 8; ++j) { h = h * 1664525u + 1013904223u; a[j] = (int)(MFMA_BENCH == 1 ? ((h & 0x00ff00ffu) | 0x3f003f00u) : ((h & 0x0f0f0f0fu) | 0x30303030u));
                                    h = h * 1664525u + 1013904223u; b[j] = (int)(MFMA_BENCH == 1 ? ((h & 0x00ff00ffu) | 0x3f003f00u) : ((h & 0x0f0f0f0fu) | 0x30303030u)); }
      f32x4 c[8]; const f32x4 z0 = zero4f();
#pragma unroll
      for (int j = 0; j < 8; ++j) c[j] = z0;
      const int one_scale = 0x7f7f7f7f;
#pragma clang loop unroll(disable)
      for (int it = 0; it < (MFMA_BENCH == 1 ? 1875 : 938); ++it) {
#pragma unroll
          for (int j = 0; j < 8; ++j) {
              if (MFMA_BENCH == 1) c[j] = (j & 1) ? __builtin_amdgcn_mfma_f32_16x16x32_bf16(pg8::half8<1>(a), pg8::half8<1>(b), c[j], 0, 0, 0) : __builtin_amdgcn_mfma_f32_16x16x32_bf16(pg8::half8<0>(a), pg8::half8<0>(b), c[j], 0, 0, 0);
              else asm volatile("v_mfma_scale_f32_16x16x128_f8f6f4 %0, %1, %2, %0, %3, %3 op_sel_hi:[0,0,0]" : "+v"(c[j]) : "v"(a), "v"(b), "v"(one_scale)); } }
      asm volatile("s_nop 15\n\ts_nop 15" ::: "memory");
      float sm = 0.f;
#pragma unroll
      for (int j = 0; j < 8; ++j) sm += c[j][0] + c[j][1] + c[j][2] + c[j][3];
      if (sm == 1.2345f) *(float*)(ws + OFF_CTL + 8192) = sm; }
#endif
    for (int ph = p.ph_lo; ph < p.ph_hi; ++ph) {
      if (ph == 2 || ph == 3 || ph == 10) continue;
      for (int rep = 0; rep < (((DBL_MASK >> ph) & 1) ? 2 : 1); ++rep) {
        KParams& q = *kparams(); unsigned char* ws = q.ws;
        switch (ph) {
        case 0: phase_prep(wv, lds); break;
        case 1: {
                  { const int c = blockIdx.x, ne = NTILE - NRES - NSMALL, cntc = (ne - 1 - c >= 0) ? (ne - 1 - c) / 256 + 1 : 0;
                    auto grp_is = [&](int k) { int b_ = (int)blockIdx.x; asm volatile("" : "+s"(b_)); return b_ % 3 == k; };
                    if (grp_is(0)) { int cc = c; asm volatile("" : "+s"(cc)); prep_tiles(wv, lds, cntc, [&](int n) { return NSMALL + cc + n * 256; }); }
                    { SchedZ S; S.H = (const char*)(ws + OFF_H); S.WinT = (const char*)(ws + OFF_WINT); S.HM = (const char*)(ws + OFF_HM); S.WmkvT = (const char*)(ws + OFF_WMKVT); S.G = gridDim.x; S.c = blockIdx.x;
                      EpiZ E; E.Z = (bf16_t*)(ws + OFF_Z); E.KV = (bf16_t*)(ws + OFF_KV); E.GFp = (bf16_t*)(ws + OFF_GF); E.pn0 = 0; E.scale = 1.0f; pg8::gemm_phase(wv, lds, 1024, S, E); }
                    if (grp_is(1)) { int cc = c; asm volatile("" : "+s"(cc)); prep_tiles(wv, lds, cntc, [&](int n) { return NSMALL + cc + n * 256; }); }
                    { SchedZ8 S; S.H8 = (const char*)(ws + OFF_H8); S.WIN8 = (const char*)(ws + OFF_WIN8); S.G = gridDim.x; S.c = blockIdx.x;
                      EpiZ E; E.Z = (bf16_t*)(ws + OFF_Z); E.KV = (bf16_t*)(ws + OFF_KV); E.GFp = (bf16_t*)(ws + OFF_GF); E.pn0 = 7; E.scale = 1.0f / 256.0f; pg8::gemm_phase<EpiZ, SchedZ8, 1>(wv, lds, 1024, S, E); }
                    if (grp_is(2)) { int cc = c; asm volatile("" : "+s"(cc)); prep_tiles(wv, lds, cntc, [&](int n) { return NSMALL + cc + n * 256; }); } }
                  { const int c = blockIdx.x; if (c >= 192) { const int r0 = c < 224 ? (c - 192) * TAIL1_A : 32 * TAIL1_A + (c - 224) * TAIL1_B;
                        prep_tiles(wv, lds, c < 224 ? TAIL1_A : TAIL1_B, [&](int n) { return NTILE - NRES + r0 + n; }); } } } break;
        case 2: phase_elem_c(wv); break;
        case 3: { pg8::DenseOrder S; S.init(ws + OFF_ALORA, ws + OFF_LORAT, NTOK, 1536, 256); EpiLora E; E.L = (float*)(ws + OFF_L); E.w0 = q.in[5]; E.a0 = q.in[7]; pg8::gemm_phase(wv, lds, 256, S, E); } break;
        case 4: phase_chunk_pre(wv, lds); break;
        case 5: for (int r2 = 0; r2 < (((DBL_MASK >> 16) & 1) ? 2 : 1); ++r2) phase_scan_seq(wv, lds);
                for (int r2 = 0; r2 < (((DBL_MASK >> 17) & 1) ? 2 : 1); ++r2) phase_dil_attn(wv, lds);
                for (int r2 = 0; r2 < (((DBL_MASK >> 18) & 1) ? 2 : 1); ++r2) phase_mem_attn(wv, lds); break;
        case 6: phase_post(wv); break;
        case 7: { pg8::DenseOrder S; S.init(ws + OFF_YCAT, ws + OFF_PCAT, NTOK, 1024, 1280); EpiMixCat E; E.mixbf = (bf16_t*)(ws + OFF_MIXBF); E.GF = (const bf16_t*)(ws + OFF_GF); E.tid = (wv << 6) | lane_id(); pg8::gemm_phase(wv, lds, 1280, S, E); } break;
        case 8: { pg8::DenseOrder S; S.init(ws + OFF_MIXBF, ws + OFF_WOT, NTOK, 1024, 1024); EpiX1 E; E.x = q.in[0]; E.x1 = (bf16_t*)(ws + OFF_X1B); pg8::gemm_phase(wv, lds, 1024, S, E); } break;
        case 9: phase_router(wv, lds, rep + 1 == (((DBL_MASK >> ph) & 1) ? 2 : 1)); break;
        case 11: { build_tables(wv, lds);
                   SchedMoe<true> S; S.A = (const char*)(ws + OFF_XN2); S.Bt = (const char*)(ws + OFF_W1T); S.tstart = (const LAS int*)(lds + LX_TSTART); S.stok = (const int*)(ws + OFF_STOKE); S.lgN = 3; S.total = S.tstart[32] * 8; S.estride = (size_t)2048 * 1024; S.tbytes = (size_t)256 * 1024;
                   EpiSwiglu E; E.act = ws + OFF_ACT; E.b1 = q.in[29]; E.lds = lds; pg8::gemm_phase<EpiSwiglu, SchedMoe<true>, 1>(wv, lds, 1024, S, E);
                   { const int* TOPE = (const int*)(ws + OFF_TOPE); const int* POS = (const int*)(ws + OFF_POS); int* SLOT = (int*)(ws + OFF_SLOT); const LAS int* sb = (const LAS int*)(lds + LX_SBASE);
                     for (int i = blockIdx.x * 512 + ((wv << 6) | lane_id()); i < NTOK * 4; i += gridDim.x * 512) SLOT[i] = sb[TOPE[i]] + POS[i]; }
                   { const int c = blockIdx.x, rem = S.total & 255, nearly = rem ? 256 - rem : 0, j = ((c & 7) * 32 + (c >> 3)) - rem;
                     if (rem && j >= 0 && j < 128) prep_tiles(wv, lds, TAIL6, [&](int n) { return NTILE - NRES + NRES1 + n * 128 + j; });
                     const int m = 128 - (nearly < 128 ? nearly : 128);
                     if (m > 0) { const int nf = m * TAIL6, top = nf - 1 - c; prep_tiles(wv, lds, top >= 0 ? top / (int)gridDim.x + 1 : 0, [&](int n) { const int f = top - n * (int)gridDim.x; return NTILE - NRES + NRES1 + (f / m) * 128 + nearly + (f % m); }); } } } break;
        case 12: { SchedMoe<false> S;
                   S.A = (const char*)(ws + OFF_ACT); S.Bt = (const char*)(ws + OFF_W2T); S.tstart = (const LAS int*)(lds + LX_TSTART); S.stok = nullptr; S.lgN = 2; S.total = S.tstart[32] * 4; S.estride = (size_t)1024 * 1024; S.tbytes = (size_t)256 * 1024;
                   EpiYs E; E.ys = ws + OFF_YS; E.b2 = q.in[31]; E.lds = lds; pg8::gemm_phase<EpiYs, SchedMoe<false>, 1>(wv, lds, 1024, S, E); } break;
        case 13: phase_combine(wv, rep + 1 == (((DBL_MASK >> ph) & 1) ? 2 : 1)); break;
        default: break;
        }
      }
        if (ph + 1 < p.ph_hi) xcd_barrier(xb, wv);
        if (((DBL_MASK >> 20) & 1) && ph == 3 && multi) for (int e = 0; e < 10; ++e) xcd_barrier(xb, wv);
    }
}

extern "C" void kernel_launch(void* const* d_in, const int* in_sizes, int n_in, void* d_out, int out_size, void* d_ws, size_t ws_size, hipStream_t stream) {
    static int ready = 0;
    if (ready == 0) {
        if (n_in != 32 || out_size != NTOK * 1024 || ws_size < WS_NEED) { fprintf(stderr, "kernel_launch: unexpected shapes (n_in %d, out %d, ws %zu < %zu)\n", n_in, out_size, ws_size, (size_t)WS_NEED); ready = -1; return; }
        if (hipFuncSetAttribute((const void*)mk_fwd, hipFuncAttributeMaxDynamicSharedMemorySize, LDS_BYTES) != hipSuccess) { fprintf(stderr, "kernel_launch: hipFuncSetAttribute failed\n"); ready = -1; return; }
        int per_cu = 0, dev = 0, cus = 0; hipGetDevice(&dev); hipDeviceGetAttribute(&cus, hipDeviceAttributeMultiprocessorCount, dev);
        hipOccupancyMaxActiveBlocksPerMultiprocessor(&per_cu, (const void*)mk_fwd, 512, LDS_BYTES);
        if (per_cu < 1 || cus < 256) { fprintf(stderr, "kernel_launch: occupancy %d blocks/CU on %d CUs; need >= 1 on 256\n", per_cu, cus); ready = -1; (void)hipGetLastError(); return; }
        ready = 1;
    }
    if (ready < 0) return;
    hipMemsetAsync((char*)d_ws + OFF_CTL, 0, CTL_BYTES, stream);
    Params p{};
    for (int i = 0; i < 32; ++i) p.in[i] = (const float*)d_in[i];
    p.out = (float*)d_out; p.ws = (unsigned char*)d_ws;
#if MK_N_LAUNCH_PER_PHASE
    for (int ph = 0; ph < NPHASE; ++ph) { p.ph_lo = ph; p.ph_hi = ph + 1; hipLaunchKernelGGL(mk_fwd, dim3(256), dim3(512), LDS_BYTES, stream, p); }
#else
    p.ph_lo = 0; p.ph_hi = NPHASE;
    void* args[] = {&p};
    hipError_t e = hipLaunchCooperativeKernel((const void*)mk_fwd, dim3(256), dim3(512), args, LDS_BYTES, stream);
    if (e != hipSuccess) fprintf(stderr, "cooperative launch failed: %s\n", hipGetErrorString(e));
#endif
}
```
